# Optimizing an MI355X kernel written in HIP

```python
import math
import jax
import jax.numpy as jnp
from jax import lax
import numpy as np

D_MODEL = 2048
BATCH = 4
SEQ = 2048
DEPTH = 2

CHUNK = 64
N_META = 16
MIX_WIDTH = D_MODEL
HGRN_DK = 128
HGRN_WIDTH = MIX_WIDTH // 4
HGRN_HEADS = HGRN_WIDTH // HGRN_DK
HGRN_BLOCK = 64
S5_CH = 16
S5_STATE = 64
S5_WIDTH = MIX_WIDTH // 4
S5_GROUPS = S5_WIDTH // S5_CH
DIFF_DH = 128
DIFF_WIDTH = MIX_WIDTH - HGRN_WIDTH - S5_WIDTH
DIFF_HEADS = DIFF_WIDTH // (2 * DIFF_DH)
Q_BLOCK = 128
N_GROUPS = 8
EXPERTS_PER_GROUP = 8
N_EXPERTS = N_GROUPS * EXPERTS_PER_GROUP
TOP_K = 2
D_EXPERT = D_MODEL // 4
MOE_BLOCK = 128
RMS_EPS = 1e-6
IN_SPLITS = (HGRN_WIDTH, HGRN_WIDTH, HGRN_WIDTH, HGRN_WIDTH, S5_WIDTH, DIFF_WIDTH, DIFF_WIDTH, DIFF_WIDTH)
IN_WIDTH = 4 * HGRN_WIDTH + S5_WIDTH + 3 * DIFF_WIDTH

kernel_name = 'hymba_hgrn2_s5_diffattn_hiermoe'


def rms_norm(x, w):
    xf = x.astype(jnp.float32)
    y = xf * lax.rsqrt(jnp.mean(xf * xf, axis=-1, keepdims=True) + RMS_EPS)
    return (y * w.astype(jnp.float32)).astype(x.dtype)


def chunk_ids(length):
    pos = jnp.arange(length, dtype=jnp.int32)
    return jnp.where(pos < N_META, 0, (pos - N_META) // CHUNK + 1)


def chunk_end(p, length):
    end = N_META if p < N_META else N_META + ((p - N_META) // CHUNK + 1) * CHUNK
    return min(end, length)


def split_columns(p):
    outs, start = [], 0
    for width in IN_SPLITS:
        outs.append(p[..., start:start + width])
        start += width
    return outs


def hgrn2_mixer(q, f_pre, v, g, lower_bound, norm_w):
    f32 = jnp.float32
    bsz, length, _ = q.shape
    nblk = -(-length // HGRN_BLOCK)
    pad = nblk * HGRN_BLOCK - length
    lb = lower_bound.astype(f32)
    log_f = jnp.logaddexp(jnp.log(lb), jnp.log1p(-lb) + jax.nn.log_sigmoid(f_pre.astype(f32)))
    k = -jnp.expm1(log_f)

    def blocks(t):
        t = jnp.pad(t.astype(f32), ((0, 0), (0, pad), (0, 0)))
        t = t.reshape(bsz, nblk, HGRN_BLOCK, HGRN_HEADS, HGRN_DK)
        return t.transpose(1, 0, 3, 2, 4)

    causal = jnp.tril(jnp.ones((HGRN_BLOCK, HGRN_BLOCK), bool))[:, :, None]

    def step(state, blk):
        q_c, k_c, v_c, lf_c = blk
        b = jnp.cumsum(lf_c, axis=2)
        rel = jnp.where(causal, b[:, :, :, None, :] - b[:, :, None, :, :], -jnp.inf)
        scores = jnp.einsum('bhtk,bhsk,bhtsk->bhts', q_c, k_c, jnp.exp(rel))
        out = (jnp.einsum('bhts,bhsv->bhtv', scores, v_c)
               + jnp.einsum('bhtk,bhkv->bhtv', q_c * jnp.exp(b), state))
        b_end = b[:, :, -1:, :]
        state = (jnp.exp(b_end[:, :, 0, :, None]) * state
                 + jnp.einsum('bhsk,bhsv->bhkv', k_c * jnp.exp(b_end - b), v_c))
        return state, out

    s0 = jnp.zeros((bsz, HGRN_HEADS, HGRN_DK, HGRN_DK), f32)
    _, o = lax.scan(step, s0, (blocks(q), blocks(k), blocks(v), blocks(log_f)))
    o = o.transpose(1, 0, 3, 2, 4).reshape(bsz, nblk * HGRN_BLOCK, HGRN_HEADS, HGRN_DK)[:, :length]
    gate = g.astype(f32).reshape(bsz, length, HGRN_HEADS, HGRN_DK)
    o = rms_norm(o, norm_w) * jax.nn.silu(gate)
    return o.reshape(bsz, length, HGRN_WIDTH)


def s5_mixer(u, a_re, a_im, b_re, b_im, c_re, c_im, d_skip, log_dt, w_glu, b_glu):
    f32 = jnp.float32
    bsz, length, _ = u.shape
    uf = u.astype(f32).reshape(bsz, length, S5_GROUPS, S5_CH)
    a_re, a_im = a_re.astype(f32), a_im.astype(f32)
    dt = jnp.exp(log_dt.astype(f32))[:, None]
    mag = jnp.exp(a_re * dt)
    ab_re, ab_im = mag * jnp.cos(a_im * dt), mag * jnp.sin(a_im * dt)
    den = a_re * a_re + a_im * a_im
    z_re = ((ab_re - 1.0) * a_re + ab_im * a_im) / den
    z_im = (ab_im * a_re - (ab_re - 1.0) * a_im) / den
    b_re, b_im = b_re.astype(f32), b_im.astype(f32)
    bb_re = z_re[..., None] * b_re - z_im[..., None] * b_im
    bb_im = z_re[..., None] * b_im + z_im[..., None] * b_re
    bu_re = jnp.einsum('blgc,gpc->blgp', uf, bb_re)
    bu_im = jnp.einsum('blgc,gpc->blgp', uf, bb_im)
    a_seq_re = jnp.broadcast_to(ab_re, bu_re.shape)
    a_seq_im = jnp.broadcast_to(ab_im, bu_im.shape)

    def combine(e1, e2):
        a1r, a1i, b1r, b1i = e1
        a2r, a2i, b2r, b2i = e2
        return (a2r * a1r - a2i * a1i, a2r * a1i + a2i * a1r,
                a2r * b1r - a2i * b1i + b2r, a2r * b1i + a2i * b1r + b2i)

    _, _, x_re, x_im = lax.associative_scan(combine, (a_seq_re, a_seq_im, bu_re, bu_im), axis=1)
    y = (jnp.einsum('blgp,gcp->blgc', x_re, c_re.astype(f32))
         - jnp.einsum('blgp,gcp->blgc', x_im, c_im.astype(f32)))
    y = y + d_skip.astype(f32).reshape(S5_GROUPS, S5_CH) * uf
    y = jax.nn.gelu(y.reshape(bsz, length, S5_WIDTH))
    val, gate = jnp.split(y @ w_glu.astype(f32) + b_glu.astype(f32), 2, axis=-1)
    return val * jax.nn.sigmoid(gate)


def diff_attention_mixer(q, k, v, lq1, lk1, lq2, lk2, subln_w, lambda_init):
    f32 = jnp.float32
    bsz, length, _ = q.shape
    q = q.reshape(bsz, length, DIFF_HEADS, 2, DIFF_DH).transpose(0, 2, 3, 1, 4)
    k = k.reshape(bsz, length, DIFF_HEADS, 2, DIFF_DH).transpose(0, 2, 3, 1, 4)
    v = v.reshape(bsz, length, DIFF_HEADS, 2 * DIFF_DH).transpose(0, 2, 1, 3).astype(f32)
    lam = (jnp.exp(jnp.sum(lq1.astype(f32) * lk1.astype(f32)))
           - jnp.exp(jnp.sum(lq2.astype(f32) * lk2.astype(f32))) + lambda_init)
    ids = chunk_ids(length)
    scale = DIFF_DH ** -0.5
    outs = []
    for q0 in range(0, length, Q_BLOCK):
        q1 = min(q0 + Q_BLOCK, length)
        kend = chunk_end(q1 - 1, length)
        s = jnp.einsum('bhiqd,bhikd->bhiqk', q[:, :, :, q0:q1], k[:, :, :, :kend]).astype(f32) * scale
        mask = ids[None, :kend] <= ids[q0:q1, None]
        p = jax.nn.softmax(jnp.where(mask, s, -jnp.inf), axis=-1)
        w = p[:, :, 0] - lam * p[:, :, 1]
        outs.append(jnp.einsum('bhqk,bhkd->bhqd', w, v[:, :, :kend]))
    o = jnp.concatenate(outs, axis=2)
    o = rms_norm(o, subln_w) * (1.0 - lambda_init)
    return o.transpose(0, 2, 1, 3).reshape(bsz, length, DIFF_WIDTH)


def hierarchical_moe(h, w_rg, b_rg, w_re, b_re, w1, w3, w2):
    f32 = jnp.float32
    bsz, length, dim = h.shape
    xt = h.reshape(-1, dim)
    n_tok = xt.shape[0]
    g_logits = (xt @ w_rg).astype(f32) + b_rg.astype(f32)
    g_prob = jax.nn.softmax(g_logits, axis=-1)
    g_sel = jnp.argmax(g_logits, axis=-1).astype(jnp.int32)
    p_group = jnp.take_along_axis(g_prob, g_sel[:, None], axis=1)
    e_logits = ((xt @ w_re).astype(f32) + b_re.astype(f32)).reshape(n_tok, N_GROUPS, EXPERTS_PER_GROUP)
    e_logits = jnp.take_along_axis(e_logits, g_sel[:, None, None], axis=1)[:, 0]
    top_v, top_j = lax.top_k(e_logits, TOP_K)
    gate = jax.nn.softmax(top_v, axis=-1) * p_group
    expert = g_sel[:, None] * EXPERTS_PER_GROUP + top_j.astype(jnp.int32)

    n_assign = n_tok * TOP_K
    flat_e = expert.reshape(-1)
    order = jnp.argsort(flat_e)
    sorted_e = flat_e[order]
    counts = jnp.zeros((N_EXPERTS,), jnp.int32).at[flat_e].add(1)
    padded = (counts + MOE_BLOCK - 1) // MOE_BLOCK * MOE_BLOCK
    pad_end = jnp.cumsum(padded)
    pad_start = pad_end - padded
    start = jnp.cumsum(counts) - counts
    dest = pad_start[sorted_e] + jnp.arange(n_assign, dtype=jnp.int32) - start[sorted_e]
    n_blocks = -(-(n_assign + N_EXPERTS * (MOE_BLOCK - 1)) // MOE_BLOCK)
    n_rows = n_blocks * MOE_BLOCK
    row_token = jnp.full((n_rows,), n_tok, jnp.int32).at[dest].set(order // TOP_K)
    x_ext = jnp.concatenate([xt, jnp.zeros((1, dim), xt.dtype)], axis=0)
    xb = x_ext[row_token].reshape(n_blocks, MOE_BLOCK, dim)
    block_start = jnp.arange(n_blocks, dtype=jnp.int32) * MOE_BLOCK
    block_expert = jnp.minimum(jnp.searchsorted(pad_end, block_start, side='right'), N_EXPERTS - 1)

    def expert_block(args):
        rows, e = args
        hid = jax.nn.silu(rows @ w1[e]) * (rows @ w3[e])
        return hid @ w2[e]

    y_rows = lax.map(expert_block, (xb, block_expert)).reshape(n_rows, dim)
    contrib = y_rows[dest].astype(f32) * gate.reshape(-1)[order][:, None]
    out = jnp.zeros((n_tok, dim), f32).at[order // TOP_K].add(contrib)
    return out.astype(h.dtype).reshape(bsz, length, dim)


def setup_inputs(seed: int = 0) -> dict:
    key = jax.random.key(seed)
    keys = iter(jax.random.split(key, 40))
    f32 = jnp.float32

    def nrm(shape, scale):
        return scale * jax.random.normal(next(keys), shape, f32)

    def gain(shape):
        return 1.0 + 0.02 * jax.random.normal(next(keys), shape, f32)

    n_idx = jnp.arange(S5_STATE, dtype=f32)
    return {
        'x': nrm((BATCH, SEQ, D_MODEL), 1.0),
        'meta_tokens': nrm((N_META, D_MODEL), 1.0),
        'ln1_w': gain((DEPTH, D_MODEL)),
        'w_in': nrm((DEPTH, D_MODEL, IN_WIDTH), D_MODEL ** -0.5),
        'hgrn_lower_bounds': nrm((DEPTH, HGRN_WIDTH), 1.0),
        'hgrn_norm_w': gain((DEPTH, HGRN_DK)),
        's5_a_re': -0.5 + nrm((DEPTH, S5_GROUPS, S5_STATE), 0.01),
        's5_a_im': math.pi * n_idx + nrm((DEPTH, S5_GROUPS, S5_STATE), 0.01),
        's5_b_re': nrm((DEPTH, S5_GROUPS, S5_STATE, S5_CH), (2 * S5_CH) ** -0.5),
        's5_b_im': nrm((DEPTH, S5_GROUPS, S5_STATE, S5_CH), (2 * S5_CH) ** -0.5),
        's5_c_re': nrm((DEPTH, S5_GROUPS, S5_CH, S5_STATE), S5_STATE ** -0.5),
        's5_c_im': nrm((DEPTH, S5_GROUPS, S5_CH, S5_STATE), S5_STATE ** -0.5),
        's5_d': nrm((DEPTH, S5_WIDTH), 1.0),
        's5_log_dt': jax.random.uniform(next(keys), (DEPTH, S5_GROUPS), f32, math.log(1e-3), math.log(1e-1)),
        's5_w_glu': nrm((DEPTH, S5_WIDTH, 2 * S5_WIDTH), S5_WIDTH ** -0.5),
        's5_b_glu': nrm((DEPTH, 2 * S5_WIDTH), 0.01),
        'diff_lambda_q1': nrm((DEPTH, DIFF_DH), 0.1),
        'diff_lambda_k1': nrm((DEPTH, DIFF_DH), 0.1),
        'diff_lambda_q2': nrm((DEPTH, DIFF_DH), 0.1),
        'diff_lambda_k2': nrm((DEPTH, DIFF_DH), 0.1),
        'diff_subln_w': gain((DEPTH, 2 * DIFF_DH)),
        'w_out': nrm((DEPTH, MIX_WIDTH, D_MODEL), MIX_WIDTH ** -0.5),
        'ln2_w': gain((DEPTH, D_MODEL)),
        'router_group_w': nrm((DEPTH, D_MODEL, N_GROUPS), D_MODEL ** -0.5),
        'router_group_b': nrm((DEPTH, N_GROUPS), 0.01),
        'router_expert_w': nrm((DEPTH, D_MODEL, N_EXPERTS), D_MODEL ** -0.5),
        'router_expert_b': nrm((DEPTH, N_EXPERTS), 0.01),
        'expert_w1': nrm((DEPTH, N_EXPERTS, D_MODEL, D_EXPERT), D_MODEL ** -0.5),
        'expert_w3': nrm((DEPTH, N_EXPERTS, D_MODEL, D_EXPERT), D_MODEL ** -0.5),
        'expert_w2': nrm((DEPTH, N_EXPERTS, D_EXPERT, D_MODEL), D_EXPERT ** -0.5),
        'final_norm_w': gain((D_MODEL,)),
    }


def reference(x, meta_tokens, ln1_w, w_in, hgrn_lower_bounds, hgrn_norm_w, s5_a_re, s5_a_im,
              s5_b_re, s5_b_im, s5_c_re, s5_c_im, s5_d, s5_log_dt, s5_w_glu, s5_b_glu,
              diff_lambda_q1, diff_lambda_k1, diff_lambda_q2, diff_lambda_k2, diff_subln_w,
              w_out, ln2_w, router_group_w, router_group_b, router_expert_w, router_expert_b,
              expert_w1, expert_w3, expert_w2, final_norm_w):
    bsz = x.shape[0]
    meta = jnp.broadcast_to(meta_tokens.astype(x.dtype)[None], (bsz, N_META, D_MODEL))
    z = jnp.concatenate([meta, x], axis=1)
    lb_all = jnp.cumsum(jax.nn.softmax(hgrn_lower_bounds.astype(jnp.float32), axis=0), axis=0)
    lb_all = lb_all - lb_all[0]
    for layer in range(DEPTH):
        hn = rms_norm(z, ln1_w[layer])
        proj = hn @ w_in[layer]
        hq, hf, hi, hg, su, dq, dk, dv = split_columns(proj)
        o_a = hgrn2_mixer(hq, hf, hi, hg, lb_all[layer], hgrn_norm_w[layer])
        o_b = s5_mixer(su, s5_a_re[layer], s5_a_im[layer], s5_b_re[layer], s5_b_im[layer],
                       s5_c_re[layer], s5_c_im[layer], s5_d[layer], s5_log_dt[layer],
                       s5_w_glu[layer], s5_b_glu[layer])
        lambda_init = 0.8 - 0.6 * math.exp(-0.3 * layer)
        o_c = diff_attention_mixer(dq, dk, dv, diff_lambda_q1[layer], diff_lambda_k1[layer],
                                   diff_lambda_q2[layer], diff_lambda_k2[layer],
                                   diff_subln_w[layer], lambda_init)
        mixed = jnp.concatenate([o_a.astype(z.dtype), o_b.astype(z.dtype), o_c.astype(z.dtype)], axis=-1)
        z = z + mixed @ w_out[layer]
        z = z + hierarchical_moe(rms_norm(z, ln2_w[layer]), router_group_w[layer], router_group_b[layer],
                                 router_expert_w[layer], router_expert_b[layer],
                                 expert_w1[layer], expert_w3[layer], expert_w2[layer])
    return rms_norm(z, final_norm_w)[:, N_META:]
```

```cpp
#include <hip/hip_runtime.h>
#include <stdint.h>
#include <math.h>

namespace {
typedef unsigned short bf16_t;
constexpr int DM = 2048, NB = 4, SEQ = 2048, NMETA = 16, LL = SEQ + NMETA, TOK = NB * LL, MP = 8448;
constexpr int HW = 512, HDK = 128;
constexpr int S5G = 32;
constexpr int INW = 5632, PAW = 2560, QKVW = 3072;
constexpr int NE = 64, DE = 512, NASSIGN = TOK * 2;
constexpr int RB = 64;
constexpr int NRMAX = NASSIGN + NE * RB;
constexpr float EPS = 1e-6f;

__device__ __forceinline__ float bf2f(bf16_t h) { return __uint_as_float(((unsigned)h) << 16); }
__device__ __forceinline__ bf16_t f2bf(float f) { unsigned u = __float_as_uint(f); return (bf16_t)((u + 0x7fffu + ((u >> 16) & 1u)) >> 16); }
__device__ __forceinline__ float sigmoidf_(float x) { return 1.f / (1.f + expf(-x)); }

template <class F>
__global__ void __launch_bounds__(256) k_gemm(int K, F f) {
    __shared__ float As[16][68];
    __shared__ float Bs[16][68];
    const int tid = threadIdx.x, tx = tid & 15, ty = tid >> 4;
    const int bx = blockIdx.x, by = blockIdx.y, z = blockIdx.z;
    const int bm = by * 64, bn = bx * 64;
    float acc[4][4];
#pragma unroll
    for (int i = 0; i < 4; ++i)
#pragma unroll
        for (int j = 0; j < 4; ++j) acc[i][j] = 0.f;
    if (!f.active(z, by)) return;
    for (int k0 = 0; k0 < K; k0 += 16) {
#pragma unroll
        for (int j = 0; j < 4; ++j) {
            const int idx = tid + 256 * j;
            { const int m = idx >> 4, k = idx & 15; As[k][m] = f.a(z, by, bm + m, k0 + k); }
            { const int k = idx >> 6, n = idx & 63; Bs[k][n] = f.b(z, by, k0 + k, bn + n); }
        }
        __syncthreads();
#pragma unroll
        for (int k = 0; k < 16; ++k) {
            const float4 a4 = *(const float4*)&As[k][ty * 4];
            const float4 b4 = *(const float4*)&Bs[k][tx * 4];
            const float a[4] = {a4.x, a4.y, a4.z, a4.w}, b[4] = {b4.x, b4.y, b4.z, b4.w};
#pragma unroll
            for (int i = 0; i < 4; ++i)
#pragma unroll
                for (int j = 0; j < 4; ++j) acc[i][j] = fmaf(a[i], b[j], acc[i][j]);
        }
        __syncthreads();
    }
#pragma unroll
    for (int i = 0; i < 4; ++i)
#pragma unroll
        for (int j = 0; j < 4; ++j) f.e(z, by, bm + ty * 4 + i, bn + tx * 4 + j, acc[i][j]);
}

struct FInProj {
    const bf16_t* HN; const float* W; float* PA; bf16_t* QKV;
    __device__ bool active(int, int) const { return true; }
    __device__ float a(int, int, int m, int k) const { return bf2f(HN[(size_t)m * DM + k]); }
    __device__ float b(int, int, int k, int n) const { return W[(size_t)k * INW + n]; }
    __device__ void e(int, int, int m, int n, float v) const {
        if (n < PAW) PA[(size_t)m * PAW + n] = v; else QKV[(size_t)m * QKVW + (n - PAW)] = f2bf(v);
    }
};
struct FGlu {
    const bf16_t* YG; const float* W; const float* bias; float* T;
    __device__ bool active(int, int) const { return true; }
    __device__ float a(int, int, int m, int k) const { return bf2f(YG[(size_t)m * 512 + k]); }
    __device__ float b(int, int, int k, int n) const { return W[(size_t)k * 1024 + n]; }
    __device__ void e(int, int, int m, int n, float v) const { T[(size_t)m * 1024 + n] = v + bias[n]; }
};
struct FScore {
    const bf16_t* QKV; float* S;
    __device__ bool active(int, int) const { return true; }
    __device__ float a(int z, int, int m, int k) const {
        if (m >= LL) return 0.f; const int b = z >> 3, h = (z >> 1) & 3, i = z & 1;
        return bf2f(QKV[(size_t)(b * LL + m) * QKVW + h * 256 + i * 128 + k]); }
    __device__ float b(int z, int, int k, int n) const {
        if (n >= LL) return 0.f; const int b = z >> 3, h = (z >> 1) & 3, i = z & 1;
        return bf2f(QKV[(size_t)(b * LL + n) * QKVW + 1024 + h * 256 + i * 128 + k]); }
    __device__ void e(int z, int, int m, int n, float v) const {
        if (m >= LL || n >= LL) return;
        const int cq = m < NMETA ? 0 : (m - NMETA) / 64 + 1, ck = n < NMETA ? 0 : (n - NMETA) / 64 + 1;
        S[((size_t)z * LL + m) * LL + n] = (ck <= cq) ? v * 0.08838834764831845f : -INFINITY;
    }
};
struct FPV {
    const float* S; const bf16_t* QKV; float* OC; const float* lam;
    __device__ bool active(int, int) const { return true; }
    __device__ float a(int z, int, int m, int k) const {
        if (m >= LL) return 0.f;
        return S[((size_t)(z * 2) * LL + m) * LL + k] - lam[0] * S[((size_t)(z * 2 + 1) * LL + m) * LL + k]; }
    __device__ float b(int z, int, int k, int n) const { const int b = z >> 2, h = z & 3;
        return bf2f(QKV[(size_t)(b * LL + k) * QKVW + 2048 + h * 256 + n]); }
    __device__ void e(int z, int, int m, int n, float v) const { if (m >= LL) return; const int b = z >> 2, h = z & 3;
        OC[(size_t)(b * LL + m) * 1024 + h * 256 + n] = v; }
};
struct FOutProj {
    const bf16_t* MIX; const float* W; float* Z;
    __device__ bool active(int, int) const { return true; }
    __device__ float a(int, int, int m, int k) const { return m < TOK ? bf2f(MIX[(size_t)m * DM + k]) : 0.f; }
    __device__ float b(int, int, int k, int n) const { return W[(size_t)k * DM + n]; }
    __device__ void e(int, int, int m, int n, float v) const { if (m < TOK) Z[(size_t)m * DM + n] += v; }
};
struct FMoeUp {
    const bf16_t* HN; const int* rowtok; const int* blk_e; const float* W; float* H1; bf16_t* H; int pass; int pad;
    __device__ bool active(int, int by) const { return blk_e[by] >= 0; }
    __device__ float a(int, int, int m, int k) const { const int t = rowtok[m]; return t < 0 ? 0.f : bf2f(HN[(size_t)t * DM + k]); }
    __device__ float b(int, int by, int k, int n) const { return W[((size_t)blk_e[by] * DM + k) * DE + n]; }
    __device__ void e(int, int, int m, int n, float v) const {
        if (pass == 0) H1[(size_t)m * DE + n] = v;
        else { const float g = H1[(size_t)m * DE + n]; H[(size_t)m * DE + n] = f2bf(g * sigmoidf_(g) * v); }
    }
};
struct FMoeDown {
    const bf16_t* H; const int* blk_e; const float* W; bf16_t* Y;
    __device__ bool active(int, int by) const { return blk_e[by] >= 0; }
    __device__ float a(int, int, int m, int k) const { return bf2f(H[(size_t)m * DE + k]); }
    __device__ float b(int, int by, int k, int n) const { return W[((size_t)blk_e[by] * DE + k) * DM + n]; }
    __device__ void e(int, int, int m, int n, float v) const { Y[(size_t)m * DM + n] = f2bf(v); }
};

__device__ __forceinline__ float block_sum_256(float v, float* red) {
#pragma unroll
    for (int o = 32; o > 0; o >>= 1) v += __shfl_xor(v, o);
    const int w = threadIdx.x >> 6;
    __syncthreads();
    if ((threadIdx.x & 63) == 0) red[w] = v;
    __syncthreads();
    float s = 0.f;
    const int nw = blockDim.x >> 6;
    for (int i = 0; i < nw; ++i) s += red[i];
    return s;
}

__global__ void __launch_bounds__(256) k_build_z(const float* x, const float* meta, float* Z) {
    const int r = blockIdx.x, tid = threadIdx.x;
    float4* dst = (float4*)(Z + (size_t)r * DM);
    if (r >= TOK) { dst[tid] = make_float4(0, 0, 0, 0); dst[tid + 256] = make_float4(0, 0, 0, 0); return; }
    const int b = r / LL, t = r % LL;
    const float4* src = (const float4*)(t < NMETA ? meta + (size_t)t * DM : x + ((size_t)b * SEQ + (t - NMETA)) * DM);
    dst[tid] = src[tid]; dst[tid + 256] = src[tid + 256];
}

__global__ void __launch_bounds__(512) k_prep(const float* lbnd, const float* lq1, const float* lk1, const float* lq2, const float* lk2, float* lbtab, float* lam) {
    const int c = threadIdx.x;
    const float l0 = lbnd[c], l1 = lbnd[512 + c], m = fmaxf(l0, l1), e0 = expf(l0 - m), e1 = expf(l1 - m);
    lbtab[c] = 0.f; lbtab[512 + c] = e1 / (e0 + e1);
    if (c < 2) {
        float s1 = 0.f, s2 = 0.f;
        for (int i = 0; i < 128; ++i) { s1 += lq1[c * 128 + i] * lk1[c * 128 + i]; s2 += lq2[c * 128 + i] * lk2[c * 128 + i]; }
        const float li = 0.8f - 0.6f * expf(-0.3f * (float)c);
        lam[c] = expf(s1) - expf(s2) + li;
    }
}

__global__ void __launch_bounds__(256) k_rmsnorm(const float* Z, const float* w, bf16_t* HN) {
    __shared__ float red[8];
    const int r = blockIdx.x, tid = threadIdx.x;
    const float* zr = Z + (size_t)r * DM;
    float v[8]; float ss = 0.f;
#pragma unroll
    for (int j = 0; j < 8; ++j) { v[j] = zr[tid + 256 * j]; ss += v[j] * v[j]; }
    ss = block_sum_256(ss, red);
    const float rs = rsqrtf(ss * (1.f / DM) + EPS);
#pragma unroll
    for (int j = 0; j < 8; ++j) HN[(size_t)r * DM + tid + 256 * j] = f2bf(v[j] * rs * w[tid + 256 * j]);
}

__global__ void __launch_bounds__(256) k_hgrn(const float* PA, const float* lb, float* OA) {
    __shared__ float qs[128], fs[128], ks[128], op[2][128];
    const int b = blockIdx.x >> 2, h = blockIdx.x & 3, tid = threadIdx.x, v = tid & 127, kh = tid >> 7;
    float S[64];
#pragma unroll
    for (int j = 0; j < 64; ++j) S[j] = 0.f;
    for (int t = 0; t < LL; ++t) {
        const size_t r = (size_t)b * LL + t;
        if (tid < 128) {
            const int c = h * 128 + tid;
            const float q = PA[r * PAW + c], fp = PA[r * PAW + 512 + c], lbv = lb[c];
            const float sg = sigmoidf_(fp), sgn = sigmoidf_(-fp);
            qs[tid] = q; fs[tid] = lbv + (1.f - lbv) * sg; ks[tid] = (1.f - lbv) * sgn;
        }
        __syncthreads();
        const float vv = PA[r * PAW + 1024 + h * 128 + v];
        float part = 0.f;
#pragma unroll
        for (int j = 0; j < 64; ++j) { const int kk = kh * 64 + j; S[j] = fmaf(fs[kk], S[j], ks[kk] * vv); part = fmaf(qs[kk], S[j], part); }
        op[kh][v] = part;
        __syncthreads();
        if (tid < 128) OA[r * HW + h * 128 + v] = op[0][v] + op[1][v];
    }
}
__global__ void __launch_bounds__(128) k_hgrn_out(const float* OA, const float* PA, const float* nw, bf16_t* MIX) {
    __shared__ float red[2];
    const int r = blockIdx.x, h = blockIdx.y, k = threadIdx.x;
    const float o = OA[(size_t)r * HW + h * 128 + k];
    float ss = o * o;
#pragma unroll
    for (int off = 32; off > 0; off >>= 1) ss += __shfl_xor(ss, off);
    if ((k & 63) == 0) red[k >> 6] = ss;
    __syncthreads();
    ss = red[0] + red[1];
    const float g = PA[(size_t)r * PAW + 1536 + h * 128 + k];
    const float y = o * rsqrtf(ss * (1.f / 128.f) + EPS) * nw[k] * (g * sigmoidf_(g));
    MIX[(size_t)r * DM + h * 128 + k] = f2bf(y);
}

__device__ __forceinline__ float gelu_tanh(float x) {
    const float u = 0.7978845608028654f * (x + 0.044715f * x * x * x);
    return 0.5f * x * (1.f + tanhf(u));
}
__global__ void __launch_bounds__(64) k_s5(const float* PA, const float* a_re, const float* a_im, const float* b_re, const float* b_im,
                                           const float* c_re, const float* c_im, const float* dsk, const float* log_dt, bf16_t* YG) {
    __shared__ float us[16][16], xr[16][64], xi[16][64], cre[16][64], cim[16][64];
    const int b = blockIdx.x >> 5, g = blockIdx.x & 31, p = threadIdx.x;
    const float dt = expf(log_dt[g]), are = a_re[g * 64 + p], aim = a_im[g * 64 + p];
    const float mag = expf(are * dt), abr = mag * cosf(aim * dt), abi = mag * sinf(aim * dt);
    const float den = are * are + aim * aim;
    const float zr = ((abr - 1.f) * are + abi * aim) / den, zi = (abi * are - (abr - 1.f) * aim) / den;
    float bbr[16], bbi[16];
#pragma unroll
    for (int c = 0; c < 16; ++c) {
        const float br = b_re[(g * 64 + p) * 16 + c], bi = b_im[(g * 64 + p) * 16 + c];
        bbr[c] = zr * br - zi * bi; bbi[c] = zr * bi + zi * br;
        cre[c][p] = c_re[(g * 16 + c) * 64 + p]; cim[c][p] = c_im[(g * 16 + c) * 64 + p];
    }
    float x_r = 0.f, x_i = 0.f;
    for (int t0 = 0; t0 < LL; t0 += 16) {
#pragma unroll
        for (int j = 0; j < 4; ++j) { const int idx = p + 64 * j, tl = idx >> 4, c = idx & 15;
            us[tl][c] = PA[((size_t)b * LL + t0 + tl) * PAW + 2048 + g * 16 + c]; }
        __syncthreads();
        for (int tl = 0; tl < 16; ++tl) {
            float bur = 0.f, bui = 0.f;
#pragma unroll
            for (int c = 0; c < 16; ++c) { const float u = us[tl][c]; bur = fmaf(bbr[c], u, bur); bui = fmaf(bbi[c], u, bui); }
            const float nr = abr * x_r - abi * x_i + bur, ni = abr * x_i + abi * x_r + bui;
            x_r = nr; x_i = ni; xr[tl][p] = nr; xi[tl][p] = ni;
        }
        __syncthreads();
#pragma unroll
        for (int j = 0; j < 4; ++j) { const int idx = p + 64 * j, tl = idx >> 4, c = idx & 15;
            float y = 0.f;
            for (int q = 0; q < 64; ++q) y += cre[c][q] * xr[tl][q] - cim[c][q] * xi[tl][q];
            y += dsk[g * 16 + c] * us[tl][c];
            YG[((size_t)b * LL + t0 + tl) * 512 + g * 16 + c] = f2bf(gelu_tanh(y)); }
        __syncthreads();
    }
}
__global__ void __launch_bounds__(256) k_glu_out(const float* T, bf16_t* MIX) {
    const int r = blockIdx.x, tid = threadIdx.x;
#pragma unroll
    for (int j = 0; j < 2; ++j) { const int n = tid + 256 * j;
        const float val = T[(size_t)r * 1024 + n], gate = T[(size_t)r * 1024 + 512 + n];
        MIX[(size_t)r * DM + 512 + n] = f2bf(val * sigmoidf_(gate)); }
}
__global__ void __launch_bounds__(256) k_softmax(float* S) {
    __shared__ float red[8];
    float* row = S + ((size_t)blockIdx.y * LL + blockIdx.x) * LL;
    const int tid = threadIdx.x;
    float m = -INFINITY;
    for (int n = tid; n < LL; n += 256) m = fmaxf(m, row[n]);
#pragma unroll
    for (int o = 32; o > 0; o >>= 1) m = fmaxf(m, __shfl_xor(m, o));
    if ((tid & 63) == 0) red[tid >> 6] = m;
    __syncthreads();
    m = fmaxf(fmaxf(red[0], red[1]), fmaxf(red[2], red[3]));
    float s = 0.f;
    for (int n = tid; n < LL; n += 256) s += expf(row[n] - m);
    s = block_sum_256(s, red + 4);
    const float inv = 1.f / s;
    for (int n = tid; n < LL; n += 256) row[n] = expf(row[n] - m) * inv;
}
__global__ void __launch_bounds__(256) k_attn_out(const float* OC, const float* sw, float scale, bf16_t* MIX) {
    __shared__ float red[8];
    const int r = blockIdx.x, h = blockIdx.y, n = threadIdx.x;
    const float o = OC[(size_t)r * 1024 + h * 256 + n];
    const float ss = block_sum_256(o * o, red);
    MIX[(size_t)r * DM + 1024 + h * 256 + n] = f2bf(o * rsqrtf(ss * (1.f / 256.f) + EPS) * sw[n] * scale);
}

__global__ void __launch_bounds__(256) k_norm_router(const float* Z, const float* w, const float* wrg, const float* brg, const float* wre, const float* bre,
                                                     bf16_t* HN, int* ridx, float* rgate, int* rslot, int* cnt) {
    __shared__ float hs[4][DM];
    __shared__ float lg[4][72];
    __shared__ float red[8];
    const int tid = threadIdx.x, t0 = blockIdx.x * 4;
    for (int tk = 0; tk < 4; ++tk) {
        const float* zr = Z + (size_t)(t0 + tk) * DM;
        float v[8]; float ss = 0.f;
#pragma unroll
        for (int j = 0; j < 8; ++j) { v[j] = zr[tid + 256 * j]; ss += v[j] * v[j]; }
        ss = block_sum_256(ss, red);
        const float rs = rsqrtf(ss * (1.f / DM) + EPS);
#pragma unroll
        for (int j = 0; j < 8; ++j) { const float y = v[j] * rs * w[tid + 256 * j]; hs[tk][tid + 256 * j] = y; HN[(size_t)(t0 + tk) * DM + tid + 256 * j] = f2bf(y); }
    }
    __syncthreads();
    for (int o = tid; o < 288; o += 256) {
        const int tk = o / 72, j = o % 72;
        float acc = 0.f;
        if (j < 8) { for (int k = 0; k < DM; ++k) acc = fmaf(hs[tk][k], wrg[k * 8 + j], acc); acc += brg[j]; }
        else { for (int k = 0; k < DM; ++k) acc = fmaf(hs[tk][k], wre[k * 64 + (j - 8)], acc); acc += bre[j - 8]; }
        lg[tk][j] = acc;
    }
    __syncthreads();
    if (tid < 4) {
        const int t = t0 + tid;
        int gs = 0; float gm = lg[tid][0];
        for (int j = 1; j < 8; ++j) if (lg[tid][j] > gm) { gm = lg[tid][j]; gs = j; }
        float den = 0.f; for (int j = 0; j < 8; ++j) den += expf(lg[tid][j] - gm);
        const float pg = 1.f / den;
        const float* el = &lg[tid][8 + gs * 8];
        int j0 = 0; float v0 = el[0];
        for (int j = 1; j < 8; ++j) if (el[j] > v0) { v0 = el[j]; j0 = j; }
        int j1 = -1; float v1 = -INFINITY;
        for (int j = 0; j < 8; ++j) if (j != j0 && el[j] > v1) { v1 = el[j]; j1 = j; }
        const float e1 = expf(v1 - v0), g0 = pg / (1.f + e1), g1 = pg * e1 / (1.f + e1);
        const int x0 = gs * 8 + j0, x1 = gs * 8 + j1;
        ridx[t * 2] = x0; ridx[t * 2 + 1] = x1; rgate[t * 2] = g0; rgate[t * 2 + 1] = g1;
        rslot[t * 2] = atomicAdd(&cnt[x0], 1); rslot[t * 2 + 1] = atomicAdd(&cnt[x1], 1);
    }
}
__global__ void __launch_bounds__(64) k_dispatch(const int* cnt, int* base, int* blk_e) {
    if (threadIdx.x == 0) {
        int off = 0;
        for (int e = 0; e < NE; ++e) { base[e] = off; const int nb = (cnt[e] + RB - 1) / RB; for (int i = 0; i < nb; ++i) blk_e[off / RB + i] = e; off += nb * RB; }
        for (int i = off / RB; i < NRMAX / RB; ++i) blk_e[i] = -1;
    }
}
__global__ void __launch_bounds__(256) k_scatter(const int* ridx, const int* rslot, const int* base, int* rowtok, int* tokrow) {
    const int i = blockIdx.x * 256 + threadIdx.x;
    if (i >= NASSIGN) return;
    const int row = base[ridx[i]] + rslot[i];
    rowtok[row] = i >> 1; tokrow[i] = row;
}
__global__ void __launch_bounds__(256) k_combine(float* Z, const bf16_t* Y, const int* tokrow, const float* rgate) {
    const int t = blockIdx.x, tid = threadIdx.x;
    const int r0 = tokrow[t * 2], r1 = tokrow[t * 2 + 1]; const float g0 = rgate[t * 2], g1 = rgate[t * 2 + 1];
#pragma unroll
    for (int j = 0; j < 8; ++j) { const int d = tid + 256 * j;
        Z[(size_t)t * DM + d] += g0 * bf2f(Y[(size_t)r0 * DM + d]) + g1 * bf2f(Y[(size_t)r1 * DM + d]); }
}
__global__ void __launch_bounds__(256) k_final(const float* Z, const float* w, float* out) {
    __shared__ float red[8];
    const int r = blockIdx.x, tid = threadIdx.x, b = r / LL, t = r % LL;
    if (t < NMETA) return;
    const float* zr = Z + (size_t)r * DM;
    float v[8]; float ss = 0.f;
#pragma unroll
    for (int j = 0; j < 8; ++j) { v[j] = zr[tid + 256 * j]; ss += v[j] * v[j]; }
    ss = block_sum_256(ss, red);
    const float rs = rsqrtf(ss * (1.f / DM) + EPS);
    float* o = out + ((size_t)b * SEQ + (t - NMETA)) * DM;
#pragma unroll
    for (int j = 0; j < 8; ++j) o[tid + 256 * j] = v[j] * rs * w[tid + 256 * j];
}
}

extern "C" void kernel_launch(void* const* d_in, const int* in_sizes, int n_in, void* d_out, int out_size, void* d_ws, size_t ws_size, hipStream_t stream) {
    const float* x = (const float*)d_in[0]; const float* meta = (const float*)d_in[1]; const float* ln1_w = (const float*)d_in[2];
    const float* w_in = (const float*)d_in[3]; const float* lbnd = (const float*)d_in[4]; const float* hnw = (const float*)d_in[5];
    const float* a_re = (const float*)d_in[6]; const float* a_im = (const float*)d_in[7]; const float* b_re = (const float*)d_in[8];
    const float* b_im = (const float*)d_in[9]; const float* c_re = (const float*)d_in[10]; const float* c_im = (const float*)d_in[11];
    const float* s5d = (const float*)d_in[12]; const float* log_dt = (const float*)d_in[13]; const float* w_glu = (const float*)d_in[14];
    const float* b_glu = (const float*)d_in[15]; const float* lq1 = (const float*)d_in[16]; const float* lk1 = (const float*)d_in[17];
    const float* lq2 = (const float*)d_in[18]; const float* lk2 = (const float*)d_in[19]; const float* subln = (const float*)d_in[20];
    const float* w_out = (const float*)d_in[21]; const float* ln2_w = (const float*)d_in[22]; const float* wrg = (const float*)d_in[23];
    const float* brg = (const float*)d_in[24]; const float* wre = (const float*)d_in[25]; const float* bre = (const float*)d_in[26];
    const float* w1 = (const float*)d_in[27]; const float* w3 = (const float*)d_in[28]; const float* w2 = (const float*)d_in[29];
    const float* fnw = (const float*)d_in[30];
    float* out = (float*)d_out;

    char* ws = (char*)d_ws; size_t off = 0;
    auto alloc = [&](size_t bytes) { char* p = ws + off; off += (bytes + 255) & ~(size_t)255; return p; };
    int* ctl = (int*)alloc(4096);
    int* cnt = ctl; int* base = ctl + 64; int* blk_e = ctl + 256;
    float* lbtab = (float*)alloc(1024 * 4); float* lam = (float*)alloc(256);
    float* Z = (float*)alloc((size_t)MP * DM * 4);
    bf16_t* HN = (bf16_t*)alloc((size_t)MP * DM * 2);
    float* PA = (float*)alloc((size_t)MP * PAW * 4);
    bf16_t* QKV = (bf16_t*)alloc((size_t)MP * QKVW * 2);
    float* OA = (float*)alloc((size_t)MP * HW * 4);
    bf16_t* YG = (bf16_t*)alloc((size_t)MP * 512 * 2);
    float* T = (float*)alloc((size_t)MP * 1024 * 4);
    bf16_t* MIX = (bf16_t*)alloc((size_t)MP * DM * 2);
    float* OC = (float*)alloc((size_t)MP * 1024 * 4);
    int* ridx = (int*)alloc((size_t)NASSIGN * 4); float* rgate = (float*)alloc((size_t)NASSIGN * 4); int* rslot = (int*)alloc((size_t)NASSIGN * 4);
    int* tokrow = (int*)alloc((size_t)NASSIGN * 4); int* rowtok = (int*)alloc((size_t)NRMAX * 4);
    float* H1 = (float*)alloc((size_t)NRMAX * DE * 4);
    bf16_t* H = (bf16_t*)alloc((size_t)NRMAX * DE * 2);
    bf16_t* Y = (bf16_t*)alloc((size_t)NRMAX * DM * 2);
    float* S = (float*)alloc((size_t)32 * LL * LL * 4);
    if (off > ws_size) return;

    k_build_z<<<MP, 256, 0, stream>>>(x, meta, Z);
    k_prep<<<1, 512, 0, stream>>>(lbnd, lq1, lk1, lq2, lk2, lbtab, lam);
    for (int layer = 0; layer < 2; ++layer) {
        k_rmsnorm<<<MP, 256, 0, stream>>>(Z, ln1_w + layer * DM, HN);
        { FInProj f{HN, w_in + (size_t)layer * DM * INW, PA, QKV}; k_gemm<<<dim3(INW / 64, MP / 64, 1), 256, 0, stream>>>(DM, f); }
        k_hgrn<<<16, 256, 0, stream>>>(PA, lbtab + layer * 512, OA);
        k_hgrn_out<<<dim3(TOK, 4), 128, 0, stream>>>(OA, PA, hnw + layer * 128, MIX);
        k_s5<<<128, 64, 0, stream>>>(PA, a_re + layer * 2048, a_im + layer * 2048, b_re + layer * 32768, b_im + layer * 32768,
                                     c_re + layer * 32768, c_im + layer * 32768, s5d + layer * 512, log_dt + layer * 32, YG);
        { FGlu f{YG, w_glu + (size_t)layer * 512 * 1024, b_glu + layer * 1024, T}; k_gemm<<<dim3(1024 / 64, MP / 64, 1), 256, 0, stream>>>(512, f); }
        k_glu_out<<<TOK, 256, 0, stream>>>(T, MIX);
        { FScore f{QKV, S}; k_gemm<<<dim3(33, 33, 32), 256, 0, stream>>>(128, f); }
        k_softmax<<<dim3(LL, 32), 256, 0, stream>>>(S);
        { FPV f{S, QKV, OC, lam + layer}; k_gemm<<<dim3(4, 33, 16), 256, 0, stream>>>(LL, f); }
        const float li = 0.8f - 0.6f * expf(-0.3f * (float)layer);
        k_attn_out<<<dim3(TOK, 4), 256, 0, stream>>>(OC, subln + layer * 256, 1.f - li, MIX);
        { FOutProj f{MIX, w_out + (size_t)layer * DM * DM, Z}; k_gemm<<<dim3(DM / 64, MP / 64, 1), 256, 0, stream>>>(DM, f); }
        hipMemsetAsync(cnt, 0, 256, stream);
        hipMemsetAsync(rowtok, 0xFF, (size_t)NRMAX * 4, stream);
        k_norm_router<<<TOK / 4, 256, 0, stream>>>(Z, ln2_w + layer * DM, wrg + (size_t)layer * DM * 8, brg + layer * 8, wre + (size_t)layer * DM * 64, bre + layer * 64,
                                                  HN, ridx, rgate, rslot, cnt);
        k_dispatch<<<1, 64, 0, stream>>>(cnt, base, blk_e);
        k_scatter<<<(NASSIGN + 255) / 256, 256, 0, stream>>>(ridx, rslot, base, rowtok, tokrow);
        const size_t ew = (size_t)layer * NE * DM * DE;
        { FMoeUp f{HN, rowtok, blk_e, w1 + ew, H1, H, 0, 0}; k_gemm<<<dim3(DE / 64, NRMAX / 64, 1), 256, 0, stream>>>(DM, f); }
        { FMoeUp f{HN, rowtok, blk_e, w3 + ew, H1, H, 1, 0}; k_gemm<<<dim3(DE / 64, NRMAX / 64, 1), 256, 0, stream>>>(DM, f); }
        { FMoeDown f{H, blk_e, w2 + ew, Y}; k_gemm<<<dim3(DM / 64, NRMAX / 64, 1), 256, 0, stream>>>(DE, f); }
        k_combine<<<TOK, 256, 0, stream>>>(Z, Y, tokrow, rgate);
    }
    k_final<<<TOK, 256, 0, stream>>>(Z, fnw, out);
}
```

```cpp
#include <hip/hip_runtime.h>
#include <stdint.h>
#include <math.h>

namespace {
typedef unsigned short bf16_t;
constexpr int DM = 2048, NB = 4, SEQ = 2048, NMETA = 16, LL = SEQ + NMETA, TOK = NB * LL, MP = 8448;
constexpr int HW = 512;
constexpr int INW = 5632, PAW = 2560, QKVW = 3072;
constexpr int NE = 64, DE = 512, NASSIGN = TOK * 2;
constexpr int RB = 128;
constexpr int NRMAX = NASSIGN + NE * RB;
constexpr float EPS = 1e-6f;
constexpr int NTHR = 512;
constexpr int LDS_BYTES = 147456;
constexpr int LDS_CTL = 143360;

__device__ __forceinline__ float bf2f(bf16_t h) { return __uint_as_float(((unsigned)h) << 16); }
__device__ __forceinline__ bf16_t f2bf(float f) { unsigned u = __float_as_uint(f); return (bf16_t)((u + 0x7fffu + ((u >> 16) & 1u)) >> 16); }
__device__ __forceinline__ float sigmoidf_(float x) { return 1.f / (1.f + expf(-x)); }
__device__ __forceinline__ int tid_() { int t = threadIdx.x; asm volatile("" : "+v"(t)); return t; }
__device__ __forceinline__ int bid_() { int b = blockIdx.x; asm volatile("" : "+s"(b)); return b; }

#define XB_TMO      128
#define XB_XCNT(j)  (256  + 64 * (j))
#define XB_XSUB(j)  (1280 + 64 * (j))
#define XB_XGEN(j)  (2304 + 64 * (j))
#define XB_TOP      3328
#define XB_TOPGEN   3392
#define XCD_BAR_WORDS 3456
#define XB_SPIN_CAP (1u << 24)
#define LAS __attribute__((address_space(3)))
__device__ __forceinline__ unsigned xb_ld(unsigned* p)              { return __hip_atomic_load(p, __ATOMIC_RELAXED, __HIP_MEMORY_SCOPE_AGENT); }
__device__ __forceinline__ unsigned xb_add(unsigned* p, unsigned v) { return __hip_atomic_fetch_add(p, v, __ATOMIC_RELAXED, __HIP_MEMORY_SCOPE_AGENT); }
__device__ __forceinline__ unsigned xb_xcc_id() { return (unsigned)__builtin_amdgcn_s_getreg((3 << 11) | 20) & 0xFu; }
#define XB_SPIN(cond, bar) do { unsigned _sp = 0; while (cond) { __builtin_amdgcn_s_sleep(1); \
    if ((++_sp & 255u) == 0u) { if (xb_ld(&(bar)[XB_TMO])) break; if (_sp > XB_SPIN_CAP) { atomicAdd(&(bar)[XB_TMO], 1u); break; } } } } while (0)
struct XcdBarrier { unsigned* bar; unsigned x; volatile LAS unsigned* st; };
__device__ __forceinline__ XcdBarrier xcd_barrier_post(unsigned* bar, volatile LAS unsigned* st) {
    XcdBarrier b; b.bar = bar; b.x = xb_xcc_id(); b.st = st;
    if (threadIdx.x == 0) (void)xb_add(&bar[XB_XCNT(b.x)], 1u);
    return b;
}
__device__ __forceinline__ void xcd_barrier_complete(unsigned* bar, unsigned x, unsigned& nloc, unsigned& nx) {
    const unsigned G = gridDim.x * gridDim.y * gridDim.z;
    unsigned sum, cnt, mine, sp = 0u;
    for (;;) {
        sum = 0u; cnt = 0u; mine = 0u;
#pragma unroll
        for (unsigned j = 0; j < 16; ++j) { const unsigned c = xb_ld(&bar[XB_XCNT(j)]); sum += c; cnt += (c > 0u) ? 1u : 0u; mine = (j == x) ? c : mine; }
        if (sum == G) break;
        __builtin_amdgcn_s_sleep(1);
        if ((++sp & 255u) == 0u) { if (xb_ld(&bar[XB_TMO])) break; if (sp > XB_SPIN_CAP) { atomicAdd(&bar[XB_TMO], 1u); break; } }
    }
    nloc = mine > 0u ? mine : 1u; nx = cnt > 0u ? cnt : 1u;
}
__device__ __forceinline__ void xcd_barrier(const XcdBarrier& b) {
    asm volatile("s_waitcnt vmcnt(0)" ::: "memory");
    __syncthreads();
    if (threadIdx.x == 0) {
        unsigned* bar = b.bar;
        __builtin_amdgcn_s_waitcnt(0);
        unsigned nloc = b.st[0], nx = b.st[1];
        if (nloc == 0u) { xcd_barrier_complete(bar, b.x, nloc, nx); b.st[0] = nloc; b.st[1] = nx; }
        const unsigned old = xb_add(&bar[XB_XSUB(b.x)], 1u);
        const unsigned gen = old / nloc;
        if (old + 1u == (gen + 1u) * nloc) {
            __builtin_amdgcn_fence(__ATOMIC_RELEASE, "agent");
            asm volatile("s_waitcnt vmcnt(0)" ::: "memory");
            const unsigned og = xb_add(&bar[XB_TOP], 1u);
            const unsigned tg = og / nx;
            if (og + 1u == (tg + 1u) * nx) xb_add(&bar[XB_TOPGEN], 1u);
            else XB_SPIN(xb_ld(&bar[XB_TOPGEN]) == tg, bar);
            __builtin_amdgcn_fence(__ATOMIC_ACQUIRE, "agent");
            xb_add(&bar[XB_XGEN(b.x)], 1u);
            asm volatile("s_waitcnt vmcnt(0)" ::: "memory");
        } else {
            XB_SPIN(xb_ld(&bar[XB_XGEN(b.x)]) == gen, bar);
            __builtin_amdgcn_fence(__ATOMIC_ACQUIRE, "agent");
            asm volatile("s_waitcnt vmcnt(0)" ::: "memory");
        }
    }
    __syncthreads();
}

struct Params {
    const float *x, *meta, *ln1_w, *w_in, *lbnd, *hnw, *a_re, *a_im, *b_re, *b_im, *c_re, *c_im, *s5d, *log_dt, *w_glu, *b_glu,
                *lq1, *lk1, *lq2, *lk2, *subln, *w_out, *ln2_w, *wrg, *brg, *wre, *bre, *w1, *w3, *w2, *fnw;
    float* out;
    unsigned* bar;
    int *cnt, *blk_e, *ridx, *rslot, *tokrow, *rowtok;
    float *lbtab, *lam, *Z, *PA, *OA, *T, *OC, *rgate, *H1, *S;
    bf16_t *HN, *QKV, *YG, *MIX, *H, *Y;
};

template <class F>
__device__ __forceinline__ void gemm_naive(char* lds, int K, int ntx, int nty, int ntz, const F& f) {
    float (*As)[132] = (float (*)[132])lds;
    float (*Bs)[68] = (float (*)[68])(lds + 16 * 132 * 4);
    const int tid = tid_(), tx = tid & 15, ty = tid >> 4;
    const int ntiles = ntx * nty * ntz;
    for (int u = bid_(); u < ntiles; u += gridDim.x) {
        const int bx = u % ntx, by = (u / ntx) % nty, z = u / (ntx * nty);
        if (!f.active(z, by)) continue;
        const int bm = by * 128, bn = bx * 64;
        float acc[4][4];
#pragma unroll
        for (int i = 0; i < 4; ++i)
#pragma unroll
            for (int j = 0; j < 4; ++j) acc[i][j] = 0.f;
        for (int k0 = 0; k0 < K; k0 += 16) {
#pragma unroll
            for (int j = 0; j < 4; ++j) { const int idx = tid + 512 * j, m = idx >> 4, k = idx & 15; As[k][m] = f.a(z, by, bm + m, k0 + k); }
#pragma unroll
            for (int j = 0; j < 2; ++j) { const int idx = tid + 512 * j, k = idx >> 6, n = idx & 63; Bs[k][n] = f.b(z, by, k0 + k, bn + n); }
            __syncthreads();
#pragma unroll
            for (int k = 0; k < 16; ++k) {
                const float4 a4 = *(const float4*)&As[k][ty * 4];
                const float4 b4 = *(const float4*)&Bs[k][tx * 4];
                const float a[4] = {a4.x, a4.y, a4.z, a4.w}, b[4] = {b4.x, b4.y, b4.z, b4.w};
#pragma unroll
                for (int i = 0; i < 4; ++i)
#pragma unroll
                    for (int j = 0; j < 4; ++j) acc[i][j] = fmaf(a[i], b[j], acc[i][j]);
            }
            __syncthreads();
        }
#pragma unroll
        for (int i = 0; i < 4; ++i)
#pragma unroll
            for (int j = 0; j < 4; ++j) f.e(z, by, bm + ty * 4 + i, bn + tx * 4 + j, acc[i][j]);
    }
}

struct FInProj {
    const bf16_t* HN; const float* W; float* PA; bf16_t* QKV;
    __device__ bool active(int, int) const { return true; }
    __device__ float a(int, int, int m, int k) const { return bf2f(HN[(size_t)m * DM + k]); }
    __device__ float b(int, int, int k, int n) const { return W[(size_t)k * INW + n]; }
    __device__ void e(int, int, int m, int n, float v) const {
        if (n < PAW) PA[(size_t)m * PAW + n] = v; else QKV[(size_t)m * QKVW + (n - PAW)] = f2bf(v);
    }
};
struct FGlu {
    const bf16_t* YG; const float* W; const float* bias; float* T;
    __device__ bool active(int, int) const { return true; }
    __device__ float a(int, int, int m, int k) const { return m < TOK ? bf2f(YG[(size_t)m * 512 + k]) : 0.f; }
    __device__ float b(int, int, int k, int n) const { return W[(size_t)k * 1024 + n]; }
    __device__ void e(int, int, int m, int n, float v) const { T[(size_t)m * 1024 + n] = v + bias[n]; }
};
struct FScore {
    const bf16_t* QKV; float* S;
    __device__ bool active(int, int) const { return true; }
    __device__ float a(int z, int, int m, int k) const {
        if (m >= LL) return 0.f; const int b = z >> 3, h = (z >> 1) & 3, i = z & 1;
        return bf2f(QKV[(size_t)(b * LL + m) * QKVW + h * 256 + i * 128 + k]); }
    __device__ float b(int z, int, int k, int n) const {
        if (n >= LL) return 0.f; const int b = z >> 3, h = (z >> 1) & 3, i = z & 1;
        return bf2f(QKV[(size_t)(b * LL + n) * QKVW + 1024 + h * 256 + i * 128 + k]); }
    __device__ void e(int z, int, int m, int n, float v) const {
        if (m >= LL || n >= LL) return;
        const int cq = m < NMETA ? 0 : (m - NMETA) / 64 + 1, ck = n < NMETA ? 0 : (n - NMETA) / 64 + 1;
        S[((size_t)z * LL + m) * LL + n] = (ck <= cq) ? v * 0.08838834764831845f : -INFINITY;
    }
};
struct FPV {
    const float* S; const bf16_t* QKV; float* OC; const float* lam;
    __device__ bool active(int, int) const { return true; }
    __device__ float a(int z, int, int m, int k) const {
        if (m >= LL) return 0.f;
        return S[((size_t)(z * 2) * LL + m) * LL + k] - lam[0] * S[((size_t)(z * 2 + 1) * LL + m) * LL + k]; }
    __device__ float b(int z, int, int k, int n) const { const int b = z >> 2, h = z & 3;
        return bf2f(QKV[(size_t)(b * LL + k) * QKVW + 2048 + h * 256 + n]); }
    __device__ void e(int z, int, int m, int n, float v) const { if (m >= LL) return; const int b = z >> 2, h = z & 3;
        OC[(size_t)(b * LL + m) * 1024 + h * 256 + n] = v; }
};
struct FOutProj {
    const bf16_t* MIX; const float* W; float* Z;
    __device__ bool active(int, int) const { return true; }
    __device__ float a(int, int, int m, int k) const { return m < TOK ? bf2f(MIX[(size_t)m * DM + k]) : 0.f; }
    __device__ float b(int, int, int k, int n) const { return W[(size_t)k * DM + n]; }
    __device__ void e(int, int, int m, int n, float v) const { if (m < TOK) Z[(size_t)m * DM + n] += v; }
};
struct FMoeUp {
    const bf16_t* HN; const int* rowtok; const int* blk_e; const float* W; float* H1; bf16_t* H; int pass; int pad;
    __device__ bool active(int, int by) const { return blk_e[by] >= 0; }
    __device__ float a(int, int, int m, int k) const { const int t = rowtok[m]; return t < 0 ? 0.f : bf2f(HN[(size_t)t * DM + k]); }
    __device__ float b(int, int by, int k, int n) const { return W[((size_t)blk_e[by] * DM + k) * DE + n]; }
    __device__ void e(int, int, int m, int n, float v) const {
        if (pass == 0) H1[(size_t)m * DE + n] = v;
        else { const float g = H1[(size_t)m * DE + n]; H[(size_t)m * DE + n] = f2bf(g * sigmoidf_(g) * v); }
    }
};
struct FMoeDown {
    const bf16_t* H; const int* blk_e; const float* W; bf16_t* Y;
    __device__ bool active(int, int by) const { return blk_e[by] >= 0; }
    __device__ float a(int, int, int m, int k) const { return bf2f(H[(size_t)m * DE + k]); }
    __device__ float b(int, int by, int k, int n) const { return W[((size_t)blk_e[by] * DE + k) * DM + n]; }
    __device__ void e(int, int, int m, int n, float v) const { Y[(size_t)m * DM + n] = f2bf(v); }
};

__device__ __forceinline__ float block_sum(float v, float* red) {
#pragma unroll
    for (int o = 32; o > 0; o >>= 1) v += __shfl_xor(v, o);
    __syncthreads();
    if ((threadIdx.x & 63) == 0) red[threadIdx.x >> 6] = v;
    __syncthreads();
    float s = 0.f;
#pragma unroll
    for (int i = 0; i < 8; ++i) s += red[i];
    return s;
}
__device__ __forceinline__ float block_max(float v, float* red) {
#pragma unroll
    for (int o = 32; o > 0; o >>= 1) v = fmaxf(v, __shfl_xor(v, o));
    __syncthreads();
    if ((threadIdx.x & 63) == 0) red[threadIdx.x >> 6] = v;
    __syncthreads();
    float s = red[0];
#pragma unroll
    for (int i = 1; i < 8; ++i) s = fmaxf(s, red[i]);
    return s;
}
__device__ __forceinline__ float gelu_tanh(float x) {
    const float u = 0.7978845608028654f * (x + 0.044715f * x * x * x);
    return 0.5f * x * (1.f + tanhf(u));
}

__device__ __forceinline__ void ph_build_norm(const Params& P, char* lds) {
    float* red = (float*)lds;
    const int tid = tid_();
    for (int r = bid_(); r < MP; r += gridDim.x) {
        float4 v = make_float4(0.f, 0.f, 0.f, 0.f);
        if (r < TOK) { const int b = r / LL, t = r % LL;
            const float4* src = (const float4*)(t < NMETA ? P.meta + (size_t)t * DM : P.x + ((size_t)b * SEQ + (t - NMETA)) * DM);
            v = src[tid]; }
        ((float4*)(P.Z + (size_t)r * DM))[tid] = v;
        const float ss = block_sum(v.x * v.x + v.y * v.y + v.z * v.z + v.w * v.w, red);
        const float rs = rsqrtf(ss * (1.f / DM) + EPS);
        const float4 w = ((const float4*)P.ln1_w)[tid];
        bf16_t* o = P.HN + (size_t)r * DM + tid * 4;
        o[0] = f2bf(v.x * rs * w.x); o[1] = f2bf(v.y * rs * w.y); o[2] = f2bf(v.z * rs * w.z); o[3] = f2bf(v.w * rs * w.w);
    }
}
__device__ __forceinline__ void ph_prep(const Params& P) {
    if (blockIdx.x != 0) return;
    const int c = threadIdx.x;
    const float l0 = P.lbnd[c], l1 = P.lbnd[512 + c], m = fmaxf(l0, l1), e0 = expf(l0 - m), e1 = expf(l1 - m);
    P.lbtab[c] = 0.f; P.lbtab[512 + c] = e1 / (e0 + e1);
    if (c < 2) {
        float s1 = 0.f, s2 = 0.f;
        for (int i = 0; i < 128; ++i) { s1 += P.lq1[c * 128 + i] * P.lk1[c * 128 + i]; s2 += P.lq2[c * 128 + i] * P.lk2[c * 128 + i]; }
        const float li = 0.8f - 0.6f * expf(-0.3f * (float)c);
        P.lam[c] = expf(s1) - expf(s2) + li;
    }
}
__device__ __forceinline__ void ph_hgrn(const Params& P, char* lds, int layer, int unit) {
    float* qs = (float*)lds; float* fs = qs + 128; float* ks = fs + 128; float (*op)[128] = (float (*)[128])(ks + 128);
    const float* PA = P.PA; const float* lb = P.lbtab + layer * 512;
    const int b = unit >> 2, h = unit & 3, tid = threadIdx.x, v = tid & 127, kq = tid >> 7;
    float S[32];
#pragma unroll
    for (int j = 0; j < 32; ++j) S[j] = 0.f;
#pragma unroll 1
    for (int t = 0; t < LL; ++t) {
        const size_t r = (size_t)b * LL + t;
        if (tid < 128) {
            const int c = h * 128 + tid;
            const float q = PA[r * PAW + c], fp = PA[r * PAW + 512 + c], lbv = lb[c];
            const float sg = sigmoidf_(fp), sgn = sigmoidf_(-fp);
            qs[tid] = q; fs[tid] = lbv + (1.f - lbv) * sg; ks[tid] = (1.f - lbv) * sgn;
        }
        __syncthreads();
        const float vv = PA[r * PAW + 1024 + h * 128 + v];
        float part = 0.f;
#pragma unroll
        for (int j = 0; j < 32; ++j) { const int kk = kq * 32 + j; S[j] = fmaf(fs[kk], S[j], ks[kk] * vv); part = fmaf(qs[kk], S[j], part); }
        op[kq][v] = part;
        __syncthreads();
        if (tid < 128) P.OA[r * HW + h * 128 + v] = (op[0][v] + op[1][v]) + (op[2][v] + op[3][v]);
    }
    __syncthreads();
}
__device__ __forceinline__ void ph_hgrn_out(const Params& P, char* lds, int layer) {
    float* red = (float*)lds;
    const int tid = tid_(), h = tid >> 7, k = tid & 127;
    const float* nw = P.hnw + layer * 128;
    for (int r = bid_(); r < TOK; r += gridDim.x) {
        const float o = P.OA[(size_t)r * HW + tid];
        float ss = o * o;
#pragma unroll
        for (int off = 32; off > 0; off >>= 1) ss += __shfl_xor(ss, off);
        __syncthreads();
        if ((tid & 63) == 0) red[tid >> 6] = ss;
        __syncthreads();
        ss = red[h * 2] + red[h * 2 + 1];
        const float g = P.PA[(size_t)r * PAW + 1536 + tid];
        const float y = o * rsqrtf(ss * (1.f / 128.f) + EPS) * nw[k] * (g * sigmoidf_(g));
        P.MIX[(size_t)r * DM + tid] = f2bf(y);
    }
}
__device__ __forceinline__ void ph_s5(const Params& P, char* lds, int layer, int unit8) {
    const int w = threadIdx.x >> 6, p = threadIdx.x & 63, unit = unit8 * 8 + w;
    float* base = (float*)lds + w * (256 + 4 * 1024);
    float (*us)[16] = (float (*)[16])base; float (*xr)[64] = (float (*)[64])(base + 256); float (*xi)[64] = (float (*)[64])(base + 256 + 1024);
    float (*cre)[64] = (float (*)[64])(base + 256 + 2048); float (*cim)[64] = (float (*)[64])(base + 256 + 3072);
    const int b = unit >> 5, g = unit & 31;
    const float* a_re = P.a_re + layer * 2048; const float* a_im = P.a_im + layer * 2048;
    const float* b_re = P.b_re + layer * 32768; const float* b_im = P.b_im + layer * 32768;
    const float* c_re = P.c_re + layer * 32768; const float* c_im = P.c_im + layer * 32768;
    const float* dsk = P.s5d + layer * 512;
    const float dt = expf(P.log_dt[layer * 32 + g]), are = a_re[g * 64 + p], aim = a_im[g * 64 + p];
    const float mag = expf(are * dt), abr = mag * cosf(aim * dt), abi = mag * sinf(aim * dt);
    const float den = are * are + aim * aim;
    const float zr = ((abr - 1.f) * are + abi * aim) / den, zi = (abi * are - (abr - 1.f) * aim) / den;
    float bbr[16], bbi[16];
#pragma unroll
    for (int c = 0; c < 16; ++c) {
        const float br = b_re[(g * 64 + p) * 16 + c], bi = b_im[(g * 64 + p) * 16 + c];
        bbr[c] = zr * br - zi * bi; bbi[c] = zr * bi + zi * br;
        cre[c][p] = c_re[(g * 16 + c) * 64 + p]; cim[c][p] = c_im[(g * 16 + c) * 64 + p];
    }
    float x_r = 0.f, x_i = 0.f;
    for (int t0 = 0; t0 < LL; t0 += 16) {
#pragma unroll
        for (int j = 0; j < 4; ++j) { const int idx = p + 64 * j, tl = idx >> 4, c = idx & 15;
            us[tl][c] = P.PA[((size_t)b * LL + t0 + tl) * PAW + 2048 + g * 16 + c]; }
        __syncthreads();
#pragma unroll 1
        for (int tl = 0; tl < 16; ++tl) {
            float bur = 0.f, bui = 0.f;
#pragma unroll
            for (int c = 0; c < 16; ++c) { const float u = us[tl][c]; bur = fmaf(bbr[c], u, bur); bui = fmaf(bbi[c], u, bui); }
            const float nr = abr * x_r - abi * x_i + bur, ni = abr * x_i + abi * x_r + bui;
            x_r = nr; x_i = ni; xr[tl][p] = nr; xi[tl][p] = ni;
        }
        __syncthreads();
#pragma unroll
        for (int j = 0; j < 4; ++j) { const int idx = p + 64 * j, tl = idx >> 4, c = idx & 15;
            float y = 0.f;
#pragma unroll 4
            for (int q = 0; q < 64; ++q) y += cre[c][q] * xr[tl][q] - cim[c][q] * xi[tl][q];
            y += dsk[g * 16 + c] * us[tl][c];
            P.YG[((size_t)b * LL + t0 + tl) * 512 + g * 16 + c] = f2bf(gelu_tanh(y)); }
        __syncthreads();
    }
}
__device__ __forceinline__ void ph_glu_out(const Params& P) {
    const int tid = tid_();
    for (int r = bid_(); r < TOK; r += gridDim.x) {
        const float val = P.T[(size_t)r * 1024 + tid], gate = P.T[(size_t)r * 1024 + 512 + tid];
        P.MIX[(size_t)r * DM + 512 + tid] = f2bf(val * sigmoidf_(gate));
    }
}
__device__ __forceinline__ void ph_softmax(const Params& P, char* lds) {
    float* red = (float*)lds;
    const int tid = tid_();
    for (int u = bid_(); u < 32 * LL; u += gridDim.x) {
        float* row = P.S + (size_t)u * LL;
        float m = -INFINITY;
        for (int n = tid; n < LL; n += NTHR) m = fmaxf(m, row[n]);
        m = block_max(m, red);
        float s = 0.f;
        for (int n = tid; n < LL; n += NTHR) s += expf(row[n] - m);
        s = block_sum(s, red + 8);
        const float inv = 1.f / s;
        for (int n = tid; n < LL; n += NTHR) row[n] = expf(row[n] - m) * inv;
    }
}
__device__ __forceinline__ void ph_attn_out(const Params& P, char* lds, int layer) {
    float* red = (float*)lds;
    const int tid = tid_(), hh = tid >> 8, n = tid & 255;
    const float* sw = P.subln + layer * 256;
    const float scale = 1.f - (0.8f - 0.6f * expf(-0.3f * (float)layer));
    for (int u = bid_(); u < TOK * 2; u += gridDim.x) {
        const int r = u >> 1, h = (u & 1) * 2 + hh;
        const float o = P.OC[(size_t)r * 1024 + h * 256 + n];
        float ss = o * o;
#pragma unroll
        for (int off = 32; off > 0; off >>= 1) ss += __shfl_xor(ss, off);
        __syncthreads();
        if ((tid & 63) == 0) red[tid >> 6] = ss;
        __syncthreads();
        ss = (red[hh * 4] + red[hh * 4 + 1]) + (red[hh * 4 + 2] + red[hh * 4 + 3]);
        P.MIX[(size_t)r * DM + 1024 + h * 256 + n] = f2bf(o * rsqrtf(ss * (1.f / 256.f) + EPS) * sw[n] * scale);
    }
}
__device__ __forceinline__ void ph_norm_router(const Params& P, char* lds, int layer) {
    float (*hs)[DM] = (float (*)[DM])lds;
    float (*lg)[72] = (float (*)[72])(lds + 4 * DM * 4);
    float* red = (float*)(lds + 4 * DM * 4 + 4 * 72 * 4);
    const int tid = tid_();
    const float* w = P.ln2_w + layer * DM; const float* wrg = P.wrg + (size_t)layer * DM * 8; const float* brg = P.brg + layer * 8;
    const float* wre = P.wre + (size_t)layer * DM * 64; const float* bre = P.bre + layer * 64;
    for (int u = bid_(); u < TOK / 4; u += gridDim.x) {
        const int t0 = u * 4;
        for (int tk = 0; tk < 4; ++tk) {
            const float4 v = ((const float4*)(P.Z + (size_t)(t0 + tk) * DM))[tid];
            const float ss = block_sum(v.x * v.x + v.y * v.y + v.z * v.z + v.w * v.w, red);
            const float rs = rsqrtf(ss * (1.f / DM) + EPS);
            const float4 ww = ((const float4*)w)[tid];
            const float y0 = v.x * rs * ww.x, y1 = v.y * rs * ww.y, y2 = v.z * rs * ww.z, y3 = v.w * rs * ww.w;
            hs[tk][tid * 4] = y0; hs[tk][tid * 4 + 1] = y1; hs[tk][tid * 4 + 2] = y2; hs[tk][tid * 4 + 3] = y3;
            bf16_t* o = P.HN + (size_t)(t0 + tk) * DM + tid * 4;
            o[0] = f2bf(y0); o[1] = f2bf(y1); o[2] = f2bf(y2); o[3] = f2bf(y3);
        }
        __syncthreads();
        if (tid < 288) {
            const int tk = tid / 72, j = tid % 72;
            float acc = 0.f;
            if (j < 8) { for (int k = 0; k < DM; ++k) acc = fmaf(hs[tk][k], wrg[k * 8 + j], acc); acc += brg[j]; }
            else { for (int k = 0; k < DM; ++k) acc = fmaf(hs[tk][k], wre[k * 64 + (j - 8)], acc); acc += bre[j - 8]; }
            lg[tk][j] = acc;
        }
        __syncthreads();
        if (tid < 4) {
            const int t = t0 + tid;
            int gs = 0; float gm = lg[tid][0];
            for (int j = 1; j < 8; ++j) if (lg[tid][j] > gm) { gm = lg[tid][j]; gs = j; }
            float den = 0.f; for (int j = 0; j < 8; ++j) den += expf(lg[tid][j] - gm);
            const float pg = 1.f / den;
            const float* el = &lg[tid][8 + gs * 8];
            int j0 = 0; float v0 = el[0];
            for (int j = 1; j < 8; ++j) if (el[j] > v0) { v0 = el[j]; j0 = j; }
            int j1 = -1; float v1 = -INFINITY;
            for (int j = 0; j < 8; ++j) if (j != j0 && el[j] > v1) { v1 = el[j]; j1 = j; }
            const float e1 = expf(v1 - v0), g0 = pg / (1.f + e1), g1 = pg * e1 / (1.f + e1);
            const int x0 = gs * 8 + j0, x1 = gs * 8 + j1;
            P.ridx[t * 2] = x0; P.ridx[t * 2 + 1] = x1; P.rgate[t * 2] = g0; P.rgate[t * 2 + 1] = g1;
            P.rslot[t * 2] = atomicAdd(&P.cnt[x0], 1); P.rslot[t * 2 + 1] = atomicAdd(&P.cnt[x1], 1);
        }
        __syncthreads();
    }
}
__device__ __forceinline__ void ph_dispatch(const Params& P, char* lds) {
    int* base = (int*)lds;
    const int tid = tid_();
    if (tid == 0) {
        int off = 0;
        for (int e = 0; e < NE; ++e) { base[e] = off; const int nb = (P.cnt[e] + RB - 1) / RB;
            if (blockIdx.x == 0) for (int i = 0; i < nb; ++i) P.blk_e[off / RB + i] = e;
            off += nb * RB; }
        if (blockIdx.x == 0) for (int i = off / RB; i < NRMAX / RB; ++i) P.blk_e[i] = -1;
    }
    __syncthreads();
    for (int i = blockIdx.x * NTHR + tid; i < NASSIGN; i += gridDim.x * NTHR) {
        const int row = base[P.ridx[i]] + P.rslot[i];
        P.rowtok[row] = i >> 1; P.tokrow[i] = row;
    }
    __syncthreads();
}
__device__ __forceinline__ void ph_combine_norm(const Params& P, char* lds, int layer) {
    float* red = (float*)lds;
    const int tid = tid_();
    for (int t = bid_(); t < TOK; t += gridDim.x) {
        const int r0 = P.tokrow[t * 2], r1 = P.tokrow[t * 2 + 1]; const float g0 = P.rgate[t * 2], g1 = P.rgate[t * 2 + 1];
        float4 v = ((const float4*)(P.Z + (size_t)t * DM))[tid];
        const bf16_t* y0 = P.Y + (size_t)r0 * DM + tid * 4; const bf16_t* y1 = P.Y + (size_t)r1 * DM + tid * 4;
        v.x += g0 * bf2f(y0[0]) + g1 * bf2f(y1[0]); v.y += g0 * bf2f(y0[1]) + g1 * bf2f(y1[1]);
        v.z += g0 * bf2f(y0[2]) + g1 * bf2f(y1[2]); v.w += g0 * bf2f(y0[3]) + g1 * bf2f(y1[3]);
        const float ss = block_sum(v.x * v.x + v.y * v.y + v.z * v.z + v.w * v.w, red);
        const float rs = rsqrtf(ss * (1.f / DM) + EPS);
        if (layer == 0) {
            ((float4*)(P.Z + (size_t)t * DM))[tid] = v;
            const float4 w = ((const float4*)(P.ln1_w + DM))[tid];
            bf16_t* o = P.HN + (size_t)t * DM + tid * 4;
            o[0] = f2bf(v.x * rs * w.x); o[1] = f2bf(v.y * rs * w.y); o[2] = f2bf(v.z * rs * w.z); o[3] = f2bf(v.w * rs * w.w);
        } else {
            const int b = t / LL, tt = t % LL;
            if (tt >= NMETA) { const float4 w = ((const float4*)P.fnw)[tid];
                ((float4*)(P.out + ((size_t)b * SEQ + (tt - NMETA)) * DM))[tid] = make_float4(v.x * rs * w.x, v.y * rs * w.y, v.z * rs * w.z, v.w * rs * w.w); }
        }
    }
}

__global__ void __launch_bounds__(NTHR, 2) mega_fwd(Params P) {
    extern __shared__ __attribute__((aligned(16))) char lds[];
    const int tid = tid_(), G = gridDim.x;
    volatile LAS unsigned* ctlw = (volatile LAS unsigned*)((LAS char*)lds + LDS_CTL);
    if (tid < 64) ctlw[tid] = 0u;
    __syncthreads();
    XcdBarrier bar = xcd_barrier_post(P.bar, ctlw + 8);
#define GRID_BAR() xcd_barrier(bar)

    ph_build_norm(P, lds);
    ph_prep(P);
    GRID_BAR();
    for (int layer = 0; layer < 2; ++layer) {
        { FInProj f{P.HN, P.w_in + (size_t)layer * DM * INW, P.PA, P.QKV}; gemm_naive(lds, DM, INW / 64, MP / 128, 1, f); }
        if (blockIdx.x == 0 && tid < NE) P.cnt[tid] = 0;
        for (int i = blockIdx.x * NTHR + tid; i < NRMAX; i += G * NTHR) P.rowtok[i] = -1;
        GRID_BAR();
        if (blockIdx.x < 16) ph_hgrn(P, lds, layer, blockIdx.x);
        else if (blockIdx.x < 32) ph_s5(P, lds, layer, blockIdx.x - 16);
        { FScore f{P.QKV, P.S}; gemm_naive(lds, 128, 33, 17, 32, f); }
        GRID_BAR();
        ph_softmax(P, lds);
        ph_hgrn_out(P, lds, layer);
        { FGlu f{P.YG, P.w_glu + (size_t)layer * 512 * 1024, P.b_glu + layer * 1024, P.T}; gemm_naive(lds, 512, 1024 / 64, MP / 128, 1, f); }
        GRID_BAR();
        { FPV f{P.S, P.QKV, P.OC, P.lam + layer}; gemm_naive(lds, LL, 4, 17, 16, f); }
        ph_glu_out(P);
        GRID_BAR();
        ph_attn_out(P, lds, layer);
        GRID_BAR();
        { FOutProj f{P.MIX, P.w_out + (size_t)layer * DM * DM, P.Z}; gemm_naive(lds, DM, DM / 64, MP / 128, 1, f); }
        GRID_BAR();
        ph_norm_router(P, lds, layer);
        GRID_BAR();
        ph_dispatch(P, lds);
        GRID_BAR();
        const size_t ew = (size_t)layer * NE * DM * DE;
        { FMoeUp f{P.HN, P.rowtok, P.blk_e, P.w1 + ew, P.H1, P.H, 0, 0}; gemm_naive(lds, DM, DE / 64, NRMAX / 128, 1, f); }
        GRID_BAR();
        { FMoeUp f{P.HN, P.rowtok, P.blk_e, P.w3 + ew, P.H1, P.H, 1, 0}; gemm_naive(lds, DM, DE / 64, NRMAX / 128, 1, f); }
        GRID_BAR();
        { FMoeDown f{P.H, P.blk_e, P.w2 + ew, P.Y}; gemm_naive(lds, DE, DM / 64, NRMAX / 128, 1, f); }
        GRID_BAR();
        ph_combine_norm(P, lds, layer);
        if (layer == 0) GRID_BAR();
    }
}
}

extern "C" void kernel_launch(void* const* d_in, const int* in_sizes, int n_in, void* d_out, int out_size, void* d_ws, size_t ws_size, hipStream_t stream) {
    static int grid = 0;
    if (grid == 0) {
        int dev = 0, cus = 0;
        if (hipGetDevice(&dev) != hipSuccess || hipDeviceGetAttribute(&cus, hipDeviceAttributeMultiprocessorCount, dev) != hipSuccess) { grid = -1; return; }
        if (hipFuncSetAttribute((const void*)mega_fwd, hipFuncAttributeMaxDynamicSharedMemorySize, LDS_BYTES) != hipSuccess) { grid = -1; return; }
        int per_cu = 0;
        if (hipOccupancyMaxActiveBlocksPerMultiprocessor(&per_cu, (const void*)mega_fwd, NTHR, LDS_BYTES) != hipSuccess || per_cu < 1) { (void)hipGetLastError(); }
        grid = cus;
    }
    if (grid < 0) return;
    Params p{};
    const float** pin = (const float**)&p;
    for (int i = 0; i < 31; ++i) pin[i] = (const float*)d_in[i];
    p.out = (float*)d_out;
    char* ws = (char*)d_ws; size_t off = 0;
    auto alloc = [&](size_t bytes) { char* q = ws + off; off += (bytes + 255) & ~(size_t)255; return q; };
    p.bar = (unsigned*)alloc(XCD_BAR_WORDS * 4);
    p.cnt = (int*)alloc(256); p.blk_e = (int*)alloc(1024);
    p.lbtab = (float*)alloc(1024 * 4); p.lam = (float*)alloc(256);
    p.Z = (float*)alloc((size_t)MP * DM * 4);
    p.HN = (bf16_t*)alloc((size_t)MP * DM * 2);
    p.PA = (float*)alloc((size_t)MP * PAW * 4);
    p.QKV = (bf16_t*)alloc((size_t)MP * QKVW * 2);
    p.OA = (float*)alloc((size_t)MP * HW * 4);
    p.YG = (bf16_t*)alloc((size_t)MP * 512 * 2);
    p.T = (float*)alloc((size_t)MP * 1024 * 4);
    p.MIX = (bf16_t*)alloc((size_t)MP * DM * 2);
    p.OC = (float*)alloc((size_t)MP * 1024 * 4);
    p.ridx = (int*)alloc((size_t)NASSIGN * 4); p.rgate = (float*)alloc((size_t)NASSIGN * 4); p.rslot = (int*)alloc((size_t)NASSIGN * 4);
    p.tokrow = (int*)alloc((size_t)NASSIGN * 4); p.rowtok = (int*)alloc((size_t)NRMAX * 4);
    p.H1 = (float*)alloc((size_t)NRMAX * DE * 4);
    p.H = (bf16_t*)alloc((size_t)NRMAX * DE * 2);
    p.Y = (bf16_t*)alloc((size_t)NRMAX * DM * 2);
    p.S = (float*)alloc((size_t)32 * LL * LL * 4);
    if (off > ws_size) return;
    if (hipMemsetAsync(p.bar, 0, XCD_BAR_WORDS * 4, stream) != hipSuccess) return;
    hipLaunchKernelGGL(mega_fwd, dim3(grid), dim3(NTHR), LDS_BYTES, stream, p);
}
```

```cpp
#include <hip/hip_runtime.h>
#include <stdint.h>
#include <math.h>

namespace {
typedef unsigned short bf16_t;
constexpr int DM = 2048, NB = 4, SEQ = 2048, NMETA = 16, LL = SEQ + NMETA, TOK = NB * LL, MP = 8448;
constexpr int HW = 512;
constexpr int INW = 5632, PAW = 2560, QKVW = 3072;
constexpr int NE = 64, DE = 512, NASSIGN = TOK * 2;
constexpr int RB = 128;
constexpr int NRMAX = NASSIGN + NE * RB;
constexpr float EPS = 1e-6f;
constexpr int NTHR = 512;
constexpr int LDS_BYTES = 147456;
constexpr int LDS_CTL = 143360;

__device__ __forceinline__ float bf2f(bf16_t h) { return __uint_as_float(((unsigned)h) << 16); }
__device__ __forceinline__ bf16_t f2bf(float f) { unsigned u = __float_as_uint(f); return (bf16_t)((u + 0x7fffu + ((u >> 16) & 1u)) >> 16); }
__device__ __forceinline__ float sigmoidf_(float x) { return 1.f / (1.f + expf(-x)); }
__device__ __forceinline__ int tid_() { int t = threadIdx.x; asm volatile("" : "+v"(t)); return t; }
__device__ __forceinline__ int bid_() { int b = blockIdx.x; asm volatile("" : "+s"(b)); return b; }

#define XB_TMO      128
#define XB_XCNT(j)  (256  + 64 * (j))
#define XB_XSUB(j)  (1280 + 64 * (j))
#define XB_XGEN(j)  (2304 + 64 * (j))
#define XB_TOP      3328
#define XB_TOPGEN   3392
#define XCD_BAR_WORDS 3456
#define XB_SPIN_CAP (1u << 24)
#define LAS __attribute__((address_space(3)))
__device__ __forceinline__ unsigned xb_ld(unsigned* p)              { return __hip_atomic_load(p, __ATOMIC_RELAXED, __HIP_MEMORY_SCOPE_AGENT); }
__device__ __forceinline__ unsigned xb_add(unsigned* p, unsigned v) { return __hip_atomic_fetch_add(p, v, __ATOMIC_RELAXED, __HIP_MEMORY_SCOPE_AGENT); }
__device__ __forceinline__ unsigned xb_xcc_id() { return (unsigned)__builtin_amdgcn_s_getreg((3 << 11) | 20) & 0xFu; }
#define XB_SPIN(cond, bar) do { unsigned _sp = 0; while (cond) { __builtin_amdgcn_s_sleep(1); \
    if ((++_sp & 255u) == 0u) { if (xb_ld(&(bar)[XB_TMO])) break; if (_sp > XB_SPIN_CAP) { atomicAdd(&(bar)[XB_TMO], 1u); break; } } } } while (0)
struct XcdBarrier { unsigned* bar; unsigned x; volatile LAS unsigned* st; };
__device__ __forceinline__ XcdBarrier xcd_barrier_post(unsigned* bar, volatile LAS unsigned* st) {
    XcdBarrier b; b.bar = bar; b.x = xb_xcc_id(); b.st = st;
    if (threadIdx.x == 0) (void)xb_add(&bar[XB_XCNT(b.x)], 1u);
    return b;
}
__device__ __forceinline__ void xcd_barrier_complete(unsigned* bar, unsigned x, unsigned& nloc, unsigned& nx) {
    const unsigned G = gridDim.x * gridDim.y * gridDim.z;
    unsigned sum, cnt, mine, sp = 0u;
    for (;;) {
        sum = 0u; cnt = 0u; mine = 0u;
#pragma unroll
        for (unsigned j = 0; j < 16; ++j) { const unsigned c = xb_ld(&bar[XB_XCNT(j)]); sum += c; cnt += (c > 0u) ? 1u : 0u; mine = (j == x) ? c : mine; }
        if (sum == G) break;
        __builtin_amdgcn_s_sleep(1);
        if ((++sp & 255u) == 0u) { if (xb_ld(&bar[XB_TMO])) break; if (sp > XB_SPIN_CAP) { atomicAdd(&bar[XB_TMO], 1u); break; } }
    }
    nloc = mine > 0u ? mine : 1u; nx = cnt > 0u ? cnt : 1u;
}
__device__ __forceinline__ void xcd_barrier(const XcdBarrier& b) {
    asm volatile("s_waitcnt vmcnt(0)" ::: "memory");
    __syncthreads();
    if (threadIdx.x == 0) {
        unsigned* bar = b.bar;
        const unsigned bx_ = xb_xcc_id();
        __builtin_amdgcn_s_waitcnt(0);
        unsigned nloc = b.st[0], nx = b.st[1];
        if (nloc == 0u) { xcd_barrier_complete(bar, bx_, nloc, nx); b.st[0] = nloc; b.st[1] = nx; }
        const unsigned old = xb_add(&bar[XB_XSUB(bx_)], 1u);
        const unsigned gen = old / nloc;
        if (old + 1u == (gen + 1u) * nloc) {
            __builtin_amdgcn_fence(__ATOMIC_RELEASE, "agent");
            asm volatile("s_waitcnt vmcnt(0)" ::: "memory");
            const unsigned og = xb_add(&bar[XB_TOP], 1u);
            const unsigned tg = og / nx;
            if (og + 1u == (tg + 1u) * nx) xb_add(&bar[XB_TOPGEN], 1u);
            else XB_SPIN(xb_ld(&bar[XB_TOPGEN]) == tg, bar);
            __builtin_amdgcn_fence(__ATOMIC_ACQUIRE, "agent");
            xb_add(&bar[XB_XGEN(bx_)], 1u);
            asm volatile("s_waitcnt vmcnt(0)" ::: "memory");
        } else {
            XB_SPIN(xb_ld(&bar[XB_XGEN(bx_)]) == gen, bar);
            __builtin_amdgcn_fence(__ATOMIC_ACQUIRE, "agent");
            asm volatile("s_waitcnt vmcnt(0)" ::: "memory");
        }
    }
    __syncthreads();
}

struct Params {
    const float *x, *meta, *ln1_w, *w_in, *lbnd, *hnw, *a_re, *a_im, *b_re, *b_im, *c_re, *c_im, *s5d, *log_dt, *w_glu, *b_glu,
                *lq1, *lk1, *lq2, *lk2, *subln, *w_out, *ln2_w, *wrg, *brg, *wre, *bre, *w1, *w3, *w2, *fnw;
    float* out;
    unsigned* bar;
    int *cnt, *blk_e, *ridx, *rslot, *tokrow, *rowtok, *base;
    float *lbtab, *lam, *Z, *PA, *OA, *T, *OC, *rgate, *H1, *S, *SLOC, *DEC, *A16, *S5E, *S5X;
    bf16_t *HN, *QKV, *YG, *MIX, *H, *Y, *WinT, *WoutT, *WgluT, *SPREV, *BtY, *BtE;
};
typedef const __attribute__((address_space(4))) Params* KP;
__device__ __forceinline__ KP kp_() { KP p = (KP)__builtin_amdgcn_kernarg_segment_ptr(); asm volatile("" : "+s"(p)); return p; }

template <class F>
__device__ __forceinline__ void gemm_naive(char* lds, int K, int ntx, int nty, int ntz, const F& f) {
    float (*As)[132] = (float (*)[132])lds;
    float (*Bs)[68] = (float (*)[68])(lds + 16 * 132 * 4);
    const int tid = tid_(), tx = tid & 15, ty = tid >> 4;
    const int ntiles = ntx * nty * ntz;
    for (int u = bid_(); u < ntiles; u += gridDim.x) {
        const int bx = u % ntx, by = (u / ntx) % nty, z = u / (ntx * nty);
        if (!f.active(z, by)) continue;
        const int bm = by * 128, bn = bx * 64;
        float acc[4][4];
#pragma unroll
        for (int i = 0; i < 4; ++i)
#pragma unroll
            for (int j = 0; j < 4; ++j) acc[i][j] = 0.f;
        for (int k0 = 0; k0 < K; k0 += 16) {
#pragma unroll
            for (int j = 0; j < 4; ++j) { const int idx = tid + 512 * j, m = idx >> 4, k = idx & 15; As[k][m] = f.a(z, by, bm + m, k0 + k); }
#pragma unroll
            for (int j = 0; j < 2; ++j) { const int idx = tid + 512 * j, k = idx >> 6, n = idx & 63; Bs[k][n] = f.b(z, by, k0 + k, bn + n); }
            __syncthreads();
#pragma unroll
            for (int k = 0; k < 16; ++k) {
                const float4 a4 = *(const float4*)&As[k][ty * 4];
                const float4 b4 = *(const float4*)&Bs[k][tx * 4];
                const float a[4] = {a4.x, a4.y, a4.z, a4.w}, b[4] = {b4.x, b4.y, b4.z, b4.w};
#pragma unroll
                for (int i = 0; i < 4; ++i)
#pragma unroll
                    for (int j = 0; j < 4; ++j) acc[i][j] = fmaf(a[i], b[j], acc[i][j]);
            }
            __syncthreads();
        }
#pragma unroll
        for (int i = 0; i < 4; ++i)
#pragma unroll
            for (int j = 0; j < 4; ++j) f.e(z, by, bm + ty * 4 + i, bn + tx * 4 + j, acc[i][j]);
    }
}

struct FInProj {
    const bf16_t* HN; const float* W; float* PA; bf16_t* QKV;
    __device__ bool active(int, int) const { return true; }
    __device__ float a(int, int, int m, int k) const { return bf2f(HN[(size_t)m * DM + k]); }
    __device__ float b(int, int, int k, int n) const { return W[(size_t)k * INW + n]; }
    __device__ void e(int, int, int m, int n, float v) const {
        if (n < PAW) PA[(size_t)m * PAW + n] = v; else QKV[(size_t)m * QKVW + (n - PAW)] = f2bf(v);
    }
};
struct FGlu {
    const bf16_t* YG; const float* W; const float* bias; float* T;
    __device__ bool active(int, int) const { return true; }
    __device__ float a(int, int, int m, int k) const { return m < TOK ? bf2f(YG[(size_t)m * 512 + k]) : 0.f; }
    __device__ float b(int, int, int k, int n) const { return W[(size_t)k * 1024 + n]; }
    __device__ void e(int, int, int m, int n, float v) const { T[(size_t)m * 1024 + n] = v + bias[n]; }
};
struct FScore {
    const bf16_t* QKV; float* S;
    __device__ bool active(int, int) const { return true; }
    __device__ float a(int z, int, int m, int k) const {
        if (m >= LL) return 0.f; const int b = z >> 3, h = (z >> 1) & 3, i = z & 1;
        return bf2f(QKV[(size_t)(b * LL + m) * QKVW + h * 256 + i * 128 + k]); }
    __device__ float b(int z, int, int k, int n) const {
        if (n >= LL) return 0.f; const int b = z >> 3, h = (z >> 1) & 3, i = z & 1;
        return bf2f(QKV[(size_t)(b * LL + n) * QKVW + 1024 + h * 256 + i * 128 + k]); }
    __device__ void e(int z, int, int m, int n, float v) const {
        if (m >= LL || n >= LL) return;
        const int cq = m < NMETA ? 0 : (m - NMETA) / 64 + 1, ck = n < NMETA ? 0 : (n - NMETA) / 64 + 1;
        S[((size_t)z * LL + m) * LL + n] = (ck <= cq) ? v * 0.08838834764831845f : -INFINITY;
    }
};
struct FPV {
    const float* S; const bf16_t* QKV; float* OC; const float* lam;
    __device__ bool active(int, int) const { return true; }
    __device__ float a(int z, int, int m, int k) const {
        if (m >= LL) return 0.f;
        return S[((size_t)(z * 2) * LL + m) * LL + k] - lam[0] * S[((size_t)(z * 2 + 1) * LL + m) * LL + k]; }
    __device__ float b(int z, int, int k, int n) const { const int b = z >> 2, h = z & 3;
        return bf2f(QKV[(size_t)(b * LL + k) * QKVW + 2048 + h * 256 + n]); }
    __device__ void e(int z, int, int m, int n, float v) const { if (m >= LL) return; const int b = z >> 2, h = z & 3;
        OC[(size_t)(b * LL + m) * 1024 + h * 256 + n] = v; }
};
struct FOutProj {
    const bf16_t* MIX; const float* W; float* Z;
    __device__ bool active(int, int) const { return true; }
    __device__ float a(int, int, int m, int k) const { return m < TOK ? bf2f(MIX[(size_t)m * DM + k]) : 0.f; }
    __device__ float b(int, int, int k, int n) const { return W[(size_t)k * DM + n]; }
    __device__ void e(int, int, int m, int n, float v) const { if (m < TOK) Z[(size_t)m * DM + n] += v; }
};
struct FMoeUp {
    const bf16_t* HN; const int* rowtok; const int* blk_e; const float* W; float* H1; bf16_t* H; int pass; int pad;
    __device__ bool active(int, int by) const { return blk_e[by] >= 0; }
    __device__ float a(int, int, int m, int k) const { const int t = rowtok[m]; return t < 0 ? 0.f : bf2f(HN[(size_t)t * DM + k]); }
    __device__ float b(int, int by, int k, int n) const { return W[((size_t)blk_e[by] * DM + k) * DE + n]; }
    __device__ void e(int, int, int m, int n, float v) const {
        if (pass == 0) H1[(size_t)m * DE + n] = v;
        else { const float g = H1[(size_t)m * DE + n]; H[(size_t)m * DE + n] = f2bf(g * sigmoidf_(g) * v); }
    }
};
struct FMoeDown {
    const bf16_t* H; const int* blk_e; const float* W; bf16_t* Y;
    __device__ bool active(int, int by) const { return blk_e[by] >= 0; }
    __device__ float a(int, int, int m, int k) const { return bf2f(H[(size_t)m * DE + k]); }
    __device__ float b(int, int by, int k, int n) const { return W[((size_t)blk_e[by] * DE + k) * DM + n]; }
    __device__ void e(int, int, int m, int n, float v) const { Y[(size_t)m * DM + n] = f2bf(v); }
};


namespace pg8 {
#define PG8_LAS __attribute__((address_space(3)))
typedef short bf16x8 __attribute__((ext_vector_type(8)));
typedef float f32x4 __attribute__((ext_vector_type(4)));
typedef unsigned u32x4 __attribute__((ext_vector_type(4)));
constexpr int BM = 256, BK = 64, HALF = 128, HTB = HALF * BK * 2, STAGE_BYTES = 8 * HTB, NXCD = 8, WGM = 8;
__host__ __device__ __forceinline__ int lds_byte(int r, int c) { const int st = (r >> 4) * 2 + (c >> 5), rr = r & 15, cc = c & 31, ob = rr * 64 + cc * 2; return st * 1024 + (ob ^ (((ob >> 9) & 1) << 5)); }
__host__ __device__ __forceinline__ void stage_rc(int b, int& R, int& C) { const int st = b / 1024, sb = b % 1024, swz = sb ^ (((sb >> 9) & 1) << 5); R = (st >> 1) * 16 + swz / 64; C = (st & 1) * 32 + (swz % 64) / 2; }
__host__ __device__ __forceinline__ int perm32(int rho) { const int n = rho >> 4, i = rho & 15; return 8 * (i >> 2) + 4 * n + (i & 3); }
struct Unit { int pm, pn; };
struct Gemm { const bf16_t* A; const bf16_t* Bt; int M, N, K; };
struct StaticOrder {
    int nM, nN, nwg, G, c;
    __host__ __device__ void init(int M, int N, int G_, int c_) { nM = M / BM; nN = N / BM; nwg = nM * nN; G = G_; c = c_; }
    __host__ __device__ bool next(int i, Unit& u) const {
        const long L = (long)i * G + c; if (L >= nwg) return false;
        int wgid = (int)L; { const int q = nwg / NXCD, r = nwg % NXCD, xcd = wgid % NXCD, off = wgid / NXCD; wgid = (xcd < r ? xcd * (q + 1) : r * (q + 1) + (xcd - r) * q) + off; }
        const int nig = WGM * nN, gid = wgid / nig, fm = gid * WGM, gsz = (nM - fm) < WGM ? (nM - fm) : WGM;
        u.pm = fm + ((wgid % nig) % gsz); u.pn = (wgid % nig) / gsz; return true;
    }
    __device__ __forceinline__ void a_ready(const Unit&) const {}
    __device__ __forceinline__ void done(const Unit&) const {}
};
__device__ __forceinline__ unsigned cvt_pk_bf16(float lo, float hi) { unsigned r; asm volatile("v_cvt_pk_bf16_f32 %0, %1, %2" : "=v"(r) : "v"(lo), "v"(hi)); return r; }

template <class Epi, class Sched, bool ALIGN_EPI = false, bool SP2 = false>
__device__ __forceinline__ void gemm_phase(PG8_LAS unsigned char* lds, const Gemm g, const Sched& S, const Epi& E) {
    const int tid = tid_(), wid = __builtin_amdgcn_readfirstlane(tid >> 6), lane = tid & 63, wr = wid >> 2, wc = wid & 3, fr = lane & 15, fq = lane >> 4;
    const int K = g.K, nt = K / BK;
    unsigned voffA[2], voffB[2];
#pragma unroll
    for (int i = 0; i < 2; ++i) { int R, C; stage_rc(tid * 16 + i * 8192, R, C); const int Rb = Epi::PERM ? ((R & ~31) + perm32(R & 31)) : R;
        voffA[i] = (unsigned)(R * K + C) * 2u; voffB[i] = (unsigned)(Rb * K + C) * 2u; }
    const size_t kstep = (size_t)(BK * 2);
    const size_t hstep = (size_t)HALF * K * 2;
    const size_t tstep = 2 * hstep;
    const unsigned ldsw = (unsigned)wid * 1024u;
    const int aoff = lds_byte(wr * 64 + fr, fq * 8), boff = lds_byte(wc * 32 + fr, fq * 8);
#define PG8_SA(b, h) (((b) * 2 + (h)) * HTB)
#define PG8_SB(b, h) ((4 + (b) * 2 + (h)) * HTB)
#define PG8_STAGE(bufoff, gbase, voff) do { _Pragma("unroll") for (int _i = 0; _i < 2; ++_i) \
        __builtin_amdgcn_global_load_lds((const unsigned*)((const char*)(gbase) + (voff)[_i]), (PG8_LAS unsigned*)(lds + (bufoff) + ldsw + _i * 8192), 16, 0, 0); } while (0)
#define PG8_LDA(dst, b, h) do { _Pragma("unroll") for (int m = 0; m < 4; ++m) _Pragma("unroll") for (int k = 0; k < 2; ++k) dst[m][k] = *(const PG8_LAS bf16x8*)(lds + PG8_SA(b, h) + aoff + m * 2048 + k * 1024); } while (0)
#define PG8_LDB(dst, b, h) do { _Pragma("unroll") for (int n = 0; n < 2; ++n) _Pragma("unroll") for (int k = 0; k < 2; ++k) dst[n][k] = *(const PG8_LAS bf16x8*)(lds + PG8_SB(b, h) + boff + n * 2048 + k * 1024); } while (0)
#define PG8_MMA(ai, bj, At, Bt) do { __builtin_amdgcn_s_setprio(1); _Pragma("unroll") for (int m = 0; m < 4; ++m) _Pragma("unroll") for (int n = 0; n < 2; ++n) _Pragma("unroll") for (int k = 0; k < 2; ++k) \
        acc[ai][bj][m][n] = __builtin_amdgcn_mfma_f32_16x16x32_bf16(Bt[n][k], At[m][k], acc[ai][bj][m][n], 0, 0, 0); __builtin_amdgcn_s_setprio(0); } while (0)
#define PG8_WAIT_V(n) asm volatile("s_waitcnt vmcnt(" #n ")" ::: "memory")
#define PG8_WAIT_L(n) asm volatile("s_waitcnt lgkmcnt(" #n ")" ::: "memory")
#define PG8_BAR __builtin_amdgcn_s_barrier()
#define PG8_SCHED __builtin_amdgcn_sched_barrier(0)
    Unit cur, nxt; int ui = 0;
    if (!S.next(0, cur)) return;
    f32x4 acc[2][2][4][2];
#pragma unroll
    for (int a = 0; a < 2; ++a)
#pragma unroll
        for (int b = 0; b < 2; ++b)
#pragma unroll
            for (int m = 0; m < 4; ++m)
#pragma unroll
                for (int n = 0; n < 2; ++n) acc[a][b][m][n] = (f32x4){0.f, 0.f, 0.f, 0.f};
    bf16x8 At[4][2], B0[2][2], B1[2][2];
    const char* cA = (const char*)g.A + (size_t)cur.pm * tstep; const char* cB = (const char*)g.Bt + (size_t)cur.pn * tstep;
    S.a_ready(cur);
    if constexpr (SP2) {
        PG8_STAGE(PG8_SB(0, 0), cB, voffB); PG8_STAGE(PG8_SB(0, 1), cB + hstep, voffB); PG8_STAGE(PG8_SA(0, 0), cA, voffA); PG8_STAGE(PG8_SA(0, 1), cA + hstep, voffA);
        if (wr == 1) PG8_BAR;
        PG8_WAIT_V(2); PG8_BAR;
        PG8_STAGE(PG8_SB(1, 0), cB + kstep, voffB); PG8_STAGE(PG8_SA(1, 0), cA + kstep, voffA); PG8_STAGE(PG8_SB(1, 1), cB + hstep + kstep, voffB);
        PG8_WAIT_V(6); PG8_BAR;
    } else {
        PG8_STAGE(PG8_SB(0, 0), cB, voffB); PG8_STAGE(PG8_SA(0, 0), cA, voffA); PG8_STAGE(PG8_SB(0, 1), cB + hstep, voffB); PG8_STAGE(PG8_SA(0, 1), cA + hstep, voffA);
        if (wr == 1) PG8_BAR;
        PG8_WAIT_V(4); PG8_BAR;
        PG8_STAGE(PG8_SB(1, 0), cB + kstep, voffB); PG8_STAGE(PG8_SA(1, 0), cA + kstep, voffA); PG8_STAGE(PG8_SB(1, 1), cB + hstep + kstep, voffB);
        PG8_WAIT_V(6); PG8_BAR;
    }
    for (;;) {
        const bool has_next = S.next(ui + 1, nxt);
        const char* nA = has_next ? (const char*)g.A + (size_t)nxt.pm * tstep : cA; const char* nB = has_next ? (const char*)g.Bt + (size_t)nxt.pn * tstep : cB;
        for (int t = 0; t < nt; t += 2) {
            const bool last = (t == nt - 2);
            const char* a1 = cA + (size_t)(t + 1) * kstep;
            const char* a2 = last ? nA : cA + (size_t)(t + 2) * kstep; const char* b2 = last ? nB : cB + (size_t)(t + 2) * kstep;
            const char* a3 = a2 + kstep; const char* b3 = b2 + kstep;
            if (last && has_next) S.a_ready(nxt);
            if constexpr (SP2) {
            PG8_LDB(B0, 0, 0); PG8_LDB(B1, 0, 1); PG8_SCHED; PG8_LDA(At, 0, 0); PG8_STAGE(PG8_SA(1, 1), a1 + hstep, voffA);
            PG8_WAIT_V(8); PG8_WAIT_L(0); PG8_BAR; PG8_MMA(0, 0, At, B0); PG8_MMA(0, 1, At, B1); PG8_BAR; PG8_SCHED;
            PG8_LDA(At, 0, 1); PG8_STAGE(PG8_SB(0, 0), b2, voffB); PG8_STAGE(PG8_SB(0, 1), b2 + hstep, voffB); PG8_STAGE(PG8_SA(0, 0), a2, voffA);
            PG8_WAIT_V(8); PG8_WAIT_L(0); PG8_BAR; PG8_MMA(1, 0, At, B0); PG8_MMA(1, 1, At, B1); PG8_BAR; PG8_SCHED;
            PG8_LDB(B0, 1, 0); PG8_LDB(B1, 1, 1); PG8_SCHED; PG8_LDA(At, 1, 0); PG8_STAGE(PG8_SA(0, 1), a2 + hstep, voffA);
            PG8_WAIT_V(8); PG8_WAIT_L(0); PG8_BAR; PG8_MMA(0, 0, At, B0); PG8_MMA(0, 1, At, B1); PG8_BAR; PG8_SCHED;
            PG8_LDA(At, 1, 1); PG8_STAGE(PG8_SB(1, 0), b3, voffB); PG8_STAGE(PG8_SB(1, 1), b3 + hstep, voffB); PG8_STAGE(PG8_SA(1, 0), a3, voffA);
            PG8_WAIT_V(8); PG8_WAIT_L(0); PG8_BAR; PG8_MMA(1, 0, At, B0); PG8_MMA(1, 1, At, B1); PG8_BAR; PG8_SCHED;
            } else {
            PG8_LDB(B0, 0, 0); PG8_SCHED; PG8_LDA(At, 0, 0); PG8_STAGE(PG8_SA(1, 1), a1 + hstep, voffA);
            PG8_WAIT_L(8); PG8_BAR; PG8_WAIT_L(0); PG8_MMA(0, 0, At, B0); PG8_BAR; PG8_SCHED;
            PG8_LDB(B1, 0, 1); PG8_STAGE(PG8_SB(0, 0), b2, voffB);
            PG8_BAR; PG8_WAIT_L(0); PG8_MMA(0, 1, At, B1); PG8_BAR;
            PG8_LDA(At, 0, 1); PG8_STAGE(PG8_SA(0, 0), a2, voffA);
            PG8_BAR; PG8_WAIT_L(0); PG8_MMA(1, 0, At, B0); PG8_BAR; PG8_SCHED;
            PG8_STAGE(PG8_SB(0, 1), b2 + hstep, voffB);
            PG8_WAIT_V(6); PG8_BAR; PG8_MMA(1, 1, At, B1); PG8_BAR;
            PG8_LDB(B0, 1, 0); PG8_SCHED; PG8_LDA(At, 1, 0); PG8_STAGE(PG8_SA(0, 1), a2 + hstep, voffA);
            PG8_WAIT_L(8); PG8_BAR; PG8_WAIT_L(0); PG8_MMA(0, 0, At, B0); PG8_BAR; PG8_SCHED;
            PG8_LDB(B1, 1, 1); PG8_STAGE(PG8_SB(1, 0), b3, voffB);
            PG8_BAR; PG8_WAIT_L(0); PG8_MMA(0, 1, At, B1); PG8_BAR;
            PG8_LDA(At, 1, 1); PG8_STAGE(PG8_SA(1, 0), a3, voffA);
            PG8_BAR; PG8_WAIT_L(0); PG8_MMA(1, 0, At, B0); PG8_BAR; PG8_SCHED;
            PG8_STAGE(PG8_SB(1, 1), b3 + hstep, voffB);
            PG8_WAIT_V(6); PG8_BAR; PG8_MMA(1, 1, At, B1); PG8_BAR;
            }
        }
        if constexpr (ALIGN_EPI) { if (wr == 0) PG8_BAR; }
        E(acc, cur, wr, wc, fr, fq);
        if (!has_next) break;
#pragma unroll
        for (int a = 0; a < 2; ++a)
#pragma unroll
            for (int b = 0; b < 2; ++b)
#pragma unroll
                for (int m = 0; m < 4; ++m)
#pragma unroll
                    for (int n = 0; n < 2; ++n) acc[a][b][m][n] = (f32x4){0.f, 0.f, 0.f, 0.f};
        cur = nxt; cA = nA; cB = nB; ++ui;
        if constexpr (ALIGN_EPI) { if (wr == 1) PG8_BAR; }
    }
    PG8_WAIT_V(0);
    if constexpr (!ALIGN_EPI) { if (wr == 0) PG8_BAR; }
    PG8_BAR;
#undef PG8_SA
#undef PG8_SB
#undef PG8_STAGE
#undef PG8_LDA
#undef PG8_LDB
#undef PG8_MMA
#undef PG8_WAIT_V
#undef PG8_WAIT_L
#undef PG8_BAR
#undef PG8_SCHED
}
struct EpiInProj {
    static constexpr bool PERM = true;
    float* PA; bf16_t* QKV;
    __device__ __forceinline__ void operator()(const f32x4 (&acc)[2][2][4][2], const Unit& u, int wr, int wc, int fr, int fq) const {
        const int row0 = u.pm * BM + wr * 64 + fr, colt = u.pn * BM + wc * 32 + 8 * fq;
        if (colt < PAW) {
#pragma unroll
            for (int ai = 0; ai < 2; ++ai)
#pragma unroll
                for (int m = 0; m < 4; ++m) { float* rp = PA + (size_t)(row0 + ai * HALF + m * 16) * PAW + colt;
#pragma unroll
                    for (int bj = 0; bj < 2; ++bj) { *(f32x4*)(rp + bj * HALF) = acc[ai][bj][m][0]; *(f32x4*)(rp + bj * HALF + 4) = acc[ai][bj][m][1]; } }
        } else {
#pragma unroll
            for (int ai = 0; ai < 2; ++ai)
#pragma unroll
                for (int m = 0; m < 4; ++m) { bf16_t* rp = QKV + (size_t)(row0 + ai * HALF + m * 16) * QKVW + (colt - PAW);
#pragma unroll
                    for (int bj = 0; bj < 2; ++bj) { const f32x4 v0 = acc[ai][bj][m][0], v1 = acc[ai][bj][m][1];
                        u32x4 w; w.x = cvt_pk_bf16(v0[0], v0[1]); w.y = cvt_pk_bf16(v0[2], v0[3]); w.z = cvt_pk_bf16(v1[0], v1[1]); w.w = cvt_pk_bf16(v1[2], v1[3]);
                        *(u32x4*)(rp + bj * HALF) = w; } }
        }
    }
};
struct EpiResidual {
    static constexpr bool PERM = true;
    float* Z;
    __device__ __forceinline__ void operator()(const f32x4 (&acc)[2][2][4][2], const Unit& u, int wr, int wc, int fr, int fq) const {
        const int row0 = u.pm * BM + wr * 64 + fr, colt = u.pn * BM + wc * 32 + 8 * fq;
#pragma unroll
        for (int ai = 0; ai < 2; ++ai)
#pragma unroll
            for (int m = 0; m < 4; ++m) { const int row = row0 + ai * HALF + m * 16; if (row < TOK) { float* rp = Z + (size_t)row * DM + colt;
#pragma unroll
                for (int bj = 0; bj < 2; ++bj) { f32x4* p0 = (f32x4*)(rp + bj * HALF); f32x4* p1 = (f32x4*)(rp + bj * HALF + 4);
                    const f32x4 z0 = *p0, z1 = *p1; *p0 = z0 + acc[ai][bj][m][0]; *p1 = z1 + acc[ai][bj][m][1]; } } }
    }
};
struct EpiGlu {
    static constexpr bool PERM = true;
    bf16_t* MIX; const float* bias;
    __device__ __forceinline__ void operator()(const f32x4 (&acc)[2][2][4][2], const Unit& u, int wr, int wc, int fr, int fq) const {
        const int row0 = u.pm * BM + wr * 64 + fr, c0 = u.pn * HALF + wc * 32 + 8 * fq;
        const f32x4 bv0 = *(const f32x4*)(bias + c0), bv1 = *(const f32x4*)(bias + c0 + 4), bg0 = *(const f32x4*)(bias + 512 + c0), bg1 = *(const f32x4*)(bias + 512 + c0 + 4);
#pragma unroll
        for (int ai = 0; ai < 2; ++ai)
#pragma unroll
            for (int m = 0; m < 4; ++m) { const f32x4 v0 = acc[ai][0][m][0] + bv0, v1 = acc[ai][0][m][1] + bv1, g0 = acc[ai][1][m][0] + bg0, g1 = acc[ai][1][m][1] + bg1;
                float o[8];
#pragma unroll
                for (int e = 0; e < 4; ++e) { o[e] = v0[e] / (1.f + __expf(-g0[e])); o[4 + e] = v1[e] / (1.f + __expf(-g1[e])); }
                u32x4 w; w.x = cvt_pk_bf16(o[0], o[1]); w.y = cvt_pk_bf16(o[2], o[3]); w.z = cvt_pk_bf16(o[4], o[5]); w.w = cvt_pk_bf16(o[6], o[7]);
                *(u32x4*)(MIX + (size_t)(row0 + ai * HALF + m * 16) * DM + 512 + c0) = w; }
    }
};
}

__device__ __forceinline__ void transpose_item(const float* W, int K, int N, bf16_t* WT, int k0, int n0, int row0, float* scr, int lane) {
#pragma unroll 8
    for (int i = 0; i < 32; ++i) { const int kk = 2 * i + (lane >> 5); scr[kk * 33 + (lane & 31)] = W[(size_t)(k0 + kk) * N + n0 + (lane & 31)]; }
    asm volatile("s_waitcnt lgkmcnt(0)" ::: "memory");
    const int c = lane & 7;
#pragma unroll
    for (int j = 0; j < 4; ++j) { const int n = (lane >> 3) + 8 * j; const float* sp = scr + (8 * c) * 33 + n;
        pg8::u32x4 o; o.x = pg8::cvt_pk_bf16(sp[0 * 33], sp[1 * 33]); o.y = pg8::cvt_pk_bf16(sp[2 * 33], sp[3 * 33]); o.z = pg8::cvt_pk_bf16(sp[4 * 33], sp[5 * 33]); o.w = pg8::cvt_pk_bf16(sp[6 * 33], sp[7 * 33]);
        *(pg8::u32x4*)(WT + (size_t)(row0 + n) * K + k0 + 8 * c) = o; }
    asm volatile("s_waitcnt lgkmcnt(0)" ::: "memory");
}
__device__ __forceinline__ void ph_weights(KP P, char* lds) {
    const int tid = tid_(), lane = tid & 63, wave = tid >> 6;
    float* scr = (float*)lds + wave * (64 * 33);
    const int gw = bid_() * 8 + wave, NGW = gridDim.x * 8;
    constexpr int I_IN = (DM / 64) * (INW / 32), I_OUT = (DM / 64) * (DM / 32), I_GLU = (512 / 64) * (1024 / 32), I_L = I_IN + I_OUT + I_GLU;
    for (int it = gw; it < 2 * I_L; it += NGW) {
        const int layer = it / I_L; int r = it % I_L;
        if (r < I_IN) { const int nb = INW / 32, kb = r / nb, n0 = (r % nb) * 32;
            transpose_item(P->w_in + (size_t)layer * DM * INW, DM, INW, P->WinT + (size_t)layer * INW * DM, kb * 64, n0, n0, scr, lane); continue; }
        r -= I_IN;
        if (r < I_OUT) { const int nb = DM / 32, kb = r / nb, n0 = (r % nb) * 32;
            transpose_item(P->w_out + (size_t)layer * DM * DM, DM, DM, P->WoutT + (size_t)layer * DM * DM, kb * 64, n0, n0, scr, lane); continue; }
        r -= I_OUT;
        { const int nb = 1024 / 32, kb = r / nb, n0 = (r % nb) * 32;
          const int row0 = ((n0 & 511) >> 7) * 256 + (n0 >> 9) * 128 + (n0 & 127);
          transpose_item(P->w_glu + (size_t)layer * 512 * 1024, 512, 1024, P->WgluT + (size_t)layer * 1024 * 512, kb * 64, n0, row0, scr, lane); }
    }
}


namespace fa {
using bf16x8 = __attribute__((ext_vector_type(8))) short;
using s16x4  = __attribute__((ext_vector_type(4))) short;
using f32x16 = __attribute__((ext_vector_type(16))) float;
using u32x4  = __attribute__((ext_vector_type(4))) unsigned;
constexpr int D = 128, NW = 8, QBLK = 32, KVBLK = 64, LDQK = QKVW;
constexpr float SCALE = 0.088388347648318440f, THR = 8.f, NEG = -1e30f;
constexpr size_t SHM_V = KVBLK * D * 2, SHM_K = KVBLK * D * 2, SHM_ATTN = 2 * SHM_V + 2 * SHM_K + NW * 64 * 4;
#define KSWZ(row, colB) ((row) * 256 + ((colB) ^ (((row) & 7) << 4)))
#define SBAR() __builtin_amdgcn_sched_barrier(0)
__device__ __forceinline__ int crow(int r, int hi) { return (r & 3) + 8 * (r >> 2) + 4 * hi; }
__device__ __forceinline__ unsigned cvtpk(float lo, float hi) { unsigned r; asm volatile("v_cvt_pk_bf16_f32 %0, %1, %2" : "=v"(r) : "v"(lo), "v"(hi)); return r; }
__device__ __forceinline__ void partialSM(f32x16& p0, f32x16& p1, float& m_reg, float& mn, float& alpha) {
  constexpr float C = SCALE * 1.4426950408889634f;
  float pmax = p0[0]; for (int r = 1; r < 16; ++r) pmax = fmaxf(pmax, p0[r]); for (int r = 0; r < 16; ++r) pmax = fmaxf(pmax, p1[r]);
  { auto rr = __builtin_amdgcn_permlane32_swap(__float_as_uint(pmax), __float_as_uint(pmax), false, false);
    pmax = fmaxf(__uint_as_float(rr[0]), __uint_as_float(rr[1])); }
  if (__builtin_expect(__all(pmax - m_reg <= THR / SCALE), 1)) { mn = m_reg; alpha = 1.f; }
  else { mn = fmaxf(m_reg, pmax); alpha = __builtin_amdgcn_exp2f((m_reg - mn) * C); m_reg = mn; }
  float mnC = -mn * C;
  for (int r = 0; r < 16; ++r) p0[r] = fmaf(p0[r], C, mnC); for (int r = 0; r < 16; ++r) p1[r] = fmaf(p1[r], C, mnC);
  for (int r = 0; r < 16; ++r) p0[r] = __builtin_amdgcn_exp2f(p0[r]);
}
__device__ __forceinline__ void finishSM(f32x16& p0, f32x16& p1, float alpha, float& l_reg, bf16x8& pa0, bf16x8& pa1, bf16x8& pa2, bf16x8& pa3) {
  for (int r = 0; r < 16; ++r) p1[r] = __builtin_amdgcn_exp2f(p1[r]);
  float ps = 0; for (int r = 0; r < 16; ++r) ps += p0[r]; for (int r = 0; r < 16; ++r) ps += p1[r];
  { auto rr = __builtin_amdgcn_permlane32_swap(__float_as_uint(ps), __float_as_uint(ps), false, false);
    ps = __uint_as_float(rr[0]) + __uint_as_float(rr[1]); }
  l_reg = l_reg * alpha + ps;
#define PK4(P, BASE, OUT) do { unsigned a0 = cvtpk(P[BASE + 0], P[BASE + 1]), a1 = cvtpk(P[BASE + 2], P[BASE + 3]);   \
    unsigned b0 = cvtpk(P[BASE + 4], P[BASE + 5]), b1 = cvtpk(P[BASE + 6], P[BASE + 7]);                              \
    auto r0 = __builtin_amdgcn_permlane32_swap(a0, b0, false, false); auto r1 = __builtin_amdgcn_permlane32_swap(a1, b1, false, false); \
    u32x4 w = {r0[0], r1[0], r0[1], r1[1]}; OUT = *reinterpret_cast<bf16x8*>(&w); } while (0)
  PK4(p0, 0, pa0); PK4(p0, 8, pa1); PK4(p1, 0, pa2); PK4(p1, 8, pa3);
#undef PK4
}
__device__ __forceinline__ void qkt(f32x16& p0, f32x16& p1, const bf16_t* Ks, const bf16x8* qr, int r32, int hi) {
  p0 = f32x16{}; p1 = f32x16{};
  for (int d0 = 0; d0 < 8; ++d0) { int cb = (d0 * 16 + hi * 8) * 2;
    bf16x8 b0 = *reinterpret_cast<const bf16x8*>((const char*)Ks + KSWZ(r32, cb));
    bf16x8 b1 = *reinterpret_cast<const bf16x8*>((const char*)Ks + KSWZ(32 + r32, cb));
    p0 = __builtin_amdgcn_mfma_f32_32x32x16_bf16(b0, qr[d0], p0, 0, 0, 0);
    p1 = __builtin_amdgcn_mfma_f32_32x32x16_bf16(b1, qr[d0], p1, 0, 0, 0); }
}
__device__ __forceinline__ void mask_tile(f32x16& p0, f32x16& p1, int kt, int vis) {
  if (kt > vis) {
    const bool part = (kt == vis + 1);
    for (int r = 0; r < 16; ++r) p1[r] = NEG;
    for (int r = 8; r < 16; ++r) p0[r] = NEG;
    if (!part) for (int r = 0; r < 8; ++r) p0[r] = NEG;
  }
}
__device__ __forceinline__ int v_st(int k, int c) { const int kk = (k & ~0xC) | ((k & 4) << 1) | ((k & 8) >> 1); return ((kk >> 3) * 4 + (c >> 5)) * 512 + ((kk & 7) * 32 + (c & 31)) * 2; }
__device__ __forceinline__ int v_rd_base(int lane) { return ((lane & 3) << 3) | (((lane >> 2) & 3) << 6) | (((lane >> 4) & 1) << 5) | (((lane >> 5) & 1) << 8); }
constexpr int v_rd_off(int d0, int ks, int half) { return d0 * 512 + ks * 4096 + half * 2048; }
template <int OFF> __device__ __forceinline__ s16x4 tr_read(int vb) {
  s16x4 r; asm volatile("ds_read_b64_tr_b16 %0, %1 offset:%2" : "=&v"(r) : "v"(vb), "i"(OFF) : "memory"); return r;
}
template <int D0> __device__ __forceinline__ void pv_one(f32x16& od, int vb, bf16x8 pa0, bf16x8 pa1, bf16x8 pa2, bf16x8 pa3) {
  const s16x4 l0 = tr_read<v_rd_off(D0, 0, 0)>(vb), h0 = tr_read<v_rd_off(D0, 0, 1)>(vb), l1 = tr_read<v_rd_off(D0, 1, 0)>(vb), h1 = tr_read<v_rd_off(D0, 1, 1)>(vb);
  const s16x4 l2 = tr_read<v_rd_off(D0, 2, 0)>(vb), h2 = tr_read<v_rd_off(D0, 2, 1)>(vb), l3 = tr_read<v_rd_off(D0, 3, 0)>(vb), h3 = tr_read<v_rd_off(D0, 3, 1)>(vb);
  asm volatile("s_waitcnt lgkmcnt(0)" ::: "memory"); SBAR();
#define PK(L, H) (bf16x8){L[0], L[1], L[2], L[3], H[0], H[1], H[2], H[3]}
  od = __builtin_amdgcn_mfma_f32_32x32x16_bf16(pa0, PK(l0, h0), od, 0, 0, 0);
  od = __builtin_amdgcn_mfma_f32_32x32x16_bf16(pa1, PK(l1, h1), od, 0, 0, 0);
  od = __builtin_amdgcn_mfma_f32_32x32x16_bf16(pa2, PK(l2, h2), od, 0, 0, 0);
  od = __builtin_amdgcn_mfma_f32_32x32x16_bf16(pa3, PK(l3, h3), od, 0, 0, 0);
#undef PK
}
__device__ __forceinline__ void pv_d0(f32x16* o, int vb, bf16x8 pa0, bf16x8 pa1, bf16x8 pa2, bf16x8 pa3) {
  pv_one<0>(o[0], vb, pa0, pa1, pa2, pa3); pv_one<1>(o[1], vb, pa0, pa1, pa2, pa3); pv_one<2>(o[2], vb, pa0, pa1, pa2, pa3); pv_one<3>(o[3], vb, pa0, pa1, pa2, pa3);
}
__device__ __forceinline__ void attn_unit(const bf16_t* __restrict__ Qb, const bf16_t* __restrict__ Kh, const bf16_t* __restrict__ Vh, float* __restrict__ Ob, int NT, int vis4, char* lds) {
  const int tid = tid_(), wid = tid >> 6, lane = tid & 63, r32 = lane & 31, hi = lane >> 5;
  const int vis = vis4 + (wid >> 1);
  bf16_t* V_lds = (bf16_t*)lds; bf16_t* K_lds = (bf16_t*)(lds + 2 * SHM_V);
  float* ws = (float*)(lds + 2 * SHM_V + 2 * SHM_K) + wid * 64; float* li_l = ws; float* al_l = ws + 32;
  float m_reg = NEG, l_reg = 0; f32x16 o[4] = {}; bf16x8 qr[8];
  const bf16_t* Qw = Qb + (long)(wid * QBLK + r32) * LDQK + hi * 8;
#pragma unroll
  for (int d0 = 0; d0 < 8; ++d0) qr[d0] = *reinterpret_cast<const bf16x8*>(Qw + d0 * 16);
  const int sr = tid >> 4, sc = (tid & 15) * 8, vst0 = v_st(sr, sc), vst1 = v_st(32 + sr, sc);
  const int vb0 = (int)(uintptr_t)V_lds + v_rd_base(lane);
  struct { bf16x8 vs0, vs1, ks0, ks1; } sr_[2];
#define SLOAD(i, k0) do { sr_[i].vs0 = *reinterpret_cast<const bf16x8*>(&Vh[(long)((k0) + sr) * LDQK + sc]); sr_[i].vs1 = *reinterpret_cast<const bf16x8*>(&Vh[(long)((k0) + 32 + sr) * LDQK + sc]); \
    sr_[i].ks0 = *reinterpret_cast<const bf16x8*>(&Kh[(long)((k0) + sr) * LDQK + sc]); sr_[i].ks1 = *reinterpret_cast<const bf16x8*>(&Kh[(long)((k0) + 32 + sr) * LDQK + sc]); } while (0)
#define SWRITE(b, i) do { *(bf16x8*)((char*)V_lds + (b) * SHM_V + vst0) = sr_[i].vs0;          \
    *(bf16x8*)((char*)V_lds + (b) * SHM_V + vst1) = sr_[i].vs1; int kc = sc * 2;               \
    *(bf16x8*)((char*)K_lds + (b) * SHM_K + KSWZ(sr, kc)) = sr_[i].ks0;                       \
    *(bf16x8*)((char*)K_lds + (b) * SHM_K + KSWZ(32 + sr, kc)) = sr_[i].ks1; } while (0)
#define SWAIT() asm volatile("s_waitcnt vmcnt(4)" ::: "memory")
#define RESC(a) do { if (__any((a) < 1.f)) { if (hi == 0) al_l[r32] = (a); asm volatile("s_waitcnt lgkmcnt(0)" ::: "memory"); \
    for (int d = 0; d < 4; ++d) for (int r = 0; r < 16; ++r) o[d][r] *= al_l[crow(r, hi)]; } } while (0)
  f32x16 pA0, pA1, pB0, pB1; float mnA, mnB, alA, alB; bf16x8 pa0, pa1, pa2, pa3;
  constexpr int SE = 0, SO = 1;
  SLOAD(SE, 0); asm volatile("s_waitcnt vmcnt(0)" ::: "memory"); SWRITE(0, SE); __syncthreads();
  qkt(pA0, pA1, K_lds, qr, r32, hi); mask_tile(pA0, pA1, 0, vis); partialSM(pA0, pA1, m_reg, mnA, alA);
  SLOAD(SO, KVBLK); if (2 < NT) SLOAD(SE, 2 * KVBLK);
  SWAIT(); SWRITE(1, SO); __syncthreads();
  for (int j = 1; j + 1 < NT; j += 2) {
    SBAR(); qkt(pB0, pB1, (bf16_t*)((char*)K_lds + SHM_K), qr, r32, hi); mask_tile(pB0, pB1, j, vis);
    finishSM(pA0, pA1, alA, l_reg, pa0, pa1, pa2, pa3); SBAR();
    SLOAD(SO, (j + 2) * KVBLK); SBAR();
    pv_d0(o, vb0, pa0, pa1, pa2, pa3); partialSM(pB0, pB1, m_reg, mnB, alB);
    __syncthreads(); SWAIT(); SWRITE(0, SE);
    RESC(alB); __syncthreads();
    SBAR(); qkt(pA0, pA1, K_lds, qr, r32, hi); mask_tile(pA0, pA1, j + 1, vis);
    finishSM(pB0, pB1, alB, l_reg, pa0, pa1, pa2, pa3); SBAR();
    if (j + 3 < NT) SLOAD(SE, (j + 3) * KVBLK); SBAR();
    pv_d0(o, vb0 + (int)SHM_V, pa0, pa1, pa2, pa3); partialSM(pA0, pA1, m_reg, mnA, alA);
    __syncthreads(); SWAIT(); SWRITE(1, SO);
    RESC(alA); __syncthreads();
  }
  SBAR(); qkt(pB0, pB1, (bf16_t*)((char*)K_lds + SHM_K), qr, r32, hi); mask_tile(pB0, pB1, NT - 1, vis);
  finishSM(pA0, pA1, alA, l_reg, pa0, pa1, pa2, pa3); SBAR();
  pv_d0(o, vb0, pa0, pa1, pa2, pa3); partialSM(pB0, pB1, m_reg, mnB, alB);
  __syncthreads(); RESC(alB);
  finishSM(pB0, pB1, alB, l_reg, pa0, pa1, pa2, pa3); SBAR();
  pv_d0(o, vb0 + (int)SHM_V, pa0, pa1, pa2, pa3);
  if (hi == 0) li_l[r32] = l_reg; asm volatile("s_waitcnt lgkmcnt(0)" ::: "memory");
  float rli[16];
#pragma unroll
  for (int r = 0; r < 16; ++r) rli[r] = __builtin_amdgcn_rcpf(li_l[crow(r, hi)]);
  float* Ow = Ob + (long)(wid * QBLK) * DM;
#pragma unroll
  for (int r = 0; r < 16; ++r) { int orow = crow(r, hi);
    for (int d0 = 0; d0 < 4; ++d0) Ow[(long)orow * DM + d0 * 32 + r32] = o[d0][r] * rli[r]; }
  __syncthreads();
#undef SLOAD
#undef SWRITE
#undef SWAIT
#undef RESC
}
#undef KSWZ
#undef SBAR
}

__device__ __forceinline__ void ph_attention(KP P, char* lds) {
    const bf16_t* QKV = P->QKV; float* OC = P->OC;
    const int c = bid_();
    if (c < 256) {
        const int combo = c >> 2, b = combo >> 4, h = (combo >> 2) & 3, i = (combo >> 1) & 1, vh = combo & 1;
        const bf16_t* Kh = QKV + (size_t)(b * LL) * QKVW + 1024 + h * 256 + i * 128;
        const bf16_t* Vh = QKV + (size_t)(b * LL) * QKVW + 2048 + h * 256 + vh * 128;
#pragma unroll 1
        for (int s = 0; s < 2; ++s) {
            const int jb = s == 0 ? (c & 3) : 7 - (c & 3);
            const size_t row0 = (size_t)(b * LL) + NMETA + 256 * jb;
            fa::attn_unit(QKV + row0 * QKVW + h * 256 + i * 128, Kh, Vh, OC + row0 * DM + h * 512 + i * 256 + vh * 128, 4 * jb + 6, 4 * jb, lds);
        }
    }
    {
        const int tid = tid_(), lane = tid & 63, gw = c * 8 + (tid >> 6);
        if (gw < 512) {
            const int b = gw >> 7, h = (gw >> 5) & 3, i = (gw >> 4) & 1, row = gw & 15;
            const bf16_t* q = QKV + (size_t)(b * LL + row) * QKVW + h * 256 + i * 128;
            const int key = lane & 15;
            const bf16_t* k = QKV + (size_t)(b * LL + key) * QKVW + 1024 + h * 256 + i * 128;
            float sc = 0.f;
            for (int d = 0; d < 128; ++d) sc = fmaf(bf2f(q[d]), bf2f(k[d]), sc);
            sc *= 0.08838834764831845f;
            float m = sc;
#pragma unroll
            for (int o = 8; o > 0; o >>= 1) m = fmaxf(m, __shfl_xor(m, o));
            const float e = expf(sc - m);
            float ssum = e;
#pragma unroll
            for (int o = 8; o > 0; o >>= 1) ssum += __shfl_xor(ssum, o);
            const float p = e / ssum;
            float acc[4] = {0.f, 0.f, 0.f, 0.f};
            for (int j = 0; j < 16; ++j) {
                const float pj = __shfl(p, j);
                const bf16_t* v = QKV + (size_t)(b * LL + j) * QKVW + 2048 + h * 256 + lane * 4;
#pragma unroll
                for (int e2 = 0; e2 < 4; ++e2) acc[e2] = fmaf(pj, bf2f(v[e2]), acc[e2]);
            }
            float* o = OC + (size_t)(b * LL + row) * DM + h * 512 + i * 256 + lane * 4;
            o[0] = acc[0]; o[1] = acc[1]; o[2] = acc[2]; o[3] = acc[3];
        }
    }
}


namespace hg {
using bf16x8 = __attribute__((ext_vector_type(8))) short;
using s16x4  = __attribute__((ext_vector_type(4))) short;
using f32x16 = __attribute__((ext_vector_type(16))) float;
using u32x4  = __attribute__((ext_vector_type(4))) unsigned;
constexpr int NCH = 33, NU = 16 * NCH;
constexpr int SK = 136;
constexpr int SS = 72;
__device__ __forceinline__ int crow(int r, int hi) { return (r & 3) + 8 * (r >> 2) + 4 * hi; }
__device__ __forceinline__ unsigned cvtpk(float lo, float hi) { unsigned r; asm volatile("v_cvt_pk_bf16_f32 %0, %1, %2" : "=v"(r) : "v"(lo), "v"(hi)); return r; }

__device__ __forceinline__ void prep(const float* PA, const float* lbtab, size_t row0, int c, int h, int k, int tq, float* qsum, float (&b)[16], float (&kk)[16], float& bend, float& r) {
    const float lbv = lbtab[h * 128 + k];
    float run = 0.f;
#pragma unroll
    for (int i = 0; i < 16; ++i) {
        const int t = 16 * tq + i; const bool valid = (c * 64 + t) < LL;
        const float fp = valid ? PA[(row0 + t) * PAW + 512 + h * 128 + k] : 0.f;
        const float kv = valid ? (1.f - lbv) / (1.f + __expf(fp)) : 0.f;
        kk[i] = kv; run += fmaxf(log1pf(-kv), -30.f); b[i] = run;
    }
    qsum[tq * 128 + k] = run;
    __syncthreads();
    const float q0 = qsum[k], q1 = qsum[128 + k], q2 = qsum[256 + k], q3 = qsum[384 + k];
    const float off = tq == 0 ? 0.f : (tq == 1 ? q0 : (tq == 2 ? q0 + q1 : q0 + q1 + q2));
    r = q0 + q1; bend = (q0 + q1) + (q2 + q3);
#pragma unroll
    for (int i = 0; i < 16; ++i) b[i] += off;
}
__device__ __forceinline__ void store16(bf16_t* dst, const float (&x)[16]) {
    u32x4 w0, w1;
    w0.x = cvtpk(x[0], x[1]); w0.y = cvtpk(x[2], x[3]); w0.z = cvtpk(x[4], x[5]); w0.w = cvtpk(x[6], x[7]);
    w1.x = cvtpk(x[8], x[9]); w1.y = cvtpk(x[10], x[11]); w1.z = cvtpk(x[12], x[13]); w1.w = cvtpk(x[14], x[15]);
    *(u32x4*)dst = w0; *(u32x4*)(dst + 8) = w1;
}

__device__ __forceinline__ void local_states(KP P, char* lds, int layer) {
    bf16_t* KhT = (bf16_t*)lds; bf16_t* VT = KhT + 128 * SS; float* qsum = (float*)(VT + 128 * SS);
    const float* PA = P->PA; const float* lbtab = P->lbtab + layer * 512; float* SLOC = P->SLOC; float* DEC = P->DEC;
    const int tid = tid_(), k = tid & 127, tq = tid >> 7, lane = tid & 63, wid = tid >> 6, r32 = lane & 31, hh = lane >> 5;
    for (int u = bid_(); u < NU; u += gridDim.x) {
        const int bh = u / NCH, c = u % NCH, b_ = bh >> 2, h = bh & 3; const size_t row0 = (size_t)b_ * LL + c * 64;
        float b[16], kk[16], bend, r;
        prep(PA, lbtab, row0, c, h, k, tq, qsum, b, kk, bend, r);
        float x[16];
#pragma unroll
        for (int i = 0; i < 16; ++i) x[i] = kk[i] * __expf(bend - b[i]);
        store16(KhT + k * SS + 16 * tq, x);
#pragma unroll
        for (int i = 0; i < 16; ++i) { const int t = 16 * tq + i; x[i] = (c * 64 + t) < LL ? PA[(row0 + t) * PAW + 1024 + h * 128 + k] : 0.f; }
        store16(VT + k * SS + 16 * tq, x);
        if (tq == 0) DEC[u * 128 + k] = __expf(bend);
        __syncthreads();
        const int vt = wid >> 1;
#pragma unroll
        for (int j = 0; j < 2; ++j) {
            const int kt = (wid & 1) * 2 + j;
            f32x16 acc = {};
#pragma unroll
            for (int sg = 0; sg < 4; ++sg) {
                const bf16x8 a = *(const bf16x8*)(VT + (vt * 32 + r32) * SS + sg * 16 + hh * 8);
                const bf16x8 bb = *(const bf16x8*)(KhT + (kt * 32 + r32) * SS + sg * 16 + hh * 8);
                acc = __builtin_amdgcn_mfma_f32_32x32x16_bf16(a, bb, acc, 0, 0, 0);
            }
            float* o = SLOC + (size_t)u * 16384 + kt * 32 + r32;
#pragma unroll
            for (int rg = 0; rg < 16; ++rg) o[(vt * 32 + crow(rg, hh)) * 128] = acc[rg];
        }
        __syncthreads();
    }
}
__device__ __forceinline__ void scan_states(KP P) {
    const float* SLOC = P->SLOC; const float* DEC = P->DEC; bf16_t* SPREV = P->SPREV;
    const int tid = tid_();
    for (int e = bid_() * NTHR + tid; e < 16 * 16384; e += gridDim.x * NTHR) {
        const int bh = e >> 14, vk = e & 16383, k = vk & 127;
        float S = 0.f;
#pragma unroll 8
        for (int c = 0; c < NCH - 1; ++c) {
            const int u = bh * NCH + c;
            S = fmaf(DEC[u * 128 + k], S, SLOC[(size_t)u * 16384 + vk]);
            SPREV[(size_t)(u + 1) * 16384 + vk] = f2bf(S);
        }
    }
}
__device__ __forceinline__ void outputs(KP P, char* lds, int layer) {
    bf16_t* Qt = (bf16_t*)lds; bf16_t* Qh = Qt + 64 * SK; bf16_t* Kt = Qh + 64 * SK; bf16_t* VT = Kt + 64 * SK; bf16_t* SpT = VT + 128 * SS;
    float* qsum = (float*)(SpT + 128 * SK); float* part = qsum + 512;
    const float* PA = P->PA; const float* lbtab = P->lbtab + layer * 512; const bf16_t* SPREV = P->SPREV; const float* nw = P->hnw + layer * 128; bf16_t* MIX = P->MIX;
    const int tid = tid_(), k = tid & 127, tq = tid >> 7, lane = tid & 63, wid = tid >> 6, r32 = lane & 31, hh = lane >> 5;
    for (int u = bid_(); u < NU; u += gridDim.x) {
        const int bh = u / NCH, c = u % NCH, b_ = bh >> 2, h = bh & 3; const size_t row0 = (size_t)b_ * LL + c * 64;
        float b[16], kk[16], bend, r;
        prep(PA, lbtab, row0, c, h, k, tq, qsum, b, kk, bend, r);
#pragma unroll
        for (int i = 0; i < 16; ++i) { const int t = 16 * tq + i; const bool valid = (c * 64 + t) < LL;
            const float q = valid ? PA[(row0 + t) * PAW + h * 128 + k] : 0.f;
            Qt[t * SK + k] = f2bf(q * __expf(b[i] - r)); Qh[t * SK + k] = f2bf(q * __expf(b[i])); Kt[t * SK + k] = f2bf(kk[i] * __expf(r - b[i])); }
        { float x[16];
#pragma unroll
          for (int i = 0; i < 16; ++i) { const int t = 16 * tq + i; x[i] = (c * 64 + t) < LL ? PA[(row0 + t) * PAW + 1024 + h * 128 + k] : 0.f; }
          store16(VT + k * SS + 16 * tq, x); }
        if (c > 0) {
#pragma unroll
            for (int j = 0; j < 4; ++j) { const int idx = tid + 512 * j, v = idx >> 4, ch = idx & 15;
                *(u32x4*)(SpT + v * SK + ch * 8) = *(const u32x4*)(SPREV + (size_t)u * 16384 + v * 128 + ch * 8); }
        }
        __syncthreads();
        const int tt = wid & 1, vt = wid >> 1;
        f32x16 oacc = {};
#pragma unroll
        for (int st = 0; st < 2; ++st) {
            if (st <= tt) {
                f32x16 sc = {};
#pragma unroll
                for (int d0 = 0; d0 < 8; ++d0) {
                    const bf16x8 a = *(const bf16x8*)(Kt + (st * 32 + r32) * SK + d0 * 16 + hh * 8);
                    const bf16x8 bq = *(const bf16x8*)(Qt + (tt * 32 + r32) * SK + d0 * 16 + hh * 8);
                    sc = __builtin_amdgcn_mfma_f32_32x32x16_bf16(a, bq, sc, 0, 0, 0);
                }
                if (st == tt) {
#pragma unroll
                    for (int rg = 0; rg < 16; ++rg) sc[rg] = (crow(rg, hh) <= r32) ? sc[rg] : 0.f;
                }
#pragma unroll
                for (int g = 0; g < 2; ++g) {
                    u32x4 w; w.x = cvtpk(sc[8 * g + 0], sc[8 * g + 1]); w.y = cvtpk(sc[8 * g + 2], sc[8 * g + 3]); w.z = cvtpk(sc[8 * g + 4], sc[8 * g + 5]); w.w = cvtpk(sc[8 * g + 6], sc[8 * g + 7]);
                    const bf16x8 pb = *reinterpret_cast<bf16x8*>(&w);
                    const bf16_t* vp = VT + (vt * 32 + r32) * SS + st * 32 + 16 * g + 4 * hh;
                    const s16x4 lo = *(const s16x4*)vp, hi4 = *(const s16x4*)(vp + 8);
                    const bf16x8 a = (bf16x8){lo[0], lo[1], lo[2], lo[3], hi4[0], hi4[1], hi4[2], hi4[3]};
                    oacc = __builtin_amdgcn_mfma_f32_32x32x16_bf16(a, pb, oacc, 0, 0, 0);
                }
            }
        }
        if (c > 0) {
#pragma unroll
            for (int d0 = 0; d0 < 8; ++d0) {
                const bf16x8 a = *(const bf16x8*)(SpT + (vt * 32 + r32) * SK + d0 * 16 + hh * 8);
                const bf16x8 bq = *(const bf16x8*)(Qh + (tt * 32 + r32) * SK + d0 * 16 + hh * 8);
                oacc = __builtin_amdgcn_mfma_f32_32x32x16_bf16(a, bq, oacc, 0, 0, 0);
            }
        }
        float ss = 0.f;
#pragma unroll
        for (int rg = 0; rg < 16; ++rg) ss = fmaf(oacc[rg], oacc[rg], ss);
        { auto rr = __builtin_amdgcn_permlane32_swap(__float_as_uint(ss), __float_as_uint(ss), false, false); ss = __uint_as_float(rr[0]) + __uint_as_float(rr[1]); }
        if (hh == 0) part[vt * 64 + tt * 32 + r32] = ss;
        __syncthreads();
        const int t = tt * 32 + r32;
        const float tot = (part[t] + part[64 + t]) + (part[128 + t] + part[192 + t]);
        const float scale = rsqrtf(tot * (1.f / 128.f) + EPS);
        if ((c * 64 + t) < LL) {
            const float* gp = PA + (row0 + t) * PAW + 1536 + h * 128 + vt * 32;
            bf16_t* op = MIX + (row0 + t) * DM + h * 128 + vt * 32;
#pragma unroll
            for (int g4 = 0; g4 < 4; ++g4) {
                const int v0 = 8 * g4 + 4 * hh;
                const float4 gv = *(const float4*)(gp + v0); const float4 wv = *(const float4*)(nw + vt * 32 + v0);
                const float y0 = oacc[4 * g4 + 0] * scale * wv.x * gv.x / (1.f + __expf(-gv.x)), y1 = oacc[4 * g4 + 1] * scale * wv.y * gv.y / (1.f + __expf(-gv.y));
                const float y2 = oacc[4 * g4 + 2] * scale * wv.z * gv.z / (1.f + __expf(-gv.z)), y3 = oacc[4 * g4 + 3] * scale * wv.w * gv.w / (1.f + __expf(-gv.w));
                uint2 w; w.x = cvtpk(y0, y1); w.y = cvtpk(y2, y3);
                *(uint2*)(op + v0) = w;
            }
        }
        __syncthreads();
    }
}
}


namespace moe {
using bf16x8 = __attribute__((ext_vector_type(8))) short;
using f32x16 = __attribute__((ext_vector_type(16))) float;
using u32x4  = __attribute__((ext_vector_type(4))) unsigned;
constexpr int TW = 5, PROWS = 64 * TW, XS = 144, XBUF = PROWS * XS;
__device__ __forceinline__ unsigned cvtpk(float lo, float hi) { unsigned r; asm volatile("v_cvt_pk_bf16_f32 %0, %1, %2" : "=v"(r) : "v"(lo), "v"(hi)); return r; }
#define MOE_BAR() asm volatile("s_waitcnt lgkmcnt(0)\n\ts_barrier" ::: "memory")
template <bool UP>
__device__ __forceinline__ void stream_gemm(KP P, char* lds, int layer) {
    constexpr int KTOT = UP ? DM : DE, NSLAB = KTOT / 64, NCP = UP ? 2 : 4, LDW = UP ? DE : DM;
    const int tid = tid_(), lane = tid & 63, wid = tid >> 6, r32 = lane & 31, hh = lane >> 5, cg = wid & 3, th = wid >> 2;
    const int* cnt_ = P->cnt; const int* base_ = P->base; const int* rowtok = P->rowtok;
    const bf16_t* X = UP ? P->HN : P->H;
    for (int u = bid_(); u < 256; u += gridDim.x) {
        const int e = u >> 2, ns = u & 3;
        const int cnt = cnt_[e], row0 = base_[e];
        for (int pass0 = 0; pass0 < cnt; pass0 += PROWS) {
            const int cntp = (cnt - pass0) < PROWS ? (cnt - pass0) : PROWS, T = (cntp + 31) >> 5;
            const int Tw = (T - TW * th) < 0 ? 0 : ((T - TW * th) > TW ? TW : (T - TW * th));
            int xoff[5];
#pragma unroll
            for (int j = 0; j < 5; ++j) { int rho = (tid >> 3) + 64 * j; rho = rho < cntp ? rho : cntp - 1; const int grow = row0 + pass0 + rho;
                xoff[j] = (UP ? rowtok[grow] * DM : grow * DE) + (tid & 7) * 8; }
            char* const xw = lds + (tid >> 3) * XS + (tid & 7) * 16;
#pragma unroll 1
            for (int cp = 0; cp < NCP; ++cp) {
                const int cgi = cp * 4 + cg;
                const float* wp;
                if constexpr (UP) wp = (r32 < 16 ? P->w1 : P->w3) + ((size_t)(layer * NE + e) * DM + 8 * hh) * DE + ns * 128 + cgi * 16 + (r32 & 15);
                else wp = P->w2 + ((size_t)(layer * NE + e) * DE + 8 * hh) * DM + ns * 512 + cgi * 32 + r32;
                f32x16 acc[TW];
#pragma unroll
                for (int tl = 0; tl < TW; ++tl) acc[tl] = f32x16{};
                float wreg[4][8]; u32x4 xs[5];
#pragma unroll
                for (int j = 0; j < 5; ++j) xs[j] = *(const u32x4*)(X + xoff[j]);
#pragma unroll
                for (int kk = 0; kk < 4; ++kk)
#pragma unroll
                    for (int jj = 0; jj < 8; ++jj) wreg[kk][jj] = wp[(size_t)(kk * 16 + jj) * LDW];
#pragma unroll
                for (int j = 0; j < 5; ++j) *(u32x4*)(xw + 64 * j * XS) = xs[j];
                MOE_BAR();
#pragma unroll 1
                for (int s = 0; s < NSLAB; ++s) {
                    const bool more = (s + 1) < NSLAB;
                    if (more) {
#pragma unroll
                        for (int j = 0; j < 5; ++j) xs[j] = *(const u32x4*)(X + xoff[j] + (s + 1) * 64);
                    }
                    const char* xb = lds + (s & 1) * XBUF + (th * TW * 32 + r32) * XS + hh * 16;
#pragma unroll
                    for (int kk = 0; kk < 4; ++kk) {
                        u32x4 fw; fw.x = cvtpk(wreg[kk][0], wreg[kk][1]); fw.y = cvtpk(wreg[kk][2], wreg[kk][3]); fw.z = cvtpk(wreg[kk][4], wreg[kk][5]); fw.w = cvtpk(wreg[kk][6], wreg[kk][7]);
                        const bf16x8 frag = *reinterpret_cast<bf16x8*>(&fw);
                        if (more) {
#pragma unroll
                            for (int jj = 0; jj < 8; ++jj) wreg[kk][jj] = wp[(size_t)((s + 1) * 64 + kk * 16 + jj) * LDW];
                        }
#pragma unroll
                        for (int tl = 0; tl < TW; ++tl) if (tl < Tw) {
                            const bf16x8 xf = *(const bf16x8*)(xb + tl * 32 * XS + kk * 32);
                            acc[tl] = __builtin_amdgcn_mfma_f32_32x32x16_bf16(frag, xf, acc[tl], 0, 0, 0);
                        }
                    }
                    if (more) {
#pragma unroll
                        for (int j = 0; j < 5; ++j) *(u32x4*)(xw + ((s + 1) & 1) * XBUF + 64 * j * XS) = xs[j];
                    }
                    MOE_BAR();
                }
#pragma unroll
                for (int tl = 0; tl < TW; ++tl) if (tl < Tw) {
                    const int rho = (th * TW + tl) * 32 + r32;
                    if (rho < cntp) {
                        const size_t grow = (size_t)(row0 + pass0 + rho);
                        if constexpr (UP) {
                            bf16_t* hp = P->H + grow * DE + ns * 128 + cgi * 16 + 4 * hh;
#pragma unroll
                            for (int g = 0; g < 2; ++g) {
                                float y[4];
#pragma unroll
                                for (int q = 0; q < 4; ++q) { const float a = acc[tl][4 * g + q], b = acc[tl][8 + 4 * g + q]; y[q] = a / (1.f + __expf(-a)) * b; }
                                uint2 w; w.x = cvtpk(y[0], y[1]); w.y = cvtpk(y[2], y[3]);
                                *(uint2*)(hp + 8 * g) = w;
                            }
                        } else {
                            bf16_t* yp = P->Y + grow * DM + ns * 512 + cgi * 32 + 4 * hh;
#pragma unroll
                            for (int g = 0; g < 4; ++g) {
                                uint2 w; w.x = cvtpk(acc[tl][4 * g + 0], acc[tl][4 * g + 1]); w.y = cvtpk(acc[tl][4 * g + 2], acc[tl][4 * g + 3]);
                                *(uint2*)(yp + 8 * g) = w;
                            }
                        }
                    }
                }
            }
        }
    }
}
#undef MOE_BAR
}


namespace s5 {
using bf16x8 = __attribute__((ext_vector_type(8))) short;
using f32x16 = __attribute__((ext_vector_type(16))) float;
using u32x4  = __attribute__((ext_vector_type(4))) unsigned;
constexpr int NCHK = 516, NMT = 17;
__device__ __forceinline__ unsigned cvtpk(float lo, float hi) { unsigned r; asm volatile("v_cvt_pk_bf16_f32 %0, %1, %2" : "=v"(r) : "v"(lo), "v"(hi)); return r; }
__device__ __forceinline__ bf16x8 ld8f(const float* p) {
    const float4 a = *(const float4*)p, b = *(const float4*)(p + 4);
    u32x4 w; w.x = cvtpk(a.x, a.y); w.y = cvtpk(a.z, a.w); w.z = cvtpk(b.x, b.y); w.w = cvtpk(b.z, b.w);
    return *reinterpret_cast<bf16x8*>(&w);
}
__device__ __forceinline__ void prep_unit(KP P, char* lds, int layer, int g) {
    float2* pw = (float2*)lds; float2* bb = pw + 17 * 64; float2* cc = bb + 1024; float* kd = (float*)(cc + 1024);
    const int tid = tid_();
    const float dt = expf(P->log_dt[layer * 32 + g]);
    const float* a_re = P->a_re + (layer * 32 + g) * 64; const float* a_im = P->a_im + (layer * 32 + g) * 64;
    for (int idx = tid; idx < 17 * 64; idx += NTHR) { const int d = idx >> 6, p = idx & 63;
        const float mag = expf(a_re[p] * dt * (float)d), ang = a_im[p] * dt * (float)d; pw[idx] = make_float2(mag * cosf(ang), mag * sinf(ang)); }
    for (int idx = tid; idx < 1024; idx += NTHR) {
        { const int p = idx >> 4, c = idx & 15; const float are = a_re[p], aim = a_im[p];
          const float mag = expf(are * dt), abr = mag * cosf(aim * dt), abi = mag * sinf(aim * dt), den = are * are + aim * aim;
          const float zr = ((abr - 1.f) * are + abi * aim) / den, zi = (abi * are - (abr - 1.f) * aim) / den;
          const float br = P->b_re[((layer * 32 + g) * 64 + p) * 16 + c], bi = P->b_im[((layer * 32 + g) * 64 + p) * 16 + c];
          bb[idx] = make_float2(zr * br - zi * bi, zr * bi + zi * br); }
        { const int c = idx >> 6, p = idx & 63; cc[idx] = make_float2(P->c_re[((layer * 32 + g) * 16 + c) * 64 + p], P->c_im[((layer * 32 + g) * 16 + c) * 64 + p]); }
    }
    __syncthreads();
    if (tid < 64) ((float2*)P->A16)[(layer * 32 + g) * 64 + tid] = pw[16 * 64 + tid];
    for (int idx = tid; idx < 4096; idx += NTHR) { const int d = idx >> 8, c = (idx >> 4) & 15, c2 = idx & 15;
        float acc = 0.f;
        for (int p = 0; p < 64; ++p) { const float2 C = cc[c * 64 + p], W = pw[d * 64 + p], B = bb[p * 16 + c2];
            const float xr = C.x * W.x - C.y * W.y, xi = C.x * W.y + C.y * W.x; acc += xr * B.x - xi * B.y; }
        if (d == 0 && c == c2) acc += P->s5d[layer * 512 + g * 16 + c];
        kd[idx] = acc; }
    __syncthreads();
    bf16_t* BtY = P->BtY + (size_t)(layer * 32 + g) * 256 * 384; bf16_t* BtE = P->BtE + (size_t)(layer * 32 + g) * 128 * 256;
    for (int idx = tid; idx < 256 * 48; idx += NTHR) { const int n = idx / 48, ch = idx % 48, t = n >> 4, c = n & 15;
        float v[8];
        if (ch < 32) { const int s = ch >> 1, c0 = (ch & 1) * 8;
#pragma unroll
            for (int jj = 0; jj < 8; ++jj) v[jj] = (s <= t) ? kd[((t - s) * 16 + c) * 16 + c0 + jj] : 0.f;
        } else {
#pragma unroll
            for (int jj = 0; jj < 8; ++jj) { const int kq = (ch - 32) * 8 + jj, p = kq >> 1; const float2 C = cc[c * 64 + p], W = pw[(t + 1) * 64 + p];
                v[jj] = (kq & 1) ? -(C.x * W.y + C.y * W.x) : (C.x * W.x - C.y * W.y); }
        }
        u32x4 w; w.x = cvtpk(v[0], v[1]); w.y = cvtpk(v[2], v[3]); w.z = cvtpk(v[4], v[5]); w.w = cvtpk(v[6], v[7]);
        *(u32x4*)(BtY + (size_t)n * 384 + ch * 8) = w; }
    for (int idx = tid; idx < 128 * 32; idx += NTHR) { const int n = idx >> 5, ch = idx & 31, p = n >> 1, s = ch >> 1, c0 = (ch & 1) * 8;
        const float2 W = pw[(15 - s) * 64 + p];
        float v[8];
#pragma unroll
        for (int jj = 0; jj < 8; ++jj) { const float2 B = bb[p * 16 + c0 + jj]; v[jj] = (n & 1) ? (W.x * B.y + W.y * B.x) : (W.x * B.x - W.y * B.y); }
        u32x4 w; w.x = cvtpk(v[0], v[1]); w.y = cvtpk(v[2], v[3]); w.z = cvtpk(v[4], v[5]); w.w = cvtpk(v[6], v[7]);
        *(u32x4*)(BtE + (size_t)n * 256 + ch * 8) = w; }
    __syncthreads();
}
__device__ __forceinline__ void local_states(KP P, int layer) {
    const int tid = tid_(), lane = tid & 63, r32 = lane & 31, hh = lane >> 5, gw = bid_() * 8 + (tid >> 6), NGW = gridDim.x * 8;
    const float* PA = P->PA; float* E = P->S5E;
    for (int wu = gw; wu < 32 * NMT; wu += NGW) {
        const int g = wu / NMT, mt = wu % NMT, m = mt * 32 + r32, mc = m < NCHK ? m : NCHK - 1;
        const bf16_t* Bt = P->BtE + ((size_t)(layer * 32 + g) * 128 + r32) * 256 + 8 * hh;
        const float* up = PA + (size_t)(mc * 16) * PAW + 2048 + g * 16 + 8 * hh;
        f32x16 acc[4];
#pragma unroll
        for (int nt = 0; nt < 4; ++nt) acc[nt] = f32x16{};
#pragma unroll 4
        for (int s = 0; s < 16; ++s) {
            const bf16x8 bf = ld8f(up + (size_t)s * PAW);
#pragma unroll
            for (int nt = 0; nt < 4; ++nt) { const bf16x8 af = *(const bf16x8*)(Bt + (size_t)nt * 32 * 256 + s * 16); acc[nt] = __builtin_amdgcn_mfma_f32_32x32x16_bf16(af, bf, acc[nt], 0, 0, 0); }
        }
        if (m < NCHK) { float* ep = E + ((size_t)m * 32 + g) * 128 + 4 * hh;
#pragma unroll
            for (int nt = 0; nt < 4; ++nt)
#pragma unroll
                for (int q = 0; q < 4; ++q) *(float4*)(ep + nt * 32 + 8 * q) = make_float4(acc[nt][4 * q], acc[nt][4 * q + 1], acc[nt][4 * q + 2], acc[nt][4 * q + 3]); }
    }
}
__device__ __forceinline__ void scan_states(KP P, int layer) {
    const int idx = bid_() * NTHR + tid_();
    if (idx >= 8192) return;
    const int b = idx >> 11, g = (idx >> 6) & 31, p = idx & 63;
    const float2 A = ((const float2*)P->A16)[(layer * 32 + g) * 64 + p];
    const float2* E = (const float2*)P->S5E; float2* XP = (float2*)P->S5X;
    float xr = 0.f, xi = 0.f;
#pragma unroll 8
    for (int j = 0; j < 129; ++j) { const size_t o = ((size_t)(b * 129 + j) * 32 + g) * 64 + p;
        XP[o] = make_float2(xr, xi); const float2 e = E[o];
        const float nr = A.x * xr - A.y * xi + e.x, ni = A.x * xi + A.y * xr + e.y; xr = nr; xi = ni; }
}
__device__ __forceinline__ float gelu_t(float x) { const float u = 0.7978845608028654f * (x + 0.044715f * x * x * x); const float e = __expf(2.f * u); return x - x / (e + 1.f); }
__device__ __forceinline__ void outputs(KP P, int layer) {
    const int tid = tid_(), lane = tid & 63, r32 = lane & 31, hh = lane >> 5, gw = bid_() * 8 + (tid >> 6), NGW = gridDim.x * 8;
    const float* PA = P->PA; const float* XP = P->S5X; bf16_t* YG = P->YG;
    for (int wu = gw; wu < 32 * NMT; wu += NGW) {
        const int g = wu / NMT, mt = wu % NMT, m = mt * 32 + r32, mc = m < NCHK ? m : NCHK - 1;
        const bf16_t* Bt = P->BtY + ((size_t)(layer * 32 + g) * 256 + r32) * 384 + 8 * hh;
        const float* up = PA + (size_t)(mc * 16) * PAW + 2048 + g * 16 + 8 * hh;
        const float* xp = XP + ((size_t)mc * 32 + g) * 128 + 8 * hh;
        f32x16 acc[8];
#pragma unroll
        for (int nt = 0; nt < 8; ++nt) acc[nt] = f32x16{};
#pragma unroll
        for (int s = 0; s < 16; ++s) {
            const bf16x8 bf = ld8f(up + (size_t)s * PAW);
#pragma unroll
            for (int nt = 0; nt < 8; ++nt) if (2 * nt + 1 >= s) { const bf16x8 af = *(const bf16x8*)(Bt + (size_t)nt * 32 * 384 + s * 16); acc[nt] = __builtin_amdgcn_mfma_f32_32x32x16_bf16(af, bf, acc[nt], 0, 0, 0); }
        }
#pragma unroll
        for (int ks = 0; ks < 8; ++ks) {
            const bf16x8 bf = ld8f(xp + ks * 16);
#pragma unroll
            for (int nt = 0; nt < 8; ++nt) { const bf16x8 af = *(const bf16x8*)(Bt + (size_t)nt * 32 * 384 + 256 + ks * 16); acc[nt] = __builtin_amdgcn_mfma_f32_32x32x16_bf16(af, bf, acc[nt], 0, 0, 0); }
        }
        if (m < NCHK) {
#pragma unroll
            for (int nt = 0; nt < 8; ++nt)
#pragma unroll
                for (int q = 0; q < 4; ++q) { const int t = 2 * nt + (q >> 1);
                    uint2 w; w.x = cvtpk(gelu_t(acc[nt][4 * q]), gelu_t(acc[nt][4 * q + 1])); w.y = cvtpk(gelu_t(acc[nt][4 * q + 2]), gelu_t(acc[nt][4 * q + 3]));
                    *(uint2*)(YG + (size_t)(m * 16 + t) * 512 + g * 16 + 8 * (q & 1) + 4 * hh) = w; }
        }
    }
}
}

__device__ __forceinline__ float block_sum(float v, float* red) {
#pragma unroll
    for (int o = 32; o > 0; o >>= 1) v += __shfl_xor(v, o);
    __syncthreads();
    if ((threadIdx.x & 63) == 0) red[threadIdx.x >> 6] = v;
    __syncthreads();
    float s = 0.f;
#pragma unroll
    for (int i = 0; i < 8; ++i) s += red[i];
    return s;
}
__device__ __forceinline__ float block_max(float v, float* red) {
#pragma unroll
    for (int o = 32; o > 0; o >>= 1) v = fmaxf(v, __shfl_xor(v, o));
    __syncthreads();
    if ((threadIdx.x & 63) == 0) red[threadIdx.x >> 6] = v;
    __syncthreads();
    float s = red[0];
#pragma unroll
    for (int i = 1; i < 8; ++i) s = fmaxf(s, red[i]);
    return s;
}
__device__ __forceinline__ float gelu_tanh(float x) {
    const float u = 0.7978845608028654f * (x + 0.044715f * x * x * x);
    return 0.5f * x * (1.f + tanhf(u));
}

__device__ __forceinline__ void ph_build_norm(KP P, char* lds) {
    float* red = (float*)lds;
    const int tid = tid_();
    for (int r = bid_(); r < MP; r += gridDim.x) {
        float4 v = make_float4(0.f, 0.f, 0.f, 0.f);
        if (r < TOK) { const int b = r / LL, t = r % LL;
            const float4* src = (const float4*)(t < NMETA ? P->meta + (size_t)t * DM : P->x + ((size_t)b * SEQ + (t - NMETA)) * DM);
            v = src[tid]; }
        ((float4*)(P->Z + (size_t)r * DM))[tid] = v;
        const float ss = block_sum(v.x * v.x + v.y * v.y + v.z * v.z + v.w * v.w, red);
        const float rs = rsqrtf(ss * (1.f / DM) + EPS);
        const float4 w = ((const float4*)P->ln1_w)[tid];
        bf16_t* o = P->HN + (size_t)r * DM + tid * 4;
        o[0] = f2bf(v.x * rs * w.x); o[1] = f2bf(v.y * rs * w.y); o[2] = f2bf(v.z * rs * w.z); o[3] = f2bf(v.w * rs * w.w);
    }
}
__device__ __forceinline__ void ph_prep(KP P) {
    if (blockIdx.x != 0) return;
    const int c = threadIdx.x;
    const float l0 = P->lbnd[c], l1 = P->lbnd[512 + c], m = fmaxf(l0, l1), e0 = expf(l0 - m), e1 = expf(l1 - m);
    P->lbtab[c] = 0.f; P->lbtab[512 + c] = e1 / (e0 + e1);
    if (c < 2) {
        float s1 = 0.f, s2 = 0.f;
        for (int i = 0; i < 128; ++i) { s1 += P->lq1[c * 128 + i] * P->lk1[c * 128 + i]; s2 += P->lq2[c * 128 + i] * P->lk2[c * 128 + i]; }
        const float li = 0.8f - 0.6f * expf(-0.3f * (float)c);
        P->lam[c] = expf(s1) - expf(s2) + li;
    }
}
__device__ __forceinline__ void ph_hgrn(KP P, char* lds, int layer, int unit) {
    float* qs = (float*)lds; float* fs = qs + 128; float* ks = fs + 128; float (*op)[128] = (float (*)[128])(ks + 128);
    const float* PA = P->PA; const float* lb = P->lbtab + layer * 512;
    const int b = unit >> 2, h = unit & 3, tid = tid_(), v = tid & 127, kq = tid >> 7;
    float S[32];
#pragma unroll
    for (int j = 0; j < 32; ++j) S[j] = 0.f;
#pragma unroll 1
    for (int t = 0; t < LL; ++t) {
        const size_t r = (size_t)b * LL + t;
        if (tid < 128) {
            const int c = h * 128 + tid;
            const float q = PA[r * PAW + c], fp = PA[r * PAW + 512 + c], lbv = lb[c];
            const float sg = sigmoidf_(fp), sgn = sigmoidf_(-fp);
            qs[tid] = q; fs[tid] = lbv + (1.f - lbv) * sg; ks[tid] = (1.f - lbv) * sgn;
        }
        __syncthreads();
        const float vv = PA[r * PAW + 1024 + h * 128 + v];
        float part = 0.f;
#pragma unroll
        for (int j = 0; j < 32; ++j) { const int kk = kq * 32 + j; S[j] = fmaf(fs[kk], S[j], ks[kk] * vv); part = fmaf(qs[kk], S[j], part); }
        op[kq][v] = part;
        __syncthreads();
        if (tid < 128) P->OA[r * HW + h * 128 + v] = (op[0][v] + op[1][v]) + (op[2][v] + op[3][v]);
    }
    __syncthreads();
}
__device__ __forceinline__ void ph_hgrn_out(KP P, char* lds, int layer) {
    float* red = (float*)lds;
    const int tid = tid_(), h = tid >> 7, k = tid & 127;
    const float* nw = P->hnw + layer * 128;
    for (int r = bid_(); r < TOK; r += gridDim.x) {
        const float o = P->OA[(size_t)r * HW + tid];
        float ss = o * o;
#pragma unroll
        for (int off = 32; off > 0; off >>= 1) ss += __shfl_xor(ss, off);
        __syncthreads();
        if ((tid & 63) == 0) red[tid >> 6] = ss;
        __syncthreads();
        ss = red[h * 2] + red[h * 2 + 1];
        const float g = P->PA[(size_t)r * PAW + 1536 + tid];
        const float y = o * rsqrtf(ss * (1.f / 128.f) + EPS) * nw[k] * (g * sigmoidf_(g));
        P->MIX[(size_t)r * DM + tid] = f2bf(y);
    }
}
__device__ __forceinline__ void ph_s5(KP P, char* lds, int layer, int unit8) {
    const int tid = tid_(), w = tid >> 6, p = tid & 63, unit = unit8 * 8 + w;
    float* base = (float*)lds + w * (256 + 4 * 1024);
    float (*us)[16] = (float (*)[16])base; float (*xr)[64] = (float (*)[64])(base + 256); float (*xi)[64] = (float (*)[64])(base + 256 + 1024);
    float (*cre)[64] = (float (*)[64])(base + 256 + 2048); float (*cim)[64] = (float (*)[64])(base + 256 + 3072);
    const int b = unit >> 5, g = unit & 31;
    const float* a_re = P->a_re + layer * 2048; const float* a_im = P->a_im + layer * 2048;
    const float* b_re = P->b_re + layer * 32768; const float* b_im = P->b_im + layer * 32768;
    const float* c_re = P->c_re + layer * 32768; const float* c_im = P->c_im + layer * 32768;
    const float* dsk = P->s5d + layer * 512;
    const float dt = expf(P->log_dt[layer * 32 + g]), are = a_re[g * 64 + p], aim = a_im[g * 64 + p];
    const float mag = expf(are * dt), abr = mag * cosf(aim * dt), abi = mag * sinf(aim * dt);
    const float den = are * are + aim * aim;
    const float zr = ((abr - 1.f) * are + abi * aim) / den, zi = (abi * are - (abr - 1.f) * aim) / den;
    float bbr[16], bbi[16];
#pragma unroll
    for (int c = 0; c < 16; ++c) {
        const float br = b_re[(g * 64 + p) * 16 + c], bi = b_im[(g * 64 + p) * 16 + c];
        bbr[c] = zr * br - zi * bi; bbi[c] = zr * bi + zi * br;
        cre[0][p * 16 + c] = c_re[(g * 16 + c) * 64 + p]; cim[0][p * 16 + c] = c_im[(g * 16 + c) * 64 + p];
    }
    float x_r = 0.f, x_i = 0.f;
    for (int t0 = 0; t0 < LL; t0 += 16) {
#pragma unroll
        for (int j = 0; j < 4; ++j) { const int idx = p + 64 * j, tl = idx >> 4, c = idx & 15;
            us[tl][c] = P->PA[((size_t)b * LL + t0 + tl) * PAW + 2048 + g * 16 + c]; }
        __syncthreads();
#pragma unroll 1
        for (int tl = 0; tl < 16; ++tl) {
            float bur = 0.f, bui = 0.f;
#pragma unroll
            for (int c = 0; c < 16; ++c) { const float u = us[tl][c]; bur = fmaf(bbr[c], u, bur); bui = fmaf(bbi[c], u, bui); }
            const float nr = abr * x_r - abi * x_i + bur, ni = abr * x_i + abi * x_r + bui;
            x_r = nr; x_i = ni; xr[tl][p] = nr; xi[tl][p] = ni;
        }
        __syncthreads();
#pragma unroll
        for (int j = 0; j < 4; ++j) { const int idx = p + 64 * j, tl = idx >> 4, c = idx & 15;
            float y = 0.f;
#pragma unroll 4
            for (int q = 0; q < 64; ++q) y += cre[0][q * 16 + c] * xr[tl][q] - cim[0][q * 16 + c] * xi[tl][q];
            y += dsk[g * 16 + c] * us[tl][c];
            P->YG[((size_t)b * LL + t0 + tl) * 512 + g * 16 + c] = f2bf(gelu_tanh(y)); }
        __syncthreads();
    }
}
__device__ __forceinline__ void ph_glu_out(KP P) {
    const int tid = tid_();
    for (int r = bid_(); r < TOK; r += gridDim.x) {
        const float val = P->T[(size_t)r * 1024 + tid], gate = P->T[(size_t)r * 1024 + 512 + tid];
        P->MIX[(size_t)r * DM + 512 + tid] = f2bf(val * sigmoidf_(gate));
    }
}
__device__ __forceinline__ void ph_softmax(KP P, char* lds) {
    float* red = (float*)lds;
    const int tid = tid_();
    for (int u = bid_(); u < 32 * LL; u += gridDim.x) {
        float* row = P->S + (size_t)u * LL;
        float m = -INFINITY;
        for (int n = tid; n < LL; n += NTHR) m = fmaxf(m, row[n]);
        m = block_max(m, red);
        float s = 0.f;
        for (int n = tid; n < LL; n += NTHR) s += expf(row[n] - m);
        s = block_sum(s, red + 8);
        const float inv = 1.f / s;
        for (int n = tid; n < LL; n += NTHR) row[n] = expf(row[n] - m) * inv;
    }
}
__device__ __forceinline__ void ph_attn_out(KP P, char* lds, int layer) {
    float* red = (float*)lds;
    const int tid = tid_(), hh = tid >> 8, n = tid & 255;
    const float* sw = P->subln + layer * 256;
    const float scale = 1.f - (0.8f - 0.6f * expf(-0.3f * (float)layer));
    const float lam = P->lam[layer];
    for (int u = bid_(); u < TOK * 2; u += gridDim.x) {
        const int r = u >> 1, h = (u & 1) * 2 + hh;
        const float o = P->OC[(size_t)r * DM + h * 512 + n] - lam * P->OC[(size_t)r * DM + h * 512 + 256 + n];
        float ss = o * o;
#pragma unroll
        for (int off = 32; off > 0; off >>= 1) ss += __shfl_xor(ss, off);
        __syncthreads();
        if ((tid & 63) == 0) red[tid >> 6] = ss;
        __syncthreads();
        ss = (red[hh * 4] + red[hh * 4 + 1]) + (red[hh * 4 + 2] + red[hh * 4 + 3]);
        P->MIX[(size_t)r * DM + 1024 + h * 256 + n] = f2bf(o * rsqrtf(ss * (1.f / 256.f) + EPS) * sw[n] * scale);
    }
}
__device__ __forceinline__ void ph_norm_router(KP P, char* lds, int layer) {
    float (*hs)[DM] = (float (*)[DM])lds;
    float (*lg)[72] = (float (*)[72])(lds + 4 * DM * 4);
    float* red = (float*)(lds + 4 * DM * 4 + 4 * 72 * 4);
    const int tid = tid_();
    const float* w = P->ln2_w + layer * DM; const float* wrg = P->wrg + (size_t)layer * DM * 8; const float* brg = P->brg + layer * 8;
    const float* wre = P->wre + (size_t)layer * DM * 64; const float* bre = P->bre + layer * 64;
    for (int u = bid_(); u < TOK / 4; u += gridDim.x) {
        const int t0 = u * 4;
        for (int tk = 0; tk < 4; ++tk) {
            const float4 v = ((const float4*)(P->Z + (size_t)(t0 + tk) * DM))[tid];
            const float ss = block_sum(v.x * v.x + v.y * v.y + v.z * v.z + v.w * v.w, red);
            const float rs = rsqrtf(ss * (1.f / DM) + EPS);
            const float4 ww = ((const float4*)w)[tid];
            const float y0 = v.x * rs * ww.x, y1 = v.y * rs * ww.y, y2 = v.z * rs * ww.z, y3 = v.w * rs * ww.w;
            hs[tk][tid * 4] = y0; hs[tk][tid * 4 + 1] = y1; hs[tk][tid * 4 + 2] = y2; hs[tk][tid * 4 + 3] = y3;
            bf16_t* o = P->HN + (size_t)(t0 + tk) * DM + tid * 4;
            o[0] = f2bf(y0); o[1] = f2bf(y1); o[2] = f2bf(y2); o[3] = f2bf(y3);
        }
        __syncthreads();
        if (tid < 288) {
            const int tk = tid / 72, j = tid % 72;
            float acc = 0.f;
            if (j < 8) { for (int k = 0; k < DM; ++k) acc = fmaf(hs[tk][k], wrg[k * 8 + j], acc); acc += brg[j]; }
            else { for (int k = 0; k < DM; ++k) acc = fmaf(hs[tk][k], wre[k * 64 + (j - 8)], acc); acc += bre[j - 8]; }
            lg[tk][j] = acc;
        }
        __syncthreads();
        if (tid < 4) {
            const int t = t0 + tid;
            int gs = 0; float gm = lg[tid][0];
            for (int j = 1; j < 8; ++j) if (lg[tid][j] > gm) { gm = lg[tid][j]; gs = j; }
            float den = 0.f; for (int j = 0; j < 8; ++j) den += expf(lg[tid][j] - gm);
            const float pg = 1.f / den;
            const float* el = &lg[tid][8 + gs * 8];
            int j0 = 0; float v0 = el[0];
            for (int j = 1; j < 8; ++j) if (el[j] > v0) { v0 = el[j]; j0 = j; }
            int j1 = -1; float v1 = -INFINITY;
            for (int j = 0; j < 8; ++j) if (j != j0 && el[j] > v1) { v1 = el[j]; j1 = j; }
            const float e1 = expf(v1 - v0), g0 = pg / (1.f + e1), g1 = pg * e1 / (1.f + e1);
            const int x0 = gs * 8 + j0, x1 = gs * 8 + j1;
            P->ridx[t * 2] = x0; P->ridx[t * 2 + 1] = x1; P->rgate[t * 2] = g0; P->rgate[t * 2 + 1] = g1;
            P->rslot[t * 2] = atomicAdd(&P->cnt[x0], 1); P->rslot[t * 2 + 1] = atomicAdd(&P->cnt[x1], 1);
        }
        __syncthreads();
    }
}
__device__ __forceinline__ void ph_dispatch(KP P, char* lds) {
    int* base = (int*)lds;
    const int tid = tid_();
    if (tid == 0) {
        int off = 0; const bool wr = bid_() == 0;
        for (int e = 0; e < NE; ++e) { base[e] = off; if (wr) P->base[e] = off; off += P->cnt[e]; }
    }
    __syncthreads();
    for (int i = bid_() * NTHR + tid; i < NASSIGN; i += gridDim.x * NTHR) {
        const int row = base[P->ridx[i]] + P->rslot[i];
        P->rowtok[row] = i >> 1; P->tokrow[i] = row;
    }
    __syncthreads();
}
__device__ __forceinline__ void ph_combine_norm(KP P, char* lds, int layer) {
    float* red = (float*)lds;
    const int tid = tid_();
    for (int t = bid_(); t < TOK; t += gridDim.x) {
        const int r0 = P->tokrow[t * 2], r1 = P->tokrow[t * 2 + 1]; const float g0 = P->rgate[t * 2], g1 = P->rgate[t * 2 + 1];
        float4 v = ((const float4*)(P->Z + (size_t)t * DM))[tid];
        const bf16_t* y0 = P->Y + (size_t)r0 * DM + tid * 4; const bf16_t* y1 = P->Y + (size_t)r1 * DM + tid * 4;
        v.x += g0 * bf2f(y0[0]) + g1 * bf2f(y1[0]); v.y += g0 * bf2f(y0[1]) + g1 * bf2f(y1[1]);
        v.z += g0 * bf2f(y0[2]) + g1 * bf2f(y1[2]); v.w += g0 * bf2f(y0[3]) + g1 * bf2f(y1[3]);
        const float ss = block_sum(v.x * v.x + v.y * v.y + v.z * v.z + v.w * v.w, red);
        const float rs = rsqrtf(ss * (1.f / DM) + EPS);
        if (layer == 0) {
            ((float4*)(P->Z + (size_t)t * DM))[tid] = v;
            const float4 w = ((const float4*)(P->ln1_w + DM))[tid];
            bf16_t* o = P->HN + (size_t)t * DM + tid * 4;
            o[0] = f2bf(v.x * rs * w.x); o[1] = f2bf(v.y * rs * w.y); o[2] = f2bf(v.z * rs * w.z); o[3] = f2bf(v.w * rs * w.w);
        } else {
            const int b = t / LL, tt = t % LL;
            if (tt >= NMETA) { const float4 w = ((const float4*)P->fnw)[tid];
                ((float4*)(P->out + ((size_t)b * SEQ + (tt - NMETA)) * DM))[tid] = make_float4(v.x * rs * w.x, v.y * rs * w.y, v.z * rs * w.z, v.w * rs * w.w); }
        }
    }
}

__global__ void __launch_bounds__(NTHR, 2) mega_fwd(Params P_arg) {
    extern __shared__ __attribute__((aligned(16))) char lds[];
    const int tid = tid_(), G = gridDim.x;
    volatile LAS unsigned* ctlw = (volatile LAS unsigned*)((LAS char*)lds + LDS_CTL);
    if (tid < 64) ctlw[tid] = 0u;
    __syncthreads();
    KP P = kp_();
    XcdBarrier bar = xcd_barrier_post(P->bar, ctlw + 8);
#define GRID_BAR() do { xcd_barrier(bar); P = kp_(); } while (0)

    ph_build_norm(P, lds);
    ph_prep(P);
    __syncthreads();
    ph_weights(P, lds);
    __syncthreads();
    for (int un = bid_(); un < 64; un += G) s5::prep_unit(P, lds, un >> 5, un & 31);
    GRID_BAR();
#pragma unroll
    for (int layer = 0; layer < 2; ++layer) {
        { pg8::Gemm g{P->HN, P->WinT + (size_t)layer * INW * DM, MP, INW, DM}; pg8::StaticOrder S; S.init(MP, INW, G, bid_()); pg8::EpiInProj E{P->PA, P->QKV};
          pg8::gemm_phase<pg8::EpiInProj, pg8::StaticOrder, true, true>((LAS unsigned char*)lds, g, S, E); }
        { const int t2 = tid_(), b2 = bid_(); if (b2 == 0 && t2 < NE) P->cnt[t2] = 0;
 }
        GRID_BAR();
        hg::local_states(P, lds, layer);
        s5::local_states(P, layer);
        __syncthreads();
        ph_attention(P, lds);
        GRID_BAR();
        s5::scan_states(P, layer);
        hg::scan_states(P);
        GRID_BAR();
        s5::outputs(P, layer);
        __syncthreads();
        ph_attn_out(P, lds, layer);
        __syncthreads();
        hg::outputs(P, lds, layer);
        GRID_BAR();
        { pg8::Gemm g{P->YG, P->WgluT + (size_t)layer * 1024 * 512, MP, 1024, 512}; pg8::StaticOrder S; S.init(MP, 1024, G, bid_()); pg8::EpiGlu E{P->MIX, P->b_glu + layer * 1024};
          pg8::gemm_phase<pg8::EpiGlu, pg8::StaticOrder, true, true>((LAS unsigned char*)lds, g, S, E); }
        GRID_BAR();
        { pg8::Gemm g{P->MIX, P->WoutT + (size_t)layer * DM * DM, MP, DM, DM}; pg8::StaticOrder S; S.init(MP, DM, G, bid_()); pg8::EpiResidual E{P->Z};
          pg8::gemm_phase<pg8::EpiResidual, pg8::StaticOrder, true, true>((LAS unsigned char*)lds, g, S, E); }
        GRID_BAR();
        ph_norm_router(P, lds, layer);
        GRID_BAR();
        ph_dispatch(P, lds);
        GRID_BAR();
        moe::stream_gemm<true>(P, lds, layer);
        GRID_BAR();
        moe::stream_gemm<false>(P, lds, layer);
        GRID_BAR();
        ph_combine_norm(P, lds, layer);
        if (layer == 0) GRID_BAR();
    }
}
}

extern "C" void kernel_launch(void* const* d_in, const int* in_sizes, int n_in, void* d_out, int out_size, void* d_ws, size_t ws_size, hipStream_t stream) {
    static int grid = 0;
    if (grid == 0) {
        int dev = 0, cus = 0;
        if (hipGetDevice(&dev) != hipSuccess || hipDeviceGetAttribute(&cus, hipDeviceAttributeMultiprocessorCount, dev) != hipSuccess) { grid = -1; return; }
        if (hipFuncSetAttribute((const void*)mega_fwd, hipFuncAttributeMaxDynamicSharedMemorySize, LDS_BYTES) != hipSuccess) { grid = -1; return; }
        int per_cu = 0;
        if (hipOccupancyMaxActiveBlocksPerMultiprocessor(&per_cu, (const void*)mega_fwd, NTHR, LDS_BYTES) != hipSuccess || per_cu < 1) { (void)hipGetLastError(); }
        grid = cus;
    }
    if (grid < 0) return;
    Params p{};
    const float** pin = (const float**)&p;
    for (int i = 0; i < 31; ++i) pin[i] = (const float*)d_in[i];
    p.out = (float*)d_out;
    char* ws = (char*)d_ws; size_t off = 0;
    auto alloc = [&](size_t bytes) { char* q = ws + off; off += (bytes + 255) & ~(size_t)255; return q; };
    p.bar = (unsigned*)alloc(XCD_BAR_WORDS * 4);
    p.cnt = (int*)alloc(256); p.blk_e = (int*)alloc(1024); p.base = (int*)alloc(256);
    p.lbtab = (float*)alloc(1024 * 4); p.lam = (float*)alloc(256);
    p.Z = (float*)alloc((size_t)MP * DM * 4);
    p.HN = (bf16_t*)alloc((size_t)MP * DM * 2);
    p.PA = (float*)alloc((size_t)MP * PAW * 4);
    p.QKV = (bf16_t*)alloc((size_t)MP * QKVW * 2);
    p.OA = (float*)alloc((size_t)MP * HW * 4);
    p.A16 = (float*)alloc(2 * 32 * 64 * 8); p.S5E = (float*)alloc((size_t)516 * 32 * 128 * 4); p.S5X = (float*)alloc((size_t)516 * 32 * 128 * 4);
    p.BtY = (bf16_t*)alloc((size_t)2 * 32 * 256 * 384 * 2); p.BtE = (bf16_t*)alloc((size_t)2 * 32 * 128 * 256 * 2);
    p.SLOC = (float*)alloc((size_t)528 * 16384 * 4); p.DEC = (float*)alloc((size_t)528 * 128 * 4); p.SPREV = (bf16_t*)alloc((size_t)529 * 16384 * 2);
    p.YG = (bf16_t*)alloc((size_t)MP * 512 * 2);
    p.T = (float*)alloc((size_t)MP * 1024 * 4);
    p.MIX = (bf16_t*)alloc((size_t)MP * DM * 2);
    p.OC = (float*)alloc((size_t)MP * DM * 4);
    p.ridx = (int*)alloc((size_t)NASSIGN * 4); p.rgate = (float*)alloc((size_t)NASSIGN * 4); p.rslot = (int*)alloc((size_t)NASSIGN * 4);
    p.tokrow = (int*)alloc((size_t)NASSIGN * 4); p.rowtok = (int*)alloc((size_t)NRMAX * 4);
    p.H1 = (float*)alloc((size_t)NRMAX * DE * 4);
    p.H = (bf16_t*)alloc((size_t)NRMAX * DE * 2);
    p.Y = (bf16_t*)alloc((size_t)NRMAX * DM * 2);
    p.S = (float*)alloc((size_t)32 * LL * LL * 4);
    p.WinT = (bf16_t*)alloc((size_t)2 * INW * DM * 2); p.WoutT = (bf16_t*)alloc((size_t)2 * DM * DM * 2); p.WgluT = (bf16_t*)alloc((size_t)2 * 1024 * 512 * 2);
    if (off > ws_size) return;
    if (hipMemsetAsync(p.bar, 0, XCD_BAR_WORDS * 4, stream) != hipSuccess) return;
    hipLaunchKernelGGL(mega_fwd, dim3(grid), dim3(NTHR), LDS_BYTES, stream, p);
}
```

```cpp
#include <hip/hip_runtime.h>
#include <stdint.h>
#include <math.h>

namespace {
typedef unsigned short bf16_t;
constexpr int DM = 2048, NB = 4, SEQ = 2048, NMETA = 16, LL = SEQ + NMETA, TOK = NB * LL, MP = 8448;
constexpr int HW = 512;
constexpr int INW = 5632, PAW = 2560, QKVW = 3072;
constexpr int NE = 64, DE = 512, NASSIGN = TOK * 2;
constexpr int RB = 128;
constexpr int NRMAX = NASSIGN + NE * RB;
constexpr float EPS = 1e-6f;
constexpr int NTHR = 512;
constexpr int LDS_BYTES = 147456;
constexpr int LDS_CTL = 143360;

__device__ __forceinline__ float bf2f(bf16_t h) { return __uint_as_float(((unsigned)h) << 16); }
__device__ __forceinline__ bf16_t f2bf(float f) { unsigned u = __float_as_uint(f); return (bf16_t)((u + 0x7fffu + ((u >> 16) & 1u)) >> 16); }
__device__ __forceinline__ float sigmoidf_(float x) { return 1.f / (1.f + expf(-x)); }
__device__ __forceinline__ int tid_() { int t = threadIdx.x; asm volatile("" : "+v"(t)); return t; }
__device__ __forceinline__ int bid_() { int b = blockIdx.x; asm volatile("" : "+s"(b)); return b; }

#define XB_TMO      128
#define XB_XCNT(j)  (256  + 64 * (j))
#define XB_XSUB(j)  (1280 + 64 * (j))
#define XB_XGEN(j)  (2304 + 64 * (j))
#define XB_TOP      3328
#define XB_TOPGEN   3392
#define XCD_BAR_WORDS 3456
#define XB_SPIN_CAP (1u << 24)
#define LAS __attribute__((address_space(3)))
__device__ __forceinline__ unsigned xb_ld(unsigned* p)              { return __hip_atomic_load(p, __ATOMIC_RELAXED, __HIP_MEMORY_SCOPE_AGENT); }
__device__ __forceinline__ unsigned xb_add(unsigned* p, unsigned v) { return __hip_atomic_fetch_add(p, v, __ATOMIC_RELAXED, __HIP_MEMORY_SCOPE_AGENT); }
__device__ __forceinline__ unsigned xb_xcc_id() { return (unsigned)__builtin_amdgcn_s_getreg((3 << 11) | 20) & 0xFu; }
#define XB_SPIN(cond, bar) do { unsigned _sp = 0; while (cond) { __builtin_amdgcn_s_sleep(1); \
    if ((++_sp & 255u) == 0u) { if (xb_ld(&(bar)[XB_TMO])) break; if (_sp > XB_SPIN_CAP) { atomicAdd(&(bar)[XB_TMO], 1u); break; } } } } while (0)
struct XcdBarrier { unsigned* bar; unsigned x; volatile LAS unsigned* st; };
__device__ __forceinline__ XcdBarrier xcd_barrier_post(unsigned* bar, volatile LAS unsigned* st) {
    XcdBarrier b; b.bar = bar; b.x = xb_xcc_id(); b.st = st;
    if (threadIdx.x == 0) (void)xb_add(&bar[XB_XCNT(b.x)], 1u);
    return b;
}
__device__ __forceinline__ void xcd_barrier_complete(unsigned* bar, unsigned x, unsigned& nloc, unsigned& nx) {
    const unsigned G = gridDim.x * gridDim.y * gridDim.z;
    unsigned sum, cnt, mine, sp = 0u;
    for (;;) {
        sum = 0u; cnt = 0u; mine = 0u;
#pragma unroll
        for (unsigned j = 0; j < 16; ++j) { const unsigned c = xb_ld(&bar[XB_XCNT(j)]); sum += c; cnt += (c > 0u) ? 1u : 0u; mine = (j == x) ? c : mine; }
        if (sum == G) break;
        __builtin_amdgcn_s_sleep(1);
        if ((++sp & 255u) == 0u) { if (xb_ld(&bar[XB_TMO])) break; if (sp > XB_SPIN_CAP) { atomicAdd(&bar[XB_TMO], 1u); break; } }
    }
    nloc = mine > 0u ? mine : 1u; nx = cnt > 0u ? cnt : 1u;
}
__device__ __forceinline__ void xcd_barrier(const XcdBarrier& b) {
    asm volatile("s_waitcnt vmcnt(0)" ::: "memory");
    __syncthreads();
    if (threadIdx.x == 0) {
        unsigned* bar = b.bar;
        const unsigned bx_ = xb_xcc_id();
        __builtin_amdgcn_s_waitcnt(0);
        unsigned nloc = b.st[0], nx = b.st[1];
        if (nloc == 0u) { xcd_barrier_complete(bar, bx_, nloc, nx); b.st[0] = nloc; b.st[1] = nx; }
        const unsigned old = xb_add(&bar[XB_XSUB(bx_)], 1u);
        const unsigned gen = old / nloc;
        if (old + 1u == (gen + 1u) * nloc) {
            __builtin_amdgcn_fence(__ATOMIC_RELEASE, "agent");
            asm volatile("s_waitcnt vmcnt(0)" ::: "memory");
            const unsigned og = xb_add(&bar[XB_TOP], 1u);
            const unsigned tg = og / nx;
            if (og + 1u == (tg + 1u) * nx) xb_add(&bar[XB_TOPGEN], 1u);
            else XB_SPIN(xb_ld(&bar[XB_TOPGEN]) == tg, bar);
            __builtin_amdgcn_fence(__ATOMIC_ACQUIRE, "agent");
            xb_add(&bar[XB_XGEN(bx_)], 1u);
            asm volatile("s_waitcnt vmcnt(0)" ::: "memory");
        } else {
            XB_SPIN(xb_ld(&bar[XB_XGEN(bx_)]) == gen, bar);
            __builtin_amdgcn_fence(__ATOMIC_ACQUIRE, "agent");
            asm volatile("s_waitcnt vmcnt(0)" ::: "memory");
        }
    }
    __syncthreads();
}

struct Params {
    const float *x, *meta, *ln1_w, *w_in, *lbnd, *hnw, *a_re, *a_im, *b_re, *b_im, *c_re, *c_im, *s5d, *log_dt, *w_glu, *b_glu,
                *lq1, *lk1, *lq2, *lk2, *subln, *w_out, *ln2_w, *wrg, *brg, *wre, *bre, *w1, *w3, *w2, *fnw;
    float* out;
    unsigned* bar;
    int *cnt, *blk_e, *ridx, *rslot, *tokrow, *rowtok, *base;
    float *lbtab, *lam, *Z, *PA, *OA, *T, *OC, *rgate, *H1, *S, *SLOC, *DEC, *A16, *S5E, *S5X, *ZP;
    bf16_t *HN, *QKV, *YG, *MIX, *H, *Y, *WinT, *WoutT, *WgluT, *SPREV, *BtY, *BtE, *WRT;
};
typedef const __attribute__((address_space(4))) Params* KP;
__device__ __forceinline__ KP kp_() { KP p = (KP)__builtin_amdgcn_kernarg_segment_ptr(); asm volatile("" : "+s"(p)); return p; }


namespace pg8 {
#define PG8_LAS __attribute__((address_space(3)))
typedef short bf16x8 __attribute__((ext_vector_type(8)));
typedef float f32x4 __attribute__((ext_vector_type(4)));
typedef unsigned u32x4 __attribute__((ext_vector_type(4)));
constexpr int BM = 256, BK = 64, HALF = 128, HTB = HALF * BK * 2, STAGE_BYTES = 8 * HTB, NXCD = 8, WGM = 8;
__host__ __device__ __forceinline__ int lds_byte(int r, int c) { const int st = (r >> 4) * 2 + (c >> 5), rr = r & 15, cc = c & 31, ob = rr * 64 + cc * 2; return st * 1024 + (ob ^ (((ob >> 9) & 1) << 5)); }
__host__ __device__ __forceinline__ void stage_rc(int b, int& R, int& C) { const int st = b / 1024, sb = b % 1024, swz = sb ^ (((sb >> 9) & 1) << 5); R = (st >> 1) * 16 + swz / 64; C = (st & 1) * 32 + (swz % 64) / 2; }
__host__ __device__ __forceinline__ int perm32(int rho) { const int n = rho >> 4, i = rho & 15; return 8 * (i >> 2) + 4 * n + (i & 3); }
struct Unit { int pm, pn, ko, nt; };
struct Gemm { const bf16_t* A; const bf16_t* Bt; int M, N, K, ld; };
struct StaticOrder {
    static constexpr bool PER_UNIT_K = false;
    int nM, nN, nwg, G, c, nt;
    __host__ __device__ void init(int M, int N, int G_, int c_, int nt_) { nM = M / BM; nN = N / BM; nwg = nM * nN; G = G_; c = c_; nt = nt_; }
    __host__ __device__ bool next(int i, Unit& u) const {
        const long L = (long)i * G + c; if (L >= nwg) return false;
        int wgid = (int)L; { const int q = nwg / NXCD, r = nwg % NXCD, xcd = wgid % NXCD, off = wgid / NXCD; wgid = (xcd < r ? xcd * (q + 1) : r * (q + 1) + (xcd - r) * q) + off; }
        const int nig = WGM * nN, gid = wgid / nig, fm = gid * WGM, gsz = (nM - fm) < WGM ? (nM - fm) : WGM;
        u.pm = fm + ((wgid % nig) % gsz); u.pn = (wgid % nig) / gsz; u.ko = 0; u.nt = nt; return true;
    }
    __device__ __forceinline__ void a_ready(const Unit&) const {}
    __device__ __forceinline__ void done(const Unit&) const {}
};
__device__ __forceinline__ unsigned cvt_pk_bf16(float lo, float hi) { unsigned r; asm volatile("v_cvt_pk_bf16_f32 %0, %1, %2" : "=v"(r) : "v"(lo), "v"(hi)); return r; }

template <class Epi, class Sched, bool ALIGN_EPI = false, bool SP2 = false>
__device__ __forceinline__ void gemm_phase(PG8_LAS unsigned char* lds, const Gemm g, const Sched& S, const Epi& E) {
    const int tid = tid_(), wid = __builtin_amdgcn_readfirstlane(tid >> 6), lane = tid & 63, wr = wid >> 2, wc = wid & 3, fr = lane & 15, fq = lane >> 4;
    const int K = g.ld;
    unsigned voffA[2], voffB[2];
#pragma unroll
    for (int i = 0; i < 2; ++i) { int R, C; stage_rc(tid * 16 + i * 8192, R, C); const int Rb = Epi::PERM ? ((R & ~31) + perm32(R & 31)) : R;
        voffA[i] = (unsigned)(R * K + C) * 2u; voffB[i] = (unsigned)(Rb * K + C) * 2u; }
    const size_t kstep = (size_t)(BK * 2);
    const size_t hstep = (size_t)HALF * K * 2;
    const size_t tstep = 2 * hstep;
    const unsigned ldsw = (unsigned)wid * 1024u;
    const int aoff = lds_byte(wr * 64 + fr, fq * 8), boff = lds_byte(wc * 32 + fr, fq * 8);
#define PG8_SA(b, h) (((b) * 2 + (h)) * HTB)
#define PG8_SB(b, h) ((4 + (b) * 2 + (h)) * HTB)
#define PG8_STAGE(bufoff, gbase, voff) do { _Pragma("unroll") for (int _i = 0; _i < 2; ++_i) \
        __builtin_amdgcn_global_load_lds((const unsigned*)((const char*)(gbase) + (voff)[_i]), (PG8_LAS unsigned*)(lds + (bufoff) + ldsw + _i * 8192), 16, 0, 0); } while (0)
#define PG8_LDA(dst, b, h) do { _Pragma("unroll") for (int m = 0; m < 4; ++m) _Pragma("unroll") for (int k = 0; k < 2; ++k) dst[m][k] = *(const PG8_LAS bf16x8*)(lds + PG8_SA(b, h) + aoff + m * 2048 + k * 1024); } while (0)
#define PG8_LDB(dst, b, h) do { _Pragma("unroll") for (int n = 0; n < 2; ++n) _Pragma("unroll") for (int k = 0; k < 2; ++k) dst[n][k] = *(const PG8_LAS bf16x8*)(lds + PG8_SB(b, h) + boff + n * 2048 + k * 1024); } while (0)
#define PG8_MMA(ai, bj, At, Bt) do { __builtin_amdgcn_s_setprio(1); _Pragma("unroll") for (int m = 0; m < 4; ++m) _Pragma("unroll") for (int n = 0; n < 2; ++n) _Pragma("unroll") for (int k = 0; k < 2; ++k) \
        acc[ai][bj][m][n] = __builtin_amdgcn_mfma_f32_16x16x32_bf16(Bt[n][k], At[m][k], acc[ai][bj][m][n], 0, 0, 0); __builtin_amdgcn_s_setprio(0); } while (0)
#define PG8_WAIT_V(n) asm volatile("s_waitcnt vmcnt(" #n ")" ::: "memory")
#define PG8_WAIT_L(n) asm volatile("s_waitcnt lgkmcnt(" #n ")" ::: "memory")
#define PG8_BAR __builtin_amdgcn_s_barrier()
#define PG8_SCHED __builtin_amdgcn_sched_barrier(0)
    Unit cur, nxt; int ui = 0;
    if (!S.next(0, cur)) return;
    f32x4 acc[2][2][4][2];
#pragma unroll
    for (int a = 0; a < 2; ++a)
#pragma unroll
        for (int b = 0; b < 2; ++b)
#pragma unroll
            for (int m = 0; m < 4; ++m)
#pragma unroll
                for (int n = 0; n < 2; ++n) acc[a][b][m][n] = (f32x4){0.f, 0.f, 0.f, 0.f};
    bf16x8 At[4][2], B0[2][2], B1[2][2];
    const char* cA = (const char*)g.A + (size_t)cur.pm * tstep + (size_t)cur.ko * 2; const char* cB = (const char*)g.Bt + (size_t)cur.pn * tstep + (size_t)cur.ko * 2;
    S.a_ready(cur);
    if constexpr (SP2) {
        PG8_STAGE(PG8_SB(0, 0), cB, voffB); PG8_STAGE(PG8_SB(0, 1), cB + hstep, voffB); PG8_STAGE(PG8_SA(0, 0), cA, voffA); PG8_STAGE(PG8_SA(0, 1), cA + hstep, voffA);
        if (wr == 1) PG8_BAR;
        PG8_WAIT_V(2); PG8_BAR;
        PG8_STAGE(PG8_SB(1, 0), cB + kstep, voffB); PG8_STAGE(PG8_SA(1, 0), cA + kstep, voffA); PG8_STAGE(PG8_SB(1, 1), cB + hstep + kstep, voffB);
        PG8_WAIT_V(6); PG8_BAR;
    } else {
        PG8_STAGE(PG8_SB(0, 0), cB, voffB); PG8_STAGE(PG8_SA(0, 0), cA, voffA); PG8_STAGE(PG8_SB(0, 1), cB + hstep, voffB); PG8_STAGE(PG8_SA(0, 1), cA + hstep, voffA);
        if (wr == 1) PG8_BAR;
        PG8_WAIT_V(4); PG8_BAR;
        PG8_STAGE(PG8_SB(1, 0), cB + kstep, voffB); PG8_STAGE(PG8_SA(1, 0), cA + kstep, voffA); PG8_STAGE(PG8_SB(1, 1), cB + hstep + kstep, voffB);
        PG8_WAIT_V(6); PG8_BAR;
    }
    for (;;) {
        const bool has_next = S.next(ui + 1, nxt);
        const char* nA = has_next ? (const char*)g.A + (size_t)nxt.pm * tstep + (size_t)nxt.ko * 2 : cA; const char* nB = has_next ? (const char*)g.Bt + (size_t)nxt.pn * tstep + (size_t)nxt.ko * 2 : cB;
        const int nt = Sched::PER_UNIT_K ? cur.nt : g.K / BK;
        for (int t = 0; t < nt; t += 2) {
            const bool last = (t == nt - 2);
            const char* a1 = cA + (size_t)(t + 1) * kstep;
            const char* a2 = last ? nA : cA + (size_t)(t + 2) * kstep; const char* b2 = last ? nB : cB + (size_t)(t + 2) * kstep;
            const char* a3 = a2 + kstep; const char* b3 = b2 + kstep;
            if (last && has_next) S.a_ready(nxt);
            if constexpr (SP2) {
            PG8_LDB(B0, 0, 0); PG8_LDB(B1, 0, 1); PG8_SCHED; PG8_LDA(At, 0, 0); PG8_STAGE(PG8_SA(1, 1), a1 + hstep, voffA);
            PG8_WAIT_V(8); PG8_WAIT_L(0); PG8_BAR; PG8_MMA(0, 0, At, B0); PG8_MMA(0, 1, At, B1); PG8_BAR; PG8_SCHED;
            PG8_LDA(At, 0, 1); PG8_STAGE(PG8_SB(0, 0), b2, voffB); PG8_STAGE(PG8_SB(0, 1), b2 + hstep, voffB); PG8_STAGE(PG8_SA(0, 0), a2, voffA);
            PG8_WAIT_V(8); PG8_WAIT_L(0); PG8_BAR; PG8_MMA(1, 0, At, B0); PG8_MMA(1, 1, At, B1); PG8_BAR; PG8_SCHED;
            PG8_LDB(B0, 1, 0); PG8_LDB(B1, 1, 1); PG8_SCHED; PG8_LDA(At, 1, 0); PG8_STAGE(PG8_SA(0, 1), a2 + hstep, voffA);
            PG8_WAIT_V(8); PG8_WAIT_L(0); PG8_BAR; PG8_MMA(0, 0, At, B0); PG8_MMA(0, 1, At, B1); PG8_BAR; PG8_SCHED;
            PG8_LDA(At, 1, 1); PG8_STAGE(PG8_SB(1, 0), b3, voffB); PG8_STAGE(PG8_SB(1, 1), b3 + hstep, voffB); PG8_STAGE(PG8_SA(1, 0), a3, voffA);
            PG8_WAIT_V(8); PG8_WAIT_L(0); PG8_BAR; PG8_MMA(1, 0, At, B0); PG8_MMA(1, 1, At, B1); PG8_BAR; PG8_SCHED;
            } else {
            PG8_LDB(B0, 0, 0); PG8_SCHED; PG8_LDA(At, 0, 0); PG8_STAGE(PG8_SA(1, 1), a1 + hstep, voffA);
            PG8_WAIT_L(8); PG8_BAR; PG8_WAIT_L(0); PG8_MMA(0, 0, At, B0); PG8_BAR; PG8_SCHED;
            PG8_LDB(B1, 0, 1); PG8_STAGE(PG8_SB(0, 0), b2, voffB);
            PG8_BAR; PG8_WAIT_L(0); PG8_MMA(0, 1, At, B1); PG8_BAR;
            PG8_LDA(At, 0, 1); PG8_STAGE(PG8_SA(0, 0), a2, voffA);
            PG8_BAR; PG8_WAIT_L(0); PG8_MMA(1, 0, At, B0); PG8_BAR; PG8_SCHED;
            PG8_STAGE(PG8_SB(0, 1), b2 + hstep, voffB);
            PG8_WAIT_V(6); PG8_BAR; PG8_MMA(1, 1, At, B1); PG8_BAR;
            PG8_LDB(B0, 1, 0); PG8_SCHED; PG8_LDA(At, 1, 0); PG8_STAGE(PG8_SA(0, 1), a2 + hstep, voffA);
            PG8_WAIT_L(8); PG8_BAR; PG8_WAIT_L(0); PG8_MMA(0, 0, At, B0); PG8_BAR; PG8_SCHED;
            PG8_LDB(B1, 1, 1); PG8_STAGE(PG8_SB(1, 0), b3, voffB);
            PG8_BAR; PG8_WAIT_L(0); PG8_MMA(0, 1, At, B1); PG8_BAR;
            PG8_LDA(At, 1, 1); PG8_STAGE(PG8_SA(1, 0), a3, voffA);
            PG8_BAR; PG8_WAIT_L(0); PG8_MMA(1, 0, At, B0); PG8_BAR; PG8_SCHED;
            PG8_STAGE(PG8_SB(1, 1), b3 + hstep, voffB);
            PG8_WAIT_V(6); PG8_BAR; PG8_MMA(1, 1, At, B1); PG8_BAR;
            }
        }
        if constexpr (ALIGN_EPI) { if (wr == 0) PG8_BAR; }
        E(acc, cur, wr, wc, fr, fq);
        if (!has_next) break;
#pragma unroll
        for (int a = 0; a < 2; ++a)
#pragma unroll
            for (int b = 0; b < 2; ++b)
#pragma unroll
                for (int m = 0; m < 4; ++m)
#pragma unroll
                    for (int n = 0; n < 2; ++n) acc[a][b][m][n] = (f32x4){0.f, 0.f, 0.f, 0.f};
        cur = nxt; cA = nA; cB = nB; ++ui;
        if constexpr (ALIGN_EPI) { if (wr == 1) PG8_BAR; }
    }
    PG8_WAIT_V(0);
    if constexpr (!ALIGN_EPI) { if (wr == 0) PG8_BAR; }
    PG8_BAR;
#undef PG8_SA
#undef PG8_SB
#undef PG8_STAGE
#undef PG8_LDA
#undef PG8_LDB
#undef PG8_MMA
#undef PG8_WAIT_V
#undef PG8_WAIT_L
#undef PG8_BAR
#undef PG8_SCHED
}
struct EpiInProj {
    static constexpr bool PERM = true;
    float* PA; bf16_t* QKV;
    __device__ __forceinline__ void operator()(const f32x4 (&acc)[2][2][4][2], const Unit& u, int wr, int wc, int fr, int fq) const {
        const int row0 = u.pm * BM + wr * 64 + fr, colt = u.pn * BM + wc * 32 + 8 * fq;
        if (colt < PAW) {
#pragma unroll
            for (int ai = 0; ai < 2; ++ai)
#pragma unroll
                for (int m = 0; m < 4; ++m) { float* rp = PA + (size_t)(row0 + ai * HALF + m * 16) * PAW + colt;
#pragma unroll
                    for (int bj = 0; bj < 2; ++bj) { *(f32x4*)(rp + bj * HALF) = acc[ai][bj][m][0]; *(f32x4*)(rp + bj * HALF + 4) = acc[ai][bj][m][1]; } }
        } else {
#pragma unroll
            for (int ai = 0; ai < 2; ++ai)
#pragma unroll
                for (int m = 0; m < 4; ++m) { bf16_t* rp = QKV + (size_t)(row0 + ai * HALF + m * 16) * QKVW + (colt - PAW);
#pragma unroll
                    for (int bj = 0; bj < 2; ++bj) { const f32x4 v0 = acc[ai][bj][m][0], v1 = acc[ai][bj][m][1];
                        u32x4 w; w.x = cvt_pk_bf16(v0[0], v0[1]); w.y = cvt_pk_bf16(v0[2], v0[3]); w.z = cvt_pk_bf16(v1[0], v1[1]); w.w = cvt_pk_bf16(v1[2], v1[3]);
                        *(u32x4*)(rp + bj * HALF) = w; } }
        }
    }
};
struct EpiResidual {
    static constexpr bool PERM = true;
    float* Z;
    __device__ __forceinline__ void operator()(const f32x4 (&acc)[2][2][4][2], const Unit& u, int wr, int wc, int fr, int fq) const {
        const int row0 = u.pm * BM + wr * 64 + fr, colt = u.pn * BM + wc * 32 + 8 * fq;
#pragma unroll
        for (int ai = 0; ai < 2; ++ai)
#pragma unroll
            for (int m = 0; m < 4; ++m) { const int row = row0 + ai * HALF + m * 16; if (row < TOK) { float* rp = Z + (size_t)row * DM + colt;
#pragma unroll
                for (int bj = 0; bj < 2; ++bj) { f32x4* p0 = (f32x4*)(rp + bj * HALF); f32x4* p1 = (f32x4*)(rp + bj * HALF + 4);
                    const f32x4 z0 = *p0, z1 = *p1; *p0 = z0 + acc[ai][bj][m][0]; *p1 = z1 + acc[ai][bj][m][1]; } } }
    }
};
struct OutOrder {
    static constexpr bool PER_UNIT_K = true;
    StaticOrder main;
    __device__ bool next(int i, Unit& u) const {
        if (main.next(i, u)) return true;
        const int r0 = (main.nwg + main.G - 1) / main.G;
        const int L = (i - r0) * main.G + main.c; if (i < r0 || L >= 64) return false;
        u.pm = 32; u.pn = L & 7; u.ko = (L >> 3) * 256; u.nt = 4; return true; }
    __device__ __forceinline__ void a_ready(const Unit&) const {}
    __device__ __forceinline__ void done(const Unit&) const {}
};
struct EpiOutProj {
    static constexpr bool PERM = true;
    float* Z; float* ZP;
    __device__ __forceinline__ void operator()(const f32x4 (&acc)[2][2][4][2], const Unit& u, int wr, int wc, int fr, int fq) const {
        const bool tail = u.pm == 32;
        const int row0 = (tail ? (u.ko >> 8) * BM : u.pm * BM) + wr * 64 + fr, colt = u.pn * BM + wc * 32 + 8 * fq;
        float* base = tail ? ZP : Z;
#pragma unroll
        for (int ai = 0; ai < 2; ++ai)
#pragma unroll
            for (int m = 0; m < 4; ++m) { float* rp = base + (size_t)(row0 + ai * HALF + m * 16) * DM + colt;
#pragma unroll
                for (int bj = 0; bj < 2; ++bj) { f32x4* p0 = (f32x4*)(rp + bj * HALF); f32x4* p1 = (f32x4*)(rp + bj * HALF + 4);
                    f32x4 z0 = {0.f, 0.f, 0.f, 0.f}, z1 = {0.f, 0.f, 0.f, 0.f};
                    if (!tail) { z0 = *p0; z1 = *p1; }
                    *p0 = z0 + acc[ai][bj][m][0]; *p1 = z1 + acc[ai][bj][m][1]; } }
    }
};
struct EpiGlu {
    static constexpr bool PERM = true;
    bf16_t* MIX; const float* bias;
    __device__ __forceinline__ void operator()(const f32x4 (&acc)[2][2][4][2], const Unit& u, int wr, int wc, int fr, int fq) const {
        const int row0 = u.pm * BM + wr * 64 + fr, c0 = u.pn * HALF + wc * 32 + 8 * fq;
        const f32x4 bv0 = *(const f32x4*)(bias + c0), bv1 = *(const f32x4*)(bias + c0 + 4), bg0 = *(const f32x4*)(bias + 512 + c0), bg1 = *(const f32x4*)(bias + 512 + c0 + 4);
#pragma unroll
        for (int ai = 0; ai < 2; ++ai)
#pragma unroll
            for (int m = 0; m < 4; ++m) { const f32x4 v0 = acc[ai][0][m][0] + bv0, v1 = acc[ai][0][m][1] + bv1, g0 = acc[ai][1][m][0] + bg0, g1 = acc[ai][1][m][1] + bg1;
                float o[8];
#pragma unroll
                for (int e = 0; e < 4; ++e) { o[e] = v0[e] / (1.f + __expf(-g0[e])); o[4 + e] = v1[e] / (1.f + __expf(-g1[e])); }
                u32x4 w; w.x = cvt_pk_bf16(o[0], o[1]); w.y = cvt_pk_bf16(o[2], o[3]); w.z = cvt_pk_bf16(o[4], o[5]); w.w = cvt_pk_bf16(o[6], o[7]);
                *(u32x4*)(MIX + (size_t)(row0 + ai * HALF + m * 16) * DM + 512 + c0) = w; }
    }
};
}

__device__ __forceinline__ void transpose_item(const float* W, int K, int N, bf16_t* WT, int k0, int n0, int row0, float* scr, int lane) {
#pragma unroll 8
    for (int i = 0; i < 32; ++i) { const int kk = 2 * i + (lane >> 5); scr[kk * 33 + (lane & 31)] = W[(size_t)(k0 + kk) * N + n0 + (lane & 31)]; }
    asm volatile("s_waitcnt lgkmcnt(0)" ::: "memory");
    const int c = lane & 7;
#pragma unroll
    for (int j = 0; j < 4; ++j) { const int n = (lane >> 3) + 8 * j; const float* sp = scr + (8 * c) * 33 + n;
        pg8::u32x4 o; o.x = pg8::cvt_pk_bf16(sp[0 * 33], sp[1 * 33]); o.y = pg8::cvt_pk_bf16(sp[2 * 33], sp[3 * 33]); o.z = pg8::cvt_pk_bf16(sp[4 * 33], sp[5 * 33]); o.w = pg8::cvt_pk_bf16(sp[6 * 33], sp[7 * 33]);
        *(pg8::u32x4*)(WT + (size_t)(row0 + n) * K + k0 + 8 * c) = o; }
    asm volatile("s_waitcnt lgkmcnt(0)" ::: "memory");
}
__device__ __forceinline__ void ph_weights(KP P, char* lds) {
    const int tid = tid_(), lane = tid & 63, wave = tid >> 6;
    float* scr = (float*)lds + wave * (64 * 33);
    const int gw = bid_() * 8 + wave, NGW = gridDim.x * 8;
    constexpr int I_IN = (DM / 64) * (INW / 32), I_OUT = (DM / 64) * (DM / 32), I_GLU = (512 / 64) * (1024 / 32), I_L = I_IN + I_OUT + I_GLU;
    for (int it = gw; it < 2 * I_L; it += NGW) {
        const int layer = it / I_L; int r = it % I_L;
        if (r < I_IN) { const int nb = INW / 32, kb = r / nb, n0 = (r % nb) * 32;
            transpose_item(P->w_in + (size_t)layer * DM * INW, DM, INW, P->WinT + (size_t)layer * INW * DM, kb * 64, n0, n0, scr, lane); continue; }
        r -= I_IN;
        if (r < I_OUT) { const int nb = DM / 32, kb = r / nb, n0 = (r % nb) * 32;
            transpose_item(P->w_out + (size_t)layer * DM * DM, DM, DM, P->WoutT + (size_t)layer * DM * DM, kb * 64, n0, n0, scr, lane); continue; }
        r -= I_OUT;
        { const int nb = 1024 / 32, kb = r / nb, n0 = (r % nb) * 32;
          const int row0 = ((n0 & 511) >> 7) * 256 + (n0 >> 9) * 128 + (n0 & 127);
          transpose_item(P->w_glu + (size_t)layer * 512 * 1024, 512, 1024, P->WgluT + (size_t)layer * 1024 * 512, kb * 64, n0, row0, scr, lane); }
    }
}


namespace fa {
using bf16x8 = __attribute__((ext_vector_type(8))) short;
using s16x4  = __attribute__((ext_vector_type(4))) short;
using f32x16 = __attribute__((ext_vector_type(16))) float;
using u32x4  = __attribute__((ext_vector_type(4))) unsigned;
constexpr int D = 128, NW = 8, QBLK = 32, KVBLK = 64, LDQK = QKVW;
constexpr float SCALE = 0.088388347648318440f, THR = 8.f, NEG = -1e30f;
constexpr size_t SHM_V = KVBLK * D * 2, SHM_K = KVBLK * D * 2, SHM_ATTN = 2 * SHM_V + 2 * SHM_K + NW * 64 * 4;
#define KSWZ(row, colB) ((row) * 256 + ((colB) ^ (((row) & 7) << 4)))
#define SBAR() __builtin_amdgcn_sched_barrier(0)
__device__ __forceinline__ int crow(int r, int hi) { return (r & 3) + 8 * (r >> 2) + 4 * hi; }
__device__ __forceinline__ unsigned cvtpk(float lo, float hi) { unsigned r; asm volatile("v_cvt_pk_bf16_f32 %0, %1, %2" : "=v"(r) : "v"(lo), "v"(hi)); return r; }
__device__ __forceinline__ void partialSM(f32x16& p0, f32x16& p1, float& m_reg, float& mn, float& alpha) {
  constexpr float C = SCALE * 1.4426950408889634f;
  float pmax = p0[0]; for (int r = 1; r < 16; ++r) pmax = fmaxf(pmax, p0[r]); for (int r = 0; r < 16; ++r) pmax = fmaxf(pmax, p1[r]);
  { auto rr = __builtin_amdgcn_permlane32_swap(__float_as_uint(pmax), __float_as_uint(pmax), false, false);
    pmax = fmaxf(__uint_as_float(rr[0]), __uint_as_float(rr[1])); }
  if (__builtin_expect(__all(pmax - m_reg <= THR / SCALE), 1)) { mn = m_reg; alpha = 1.f; }
  else { mn = fmaxf(m_reg, pmax); alpha = __builtin_amdgcn_exp2f((m_reg - mn) * C); m_reg = mn; }
  float mnC = -mn * C;
  for (int r = 0; r < 16; ++r) p0[r] = fmaf(p0[r], C, mnC); for (int r = 0; r < 16; ++r) p1[r] = fmaf(p1[r], C, mnC);
  for (int r = 0; r < 16; ++r) p0[r] = __builtin_amdgcn_exp2f(p0[r]);
}
__device__ __forceinline__ void finishSM(f32x16& p0, f32x16& p1, float alpha, float& l_reg, bf16x8& pa0, bf16x8& pa1, bf16x8& pa2, bf16x8& pa3) {
  for (int r = 0; r < 16; ++r) p1[r] = __builtin_amdgcn_exp2f(p1[r]);
  float ps = 0; for (int r = 0; r < 16; ++r) ps += p0[r]; for (int r = 0; r < 16; ++r) ps += p1[r];
  { auto rr = __builtin_amdgcn_permlane32_swap(__float_as_uint(ps), __float_as_uint(ps), false, false);
    ps = __uint_as_float(rr[0]) + __uint_as_float(rr[1]); }
  l_reg = l_reg * alpha + ps;
#define PK4(P, BASE, OUT) do { unsigned a0 = cvtpk(P[BASE + 0], P[BASE + 1]), a1 = cvtpk(P[BASE + 2], P[BASE + 3]);   \
    unsigned b0 = cvtpk(P[BASE + 4], P[BASE + 5]), b1 = cvtpk(P[BASE + 6], P[BASE + 7]);                              \
    auto r0 = __builtin_amdgcn_permlane32_swap(a0, b0, false, false); auto r1 = __builtin_amdgcn_permlane32_swap(a1, b1, false, false); \
    u32x4 w = {r0[0], r1[0], r0[1], r1[1]}; OUT = *reinterpret_cast<bf16x8*>(&w); } while (0)
  PK4(p0, 0, pa0); PK4(p0, 8, pa1); PK4(p1, 0, pa2); PK4(p1, 8, pa3);
#undef PK4
}
__device__ __forceinline__ void qkt(f32x16& p0, f32x16& p1, const bf16_t* Ks, const bf16x8* qr, int r32, int hi) {
  p0 = f32x16{}; p1 = f32x16{};
  for (int d0 = 0; d0 < 8; ++d0) { int cb = (d0 * 16 + hi * 8) * 2;
    bf16x8 b0 = *reinterpret_cast<const bf16x8*>((const char*)Ks + KSWZ(r32, cb));
    bf16x8 b1 = *reinterpret_cast<const bf16x8*>((const char*)Ks + KSWZ(32 + r32, cb));
    p0 = __builtin_amdgcn_mfma_f32_32x32x16_bf16(b0, qr[d0], p0, 0, 0, 0);
    p1 = __builtin_amdgcn_mfma_f32_32x32x16_bf16(b1, qr[d0], p1, 0, 0, 0); }
}
__device__ __forceinline__ void mask_tile(f32x16& p0, f32x16& p1, int kt, int vis) {
  if (kt > vis) {
    const bool part = (kt == vis + 1);
    for (int r = 0; r < 16; ++r) p1[r] = NEG;
    for (int r = 8; r < 16; ++r) p0[r] = NEG;
    if (!part) for (int r = 0; r < 8; ++r) p0[r] = NEG;
  }
}
__device__ __forceinline__ int v_st(int k, int c) { const int kk = (k & ~0xC) | ((k & 4) << 1) | ((k & 8) >> 1); return ((kk >> 3) * 4 + (c >> 5)) * 512 + ((kk & 7) * 32 + (c & 31)) * 2; }
__device__ __forceinline__ int v_rd_base(int lane) { return ((lane & 3) << 3) | (((lane >> 2) & 3) << 6) | (((lane >> 4) & 1) << 5) | (((lane >> 5) & 1) << 8); }
constexpr int v_rd_off(int d0, int ks, int half) { return d0 * 512 + ks * 4096 + half * 2048; }
template <int OFF> __device__ __forceinline__ s16x4 tr_read(int vb) {
  s16x4 r; asm volatile("ds_read_b64_tr_b16 %0, %1 offset:%2" : "=&v"(r) : "v"(vb), "i"(OFF) : "memory"); return r;
}
template <int D0> __device__ __forceinline__ void pv_one(f32x16& od, int vb, bf16x8 pa0, bf16x8 pa1, bf16x8 pa2, bf16x8 pa3) {
  const s16x4 l0 = tr_read<v_rd_off(D0, 0, 0)>(vb), h0 = tr_read<v_rd_off(D0, 0, 1)>(vb), l1 = tr_read<v_rd_off(D0, 1, 0)>(vb), h1 = tr_read<v_rd_off(D0, 1, 1)>(vb);
  const s16x4 l2 = tr_read<v_rd_off(D0, 2, 0)>(vb), h2 = tr_read<v_rd_off(D0, 2, 1)>(vb), l3 = tr_read<v_rd_off(D0, 3, 0)>(vb), h3 = tr_read<v_rd_off(D0, 3, 1)>(vb);
  asm volatile("s_waitcnt lgkmcnt(0)" ::: "memory"); SBAR();
#define PK(L, H) (bf16x8){L[0], L[1], L[2], L[3], H[0], H[1], H[2], H[3]}
  od = __builtin_amdgcn_mfma_f32_32x32x16_bf16(pa0, PK(l0, h0), od, 0, 0, 0);
  od = __builtin_amdgcn_mfma_f32_32x32x16_bf16(pa1, PK(l1, h1), od, 0, 0, 0);
  od = __builtin_amdgcn_mfma_f32_32x32x16_bf16(pa2, PK(l2, h2), od, 0, 0, 0);
  od = __builtin_amdgcn_mfma_f32_32x32x16_bf16(pa3, PK(l3, h3), od, 0, 0, 0);
#undef PK
}
__device__ __forceinline__ void pv_d0(f32x16* o, int vb, bf16x8 pa0, bf16x8 pa1, bf16x8 pa2, bf16x8 pa3) {
  pv_one<0>(o[0], vb, pa0, pa1, pa2, pa3); pv_one<1>(o[1], vb, pa0, pa1, pa2, pa3); pv_one<2>(o[2], vb, pa0, pa1, pa2, pa3); pv_one<3>(o[3], vb, pa0, pa1, pa2, pa3);
}
__device__ __forceinline__ void attn_unit(const bf16_t* __restrict__ Qb, const bf16_t* __restrict__ Kh, const bf16_t* __restrict__ Vh, float* __restrict__ Ob, int NT, int vis4, char* lds) {
  const int tid = tid_(), wid = tid >> 6, lane = tid & 63, r32 = lane & 31, hi = lane >> 5;
  const int vis = vis4 + (wid >> 1);
  bf16_t* V_lds = (bf16_t*)lds; bf16_t* K_lds = (bf16_t*)(lds + 2 * SHM_V);
  float* ws = (float*)(lds + 2 * SHM_V + 2 * SHM_K) + wid * 64; float* li_l = ws; float* al_l = ws + 32;
  float m_reg = NEG, l_reg = 0; f32x16 o[4] = {}; bf16x8 qr[8];
  const bf16_t* Qw = Qb + (long)(wid * QBLK + r32) * LDQK + hi * 8;
#pragma unroll
  for (int d0 = 0; d0 < 8; ++d0) qr[d0] = *reinterpret_cast<const bf16x8*>(Qw + d0 * 16);
  const int sr = tid >> 4, sc = (tid & 15) * 8, vst0 = v_st(sr, sc), vst1 = v_st(32 + sr, sc);
  const int vb0 = (int)(uintptr_t)V_lds + v_rd_base(lane);
  struct { bf16x8 vs0, vs1, ks0, ks1; } sr_[2];
#define SLOAD(i, k0) do { sr_[i].vs0 = *reinterpret_cast<const bf16x8*>(&Vh[(long)((k0) + sr) * LDQK + sc]); sr_[i].vs1 = *reinterpret_cast<const bf16x8*>(&Vh[(long)((k0) + 32 + sr) * LDQK + sc]); \
    sr_[i].ks0 = *reinterpret_cast<const bf16x8*>(&Kh[(long)((k0) + sr) * LDQK + sc]); sr_[i].ks1 = *reinterpret_cast<const bf16x8*>(&Kh[(long)((k0) + 32 + sr) * LDQK + sc]); } while (0)
#define SWRITE(b, i) do { *(bf16x8*)((char*)V_lds + (b) * SHM_V + vst0) = sr_[i].vs0;          \
    *(bf16x8*)((char*)V_lds + (b) * SHM_V + vst1) = sr_[i].vs1; int kc = sc * 2;               \
    *(bf16x8*)((char*)K_lds + (b) * SHM_K + KSWZ(sr, kc)) = sr_[i].ks0;                       \
    *(bf16x8*)((char*)K_lds + (b) * SHM_K + KSWZ(32 + sr, kc)) = sr_[i].ks1; } while (0)
#define SWAIT() asm volatile("s_waitcnt vmcnt(4)" ::: "memory")
#define RESC(a) do { if (__any((a) < 1.f)) { if (hi == 0) al_l[r32] = (a); asm volatile("s_waitcnt lgkmcnt(0)" ::: "memory"); \
    for (int d = 0; d < 4; ++d) for (int r = 0; r < 16; ++r) o[d][r] *= al_l[crow(r, hi)]; } } while (0)
  f32x16 pA0, pA1, pB0, pB1; float mnA, mnB, alA, alB; bf16x8 pa0, pa1, pa2, pa3;
  constexpr int SE = 0, SO = 1;
  SLOAD(SE, 0); asm volatile("s_waitcnt vmcnt(0)" ::: "memory"); SWRITE(0, SE); __syncthreads();
  qkt(pA0, pA1, K_lds, qr, r32, hi); mask_tile(pA0, pA1, 0, vis); partialSM(pA0, pA1, m_reg, mnA, alA);
  SLOAD(SO, KVBLK); if (2 < NT) SLOAD(SE, 2 * KVBLK);
  SWAIT(); SWRITE(1, SO); __syncthreads();
  for (int j = 1; j + 1 < NT; j += 2) {
    SBAR(); qkt(pB0, pB1, (bf16_t*)((char*)K_lds + SHM_K), qr, r32, hi); mask_tile(pB0, pB1, j, vis);
    finishSM(pA0, pA1, alA, l_reg, pa0, pa1, pa2, pa3); SBAR();
    SLOAD(SO, (j + 2) * KVBLK); SBAR();
    pv_d0(o, vb0, pa0, pa1, pa2, pa3); partialSM(pB0, pB1, m_reg, mnB, alB);
    __syncthreads(); SWAIT(); SWRITE(0, SE);
    RESC(alB); __syncthreads();
    SBAR(); qkt(pA0, pA1, K_lds, qr, r32, hi); mask_tile(pA0, pA1, j + 1, vis);
    finishSM(pB0, pB1, alB, l_reg, pa0, pa1, pa2, pa3); SBAR();
    if (j + 3 < NT) SLOAD(SE, (j + 3) * KVBLK); SBAR();
    pv_d0(o, vb0 + (int)SHM_V, pa0, pa1, pa2, pa3); partialSM(pA0, pA1, m_reg, mnA, alA);
    __syncthreads(); SWAIT(); SWRITE(1, SO);
    RESC(alA); __syncthreads();
  }
  SBAR(); qkt(pB0, pB1, (bf16_t*)((char*)K_lds + SHM_K), qr, r32, hi); mask_tile(pB0, pB1, NT - 1, vis);
  finishSM(pA0, pA1, alA, l_reg, pa0, pa1, pa2, pa3); SBAR();
  pv_d0(o, vb0, pa0, pa1, pa2, pa3); partialSM(pB0, pB1, m_reg, mnB, alB);
  __syncthreads(); RESC(alB);
  finishSM(pB0, pB1, alB, l_reg, pa0, pa1, pa2, pa3); SBAR();
  pv_d0(o, vb0 + (int)SHM_V, pa0, pa1, pa2, pa3);
  if (hi == 0) li_l[r32] = l_reg; asm volatile("s_waitcnt lgkmcnt(0)" ::: "memory");
  float rli[16];
#pragma unroll
  for (int r = 0; r < 16; ++r) rli[r] = __builtin_amdgcn_rcpf(li_l[crow(r, hi)]);
  float* Ow = Ob + (long)(wid * QBLK) * DM;
#pragma unroll
  for (int r = 0; r < 16; ++r) { int orow = crow(r, hi);
    for (int d0 = 0; d0 < 4; ++d0) Ow[(long)orow * DM + d0 * 32 + r32] = o[d0][r] * rli[r]; }
  __syncthreads();
#undef SLOAD
#undef SWRITE
#undef SWAIT
#undef RESC
}
#undef KSWZ
#undef SBAR
}

__device__ __forceinline__ void ph_attention(KP P, char* lds) {
    const bf16_t* QKV = P->QKV; float* OC = P->OC;
    const int c = bid_();
    if (c < 256) {
        const int combo = c >> 2, b = combo >> 4, h = (combo >> 2) & 3, i = (combo >> 1) & 1, vh = combo & 1;
        const bf16_t* Kh = QKV + (size_t)(b * LL) * QKVW + 1024 + h * 256 + i * 128;
        const bf16_t* Vh = QKV + (size_t)(b * LL) * QKVW + 2048 + h * 256 + vh * 128;
#pragma unroll 1
        for (int s = 0; s < 2; ++s) {
            const int jb = s == 0 ? (c & 3) : 7 - (c & 3);
            const size_t row0 = (size_t)(b * LL) + NMETA + 256 * jb;
            fa::attn_unit(QKV + row0 * QKVW + h * 256 + i * 128, Kh, Vh, OC + row0 * DM + h * 512 + i * 256 + vh * 128, 4 * jb + 6, 4 * jb, lds);
        }
    }
    {
        const int tid = tid_(), lane = tid & 63, gw = c * 8 + (tid >> 6);
        if (gw < 512) {
            const int b = gw >> 7, h = (gw >> 5) & 3, i = (gw >> 4) & 1, row = gw & 15;
            const bf16_t* q = QKV + (size_t)(b * LL + row) * QKVW + h * 256 + i * 128;
            const int key = lane & 15;
            const bf16_t* k = QKV + (size_t)(b * LL + key) * QKVW + 1024 + h * 256 + i * 128;
            float sc = 0.f;
            for (int d = 0; d < 128; ++d) sc = fmaf(bf2f(q[d]), bf2f(k[d]), sc);
            sc *= 0.08838834764831845f;
            float m = sc;
#pragma unroll
            for (int o = 8; o > 0; o >>= 1) m = fmaxf(m, __shfl_xor(m, o));
            const float e = expf(sc - m);
            float ssum = e;
#pragma unroll
            for (int o = 8; o > 0; o >>= 1) ssum += __shfl_xor(ssum, o);
            const float p = e / ssum;
            float acc[4] = {0.f, 0.f, 0.f, 0.f};
            for (int j = 0; j < 16; ++j) {
                const float pj = __shfl(p, j);
                const bf16_t* v = QKV + (size_t)(b * LL + j) * QKVW + 2048 + h * 256 + lane * 4;
#pragma unroll
                for (int e2 = 0; e2 < 4; ++e2) acc[e2] = fmaf(pj, bf2f(v[e2]), acc[e2]);
            }
            float* o = OC + (size_t)(b * LL + row) * DM + h * 512 + i * 256 + lane * 4;
            o[0] = acc[0]; o[1] = acc[1]; o[2] = acc[2]; o[3] = acc[3];
        }
    }
}


namespace hg {
using bf16x8 = __attribute__((ext_vector_type(8))) short;
using s16x4  = __attribute__((ext_vector_type(4))) short;
using f32x16 = __attribute__((ext_vector_type(16))) float;
using u32x4  = __attribute__((ext_vector_type(4))) unsigned;
constexpr int NCH = 33, NU = 16 * NCH;
constexpr int SK = 136;
constexpr int SS = 72;
__device__ __forceinline__ int crow(int r, int hi) { return (r & 3) + 8 * (r >> 2) + 4 * hi; }
__device__ __forceinline__ unsigned cvtpk(float lo, float hi) { unsigned r; asm volatile("v_cvt_pk_bf16_f32 %0, %1, %2" : "=v"(r) : "v"(lo), "v"(hi)); return r; }

__device__ __forceinline__ void prep(const float* PA, const float* lbtab, size_t row0, int c, int h, int k, int tq, float* qsum, float (&b)[16], float (&kk)[16], float& bend, float& r) {
    const float lbv = lbtab[h * 128 + k];
    float run = 0.f;
#pragma unroll
    for (int i = 0; i < 16; ++i) {
        const int t = 16 * tq + i; const bool valid = (c * 64 + t) < LL;
        const float fp = valid ? PA[(row0 + t) * PAW + 512 + h * 128 + k] : 0.f;
        const float kv = valid ? (1.f - lbv) / (1.f + __expf(fp)) : 0.f;
        kk[i] = kv; run += fmaxf(log1pf(-kv), -30.f); b[i] = run;
    }
    qsum[tq * 128 + k] = run;
    __syncthreads();
    const float q0 = qsum[k], q1 = qsum[128 + k], q2 = qsum[256 + k], q3 = qsum[384 + k];
    const float off = tq == 0 ? 0.f : (tq == 1 ? q0 : (tq == 2 ? q0 + q1 : q0 + q1 + q2));
    r = q0 + q1; bend = (q0 + q1) + (q2 + q3);
#pragma unroll
    for (int i = 0; i < 16; ++i) b[i] += off;
}
__device__ __forceinline__ void store16(bf16_t* dst, const float (&x)[16]) {
    u32x4 w0, w1;
    w0.x = cvtpk(x[0], x[1]); w0.y = cvtpk(x[2], x[3]); w0.z = cvtpk(x[4], x[5]); w0.w = cvtpk(x[6], x[7]);
    w1.x = cvtpk(x[8], x[9]); w1.y = cvtpk(x[10], x[11]); w1.z = cvtpk(x[12], x[13]); w1.w = cvtpk(x[14], x[15]);
    *(u32x4*)dst = w0; *(u32x4*)(dst + 8) = w1;
}

__device__ __forceinline__ void local_states(KP P, char* lds, int layer) {
    bf16_t* KhT = (bf16_t*)lds; bf16_t* VT = KhT + 128 * SS; float* qsum = (float*)(VT + 128 * SS);
    const float* PA = P->PA; const float* lbtab = P->lbtab + layer * 512; float* SLOC = P->SLOC; float* DEC = P->DEC;
    const int tid = tid_(), k = tid & 127, tq = tid >> 7, lane = tid & 63, wid = tid >> 6, r32 = lane & 31, hh = lane >> 5;
    for (int u = bid_(); u < NU; u += gridDim.x) {
        const int bh = u / NCH, c = u % NCH, b_ = bh >> 2, h = bh & 3; const size_t row0 = (size_t)b_ * LL + c * 64;
        float b[16], kk[16], bend, r;
        prep(PA, lbtab, row0, c, h, k, tq, qsum, b, kk, bend, r);
        float x[16];
#pragma unroll
        for (int i = 0; i < 16; ++i) x[i] = kk[i] * __expf(bend - b[i]);
        store16(KhT + k * SS + 16 * tq, x);
#pragma unroll
        for (int i = 0; i < 16; ++i) { const int t = 16 * tq + i; x[i] = (c * 64 + t) < LL ? PA[(row0 + t) * PAW + 1024 + h * 128 + k] : 0.f; }
        store16(VT + k * SS + 16 * tq, x);
        if (tq == 0) DEC[u * 128 + k] = __expf(bend);
        __syncthreads();
        const int vt = wid >> 1;
#pragma unroll
        for (int j = 0; j < 2; ++j) {
            const int kt = (wid & 1) * 2 + j;
            f32x16 acc = {};
#pragma unroll
            for (int sg = 0; sg < 4; ++sg) {
                const bf16x8 a = *(const bf16x8*)(VT + (vt * 32 + r32) * SS + sg * 16 + hh * 8);
                const bf16x8 bb = *(const bf16x8*)(KhT + (kt * 32 + r32) * SS + sg * 16 + hh * 8);
                acc = __builtin_amdgcn_mfma_f32_32x32x16_bf16(a, bb, acc, 0, 0, 0);
            }
            float* o = SLOC + (size_t)u * 16384 + kt * 32 + r32;
#pragma unroll
            for (int rg = 0; rg < 16; ++rg) o[(vt * 32 + crow(rg, hh)) * 128] = acc[rg];
        }
        __syncthreads();
    }
}
__device__ __forceinline__ void scan_states(KP P) {
    const float* SLOC = P->SLOC; const float* DEC = P->DEC; bf16_t* SPREV = P->SPREV;
    const int tid = tid_();
    for (int e = bid_() * NTHR + tid; e < 16 * 16384; e += gridDim.x * NTHR) {
        const int bh = e >> 14, vk = e & 16383, k = vk & 127;
        float d[NCH - 1], x[NCH - 1];
#pragma unroll
        for (int c = 0; c < NCH - 1; ++c) { const int u = bh * NCH + c; d[c] = DEC[u * 128 + k]; x[c] = SLOC[(size_t)u * 16384 + vk]; }
        float S = 0.f;
#pragma unroll
        for (int c = 0; c < NCH - 1; ++c) { S = fmaf(d[c], S, x[c]); SPREV[(size_t)(bh * NCH + c + 1) * 16384 + vk] = f2bf(S); }
    }
}
__device__ __forceinline__ void outputs(KP P, char* lds, int layer) {
    bf16_t* Qt = (bf16_t*)lds; bf16_t* Qh = Qt + 64 * SK; bf16_t* Kt = Qh + 64 * SK; bf16_t* VT = Kt + 64 * SK; bf16_t* SpT = VT + 128 * SS;
    float* qsum = (float*)(SpT + 128 * SK); float* part = qsum + 512;
    const float* PA = P->PA; const float* lbtab = P->lbtab + layer * 512; const bf16_t* SPREV = P->SPREV; const float* nw = P->hnw + layer * 128; bf16_t* MIX = P->MIX;
    const int tid = tid_(), k = tid & 127, tq = tid >> 7, lane = tid & 63, wid = tid >> 6, r32 = lane & 31, hh = lane >> 5;
    for (int u = bid_(); u < NU; u += gridDim.x) {
        const int bh = u / NCH, c = u % NCH, b_ = bh >> 2, h = bh & 3; const size_t row0 = (size_t)b_ * LL + c * 64;
        float b[16], kk[16], bend, r;
        prep(PA, lbtab, row0, c, h, k, tq, qsum, b, kk, bend, r);
#pragma unroll
        for (int i = 0; i < 16; ++i) { const int t = 16 * tq + i; const bool valid = (c * 64 + t) < LL;
            const float q = valid ? PA[(row0 + t) * PAW + h * 128 + k] : 0.f;
            Qt[t * SK + k] = f2bf(q * __expf(b[i] - r)); Qh[t * SK + k] = f2bf(q * __expf(b[i])); Kt[t * SK + k] = f2bf(kk[i] * __expf(r - b[i])); }
        { float x[16];
#pragma unroll
          for (int i = 0; i < 16; ++i) { const int t = 16 * tq + i; x[i] = (c * 64 + t) < LL ? PA[(row0 + t) * PAW + 1024 + h * 128 + k] : 0.f; }
          store16(VT + k * SS + 16 * tq, x); }
        if (c > 0) {
#pragma unroll
            for (int j = 0; j < 4; ++j) { const int idx = tid + 512 * j, v = idx >> 4, ch = idx & 15;
                *(u32x4*)(SpT + v * SK + ch * 8) = *(const u32x4*)(SPREV + (size_t)u * 16384 + v * 128 + ch * 8); }
        }
        __syncthreads();
        const int tt = wid & 1, vt = wid >> 1;
        f32x16 oacc = {};
#pragma unroll
        for (int st = 0; st < 2; ++st) {
            if (st <= tt) {
                f32x16 sc = {};
#pragma unroll
                for (int d0 = 0; d0 < 8; ++d0) {
                    const bf16x8 a = *(const bf16x8*)(Kt + (st * 32 + r32) * SK + d0 * 16 + hh * 8);
                    const bf16x8 bq = *(const bf16x8*)(Qt + (tt * 32 + r32) * SK + d0 * 16 + hh * 8);
                    sc = __builtin_amdgcn_mfma_f32_32x32x16_bf16(a, bq, sc, 0, 0, 0);
                }
                if (st == tt) {
#pragma unroll
                    for (int rg = 0; rg < 16; ++rg) sc[rg] = (crow(rg, hh) <= r32) ? sc[rg] : 0.f;
                }
#pragma unroll
                for (int g = 0; g < 2; ++g) {
                    u32x4 w; w.x = cvtpk(sc[8 * g + 0], sc[8 * g + 1]); w.y = cvtpk(sc[8 * g + 2], sc[8 * g + 3]); w.z = cvtpk(sc[8 * g + 4], sc[8 * g + 5]); w.w = cvtpk(sc[8 * g + 6], sc[8 * g + 7]);
                    const bf16x8 pb = *reinterpret_cast<bf16x8*>(&w);
                    const bf16_t* vp = VT + (vt * 32 + r32) * SS + st * 32 + 16 * g + 4 * hh;
                    const s16x4 lo = *(const s16x4*)vp, hi4 = *(const s16x4*)(vp + 8);
                    const bf16x8 a = (bf16x8){lo[0], lo[1], lo[2], lo[3], hi4[0], hi4[1], hi4[2], hi4[3]};
                    oacc = __builtin_amdgcn_mfma_f32_32x32x16_bf16(a, pb, oacc, 0, 0, 0);
                }
            }
        }
        if (c > 0) {
#pragma unroll
            for (int d0 = 0; d0 < 8; ++d0) {
                const bf16x8 a = *(const bf16x8*)(SpT + (vt * 32 + r32) * SK + d0 * 16 + hh * 8);
                const bf16x8 bq = *(const bf16x8*)(Qh + (tt * 32 + r32) * SK + d0 * 16 + hh * 8);
                oacc = __builtin_amdgcn_mfma_f32_32x32x16_bf16(a, bq, oacc, 0, 0, 0);
            }
        }
        float ss = 0.f;
#pragma unroll
        for (int rg = 0; rg < 16; ++rg) ss = fmaf(oacc[rg], oacc[rg], ss);
        { auto rr = __builtin_amdgcn_permlane32_swap(__float_as_uint(ss), __float_as_uint(ss), false, false); ss = __uint_as_float(rr[0]) + __uint_as_float(rr[1]); }
        if (hh == 0) part[vt * 64 + tt * 32 + r32] = ss;
        __syncthreads();
        const int t = tt * 32 + r32;
        const float tot = (part[t] + part[64 + t]) + (part[128 + t] + part[192 + t]);
        const float scale = rsqrtf(tot * (1.f / 128.f) + EPS);
        if ((c * 64 + t) < LL) {
            const float* gp = PA + (row0 + t) * PAW + 1536 + h * 128 + vt * 32;
            bf16_t* op = MIX + (row0 + t) * DM + h * 128 + vt * 32;
#pragma unroll
            for (int g4 = 0; g4 < 4; ++g4) {
                const int v0 = 8 * g4 + 4 * hh;
                const float4 gv = *(const float4*)(gp + v0); const float4 wv = *(const float4*)(nw + vt * 32 + v0);
                const float y0 = oacc[4 * g4 + 0] * scale * wv.x * gv.x / (1.f + __expf(-gv.x)), y1 = oacc[4 * g4 + 1] * scale * wv.y * gv.y / (1.f + __expf(-gv.y));
                const float y2 = oacc[4 * g4 + 2] * scale * wv.z * gv.z / (1.f + __expf(-gv.z)), y3 = oacc[4 * g4 + 3] * scale * wv.w * gv.w / (1.f + __expf(-gv.w));
                uint2 w; w.x = cvtpk(y0, y1); w.y = cvtpk(y2, y3);
                *(uint2*)(op + v0) = w;
            }
        }
        __syncthreads();
    }
}
}


namespace moe {
using bf16x8 = __attribute__((ext_vector_type(8))) short;
using f32x16 = __attribute__((ext_vector_type(16))) float;
using u32x4  = __attribute__((ext_vector_type(4))) unsigned;
constexpr int TW = 5, PROWS = 64 * TW, XS = 144, XBUF = PROWS * XS;
__device__ __forceinline__ unsigned cvtpk(float lo, float hi) { unsigned r; asm volatile("v_cvt_pk_bf16_f32 %0, %1, %2" : "=v"(r) : "v"(lo), "v"(hi)); return r; }
#define MOE_BAR() asm volatile("s_waitcnt lgkmcnt(0)\n\ts_barrier" ::: "memory")
constexpr int WD = 2;
constexpr int ABUF = 4 * 4 * 1024, AOFF = 2 * XBUF, LOFF = AOFF + 2 * ABUF;
template <bool UP>
__device__ __forceinline__ void stream_gemm(KP P, char* lds, int layer) {
    constexpr int KTOT = UP ? DM : DE, NSLAB = KTOT / 64, NCP = UP ? 2 : 4, LDW = UP ? DE : DM;
    static_assert(NSLAB % WD == 0 && NSLAB >= 2 * WD, "slab loop is unrolled by WD");
    const int tid = tid_(), lane = tid & 63, wid = tid >> 6, r32 = lane & 31, hh = lane >> 5, cg = wid & 3, th = wid >> 2;
    const int* cnt_ = P->cnt;
    const bf16_t* X = UP ? P->HN : P->H;
    int* basel = (int*)(lds + LOFF); int* tlist = basel + 64;
    for (int u = bid_(); u < 256; u += gridDim.x) {
        const int e = u >> 2, ns = u & 3;
        const int rot = (u * 11) & (NSLAB - 1);
        __syncthreads();
        if (tid < 64) { const int c = cnt_[tid]; int inc = c;
#pragma unroll
            for (int o = 1; o < 64; o <<= 1) { const int v = __shfl_up(inc, o); if (lane >= o) inc += v; }
            basel[tid] = inc - c; }
        __syncthreads();
        const int cnt = cnt_[e], row0 = basel[e];
        for (int pass0 = 0; pass0 < cnt; pass0 += PROWS) {
            const int cntp = (cnt - pass0) < PROWS ? (cnt - pass0) : PROWS;
            if constexpr (UP) {
                __syncthreads();
                const int* ridx = P->ridx; const int* rslot = P->rslot;
#pragma unroll 1
                for (int i0 = tid; i0 < NASSIGN; i0 += NTHR * 8) {
                    int ex[8], sl[8];
#pragma unroll
                    for (int q = 0; q < 8; ++q) { const int i = i0 + NTHR * q; ex[q] = i < NASSIGN ? ridx[i] : -1; sl[q] = i < NASSIGN ? rslot[i] : 0; }
#pragma unroll
                    for (int q = 0; q < 8; ++q) { const int sp = sl[q] - pass0; if (ex[q] == e && sp >= 0 && sp < PROWS) tlist[sp] = (i0 + NTHR * q) >> 1; }
                }
                __syncthreads();
            }
            int xoff[5];
#pragma unroll
            for (int j = 0; j < 5; ++j) { int rho = (tid >> 3) + 64 * j; rho = rho < cntp ? rho : cntp - 1; const int grow = row0 + pass0 + rho;
                xoff[j] = (UP ? tlist[rho] * DM : grow * DE) + (tid & 7) * 8; }
            char* const xw = lds + (tid >> 3) * XS + (tid & 7) * 16;
            char* const aw = lds + AOFF + (cg * 4 + 2 * th) * 1024 + lane * 16;
            const char* const ar = lds + AOFF + cg * 4 * 1024 + lane * 16;
#pragma unroll 1
            for (int cp = 0; cp < NCP; ++cp) {
                const int cgi = cp * 4 + cg;
                const int kkw = wid >> 1, half = wid & 1;
                const float* wp;
                if constexpr (UP) wp = (r32 < 16 ? P->w1 : P->w3) + ((size_t)(layer * NE + e) * DM + kkw * 16 + 8 * hh + 4 * half) * DE + ns * 128 + cp * 64 + 4 * (r32 & 15);
                else wp = P->w2 + ((size_t)(layer * NE + e) * DE + 32 * hh + 2 * th) * DM + ns * 512 + cgi * 32 + r32;
                f32x16 acc[TW];
#pragma unroll
                for (int tl = 0; tl < TW; ++tl) acc[tl] = f32x16{};
                float wreg[WD][16]; u32x4 xs[5];
#define MOE_WLD1(wn_, R, li) do { if constexpr (UP) { if ((li) < 4) { const float4 t_ = *(const float4*)((wn_) + (size_t)(li) * DE); wreg[R][4 * (li)] = t_.x; wreg[R][4 * (li) + 1] = t_.y; wreg[R][4 * (li) + 2] = t_.z; wreg[R][4 * (li) + 3] = t_.w; } } \
                    else { if ((li) < 16) wreg[R][li] = (wn_)[(size_t)(((li) >> 3) + 4 * ((li) & 7)) * DM]; } } while (0)
#define MOE_WLOAD(slab, R) do { const float* wn_ = wp + (size_t)(((slab) + rot) & (NSLAB - 1)) * 64 * LDW; \
                    _Pragma("unroll") for (int li = 0; li < 16; ++li) MOE_WLD1(wn_, R, li); } while (0)
#define MOE_WPARK(R, PAR) do { if constexpr (UP) { _Pragma("unroll") for (int q = 0; q < 4; ++q) { uint2 fw; fw.x = cvtpk(wreg[R][q], wreg[R][4 + q]); fw.y = cvtpk(wreg[R][8 + q], wreg[R][12 + q]); \
                            *(uint2*)(lds + AOFF + (PAR) * ABUF + (q * 4 + kkw) * 1024 + lane * 16 + half * 8) = fw; } } \
                    else { _Pragma("unroll") for (int i = 0; i < 2; ++i) { u32x4 fw; fw.x = cvtpk(wreg[R][8 * i + 0], wreg[R][8 * i + 1]); fw.y = cvtpk(wreg[R][8 * i + 2], wreg[R][8 * i + 3]); \
                            fw.z = cvtpk(wreg[R][8 * i + 4], wreg[R][8 * i + 5]); fw.w = cvtpk(wreg[R][8 * i + 6], wreg[R][8 * i + 7]); *(u32x4*)(aw + (PAR) * ABUF + i * 1024) = fw; } } } while (0)
#pragma unroll
                for (int j = 0; j < 5; ++j) xs[j] = *(const u32x4*)(X + xoff[j] + (rot & (NSLAB - 1)) * 64);
                MOE_WLOAD(0, 0); MOE_WLOAD(1, 1);
#pragma unroll
                for (int j = 0; j < 5; ++j) *(u32x4*)(xw + 64 * j * XS) = xs[j];
                MOE_WPARK(0, 0); MOE_WLOAD(2, 0);
                MOE_BAR();
#define MOE_SLAB(s, PAR, R1) do { \
                    const int sx = ((s) + 1) < NSLAB ? (s) + 1 : NSLAB - 1, sw = ((s) + 1 + WD) < NSLAB ? (s) + 1 + WD : NSLAB - 1;     \
                    { const bf16_t* xn0_ = X + ((sx + rot) & (NSLAB - 1)) * 64; _Pragma("unroll") for (int j = 0; j < 5; ++j) xs[j] = *(const u32x4*)(xn0_ + xoff[j]); } \
                    MOE_WPARK(R1, 1 - (PAR)); \
                    const float* wn_ = wp + (size_t)((sw + rot) & (NSLAB - 1)) * 64 * LDW; \
                    const char* xb = lds + (PAR) * XBUF + (th * TW * 32 + r32) * XS + hh * 16; \
                    bf16x8 xq[4]; bf16x8 fq[2];                                                       \
                    xq[0] = *(const bf16x8*)(xb); xq[1] = *(const bf16x8*)(xb + 32 * XS); xq[2] = *(const bf16x8*)(xb + 64 * XS); \
                    fq[0] = *(const bf16x8*)(ar + (PAR) * ABUF); \
                    _Pragma("unroll") for (int kk = 0; kk < 4; ++kk) { \
                        if (kk < 3) fq[(kk + 1) & 1] = *(const bf16x8*)(ar + (PAR) * ABUF + (kk + 1) * 1024); \
                        _Pragma("unroll") for (int tl = 0; tl < TW; ++tl) { \
                            const int cur = kk * TW + tl, nx = cur + 3, nkk = nx / TW, ntl = nx % TW;       \
                            if (nx < 4 * TW) xq[nx & 3] = *(const bf16x8*)(xb + ntl * 32 * XS + nkk * 32); \
                            acc[tl] = __builtin_amdgcn_mfma_f32_32x32x16_bf16(fq[kk & 1], xq[cur & 3], acc[tl], 0, 0, 0); \
                            const int li = kk * TW + tl; \
                            MOE_WLD1(wn_, R1, li); \
                            __builtin_amdgcn_sched_barrier(0); } } \
                    _Pragma("unroll") for (int j = 0; j < 5; ++j) *(u32x4*)(xw + (1 - (PAR)) * XBUF + 64 * j * XS) = xs[j]; \
                    MOE_BAR(); } while (0)
#pragma unroll 1
                for (int s = 0; s < NSLAB; s += 2) { MOE_SLAB(s, 0, 1); MOE_SLAB(s + 1, 1, 0); }
#undef MOE_SLAB
#undef MOE_WLOAD
#undef MOE_WLD1
#undef MOE_WPARK
                const int T = (cntp + 31) >> 5;
                const int Tw = (T - TW * th) < 0 ? 0 : ((T - TW * th) > TW ? TW : (T - TW * th));
#pragma unroll
                for (int tl = 0; tl < TW; ++tl) if (tl < Tw) {
                    const int rho = (th * TW + tl) * 32 + r32;
                    if (rho < cntp) {
                        const size_t grow = (size_t)(row0 + pass0 + rho);
                        if constexpr (UP) {
                            bf16_t* hp = P->H + grow * DE + ns * 128 + cgi * 16 + 4 * hh;
#pragma unroll
                            for (int g = 0; g < 2; ++g) {
                                float y[4];
#pragma unroll
                                for (int q = 0; q < 4; ++q) { const float a = acc[tl][4 * g + q], b = acc[tl][8 + 4 * g + q]; y[q] = a / (1.f + __expf(-a)) * b; }
                                uint2 w; w.x = cvtpk(y[0], y[1]); w.y = cvtpk(y[2], y[3]);
                                *(uint2*)(hp + 8 * g) = w;
                            }
                        } else {
                            bf16_t* yp = P->Y + grow * DM + ns * 512 + cgi * 32 + 4 * hh;
#pragma unroll
                            for (int g = 0; g < 4; ++g) {
                                uint2 w; w.x = cvtpk(acc[tl][4 * g + 0], acc[tl][4 * g + 1]); w.y = cvtpk(acc[tl][4 * g + 2], acc[tl][4 * g + 3]);
                                *(uint2*)(yp + 8 * g) = w;
                            }
                        }
                    }
                }
            }
        }
    }
}
#undef MOE_BAR
}


namespace s5 {
using bf16x8 = __attribute__((ext_vector_type(8))) short;
using f32x16 = __attribute__((ext_vector_type(16))) float;
using u32x4  = __attribute__((ext_vector_type(4))) unsigned;
constexpr int NCHK = 516, NMT = 17;
__device__ __forceinline__ unsigned cvtpk(float lo, float hi) { unsigned r; asm volatile("v_cvt_pk_bf16_f32 %0, %1, %2" : "=v"(r) : "v"(lo), "v"(hi)); return r; }
__device__ __forceinline__ bf16x8 ld8f(const float* p) {
    const float4 a = *(const float4*)p, b = *(const float4*)(p + 4);
    u32x4 w; w.x = cvtpk(a.x, a.y); w.y = cvtpk(a.z, a.w); w.z = cvtpk(b.x, b.y); w.w = cvtpk(b.z, b.w);
    return *reinterpret_cast<bf16x8*>(&w);
}
__device__ __forceinline__ void prep_unit(KP P, char* lds, int layer, int g) {
    float2* pw = (float2*)lds; float2* bb = pw + 17 * 64; float2* cc = bb + 1024; float* kd = (float*)(cc + 1024);
    const int tid = tid_();
    const float dt = expf(P->log_dt[layer * 32 + g]);
    const float* a_re = P->a_re + (layer * 32 + g) * 64; const float* a_im = P->a_im + (layer * 32 + g) * 64;
    for (int idx = tid; idx < 17 * 64; idx += NTHR) { const int d = idx >> 6, p = idx & 63;
        const float mag = expf(a_re[p] * dt * (float)d), ang = a_im[p] * dt * (float)d; pw[idx] = make_float2(mag * cosf(ang), mag * sinf(ang)); }
    for (int idx = tid; idx < 1024; idx += NTHR) {
        { const int p = idx >> 4, c = idx & 15; const float are = a_re[p], aim = a_im[p];
          const float mag = expf(are * dt), abr = mag * cosf(aim * dt), abi = mag * sinf(aim * dt), den = are * are + aim * aim;
          const float zr = ((abr - 1.f) * are + abi * aim) / den, zi = (abi * are - (abr - 1.f) * aim) / den;
          const float br = P->b_re[((layer * 32 + g) * 64 + p) * 16 + c], bi = P->b_im[((layer * 32 + g) * 64 + p) * 16 + c];
          bb[idx] = make_float2(zr * br - zi * bi, zr * bi + zi * br); }
        { const int c = idx >> 6, p = idx & 63; cc[idx] = make_float2(P->c_re[((layer * 32 + g) * 16 + c) * 64 + p], P->c_im[((layer * 32 + g) * 16 + c) * 64 + p]); }
    }
    __syncthreads();
    if (tid < 64) ((float2*)P->A16)[(layer * 32 + g) * 64 + tid] = pw[16 * 64 + tid];
    for (int idx = tid; idx < 4096; idx += NTHR) { const int d = idx >> 8, c = (idx >> 4) & 15, c2 = idx & 15;
        float acc = 0.f;
        for (int p = 0; p < 64; ++p) { const float2 C = cc[c * 64 + p], W = pw[d * 64 + p], B = bb[p * 16 + c2];
            const float xr = C.x * W.x - C.y * W.y, xi = C.x * W.y + C.y * W.x; acc += xr * B.x - xi * B.y; }
        if (d == 0 && c == c2) acc += P->s5d[layer * 512 + g * 16 + c];
        kd[idx] = acc; }
    __syncthreads();
    bf16_t* BtY = P->BtY + (size_t)(layer * 32 + g) * 256 * 384; bf16_t* BtE = P->BtE + (size_t)(layer * 32 + g) * 128 * 256;
    for (int idx = tid; idx < 256 * 48; idx += NTHR) { const int n = idx / 48, ch = idx % 48, t = n >> 4, c = n & 15;
        float v[8];
        if (ch < 32) { const int s = ch >> 1, c0 = (ch & 1) * 8;
#pragma unroll
            for (int jj = 0; jj < 8; ++jj) v[jj] = (s <= t) ? kd[((t - s) * 16 + c) * 16 + c0 + jj] : 0.f;
        } else {
#pragma unroll
            for (int jj = 0; jj < 8; ++jj) { const int kq = (ch - 32) * 8 + jj, p = kq >> 1; const float2 C = cc[c * 64 + p], W = pw[(t + 1) * 64 + p];
                v[jj] = (kq & 1) ? -(C.x * W.y + C.y * W.x) : (C.x * W.x - C.y * W.y); }
        }
        u32x4 w; w.x = cvtpk(v[0], v[1]); w.y = cvtpk(v[2], v[3]); w.z = cvtpk(v[4], v[5]); w.w = cvtpk(v[6], v[7]);
        *(u32x4*)(BtY + (size_t)n * 384 + ch * 8) = w; }
    for (int idx = tid; idx < 128 * 32; idx += NTHR) { const int n = idx >> 5, ch = idx & 31, p = n >> 1, s = ch >> 1, c0 = (ch & 1) * 8;
        const float2 W = pw[(15 - s) * 64 + p];
        float v[8];
#pragma unroll
        for (int jj = 0; jj < 8; ++jj) { const float2 B = bb[p * 16 + c0 + jj]; v[jj] = (n & 1) ? (W.x * B.y + W.y * B.x) : (W.x * B.x - W.y * B.y); }
        u32x4 w; w.x = cvtpk(v[0], v[1]); w.y = cvtpk(v[2], v[3]); w.z = cvtpk(v[4], v[5]); w.w = cvtpk(v[6], v[7]);
        *(u32x4*)(BtE + (size_t)n * 256 + ch * 8) = w; }
    __syncthreads();
}
__device__ __forceinline__ void local_states(KP P, int layer) {
    const int tid = tid_(), lane = tid & 63, r32 = lane & 31, hh = lane >> 5, gw = bid_() * 8 + (tid >> 6), NGW = gridDim.x * 8;
    const float* PA = P->PA; float* E = P->S5E;
    for (int wu = gw; wu < 32 * NMT; wu += NGW) {
        const int g = wu / NMT, mt = wu % NMT, m = mt * 32 + r32, mc = m < NCHK ? m : NCHK - 1;
        const bf16_t* Bt = P->BtE + ((size_t)(layer * 32 + g) * 128 + r32) * 256 + 8 * hh;
        const float* up = PA + (size_t)(mc * 16) * PAW + 2048 + g * 16 + 8 * hh;
        f32x16 acc[4];
#pragma unroll
        for (int nt = 0; nt < 4; ++nt) acc[nt] = f32x16{};
#pragma unroll 4
        for (int s = 0; s < 16; ++s) {
            const bf16x8 bf = ld8f(up + (size_t)s * PAW);
#pragma unroll
            for (int nt = 0; nt < 4; ++nt) { const bf16x8 af = *(const bf16x8*)(Bt + (size_t)nt * 32 * 256 + s * 16); acc[nt] = __builtin_amdgcn_mfma_f32_32x32x16_bf16(af, bf, acc[nt], 0, 0, 0); }
        }
        if (m < NCHK) { float* ep = E + ((size_t)m * 32 + g) * 128 + 4 * hh;
#pragma unroll
            for (int nt = 0; nt < 4; ++nt)
#pragma unroll
                for (int q = 0; q < 4; ++q) *(float4*)(ep + nt * 32 + 8 * q) = make_float4(acc[nt][4 * q], acc[nt][4 * q + 1], acc[nt][4 * q + 2], acc[nt][4 * q + 3]); }
    }
}
__device__ __forceinline__ void scan_states(KP P, int layer) {
    const int idx = bid_() * NTHR + tid_();
    if (idx >= 8192) return;
    const int b = idx >> 11, g = (idx >> 6) & 31, p = idx & 63;
    const float2 A = ((const float2*)P->A16)[(layer * 32 + g) * 64 + p];
    const float2* E = (const float2*)P->S5E; float2* XP = (float2*)P->S5X;
    float xr = 0.f, xi = 0.f;
    const size_t o0 = ((size_t)(b * 129) * 32 + g) * 64 + p;
    float2 e[16];
#pragma unroll
    for (int i = 0; i < 16; ++i) e[i] = E[o0 + (size_t)i * 2048];
#pragma unroll 1
    for (int jb = 0; jb < 129; jb += 16) {
        float2 en[16];
#pragma unroll
        for (int i = 0; i < 16; ++i) { const int j = jb + 16 + i; en[i] = (j < 129) ? E[o0 + (size_t)j * 2048] : make_float2(0.f, 0.f); }
#pragma unroll
        for (int i = 0; i < 16; ++i) { const int j = jb + i;
            if (j < 129) { XP[o0 + (size_t)j * 2048] = make_float2(xr, xi);
                const float nr = A.x * xr - A.y * xi + e[i].x, ni = A.x * xi + A.y * xr + e[i].y; xr = nr; xi = ni; } }
#pragma unroll
        for (int i = 0; i < 16; ++i) e[i] = en[i];
    }
}
__device__ __forceinline__ float gelu_t(float x) { const float u = 0.7978845608028654f * (x + 0.044715f * x * x * x); const float e = __expf(2.f * u); return x - x / (e + 1.f); }
__device__ __forceinline__ void outputs(KP P, int layer) {
    const int tid = tid_(), lane = tid & 63, r32 = lane & 31, hh = lane >> 5, gw = bid_() * 8 + (tid >> 6), NGW = gridDim.x * 8;
    const float* PA = P->PA; const float* XP = P->S5X; bf16_t* YG = P->YG;
    for (int wu = gw; wu < 32 * NMT; wu += NGW) {
        const int g = wu / NMT, mt = wu % NMT, m = mt * 32 + r32, mc = m < NCHK ? m : NCHK - 1;
        const bf16_t* Bt = P->BtY + ((size_t)(layer * 32 + g) * 256 + r32) * 384 + 8 * hh;
        const float* up = PA + (size_t)(mc * 16) * PAW + 2048 + g * 16 + 8 * hh;
        const float* xp = XP + ((size_t)mc * 32 + g) * 128 + 8 * hh;
        f32x16 acc[8];
#pragma unroll
        for (int nt = 0; nt < 8; ++nt) acc[nt] = f32x16{};
#pragma unroll
        for (int s = 0; s < 16; ++s) {
            const bf16x8 bf = ld8f(up + (size_t)s * PAW);
#pragma unroll
            for (int nt = 0; nt < 8; ++nt) if (2 * nt + 1 >= s) { const bf16x8 af = *(const bf16x8*)(Bt + (size_t)nt * 32 * 384 + s * 16); acc[nt] = __builtin_amdgcn_mfma_f32_32x32x16_bf16(af, bf, acc[nt], 0, 0, 0); }
        }
#pragma unroll
        for (int ks = 0; ks < 8; ++ks) {
            const bf16x8 bf = ld8f(xp + ks * 16);
#pragma unroll
            for (int nt = 0; nt < 8; ++nt) { const bf16x8 af = *(const bf16x8*)(Bt + (size_t)nt * 32 * 384 + 256 + ks * 16); acc[nt] = __builtin_amdgcn_mfma_f32_32x32x16_bf16(af, bf, acc[nt], 0, 0, 0); }
        }
        if (m < NCHK) {
#pragma unroll
            for (int nt = 0; nt < 8; ++nt)
#pragma unroll
                for (int q = 0; q < 4; ++q) { const int t = 2 * nt + (q >> 1);
                    uint2 w; w.x = cvtpk(gelu_t(acc[nt][4 * q]), gelu_t(acc[nt][4 * q + 1])); w.y = cvtpk(gelu_t(acc[nt][4 * q + 2]), gelu_t(acc[nt][4 * q + 3]));
                    *(uint2*)(YG + (size_t)(m * 16 + t) * 512 + g * 16 + 8 * (q & 1) + 4 * hh) = w; }
        }
    }
}
__device__ __forceinline__ void fused_unit(KP P, char* lds, int layer, int b, int g) {
    const int tid = tid_(), lane = tid & 63, wid = tid >> 6, r32 = lane & 31, hh = lane >> 5;
    float* El = (float*)lds;
    const float* PA = P->PA; bf16_t* YG = P->YG;
    const int ml = wid * 32 + r32, mc = b * 129 + (ml < 129 ? ml : 128);
    const float* up = PA + (size_t)(mc * 16) * PAW + 2048 + g * 16 + 8 * hh;
    if (wid < 5) {
        const bf16_t* Bt = P->BtE + ((size_t)(layer * 32 + g) * 128 + r32) * 256 + 8 * hh;
        f32x16 acc[4];
#pragma unroll
        for (int nt = 0; nt < 4; ++nt) acc[nt] = f32x16{};
#pragma unroll 4
        for (int s = 0; s < 16; ++s) {
            const bf16x8 bf = ld8f(up + (size_t)s * PAW);
#pragma unroll
            for (int nt = 0; nt < 4; ++nt) { const bf16x8 af = *(const bf16x8*)(Bt + (size_t)nt * 32 * 256 + s * 16); acc[nt] = __builtin_amdgcn_mfma_f32_32x32x16_bf16(af, bf, acc[nt], 0, 0, 0); }
        }
        float* ep = El + ml * 128 + 4 * hh;
#pragma unroll
        for (int nt = 0; nt < 4; ++nt)
#pragma unroll
            for (int q = 0; q < 4; ++q) *(float4*)(ep + nt * 32 + 8 * q) = make_float4(acc[nt][4 * q], acc[nt][4 * q + 1], acc[nt][4 * q + 2], acc[nt][4 * q + 3]);
    }
    __syncthreads();
    if (tid < 64) {
        const float2 A = ((const float2*)P->A16)[(layer * 32 + g) * 64 + tid];
        float2* e2 = (float2*)El + tid;
        float xr = 0.f, xi = 0.f;
#pragma unroll 4
        for (int j = 0; j < 129; ++j) { const float2 e = e2[j * 64]; e2[j * 64] = make_float2(xr, xi);
            const float nr = A.x * xr - A.y * xi + e.x, ni = A.x * xi + A.y * xr + e.y; xr = nr; xi = ni; }
    }
    __syncthreads();
    if (wid < 5) {
        const bf16_t* Bt = P->BtY + ((size_t)(layer * 32 + g) * 256 + r32) * 384 + 8 * hh;
        const float* xp = El + (ml < 129 ? ml : 128) * 128 + 8 * hh;
        f32x16 acc[8];
#pragma unroll
        for (int nt = 0; nt < 8; ++nt) acc[nt] = f32x16{};
#pragma unroll
        for (int s = 0; s < 16; ++s) {
            const bf16x8 bf = ld8f(up + (size_t)s * PAW);
#pragma unroll
            for (int nt = 0; nt < 8; ++nt) if (2 * nt + 1 >= s) { const bf16x8 af = *(const bf16x8*)(Bt + (size_t)nt * 32 * 384 + s * 16); acc[nt] = __builtin_amdgcn_mfma_f32_32x32x16_bf16(af, bf, acc[nt], 0, 0, 0); }
        }
#pragma unroll
        for (int ks = 0; ks < 8; ++ks) {
            const bf16x8 bf = ld8f(xp + ks * 16);
#pragma unroll
            for (int nt = 0; nt < 8; ++nt) { const bf16x8 af = *(const bf16x8*)(Bt + (size_t)nt * 32 * 384 + 256 + ks * 16); acc[nt] = __builtin_amdgcn_mfma_f32_32x32x16_bf16(af, bf, acc[nt], 0, 0, 0); }
        }
        if (ml < 129) { const int m = b * 129 + ml;
#pragma unroll
            for (int nt = 0; nt < 8; ++nt)
#pragma unroll
                for (int q = 0; q < 4; ++q) { const int t = 2 * nt + (q >> 1);
                    uint2 w; w.x = cvtpk(gelu_t(acc[nt][4 * q]), gelu_t(acc[nt][4 * q + 1])); w.y = cvtpk(gelu_t(acc[nt][4 * q + 2]), gelu_t(acc[nt][4 * q + 3]));
                    *(uint2*)(YG + (size_t)(m * 16 + t) * 512 + g * 16 + 8 * (q & 1) + 4 * hh) = w; }
        }
    }
    __syncthreads();
}
}

__device__ __forceinline__ float wave_sum(float v) {
#pragma unroll
    for (int o = 32; o > 0; o >>= 1) v += __shfl_xor(v, o);
    return v;
}
__device__ __forceinline__ unsigned cvtpk_(float lo, float hi) { unsigned r; asm volatile("v_cvt_pk_bf16_f32 %0, %1, %2" : "=v"(r) : "v"(lo), "v"(hi)); return r; }
__device__ __forceinline__ void ph_attn_out(KP P, int layer) {
    const int tid = tid_(), lane = tid & 63, gw = bid_() * 8 + (tid >> 6), NGW = gridDim.x * 8;
    const float scale = 1.f - (0.8f - 0.6f * expf(-0.3f * (float)layer));
    const float lam = P->lam[layer];
    const float4 sw = ((const float4*)(P->subln + layer * 256))[lane];
    const float* OC = P->OC; bf16_t* MIX = P->MIX;
    for (int it0 = gw; it0 < TOK * 4; it0 += NGW * 4) {
        float4 a[4], b[4];
#pragma unroll
        for (int q = 0; q < 4; ++q) { const int it = it0 + NGW * q, itc = it < TOK * 4 ? it : TOK * 4 - 1, r = itc >> 2, h = itc & 3;
            a[q] = *(const float4*)(OC + (size_t)r * DM + h * 512 + lane * 4); b[q] = *(const float4*)(OC + (size_t)r * DM + h * 512 + 256 + lane * 4); }
#pragma unroll
        for (int q = 0; q < 4; ++q) { const int it = it0 + NGW * q; if (it < TOK * 4) { const int r = it >> 2, h = it & 3;
            const float o0 = a[q].x - lam * b[q].x, o1 = a[q].y - lam * b[q].y, o2 = a[q].z - lam * b[q].z, o3 = a[q].w - lam * b[q].w;
            const float ss = wave_sum(o0 * o0 + o1 * o1 + o2 * o2 + o3 * o3);
            const float rs = rsqrtf(ss * (1.f / 256.f) + EPS) * scale;
            uint2 w; w.x = cvtpk_(o0 * rs * sw.x, o1 * rs * sw.y); w.y = cvtpk_(o2 * rs * sw.z, o3 * rs * sw.w);
            *(uint2*)(MIX + (size_t)r * DM + 1024 + h * 256 + lane * 4) = w; } }
    }
}
__device__ __forceinline__ void ph_build_norm(KP P) {
    const int tid = tid_(), lane = tid & 63, gw = bid_() * 8 + (tid >> 6), NGW = gridDim.x * 8;
    for (int r = gw; r < MP; r += NGW) {
        float4 v[8];
        if (r < TOK) { const int b = r / LL, t = r % LL;
            const float4* src = (const float4*)(t < NMETA ? P->meta + (size_t)t * DM : P->x + ((size_t)b * SEQ + (t - NMETA)) * DM);
#pragma unroll
            for (int j = 0; j < 8; ++j) v[j] = src[lane + 64 * j];
        } else {
#pragma unroll
            for (int j = 0; j < 8; ++j) v[j] = make_float4(0.f, 0.f, 0.f, 0.f);
        }
        float ss = 0.f;
#pragma unroll
        for (int j = 0; j < 8; ++j) { ((float4*)(P->Z + (size_t)r * DM))[lane + 64 * j] = v[j]; ss += v[j].x * v[j].x + v[j].y * v[j].y + v[j].z * v[j].z + v[j].w * v[j].w; }
        const float rs = rsqrtf(wave_sum(ss) * (1.f / DM) + EPS);
#pragma unroll
        for (int j = 0; j < 8; ++j) { const float4 w = ((const float4*)P->ln1_w)[lane + 64 * j];
            uint2 o; o.x = cvtpk_(v[j].x * rs * w.x, v[j].y * rs * w.y); o.y = cvtpk_(v[j].z * rs * w.z, v[j].w * rs * w.w);
            ((uint2*)(P->HN + (size_t)r * DM))[lane + 64 * j] = o; }
    }
}
__device__ __forceinline__ void ph_prep(KP P) {
    const int tid = tid_();
    if (bid_() == 0) {
        const int c = tid;
        const float l0 = P->lbnd[c], l1 = P->lbnd[512 + c], m = fmaxf(l0, l1), e0 = expf(l0 - m), e1 = expf(l1 - m);
        P->lbtab[c] = 0.f; P->lbtab[512 + c] = e1 / (e0 + e1);
        if (c < 2) {
            float s1 = 0.f, s2 = 0.f;
            for (int i = 0; i < 128; ++i) { s1 += P->lq1[c * 128 + i] * P->lk1[c * 128 + i]; s2 += P->lq2[c * 128 + i] * P->lk2[c * 128 + i]; }
            const float li = 0.8f - 0.6f * expf(-0.3f * (float)c);
            P->lam[c] = expf(s1) - expf(s2) + li;
        }
    }
    for (int i = bid_() * NTHR + tid; i < 2 * 96 * DM; i += gridDim.x * NTHR) {
        const int layer = i / (96 * DM), jc = (i / DM) % 96, k = i % DM;
        float v = 0.f;
        if (jc < 8) v = P->wrg[((size_t)layer * DM + k) * 8 + jc]; else if (jc < 72) v = P->wre[((size_t)layer * DM + k) * 64 + jc - 8];
        v *= P->ln2_w[layer * DM + k];
        const bf16_t hi = f2bf(v), lo = f2bf(v - bf2f(hi));
        P->WRT[((size_t)(layer * 2 + 0) * 96 + jc) * DM + k] = hi; P->WRT[((size_t)(layer * 2 + 1) * 96 + jc) * DM + k] = lo;
    }
}
namespace rt {
using f32x16 = __attribute__((ext_vector_type(16))) float;
using bf16x8 = __attribute__((ext_vector_type(8))) short;
using u32x4  = __attribute__((ext_vector_type(4))) unsigned;
__device__ __forceinline__ void norm_router(KP P, char* lds, int layer) {
    const int tid = tid_(), lane = tid & 63, wid = tid >> 6, r32 = lane & 31, hh = lane >> 5;
    float* part = (float*)lds;
    float* ssqp = (float*)(lds + 98304);
    float* lg = ssqp + 256;
    float* rsv = lg + 32 * 97;
    const bf16_t* Whi = P->WRT + (size_t)(layer * 2 + 0) * 96 * DM; const bf16_t* Wlo = P->WRT + (size_t)(layer * 2 + 1) * 96 * DM;
    const float* Z = P->Z;
    for (int u = bid_(); u < TOK / 32; u += gridDim.x) {
        const int tok0 = u * 32, kb = wid * 256;
        if (false) {
            float* Zw = P->Z; const float* ZP = P->ZP;
            for (int i = tid; i < 32 * DM / 4; i += NTHR) { const int r = i / (DM / 4), c4 = i % (DM / 4);
                float4 z = ((const float4*)(Zw + (size_t)(tok0 + r) * DM))[c4];
#pragma unroll
                for (int ks = 0; ks < 8; ++ks) { const float4 p4 = ((const float4*)(ZP + ((size_t)ks * 256 + (tok0 - 8192 + r)) * DM))[c4]; z.x += p4.x; z.y += p4.y; z.z += p4.z; z.w += p4.w; }
                ((float4*)(Zw + (size_t)(tok0 + r) * DM))[c4] = z; }
            asm volatile("s_waitcnt vmcnt(0)" ::: "memory");
            __syncthreads();
        }
        f32x16 acc[3] = {f32x16{}, f32x16{}, f32x16{}};
        float sq = 0.f;
        const float* zp = Z + (size_t)(tok0 + r32) * DM + kb + 8 * hh;
        const bf16_t* wh = Whi + (size_t)r32 * DM + kb + 8 * hh; const bf16_t* wl = Wlo + (size_t)r32 * DM + kb + 8 * hh;
#pragma unroll 4
        for (int ks = 0; ks < 16; ++ks) {
            const float4 z0 = *(const float4*)(zp + ks * 16), z1 = *(const float4*)(zp + ks * 16 + 4);
            sq += (z0.x * z0.x + z0.y * z0.y + z0.z * z0.z + z0.w * z0.w) + (z1.x * z1.x + z1.y * z1.y + z1.z * z1.z + z1.w * z1.w);
            u32x4 h; h.x = cvtpk_(z0.x, z0.y); h.y = cvtpk_(z0.z, z0.w); h.z = cvtpk_(z1.x, z1.y); h.w = cvtpk_(z1.z, z1.w);
            u32x4 l; l.x = cvtpk_(z0.x - __uint_as_float(h.x << 16), z0.y - __uint_as_float(h.x & 0xffff0000u)); l.y = cvtpk_(z0.z - __uint_as_float(h.y << 16), z0.w - __uint_as_float(h.y & 0xffff0000u));
            l.z = cvtpk_(z1.x - __uint_as_float(h.z << 16), z1.y - __uint_as_float(h.z & 0xffff0000u)); l.w = cvtpk_(z1.z - __uint_as_float(h.w << 16), z1.w - __uint_as_float(h.w & 0xffff0000u));
            const bf16x8 zh = *reinterpret_cast<bf16x8*>(&h), zl = *reinterpret_cast<bf16x8*>(&l);
#pragma unroll
            for (int ct = 0; ct < 3; ++ct) {
                const bf16x8 ah = *(const bf16x8*)(wh + (size_t)ct * 32 * DM + ks * 16), al = *(const bf16x8*)(wl + (size_t)ct * 32 * DM + ks * 16);
                acc[ct] = __builtin_amdgcn_mfma_f32_32x32x16_bf16(ah, zh, acc[ct], 0, 0, 0);
                acc[ct] = __builtin_amdgcn_mfma_f32_32x32x16_bf16(ah, zl, acc[ct], 0, 0, 0);
                acc[ct] = __builtin_amdgcn_mfma_f32_32x32x16_bf16(al, zh, acc[ct], 0, 0, 0);
            }
        }
        { auto rr = __builtin_amdgcn_permlane32_swap(__float_as_uint(sq), __float_as_uint(sq), false, false); sq = __uint_as_float(rr[0]) + __uint_as_float(rr[1]); }
        if (hh == 0) ssqp[wid * 32 + r32] = sq;
#pragma unroll
        for (int ct = 0; ct < 3; ++ct)
#pragma unroll
            for (int rg = 0; rg < 16; ++rg) part[((wid * 3 + ct) * 16 + rg) * 64 + lane] = acc[ct][rg];
        __syncthreads();
        if (tid < 32) { float t = 0.f;
#pragma unroll
            for (int w = 0; w < 8; ++w) t += ssqp[w * 32 + tid];
            rsv[tid] = rsqrtf(t * (1.f / DM) + EPS); }
#pragma unroll
        for (int q = 0; q < 6; ++q) { const int o = tid + NTHR * q, col = o >> 5, tok = o & 31, ct = col >> 5, cl = col & 31, h2 = (cl >> 2) & 1, rg = (cl & 3) + 4 * (cl >> 3);
            float t = 0.f;
#pragma unroll
            for (int w = 0; w < 8; ++w) t += part[((w * 3 + ct) * 16 + rg) * 64 + h2 * 32 + tok];
            lg[tok * 97 + col] = t; }
        __syncthreads();
        if (tid < 32) {
            const int t = tok0 + tid; const float rs = rsv[tid]; const float* l = lg + tid * 97;
            const float* brg = P->brg + layer * 8; const float* bre = P->bre + layer * 64;
            float gl[8];
#pragma unroll
            for (int j = 0; j < 8; ++j) gl[j] = l[j] * rs + brg[j];
            int gs = 0; float gm = gl[0];
#pragma unroll
            for (int j = 1; j < 8; ++j) if (gl[j] > gm) { gm = gl[j]; gs = j; }
            float den = 0.f;
#pragma unroll
            for (int j = 0; j < 8; ++j) den += expf(gl[j] - gm);
            const float pg = 1.f / den;
            float el[8];
#pragma unroll
            for (int j = 0; j < 8; ++j) el[j] = l[8 + gs * 8 + j] * rs + bre[gs * 8 + j];
            int j0 = 0; float v0 = el[0];
#pragma unroll
            for (int j = 1; j < 8; ++j) if (el[j] > v0) { v0 = el[j]; j0 = j; }
            int j1 = -1; float v1 = -INFINITY;
#pragma unroll
            for (int j = 0; j < 8; ++j) if (j != j0 && el[j] > v1) { v1 = el[j]; j1 = j; }
            const float e1 = expf(v1 - v0), g0 = pg / (1.f + e1), g1 = pg * e1 / (1.f + e1);
            const int x0 = gs * 8 + j0, x1 = gs * 8 + j1;
            P->ridx[t * 2] = x0; P->ridx[t * 2 + 1] = x1; P->rgate[t * 2] = g0; P->rgate[t * 2 + 1] = g1;
            P->rslot[t * 2] = atomicAdd(&P->cnt[x0], 1); P->rslot[t * 2 + 1] = atomicAdd(&P->cnt[x1], 1);
        }
#pragma unroll 1
        for (int q = 0; q < 4; ++q) { const int tk = wid * 4 + q; const float rs = rsv[tk];
            const float4* zr = (const float4*)(Z + (size_t)(tok0 + tk) * DM); const float4* wl4 = (const float4*)(P->ln2_w + layer * DM);
#pragma unroll
            for (int j = 0; j < 8; ++j) { const float4 z = zr[lane + 64 * j], w = wl4[lane + 64 * j];
                uint2 o; o.x = cvtpk_(z.x * rs * w.x, z.y * rs * w.y); o.y = cvtpk_(z.z * rs * w.z, z.w * rs * w.w);
                ((uint2*)(P->HN + (size_t)(tok0 + tk) * DM))[lane + 64 * j] = o; } }
        __syncthreads();
    }
}
}
__device__ __forceinline__ void ph_combine_norm(KP P, char* lds, int layer) {
    int* base = (int*)lds;
    const int tid = tid_(), lane = tid & 63, gw = bid_() * 8 + (tid >> 6), NGW = gridDim.x * 8;
    if (tid < 64) { const int c = P->cnt[tid]; int inc = c;
#pragma unroll
        for (int o = 1; o < 64; o <<= 1) { const int v = __shfl_up(inc, o); if (lane >= o) inc += v; }
        base[tid] = inc - c; }
    __syncthreads();
    for (int t = gw; t < TOK; t += NGW) {
        const int r0 = base[P->ridx[t * 2]] + P->rslot[t * 2], r1 = base[P->ridx[t * 2 + 1]] + P->rslot[t * 2 + 1];
        const float g0 = P->rgate[t * 2], g1 = P->rgate[t * 2 + 1];
        float4 v[8]; float ss = 0.f;
#pragma unroll
        for (int j = 0; j < 8; ++j) {
            v[j] = ((const float4*)(P->Z + (size_t)t * DM))[lane + 64 * j];
            const uint2 a = ((const uint2*)(P->Y + (size_t)r0 * DM))[lane + 64 * j], b = ((const uint2*)(P->Y + (size_t)r1 * DM))[lane + 64 * j];
            v[j].x += g0 * __uint_as_float(a.x << 16) + g1 * __uint_as_float(b.x << 16); v[j].y += g0 * __uint_as_float(a.x & 0xffff0000u) + g1 * __uint_as_float(b.x & 0xffff0000u);
            v[j].z += g0 * __uint_as_float(a.y << 16) + g1 * __uint_as_float(b.y << 16); v[j].w += g0 * __uint_as_float(a.y & 0xffff0000u) + g1 * __uint_as_float(b.y & 0xffff0000u);
            ss += v[j].x * v[j].x + v[j].y * v[j].y + v[j].z * v[j].z + v[j].w * v[j].w;
        }
        const float rs = rsqrtf(wave_sum(ss) * (1.f / DM) + EPS);
        if (layer == 0) {
#pragma unroll
            for (int j = 0; j < 8; ++j) { ((float4*)(P->Z + (size_t)t * DM))[lane + 64 * j] = v[j];
                const float4 w = ((const float4*)(P->ln1_w + DM))[lane + 64 * j];
                uint2 o; o.x = cvtpk_(v[j].x * rs * w.x, v[j].y * rs * w.y); o.y = cvtpk_(v[j].z * rs * w.z, v[j].w * rs * w.w);
                ((uint2*)(P->HN + (size_t)t * DM))[lane + 64 * j] = o; }
        } else {
            const int b = t / LL, tt = t % LL;
            if (tt >= NMETA) {
#pragma unroll
                for (int j = 0; j < 8; ++j) { const float4 w = ((const float4*)P->fnw)[lane + 64 * j];
                    ((float4*)(P->out + ((size_t)b * SEQ + (tt - NMETA)) * DM))[lane + 64 * j] = make_float4(v[j].x * rs * w.x, v[j].y * rs * w.y, v[j].z * rs * w.z, v[j].w * rs * w.w); }
            }
        }
    }
    __syncthreads();
}

__global__ void __launch_bounds__(NTHR, 2) mega_fwd(Params P_arg) {
    extern __shared__ __attribute__((aligned(16))) char lds[];
    const int tid = tid_(), G = gridDim.x;
    volatile LAS unsigned* ctlw = (volatile LAS unsigned*)((LAS char*)lds + LDS_CTL);
    if (tid < 64) ctlw[tid] = 0u;
    __syncthreads();
    KP P = kp_();
    XcdBarrier bar = xcd_barrier_post(P->bar, ctlw + 8);
#define GRID_BAR() do { xcd_barrier(bar); P = kp_(); } while (0)

    ph_build_norm(P);
    ph_prep(P);
    ph_weights(P, lds);
    __syncthreads();
    for (int un = bid_(); un < 64; un += G) s5::prep_unit(P, lds, un >> 5, un & 31);
    GRID_BAR();
#pragma unroll
    for (int layer = 0; layer < 2; ++layer) {
        { pg8::Gemm g{P->HN, P->WinT + (size_t)layer * INW * DM, MP, INW, DM, DM}; pg8::StaticOrder S; S.init(MP, INW, G, bid_(), DM / 64); pg8::EpiInProj E{P->PA, P->QKV};
          pg8::gemm_phase<pg8::EpiInProj, pg8::StaticOrder, true, true>((LAS unsigned char*)lds, g, S, E); }
        { const int t2 = tid_(), b2 = bid_(); if (b2 == 0 && t2 < NE) P->cnt[t2] = 0;
 }
        GRID_BAR();
        hg::local_states(P, lds, layer);
        for (int un = bid_(); un < 128; un += G) s5::fused_unit(P, lds, layer, un >> 5, un & 31);
        ph_attention(P, lds);
        GRID_BAR();
        hg::scan_states(P);
        ph_attn_out(P, layer);
        __syncthreads();
        { pg8::Gemm g{P->YG, P->WgluT + (size_t)layer * 1024 * 512, MP, 1024, 512, 512}; pg8::StaticOrder S; S.init(MP, 1024, G, bid_(), 512 / 64); pg8::EpiGlu E{P->MIX, P->b_glu + layer * 1024};
          pg8::gemm_phase<pg8::EpiGlu, pg8::StaticOrder, true, true>((LAS unsigned char*)lds, g, S, E); }
        GRID_BAR();
        hg::outputs(P, lds, layer);
        GRID_BAR();
        { pg8::Gemm g{P->MIX, P->WoutT + (size_t)layer * DM * DM, MP, DM, DM, DM}; pg8::StaticOrder S; S.init(MP, DM, G, bid_(), DM / 64); pg8::EpiResidual E{P->Z};
          pg8::gemm_phase<pg8::EpiResidual, pg8::StaticOrder, true, true>((LAS unsigned char*)lds, g, S, E); }
        GRID_BAR();
        rt::norm_router(P, lds, layer);
        GRID_BAR();
        moe::stream_gemm<true>(P, lds, layer);
        GRID_BAR();
        moe::stream_gemm<false>(P, lds, layer);
        GRID_BAR();
        ph_combine_norm(P, lds, layer);
        if (layer == 0) GRID_BAR();
    }
}
}

extern "C" void kernel_launch(void* const* d_in, const int* in_sizes, int n_in, void* d_out, int out_size, void* d_ws, size_t ws_size, hipStream_t stream) {
    static int grid = 0;
    if (grid == 0) {
        int dev = 0, cus = 0;
        if (hipGetDevice(&dev) != hipSuccess || hipDeviceGetAttribute(&cus, hipDeviceAttributeMultiprocessorCount, dev) != hipSuccess) { grid = -1; return; }
        if (hipFuncSetAttribute((const void*)mega_fwd, hipFuncAttributeMaxDynamicSharedMemorySize, LDS_BYTES) != hipSuccess) { grid = -1; return; }
        int per_cu = 0;
        if (hipOccupancyMaxActiveBlocksPerMultiprocessor(&per_cu, (const void*)mega_fwd, NTHR, LDS_BYTES) != hipSuccess || per_cu < 1) { (void)hipGetLastError(); }
        grid = cus;
    }
    if (grid < 0) return;
    Params p{};
    const float** pin = (const float**)&p;
    for (int i = 0; i < 31; ++i) pin[i] = (const float*)d_in[i];
    p.out = (float*)d_out;
    char* ws = (char*)d_ws; size_t off = 0;
    auto alloc = [&](size_t bytes) { char* q = ws + off; off += (bytes + 255) & ~(size_t)255; return q; };
    p.bar = (unsigned*)alloc(XCD_BAR_WORDS * 4);
    p.cnt = (int*)alloc(256); p.blk_e = (int*)alloc(1024); p.base = (int*)alloc(256);
    p.lbtab = (float*)alloc(1024 * 4); p.lam = (float*)alloc(256);
    p.Z = (float*)alloc((size_t)MP * DM * 4);
    p.HN = (bf16_t*)alloc((size_t)MP * DM * 2);
    p.PA = (float*)alloc((size_t)MP * PAW * 4);
    p.QKV = (bf16_t*)alloc((size_t)MP * QKVW * 2);
    p.OA = (float*)alloc((size_t)MP * HW * 4);
    p.ZP = (float*)alloc((size_t)8 * 256 * DM * 4);
    p.WRT = (bf16_t*)alloc((size_t)2 * 2 * 96 * DM * 2);
    p.A16 = (float*)alloc(2 * 32 * 64 * 8); p.S5E = (float*)alloc((size_t)516 * 32 * 128 * 4); p.S5X = (float*)alloc((size_t)516 * 32 * 128 * 4);
    p.BtY = (bf16_t*)alloc((size_t)2 * 32 * 256 * 384 * 2); p.BtE = (bf16_t*)alloc((size_t)2 * 32 * 128 * 256 * 2);
    p.SLOC = (float*)alloc((size_t)528 * 16384 * 4); p.DEC = (float*)alloc((size_t)528 * 128 * 4); p.SPREV = (bf16_t*)alloc((size_t)529 * 16384 * 2);
    p.YG = (bf16_t*)alloc((size_t)MP * 512 * 2);
    p.T = nullptr;
    p.MIX = (bf16_t*)alloc((size_t)MP * DM * 2);
    p.OC = (float*)alloc((size_t)MP * DM * 4);
    p.ridx = (int*)alloc((size_t)NASSIGN * 4); p.rgate = (float*)alloc((size_t)NASSIGN * 4); p.rslot = (int*)alloc((size_t)NASSIGN * 4);
    p.tokrow = (int*)alloc((size_t)NASSIGN * 4); p.rowtok = (int*)alloc((size_t)NRMAX * 4);
    p.H1 = nullptr;
    p.H = (bf16_t*)alloc((size_t)NRMAX * DE * 2);
    p.Y = (bf16_t*)alloc((size_t)NRMAX * DM * 2);
    p.S = nullptr;
    p.WinT = (bf16_t*)alloc((size_t)2 * INW * DM * 2); p.WoutT = (bf16_t*)alloc((size_t)2 * DM * DM * 2); p.WgluT = (bf16_t*)alloc((size_t)2 * 1024 * 512 * 2);
    if (off > ws_size) return;
    if (hipMemsetAsync(p.bar, 0, XCD_BAR_WORDS * 4, stream) != hipSuccess) return;
    hipLaunchKernelGGL(mega_fwd, dim3(grid), dim3(NTHR), LDS_BYTES, stream, p);
}
```

```cpp
#include <hip/hip_runtime.h>
#include <stdint.h>
#include <math.h>

namespace {
typedef unsigned short bf16_t;
constexpr int DM = 2048, NB = 4, SEQ = 2048, NMETA = 16, LL = SEQ + NMETA, TOK = NB * LL, MP = 8448;
constexpr int HW = 512;
constexpr int INW = 5632, PAW = 2560, QKVW = 3072;
constexpr int NE = 64, DE = 512, NASSIGN = TOK * 2;
constexpr int RB = 128;
constexpr int NRMAX = NASSIGN + NE * RB;
constexpr float EPS = 1e-6f;
constexpr int NTHR = 512;
constexpr int ECAP = 1024;
constexpr int LDS_BYTES = 147456;
constexpr int LDS_CTL = 143360;

__device__ __forceinline__ float bf2f(bf16_t h) { return __uint_as_float(((unsigned)h) << 16); }
__device__ __forceinline__ bf16_t f2bf(float f) { unsigned u = __float_as_uint(f); return (bf16_t)((u + 0x7fffu + ((u >> 16) & 1u)) >> 16); }
__device__ __forceinline__ float sigmoidf_(float x) { return 1.f / (1.f + expf(-x)); }
__device__ __forceinline__ int tid_() { int t = threadIdx.x; asm volatile("" : "+v"(t)); return t; }
__device__ __forceinline__ int bid_() { int b = blockIdx.x; asm volatile("" : "+s"(b)); return b; }

#define XB_TMO      128
#define XB_XCNT(j)  (256  + 64 * (j))
#define XB_XSUB(j)  (1280 + 64 * (j))
#define XB_XGEN(j)  (2304 + 64 * (j))
#define XB_TOP      3328
#define XB_TOPGEN   3392
#define XCD_BAR_WORDS 3456
#define XB_SPIN_CAP (1u << 24)
#define LAS __attribute__((address_space(3)))
__device__ __forceinline__ unsigned xb_ld(unsigned* p)              { return __hip_atomic_load(p, __ATOMIC_RELAXED, __HIP_MEMORY_SCOPE_AGENT); }
__device__ __forceinline__ unsigned xb_add(unsigned* p, unsigned v) { return __hip_atomic_fetch_add(p, v, __ATOMIC_RELAXED, __HIP_MEMORY_SCOPE_AGENT); }
__device__ __forceinline__ unsigned xb_xcc_id() { return (unsigned)__builtin_amdgcn_s_getreg((3 << 11) | 20) & 0xFu; }
#define XB_SPIN(cond, bar) do { unsigned _sp = 0; while (cond) { __builtin_amdgcn_s_sleep(1); \
    if ((++_sp & 255u) == 0u) { if (xb_ld(&(bar)[XB_TMO])) break; if (_sp > XB_SPIN_CAP) { atomicAdd(&(bar)[XB_TMO], 1u); break; } } } } while (0)
struct XcdBarrier { unsigned* bar; unsigned x; volatile LAS unsigned* st; };
__device__ __forceinline__ XcdBarrier xcd_barrier_post(unsigned* bar, volatile LAS unsigned* st) {
    XcdBarrier b; b.bar = bar; b.x = xb_xcc_id(); b.st = st;
    if (threadIdx.x == 0) (void)xb_add(&bar[XB_XCNT(b.x)], 1u);
    return b;
}
__device__ __forceinline__ void xcd_barrier_complete(unsigned* bar, unsigned x, unsigned& nloc, unsigned& nx) {
    const unsigned G = gridDim.x * gridDim.y * gridDim.z;
    unsigned sum, cnt, mine, sp = 0u;
    for (;;) {
        sum = 0u; cnt = 0u; mine = 0u;
#pragma unroll
        for (unsigned j = 0; j < 16; ++j) { const unsigned c = xb_ld(&bar[XB_XCNT(j)]); sum += c; cnt += (c > 0u) ? 1u : 0u; mine = (j == x) ? c : mine; }
        if (sum == G) break;
        __builtin_amdgcn_s_sleep(1);
        if ((++sp & 255u) == 0u) { if (xb_ld(&bar[XB_TMO])) break; if (sp > XB_SPIN_CAP) { atomicAdd(&bar[XB_TMO], 1u); break; } }
    }
    nloc = mine > 0u ? mine : 1u; nx = cnt > 0u ? cnt : 1u;
}
__device__ __forceinline__ void xcd_barrier(const XcdBarrier& b) {
    asm volatile("s_waitcnt vmcnt(0)" ::: "memory");
    __syncthreads();
    if (threadIdx.x == 0) {
        unsigned* bar = b.bar;
        const unsigned bx_ = xb_xcc_id();
        __builtin_amdgcn_s_waitcnt(0);
        unsigned nloc = b.st[0], nx = b.st[1];
        if (nloc == 0u) { xcd_barrier_complete(bar, bx_, nloc, nx); b.st[0] = nloc; b.st[1] = nx; }
        const unsigned old = xb_add(&bar[XB_XSUB(bx_)], 1u);
        const unsigned gen = old / nloc;
        if (old + 1u == (gen + 1u) * nloc) {
            __builtin_amdgcn_fence(__ATOMIC_RELEASE, "agent");
            asm volatile("s_waitcnt vmcnt(0)" ::: "memory");
            const unsigned og = xb_add(&bar[XB_TOP], 1u);
            const unsigned tg = og / nx;
            if (og + 1u == (tg + 1u) * nx) xb_add(&bar[XB_TOPGEN], 1u);
            else XB_SPIN(xb_ld(&bar[XB_TOPGEN]) == tg, bar);
            __builtin_amdgcn_fence(__ATOMIC_ACQUIRE, "agent");
            xb_add(&bar[XB_XGEN(bx_)], 1u);
            asm volatile("s_waitcnt vmcnt(0)" ::: "memory");
        } else {
            XB_SPIN(xb_ld(&bar[XB_XGEN(bx_)]) == gen, bar);
            __builtin_amdgcn_fence(__ATOMIC_ACQUIRE, "agent");
            asm volatile("s_waitcnt vmcnt(0)" ::: "memory");
        }
    }
    __syncthreads();
}

struct Params {
    const float *x, *meta, *ln1_w, *w_in, *lbnd, *hnw, *a_re, *a_im, *b_re, *b_im, *c_re, *c_im, *s5d, *log_dt, *w_glu, *b_glu,
                *lq1, *lk1, *lq2, *lk2, *subln, *w_out, *ln2_w, *wrg, *brg, *wre, *bre, *w1, *w3, *w2, *fnw;
    float* out;
    unsigned* bar;
    int *cnt, *blk_e, *ridx, *rslot, *tokrow, *rowtok, *base, *elist;
    float *lbtab, *lam, *Z, *PA, *OA, *T, *OC, *rgate, *H1, *S, *SLOC, *DEC, *A16, *S5E, *S5X, *ZP;
    bf16_t *HN, *QKV, *YG, *MIX, *H, *Y, *WinT, *WoutT, *WgluT, *SPREV, *BtY, *BtE, *WRT;
};
typedef const __attribute__((address_space(4))) Params* KP;
__device__ __forceinline__ KP kp_() { KP p = (KP)__builtin_amdgcn_kernarg_segment_ptr(); asm volatile("" : "+s"(p)); return p; }


namespace pg8 {
#define PG8_LAS __attribute__((address_space(3)))
typedef short bf16x8 __attribute__((ext_vector_type(8)));
typedef float f32x4 __attribute__((ext_vector_type(4)));
typedef unsigned u32x4 __attribute__((ext_vector_type(4)));
constexpr int BM = 256, BK = 64, HALF = 128, HTB = HALF * BK * 2, STAGE_BYTES = 8 * HTB, NXCD = 8, WGM = 8;
__host__ __device__ __forceinline__ int lds_byte(int r, int c) { const int st = (r >> 4) * 2 + (c >> 5), rr = r & 15, cc = c & 31, ob = rr * 64 + cc * 2; return st * 1024 + (ob ^ (((ob >> 9) & 1) << 5)); }
__host__ __device__ __forceinline__ void stage_rc(int b, int& R, int& C) { const int st = b / 1024, sb = b % 1024, swz = sb ^ (((sb >> 9) & 1) << 5); R = (st >> 1) * 16 + swz / 64; C = (st & 1) * 32 + (swz % 64) / 2; }
__host__ __device__ __forceinline__ int perm32(int rho) { const int n = rho >> 4, i = rho & 15; return 8 * (i >> 2) + 4 * n + (i & 3); }
struct Unit { int pm, pn, ko, nt; };
struct Gemm { const bf16_t* A; const bf16_t* Bt; int M, N, K, ld; };
struct StaticOrder {
    static constexpr bool PER_UNIT_K = false;
    int nM, nN, nwg, G, c, nt;
    __host__ __device__ void init(int M, int N, int G_, int c_, int nt_) { nM = M / BM; nN = N / BM; nwg = nM * nN; G = G_; c = c_; nt = nt_; }
    __host__ __device__ bool next(int i, Unit& u) const {
        const long L = (long)i * G + c; if (L >= nwg) return false;
        int wgid = (int)L; { const int q = nwg / NXCD, r = nwg % NXCD, xcd = wgid % NXCD, off = wgid / NXCD; wgid = (xcd < r ? xcd * (q + 1) : r * (q + 1) + (xcd - r) * q) + off; }
        const int nig = WGM * nN, gid = wgid / nig, fm = gid * WGM, gsz = (nM - fm) < WGM ? (nM - fm) : WGM;
        u.pm = fm + ((wgid % nig) % gsz); u.pn = (wgid % nig) / gsz; u.ko = 0; u.nt = nt; return true;
    }
    __device__ __forceinline__ void a_ready(const Unit&) const {}
    __device__ __forceinline__ void done(const Unit&) const {}
};
__device__ __forceinline__ unsigned cvt_pk_bf16(float lo, float hi) { unsigned r; asm volatile("v_cvt_pk_bf16_f32 %0, %1, %2" : "=v"(r) : "v"(lo), "v"(hi)); return r; }

template <class Epi, class Sched, bool ALIGN_EPI = false, bool SP2 = false>
__device__ __forceinline__ void gemm_phase(PG8_LAS unsigned char* lds, const Gemm g, const Sched& S, const Epi& E) {
    const int tid = tid_(), wid = __builtin_amdgcn_readfirstlane(tid >> 6), lane = tid & 63, wr = wid >> 2, wc = wid & 3, fr = lane & 15, fq = lane >> 4;
    const int K = g.ld;
    unsigned voffA[2], voffB[2];
#pragma unroll
    for (int i = 0; i < 2; ++i) { int R, C; stage_rc(tid * 16 + i * 8192, R, C); const int Rb = Epi::PERM ? ((R & ~31) + perm32(R & 31)) : R;
        voffA[i] = (unsigned)(R * K + C) * 2u; voffB[i] = (unsigned)(Rb * K + C) * 2u; }
    const size_t kstep = (size_t)(BK * 2);
    const size_t hstep = (size_t)HALF * K * 2;
    const size_t tstep = 2 * hstep;
    const unsigned ldsw = (unsigned)wid * 1024u;
    const int aoff = lds_byte(wr * 64 + fr, fq * 8), boff = lds_byte(wc * 32 + fr, fq * 8);
#define PG8_SA(b, h) (((b) * 2 + (h)) * HTB)
#define PG8_SB(b, h) ((4 + (b) * 2 + (h)) * HTB)
#define PG8_STAGE(bufoff, gbase, voff) do { _Pragma("unroll") for (int _i = 0; _i < 2; ++_i) \
        __builtin_amdgcn_global_load_lds((const unsigned*)((const char*)(gbase) + (voff)[_i]), (PG8_LAS unsigned*)(lds + (bufoff) + ldsw + _i * 8192), 16, 0, 0); } while (0)
#define PG8_LDA(dst, b, h) do { _Pragma("unroll") for (int m = 0; m < 4; ++m) _Pragma("unroll") for (int k = 0; k < 2; ++k) dst[m][k] = *(const PG8_LAS bf16x8*)(lds + PG8_SA(b, h) + aoff + m * 2048 + k * 1024); } while (0)
#define PG8_LDB(dst, b, h) do { _Pragma("unroll") for (int n = 0; n < 2; ++n) _Pragma("unroll") for (int k = 0; k < 2; ++k) dst[n][k] = *(const PG8_LAS bf16x8*)(lds + PG8_SB(b, h) + boff + n * 2048 + k * 1024); } while (0)
#define PG8_MMA(ai, bj, At, Bt) do { __builtin_amdgcn_s_setprio(1); _Pragma("unroll") for (int m = 0; m < 4; ++m) _Pragma("unroll") for (int n = 0; n < 2; ++n) _Pragma("unroll") for (int k = 0; k < 2; ++k) \
        acc[ai][bj][m][n] = __builtin_amdgcn_mfma_f32_16x16x32_bf16(Bt[n][k], At[m][k], acc[ai][bj][m][n], 0, 0, 0); __builtin_amdgcn_s_setprio(0); } while (0)
#define PG8_WAIT_V(n) asm volatile("s_waitcnt vmcnt(" #n ")" ::: "memory")
#define PG8_WAIT_L(n) asm volatile("s_waitcnt lgkmcnt(" #n ")" ::: "memory")
#define PG8_BAR __builtin_amdgcn_s_barrier()
#define PG8_SCHED __builtin_amdgcn_sched_barrier(0)
    Unit cur, nxt; int ui = 0;
    if (!S.next(0, cur)) return;
    f32x4 acc[2][2][4][2];
#pragma unroll
    for (int a = 0; a < 2; ++a)
#pragma unroll
        for (int b = 0; b < 2; ++b)
#pragma unroll
            for (int m = 0; m < 4; ++m)
#pragma unroll
                for (int n = 0; n < 2; ++n) acc[a][b][m][n] = (f32x4){0.f, 0.f, 0.f, 0.f};
    bf16x8 At[4][2], B0[2][2], B1[2][2];
    const char* cA = (const char*)g.A + (size_t)cur.pm * tstep + (size_t)cur.ko * 2; const char* cB = (const char*)g.Bt + (size_t)cur.pn * tstep + (size_t)cur.ko * 2;
    S.a_ready(cur);
    if constexpr (SP2) {
        PG8_STAGE(PG8_SB(0, 0), cB, voffB); PG8_STAGE(PG8_SB(0, 1), cB + hstep, voffB); PG8_STAGE(PG8_SA(0, 0), cA, voffA); PG8_STAGE(PG8_SA(0, 1), cA + hstep, voffA);
        if (wr == 1) PG8_BAR;
        PG8_WAIT_V(2); PG8_BAR;
        PG8_STAGE(PG8_SB(1, 0), cB + kstep, voffB); PG8_STAGE(PG8_SA(1, 0), cA + kstep, voffA); PG8_STAGE(PG8_SB(1, 1), cB + hstep + kstep, voffB);
        PG8_WAIT_V(6); PG8_BAR;
    } else {
        PG8_STAGE(PG8_SB(0, 0), cB, voffB); PG8_STAGE(PG8_SA(0, 0), cA, voffA); PG8_STAGE(PG8_SB(0, 1), cB + hstep, voffB); PG8_STAGE(PG8_SA(0, 1), cA + hstep, voffA);
        if (wr == 1) PG8_BAR;
        PG8_WAIT_V(4); PG8_BAR;
        PG8_STAGE(PG8_SB(1, 0), cB + kstep, voffB); PG8_STAGE(PG8_SA(1, 0), cA + kstep, voffA); PG8_STAGE(PG8_SB(1, 1), cB + hstep + kstep, voffB);
        PG8_WAIT_V(6); PG8_BAR;
    }
    for (;;) {
        const bool has_next = S.next(ui + 1, nxt);
        const char* nA = has_next ? (const char*)g.A + (size_t)nxt.pm * tstep + (size_t)nxt.ko * 2 : cA; const char* nB = has_next ? (const char*)g.Bt + (size_t)nxt.pn * tstep + (size_t)nxt.ko * 2 : cB;
        const int nt = Sched::PER_UNIT_K ? cur.nt : g.K / BK;
        for (int t = 0; t < nt; t += 2) {
            const bool last = (t == nt - 2);
            const char* a1 = cA + (size_t)(t + 1) * kstep;
            const char* a2 = last ? nA : cA + (size_t)(t + 2) * kstep; const char* b2 = last ? nB : cB + (size_t)(t + 2) * kstep;
            const char* a3 = a2 + kstep; const char* b3 = b2 + kstep;
            if (last && has_next) S.a_ready(nxt);
            if constexpr (SP2) {
            PG8_LDB(B0, 0, 0); PG8_LDB(B1, 0, 1); PG8_SCHED; PG8_LDA(At, 0, 0); PG8_STAGE(PG8_SA(1, 1), a1 + hstep, voffA);
            PG8_WAIT_V(8); PG8_WAIT_L(0); PG8_BAR; PG8_MMA(0, 0, At, B0); PG8_MMA(0, 1, At, B1); PG8_BAR; PG8_SCHED;
            PG8_LDA(At, 0, 1); PG8_STAGE(PG8_SB(0, 0), b2, voffB); PG8_STAGE(PG8_SB(0, 1), b2 + hstep, voffB); PG8_STAGE(PG8_SA(0, 0), a2, voffA);
            PG8_WAIT_V(8); PG8_WAIT_L(0); PG8_BAR; PG8_MMA(1, 0, At, B0); PG8_MMA(1, 1, At, B1); PG8_BAR; PG8_SCHED;
            PG8_LDB(B0, 1, 0); PG8_LDB(B1, 1, 1); PG8_SCHED; PG8_LDA(At, 1, 0); PG8_STAGE(PG8_SA(0, 1), a2 + hstep, voffA);
            PG8_WAIT_V(8); PG8_WAIT_L(0); PG8_BAR; PG8_MMA(0, 0, At, B0); PG8_MMA(0, 1, At, B1); PG8_BAR; PG8_SCHED;
            PG8_LDA(At, 1, 1); PG8_STAGE(PG8_SB(1, 0), b3, voffB); PG8_STAGE(PG8_SB(1, 1), b3 + hstep, voffB); PG8_STAGE(PG8_SA(1, 0), a3, voffA);
            PG8_WAIT_V(8); PG8_WAIT_L(0); PG8_BAR; PG8_MMA(1, 0, At, B0); PG8_MMA(1, 1, At, B1); PG8_BAR; PG8_SCHED;
            } else {
            PG8_LDB(B0, 0, 0); PG8_SCHED; PG8_LDA(At, 0, 0); PG8_STAGE(PG8_SA(1, 1), a1 + hstep, voffA);
            PG8_WAIT_L(8); PG8_BAR; PG8_WAIT_L(0); PG8_MMA(0, 0, At, B0); PG8_BAR; PG8_SCHED;
            PG8_LDB(B1, 0, 1); PG8_STAGE(PG8_SB(0, 0), b2, voffB);
            PG8_BAR; PG8_WAIT_L(0); PG8_MMA(0, 1, At, B1); PG8_BAR;
            PG8_LDA(At, 0, 1); PG8_STAGE(PG8_SA(0, 0), a2, voffA);
            PG8_BAR; PG8_WAIT_L(0); PG8_MMA(1, 0, At, B0); PG8_BAR; PG8_SCHED;
            PG8_STAGE(PG8_SB(0, 1), b2 + hstep, voffB);
            PG8_WAIT_V(6); PG8_BAR; PG8_MMA(1, 1, At, B1); PG8_BAR;
            PG8_LDB(B0, 1, 0); PG8_SCHED; PG8_LDA(At, 1, 0); PG8_STAGE(PG8_SA(0, 1), a2 + hstep, voffA);
            PG8_WAIT_L(8); PG8_BAR; PG8_WAIT_L(0); PG8_MMA(0, 0, At, B0); PG8_BAR; PG8_SCHED;
            PG8_LDB(B1, 1, 1); PG8_STAGE(PG8_SB(1, 0), b3, voffB);
            PG8_BAR; PG8_WAIT_L(0); PG8_MMA(0, 1, At, B1); PG8_BAR;
            PG8_LDA(At, 1, 1); PG8_STAGE(PG8_SA(1, 0), a3, voffA);
            PG8_BAR; PG8_WAIT_L(0); PG8_MMA(1, 0, At, B0); PG8_BAR; PG8_SCHED;
            PG8_STAGE(PG8_SB(1, 1), b3 + hstep, voffB);
            PG8_WAIT_V(6); PG8_BAR; PG8_MMA(1, 1, At, B1); PG8_BAR;
            }
        }
        if constexpr (ALIGN_EPI) { if (wr == 0) PG8_BAR; }
        E(acc, cur, wr, wc, fr, fq);
        if (!has_next) break;
#pragma unroll
        for (int a = 0; a < 2; ++a)
#pragma unroll
            for (int b = 0; b < 2; ++b)
#pragma unroll
                for (int m = 0; m < 4; ++m)
#pragma unroll
                    for (int n = 0; n < 2; ++n) acc[a][b][m][n] = (f32x4){0.f, 0.f, 0.f, 0.f};
        cur = nxt; cA = nA; cB = nB; ++ui;
        if constexpr (ALIGN_EPI) { if (wr == 1) PG8_BAR; }
    }
    PG8_WAIT_V(0);
    if constexpr (!ALIGN_EPI) { if (wr == 0) PG8_BAR; }
    PG8_BAR;
#undef PG8_SA
#undef PG8_SB
#undef PG8_STAGE
#undef PG8_LDA
#undef PG8_LDB
#undef PG8_MMA
#undef PG8_WAIT_V
#undef PG8_WAIT_L
#undef PG8_BAR
#undef PG8_SCHED
}
struct EpiInProj {
    static constexpr bool PERM = true;
    float* PA; bf16_t* QKV;
    __device__ __forceinline__ void operator()(const f32x4 (&acc)[2][2][4][2], const Unit& u, int wr, int wc, int fr, int fq) const {
        const int row0 = u.pm * BM + wr * 64 + fr, colt = u.pn * BM + wc * 32 + 8 * fq;
        if (colt < PAW) {
#pragma unroll
            for (int ai = 0; ai < 2; ++ai)
#pragma unroll
                for (int m = 0; m < 4; ++m) { float* rp = PA + (size_t)(row0 + ai * HALF + m * 16) * PAW + colt;
#pragma unroll
                    for (int bj = 0; bj < 2; ++bj) { *(f32x4*)(rp + bj * HALF) = acc[ai][bj][m][0]; *(f32x4*)(rp + bj * HALF + 4) = acc[ai][bj][m][1]; } }
        } else {
#pragma unroll
            for (int ai = 0; ai < 2; ++ai)
#pragma unroll
                for (int m = 0; m < 4; ++m) { bf16_t* rp = QKV + (size_t)(row0 + ai * HALF + m * 16) * QKVW + (colt - PAW);
#pragma unroll
                    for (int bj = 0; bj < 2; ++bj) { const f32x4 v0 = acc[ai][bj][m][0], v1 = acc[ai][bj][m][1];
                        u32x4 w; w.x = cvt_pk_bf16(v0[0], v0[1]); w.y = cvt_pk_bf16(v0[2], v0[3]); w.z = cvt_pk_bf16(v1[0], v1[1]); w.w = cvt_pk_bf16(v1[2], v1[3]);
                        *(u32x4*)(rp + bj * HALF) = w; } }
        }
    }
};
struct EpiResidual {
    static constexpr bool PERM = true;
    float* Z;
    __device__ __forceinline__ void operator()(const f32x4 (&acc)[2][2][4][2], const Unit& u, int wr, int wc, int fr, int fq) const {
        const int row0 = u.pm * BM + wr * 64 + fr, colt = u.pn * BM + wc * 32 + 8 * fq;
#pragma unroll
        for (int ai = 0; ai < 2; ++ai)
#pragma unroll
            for (int m = 0; m < 4; ++m) { const int row = row0 + ai * HALF + m * 16; if (row < TOK) { float* rp = Z + (size_t)row * DM + colt;
#pragma unroll
                for (int bj = 0; bj < 2; ++bj) { f32x4* p0 = (f32x4*)(rp + bj * HALF); f32x4* p1 = (f32x4*)(rp + bj * HALF + 4);
                    const f32x4 z0 = *p0, z1 = *p1; *p0 = z0 + acc[ai][bj][m][0]; *p1 = z1 + acc[ai][bj][m][1]; } } }
    }
};
struct OutOrder {
    static constexpr bool PER_UNIT_K = true;
    StaticOrder main;
    __device__ bool next(int i, Unit& u) const {
        if (main.next(i, u)) return true;
        const int r0 = (main.nwg + main.G - 1) / main.G;
        const int L = (i - r0) * main.G + main.c; if (i < r0 || L >= 64) return false;
        u.pm = 32; u.pn = L & 7; u.ko = (L >> 3) * 256; u.nt = 4; return true; }
    __device__ __forceinline__ void a_ready(const Unit&) const {}
    __device__ __forceinline__ void done(const Unit&) const {}
};
struct EpiOutProj {
    static constexpr bool PERM = true;
    float* Z; float* ZP;
    __device__ __forceinline__ void operator()(const f32x4 (&acc)[2][2][4][2], const Unit& u, int wr, int wc, int fr, int fq) const {
        const bool tail = u.pm == 32;
        const int row0 = (tail ? (u.ko >> 8) * BM : u.pm * BM) + wr * 64 + fr, colt = u.pn * BM + wc * 32 + 8 * fq;
        float* base = tail ? ZP : Z;
#pragma unroll
        for (int ai = 0; ai < 2; ++ai)
#pragma unroll
            for (int m = 0; m < 4; ++m) { float* rp = base + (size_t)(row0 + ai * HALF + m * 16) * DM + colt;
#pragma unroll
                for (int bj = 0; bj < 2; ++bj) { f32x4* p0 = (f32x4*)(rp + bj * HALF); f32x4* p1 = (f32x4*)(rp + bj * HALF + 4);
                    f32x4 z0 = {0.f, 0.f, 0.f, 0.f}, z1 = {0.f, 0.f, 0.f, 0.f};
                    if (!tail) { z0 = *p0; z1 = *p1; }
                    *p0 = z0 + acc[ai][bj][m][0]; *p1 = z1 + acc[ai][bj][m][1]; } }
    }
};
struct EpiGlu {
    static constexpr bool PERM = true;
    bf16_t* MIX; const float* bias;
    __device__ __forceinline__ void operator()(const f32x4 (&acc)[2][2][4][2], const Unit& u, int wr, int wc, int fr, int fq) const {
        const int row0 = u.pm * BM + wr * 64 + fr, c0 = u.pn * HALF + wc * 32 + 8 * fq;
        const f32x4 bv0 = *(const f32x4*)(bias + c0), bv1 = *(const f32x4*)(bias + c0 + 4), bg0 = *(const f32x4*)(bias + 512 + c0), bg1 = *(const f32x4*)(bias + 512 + c0 + 4);
#pragma unroll
        for (int ai = 0; ai < 2; ++ai)
#pragma unroll
            for (int m = 0; m < 4; ++m) { const f32x4 v0 = acc[ai][0][m][0] + bv0, v1 = acc[ai][0][m][1] + bv1, g0 = acc[ai][1][m][0] + bg0, g1 = acc[ai][1][m][1] + bg1;
                float o[8];
#pragma unroll
                for (int e = 0; e < 4; ++e) { o[e] = v0[e] / (1.f + __expf(-g0[e])); o[4 + e] = v1[e] / (1.f + __expf(-g1[e])); }
                u32x4 w; w.x = cvt_pk_bf16(o[0], o[1]); w.y = cvt_pk_bf16(o[2], o[3]); w.z = cvt_pk_bf16(o[4], o[5]); w.w = cvt_pk_bf16(o[6], o[7]);
                *(u32x4*)(MIX + (size_t)(row0 + ai * HALF + m * 16) * DM + 512 + c0) = w; }
    }
};
}

__device__ __forceinline__ void transpose_item(const float* W, int K, int N, bf16_t* WT, int k0, int n0, int row0, float* scr, int lane) {
#pragma unroll 8
    for (int i = 0; i < 32; ++i) { const int kk = 2 * i + (lane >> 5); scr[kk * 33 + (lane & 31)] = W[(size_t)(k0 + kk) * N + n0 + (lane & 31)]; }
    asm volatile("s_waitcnt lgkmcnt(0)" ::: "memory");
    const int c = lane & 7;
#pragma unroll
    for (int j = 0; j < 4; ++j) { const int n = (lane >> 3) + 8 * j; const float* sp = scr + (8 * c) * 33 + n;
        pg8::u32x4 o; o.x = pg8::cvt_pk_bf16(sp[0 * 33], sp[1 * 33]); o.y = pg8::cvt_pk_bf16(sp[2 * 33], sp[3 * 33]); o.z = pg8::cvt_pk_bf16(sp[4 * 33], sp[5 * 33]); o.w = pg8::cvt_pk_bf16(sp[6 * 33], sp[7 * 33]);
        *(pg8::u32x4*)(WT + (size_t)(row0 + n) * K + k0 + 8 * c) = o; }
    asm volatile("s_waitcnt lgkmcnt(0)" ::: "memory");
}
__device__ __forceinline__ void ph_weights(KP P, char* lds) {
    const int tid = tid_(), lane = tid & 63, wave = tid >> 6;
    float* scr = (float*)lds + wave * (64 * 33);
    const int gw = bid_() * 8 + wave, NGW = gridDim.x * 8;
    constexpr int I_IN = (DM / 64) * (INW / 32), I_OUT = (DM / 64) * (DM / 32), I_GLU = (512 / 64) * (1024 / 32), I_L = I_IN + I_OUT + I_GLU;
    for (int it = gw; it < 2 * I_L; it += NGW) {
        const int layer = it / I_L; int r = it % I_L;
        if (r < I_IN) { const int nb = INW / 32, kb = r / nb, n0 = (r % nb) * 32;
            transpose_item(P->w_in + (size_t)layer * DM * INW, DM, INW, P->WinT + (size_t)layer * INW * DM, kb * 64, n0, n0, scr, lane); continue; }
        r -= I_IN;
        if (r < I_OUT) { const int nb = DM / 32, kb = r / nb, n0 = (r % nb) * 32;
            transpose_item(P->w_out + (size_t)layer * DM * DM, DM, DM, P->WoutT + (size_t)layer * DM * DM, kb * 64, n0, n0, scr, lane); continue; }
        r -= I_OUT;
        { const int nb = 1024 / 32, kb = r / nb, n0 = (r % nb) * 32;
          const int row0 = ((n0 & 511) >> 7) * 256 + (n0 >> 9) * 128 + (n0 & 127);
          transpose_item(P->w_glu + (size_t)layer * 512 * 1024, 512, 1024, P->WgluT + (size_t)layer * 1024 * 512, kb * 64, n0, row0, scr, lane); }
    }
}


namespace fa {
using bf16x8 = __attribute__((ext_vector_type(8))) short;
using s16x4  = __attribute__((ext_vector_type(4))) short;
using f32x16 = __attribute__((ext_vector_type(16))) float;
using u32x4  = __attribute__((ext_vector_type(4))) unsigned;
constexpr int D = 128, NW = 8, QBLK = 32, KVBLK = 64, LDQK = QKVW;
constexpr float SCALE = 0.088388347648318440f, THR = 8.f, NEG = -1e30f;
constexpr size_t SHM_V = KVBLK * D * 2, SHM_K = KVBLK * D * 2, SHM_ATTN = 2 * SHM_V + 2 * SHM_K + NW * 64 * 4;
#define KSWZ(row, colB) ((row) * 256 + ((colB) ^ (((row) & 7) << 4)))
#define SBAR() __builtin_amdgcn_sched_barrier(0)
__device__ __forceinline__ int crow(int r, int hi) { return (r & 3) + 8 * (r >> 2) + 4 * hi; }
__device__ __forceinline__ unsigned cvtpk(float lo, float hi) { unsigned r; asm volatile("v_cvt_pk_bf16_f32 %0, %1, %2" : "=v"(r) : "v"(lo), "v"(hi)); return r; }
__device__ __forceinline__ void partialSM(f32x16& p0, f32x16& p1, float& m_reg, float& mn, float& alpha) {
  constexpr float C = SCALE * 1.4426950408889634f;
  float pmax = p0[0]; for (int r = 1; r < 16; ++r) pmax = fmaxf(pmax, p0[r]); for (int r = 0; r < 16; ++r) pmax = fmaxf(pmax, p1[r]);
  { auto rr = __builtin_amdgcn_permlane32_swap(__float_as_uint(pmax), __float_as_uint(pmax), false, false);
    pmax = fmaxf(__uint_as_float(rr[0]), __uint_as_float(rr[1])); }
  if (__builtin_expect(__all(pmax - m_reg <= THR / SCALE), 1)) { mn = m_reg; alpha = 1.f; }
  else { mn = fmaxf(m_reg, pmax); alpha = __builtin_amdgcn_exp2f((m_reg - mn) * C); m_reg = mn; }
  float mnC = -mn * C;
  for (int r = 0; r < 16; ++r) p0[r] = fmaf(p0[r], C, mnC); for (int r = 0; r < 16; ++r) p1[r] = fmaf(p1[r], C, mnC);
  for (int r = 0; r < 16; ++r) p0[r] = __builtin_amdgcn_exp2f(p0[r]);
}
__device__ __forceinline__ void finishSM(f32x16& p0, f32x16& p1, float alpha, float& l_reg, bf16x8& pa0, bf16x8& pa1, bf16x8& pa2, bf16x8& pa3) {
  for (int r = 0; r < 16; ++r) p1[r] = __builtin_amdgcn_exp2f(p1[r]);
  float ps = 0; for (int r = 0; r < 16; ++r) ps += p0[r]; for (int r = 0; r < 16; ++r) ps += p1[r];
  { auto rr = __builtin_amdgcn_permlane32_swap(__float_as_uint(ps), __float_as_uint(ps), false, false);
    ps = __uint_as_float(rr[0]) + __uint_as_float(rr[1]); }
  l_reg = l_reg * alpha + ps;
#define PK4(P, BASE, OUT) do { unsigned a0 = cvtpk(P[BASE + 0], P[BASE + 1]), a1 = cvtpk(P[BASE + 2], P[BASE + 3]);   \
    unsigned b0 = cvtpk(P[BASE + 4], P[BASE + 5]), b1 = cvtpk(P[BASE + 6], P[BASE + 7]);                              \
    auto r0 = __builtin_amdgcn_permlane32_swap(a0, b0, false, false); auto r1 = __builtin_amdgcn_permlane32_swap(a1, b1, false, false); \
    u32x4 w = {r0[0], r1[0], r0[1], r1[1]}; OUT = *reinterpret_cast<bf16x8*>(&w); } while (0)
  PK4(p0, 0, pa0); PK4(p0, 8, pa1); PK4(p1, 0, pa2); PK4(p1, 8, pa3);
#undef PK4
}
__device__ __forceinline__ void qkt(f32x16& p0, f32x16& p1, const bf16_t* Ks, const bf16x8* qr, int r32, int hi) {
  p0 = f32x16{}; p1 = f32x16{};
  for (int d0 = 0; d0 < 8; ++d0) { int cb = (d0 * 16 + hi * 8) * 2;
    bf16x8 b0 = *reinterpret_cast<const bf16x8*>((const char*)Ks + KSWZ(r32, cb));
    bf16x8 b1 = *reinterpret_cast<const bf16x8*>((const char*)Ks + KSWZ(32 + r32, cb));
    p0 = __builtin_amdgcn_mfma_f32_32x32x16_bf16(b0, qr[d0], p0, 0, 0, 0);
    p1 = __builtin_amdgcn_mfma_f32_32x32x16_bf16(b1, qr[d0], p1, 0, 0, 0); }
}
__device__ __forceinline__ void mask_tile(f32x16& p0, f32x16& p1, int kt, int vis) {
  if (kt > vis) {
    const bool part = (kt == vis + 1);
    for (int r = 0; r < 16; ++r) p1[r] = NEG;
    for (int r = 8; r < 16; ++r) p0[r] = NEG;
    if (!part) for (int r = 0; r < 8; ++r) p0[r] = NEG;
  }
}
__device__ __forceinline__ int v_st(int k, int c) { const int kk = (k & ~0xC) | ((k & 4) << 1) | ((k & 8) >> 1); return ((kk >> 3) * 4 + (c >> 5)) * 512 + ((kk & 7) * 32 + (c & 31)) * 2; }
__device__ __forceinline__ int v_rd_base(int lane) { return ((lane & 3) << 3) | (((lane >> 2) & 3) << 6) | (((lane >> 4) & 1) << 5) | (((lane >> 5) & 1) << 8); }
constexpr int v_rd_off(int d0, int ks, int half) { return d0 * 512 + ks * 4096 + half * 2048; }
template <int OFF> __device__ __forceinline__ s16x4 tr_read(int vb) {
  s16x4 r; asm volatile("ds_read_b64_tr_b16 %0, %1 offset:%2" : "=&v"(r) : "v"(vb), "i"(OFF) : "memory"); return r;
}
template <int D0> __device__ __forceinline__ void pv_one(f32x16& od, int vb, bf16x8 pa0, bf16x8 pa1, bf16x8 pa2, bf16x8 pa3) {
  const s16x4 l0 = tr_read<v_rd_off(D0, 0, 0)>(vb), h0 = tr_read<v_rd_off(D0, 0, 1)>(vb), l1 = tr_read<v_rd_off(D0, 1, 0)>(vb), h1 = tr_read<v_rd_off(D0, 1, 1)>(vb);
  const s16x4 l2 = tr_read<v_rd_off(D0, 2, 0)>(vb), h2 = tr_read<v_rd_off(D0, 2, 1)>(vb), l3 = tr_read<v_rd_off(D0, 3, 0)>(vb), h3 = tr_read<v_rd_off(D0, 3, 1)>(vb);
  asm volatile("s_waitcnt lgkmcnt(0)" ::: "memory"); SBAR();
#define PK(L, H) (bf16x8){L[0], L[1], L[2], L[3], H[0], H[1], H[2], H[3]}
  od = __builtin_amdgcn_mfma_f32_32x32x16_bf16(pa0, PK(l0, h0), od, 0, 0, 0);
  od = __builtin_amdgcn_mfma_f32_32x32x16_bf16(pa1, PK(l1, h1), od, 0, 0, 0);
  od = __builtin_amdgcn_mfma_f32_32x32x16_bf16(pa2, PK(l2, h2), od, 0, 0, 0);
  od = __builtin_amdgcn_mfma_f32_32x32x16_bf16(pa3, PK(l3, h3), od, 0, 0, 0);
#undef PK
}
__device__ __forceinline__ void pv_d0(f32x16* o, int vb, bf16x8 pa0, bf16x8 pa1, bf16x8 pa2, bf16x8 pa3) {
  pv_one<0>(o[0], vb, pa0, pa1, pa2, pa3); pv_one<1>(o[1], vb, pa0, pa1, pa2, pa3); pv_one<2>(o[2], vb, pa0, pa1, pa2, pa3); pv_one<3>(o[3], vb, pa0, pa1, pa2, pa3);
}
__device__ __forceinline__ void attn_unit(const bf16_t* __restrict__ Qb, const bf16_t* __restrict__ Kh, const bf16_t* __restrict__ Vh, float* __restrict__ Ob, int NT, int vis4, char* lds) {
  const int tid = tid_(), wid = tid >> 6, lane = tid & 63, r32 = lane & 31, hi = lane >> 5;
  const int vis = vis4 + (wid >> 1);
  bf16_t* V_lds = (bf16_t*)lds; bf16_t* K_lds = (bf16_t*)(lds + 2 * SHM_V);
  float* ws = (float*)(lds + 2 * SHM_V + 2 * SHM_K) + wid * 64; float* li_l = ws; float* al_l = ws + 32;
  float m_reg = NEG, l_reg = 0; f32x16 o[4] = {}; bf16x8 qr[8];
  const bf16_t* Qw = Qb + (long)(wid * QBLK + r32) * LDQK + hi * 8;
#pragma unroll
  for (int d0 = 0; d0 < 8; ++d0) qr[d0] = *reinterpret_cast<const bf16x8*>(Qw + d0 * 16);
  const int sr = tid >> 4, sc = (tid & 15) * 8, vst0 = v_st(sr, sc), vst1 = v_st(32 + sr, sc);
  const int vb0 = (int)(uintptr_t)V_lds + v_rd_base(lane);
  struct { bf16x8 vs0, vs1, ks0, ks1; } sr_[2];
#define SLOAD(i, k0) do { sr_[i].vs0 = *reinterpret_cast<const bf16x8*>(&Vh[(long)((k0) + sr) * LDQK + sc]); sr_[i].vs1 = *reinterpret_cast<const bf16x8*>(&Vh[(long)((k0) + 32 + sr) * LDQK + sc]); \
    sr_[i].ks0 = *reinterpret_cast<const bf16x8*>(&Kh[(long)((k0) + sr) * LDQK + sc]); sr_[i].ks1 = *reinterpret_cast<const bf16x8*>(&Kh[(long)((k0) + 32 + sr) * LDQK + sc]); } while (0)
#define SWRITE(b, i) do { *(bf16x8*)((char*)V_lds + (b) * SHM_V + vst0) = sr_[i].vs0;          \
    *(bf16x8*)((char*)V_lds + (b) * SHM_V + vst1) = sr_[i].vs1; int kc = sc * 2;               \
    *(bf16x8*)((char*)K_lds + (b) * SHM_K + KSWZ(sr, kc)) = sr_[i].ks0;                       \
    *(bf16x8*)((char*)K_lds + (b) * SHM_K + KSWZ(32 + sr, kc)) = sr_[i].ks1; } while (0)
#define SWAIT() asm volatile("s_waitcnt vmcnt(4)" ::: "memory")
#define RESC(a) do { if (__any((a) < 1.f)) { if (hi == 0) al_l[r32] = (a); asm volatile("s_waitcnt lgkmcnt(0)" ::: "memory"); \
    for (int d = 0; d < 4; ++d) for (int r = 0; r < 16; ++r) o[d][r] *= al_l[crow(r, hi)]; } } while (0)
  f32x16 pA0, pA1, pB0, pB1; float mnA, mnB, alA, alB; bf16x8 pa0, pa1, pa2, pa3;
  constexpr int SE = 0, SO = 1;
  SLOAD(SE, 0); asm volatile("s_waitcnt vmcnt(0)" ::: "memory"); SWRITE(0, SE); __syncthreads();
  qkt(pA0, pA1, K_lds, qr, r32, hi); mask_tile(pA0, pA1, 0, vis); partialSM(pA0, pA1, m_reg, mnA, alA);
  SLOAD(SO, KVBLK); if (2 < NT) SLOAD(SE, 2 * KVBLK);
  SWAIT(); SWRITE(1, SO); __syncthreads();
  for (int j = 1; j + 1 < NT; j += 2) {
    SBAR(); qkt(pB0, pB1, (bf16_t*)((char*)K_lds + SHM_K), qr, r32, hi); mask_tile(pB0, pB1, j, vis);
    finishSM(pA0, pA1, alA, l_reg, pa0, pa1, pa2, pa3); SBAR();
    SLOAD(SO, (j + 2) * KVBLK); SBAR();
    pv_d0(o, vb0, pa0, pa1, pa2, pa3); partialSM(pB0, pB1, m_reg, mnB, alB);
    __syncthreads(); SWAIT(); SWRITE(0, SE);
    RESC(alB); __syncthreads();
    SBAR(); qkt(pA0, pA1, K_lds, qr, r32, hi); mask_tile(pA0, pA1, j + 1, vis);
    finishSM(pB0, pB1, alB, l_reg, pa0, pa1, pa2, pa3); SBAR();
    if (j + 3 < NT) SLOAD(SE, (j + 3) * KVBLK); SBAR();
    pv_d0(o, vb0 + (int)SHM_V, pa0, pa1, pa2, pa3); partialSM(pA0, pA1, m_reg, mnA, alA);
    __syncthreads(); SWAIT(); SWRITE(1, SO);
    RESC(alA); __syncthreads();
  }
  SBAR(); qkt(pB0, pB1, (bf16_t*)((char*)K_lds + SHM_K), qr, r32, hi); mask_tile(pB0, pB1, NT - 1, vis);
  finishSM(pA0, pA1, alA, l_reg, pa0, pa1, pa2, pa3); SBAR();
  pv_d0(o, vb0, pa0, pa1, pa2, pa3); partialSM(pB0, pB1, m_reg, mnB, alB);
  __syncthreads(); RESC(alB);
  finishSM(pB0, pB1, alB, l_reg, pa0, pa1, pa2, pa3); SBAR();
  pv_d0(o, vb0 + (int)SHM_V, pa0, pa1, pa2, pa3);
  if (hi == 0) li_l[r32] = l_reg; asm volatile("s_waitcnt lgkmcnt(0)" ::: "memory");
  float rli[16];
#pragma unroll
  for (int r = 0; r < 16; ++r) rli[r] = __builtin_amdgcn_rcpf(li_l[crow(r, hi)]);
  float* Ow = Ob + (long)(wid * QBLK) * DM;
#pragma unroll
  for (int r = 0; r < 16; ++r) { int orow = crow(r, hi);
    for (int d0 = 0; d0 < 4; ++d0) Ow[(long)orow * DM + d0 * 32 + r32] = o[d0][r] * rli[r]; }
  __syncthreads();
#undef SLOAD
#undef SWRITE
#undef SWAIT
#undef RESC
}
#undef KSWZ
#undef SBAR
}

__device__ __forceinline__ void ph_attention(KP P, char* lds) {
    const bf16_t* QKV = P->QKV; float* OC = P->OC;
    const int c = bid_();
    if (c < 256) {
        const int combo = c >> 2, b = combo >> 4, h = (combo >> 2) & 3, i = (combo >> 1) & 1, vh = combo & 1;
        const bf16_t* Kh = QKV + (size_t)(b * LL) * QKVW + 1024 + h * 256 + i * 128;
        const bf16_t* Vh = QKV + (size_t)(b * LL) * QKVW + 2048 + h * 256 + vh * 128;
#pragma unroll 1
        for (int s = 0; s < 2; ++s) {
            const int jb = s == 0 ? (c & 3) : 7 - (c & 3);
            const size_t row0 = (size_t)(b * LL) + NMETA + 256 * jb;
            fa::attn_unit(QKV + row0 * QKVW + h * 256 + i * 128, Kh, Vh, OC + row0 * DM + h * 512 + i * 256 + vh * 128, 4 * jb + 6, 4 * jb, lds);
        }
    }
    {
        const int tid = tid_(), lane = tid & 63, gw = c * 8 + (tid >> 6);
        if (gw < 512) {
            const int b = gw >> 7, h = (gw >> 5) & 3, i = (gw >> 4) & 1, row = gw & 15;
            const bf16_t* q = QKV + (size_t)(b * LL + row) * QKVW + h * 256 + i * 128;
            const int key = lane & 15;
            const bf16_t* k = QKV + (size_t)(b * LL + key) * QKVW + 1024 + h * 256 + i * 128;
            float sc = 0.f;
            for (int d = 0; d < 128; ++d) sc = fmaf(bf2f(q[d]), bf2f(k[d]), sc);
            sc *= 0.08838834764831845f;
            float m = sc;
#pragma unroll
            for (int o = 8; o > 0; o >>= 1) m = fmaxf(m, __shfl_xor(m, o));
            const float e = expf(sc - m);
            float ssum = e;
#pragma unroll
            for (int o = 8; o > 0; o >>= 1) ssum += __shfl_xor(ssum, o);
            const float p = e / ssum;
            float acc[4] = {0.f, 0.f, 0.f, 0.f};
#pragma unroll
            for (int j = 0; j < 16; ++j) {
                const float pj = __int_as_float(__builtin_amdgcn_readlane(__float_as_int(p), j));
                const bf16_t* v = QKV + (size_t)(b * LL + j) * QKVW + 2048 + h * 256 + lane * 4;
#pragma unroll
                for (int e2 = 0; e2 < 4; ++e2) acc[e2] = fmaf(pj, bf2f(v[e2]), acc[e2]);
            }
            float* o = OC + (size_t)(b * LL + row) * DM + h * 512 + i * 256 + lane * 4;
            o[0] = acc[0]; o[1] = acc[1]; o[2] = acc[2]; o[3] = acc[3];
        }
    }
}


namespace hg {
using bf16x8 = __attribute__((ext_vector_type(8))) short;
using s16x4  = __attribute__((ext_vector_type(4))) short;
using f32x16 = __attribute__((ext_vector_type(16))) float;
using u32x4  = __attribute__((ext_vector_type(4))) unsigned;
constexpr int NCH = 33, NU = 16 * NCH;
constexpr int SK = 136;
constexpr int SS = 72;
__device__ __forceinline__ int crow(int r, int hi) { return (r & 3) + 8 * (r >> 2) + 4 * hi; }
__device__ __forceinline__ unsigned cvtpk(float lo, float hi) { unsigned r; asm volatile("v_cvt_pk_bf16_f32 %0, %1, %2" : "=v"(r) : "v"(lo), "v"(hi)); return r; }

__device__ __forceinline__ void prep(const float* PA, const float* lbtab, size_t row0, int c, int h, int k, int tq, float* qsum, float (&b)[16], float (&kk)[16], float& bend, float& r) {
    const float lbv = lbtab[h * 128 + k];
    float run = 0.f;
#pragma unroll
    for (int i = 0; i < 16; ++i) {
        const int t = 16 * tq + i; const bool valid = (c * 64 + t) < LL;
        const float fp = valid ? PA[(row0 + t) * PAW + 512 + h * 128 + k] : 0.f;
        const float kv = valid ? (1.f - lbv) / (1.f + __expf(fp)) : 0.f;
        kk[i] = kv; run += fmaxf(log1pf(-kv), -30.f); b[i] = run;
    }
    qsum[tq * 128 + k] = run;
    __syncthreads();
    const float q0 = qsum[k], q1 = qsum[128 + k], q2 = qsum[256 + k], q3 = qsum[384 + k];
    const float off = tq == 0 ? 0.f : (tq == 1 ? q0 : (tq == 2 ? q0 + q1 : q0 + q1 + q2));
    r = q0 + q1; bend = (q0 + q1) + (q2 + q3);
#pragma unroll
    for (int i = 0; i < 16; ++i) b[i] += off;
}
__device__ __forceinline__ void store16(bf16_t* dst, const float (&x)[16]) {
    u32x4 w0, w1;
    w0.x = cvtpk(x[0], x[1]); w0.y = cvtpk(x[2], x[3]); w0.z = cvtpk(x[4], x[5]); w0.w = cvtpk(x[6], x[7]);
    w1.x = cvtpk(x[8], x[9]); w1.y = cvtpk(x[10], x[11]); w1.z = cvtpk(x[12], x[13]); w1.w = cvtpk(x[14], x[15]);
    *(u32x4*)dst = w0; *(u32x4*)(dst + 8) = w1;
}

__device__ __forceinline__ void local_states(KP P, char* lds, int layer) {
    bf16_t* KhT = (bf16_t*)lds; bf16_t* VT = KhT + 128 * SS; float* qsum = (float*)(VT + 128 * SS);
    const float* PA = P->PA; const float* lbtab = P->lbtab + layer * 512; float* SLOC = P->SLOC; float* DEC = P->DEC;
    const int tid = tid_(), k = tid & 127, tq = tid >> 7, lane = tid & 63, wid = tid >> 6, r32 = lane & 31, hh = lane >> 5;
    for (int u = bid_(); u < NU; u += gridDim.x) {
        const int bh = u / NCH, c = u % NCH, b_ = bh >> 2, h = bh & 3; const size_t row0 = (size_t)b_ * LL + c * 64;
        float b[16], kk[16], bend, r;
        prep(PA, lbtab, row0, c, h, k, tq, qsum, b, kk, bend, r);
        float x[16];
#pragma unroll
        for (int i = 0; i < 16; ++i) x[i] = kk[i] * __expf(bend - b[i]);
        store16(KhT + k * SS + 16 * tq, x);
#pragma unroll
        for (int i = 0; i < 16; ++i) { const int t = 16 * tq + i; x[i] = (c * 64 + t) < LL ? PA[(row0 + t) * PAW + 1024 + h * 128 + k] : 0.f; }
        store16(VT + k * SS + 16 * tq, x);
        if (tq == 0) DEC[u * 128 + k] = __expf(bend);
        __syncthreads();
        const int vt = wid >> 1;
#pragma unroll
        for (int j = 0; j < 2; ++j) {
            const int kt = (wid & 1) * 2 + j;
            f32x16 acc = {};
#pragma unroll
            for (int sg = 0; sg < 4; ++sg) {
                const bf16x8 a = *(const bf16x8*)(VT + (vt * 32 + r32) * SS + sg * 16 + hh * 8);
                const bf16x8 bb = *(const bf16x8*)(KhT + (kt * 32 + r32) * SS + sg * 16 + hh * 8);
                acc = __builtin_amdgcn_mfma_f32_32x32x16_bf16(a, bb, acc, 0, 0, 0);
            }
            float* o = SLOC + (size_t)u * 16384 + kt * 32 + r32;
#pragma unroll
            for (int rg = 0; rg < 16; ++rg) o[(vt * 32 + crow(rg, hh)) * 128] = acc[rg];
        }
        __syncthreads();
    }
}
__device__ __forceinline__ void scan_states(KP P) {
    const float* SLOC = P->SLOC; const float* DEC = P->DEC; bf16_t* SPREV = P->SPREV;
    const int tid = tid_();
    for (int e = bid_() * NTHR + tid; e < 16 * 16384; e += gridDim.x * NTHR) {
        const int bh = e >> 14, vk = e & 16383, k = vk & 127;
        float d[NCH - 1], x[NCH - 1];
#pragma unroll
        for (int c = 0; c < NCH - 1; ++c) { const int u = bh * NCH + c; d[c] = DEC[u * 128 + k]; x[c] = SLOC[(size_t)u * 16384 + vk]; }
        float S = 0.f;
#pragma unroll
        for (int c = 0; c < NCH - 1; ++c) { S = fmaf(d[c], S, x[c]); SPREV[(size_t)(bh * NCH + c + 1) * 16384 + vk] = f2bf(S); }
    }
}
__device__ __forceinline__ void outputs(KP P, char* lds, int layer) {
    bf16_t* Qt = (bf16_t*)lds; bf16_t* Qh = Qt + 64 * SK; bf16_t* Kt = Qh + 64 * SK; bf16_t* VT = Kt + 64 * SK; bf16_t* SpT = VT + 128 * SS;
    float* qsum = (float*)(SpT + 128 * SK); float* part = qsum + 512;
    const float* PA = P->PA; const float* lbtab = P->lbtab + layer * 512; const bf16_t* SPREV = P->SPREV; const float* nw = P->hnw + layer * 128; bf16_t* MIX = P->MIX;
    const int tid = tid_(), k = tid & 127, tq = tid >> 7, lane = tid & 63, wid = tid >> 6, r32 = lane & 31, hh = lane >> 5;
    for (int u = bid_(); u < NU; u += gridDim.x) {
        const int bh = u / NCH, c = u % NCH, b_ = bh >> 2, h = bh & 3; const size_t row0 = (size_t)b_ * LL + c * 64;
        float b[16], kk[16], bend, r;
        prep(PA, lbtab, row0, c, h, k, tq, qsum, b, kk, bend, r);
#pragma unroll
        for (int i = 0; i < 16; ++i) { const int t = 16 * tq + i; const bool valid = (c * 64 + t) < LL;
            const float q = valid ? PA[(row0 + t) * PAW + h * 128 + k] : 0.f;
            Qt[t * SK + k] = f2bf(q * __expf(b[i] - r)); Qh[t * SK + k] = f2bf(q * __expf(b[i])); Kt[t * SK + k] = f2bf(kk[i] * __expf(r - b[i])); }
        { float x[16];
#pragma unroll
          for (int i = 0; i < 16; ++i) { const int t = 16 * tq + i; x[i] = (c * 64 + t) < LL ? PA[(row0 + t) * PAW + 1024 + h * 128 + k] : 0.f; }
          store16(VT + k * SS + 16 * tq, x); }
        if (c > 0) {
#pragma unroll
            for (int j = 0; j < 4; ++j) { const int idx = tid + 512 * j, v = idx >> 4, ch = idx & 15;
                *(u32x4*)(SpT + v * SK + ch * 8) = *(const u32x4*)(SPREV + (size_t)u * 16384 + v * 128 + ch * 8); }
        }
        __syncthreads();
        const int tt = wid & 1, vt = wid >> 1;
        f32x16 oacc = {};
#pragma unroll
        for (int st = 0; st < 2; ++st) {
            if (st <= tt) {
                f32x16 sc = {};
#pragma unroll
                for (int d0 = 0; d0 < 8; ++d0) {
                    const bf16x8 a = *(const bf16x8*)(Kt + (st * 32 + r32) * SK + d0 * 16 + hh * 8);
                    const bf16x8 bq = *(const bf16x8*)(Qt + (tt * 32 + r32) * SK + d0 * 16 + hh * 8);
                    sc = __builtin_amdgcn_mfma_f32_32x32x16_bf16(a, bq, sc, 0, 0, 0);
                }
                if (st == tt) {
#pragma unroll
                    for (int rg = 0; rg < 16; ++rg) sc[rg] = (crow(rg, hh) <= r32) ? sc[rg] : 0.f;
                }
#pragma unroll
                for (int g = 0; g < 2; ++g) {
                    u32x4 w; w.x = cvtpk(sc[8 * g + 0], sc[8 * g + 1]); w.y = cvtpk(sc[8 * g + 2], sc[8 * g + 3]); w.z = cvtpk(sc[8 * g + 4], sc[8 * g + 5]); w.w = cvtpk(sc[8 * g + 6], sc[8 * g + 7]);
                    const bf16x8 pb = *reinterpret_cast<bf16x8*>(&w);
                    const bf16_t* vp = VT + (vt * 32 + r32) * SS + st * 32 + 16 * g + 4 * hh;
                    const s16x4 lo = *(const s16x4*)vp, hi4 = *(const s16x4*)(vp + 8);
                    const bf16x8 a = (bf16x8){lo[0], lo[1], lo[2], lo[3], hi4[0], hi4[1], hi4[2], hi4[3]};
                    oacc = __builtin_amdgcn_mfma_f32_32x32x16_bf16(a, pb, oacc, 0, 0, 0);
                }
            }
        }
        if (c > 0) {
#pragma unroll
            for (int d0 = 0; d0 < 8; ++d0) {
                const bf16x8 a = *(const bf16x8*)(SpT + (vt * 32 + r32) * SK + d0 * 16 + hh * 8);
                const bf16x8 bq = *(const bf16x8*)(Qh + (tt * 32 + r32) * SK + d0 * 16 + hh * 8);
                oacc = __builtin_amdgcn_mfma_f32_32x32x16_bf16(a, bq, oacc, 0, 0, 0);
            }
        }
        float ss = 0.f;
#pragma unroll
        for (int rg = 0; rg < 16; ++rg) ss = fmaf(oacc[rg], oacc[rg], ss);
        { auto rr = __builtin_amdgcn_permlane32_swap(__float_as_uint(ss), __float_as_uint(ss), false, false); ss = __uint_as_float(rr[0]) + __uint_as_float(rr[1]); }
        if (hh == 0) part[vt * 64 + tt * 32 + r32] = ss;
        __syncthreads();
        const int t = tt * 32 + r32;
        const float tot = (part[t] + part[64 + t]) + (part[128 + t] + part[192 + t]);
        const float scale = rsqrtf(tot * (1.f / 128.f) + EPS);
        if ((c * 64 + t) < LL) {
            const float* gp = PA + (row0 + t) * PAW + 1536 + h * 128 + vt * 32;
            bf16_t* op = MIX + (row0 + t) * DM + h * 128 + vt * 32;
#pragma unroll
            for (int g4 = 0; g4 < 4; ++g4) {
                const int v0 = 8 * g4 + 4 * hh;
                const float4 gv = *(const float4*)(gp + v0); const float4 wv = *(const float4*)(nw + vt * 32 + v0);
                const float y0 = oacc[4 * g4 + 0] * scale * wv.x * gv.x / (1.f + __expf(-gv.x)), y1 = oacc[4 * g4 + 1] * scale * wv.y * gv.y / (1.f + __expf(-gv.y));
                const float y2 = oacc[4 * g4 + 2] * scale * wv.z * gv.z / (1.f + __expf(-gv.z)), y3 = oacc[4 * g4 + 3] * scale * wv.w * gv.w / (1.f + __expf(-gv.w));
                uint2 w; w.x = cvtpk(y0, y1); w.y = cvtpk(y2, y3);
                *(uint2*)(op + v0) = w;
            }
        }
        __syncthreads();
    }
}
}


namespace moe {
using bf16x8 = __attribute__((ext_vector_type(8))) short;
using f32x16 = __attribute__((ext_vector_type(16))) float;
using u32x4  = __attribute__((ext_vector_type(4))) unsigned;
constexpr int TW = 5, PROWS = 64 * TW, XS = 144, XBUF = PROWS * XS;
__device__ __forceinline__ unsigned cvtpk(float lo, float hi) { unsigned r; asm volatile("v_cvt_pk_bf16_f32 %0, %1, %2" : "=v"(r) : "v"(lo), "v"(hi)); return r; }
#define MOE_BAR() asm volatile("s_waitcnt lgkmcnt(0)\n\ts_barrier" ::: "memory")
constexpr int WD = 2;
constexpr int ABUF = 4 * 4 * 1024, AOFF = 2 * XBUF, LOFF = AOFF + 2 * ABUF;
template <bool UP>
__device__ __forceinline__ void stream_gemm(KP P, char* lds, int layer) {
    constexpr int KTOT = UP ? DM : DE, NSLAB = KTOT / 64, NCP = UP ? 2 : 4, LDW = UP ? DE : DM;
    static_assert(NSLAB % WD == 0 && NSLAB >= 2 * WD, "slab loop is unrolled by WD");
    const int tid = tid_(), lane = tid & 63, wid = tid >> 6, r32 = lane & 31, hh = lane >> 5, cg = wid & 3, th = wid >> 2;
    const int* cnt_ = P->cnt;
    const bf16_t* X = UP ? P->HN : P->H;
    int* basel = (int*)(lds + LOFF); int* tlist = basel + 64;
    for (int ub = bid_(); ub < 256; ub += gridDim.x) {
        const int u = ((ub & 7) << 5) | (ub >> 3);
        const int e = u >> 2, ns = u & 3;
        const int rot = (u * 11) & (NSLAB - 1);
        __syncthreads();
        if (tid < 64) { const int c = cnt_[tid]; int inc = c;
#pragma unroll
            for (int o = 1; o < 64; o <<= 1) { const int v = __shfl_up(inc, o); if (lane >= o) inc += v; }
            basel[tid] = inc - c; }
        __syncthreads();
        const int cnt = cnt_[e], row0 = basel[e];
        for (int pass0 = 0; pass0 < cnt; pass0 += PROWS) {
            const int cntp = (cnt - pass0) < PROWS ? (cnt - pass0) : PROWS;
            if constexpr (UP) { if (cnt <= ECAP) {
                __syncthreads();
                if (tid < PROWS && pass0 + tid < cnt) tlist[tid] = P->elist[e * ECAP + pass0 + tid];
                __syncthreads();
              } else {
                __syncthreads();
                const int* ridx = P->ridx; const int* rslot = P->rslot;
#pragma unroll 1
                for (int i0 = tid; i0 < NASSIGN; i0 += NTHR * 8) {
                    int ex[8], sl[8];
#pragma unroll
                    for (int q = 0; q < 8; ++q) { const int i = i0 + NTHR * q; ex[q] = i < NASSIGN ? ridx[i] : -1; sl[q] = i < NASSIGN ? rslot[i] : 0; }
#pragma unroll
                    for (int q = 0; q < 8; ++q) { const int sp = sl[q] - pass0; if (ex[q] == e && sp >= 0 && sp < PROWS) tlist[sp] = (i0 + NTHR * q) >> 1; }
                }
                __syncthreads();
            } }
            int xoff[5];
#pragma unroll
            for (int j = 0; j < 5; ++j) { int rho = (tid >> 3) + 64 * j; rho = rho < cntp ? rho : cntp - 1; const int grow = row0 + pass0 + rho;
                xoff[j] = (UP ? tlist[rho] * DM : grow * DE) + (tid & 7) * 8; }
            char* const xw = lds + (tid >> 3) * XS + (tid & 7) * 16;
            char* const aw = lds + AOFF + (cg * 4 + 2 * th) * 1024 + lane * 16;
            const char* const ar = lds + AOFF + cg * 4 * 1024 + lane * 16;
#pragma unroll 1
            for (int cp = 0; cp < NCP; ++cp) {
                const int cgi = cp * 4 + cg;
                const int kkw = wid >> 1, half = wid & 1;
                const float* wp;
                if constexpr (UP) wp = (r32 < 16 ? P->w1 : P->w3) + ((size_t)(layer * NE + e) * DM + kkw * 16 + 8 * hh + 4 * half) * DE + ns * 128 + cp * 64 + 4 * (r32 & 15);
                else wp = P->w2 + ((size_t)(layer * NE + e) * DE + 32 * hh + 2 * th) * DM + ns * 512 + cgi * 32 + r32;
                f32x16 acc[TW];
#pragma unroll
                for (int tl = 0; tl < TW; ++tl) acc[tl] = f32x16{};
                float wreg[WD][16]; u32x4 xs[5];
#define MOE_WLD1(wn_, R, li) do { if constexpr (UP) { if ((li) < 4) { const float4 t_ = *(const float4*)((wn_) + (size_t)(li) * DE); wreg[R][4 * (li)] = t_.x; wreg[R][4 * (li) + 1] = t_.y; wreg[R][4 * (li) + 2] = t_.z; wreg[R][4 * (li) + 3] = t_.w; } } \
                    else { if ((li) < 16) wreg[R][li] = (wn_)[(size_t)(((li) >> 3) + 4 * ((li) & 7)) * DM]; } } while (0)
#define MOE_WLOAD(slab, R) do { const float* wn_ = wp + (size_t)(((slab) + rot) & (NSLAB - 1)) * 64 * LDW; \
                    _Pragma("unroll") for (int li = 0; li < 16; ++li) MOE_WLD1(wn_, R, li); } while (0)
#define MOE_WPARK(R, PAR) do { if constexpr (UP) { _Pragma("unroll") for (int q = 0; q < 4; ++q) { uint2 fw; fw.x = cvtpk(wreg[R][q], wreg[R][4 + q]); fw.y = cvtpk(wreg[R][8 + q], wreg[R][12 + q]); \
                            *(uint2*)(lds + AOFF + (PAR) * ABUF + (q * 4 + kkw) * 1024 + lane * 16 + half * 8) = fw; } } \
                    else { _Pragma("unroll") for (int i = 0; i < 2; ++i) { u32x4 fw; fw.x = cvtpk(wreg[R][8 * i + 0], wreg[R][8 * i + 1]); fw.y = cvtpk(wreg[R][8 * i + 2], wreg[R][8 * i + 3]); \
                            fw.z = cvtpk(wreg[R][8 * i + 4], wreg[R][8 * i + 5]); fw.w = cvtpk(wreg[R][8 * i + 6], wreg[R][8 * i + 7]); *(u32x4*)(aw + (PAR) * ABUF + i * 1024) = fw; } } } while (0)
#pragma unroll
                for (int j = 0; j < 5; ++j) xs[j] = *(const u32x4*)(X + xoff[j] + (rot & (NSLAB - 1)) * 64);
                MOE_WLOAD(0, 0); MOE_WLOAD(1, 1);
#pragma unroll
                for (int j = 0; j < 5; ++j) *(u32x4*)(xw + 64 * j * XS) = xs[j];
                MOE_WPARK(0, 0); MOE_WLOAD(2, 0);
                MOE_BAR();
#define MOE_SLAB(s, PAR, R1) do { \
                    const int sx = ((s) + 1) < NSLAB ? (s) + 1 : NSLAB - 1, sw = ((s) + 1 + WD) < NSLAB ? (s) + 1 + WD : NSLAB - 1;     \
                    { const bf16_t* xn0_ = X + ((sx + rot) & (NSLAB - 1)) * 64; _Pragma("unroll") for (int j = 0; j < 5; ++j) xs[j] = *(const u32x4*)(xn0_ + xoff[j]); } \
                    MOE_WPARK(R1, 1 - (PAR)); \
                    const float* wn_ = wp + (size_t)((sw + rot) & (NSLAB - 1)) * 64 * LDW; \
                    const char* xb = lds + (PAR) * XBUF + (th * TW * 32 + r32) * XS + hh * 16; \
                    bf16x8 xq[4]; bf16x8 fq[2];                                                       \
                    xq[0] = *(const bf16x8*)(xb); xq[1] = *(const bf16x8*)(xb + 32 * XS); xq[2] = *(const bf16x8*)(xb + 64 * XS); \
                    fq[0] = *(const bf16x8*)(ar + (PAR) * ABUF); \
                    _Pragma("unroll") for (int kk = 0; kk < 4; ++kk) { \
                        if (kk < 3) fq[(kk + 1) & 1] = *(const bf16x8*)(ar + (PAR) * ABUF + (kk + 1) * 1024); \
                        _Pragma("unroll") for (int tl = 0; tl < TW; ++tl) { \
                            const int cur = kk * TW + tl, nx = cur + 3, nkk = nx / TW, ntl = nx % TW;       \
                            if (nx < 4 * TW) xq[nx & 3] = *(const bf16x8*)(xb + ntl * 32 * XS + nkk * 32); \
                            acc[tl] = __builtin_amdgcn_mfma_f32_32x32x16_bf16(fq[kk & 1], xq[cur & 3], acc[tl], 0, 0, 0); \
                            const int li = kk * TW + tl; \
                            MOE_WLD1(wn_, R1, li); \
                            __builtin_amdgcn_sched_barrier(0); } } \
                    _Pragma("unroll") for (int j = 0; j < 5; ++j) *(u32x4*)(xw + (1 - (PAR)) * XBUF + 64 * j * XS) = xs[j]; \
                    MOE_BAR(); } while (0)
#pragma unroll 1
                for (int s = 0; s < NSLAB; s += 2) { MOE_SLAB(s, 0, 1); MOE_SLAB(s + 1, 1, 0); }
#undef MOE_SLAB
#undef MOE_WLOAD
#undef MOE_WLD1
#undef MOE_WPARK
                const int T = (cntp + 31) >> 5;
                const int Tw = (T - TW * th) < 0 ? 0 : ((T - TW * th) > TW ? TW : (T - TW * th));
#pragma unroll
                for (int tl = 0; tl < TW; ++tl) if (tl < Tw) {
                    const int rho = (th * TW + tl) * 32 + r32;
                    if (rho < cntp) {
                        const size_t grow = (size_t)(row0 + pass0 + rho);
                        if constexpr (UP) {
                            bf16_t* hp = P->H + grow * DE + ns * 128 + cgi * 16 + 4 * hh;
#pragma unroll
                            for (int g = 0; g < 2; ++g) {
                                float y[4];
#pragma unroll
                                for (int q = 0; q < 4; ++q) { const float a = acc[tl][4 * g + q], b = acc[tl][8 + 4 * g + q]; y[q] = a / (1.f + __expf(-a)) * b; }
                                uint2 w; w.x = cvtpk(y[0], y[1]); w.y = cvtpk(y[2], y[3]);
                                *(uint2*)(hp + 8 * g) = w;
                            }
                        } else {
                            bf16_t* yp = P->Y + grow * DM + ns * 512 + cgi * 32 + 4 * hh;
#pragma unroll
                            for (int g = 0; g < 4; ++g) {
                                uint2 w; w.x = cvtpk(acc[tl][4 * g + 0], acc[tl][4 * g + 1]); w.y = cvtpk(acc[tl][4 * g + 2], acc[tl][4 * g + 3]);
                                *(uint2*)(yp + 8 * g) = w;
                            }
                        }
                    }
                }
            }
        }
    }
}
#undef MOE_BAR
}


namespace s5 {
using bf16x8 = __attribute__((ext_vector_type(8))) short;
using f32x16 = __attribute__((ext_vector_type(16))) float;
using u32x4  = __attribute__((ext_vector_type(4))) unsigned;
constexpr int NCHK = 516, NMT = 17;
__device__ __forceinline__ unsigned cvtpk(float lo, float hi) { unsigned r; asm volatile("v_cvt_pk_bf16_f32 %0, %1, %2" : "=v"(r) : "v"(lo), "v"(hi)); return r; }
__device__ __forceinline__ bf16x8 ld8f(const float* p) {
    const float4 a = *(const float4*)p, b = *(const float4*)(p + 4);
    u32x4 w; w.x = cvtpk(a.x, a.y); w.y = cvtpk(a.z, a.w); w.z = cvtpk(b.x, b.y); w.w = cvtpk(b.z, b.w);
    return *reinterpret_cast<bf16x8*>(&w);
}
__device__ __forceinline__ void prep_unit(KP P, char* lds, int layer, int g) {
    float2* pw = (float2*)lds; float2* bb = pw + 17 * 64; float2* cc = bb + 1024; float* kd = (float*)(cc + 1024);
    const int tid = tid_();
    const float dt = expf(P->log_dt[layer * 32 + g]);
    const float* a_re = P->a_re + (layer * 32 + g) * 64; const float* a_im = P->a_im + (layer * 32 + g) * 64;
    for (int idx = tid; idx < 17 * 64; idx += NTHR) { const int d = idx >> 6, p = idx & 63;
        const float mag = expf(a_re[p] * dt * (float)d), ang = a_im[p] * dt * (float)d; pw[idx] = make_float2(mag * cosf(ang), mag * sinf(ang)); }
    for (int idx = tid; idx < 1024; idx += NTHR) {
        { const int p = idx >> 4, c = idx & 15; const float are = a_re[p], aim = a_im[p];
          const float mag = expf(are * dt), abr = mag * cosf(aim * dt), abi = mag * sinf(aim * dt), den = are * are + aim * aim;
          const float zr = ((abr - 1.f) * are + abi * aim) / den, zi = (abi * are - (abr - 1.f) * aim) / den;
          const float br = P->b_re[((layer * 32 + g) * 64 + p) * 16 + c], bi = P->b_im[((layer * 32 + g) * 64 + p) * 16 + c];
          bb[idx] = make_float2(zr * br - zi * bi, zr * bi + zi * br); }
        { const int c = idx >> 6, p = idx & 63; cc[idx] = make_float2(P->c_re[((layer * 32 + g) * 16 + c) * 64 + p], P->c_im[((layer * 32 + g) * 16 + c) * 64 + p]); }
    }
    __syncthreads();
    if (tid < 64) ((float2*)P->A16)[(layer * 32 + g) * 64 + tid] = pw[16 * 64 + tid];
    for (int idx = tid; idx < 4096; idx += NTHR) { const int d = idx >> 8, c = (idx >> 4) & 15, c2 = idx & 15;
        float acc = 0.f;
        for (int p = 0; p < 64; ++p) { const float2 C = cc[c * 64 + p], W = pw[d * 64 + p], B = bb[p * 16 + c2];
            const float xr = C.x * W.x - C.y * W.y, xi = C.x * W.y + C.y * W.x; acc += xr * B.x - xi * B.y; }
        if (d == 0 && c == c2) acc += P->s5d[layer * 512 + g * 16 + c];
        kd[idx] = acc; }
    __syncthreads();
    bf16_t* BtY = P->BtY + (size_t)(layer * 32 + g) * 256 * 384; bf16_t* BtE = P->BtE + (size_t)(layer * 32 + g) * 128 * 256;
    for (int idx = tid; idx < 256 * 48; idx += NTHR) { const int n = idx / 48, ch = idx % 48, t = n >> 4, c = n & 15;
        float v[8];
        if (ch < 32) { const int s = ch >> 1, c0 = (ch & 1) * 8;
#pragma unroll
            for (int jj = 0; jj < 8; ++jj) v[jj] = (s <= t) ? kd[((t - s) * 16 + c) * 16 + c0 + jj] : 0.f;
        } else {
#pragma unroll
            for (int jj = 0; jj < 8; ++jj) { const int kq = (ch - 32) * 8 + jj, p = kq >> 1; const float2 C = cc[c * 64 + p], W = pw[(t + 1) * 64 + p];
                v[jj] = (kq & 1) ? -(C.x * W.y + C.y * W.x) : (C.x * W.x - C.y * W.y); }
        }
        u32x4 w; w.x = cvtpk(v[0], v[1]); w.y = cvtpk(v[2], v[3]); w.z = cvtpk(v[4], v[5]); w.w = cvtpk(v[6], v[7]);
        *(u32x4*)(BtY + (size_t)n * 384 + ch * 8) = w; }
    for (int idx = tid; idx < 128 * 32; idx += NTHR) { const int n = idx >> 5, ch = idx & 31, p = n >> 1, s = ch >> 1, c0 = (ch & 1) * 8;
        const float2 W = pw[(15 - s) * 64 + p];
        float v[8];
#pragma unroll
        for (int jj = 0; jj < 8; ++jj) { const float2 B = bb[p * 16 + c0 + jj]; v[jj] = (n & 1) ? (W.x * B.y + W.y * B.x) : (W.x * B.x - W.y * B.y); }
        u32x4 w; w.x = cvtpk(v[0], v[1]); w.y = cvtpk(v[2], v[3]); w.z = cvtpk(v[4], v[5]); w.w = cvtpk(v[6], v[7]);
        *(u32x4*)(BtE + (size_t)n * 256 + ch * 8) = w; }
    __syncthreads();
}
__device__ __forceinline__ void local_states(KP P, int layer) {
    const int tid = tid_(), lane = tid & 63, r32 = lane & 31, hh = lane >> 5, gw = bid_() * 8 + (tid >> 6), NGW = gridDim.x * 8;
    const float* PA = P->PA; float* E = P->S5E;
    for (int wu = gw; wu < 32 * NMT; wu += NGW) {
        const int g = wu / NMT, mt = wu % NMT, m = mt * 32 + r32, mc = m < NCHK ? m : NCHK - 1;
        const bf16_t* Bt = P->BtE + ((size_t)(layer * 32 + g) * 128 + r32) * 256 + 8 * hh;
        const float* up = PA + (size_t)(mc * 16) * PAW + 2048 + g * 16 + 8 * hh;
        f32x16 acc[4];
#pragma unroll
        for (int nt = 0; nt < 4; ++nt) acc[nt] = f32x16{};
#pragma unroll 4
        for (int s = 0; s < 16; ++s) {
            const bf16x8 bf = ld8f(up + (size_t)s * PAW);
#pragma unroll
            for (int nt = 0; nt < 4; ++nt) { const bf16x8 af = *(const bf16x8*)(Bt + (size_t)nt * 32 * 256 + s * 16); acc[nt] = __builtin_amdgcn_mfma_f32_32x32x16_bf16(af, bf, acc[nt], 0, 0, 0); }
        }
        if (m < NCHK) { float* ep = E + ((size_t)m * 32 + g) * 128 + 4 * hh;
#pragma unroll
            for (int nt = 0; nt < 4; ++nt)
#pragma unroll
                for (int q = 0; q < 4; ++q) *(float4*)(ep + nt * 32 + 8 * q) = make_float4(acc[nt][4 * q], acc[nt][4 * q + 1], acc[nt][4 * q + 2], acc[nt][4 * q + 3]); }
    }
}
__device__ __forceinline__ void scan_states(KP P, int layer) {
    const int idx = bid_() * NTHR + tid_();
    if (idx >= 8192) return;
    const int b = idx >> 11, g = (idx >> 6) & 31, p = idx & 63;
    const float2 A = ((const float2*)P->A16)[(layer * 32 + g) * 64 + p];
    const float2* E = (const float2*)P->S5E; float2* XP = (float2*)P->S5X;
    float xr = 0.f, xi = 0.f;
    const size_t o0 = ((size_t)(b * 129) * 32 + g) * 64 + p;
    float2 e[16];
#pragma unroll
    for (int i = 0; i < 16; ++i) e[i] = E[o0 + (size_t)i * 2048];
#pragma unroll 1
    for (int jb = 0; jb < 129; jb += 16) {
        float2 en[16];
#pragma unroll
        for (int i = 0; i < 16; ++i) { const int j = jb + 16 + i; en[i] = (j < 129) ? E[o0 + (size_t)j * 2048] : make_float2(0.f, 0.f); }
#pragma unroll
        for (int i = 0; i < 16; ++i) { const int j = jb + i;
            if (j < 129) { XP[o0 + (size_t)j * 2048] = make_float2(xr, xi);
                const float nr = A.x * xr - A.y * xi + e[i].x, ni = A.x * xi + A.y * xr + e[i].y; xr = nr; xi = ni; } }
#pragma unroll
        for (int i = 0; i < 16; ++i) e[i] = en[i];
    }
}
__device__ __forceinline__ float gelu_t(float x) { const float u = 0.7978845608028654f * (x + 0.044715f * x * x * x); const float e = __expf(2.f * u); return x - x / (e + 1.f); }
__device__ __forceinline__ void outputs(KP P, int layer) {
    const int tid = tid_(), lane = tid & 63, r32 = lane & 31, hh = lane >> 5, gw = bid_() * 8 + (tid >> 6), NGW = gridDim.x * 8;
    const float* PA = P->PA; const float* XP = P->S5X; bf16_t* YG = P->YG;
    for (int wu = gw; wu < 32 * NMT; wu += NGW) {
        const int g = wu / NMT, mt = wu % NMT, m = mt * 32 + r32, mc = m < NCHK ? m : NCHK - 1;
        const bf16_t* Bt = P->BtY + ((size_t)(layer * 32 + g) * 256 + r32) * 384 + 8 * hh;
        const float* up = PA + (size_t)(mc * 16) * PAW + 2048 + g * 16 + 8 * hh;
        const float* xp = XP + ((size_t)mc * 32 + g) * 128 + 8 * hh;
        f32x16 acc[8];
#pragma unroll
        for (int nt = 0; nt < 8; ++nt) acc[nt] = f32x16{};
#pragma unroll
        for (int s = 0; s < 16; ++s) {
            const bf16x8 bf = ld8f(up + (size_t)s * PAW);
#pragma unroll
            for (int nt = 0; nt < 8; ++nt) if (2 * nt + 1 >= s) { const bf16x8 af = *(const bf16x8*)(Bt + (size_t)nt * 32 * 384 + s * 16); acc[nt] = __builtin_amdgcn_mfma_f32_32x32x16_bf16(af, bf, acc[nt], 0, 0, 0); }
        }
#pragma unroll
        for (int ks = 0; ks < 8; ++ks) {
            const bf16x8 bf = ld8f(xp + ks * 16);
#pragma unroll
            for (int nt = 0; nt < 8; ++nt) { const bf16x8 af = *(const bf16x8*)(Bt + (size_t)nt * 32 * 384 + 256 + ks * 16); acc[nt] = __builtin_amdgcn_mfma_f32_32x32x16_bf16(af, bf, acc[nt], 0, 0, 0); }
        }
        if (m < NCHK) {
#pragma unroll
            for (int nt = 0; nt < 8; ++nt)
#pragma unroll
                for (int q = 0; q < 4; ++q) { const int t = 2 * nt + (q >> 1);
                    uint2 w; w.x = cvtpk(gelu_t(acc[nt][4 * q]), gelu_t(acc[nt][4 * q + 1])); w.y = cvtpk(gelu_t(acc[nt][4 * q + 2]), gelu_t(acc[nt][4 * q + 3]));
                    *(uint2*)(YG + (size_t)(m * 16 + t) * 512 + g * 16 + 8 * (q & 1) + 4 * hh) = w; }
        }
    }
}
__device__ __forceinline__ void fused_unit(KP P, char* lds, int layer, int b, int g) {
    const int tid = tid_(), lane = tid & 63, wid = tid >> 6, r32 = lane & 31, hh = lane >> 5;
    float* El = (float*)lds;
    const float* PA = P->PA; bf16_t* YG = P->YG;
    const int ml = wid * 32 + r32, mc = b * 129 + (ml < 129 ? ml : 128);
    const float* up = PA + (size_t)(mc * 16) * PAW + 2048 + g * 16 + 8 * hh;
    if (wid < 5) {
        const bf16_t* Bt = P->BtE + ((size_t)(layer * 32 + g) * 128 + r32) * 256 + 8 * hh;
        f32x16 acc[4];
#pragma unroll
        for (int nt = 0; nt < 4; ++nt) acc[nt] = f32x16{};
#pragma unroll 4
        for (int s = 0; s < 16; ++s) {
            const bf16x8 bf = ld8f(up + (size_t)s * PAW);
#pragma unroll
            for (int nt = 0; nt < 4; ++nt) { const bf16x8 af = *(const bf16x8*)(Bt + (size_t)nt * 32 * 256 + s * 16); acc[nt] = __builtin_amdgcn_mfma_f32_32x32x16_bf16(af, bf, acc[nt], 0, 0, 0); }
        }
        float* ep = El + ml * 128 + 4 * hh;
#pragma unroll
        for (int nt = 0; nt < 4; ++nt)
#pragma unroll
            for (int q = 0; q < 4; ++q) *(float4*)(ep + nt * 32 + 8 * q) = make_float4(acc[nt][4 * q], acc[nt][4 * q + 1], acc[nt][4 * q + 2], acc[nt][4 * q + 3]);
    }
    __syncthreads();
    if (tid < 64) {
        const float2 A = ((const float2*)P->A16)[(layer * 32 + g) * 64 + tid];
        float2* e2 = (float2*)El + tid;
        float xr = 0.f, xi = 0.f;
#pragma unroll 4
        for (int j = 0; j < 129; ++j) { const float2 e = e2[j * 64]; e2[j * 64] = make_float2(xr, xi);
            const float nr = A.x * xr - A.y * xi + e.x, ni = A.x * xi + A.y * xr + e.y; xr = nr; xi = ni; }
    }
    __syncthreads();
    if (wid < 5) {
        const bf16_t* Bt = P->BtY + ((size_t)(layer * 32 + g) * 256 + r32) * 384 + 8 * hh;
        const float* xp = El + (ml < 129 ? ml : 128) * 128 + 8 * hh;
        f32x16 acc[8];
#pragma unroll
        for (int nt = 0; nt < 8; ++nt) acc[nt] = f32x16{};
#pragma unroll
        for (int s = 0; s < 16; ++s) {
            const bf16x8 bf = ld8f(up + (size_t)s * PAW);
#pragma unroll
            for (int nt = 0; nt < 8; ++nt) if (2 * nt + 1 >= s) { const bf16x8 af = *(const bf16x8*)(Bt + (size_t)nt * 32 * 384 + s * 16); acc[nt] = __builtin_amdgcn_mfma_f32_32x32x16_bf16(af, bf, acc[nt], 0, 0, 0); }
        }
#pragma unroll
        for (int ks = 0; ks < 8; ++ks) {
            const bf16x8 bf = ld8f(xp + ks * 16);
#pragma unroll
            for (int nt = 0; nt < 8; ++nt) { const bf16x8 af = *(const bf16x8*)(Bt + (size_t)nt * 32 * 384 + 256 + ks * 16); acc[nt] = __builtin_amdgcn_mfma_f32_32x32x16_bf16(af, bf, acc[nt], 0, 0, 0); }
        }
        if (ml < 129) { const int m = b * 129 + ml;
#pragma unroll
            for (int nt = 0; nt < 8; ++nt)
#pragma unroll
                for (int q = 0; q < 4; ++q) { const int t = 2 * nt + (q >> 1);
                    uint2 w; w.x = cvtpk(gelu_t(acc[nt][4 * q]), gelu_t(acc[nt][4 * q + 1])); w.y = cvtpk(gelu_t(acc[nt][4 * q + 2]), gelu_t(acc[nt][4 * q + 3]));
                    *(uint2*)(YG + (size_t)(m * 16 + t) * 512 + g * 16 + 8 * (q & 1) + 4 * hh) = w; }
        }
    }
    __syncthreads();
}
}

__device__ __forceinline__ float wave_sum(float v) {
#pragma unroll
    for (int o = 32; o > 0; o >>= 1) v += __shfl_xor(v, o);
    return v;
}
__device__ __forceinline__ unsigned cvtpk_(float lo, float hi) { unsigned r; asm volatile("v_cvt_pk_bf16_f32 %0, %1, %2" : "=v"(r) : "v"(lo), "v"(hi)); return r; }
__device__ __forceinline__ void ph_attn_out(KP P, int layer) {
    const int tid = tid_(), lane = tid & 63, gw = bid_() * 8 + (tid >> 6), NGW = gridDim.x * 8;
    const float scale = 1.f - (0.8f - 0.6f * expf(-0.3f * (float)layer));
    const float lam = P->lam[layer];
    const float4 sw = ((const float4*)(P->subln + layer * 256))[lane];
    const float* OC = P->OC; bf16_t* MIX = P->MIX;
    for (int it0 = gw; it0 < TOK * 4; it0 += NGW * 4) {
        float4 a[4], b[4];
#pragma unroll
        for (int q = 0; q < 4; ++q) { const int it = it0 + NGW * q, itc = it < TOK * 4 ? it : TOK * 4 - 1, r = itc >> 2, h = itc & 3;
            a[q] = *(const float4*)(OC + (size_t)r * DM + h * 512 + lane * 4); b[q] = *(const float4*)(OC + (size_t)r * DM + h * 512 + 256 + lane * 4); }
#pragma unroll
        for (int q = 0; q < 4; ++q) { const int it = it0 + NGW * q; if (it < TOK * 4) { const int r = it >> 2, h = it & 3;
            const float o0 = a[q].x - lam * b[q].x, o1 = a[q].y - lam * b[q].y, o2 = a[q].z - lam * b[q].z, o3 = a[q].w - lam * b[q].w;
            const float ss = wave_sum(o0 * o0 + o1 * o1 + o2 * o2 + o3 * o3);
            const float rs = rsqrtf(ss * (1.f / 256.f) + EPS) * scale;
            uint2 w; w.x = cvtpk_(o0 * rs * sw.x, o1 * rs * sw.y); w.y = cvtpk_(o2 * rs * sw.z, o3 * rs * sw.w);
            *(uint2*)(MIX + (size_t)r * DM + 1024 + h * 256 + lane * 4) = w; } }
    }
}
__device__ __forceinline__ void ph_build_norm(KP P) {
    const int tid = tid_(), lane = tid & 63, gw = bid_() * 8 + (tid >> 6), NGW = gridDim.x * 8;
    for (int r = gw; r < MP; r += NGW) {
        float4 v[8];
        if (r < TOK) { const int b = r / LL, t = r % LL;
            const float4* src = (const float4*)(t < NMETA ? P->meta + (size_t)t * DM : P->x + ((size_t)b * SEQ + (t - NMETA)) * DM);
#pragma unroll
            for (int j = 0; j < 8; ++j) v[j] = src[lane + 64 * j];
        } else {
#pragma unroll
            for (int j = 0; j < 8; ++j) v[j] = make_float4(0.f, 0.f, 0.f, 0.f);
        }
        float ss = 0.f;
#pragma unroll
        for (int j = 0; j < 8; ++j) { ((float4*)(P->Z + (size_t)r * DM))[lane + 64 * j] = v[j]; ss += v[j].x * v[j].x + v[j].y * v[j].y + v[j].z * v[j].z + v[j].w * v[j].w; }
        const float rs = rsqrtf(wave_sum(ss) * (1.f / DM) + EPS);
#pragma unroll
        for (int j = 0; j < 8; ++j) { const float4 w = ((const float4*)P->ln1_w)[lane + 64 * j];
            uint2 o; o.x = cvtpk_(v[j].x * rs * w.x, v[j].y * rs * w.y); o.y = cvtpk_(v[j].z * rs * w.z, v[j].w * rs * w.w);
            ((uint2*)(P->HN + (size_t)r * DM))[lane + 64 * j] = o; }
    }
}
__device__ __forceinline__ void ph_prep(KP P) {
    const int tid = tid_();
    if (bid_() == 0) {
        const int c = tid;
        const float l0 = P->lbnd[c], l1 = P->lbnd[512 + c], m = fmaxf(l0, l1), e0 = expf(l0 - m), e1 = expf(l1 - m);
        P->lbtab[c] = 0.f; P->lbtab[512 + c] = e1 / (e0 + e1);
        if (c < 2) {
            float s1 = 0.f, s2 = 0.f;
            for (int i = 0; i < 128; ++i) { s1 += P->lq1[c * 128 + i] * P->lk1[c * 128 + i]; s2 += P->lq2[c * 128 + i] * P->lk2[c * 128 + i]; }
            const float li = 0.8f - 0.6f * expf(-0.3f * (float)c);
            P->lam[c] = expf(s1) - expf(s2) + li;
        }
    }
    for (int i = bid_() * NTHR + tid; i < 2 * 96 * DM; i += gridDim.x * NTHR) {
        const int layer = i / (96 * DM), jc = (i / DM) % 96, k = i % DM;
        float v = 0.f;
        if (jc < 8) v = P->wrg[((size_t)layer * DM + k) * 8 + jc]; else if (jc < 72) v = P->wre[((size_t)layer * DM + k) * 64 + jc - 8];
        v *= P->ln2_w[layer * DM + k];
        const bf16_t hi = f2bf(v), lo = f2bf(v - bf2f(hi));
        P->WRT[((size_t)(layer * 2 + 0) * 96 + jc) * DM + k] = hi; P->WRT[((size_t)(layer * 2 + 1) * 96 + jc) * DM + k] = lo;
    }
}
namespace rt {
using f32x16 = __attribute__((ext_vector_type(16))) float;
using bf16x8 = __attribute__((ext_vector_type(8))) short;
using u32x4  = __attribute__((ext_vector_type(4))) unsigned;
__device__ __forceinline__ void norm_router(KP P, char* lds, int layer) {
    const int tid = tid_(), lane = tid & 63, wid = tid >> 6, r32 = lane & 31, hh = lane >> 5;
    float* part = (float*)lds;
    float* ssqp = (float*)(lds + 98304);
    float* lg = ssqp + 256;
    float* rsv = lg + 32 * 97;
    const bf16_t* Whi = P->WRT + (size_t)(layer * 2 + 0) * 96 * DM; const bf16_t* Wlo = P->WRT + (size_t)(layer * 2 + 1) * 96 * DM;
    const float* Z = P->Z;
    for (int u = bid_(); u < TOK / 32; u += gridDim.x) {
        const int tok0 = u * 32, kb = wid * 256;
        if (false) {
            float* Zw = P->Z; const float* ZP = P->ZP;
            for (int i = tid; i < 32 * DM / 4; i += NTHR) { const int r = i / (DM / 4), c4 = i % (DM / 4);
                float4 z = ((const float4*)(Zw + (size_t)(tok0 + r) * DM))[c4];
#pragma unroll
                for (int ks = 0; ks < 8; ++ks) { const float4 p4 = ((const float4*)(ZP + ((size_t)ks * 256 + (tok0 - 8192 + r)) * DM))[c4]; z.x += p4.x; z.y += p4.y; z.z += p4.z; z.w += p4.w; }
                ((float4*)(Zw + (size_t)(tok0 + r) * DM))[c4] = z; }
            asm volatile("s_waitcnt vmcnt(0)" ::: "memory");
            __syncthreads();
        }
        f32x16 acc[3] = {f32x16{}, f32x16{}, f32x16{}};
        float sq = 0.f;
        const float* zp = Z + (size_t)(tok0 + r32) * DM + kb + 8 * hh;
        const bf16_t* wh = Whi + (size_t)r32 * DM + kb + 8 * hh; const bf16_t* wl = Wlo + (size_t)r32 * DM + kb + 8 * hh;
#pragma unroll 4
        for (int ks = 0; ks < 16; ++ks) {
            const float4 z0 = *(const float4*)(zp + ks * 16), z1 = *(const float4*)(zp + ks * 16 + 4);
            sq += (z0.x * z0.x + z0.y * z0.y + z0.z * z0.z + z0.w * z0.w) + (z1.x * z1.x + z1.y * z1.y + z1.z * z1.z + z1.w * z1.w);
            u32x4 h; h.x = cvtpk_(z0.x, z0.y); h.y = cvtpk_(z0.z, z0.w); h.z = cvtpk_(z1.x, z1.y); h.w = cvtpk_(z1.z, z1.w);
            u32x4 l; l.x = cvtpk_(z0.x - __uint_as_float(h.x << 16), z0.y - __uint_as_float(h.x & 0xffff0000u)); l.y = cvtpk_(z0.z - __uint_as_float(h.y << 16), z0.w - __uint_as_float(h.y & 0xffff0000u));
            l.z = cvtpk_(z1.x - __uint_as_float(h.z << 16), z1.y - __uint_as_float(h.z & 0xffff0000u)); l.w = cvtpk_(z1.z - __uint_as_float(h.w << 16), z1.w - __uint_as_float(h.w & 0xffff0000u));
            const bf16x8 zh = *reinterpret_cast<bf16x8*>(&h), zl = *reinterpret_cast<bf16x8*>(&l);
#pragma unroll
            for (int ct = 0; ct < 3; ++ct) {
                const bf16x8 ah = *(const bf16x8*)(wh + (size_t)ct * 32 * DM + ks * 16), al = *(const bf16x8*)(wl + (size_t)ct * 32 * DM + ks * 16);
                acc[ct] = __builtin_amdgcn_mfma_f32_32x32x16_bf16(ah, zh, acc[ct], 0, 0, 0);
                acc[ct] = __builtin_amdgcn_mfma_f32_32x32x16_bf16(ah, zl, acc[ct], 0, 0, 0);
                acc[ct] = __builtin_amdgcn_mfma_f32_32x32x16_bf16(al, zh, acc[ct], 0, 0, 0);
            }
        }
        { auto rr = __builtin_amdgcn_permlane32_swap(__float_as_uint(sq), __float_as_uint(sq), false, false); sq = __uint_as_float(rr[0]) + __uint_as_float(rr[1]); }
        if (hh == 0) ssqp[wid * 32 + r32] = sq;
#pragma unroll
        for (int ct = 0; ct < 3; ++ct)
#pragma unroll
            for (int rg = 0; rg < 16; ++rg) part[((wid * 3 + ct) * 16 + rg) * 64 + lane] = acc[ct][rg];
        __syncthreads();
        if (tid < 32) { float t = 0.f;
#pragma unroll
            for (int w = 0; w < 8; ++w) t += ssqp[w * 32 + tid];
            rsv[tid] = rsqrtf(t * (1.f / DM) + EPS); }
#pragma unroll
        for (int q = 0; q < 6; ++q) { const int o = tid + NTHR * q, col = o >> 5, tok = o & 31, ct = col >> 5, cl = col & 31, h2 = (cl >> 2) & 1, rg = (cl & 3) + 4 * (cl >> 3);
            float t = 0.f;
#pragma unroll
            for (int w = 0; w < 8; ++w) t += part[((w * 3 + ct) * 16 + rg) * 64 + h2 * 32 + tok];
            lg[tok * 97 + col] = t; }
        __syncthreads();
        if (tid < 32) {
            const int t = tok0 + tid; const float rs = rsv[tid]; const float* l = lg + tid * 97;
            const float* brg = P->brg + layer * 8; const float* bre = P->bre + layer * 64;
            float gl[8];
#pragma unroll
            for (int j = 0; j < 8; ++j) gl[j] = l[j] * rs + brg[j];
            int gs = 0; float gm = gl[0];
#pragma unroll
            for (int j = 1; j < 8; ++j) if (gl[j] > gm) { gm = gl[j]; gs = j; }
            float den = 0.f;
#pragma unroll
            for (int j = 0; j < 8; ++j) den += expf(gl[j] - gm);
            const float pg = 1.f / den;
            float el[8];
#pragma unroll
            for (int j = 0; j < 8; ++j) el[j] = l[8 + gs * 8 + j] * rs + bre[gs * 8 + j];
            int j0 = 0; float v0 = el[0];
#pragma unroll
            for (int j = 1; j < 8; ++j) if (el[j] > v0) { v0 = el[j]; j0 = j; }
            int j1 = -1; float v1 = -INFINITY;
#pragma unroll
            for (int j = 0; j < 8; ++j) if (j != j0 && el[j] > v1) { v1 = el[j]; j1 = j; }
            const float e1 = expf(v1 - v0), g0 = pg / (1.f + e1), g1 = pg * e1 / (1.f + e1);
            const int x0 = gs * 8 + j0, x1 = gs * 8 + j1;
            P->ridx[t * 2] = x0; P->ridx[t * 2 + 1] = x1; P->rgate[t * 2] = g0; P->rgate[t * 2 + 1] = g1;
            const int s0 = atomicAdd(&P->cnt[x0], 1), s1 = atomicAdd(&P->cnt[x1], 1);
            P->rslot[t * 2] = s0; P->rslot[t * 2 + 1] = s1;
            if (s0 < ECAP) P->elist[x0 * ECAP + s0] = t; if (s1 < ECAP) P->elist[x1 * ECAP + s1] = t;
        }
#pragma unroll 1
        for (int q = 0; q < 4; q += 2) { const int tk = wid * 4 + q; const float rs0 = rsv[tk], rs1 = rsv[tk + 1];
            const float4* zr = (const float4*)(Z + (size_t)(tok0 + tk) * DM); const float4* wl4 = (const float4*)(P->ln2_w + layer * DM);
            float4 za[8], zb[8];
#pragma unroll
            for (int j = 0; j < 8; ++j) { za[j] = zr[lane + 64 * j]; zb[j] = zr[DM / 4 + lane + 64 * j]; }
#pragma unroll
            for (int j = 0; j < 8; ++j) { const float4 w = wl4[lane + 64 * j];
                uint2 o; o.x = cvtpk_(za[j].x * rs0 * w.x, za[j].y * rs0 * w.y); o.y = cvtpk_(za[j].z * rs0 * w.z, za[j].w * rs0 * w.w);
                ((uint2*)(P->HN + (size_t)(tok0 + tk) * DM))[lane + 64 * j] = o;
                o.x = cvtpk_(zb[j].x * rs1 * w.x, zb[j].y * rs1 * w.y); o.y = cvtpk_(zb[j].z * rs1 * w.z, zb[j].w * rs1 * w.w);
                ((uint2*)(P->HN + (size_t)(tok0 + tk + 1) * DM))[lane + 64 * j] = o; } }
        __syncthreads();
    }
}
}
__device__ __forceinline__ void ph_combine_norm(KP P, char* lds, int layer) {
    int* base = (int*)lds;
    const int tid = tid_(), lane = tid & 63, gw = bid_() * 8 + (tid >> 6), NGW = gridDim.x * 8;
    if (tid < 64) { const int c = P->cnt[tid]; int inc = c;
#pragma unroll
        for (int o = 1; o < 64; o <<= 1) { const int v = __shfl_up(inc, o); if (lane >= o) inc += v; }
        base[tid] = inc - c; }
    __syncthreads();
    for (int t0 = gw; t0 < TOK; t0 += 2 * NGW) {
        int r0[2], r1[2]; float g0[2], g1[2]; bool ok[2];
#pragma unroll
        for (int q = 0; q < 2; ++q) { const int t = t0 + q * NGW; ok[q] = t < TOK; const int tc = ok[q] ? t : t0;
            const int2 ex = ((const int2*)P->ridx)[tc], sl = ((const int2*)P->rslot)[tc]; const float2 gg = ((const float2*)P->rgate)[tc];
            r0[q] = base[ex.x] + sl.x; r1[q] = base[ex.y] + sl.y; g0[q] = gg.x; g1[q] = gg.y; }
        float4 v[2][8]; uint2 ya[2][8], yb[2][8];
#pragma unroll
        for (int q = 0; q < 2; ++q) { const int t = ok[q] ? t0 + q * NGW : t0;
#pragma unroll
            for (int j = 0; j < 8; ++j) { v[q][j] = ((const float4*)(P->Z + (size_t)t * DM))[lane + 64 * j];
                ya[q][j] = ((const uint2*)(P->Y + (size_t)r0[q] * DM))[lane + 64 * j]; yb[q][j] = ((const uint2*)(P->Y + (size_t)r1[q] * DM))[lane + 64 * j]; } }
#pragma unroll
        for (int q = 0; q < 2; ++q) if (ok[q]) { const int t = t0 + q * NGW;
            float ss = 0.f;
#pragma unroll
            for (int j = 0; j < 8; ++j) { const uint2 a = ya[q][j], b = yb[q][j]; float4& x = v[q][j];
                x.x += g0[q] * __uint_as_float(a.x << 16) + g1[q] * __uint_as_float(b.x << 16); x.y += g0[q] * __uint_as_float(a.x & 0xffff0000u) + g1[q] * __uint_as_float(b.x & 0xffff0000u);
                x.z += g0[q] * __uint_as_float(a.y << 16) + g1[q] * __uint_as_float(b.y << 16); x.w += g0[q] * __uint_as_float(a.y & 0xffff0000u) + g1[q] * __uint_as_float(b.y & 0xffff0000u);
                ss += x.x * x.x + x.y * x.y + x.z * x.z + x.w * x.w; }
            const float rs = rsqrtf(wave_sum(ss) * (1.f / DM) + EPS);
            if (layer == 0) {
#pragma unroll
                for (int j = 0; j < 8; ++j) { ((float4*)(P->Z + (size_t)t * DM))[lane + 64 * j] = v[q][j];
                    const float4 w = ((const float4*)(P->ln1_w + DM))[lane + 64 * j];
                    uint2 o; o.x = cvtpk_(v[q][j].x * rs * w.x, v[q][j].y * rs * w.y); o.y = cvtpk_(v[q][j].z * rs * w.z, v[q][j].w * rs * w.w);
                    ((uint2*)(P->HN + (size_t)t * DM))[lane + 64 * j] = o; }
            } else {
                const int b = t / LL, tt = t % LL;
                if (tt >= NMETA) {
#pragma unroll
                    for (int j = 0; j < 8; ++j) { const float4 w = ((const float4*)P->fnw)[lane + 64 * j];
                        ((float4*)(P->out + ((size_t)b * SEQ + (tt - NMETA)) * DM))[lane + 64 * j] = make_float4(v[q][j].x * rs * w.x, v[q][j].y * rs * w.y, v[q][j].z * rs * w.z, v[q][j].w * rs * w.w); }
                }
            }
        }
    }
    __syncthreads();
}

__global__ void __launch_bounds__(NTHR, 2) mega_fwd(Params P_arg) {
    extern __shared__ __attribute__((aligned(16))) char lds[];
    const int tid = tid_(), G = gridDim.x;
    volatile LAS unsigned* ctlw = (volatile LAS unsigned*)((LAS char*)lds + LDS_CTL);
    if (tid < 64) ctlw[tid] = 0u;
    __syncthreads();
    KP P = kp_();
    XcdBarrier bar = xcd_barrier_post(P->bar, ctlw + 8);
#define GRID_BAR() do { xcd_barrier(bar); P = kp_(); } while (0)

    ph_build_norm(P);
    ph_prep(P);
    ph_weights(P, lds);
    __syncthreads();
    for (int un = bid_(); un < 64; un += G) s5::prep_unit(P, lds, un >> 5, un & 31);
    GRID_BAR();
#pragma unroll
    for (int layer = 0; layer < 2; ++layer) {
        { pg8::Gemm g{P->HN, P->WinT + (size_t)layer * INW * DM, MP, INW, DM, DM}; pg8::StaticOrder S; S.init(MP, INW, G, bid_(), DM / 64); pg8::EpiInProj E{P->PA, P->QKV};
          pg8::gemm_phase<pg8::EpiInProj, pg8::StaticOrder, true, true>((LAS unsigned char*)lds, g, S, E); }
        { const int t2 = tid_(), b2 = bid_(); if (b2 == 0 && t2 < NE) P->cnt[t2] = 0;
 }
        GRID_BAR();
        hg::local_states(P, lds, layer);
        for (int un = bid_(); un < 128; un += G) s5::fused_unit(P, lds, layer, un >> 5, un & 31);
        ph_attention(P, lds);
        GRID_BAR();
        hg::scan_states(P);
        ph_attn_out(P, layer);
        __syncthreads();
        { pg8::Gemm g{P->YG, P->WgluT + (size_t)layer * 1024 * 512, MP, 1024, 512, 512}; pg8::StaticOrder S; S.init(MP, 1024, G, bid_(), 512 / 64); pg8::EpiGlu E{P->MIX, P->b_glu + layer * 1024};
          pg8::gemm_phase<pg8::EpiGlu, pg8::StaticOrder, true, true>((LAS unsigned char*)lds, g, S, E); }
        GRID_BAR();
        hg::outputs(P, lds, layer);
        GRID_BAR();
        { pg8::Gemm g{P->MIX, P->WoutT + (size_t)layer * DM * DM, MP, DM, DM, DM}; pg8::StaticOrder S; S.init(MP, DM, G, bid_(), DM / 64); pg8::EpiResidual E{P->Z};
          pg8::gemm_phase<pg8::EpiResidual, pg8::StaticOrder, true, true>((LAS unsigned char*)lds, g, S, E); }
        GRID_BAR();
        rt::norm_router(P, lds, layer);
        GRID_BAR();
        moe::stream_gemm<true>(P, lds, layer);
        GRID_BAR();
        moe::stream_gemm<false>(P, lds, layer);
        GRID_BAR();
        ph_combine_norm(P, lds, layer);
        if (layer == 0) GRID_BAR();
    }
}
}

extern "C" void kernel_launch(void* const* d_in, const int* in_sizes, int n_in, void* d_out, int out_size, void* d_ws, size_t ws_size, hipStream_t stream) {
    static int grid = 0;
    if (grid == 0) {
        int dev = 0, cus = 0;
        if (hipGetDevice(&dev) != hipSuccess || hipDeviceGetAttribute(&cus, hipDeviceAttributeMultiprocessorCount, dev) != hipSuccess) { grid = -1; return; }
        if (hipFuncSetAttribute((const void*)mega_fwd, hipFuncAttributeMaxDynamicSharedMemorySize, LDS_BYTES) != hipSuccess) { grid = -1; return; }
        int per_cu = 0;
        if (hipOccupancyMaxActiveBlocksPerMultiprocessor(&per_cu, (const void*)mega_fwd, NTHR, LDS_BYTES) != hipSuccess || per_cu < 1) { (void)hipGetLastError(); }
        grid = cus;
    }
    if (grid < 0) return;
    Params p{};
    const float** pin = (const float**)&p;
    for (int i = 0; i < 31; ++i) pin[i] = (const float*)d_in[i];
    p.out = (float*)d_out;
    char* ws = (char*)d_ws; size_t off = 0;
    auto alloc = [&](size_t bytes) { char* q = ws + off; off += (bytes + 255) & ~(size_t)255; return q; };
    p.bar = (unsigned*)alloc(XCD_BAR_WORDS * 4);
    p.elist = (int*)alloc((size_t)NE * ECAP * 4);
    p.cnt = (int*)alloc(256); p.blk_e = (int*)alloc(1024); p.base = (int*)alloc(256);
    p.lbtab = (float*)alloc(1024 * 4); p.lam = (float*)alloc(256);
    p.Z = (float*)alloc((size_t)MP * DM * 4);
    p.HN = (bf16_t*)alloc((size_t)MP * DM * 2);
    p.PA = (float*)alloc((size_t)MP * PAW * 4);
    p.QKV = (bf16_t*)alloc((size_t)MP * QKVW * 2);
    p.OA = (float*)alloc((size_t)MP * HW * 4);
    p.ZP = (float*)alloc((size_t)8 * 256 * DM * 4);
    p.WRT = (bf16_t*)alloc((size_t)2 * 2 * 96 * DM * 2);
    p.A16 = (float*)alloc(2 * 32 * 64 * 8); p.S5E = (float*)alloc((size_t)516 * 32 * 128 * 4); p.S5X = (float*)alloc((size_t)516 * 32 * 128 * 4);
    p.BtY = (bf16_t*)alloc((size_t)2 * 32 * 256 * 384 * 2); p.BtE = (bf16_t*)alloc((size_t)2 * 32 * 128 * 256 * 2);
    p.SLOC = (float*)alloc((size_t)528 * 16384 * 4); p.DEC = (float*)alloc((size_t)528 * 128 * 4); p.SPREV = (bf16_t*)alloc((size_t)529 * 16384 * 2);
    p.YG = (bf16_t*)alloc((size_t)MP * 512 * 2);
    p.T = nullptr;
    p.MIX = (bf16_t*)alloc((size_t)MP * DM * 2);
    p.OC = (float*)alloc((size_t)MP * DM * 4);
    p.ridx = (int*)alloc((size_t)NASSIGN * 4); p.rgate = (float*)alloc((size_t)NASSIGN * 4); p.rslot = (int*)alloc((size_t)NASSIGN * 4);
    p.tokrow = (int*)alloc((size_t)NASSIGN * 4); p.rowtok = (int*)alloc((size_t)NRMAX * 4);
    p.H1 = nullptr;
    p.H = (bf16_t*)alloc((size_t)NRMAX * DE * 2);
    p.Y = (bf16_t*)alloc((size_t)NRMAX * DM * 2);
    p.S = nullptr;
    p.WinT = (bf16_t*)alloc((size_t)2 * INW * DM * 2); p.WoutT = (bf16_t*)alloc((size_t)2 * DM * DM * 2); p.WgluT = (bf16_t*)alloc((size_t)2 * 1024 * 512 * 2);
    if (off > ws_size) return;
    if (hipMemsetAsync(p.bar, 0, XCD_BAR_WORDS * 4, stream) != hipSuccess) return;
    hipLaunchKernelGGL(mega_fwd, dim3(grid), dim3(NTHR), LDS_BYTES, stream, p);
}
```

```cpp
#include <hip/hip_runtime.h>
#include <stdint.h>
#include <math.h>

namespace {
typedef unsigned short bf16_t;
constexpr int DM = 2048, NB = 4, SEQ = 2048, NMETA = 16, LL = SEQ + NMETA, TOK = NB * LL, MP = 8448;
constexpr int HW = 512;
constexpr int INW = 5632, PAW = 2560, QKVW = 3072;
constexpr int NE = 64, DE = 512, NASSIGN = TOK * 2;
constexpr int RB = 128;
constexpr int NRMAX = NASSIGN + NE * RB;
constexpr float EPS = 1e-6f;
constexpr int NTHR = 512;
constexpr int ECAP = 1024;
constexpr int LDS_BYTES = 147456;
constexpr int LDS_CTL = 143360;

__device__ __forceinline__ float bf2f(bf16_t h) { return __uint_as_float(((unsigned)h) << 16); }
__device__ __forceinline__ bf16_t f2bf(float f) { unsigned u = __float_as_uint(f); return (bf16_t)((u + 0x7fffu + ((u >> 16) & 1u)) >> 16); }
__device__ __forceinline__ float sigmoidf_(float x) { return 1.f / (1.f + expf(-x)); }
__device__ __forceinline__ int tid_() { int t = threadIdx.x; asm volatile("" : "+v"(t)); return t; }
__device__ __forceinline__ int bid_() { int b = blockIdx.x; asm volatile("" : "+s"(b)); return b; }

#define XB_TMO      128
#define XB_XCNT(j)  (256  + 64 * (j))
#define XB_XSUB(j)  (1280 + 64 * (j))
#define XB_XGEN(j)  (2304 + 64 * (j))
#define XB_TOP      3328
#define XB_TOPGEN   3392
#define XCD_BAR_WORDS 3456
#define XB_SPIN_CAP (1u << 24)
#define LAS __attribute__((address_space(3)))
__device__ __forceinline__ unsigned xb_ld(unsigned* p)              { return __hip_atomic_load(p, __ATOMIC_RELAXED, __HIP_MEMORY_SCOPE_AGENT); }
__device__ __forceinline__ unsigned xb_add(unsigned* p, unsigned v) { return __hip_atomic_fetch_add(p, v, __ATOMIC_RELAXED, __HIP_MEMORY_SCOPE_AGENT); }
__device__ __forceinline__ unsigned xb_xcc_id() { return (unsigned)__builtin_amdgcn_s_getreg((3 << 11) | 20) & 0xFu; }
#define XB_SPIN(cond, bar) do { unsigned _sp = 0; while (cond) { __builtin_amdgcn_s_sleep(1); \
    if ((++_sp & 255u) == 0u) { if (xb_ld(&(bar)[XB_TMO])) break; if (_sp > XB_SPIN_CAP) { atomicAdd(&(bar)[XB_TMO], 1u); break; } } } } while (0)
struct XcdBarrier { unsigned* bar; unsigned x; volatile LAS unsigned* st; };
__device__ __forceinline__ XcdBarrier xcd_barrier_post(unsigned* bar, volatile LAS unsigned* st) {
    XcdBarrier b; b.bar = bar; b.x = xb_xcc_id(); b.st = st;
    if (threadIdx.x == 0) (void)xb_add(&bar[XB_XCNT(b.x)], 1u);
    return b;
}
__device__ __forceinline__ void xcd_barrier_complete(unsigned* bar, unsigned x, unsigned& nloc, unsigned& nx) {
    const unsigned G = gridDim.x * gridDim.y * gridDim.z;
    unsigned sum, cnt, mine, sp = 0u;
    for (;;) {
        sum = 0u; cnt = 0u; mine = 0u;
#pragma unroll
        for (unsigned j = 0; j < 16; ++j) { const unsigned c = xb_ld(&bar[XB_XCNT(j)]); sum += c; cnt += (c > 0u) ? 1u : 0u; mine = (j == x) ? c : mine; }
        if (sum == G) break;
        __builtin_amdgcn_s_sleep(1);
        if ((++sp & 255u) == 0u) { if (xb_ld(&bar[XB_TMO])) break; if (sp > XB_SPIN_CAP) { atomicAdd(&bar[XB_TMO], 1u); break; } }
    }
    nloc = mine > 0u ? mine : 1u; nx = cnt > 0u ? cnt : 1u;
}
__device__ __forceinline__ void xcd_barrier(const XcdBarrier& b) {
    asm volatile("s_waitcnt vmcnt(0)" ::: "memory");
    __syncthreads();
    if (threadIdx.x == 0) {
        unsigned* bar = b.bar;
        const unsigned bx_ = xb_xcc_id();
        __builtin_amdgcn_s_waitcnt(0);
        unsigned nloc = b.st[0], nx = b.st[1];
        if (nloc == 0u) { xcd_barrier_complete(bar, bx_, nloc, nx); b.st[0] = nloc; b.st[1] = nx; }
        const unsigned old = xb_add(&bar[XB_XSUB(bx_)], 1u);
        const unsigned gen = old / nloc;
        if (old + 1u == (gen + 1u) * nloc) {
            __builtin_amdgcn_fence(__ATOMIC_RELEASE, "agent");
            asm volatile("s_waitcnt vmcnt(0)" ::: "memory");
            const unsigned og = xb_add(&bar[XB_TOP], 1u);
            const unsigned tg = og / nx;
            if (og + 1u == (tg + 1u) * nx) xb_add(&bar[XB_TOPGEN], 1u);
            else XB_SPIN(xb_ld(&bar[XB_TOPGEN]) == tg, bar);
            __builtin_amdgcn_fence(__ATOMIC_ACQUIRE, "agent");
            xb_add(&bar[XB_XGEN(bx_)], 1u);
            asm volatile("s_waitcnt vmcnt(0)" ::: "memory");
        } else {
            XB_SPIN(xb_ld(&bar[XB_XGEN(bx_)]) == gen, bar);
            __builtin_amdgcn_fence(__ATOMIC_ACQUIRE, "agent");
            asm volatile("s_waitcnt vmcnt(0)" ::: "memory");
        }
    }
    __syncthreads();
}

struct Params {
    const float *x, *meta, *ln1_w, *w_in, *lbnd, *hnw, *a_re, *a_im, *b_re, *b_im, *c_re, *c_im, *s5d, *log_dt, *w_glu, *b_glu,
                *lq1, *lk1, *lq2, *lk2, *subln, *w_out, *ln2_w, *wrg, *brg, *wre, *bre, *w1, *w3, *w2, *fnw;
    float* out;
    unsigned* bar;
    int *cnt, *blk_e, *ridx, *rslot, *tokrow, *rowtok, *base, *elist;
    float *lbtab, *lam, *Z, *PA, *OA, *T, *OC, *rgate, *H1, *S, *SLOC, *DEC, *A16, *S5E, *S5X, *ZP;
    bf16_t *HN, *QKV, *YG, *MIX, *H, *Y, *WinT, *WoutT, *WgluT, *SPREV, *BtY, *BtE, *WRT;
};
typedef const __attribute__((address_space(4))) Params* KP;
__device__ __forceinline__ KP kp_() { KP p = (KP)__builtin_amdgcn_kernarg_segment_ptr(); asm volatile("" : "+s"(p)); return p; }


namespace pg8 {
#define PG8_LAS __attribute__((address_space(3)))
typedef short bf16x8 __attribute__((ext_vector_type(8)));
typedef float f32x4 __attribute__((ext_vector_type(4)));
typedef unsigned u32x4 __attribute__((ext_vector_type(4)));
constexpr int BM = 256, BK = 64, HALF = 128, HTB = HALF * BK * 2, STAGE_BYTES = 8 * HTB, NXCD = 8, WGM = 8;
__host__ __device__ __forceinline__ int lds_byte(int r, int c) { const int st = (r >> 4) * 2 + (c >> 5), rr = r & 15, cc = c & 31, ob = rr * 64 + cc * 2; return st * 1024 + (ob ^ (((ob >> 9) & 1) << 5)); }
__host__ __device__ __forceinline__ void stage_rc(int b, int& R, int& C) { const int st = b / 1024, sb = b % 1024, swz = sb ^ (((sb >> 9) & 1) << 5); R = (st >> 1) * 16 + swz / 64; C = (st & 1) * 32 + (swz % 64) / 2; }
__host__ __device__ __forceinline__ int perm32(int rho) { const int n = rho >> 4, i = rho & 15; return 8 * (i >> 2) + 4 * n + (i & 3); }
struct Unit { int pm, pn, ko, nt; };
struct Gemm { const bf16_t* A; const bf16_t* Bt; int M, N, K, ld; };
struct StaticOrder {
    static constexpr bool PER_UNIT_K = false;
    int nM, nN, nwg, G, c, nt;
    __host__ __device__ void init(int M, int N, int G_, int c_, int nt_) { nM = M / BM; nN = N / BM; nwg = nM * nN; G = G_; c = c_; nt = nt_; }
    __host__ __device__ bool next(int i, Unit& u) const {
        const long L = (long)i * G + c; if (L >= nwg) return false;
        int wgid = (int)L; { const int q = nwg / NXCD, r = nwg % NXCD, xcd = wgid % NXCD, off = wgid / NXCD; wgid = (xcd < r ? xcd * (q + 1) : r * (q + 1) + (xcd - r) * q) + off; }
        const int nig = WGM * nN, gid = wgid / nig, fm = gid * WGM, gsz = (nM - fm) < WGM ? (nM - fm) : WGM;
        u.pm = fm + ((wgid % nig) % gsz); u.pn = (wgid % nig) / gsz; u.ko = 0; u.nt = nt; return true;
    }
    __device__ __forceinline__ void a_ready(const Unit&) const {}
    __device__ __forceinline__ void done(const Unit&) const {}
};
__device__ __forceinline__ unsigned cvt_pk_bf16(float lo, float hi) { unsigned r; asm volatile("v_cvt_pk_bf16_f32 %0, %1, %2" : "=v"(r) : "v"(lo), "v"(hi)); return r; }

template <class Epi, class Sched, bool ALIGN_EPI = false, bool SP2 = false>
__device__ __forceinline__ void gemm_phase(PG8_LAS unsigned char* lds, const Gemm g, const Sched& S, const Epi& E) {
    const int tid = tid_(), wid = __builtin_amdgcn_readfirstlane(tid >> 6), lane = tid & 63, wr = wid >> 2, wc = wid & 3, fr = lane & 15, fq = lane >> 4;
    const int K = g.ld;
    unsigned voffA[2], voffB[2];
#pragma unroll
    for (int i = 0; i < 2; ++i) { int R, C; stage_rc(tid * 16 + i * 8192, R, C); const int Rb = Epi::PERM ? ((R & ~31) + perm32(R & 31)) : R;
        voffA[i] = (unsigned)(R * K + C) * 2u; voffB[i] = (unsigned)(Rb * K + C) * 2u; }
    const size_t kstep = (size_t)(BK * 2);
    const size_t hstep = (size_t)HALF * K * 2;
    const size_t tstep = 2 * hstep;
    const unsigned ldsw = (unsigned)wid * 1024u;
    const int aoff = lds_byte(wr * 64 + fr, fq * 8), boff = lds_byte(wc * 32 + fr, fq * 8);
#define PG8_SA(b, h) (((b) * 2 + (h)) * HTB)
#define PG8_SB(b, h) ((4 + (b) * 2 + (h)) * HTB)
#define PG8_STAGE(bufoff, gbase, voff) do { _Pragma("unroll") for (int _i = 0; _i < 2; ++_i) \
        __builtin_amdgcn_global_load_lds((const unsigned*)((const char*)(gbase) + (voff)[_i]), (PG8_LAS unsigned*)(lds + (bufoff) + ldsw + _i * 8192), 16, 0, 0); } while (0)
#define PG8_LDA(dst, b, h) do { _Pragma("unroll") for (int m = 0; m < 4; ++m) _Pragma("unroll") for (int k = 0; k < 2; ++k) dst[m][k] = *(const PG8_LAS bf16x8*)(lds + PG8_SA(b, h) + aoff + m * 2048 + k * 1024); } while (0)
#define PG8_LDB(dst, b, h) do { _Pragma("unroll") for (int n = 0; n < 2; ++n) _Pragma("unroll") for (int k = 0; k < 2; ++k) dst[n][k] = *(const PG8_LAS bf16x8*)(lds + PG8_SB(b, h) + boff + n * 2048 + k * 1024); } while (0)
#define PG8_MMA(ai, bj, At, Bt) do { __builtin_amdgcn_s_setprio(1); _Pragma("unroll") for (int m = 0; m < 4; ++m) _Pragma("unroll") for (int n = 0; n < 2; ++n) _Pragma("unroll") for (int k = 0; k < 2; ++k) \
        acc[ai][bj][m][n] = __builtin_amdgcn_mfma_f32_16x16x32_bf16(Bt[n][k], At[m][k], acc[ai][bj][m][n], 0, 0, 0); __builtin_amdgcn_s_setprio(0); } while (0)
#define PG8_WAIT_V(n) asm volatile("s_waitcnt vmcnt(" #n ")" ::: "memory")
#define PG8_WAIT_L(n) asm volatile("s_waitcnt lgkmcnt(" #n ")" ::: "memory")
#define PG8_BAR __builtin_amdgcn_s_barrier()
#define PG8_SCHED __builtin_amdgcn_sched_barrier(0)
    Unit cur, nxt; int ui = 0;
    if (!S.next(0, cur)) return;
    f32x4 acc[2][2][4][2];
#pragma unroll
    for (int a = 0; a < 2; ++a)
#pragma unroll
        for (int b = 0; b < 2; ++b)
#pragma unroll
            for (int m = 0; m < 4; ++m)
#pragma unroll
                for (int n = 0; n < 2; ++n) acc[a][b][m][n] = (f32x4){0.f, 0.f, 0.f, 0.f};
    bf16x8 At[4][2], B0[2][2], B1[2][2];
    const char* cA = (const char*)g.A + (size_t)cur.pm * tstep + (size_t)cur.ko * 2; const char* cB = (const char*)g.Bt + (size_t)cur.pn * tstep + (size_t)cur.ko * 2;
    S.a_ready(cur);
    if constexpr (SP2) {
        PG8_STAGE(PG8_SB(0, 0), cB, voffB); PG8_STAGE(PG8_SB(0, 1), cB + hstep, voffB); PG8_STAGE(PG8_SA(0, 0), cA, voffA); PG8_STAGE(PG8_SA(0, 1), cA + hstep, voffA);
        if (wr == 1) PG8_BAR;
        PG8_WAIT_V(2); PG8_BAR;
        PG8_STAGE(PG8_SB(1, 0), cB + kstep, voffB); PG8_STAGE(PG8_SA(1, 0), cA + kstep, voffA); PG8_STAGE(PG8_SB(1, 1), cB + hstep + kstep, voffB);
        PG8_WAIT_V(6); PG8_BAR;
    } else {
        PG8_STAGE(PG8_SB(0, 0), cB, voffB); PG8_STAGE(PG8_SA(0, 0), cA, voffA); PG8_STAGE(PG8_SB(0, 1), cB + hstep, voffB); PG8_STAGE(PG8_SA(0, 1), cA + hstep, voffA);
        if (wr == 1) PG8_BAR;
        PG8_WAIT_V(4); PG8_BAR;
        PG8_STAGE(PG8_SB(1, 0), cB + kstep, voffB); PG8_STAGE(PG8_SA(1, 0), cA + kstep, voffA); PG8_STAGE(PG8_SB(1, 1), cB + hstep + kstep, voffB);
        PG8_WAIT_V(6); PG8_BAR;
    }
    for (;;) {
        const bool has_next = S.next(ui + 1, nxt);
        const char* nA = has_next ? (const char*)g.A + (size_t)nxt.pm * tstep + (size_t)nxt.ko * 2 : cA; const char* nB = has_next ? (const char*)g.Bt + (size_t)nxt.pn * tstep + (size_t)nxt.ko * 2 : cB;
        const int nt = Sched::PER_UNIT_K ? cur.nt : g.K / BK;
        for (int t = 0; t < nt; t += 2) {
            const bool last = (t == nt - 2);
            const char* a1 = cA + (size_t)(t + 1) * kstep;
            const char* a2 = last ? nA : cA + (size_t)(t + 2) * kstep; const char* b2 = last ? nB : cB + (size_t)(t + 2) * kstep;
            const char* a3 = a2 + kstep; const char* b3 = b2 + kstep;
            if (last && has_next) S.a_ready(nxt);
            if constexpr (SP2) {
            PG8_LDB(B0, 0, 0); PG8_LDB(B1, 0, 1); PG8_SCHED; PG8_LDA(At, 0, 0); PG8_STAGE(PG8_SA(1, 1), a1 + hstep, voffA);
            PG8_WAIT_V(8); PG8_WAIT_L(0); PG8_BAR; PG8_MMA(0, 0, At, B0); PG8_MMA(0, 1, At, B1); PG8_BAR; PG8_SCHED;
            PG8_LDA(At, 0, 1); PG8_STAGE(PG8_SB(0, 0), b2, voffB); PG8_STAGE(PG8_SB(0, 1), b2 + hstep, voffB); PG8_STAGE(PG8_SA(0, 0), a2, voffA);
            PG8_WAIT_V(8); PG8_WAIT_L(0); PG8_BAR; PG8_MMA(1, 0, At, B0); PG8_MMA(1, 1, At, B1); PG8_BAR; PG8_SCHED;
            PG8_LDB(B0, 1, 0); PG8_LDB(B1, 1, 1); PG8_SCHED; PG8_LDA(At, 1, 0); PG8_STAGE(PG8_SA(0, 1), a2 + hstep, voffA);
            PG8_WAIT_V(8); PG8_WAIT_L(0); PG8_BAR; PG8_MMA(0, 0, At, B0); PG8_MMA(0, 1, At, B1); PG8_BAR; PG8_SCHED;
            PG8_LDA(At, 1, 1); PG8_STAGE(PG8_SB(1, 0), b3, voffB); PG8_STAGE(PG8_SB(1, 1), b3 + hstep, voffB); PG8_STAGE(PG8_SA(1, 0), a3, voffA);
            PG8_WAIT_V(8); PG8_WAIT_L(0); PG8_BAR; PG8_MMA(1, 0, At, B0); PG8_MMA(1, 1, At, B1); PG8_BAR; PG8_SCHED;
            } else {
            PG8_LDB(B0, 0, 0); PG8_SCHED; PG8_LDA(At, 0, 0); PG8_STAGE(PG8_SA(1, 1), a1 + hstep, voffA);
            PG8_WAIT_L(8); PG8_BAR; PG8_WAIT_L(0); PG8_MMA(0, 0, At, B0); PG8_BAR; PG8_SCHED;
            PG8_LDB(B1, 0, 1); PG8_STAGE(PG8_SB(0, 0), b2, voffB);
            PG8_BAR; PG8_WAIT_L(0); PG8_MMA(0, 1, At, B1); PG8_BAR;
            PG8_LDA(At, 0, 1); PG8_STAGE(PG8_SA(0, 0), a2, voffA);
            PG8_BAR; PG8_WAIT_L(0); PG8_MMA(1, 0, At, B0); PG8_BAR; PG8_SCHED;
            PG8_STAGE(PG8_SB(0, 1), b2 + hstep, voffB);
            PG8_WAIT_V(6); PG8_BAR; PG8_MMA(1, 1, At, B1); PG8_BAR;
            PG8_LDB(B0, 1, 0); PG8_SCHED; PG8_LDA(At, 1, 0); PG8_STAGE(PG8_SA(0, 1), a2 + hstep, voffA);
            PG8_WAIT_L(8); PG8_BAR; PG8_WAIT_L(0); PG8_MMA(0, 0, At, B0); PG8_BAR; PG8_SCHED;
            PG8_LDB(B1, 1, 1); PG8_STAGE(PG8_SB(1, 0), b3, voffB);
            PG8_BAR; PG8_WAIT_L(0); PG8_MMA(0, 1, At, B1); PG8_BAR;
            PG8_LDA(At, 1, 1); PG8_STAGE(PG8_SA(1, 0), a3, voffA);
            PG8_BAR; PG8_WAIT_L(0); PG8_MMA(1, 0, At, B0); PG8_BAR; PG8_SCHED;
            PG8_STAGE(PG8_SB(1, 1), b3 + hstep, voffB);
            PG8_WAIT_V(6); PG8_BAR; PG8_MMA(1, 1, At, B1); PG8_BAR;
            }
        }
        if constexpr (ALIGN_EPI) { if (wr == 0) PG8_BAR; }
        E(acc, cur, wr, wc, fr, fq);
        if (!has_next) break;
#pragma unroll
        for (int a = 0; a < 2; ++a)
#pragma unroll
            for (int b = 0; b < 2; ++b)
#pragma unroll
                for (int m = 0; m < 4; ++m)
#pragma unroll
                    for (int n = 0; n < 2; ++n) acc[a][b][m][n] = (f32x4){0.f, 0.f, 0.f, 0.f};
        cur = nxt; cA = nA; cB = nB; ++ui;
        if constexpr (ALIGN_EPI) { if (wr == 1) PG8_BAR; }
    }
    PG8_WAIT_V(0);
    if constexpr (!ALIGN_EPI) { if (wr == 0) PG8_BAR; }
    PG8_BAR;
#undef PG8_SA
#undef PG8_SB
#undef PG8_STAGE
#undef PG8_LDA
#undef PG8_LDB
#undef PG8_MMA
#undef PG8_WAIT_V
#undef PG8_WAIT_L
#undef PG8_BAR
#undef PG8_SCHED
}
struct EpiInProj {
    static constexpr bool PERM = true;
    float* PA; bf16_t* QKV;
    __device__ __forceinline__ void operator()(const f32x4 (&acc)[2][2][4][2], const Unit& u, int wr, int wc, int fr, int fq) const {
        const int row0 = u.pm * BM + wr * 64 + fr, colt = u.pn * BM + wc * 32 + 8 * fq;
        if (colt < PAW) {
#pragma unroll
            for (int ai = 0; ai < 2; ++ai)
#pragma unroll
                for (int m = 0; m < 4; ++m) { float* rp = PA + (size_t)(row0 + ai * HALF + m * 16) * PAW + colt;
#pragma unroll
                    for (int bj = 0; bj < 2; ++bj) { *(f32x4*)(rp + bj * HALF) = acc[ai][bj][m][0]; *(f32x4*)(rp + bj * HALF + 4) = acc[ai][bj][m][1]; } }
        } else {
#pragma unroll
            for (int ai = 0; ai < 2; ++ai)
#pragma unroll
                for (int m = 0; m < 4; ++m) { bf16_t* rp = QKV + (size_t)(row0 + ai * HALF + m * 16) * QKVW + (colt - PAW);
#pragma unroll
                    for (int bj = 0; bj < 2; ++bj) { const f32x4 v0 = acc[ai][bj][m][0], v1 = acc[ai][bj][m][1];
                        u32x4 w; w.x = cvt_pk_bf16(v0[0], v0[1]); w.y = cvt_pk_bf16(v0[2], v0[3]); w.z = cvt_pk_bf16(v1[0], v1[1]); w.w = cvt_pk_bf16(v1[2], v1[3]);
                        *(u32x4*)(rp + bj * HALF) = w; } }
        }
    }
};
struct EpiResidual {
    static constexpr bool PERM = true;
    float* Z;
    __device__ __forceinline__ void operator()(const f32x4 (&acc)[2][2][4][2], const Unit& u, int wr, int wc, int fr, int fq) const {
        const int row0 = u.pm * BM + wr * 64 + fr, colt = u.pn * BM + wc * 32 + 8 * fq;
#pragma unroll
        for (int ai = 0; ai < 2; ++ai)
#pragma unroll
            for (int m = 0; m < 4; ++m) { const int row = row0 + ai * HALF + m * 16; if (row < TOK) { float* rp = Z + (size_t)row * DM + colt;
#pragma unroll
                for (int bj = 0; bj < 2; ++bj) { f32x4* p0 = (f32x4*)(rp + bj * HALF); f32x4* p1 = (f32x4*)(rp + bj * HALF + 4);
                    const f32x4 z0 = *p0, z1 = *p1; *p0 = z0 + acc[ai][bj][m][0]; *p1 = z1 + acc[ai][bj][m][1]; } } }
    }
};
struct OutOrder {
    static constexpr bool PER_UNIT_K = true;
    StaticOrder main;
    __device__ bool next(int i, Unit& u) const {
        if (main.next(i, u)) return true;
        const int r0 = (main.nwg + main.G - 1) / main.G;
        const int L = (i - r0) * main.G + main.c; if (i < r0 || L >= 64) return false;
        u.pm = 32; u.pn = L & 7; u.ko = (L >> 3) * 256; u.nt = 4; return true; }
    __device__ __forceinline__ void a_ready(const Unit&) const {}
    __device__ __forceinline__ void done(const Unit&) const {}
};
struct EpiOutProj {
    static constexpr bool PERM = true;
    float* Z; float* ZP;
    __device__ __forceinline__ void operator()(const f32x4 (&acc)[2][2][4][2], const Unit& u, int wr, int wc, int fr, int fq) const {
        const bool tail = u.pm == 32;
        const int row0 = (tail ? (u.ko >> 8) * BM : u.pm * BM) + wr * 64 + fr, colt = u.pn * BM + wc * 32 + 8 * fq;
        float* base = tail ? ZP : Z;
#pragma unroll
        for (int ai = 0; ai < 2; ++ai)
#pragma unroll
            for (int m = 0; m < 4; ++m) { float* rp = base + (size_t)(row0 + ai * HALF + m * 16) * DM + colt;
#pragma unroll
                for (int bj = 0; bj < 2; ++bj) { f32x4* p0 = (f32x4*)(rp + bj * HALF); f32x4* p1 = (f32x4*)(rp + bj * HALF + 4);
                    f32x4 z0 = {0.f, 0.f, 0.f, 0.f}, z1 = {0.f, 0.f, 0.f, 0.f};
                    if (!tail) { z0 = *p0; z1 = *p1; }
                    *p0 = z0 + acc[ai][bj][m][0]; *p1 = z1 + acc[ai][bj][m][1]; } }
    }
};
struct EpiGlu {
    static constexpr bool PERM = true;
    bf16_t* MIX; const float* bias;
    __device__ __forceinline__ void operator()(const f32x4 (&acc)[2][2][4][2], const Unit& u, int wr, int wc, int fr, int fq) const {
        const int row0 = u.pm * BM + wr * 64 + fr, c0 = u.pn * HALF + wc * 32 + 8 * fq;
        const f32x4 bv0 = *(const f32x4*)(bias + c0), bv1 = *(const f32x4*)(bias + c0 + 4), bg0 = *(const f32x4*)(bias + 512 + c0), bg1 = *(const f32x4*)(bias + 512 + c0 + 4);
#pragma unroll
        for (int ai = 0; ai < 2; ++ai)
#pragma unroll
            for (int m = 0; m < 4; ++m) { const f32x4 v0 = acc[ai][0][m][0] + bv0, v1 = acc[ai][0][m][1] + bv1, g0 = acc[ai][1][m][0] + bg0, g1 = acc[ai][1][m][1] + bg1;
                float o[8];
#pragma unroll
                for (int e = 0; e < 4; ++e) { o[e] = v0[e] / (1.f + __expf(-g0[e])); o[4 + e] = v1[e] / (1.f + __expf(-g1[e])); }
                u32x4 w; w.x = cvt_pk_bf16(o[0], o[1]); w.y = cvt_pk_bf16(o[2], o[3]); w.z = cvt_pk_bf16(o[4], o[5]); w.w = cvt_pk_bf16(o[6], o[7]);
                *(u32x4*)(MIX + (size_t)(row0 + ai * HALF + m * 16) * DM + 512 + c0) = w; }
    }
};
}

__device__ __forceinline__ void transpose_item(const float* W, int K, int N, bf16_t* WT, int k0, int n0, int row0, float* scr, int lane) {
#pragma unroll 8
    for (int i = 0; i < 32; ++i) { const int kk = 2 * i + (lane >> 5); scr[kk * 33 + (lane & 31)] = W[(size_t)(k0 + kk) * N + n0 + (lane & 31)]; }
    asm volatile("s_waitcnt lgkmcnt(0)" ::: "memory");
    const int c = lane & 7;
#pragma unroll
    for (int j = 0; j < 4; ++j) { const int n = (lane >> 3) + 8 * j; const float* sp = scr + (8 * c) * 33 + n;
        pg8::u32x4 o; o.x = pg8::cvt_pk_bf16(sp[0 * 33], sp[1 * 33]); o.y = pg8::cvt_pk_bf16(sp[2 * 33], sp[3 * 33]); o.z = pg8::cvt_pk_bf16(sp[4 * 33], sp[5 * 33]); o.w = pg8::cvt_pk_bf16(sp[6 * 33], sp[7 * 33]);
        *(pg8::u32x4*)(WT + (size_t)(row0 + n) * K + k0 + 8 * c) = o; }
    asm volatile("s_waitcnt lgkmcnt(0)" ::: "memory");
}
__device__ __forceinline__ void ph_weights(KP P, char* lds) {
    const int tid = tid_(), lane = tid & 63, wave = tid >> 6;
    float* scr = (float*)lds + wave * (64 * 33);
    const int gw = bid_() * 8 + wave, NGW = gridDim.x * 8;
    constexpr int I_IN = (DM / 64) * (INW / 32), I_OUT = (DM / 64) * (DM / 32), I_GLU = (512 / 64) * (1024 / 32), I_L = I_IN + I_OUT + I_GLU;
    for (int it = gw; it < 2 * I_L; it += NGW) {
        const int layer = it / I_L; int r = it % I_L;
        if (r < I_IN) { const int nb = INW / 32, kb = r / nb, n0 = (r % nb) * 32;
            transpose_item(P->w_in + (size_t)layer * DM * INW, DM, INW, P->WinT + (size_t)layer * INW * DM, kb * 64, n0, n0, scr, lane); continue; }
        r -= I_IN;
        if (r < I_OUT) { const int nb = DM / 32, kb = r / nb, n0 = (r % nb) * 32;
            transpose_item(P->w_out + (size_t)layer * DM * DM, DM, DM, P->WoutT + (size_t)layer * DM * DM, kb * 64, n0, n0, scr, lane); continue; }
        r -= I_OUT;
        { const int nb = 1024 / 32, kb = r / nb, n0 = (r % nb) * 32;
          const int row0 = ((n0 & 511) >> 7) * 256 + (n0 >> 9) * 128 + (n0 & 127);
          transpose_item(P->w_glu + (size_t)layer * 512 * 1024, 512, 1024, P->WgluT + (size_t)layer * 1024 * 512, kb * 64, n0, row0, scr, lane); }
    }
}


namespace fa {
using bf16x8 = __attribute__((ext_vector_type(8))) short;
using s16x4  = __attribute__((ext_vector_type(4))) short;
using f32x16 = __attribute__((ext_vector_type(16))) float;
using u32x4  = __attribute__((ext_vector_type(4))) unsigned;
constexpr int D = 128, NW = 8, QBLK = 32, KVBLK = 64, LDQK = QKVW;
constexpr float SCALE = 0.088388347648318440f, THR = 8.f, NEG = -1e30f;
constexpr size_t SHM_V = KVBLK * D * 2, SHM_K = KVBLK * D * 2, SHM_ATTN = 2 * SHM_V + 2 * SHM_K + NW * 64 * 4;
#define KSWZ(row, colB) ((row) * 256 + ((colB) ^ (((row) & 7) << 4)))
#define SBAR() __builtin_amdgcn_sched_barrier(0)
__device__ __forceinline__ int crow(int r, int hi) { return (r & 3) + 8 * (r >> 2) + 4 * hi; }
__device__ __forceinline__ unsigned cvtpk(float lo, float hi) { unsigned r; asm volatile("v_cvt_pk_bf16_f32 %0, %1, %2" : "=v"(r) : "v"(lo), "v"(hi)); return r; }
__device__ __forceinline__ void partialSM(f32x16& p0, f32x16& p1, float& m_reg, float& mn, float& alpha) {
  constexpr float C = SCALE * 1.4426950408889634f;
  float pmax = p0[0]; for (int r = 1; r < 16; ++r) pmax = fmaxf(pmax, p0[r]); for (int r = 0; r < 16; ++r) pmax = fmaxf(pmax, p1[r]);
  { auto rr = __builtin_amdgcn_permlane32_swap(__float_as_uint(pmax), __float_as_uint(pmax), false, false);
    pmax = fmaxf(__uint_as_float(rr[0]), __uint_as_float(rr[1])); }
  if (__builtin_expect(__all(pmax - m_reg <= THR / SCALE), 1)) { mn = m_reg; alpha = 1.f; }
  else { mn = fmaxf(m_reg, pmax); alpha = __builtin_amdgcn_exp2f((m_reg - mn) * C); m_reg = mn; }
  float mnC = -mn * C;
  for (int r = 0; r < 16; ++r) p0[r] = fmaf(p0[r], C, mnC); for (int r = 0; r < 16; ++r) p1[r] = fmaf(p1[r], C, mnC);
  for (int r = 0; r < 16; ++r) p0[r] = __builtin_amdgcn_exp2f(p0[r]);
}
__device__ __forceinline__ void finishSM(f32x16& p0, f32x16& p1, float alpha, float& l_reg, bf16x8& pa0, bf16x8& pa1, bf16x8& pa2, bf16x8& pa3) {
  for (int r = 0; r < 16; ++r) p1[r] = __builtin_amdgcn_exp2f(p1[r]);
  float ps = 0; for (int r = 0; r < 16; ++r) ps += p0[r]; for (int r = 0; r < 16; ++r) ps += p1[r];
  { auto rr = __builtin_amdgcn_permlane32_swap(__float_as_uint(ps), __float_as_uint(ps), false, false);
    ps = __uint_as_float(rr[0]) + __uint_as_float(rr[1]); }
  l_reg = l_reg * alpha + ps;
#define PK4(P, BASE, OUT) do { unsigned a0 = cvtpk(P[BASE + 0], P[BASE + 1]), a1 = cvtpk(P[BASE + 2], P[BASE + 3]);   \
    unsigned b0 = cvtpk(P[BASE + 4], P[BASE + 5]), b1 = cvtpk(P[BASE + 6], P[BASE + 7]);                              \
    auto r0 = __builtin_amdgcn_permlane32_swap(a0, b0, false, false); auto r1 = __builtin_amdgcn_permlane32_swap(a1, b1, false, false); \
    u32x4 w = {r0[0], r1[0], r0[1], r1[1]}; OUT = *reinterpret_cast<bf16x8*>(&w); } while (0)
  PK4(p0, 0, pa0); PK4(p0, 8, pa1); PK4(p1, 0, pa2); PK4(p1, 8, pa3);
#undef PK4
}
__device__ __forceinline__ void qkt(f32x16& p0, f32x16& p1, const bf16_t* Ks, const bf16x8* qr, int r32, int hi) {
  p0 = f32x16{}; p1 = f32x16{};
  for (int d0 = 0; d0 < 8; ++d0) { int cb = (d0 * 16 + hi * 8) * 2;
    bf16x8 b0 = *reinterpret_cast<const bf16x8*>((const char*)Ks + KSWZ(r32, cb));
    bf16x8 b1 = *reinterpret_cast<const bf16x8*>((const char*)Ks + KSWZ(32 + r32, cb));
    p0 = __builtin_amdgcn_mfma_f32_32x32x16_bf16(b0, qr[d0], p0, 0, 0, 0);
    p1 = __builtin_amdgcn_mfma_f32_32x32x16_bf16(b1, qr[d0], p1, 0, 0, 0); }
}
__device__ __forceinline__ void mask_tile(f32x16& p0, f32x16& p1, int kt, int vis) {
  if (kt > vis) {
    const bool part = (kt == vis + 1);
    for (int r = 0; r < 16; ++r) p1[r] = NEG;
    for (int r = 8; r < 16; ++r) p0[r] = NEG;
    if (!part) for (int r = 0; r < 8; ++r) p0[r] = NEG;
  }
}
__device__ __forceinline__ int v_st(int k, int c) { const int kk = (k & ~0xC) | ((k & 4) << 1) | ((k & 8) >> 1); return ((kk >> 3) * 4 + (c >> 5)) * 512 + ((kk & 7) * 32 + (c & 31)) * 2; }
__device__ __forceinline__ int v_rd_base(int lane) { return ((lane & 3) << 3) | (((lane >> 2) & 3) << 6) | (((lane >> 4) & 1) << 5) | (((lane >> 5) & 1) << 8); }
constexpr int v_rd_off(int d0, int ks, int half) { return d0 * 512 + ks * 4096 + half * 2048; }
template <int OFF> __device__ __forceinline__ s16x4 tr_read(int vb) {
  s16x4 r; asm volatile("ds_read_b64_tr_b16 %0, %1 offset:%2" : "=&v"(r) : "v"(vb), "i"(OFF) : "memory"); return r;
}
template <int D0> __device__ __forceinline__ void pv_one(f32x16& od, int vb, bf16x8 pa0, bf16x8 pa1, bf16x8 pa2, bf16x8 pa3) {
  const s16x4 l0 = tr_read<v_rd_off(D0, 0, 0)>(vb), h0 = tr_read<v_rd_off(D0, 0, 1)>(vb), l1 = tr_read<v_rd_off(D0, 1, 0)>(vb), h1 = tr_read<v_rd_off(D0, 1, 1)>(vb);
  const s16x4 l2 = tr_read<v_rd_off(D0, 2, 0)>(vb), h2 = tr_read<v_rd_off(D0, 2, 1)>(vb), l3 = tr_read<v_rd_off(D0, 3, 0)>(vb), h3 = tr_read<v_rd_off(D0, 3, 1)>(vb);
  asm volatile("s_waitcnt lgkmcnt(0)" ::: "memory"); SBAR();
#define PK(L, H) (bf16x8){L[0], L[1], L[2], L[3], H[0], H[1], H[2], H[3]}
  od = __builtin_amdgcn_mfma_f32_32x32x16_bf16(pa0, PK(l0, h0), od, 0, 0, 0);
  od = __builtin_amdgcn_mfma_f32_32x32x16_bf16(pa1, PK(l1, h1), od, 0, 0, 0);
  od = __builtin_amdgcn_mfma_f32_32x32x16_bf16(pa2, PK(l2, h2), od, 0, 0, 0);
  od = __builtin_amdgcn_mfma_f32_32x32x16_bf16(pa3, PK(l3, h3), od, 0, 0, 0);
#undef PK
}
__device__ __forceinline__ void pv_d0(f32x16* o, int vb, bf16x8 pa0, bf16x8 pa1, bf16x8 pa2, bf16x8 pa3) {
  pv_one<0>(o[0], vb, pa0, pa1, pa2, pa3); pv_one<1>(o[1], vb, pa0, pa1, pa2, pa3); pv_one<2>(o[2], vb, pa0, pa1, pa2, pa3); pv_one<3>(o[3], vb, pa0, pa1, pa2, pa3);
}
__device__ __forceinline__ void attn_unit(const bf16_t* __restrict__ Qb, const bf16_t* __restrict__ Kh, const bf16_t* __restrict__ Vh, float* __restrict__ Ob, int NT, int vis4, char* lds) {
  const int tid = tid_(), wid = tid >> 6, lane = tid & 63, r32 = lane & 31, hi = lane >> 5;
  const int vis = vis4 + (wid >> 1);
  bf16_t* V_lds = (bf16_t*)lds; bf16_t* K_lds = (bf16_t*)(lds + 2 * SHM_V);
  float* ws = (float*)(lds + 2 * SHM_V + 2 * SHM_K) + wid * 64; float* li_l = ws; float* al_l = ws + 32;
  float m_reg = NEG, l_reg = 0; f32x16 o[4] = {}; bf16x8 qr[8];
  const bf16_t* Qw = Qb + (long)(wid * QBLK + r32) * LDQK + hi * 8;
#pragma unroll
  for (int d0 = 0; d0 < 8; ++d0) qr[d0] = *reinterpret_cast<const bf16x8*>(Qw + d0 * 16);
  const int sr = tid >> 4, sc = (tid & 15) * 8, vst0 = v_st(sr, sc), vst1 = v_st(32 + sr, sc);
  const int vb0 = (int)(uintptr_t)V_lds + v_rd_base(lane);
  struct { bf16x8 vs0, vs1, ks0, ks1; } sr_[2];
#define SLOAD(i, k0) do { sr_[i].vs0 = *reinterpret_cast<const bf16x8*>(&Vh[(long)((k0) + sr) * LDQK + sc]); sr_[i].vs1 = *reinterpret_cast<const bf16x8*>(&Vh[(long)((k0) + 32 + sr) * LDQK + sc]); \
    sr_[i].ks0 = *reinterpret_cast<const bf16x8*>(&Kh[(long)((k0) + sr) * LDQK + sc]); sr_[i].ks1 = *reinterpret_cast<const bf16x8*>(&Kh[(long)((k0) + 32 + sr) * LDQK + sc]); } while (0)
#define SWRITE(b, i) do { *(bf16x8*)((char*)V_lds + (b) * SHM_V + vst0) = sr_[i].vs0;          \
    *(bf16x8*)((char*)V_lds + (b) * SHM_V + vst1) = sr_[i].vs1; int kc = sc * 2;               \
    *(bf16x8*)((char*)K_lds + (b) * SHM_K + KSWZ(sr, kc)) = sr_[i].ks0;                       \
    *(bf16x8*)((char*)K_lds + (b) * SHM_K + KSWZ(32 + sr, kc)) = sr_[i].ks1; } while (0)
#define SWAIT() asm volatile("s_waitcnt vmcnt(4)" ::: "memory")
#define RESC(a) do { if (__any((a) < 1.f)) { if (hi == 0) al_l[r32] = (a); asm volatile("s_waitcnt lgkmcnt(0)" ::: "memory"); \
    for (int d = 0; d < 4; ++d) for (int r = 0; r < 16; ++r) o[d][r] *= al_l[crow(r, hi)]; } } while (0)
  f32x16 pA0, pA1, pB0, pB1; float mnA, mnB, alA, alB; bf16x8 pa0, pa1, pa2, pa3;
  constexpr int SE = 0, SO = 1;
  SLOAD(SE, 0); asm volatile("s_waitcnt vmcnt(0)" ::: "memory"); SWRITE(0, SE); __syncthreads();
  qkt(pA0, pA1, K_lds, qr, r32, hi); mask_tile(pA0, pA1, 0, vis); partialSM(pA0, pA1, m_reg, mnA, alA);
  SLOAD(SO, KVBLK); if (2 < NT) SLOAD(SE, 2 * KVBLK);
  SWAIT(); SWRITE(1, SO); __syncthreads();
  for (int j = 1; j + 1 < NT; j += 2) {
    SBAR(); qkt(pB0, pB1, (bf16_t*)((char*)K_lds + SHM_K), qr, r32, hi); mask_tile(pB0, pB1, j, vis);
    finishSM(pA0, pA1, alA, l_reg, pa0, pa1, pa2, pa3); SBAR();
    SLOAD(SO, (j + 2) * KVBLK); SBAR();
    pv_d0(o, vb0, pa0, pa1, pa2, pa3); partialSM(pB0, pB1, m_reg, mnB, alB);
    __syncthreads(); SWAIT(); SWRITE(0, SE);
    RESC(alB); __syncthreads();
    SBAR(); qkt(pA0, pA1, K_lds, qr, r32, hi); mask_tile(pA0, pA1, j + 1, vis);
    finishSM(pB0, pB1, alB, l_reg, pa0, pa1, pa2, pa3); SBAR();
    if (j + 3 < NT) SLOAD(SE, (j + 3) * KVBLK); SBAR();
    pv_d0(o, vb0 + (int)SHM_V, pa0, pa1, pa2, pa3); partialSM(pA0, pA1, m_reg, mnA, alA);
    __syncthreads(); SWAIT(); SWRITE(1, SO);
    RESC(alA); __syncthreads();
  }
  SBAR(); qkt(pB0, pB1, (bf16_t*)((char*)K_lds + SHM_K), qr, r32, hi); mask_tile(pB0, pB1, NT - 1, vis);
  finishSM(pA0, pA1, alA, l_reg, pa0, pa1, pa2, pa3); SBAR();
  pv_d0(o, vb0, pa0, pa1, pa2, pa3); partialSM(pB0, pB1, m_reg, mnB, alB);
  __syncthreads(); RESC(alB);
  finishSM(pB0, pB1, alB, l_reg, pa0, pa1, pa2, pa3); SBAR();
  pv_d0(o, vb0 + (int)SHM_V, pa0, pa1, pa2, pa3);
  if (hi == 0) li_l[r32] = l_reg; asm volatile("s_waitcnt lgkmcnt(0)" ::: "memory");
  float rli[16];
#pragma unroll
  for (int r = 0; r < 16; ++r) rli[r] = __builtin_amdgcn_rcpf(li_l[crow(r, hi)]);
  float* Ow = Ob + (long)(wid * QBLK) * DM;
#pragma unroll
  for (int r = 0; r < 16; ++r) { int orow = crow(r, hi);
    for (int d0 = 0; d0 < 4; ++d0) Ow[(long)orow * DM + d0 * 32 + r32] = o[d0][r] * rli[r]; }
  __syncthreads();
#undef SLOAD
#undef SWRITE
#undef SWAIT
#undef RESC
}
#undef KSWZ
#undef SBAR
}

__device__ __forceinline__ void ph_attention(KP P, char* lds) {
    const bf16_t* QKV = P->QKV; float* OC = P->OC;
#pragma unroll 1
    for (int c = bid_(); c < 256; c += gridDim.x) {
        const int combo = c >> 2, b = combo >> 4, h = (combo >> 2) & 3, i = (combo >> 1) & 1, vh = combo & 1;
        const bf16_t* Kh = QKV + (size_t)(b * LL) * QKVW + 1024 + h * 256 + i * 128;
        const bf16_t* Vh = QKV + (size_t)(b * LL) * QKVW + 2048 + h * 256 + vh * 128;
#pragma unroll 1
        for (int s = 0; s < 2; ++s) {
            const int jb = s == 0 ? (c & 3) : 7 - (c & 3);
            const size_t row0 = (size_t)(b * LL) + NMETA + 256 * jb;
            fa::attn_unit(QKV + row0 * QKVW + h * 256 + i * 128, Kh, Vh, OC + row0 * DM + h * 512 + i * 256 + vh * 128, 4 * jb + 6, 4 * jb, lds);
        }
    }
#pragma unroll 1
    for (int gw0 = bid_() * 8; gw0 < 512; gw0 += gridDim.x * 8) {
        const int tid = tid_(), lane = tid & 63, gw = gw0 + (tid >> 6);
        if (gw < 512) {
            const int b = gw >> 7, h = (gw >> 5) & 3, i = (gw >> 4) & 1, row = gw & 15;
            const bf16_t* q = QKV + (size_t)(b * LL + row) * QKVW + h * 256 + i * 128;
            const int key = lane & 15;
            const bf16_t* k = QKV + (size_t)(b * LL + key) * QKVW + 1024 + h * 256 + i * 128;
            float sc = 0.f;
            for (int d = 0; d < 128; ++d) sc = fmaf(bf2f(q[d]), bf2f(k[d]), sc);
            sc *= 0.08838834764831845f;
            float m = sc;
#pragma unroll
            for (int o = 8; o > 0; o >>= 1) m = fmaxf(m, __shfl_xor(m, o));
            const float e = expf(sc - m);
            float ssum = e;
#pragma unroll
            for (int o = 8; o > 0; o >>= 1) ssum += __shfl_xor(ssum, o);
            const float p = e / ssum;
            float acc[4] = {0.f, 0.f, 0.f, 0.f};
#pragma unroll
            for (int j = 0; j < 16; ++j) {
                const float pj = __int_as_float(__builtin_amdgcn_readlane(__float_as_int(p), j));
                const bf16_t* v = QKV + (size_t)(b * LL + j) * QKVW + 2048 + h * 256 + lane * 4;
#pragma unroll
                for (int e2 = 0; e2 < 4; ++e2) acc[e2] = fmaf(pj, bf2f(v[e2]), acc[e2]);
            }
            float* o = OC + (size_t)(b * LL + row) * DM + h * 512 + i * 256 + lane * 4;
            o[0] = acc[0]; o[1] = acc[1]; o[2] = acc[2]; o[3] = acc[3];
        }
    }
}


namespace hg {
using bf16x8 = __attribute__((ext_vector_type(8))) short;
using s16x4  = __attribute__((ext_vector_type(4))) short;
using f32x16 = __attribute__((ext_vector_type(16))) float;
using u32x4  = __attribute__((ext_vector_type(4))) unsigned;
constexpr int NCH = 33, NU = 16 * NCH;
constexpr int SK = 136;
constexpr int SS = 72;
__device__ __forceinline__ int crow(int r, int hi) { return (r & 3) + 8 * (r >> 2) + 4 * hi; }
__device__ __forceinline__ unsigned cvtpk(float lo, float hi) { unsigned r; asm volatile("v_cvt_pk_bf16_f32 %0, %1, %2" : "=v"(r) : "v"(lo), "v"(hi)); return r; }

__device__ __forceinline__ void prep(const float* PA, const float* lbtab, size_t row0, int c, int h, int k, int tq, float* qsum, float (&b)[16], float (&kk)[16], float& bend, float& r) {
    const float lbv = lbtab[h * 128 + k];
    float run = 0.f;
#pragma unroll
    for (int i = 0; i < 16; ++i) {
        const int t = 16 * tq + i; const bool valid = (c * 64 + t) < LL;
        const float fp = valid ? PA[(row0 + t) * PAW + 512 + h * 128 + k] : 0.f;
        const float kv = valid ? (1.f - lbv) / (1.f + __expf(fp)) : 0.f;
        kk[i] = kv; run += fmaxf(log1pf(-kv), -30.f); b[i] = run;
    }
    qsum[tq * 128 + k] = run;
    __syncthreads();
    const float q0 = qsum[k], q1 = qsum[128 + k], q2 = qsum[256 + k], q3 = qsum[384 + k];
    const float off = tq == 0 ? 0.f : (tq == 1 ? q0 : (tq == 2 ? q0 + q1 : q0 + q1 + q2));
    r = q0 + q1; bend = (q0 + q1) + (q2 + q3);
#pragma unroll
    for (int i = 0; i < 16; ++i) b[i] += off;
}
__device__ __forceinline__ void store16(bf16_t* dst, const float (&x)[16]) {
    u32x4 w0, w1;
    w0.x = cvtpk(x[0], x[1]); w0.y = cvtpk(x[2], x[3]); w0.z = cvtpk(x[4], x[5]); w0.w = cvtpk(x[6], x[7]);
    w1.x = cvtpk(x[8], x[9]); w1.y = cvtpk(x[10], x[11]); w1.z = cvtpk(x[12], x[13]); w1.w = cvtpk(x[14], x[15]);
    *(u32x4*)dst = w0; *(u32x4*)(dst + 8) = w1;
}

__device__ __forceinline__ void local_states(KP P, char* lds, int layer) {
    bf16_t* KhT = (bf16_t*)lds; bf16_t* VT = KhT + 128 * SS; float* qsum = (float*)(VT + 128 * SS);
    const float* PA = P->PA; const float* lbtab = P->lbtab + layer * 512; float* SLOC = P->SLOC; float* DEC = P->DEC;
    const int tid = tid_(), k = tid & 127, tq = tid >> 7, lane = tid & 63, wid = tid >> 6, r32 = lane & 31, hh = lane >> 5;
    for (int u = bid_(); u < NU; u += gridDim.x) {
        const int bh = u / NCH, c = u % NCH, b_ = bh >> 2, h = bh & 3; const size_t row0 = (size_t)b_ * LL + c * 64;
        float b[16], kk[16], bend, r;
        prep(PA, lbtab, row0, c, h, k, tq, qsum, b, kk, bend, r);
        float x[16];
#pragma unroll
        for (int i = 0; i < 16; ++i) x[i] = kk[i] * __expf(bend - b[i]);
        store16(KhT + k * SS + 16 * tq, x);
#pragma unroll
        for (int i = 0; i < 16; ++i) { const int t = 16 * tq + i; x[i] = (c * 64 + t) < LL ? PA[(row0 + t) * PAW + 1024 + h * 128 + k] : 0.f; }
        store16(VT + k * SS + 16 * tq, x);
        if (tq == 0) DEC[u * 128 + k] = __expf(bend);
        __syncthreads();
        const int vt = wid >> 1;
#pragma unroll
        for (int j = 0; j < 2; ++j) {
            const int kt = (wid & 1) * 2 + j;
            f32x16 acc = {};
#pragma unroll
            for (int sg = 0; sg < 4; ++sg) {
                const bf16x8 a = *(const bf16x8*)(VT + (vt * 32 + r32) * SS + sg * 16 + hh * 8);
                const bf16x8 bb = *(const bf16x8*)(KhT + (kt * 32 + r32) * SS + sg * 16 + hh * 8);
                acc = __builtin_amdgcn_mfma_f32_32x32x16_bf16(a, bb, acc, 0, 0, 0);
            }
            float* o = SLOC + (size_t)u * 16384 + kt * 32 + r32;
#pragma unroll
            for (int rg = 0; rg < 16; ++rg) o[(vt * 32 + crow(rg, hh)) * 128] = acc[rg];
        }
        __syncthreads();
    }
}
__device__ __forceinline__ void scan_states(KP P) {
    const float* SLOC = P->SLOC; const float* DEC = P->DEC; bf16_t* SPREV = P->SPREV;
    const int tid = tid_();
    for (int e = bid_() * NTHR + tid; e < 16 * 16384; e += gridDim.x * NTHR) {
        const int bh = e >> 14, vk = e & 16383, k = vk & 127;
        float d[NCH - 1], x[NCH - 1];
#pragma unroll
        for (int c = 0; c < NCH - 1; ++c) { const int u = bh * NCH + c; d[c] = DEC[u * 128 + k]; x[c] = SLOC[(size_t)u * 16384 + vk]; }
        float S = 0.f;
#pragma unroll
        for (int c = 0; c < NCH - 1; ++c) { S = fmaf(d[c], S, x[c]); SPREV[(size_t)(bh * NCH + c + 1) * 16384 + vk] = f2bf(S); }
    }
}
__device__ __forceinline__ void outputs(KP P, char* lds, int layer) {
    bf16_t* Qt = (bf16_t*)lds; bf16_t* Qh = Qt + 64 * SK; bf16_t* Kt = Qh + 64 * SK; bf16_t* VT = Kt + 64 * SK; bf16_t* SpT = VT + 128 * SS;
    float* qsum = (float*)(SpT + 128 * SK); float* part = qsum + 512;
    const float* PA = P->PA; const float* lbtab = P->lbtab + layer * 512; const bf16_t* SPREV = P->SPREV; const float* nw = P->hnw + layer * 128; bf16_t* MIX = P->MIX;
    const int tid = tid_(), k = tid & 127, tq = tid >> 7, lane = tid & 63, wid = tid >> 6, r32 = lane & 31, hh = lane >> 5;
    for (int u = bid_(); u < NU; u += gridDim.x) {
        const int bh = u / NCH, c = u % NCH, b_ = bh >> 2, h = bh & 3; const size_t row0 = (size_t)b_ * LL + c * 64;
        float b[16], kk[16], bend, r;
        prep(PA, lbtab, row0, c, h, k, tq, qsum, b, kk, bend, r);
#pragma unroll
        for (int i = 0; i < 16; ++i) { const int t = 16 * tq + i; const bool valid = (c * 64 + t) < LL;
            const float q = valid ? PA[(row0 + t) * PAW + h * 128 + k] : 0.f;
            Qt[t * SK + k] = f2bf(q * __expf(b[i] - r)); Qh[t * SK + k] = f2bf(q * __expf(b[i])); Kt[t * SK + k] = f2bf(kk[i] * __expf(r - b[i])); }
        { float x[16];
#pragma unroll
          for (int i = 0; i < 16; ++i) { const int t = 16 * tq + i; x[i] = (c * 64 + t) < LL ? PA[(row0 + t) * PAW + 1024 + h * 128 + k] : 0.f; }
          store16(VT + k * SS + 16 * tq, x); }
        if (c > 0) {
#pragma unroll
            for (int j = 0; j < 4; ++j) { const int idx = tid + 512 * j, v = idx >> 4, ch = idx & 15;
                *(u32x4*)(SpT + v * SK + ch * 8) = *(const u32x4*)(SPREV + (size_t)u * 16384 + v * 128 + ch * 8); }
        }
        __syncthreads();
        const int tt = wid & 1, vt = wid >> 1;
        f32x16 oacc = {};
#pragma unroll
        for (int st = 0; st < 2; ++st) {
            if (st <= tt) {
                f32x16 sc = {};
#pragma unroll
                for (int d0 = 0; d0 < 8; ++d0) {
                    const bf16x8 a = *(const bf16x8*)(Kt + (st * 32 + r32) * SK + d0 * 16 + hh * 8);
                    const bf16x8 bq = *(const bf16x8*)(Qt + (tt * 32 + r32) * SK + d0 * 16 + hh * 8);
                    sc = __builtin_amdgcn_mfma_f32_32x32x16_bf16(a, bq, sc, 0, 0, 0);
                }
                if (st == tt) {
#pragma unroll
                    for (int rg = 0; rg < 16; ++rg) sc[rg] = (crow(rg, hh) <= r32) ? sc[rg] : 0.f;
                }
#pragma unroll
                for (int g = 0; g < 2; ++g) {
                    u32x4 w; w.x = cvtpk(sc[8 * g + 0], sc[8 * g + 1]); w.y = cvtpk(sc[8 * g + 2], sc[8 * g + 3]); w.z = cvtpk(sc[8 * g + 4], sc[8 * g + 5]); w.w = cvtpk(sc[8 * g + 6], sc[8 * g + 7]);
                    const bf16x8 pb = *reinterpret_cast<bf16x8*>(&w);
                    const bf16_t* vp = VT + (vt * 32 + r32) * SS + st * 32 + 16 * g + 4 * hh;
                    const s16x4 lo = *(const s16x4*)vp, hi4 = *(const s16x4*)(vp + 8);
                    const bf16x8 a = (bf16x8){lo[0], lo[1], lo[2], lo[3], hi4[0], hi4[1], hi4[2], hi4[3]};
                    oacc = __builtin_amdgcn_mfma_f32_32x32x16_bf16(a, pb, oacc, 0, 0, 0);
                }
            }
        }
        if (c > 0) {
#pragma unroll
            for (int d0 = 0; d0 < 8; ++d0) {
                const bf16x8 a = *(const bf16x8*)(SpT + (vt * 32 + r32) * SK + d0 * 16 + hh * 8);
                const bf16x8 bq = *(const bf16x8*)(Qh + (tt * 32 + r32) * SK + d0 * 16 + hh * 8);
                oacc = __builtin_amdgcn_mfma_f32_32x32x16_bf16(a, bq, oacc, 0, 0, 0);
            }
        }
        float ss = 0.f;
#pragma unroll
        for (int rg = 0; rg < 16; ++rg) ss = fmaf(oacc[rg], oacc[rg], ss);
        { auto rr = __builtin_amdgcn_permlane32_swap(__float_as_uint(ss), __float_as_uint(ss), false, false); ss = __uint_as_float(rr[0]) + __uint_as_float(rr[1]); }
        if (hh == 0) part[vt * 64 + tt * 32 + r32] = ss;
        __syncthreads();
        const int t = tt * 32 + r32;
        const float tot = (part[t] + part[64 + t]) + (part[128 + t] + part[192 + t]);
        const float scale = rsqrtf(tot * (1.f / 128.f) + EPS);
        if ((c * 64 + t) < LL) {
            const float* gp = PA + (row0 + t) * PAW + 1536 + h * 128 + vt * 32;
            bf16_t* op = MIX + (row0 + t) * DM + h * 128 + vt * 32;
#pragma unroll
            for (int g4 = 0; g4 < 4; ++g4) {
                const int v0 = 8 * g4 + 4 * hh;
                const float4 gv = *(const float4*)(gp + v0); const float4 wv = *(const float4*)(nw + vt * 32 + v0);
                const float y0 = oacc[4 * g4 + 0] * scale * wv.x * gv.x / (1.f + __expf(-gv.x)), y1 = oacc[4 * g4 + 1] * scale * wv.y * gv.y / (1.f + __expf(-gv.y));
                const float y2 = oacc[4 * g4 + 2] * scale * wv.z * gv.z / (1.f + __expf(-gv.z)), y3 = oacc[4 * g4 + 3] * scale * wv.w * gv.w / (1.f + __expf(-gv.w));
                uint2 w; w.x = cvtpk(y0, y1); w.y = cvtpk(y2, y3);
                *(uint2*)(op + v0) = w;
            }
        }
        __syncthreads();
    }
}
}


namespace moe {
using bf16x8 = __attribute__((ext_vector_type(8))) short;
using f32x16 = __attribute__((ext_vector_type(16))) float;
using u32x4  = __attribute__((ext_vector_type(4))) unsigned;
constexpr int TW = 5, PROWS = 64 * TW, XS = 144, XBUF = PROWS * XS;
__device__ __forceinline__ unsigned cvtpk(float lo, float hi) { unsigned r; asm volatile("v_cvt_pk_bf16_f32 %0, %1, %2" : "=v"(r) : "v"(lo), "v"(hi)); return r; }
#define MOE_BAR() asm volatile("s_waitcnt lgkmcnt(0)\n\ts_barrier" ::: "memory")
constexpr int WD = 2;
constexpr int ABUF = 4 * 4 * 1024, AOFF = 2 * XBUF, LOFF = AOFF + 2 * ABUF;
template <bool UP>
__device__ __forceinline__ void stream_gemm(KP P, char* lds, int layer) {
    constexpr int KTOT = UP ? DM : DE, NSLAB = KTOT / 64, NCP = UP ? 2 : 4, LDW = UP ? DE : DM;
    static_assert(NSLAB % WD == 0 && NSLAB >= 2 * WD, "slab loop is unrolled by WD");
    const int tid = tid_(), lane = tid & 63, wid = tid >> 6, r32 = lane & 31, hh = lane >> 5, cg = wid & 3, th = wid >> 2;
    const int* cnt_ = P->cnt;
    const bf16_t* X = UP ? P->HN : P->H;
    int* basel = (int*)(lds + LOFF); int* tlist = basel + 64;
    for (int ub = bid_(); ub < 256; ub += gridDim.x) {
        const int u = ((ub & 7) << 5) | (ub >> 3);
        const int e = u >> 2, ns = u & 3;
        const int rot = (u * 11) & (NSLAB - 1);
        __syncthreads();
        if (tid < 64) { const int c = cnt_[tid]; int inc = c;
#pragma unroll
            for (int o = 1; o < 64; o <<= 1) { const int v = __shfl_up(inc, o); if (lane >= o) inc += v; }
            basel[tid] = inc - c; }
        __syncthreads();
        const int cnt = cnt_[e], row0 = basel[e];
        for (int pass0 = 0; pass0 < cnt; pass0 += PROWS) {
            const int cntp = (cnt - pass0) < PROWS ? (cnt - pass0) : PROWS;
            if constexpr (UP) { if (cnt <= ECAP) {
                __syncthreads();
                if (tid < PROWS && pass0 + tid < cnt) tlist[tid] = P->elist[e * ECAP + pass0 + tid];
                __syncthreads();
              } else {
                __syncthreads();
                const int* ridx = P->ridx; const int* rslot = P->rslot;
#pragma unroll 1
                for (int i0 = tid; i0 < NASSIGN; i0 += NTHR * 8) {
                    int ex[8], sl[8];
#pragma unroll
                    for (int q = 0; q < 8; ++q) { const int i = i0 + NTHR * q; ex[q] = i < NASSIGN ? ridx[i] : -1; sl[q] = i < NASSIGN ? rslot[i] : 0; }
#pragma unroll
                    for (int q = 0; q < 8; ++q) { const int sp = sl[q] - pass0; if (ex[q] == e && sp >= 0 && sp < PROWS) tlist[sp] = (i0 + NTHR * q) >> 1; }
                }
                __syncthreads();
            } }
            int xoff[5];
#pragma unroll
            for (int j = 0; j < 5; ++j) { int rho = (tid >> 3) + 64 * j; rho = rho < cntp ? rho : cntp - 1; const int grow = row0 + pass0 + rho;
                xoff[j] = (UP ? tlist[rho] * DM : grow * DE) + (tid & 7) * 8; }
            char* const xw = lds + (tid >> 3) * XS + (tid & 7) * 16;
            char* const aw = lds + AOFF + (cg * 4 + 2 * th) * 1024 + lane * 16;
            const char* const ar = lds + AOFF + cg * 4 * 1024 + lane * 16;
#pragma unroll 1
            for (int cp = 0; cp < NCP; ++cp) {
                const int cgi = cp * 4 + cg;
                const int kkw = wid >> 1, half = wid & 1;
                const float* wp;
                if constexpr (UP) wp = (r32 < 16 ? P->w1 : P->w3) + ((size_t)(layer * NE + e) * DM + kkw * 16 + 8 * hh + 4 * half) * DE + ns * 128 + cp * 64 + 4 * (r32 & 15);
                else wp = P->w2 + ((size_t)(layer * NE + e) * DE + 32 * hh + 2 * th) * DM + ns * 512 + cgi * 32 + r32;
                f32x16 acc[TW];
#pragma unroll
                for (int tl = 0; tl < TW; ++tl) acc[tl] = f32x16{};
                float wreg[WD][16]; u32x4 xs[5];
#define MOE_WLD1(wn_, R, li) do { if constexpr (UP) { if ((li) < 4) { const float4 t_ = *(const float4*)((wn_) + (size_t)(li) * DE); wreg[R][4 * (li)] = t_.x; wreg[R][4 * (li) + 1] = t_.y; wreg[R][4 * (li) + 2] = t_.z; wreg[R][4 * (li) + 3] = t_.w; } } \
                    else { if ((li) < 16) wreg[R][li] = (wn_)[(size_t)(((li) >> 3) + 4 * ((li) & 7)) * DM]; } } while (0)
#define MOE_WLOAD(slab, R) do { const float* wn_ = wp + (size_t)(((slab) + rot) & (NSLAB - 1)) * 64 * LDW; \
                    _Pragma("unroll") for (int li = 0; li < 16; ++li) MOE_WLD1(wn_, R, li); } while (0)
#define MOE_WPARK(R, PAR) do { if constexpr (UP) { _Pragma("unroll") for (int q = 0; q < 4; ++q) { uint2 fw; fw.x = cvtpk(wreg[R][q], wreg[R][4 + q]); fw.y = cvtpk(wreg[R][8 + q], wreg[R][12 + q]); \
                            *(uint2*)(lds + AOFF + (PAR) * ABUF + (q * 4 + kkw) * 1024 + lane * 16 + half * 8) = fw; } } \
                    else { _Pragma("unroll") for (int i = 0; i < 2; ++i) { u32x4 fw; fw.x = cvtpk(wreg[R][8 * i + 0], wreg[R][8 * i + 1]); fw.y = cvtpk(wreg[R][8 * i + 2], wreg[R][8 * i + 3]); \
                            fw.z = cvtpk(wreg[R][8 * i + 4], wreg[R][8 * i + 5]); fw.w = cvtpk(wreg[R][8 * i + 6], wreg[R][8 * i + 7]); *(u32x4*)(aw + (PAR) * ABUF + i * 1024) = fw; } } } while (0)
#pragma unroll
                for (int j = 0; j < 5; ++j) xs[j] = *(const u32x4*)(X + xoff[j] + (rot & (NSLAB - 1)) * 64);
                MOE_WLOAD(0, 0); MOE_WLOAD(1, 1);
#pragma unroll
                for (int j = 0; j < 5; ++j) *(u32x4*)(xw + 64 * j * XS) = xs[j];
                MOE_WPARK(0, 0); MOE_WLOAD(2, 0);
                MOE_BAR();
#define MOE_SLAB(s, PAR, R1) do { \
                    const int sx = ((s) + 1) < NSLAB ? (s) + 1 : NSLAB - 1, sw = ((s) + 1 + WD) < NSLAB ? (s) + 1 + WD : NSLAB - 1;     \
                    { const bf16_t* xn0_ = X + ((sx + rot) & (NSLAB - 1)) * 64; _Pragma("unroll") for (int j = 0; j < 5; ++j) xs[j] = *(const u32x4*)(xn0_ + xoff[j]); } \
                    MOE_WPARK(R1, 1 - (PAR)); \
                    const float* wn_ = wp + (size_t)((sw + rot) & (NSLAB - 1)) * 64 * LDW; \
                    const char* xb = lds + (PAR) * XBUF + (th * TW * 32 + r32) * XS + hh * 16; \
                    bf16x8 xq[4]; bf16x8 fq[2];                                                       \
                    xq[0] = *(const bf16x8*)(xb); xq[1] = *(const bf16x8*)(xb + 32 * XS); xq[2] = *(const bf16x8*)(xb + 64 * XS); \
                    fq[0] = *(const bf16x8*)(ar + (PAR) * ABUF); \
                    _Pragma("unroll") for (int kk = 0; kk < 4; ++kk) { \
                        if (kk < 3) fq[(kk + 1) & 1] = *(const bf16x8*)(ar + (PAR) * ABUF + (kk + 1) * 1024); \
                        _Pragma("unroll") for (int tl = 0; tl < TW; ++tl) { \
                            const int cur = kk * TW + tl, nx = cur + 3, nkk = nx / TW, ntl = nx % TW;       \
                            if (nx < 4 * TW) xq[nx & 3] = *(const bf16x8*)(xb + ntl * 32 * XS + nkk * 32); \
                            acc[tl] = __builtin_amdgcn_mfma_f32_32x32x16_bf16(fq[kk & 1], xq[cur & 3], acc[tl], 0, 0, 0); \
                            const int li = kk * TW + tl; \
                            MOE_WLD1(wn_, R1, li); \
                            __builtin_amdgcn_sched_barrier(0); } } \
                    _Pragma("unroll") for (int j = 0; j < 5; ++j) *(u32x4*)(xw + (1 - (PAR)) * XBUF + 64 * j * XS) = xs[j]; \
                    MOE_BAR(); } while (0)
#pragma unroll 1
                for (int s = 0; s < NSLAB; s += 2) { MOE_SLAB(s, 0, 1); MOE_SLAB(s + 1, 1, 0); }
#undef MOE_SLAB
#undef MOE_WLOAD
#undef MOE_WLD1
#undef MOE_WPARK
                const int T = (cntp + 31) >> 5;
                const int Tw = (T - TW * th) < 0 ? 0 : ((T - TW * th) > TW ? TW : (T - TW * th));
#pragma unroll
                for (int tl = 0; tl < TW; ++tl) if (tl < Tw) {
                    const int rho = (th * TW + tl) * 32 + r32;
                    if (rho < cntp) {
                        const size_t grow = (size_t)(row0 + pass0 + rho);
                        if constexpr (UP) {
                            bf16_t* hp = P->H + grow * DE + ns * 128 + cgi * 16 + 4 * hh;
#pragma unroll
                            for (int g = 0; g < 2; ++g) {
                                float y[4];
#pragma unroll
                                for (int q = 0; q < 4; ++q) { const float a = acc[tl][4 * g + q], b = acc[tl][8 + 4 * g + q]; y[q] = a / (1.f + __expf(-a)) * b; }
                                uint2 w; w.x = cvtpk(y[0], y[1]); w.y = cvtpk(y[2], y[3]);
                                *(uint2*)(hp + 8 * g) = w;
                            }
                        } else {
                            bf16_t* yp = P->Y + grow * DM + ns * 512 + cgi * 32 + 4 * hh;
#pragma unroll
                            for (int g = 0; g < 4; ++g) {
                                uint2 w; w.x = cvtpk(acc[tl][4 * g + 0], acc[tl][4 * g + 1]); w.y = cvtpk(acc[tl][4 * g + 2], acc[tl][4 * g + 3]);
                                *(uint2*)(yp + 8 * g) = w;
                            }
                        }
                    }
                }
            }
        }
    }
}
#undef MOE_BAR
}


namespace s5 {
using bf16x8 = __attribute__((ext_vector_type(8))) short;
using f32x16 = __attribute__((ext_vector_type(16))) float;
using u32x4  = __attribute__((ext_vector_type(4))) unsigned;
constexpr int NCHK = 516, NMT = 17;
__device__ __forceinline__ unsigned cvtpk(float lo, float hi) { unsigned r; asm volatile("v_cvt_pk_bf16_f32 %0, %1, %2" : "=v"(r) : "v"(lo), "v"(hi)); return r; }
__device__ __forceinline__ bf16x8 ld8f(const float* p) {
    const float4 a = *(const float4*)p, b = *(const float4*)(p + 4);
    u32x4 w; w.x = cvtpk(a.x, a.y); w.y = cvtpk(a.z, a.w); w.z = cvtpk(b.x, b.y); w.w = cvtpk(b.z, b.w);
    return *reinterpret_cast<bf16x8*>(&w);
}
__device__ __forceinline__ void prep_unit(KP P, char* lds, int layer, int g) {
    float2* pw = (float2*)lds; float2* bb = pw + 17 * 64; float2* cc = bb + 1024; float* kd = (float*)(cc + 1024);
    const int tid = tid_();
    const float dt = expf(P->log_dt[layer * 32 + g]);
    const float* a_re = P->a_re + (layer * 32 + g) * 64; const float* a_im = P->a_im + (layer * 32 + g) * 64;
    for (int idx = tid; idx < 17 * 64; idx += NTHR) { const int d = idx >> 6, p = idx & 63;
        const float mag = expf(a_re[p] * dt * (float)d), ang = a_im[p] * dt * (float)d; pw[idx] = make_float2(mag * cosf(ang), mag * sinf(ang)); }
    for (int idx = tid; idx < 1024; idx += NTHR) {
        { const int p = idx >> 4, c = idx & 15; const float are = a_re[p], aim = a_im[p];
          const float mag = expf(are * dt), abr = mag * cosf(aim * dt), abi = mag * sinf(aim * dt), den = are * are + aim * aim;
          const float zr = ((abr - 1.f) * are + abi * aim) / den, zi = (abi * are - (abr - 1.f) * aim) / den;
          const float br = P->b_re[((layer * 32 + g) * 64 + p) * 16 + c], bi = P->b_im[((layer * 32 + g) * 64 + p) * 16 + c];
          bb[idx] = make_float2(zr * br - zi * bi, zr * bi + zi * br); }
        { const int c = idx >> 6, p = idx & 63; cc[idx] = make_float2(P->c_re[((layer * 32 + g) * 16 + c) * 64 + p], P->c_im[((layer * 32 + g) * 16 + c) * 64 + p]); }
    }
    __syncthreads();
    if (tid < 64) ((float2*)P->A16)[(layer * 32 + g) * 64 + tid] = pw[16 * 64 + tid];
    for (int idx = tid; idx < 4096; idx += NTHR) { const int d = idx >> 8, c = (idx >> 4) & 15, c2 = idx & 15;
        float acc = 0.f;
        for (int p = 0; p < 64; ++p) { const float2 C = cc[c * 64 + p], W = pw[d * 64 + p], B = bb[p * 16 + c2];
            const float xr = C.x * W.x - C.y * W.y, xi = C.x * W.y + C.y * W.x; acc += xr * B.x - xi * B.y; }
        if (d == 0 && c == c2) acc += P->s5d[layer * 512 + g * 16 + c];
        kd[idx] = acc; }
    __syncthreads();
    bf16_t* BtY = P->BtY + (size_t)(layer * 32 + g) * 256 * 384; bf16_t* BtE = P->BtE + (size_t)(layer * 32 + g) * 128 * 256;
    for (int idx = tid; idx < 256 * 48; idx += NTHR) { const int n = idx / 48, ch = idx % 48, t = n >> 4, c = n & 15;
        float v[8];
        if (ch < 32) { const int s = ch >> 1, c0 = (ch & 1) * 8;
#pragma unroll
            for (int jj = 0; jj < 8; ++jj) v[jj] = (s <= t) ? kd[((t - s) * 16 + c) * 16 + c0 + jj] : 0.f;
        } else {
#pragma unroll
            for (int jj = 0; jj < 8; ++jj) { const int kq = (ch - 32) * 8 + jj, p = kq >> 1; const float2 C = cc[c * 64 + p], W = pw[(t + 1) * 64 + p];
                v[jj] = (kq & 1) ? -(C.x * W.y + C.y * W.x) : (C.x * W.x - C.y * W.y); }
        }
        u32x4 w; w.x = cvtpk(v[0], v[1]); w.y = cvtpk(v[2], v[3]); w.z = cvtpk(v[4], v[5]); w.w = cvtpk(v[6], v[7]);
        *(u32x4*)(BtY + (size_t)n * 384 + ch * 8) = w; }
    for (int idx = tid; idx < 128 * 32; idx += NTHR) { const int n = idx >> 5, ch = idx & 31, p = n >> 1, s = ch >> 1, c0 = (ch & 1) * 8;
        const float2 W = pw[(15 - s) * 64 + p];
        float v[8];
#pragma unroll
        for (int jj = 0; jj < 8; ++jj) { const float2 B = bb[p * 16 + c0 + jj]; v[jj] = (n & 1) ? (W.x * B.y + W.y * B.x) : (W.x * B.x - W.y * B.y); }
        u32x4 w; w.x = cvtpk(v[0], v[1]); w.y = cvtpk(v[2], v[3]); w.z = cvtpk(v[4], v[5]); w.w = cvtpk(v[6], v[7]);
        *(u32x4*)(BtE + (size_t)n * 256 + ch * 8) = w; }
    __syncthreads();
}
__device__ __forceinline__ void local_states(KP P, int layer) {
    const int tid = tid_(), lane = tid & 63, r32 = lane & 31, hh = lane >> 5, gw = bid_() * 8 + (tid >> 6), NGW = gridDim.x * 8;
    const float* PA = P->PA; float* E = P->S5E;
    for (int wu = gw; wu < 32 * NMT; wu += NGW) {
        const int g = wu / NMT, mt = wu % NMT, m = mt * 32 + r32, mc = m < NCHK ? m : NCHK - 1;
        const bf16_t* Bt = P->BtE + ((size_t)(layer * 32 + g) * 128 + r32) * 256 + 8 * hh;
        const float* up = PA + (size_t)(mc * 16) * PAW + 2048 + g * 16 + 8 * hh;
        f32x16 acc[4];
#pragma unroll
        for (int nt = 0; nt < 4; ++nt) acc[nt] = f32x16{};
#pragma unroll 4
        for (int s = 0; s < 16; ++s) {
            const bf16x8 bf = ld8f(up + (size_t)s * PAW);
#pragma unroll
            for (int nt = 0; nt < 4; ++nt) { const bf16x8 af = *(const bf16x8*)(Bt + (size_t)nt * 32 * 256 + s * 16); acc[nt] = __builtin_amdgcn_mfma_f32_32x32x16_bf16(af, bf, acc[nt], 0, 0, 0); }
        }
        if (m < NCHK) { float* ep = E + ((size_t)m * 32 + g) * 128 + 4 * hh;
#pragma unroll
            for (int nt = 0; nt < 4; ++nt)
#pragma unroll
                for (int q = 0; q < 4; ++q) *(float4*)(ep + nt * 32 + 8 * q) = make_float4(acc[nt][4 * q], acc[nt][4 * q + 1], acc[nt][4 * q + 2], acc[nt][4 * q + 3]); }
    }
}
__device__ __forceinline__ void scan_states(KP P, int layer) {
    const int idx = bid_() * NTHR + tid_();
    if (idx >= 8192) return;
    const int b = idx >> 11, g = (idx >> 6) & 31, p = idx & 63;
    const float2 A = ((const float2*)P->A16)[(layer * 32 + g) * 64 + p];
    const float2* E = (const float2*)P->S5E; float2* XP = (float2*)P->S5X;
    float xr = 0.f, xi = 0.f;
    const size_t o0 = ((size_t)(b * 129) * 32 + g) * 64 + p;
    float2 e[16];
#pragma unroll
    for (int i = 0; i < 16; ++i) e[i] = E[o0 + (size_t)i * 2048];
#pragma unroll 1
    for (int jb = 0; jb < 129; jb += 16) {
        float2 en[16];
#pragma unroll
        for (int i = 0; i < 16; ++i) { const int j = jb + 16 + i; en[i] = (j < 129) ? E[o0 + (size_t)j * 2048] : make_float2(0.f, 0.f); }
#pragma unroll
        for (int i = 0; i < 16; ++i) { const int j = jb + i;
            if (j < 129) { XP[o0 + (size_t)j * 2048] = make_float2(xr, xi);
                const float nr = A.x * xr - A.y * xi + e[i].x, ni = A.x * xi + A.y * xr + e[i].y; xr = nr; xi = ni; } }
#pragma unroll
        for (int i = 0; i < 16; ++i) e[i] = en[i];
    }
}
__device__ __forceinline__ float gelu_t(float x) { const float u = 0.7978845608028654f * (x + 0.044715f * x * x * x); const float e = __expf(2.f * u); return x - x / (e + 1.f); }
__device__ __forceinline__ void outputs(KP P, int layer) {
    const int tid = tid_(), lane = tid & 63, r32 = lane & 31, hh = lane >> 5, gw = bid_() * 8 + (tid >> 6), NGW = gridDim.x * 8;
    const float* PA = P->PA; const float* XP = P->S5X; bf16_t* YG = P->YG;
    for (int wu = gw; wu < 32 * NMT; wu += NGW) {
        const int g = wu / NMT, mt = wu % NMT, m = mt * 32 + r32, mc = m < NCHK ? m : NCHK - 1;
        const bf16_t* Bt = P->BtY + ((size_t)(layer * 32 + g) * 256 + r32) * 384 + 8 * hh;
        const float* up = PA + (size_t)(mc * 16) * PAW + 2048 + g * 16 + 8 * hh;
        const float* xp = XP + ((size_t)mc * 32 + g) * 128 + 8 * hh;
        f32x16 acc[8];
#pragma unroll
        for (int nt = 0; nt < 8; ++nt) acc[nt] = f32x16{};
#pragma unroll
        for (int s = 0; s < 16; ++s) {
            const bf16x8 bf = ld8f(up + (size_t)s * PAW);
#pragma unroll
            for (int nt = 0; nt < 8; ++nt) if (2 * nt + 1 >= s) { const bf16x8 af = *(const bf16x8*)(Bt + (size_t)nt * 32 * 384 + s * 16); acc[nt] = __builtin_amdgcn_mfma_f32_32x32x16_bf16(af, bf, acc[nt], 0, 0, 0); }
        }
#pragma unroll
        for (int ks = 0; ks < 8; ++ks) {
            const bf16x8 bf = ld8f(xp + ks * 16);
#pragma unroll
            for (int nt = 0; nt < 8; ++nt) { const bf16x8 af = *(const bf16x8*)(Bt + (size_t)nt * 32 * 384 + 256 + ks * 16); acc[nt] = __builtin_amdgcn_mfma_f32_32x32x16_bf16(af, bf, acc[nt], 0, 0, 0); }
        }
        if (m < NCHK) {
#pragma unroll
            for (int nt = 0; nt < 8; ++nt)
#pragma unroll
                for (int q = 0; q < 4; ++q) { const int t = 2 * nt + (q >> 1);
                    uint2 w; w.x = cvtpk(gelu_t(acc[nt][4 * q]), gelu_t(acc[nt][4 * q + 1])); w.y = cvtpk(gelu_t(acc[nt][4 * q + 2]), gelu_t(acc[nt][4 * q + 3]));
                    *(uint2*)(YG + (size_t)(m * 16 + t) * 512 + g * 16 + 8 * (q & 1) + 4 * hh) = w; }
        }
    }
}
__device__ __forceinline__ void fused_unit(KP P, char* lds, int layer, int b, int g) {
    const int tid = tid_(), lane = tid & 63, wid = tid >> 6, r32 = lane & 31, hh = lane >> 5;
    float* El = (float*)lds;
    const float* PA = P->PA; bf16_t* YG = P->YG;
    const int ml = wid * 32 + r32, mc = b * 129 + (ml < 129 ? ml : 128);
    const float* up = PA + (size_t)(mc * 16) * PAW + 2048 + g * 16 + 8 * hh;
    if (wid < 5) {
        const bf16_t* Bt = P->BtE + ((size_t)(layer * 32 + g) * 128 + r32) * 256 + 8 * hh;
        f32x16 acc[4];
#pragma unroll
        for (int nt = 0; nt < 4; ++nt) acc[nt] = f32x16{};
#pragma unroll 4
        for (int s = 0; s < 16; ++s) {
            const bf16x8 bf = ld8f(up + (size_t)s * PAW);
#pragma unroll
            for (int nt = 0; nt < 4; ++nt) { const bf16x8 af = *(const bf16x8*)(Bt + (size_t)nt * 32 * 256 + s * 16); acc[nt] = __builtin_amdgcn_mfma_f32_32x32x16_bf16(af, bf, acc[nt], 0, 0, 0); }
        }
        float* ep = El + ml * 128 + 4 * hh;
#pragma unroll
        for (int nt = 0; nt < 4; ++nt)
#pragma unroll
            for (int q = 0; q < 4; ++q) *(float4*)(ep + nt * 32 + 8 * q) = make_float4(acc[nt][4 * q], acc[nt][4 * q + 1], acc[nt][4 * q + 2], acc[nt][4 * q + 3]);
    }
    __syncthreads();
    if (tid < 64) {
        const float2 A = ((const float2*)P->A16)[(layer * 32 + g) * 64 + tid];
        float2* e2 = (float2*)El + tid;
        float xr = 0.f, xi = 0.f;
#pragma unroll 4
        for (int j = 0; j < 129; ++j) { const float2 e = e2[j * 64]; e2[j * 64] = make_float2(xr, xi);
            const float nr = A.x * xr - A.y * xi + e.x, ni = A.x * xi + A.y * xr + e.y; xr = nr; xi = ni; }
    }
    __syncthreads();
    if (wid < 5) {
        const bf16_t* Bt = P->BtY + ((size_t)(layer * 32 + g) * 256 + r32) * 384 + 8 * hh;
        const float* xp = El + (ml < 129 ? ml : 128) * 128 + 8 * hh;
        f32x16 acc[8];
#pragma unroll
        for (int nt = 0; nt < 8; ++nt) acc[nt] = f32x16{};
#pragma unroll
        for (int s = 0; s < 16; ++s) {
            const bf16x8 bf = ld8f(up + (size_t)s * PAW);
#pragma unroll
            for (int nt = 0; nt < 8; ++nt) if (2 * nt + 1 >= s) { const bf16x8 af = *(const bf16x8*)(Bt + (size_t)nt * 32 * 384 + s * 16); acc[nt] = __builtin_amdgcn_mfma_f32_32x32x16_bf16(af, bf, acc[nt], 0, 0, 0); }
        }
#pragma unroll
        for (int ks = 0; ks < 8; ++ks) {
            const bf16x8 bf = ld8f(xp + ks * 16);
#pragma unroll
            for (int nt = 0; nt < 8; ++nt) { const bf16x8 af = *(const bf16x8*)(Bt + (size_t)nt * 32 * 384 + 256 + ks * 16); acc[nt] = __builtin_amdgcn_mfma_f32_32x32x16_bf16(af, bf, acc[nt], 0, 0, 0); }
        }
        if (ml < 129) { const int m = b * 129 + ml;
#pragma unroll
            for (int nt = 0; nt < 8; ++nt)
#pragma unroll
                for (int q = 0; q < 4; ++q) { const int t = 2 * nt + (q >> 1);
                    uint2 w; w.x = cvtpk(gelu_t(acc[nt][4 * q]), gelu_t(acc[nt][4 * q + 1])); w.y = cvtpk(gelu_t(acc[nt][4 * q + 2]), gelu_t(acc[nt][4 * q + 3]));
                    *(uint2*)(YG + (size_t)(m * 16 + t) * 512 + g * 16 + 8 * (q & 1) + 4 * hh) = w; }
        }
    }
    __syncthreads();
}
}

__device__ __forceinline__ float wave_sum(float v) {
#pragma unroll
    for (int o = 32; o > 0; o >>= 1) v += __shfl_xor(v, o);
    return v;
}
__device__ __forceinline__ unsigned cvtpk_(float lo, float hi) { unsigned r; asm volatile("v_cvt_pk_bf16_f32 %0, %1, %2" : "=v"(r) : "v"(lo), "v"(hi)); return r; }
__device__ __forceinline__ void ph_attn_out(KP P, int layer, int cu0) {
    const int tid = tid_(), lane = tid & 63, gw = (bid_() - cu0) * 8 + (tid >> 6), NGW = (gridDim.x - cu0) * 8;
    if (gw < 0) return;
    const float scale = 1.f - (0.8f - 0.6f * expf(-0.3f * (float)layer));
    const float lam = P->lam[layer];
    const float4 sw = ((const float4*)(P->subln + layer * 256))[lane];
    const float* OC = P->OC; bf16_t* MIX = P->MIX;
    for (int it0 = gw; it0 < TOK * 4; it0 += NGW * 4) {
        float4 a[4], b[4];
#pragma unroll
        for (int q = 0; q < 4; ++q) { const int it = it0 + NGW * q, itc = it < TOK * 4 ? it : TOK * 4 - 1, r = itc >> 2, h = itc & 3;
            a[q] = *(const float4*)(OC + (size_t)r * DM + h * 512 + lane * 4); b[q] = *(const float4*)(OC + (size_t)r * DM + h * 512 + 256 + lane * 4); }
#pragma unroll
        for (int q = 0; q < 4; ++q) { const int it = it0 + NGW * q; if (it < TOK * 4) { const int r = it >> 2, h = it & 3;
            const float o0 = a[q].x - lam * b[q].x, o1 = a[q].y - lam * b[q].y, o2 = a[q].z - lam * b[q].z, o3 = a[q].w - lam * b[q].w;
            const float ss = wave_sum(o0 * o0 + o1 * o1 + o2 * o2 + o3 * o3);
            const float rs = rsqrtf(ss * (1.f / 256.f) + EPS) * scale;
            uint2 w; w.x = cvtpk_(o0 * rs * sw.x, o1 * rs * sw.y); w.y = cvtpk_(o2 * rs * sw.z, o3 * rs * sw.w);
            *(uint2*)(MIX + (size_t)r * DM + 1024 + h * 256 + lane * 4) = w; } }
    }
}
__device__ __forceinline__ void ph_build_norm(KP P) {
    const int tid = tid_(), lane = tid & 63, gw = bid_() * 8 + (tid >> 6), NGW = gridDim.x * 8;
    for (int r = gw; r < MP; r += NGW) {
        float4 v[8];
        if (r < TOK) { const int b = r / LL, t = r % LL;
            const float4* src = (const float4*)(t < NMETA ? P->meta + (size_t)t * DM : P->x + ((size_t)b * SEQ + (t - NMETA)) * DM);
#pragma unroll
            for (int j = 0; j < 8; ++j) v[j] = src[lane + 64 * j];
        } else {
#pragma unroll
            for (int j = 0; j < 8; ++j) v[j] = make_float4(0.f, 0.f, 0.f, 0.f);
        }
        float ss = 0.f;
#pragma unroll
        for (int j = 0; j < 8; ++j) { ((float4*)(P->Z + (size_t)r * DM))[lane + 64 * j] = v[j]; ss += v[j].x * v[j].x + v[j].y * v[j].y + v[j].z * v[j].z + v[j].w * v[j].w; }
        const float rs = rsqrtf(wave_sum(ss) * (1.f / DM) + EPS);
#pragma unroll
        for (int j = 0; j < 8; ++j) { const float4 w = ((const float4*)P->ln1_w)[lane + 64 * j];
            uint2 o; o.x = cvtpk_(v[j].x * rs * w.x, v[j].y * rs * w.y); o.y = cvtpk_(v[j].z * rs * w.z, v[j].w * rs * w.w);
            ((uint2*)(P->HN + (size_t)r * DM))[lane + 64 * j] = o; }
    }
}
__device__ __forceinline__ void ph_prep(KP P) {
    const int tid = tid_();
    if (bid_() == 0) {
        const int c = tid;
        const float l0 = P->lbnd[c], l1 = P->lbnd[512 + c], m = fmaxf(l0, l1), e0 = expf(l0 - m), e1 = expf(l1 - m);
        P->lbtab[c] = 0.f; P->lbtab[512 + c] = e1 / (e0 + e1);
        if (c < 2) {
            float s1 = 0.f, s2 = 0.f;
            for (int i = 0; i < 128; ++i) { s1 += P->lq1[c * 128 + i] * P->lk1[c * 128 + i]; s2 += P->lq2[c * 128 + i] * P->lk2[c * 128 + i]; }
            const float li = 0.8f - 0.6f * expf(-0.3f * (float)c);
            P->lam[c] = expf(s1) - expf(s2) + li;
        }
    }
    for (int i = bid_() * NTHR + tid; i < 2 * 96 * DM; i += gridDim.x * NTHR) {
        const int layer = i / (96 * DM), jc = (i / DM) % 96, k = i % DM;
        float v = 0.f;
        if (jc < 8) v = P->wrg[((size_t)layer * DM + k) * 8 + jc]; else if (jc < 72) v = P->wre[((size_t)layer * DM + k) * 64 + jc - 8];
        v *= P->ln2_w[layer * DM + k];
        const bf16_t hi = f2bf(v), lo = f2bf(v - bf2f(hi));
        P->WRT[((size_t)(layer * 2 + 0) * 96 + jc) * DM + k] = hi; P->WRT[((size_t)(layer * 2 + 1) * 96 + jc) * DM + k] = lo;
    }
}
namespace rt {
using f32x16 = __attribute__((ext_vector_type(16))) float;
using bf16x8 = __attribute__((ext_vector_type(8))) short;
using u32x4  = __attribute__((ext_vector_type(4))) unsigned;
__device__ __forceinline__ void norm_router(KP P, char* lds, int layer) {
    const int tid = tid_(), lane = tid & 63, wid = tid >> 6, r32 = lane & 31, hh = lane >> 5;
    float* part = (float*)lds;
    float* ssqp = (float*)(lds + 98304);
    float* lg = ssqp + 256;
    float* rsv = lg + 32 * 97;
    const bf16_t* Whi = P->WRT + (size_t)(layer * 2 + 0) * 96 * DM; const bf16_t* Wlo = P->WRT + (size_t)(layer * 2 + 1) * 96 * DM;
    const float* Z = P->Z;
    for (int u = bid_(); u < TOK / 32; u += gridDim.x) {
        const int tok0 = u * 32, kb = wid * 256;
        if (false) {
            float* Zw = P->Z; const float* ZP = P->ZP;
            for (int i = tid; i < 32 * DM / 4; i += NTHR) { const int r = i / (DM / 4), c4 = i % (DM / 4);
                float4 z = ((const float4*)(Zw + (size_t)(tok0 + r) * DM))[c4];
#pragma unroll
                for (int ks = 0; ks < 8; ++ks) { const float4 p4 = ((const float4*)(ZP + ((size_t)ks * 256 + (tok0 - 8192 + r)) * DM))[c4]; z.x += p4.x; z.y += p4.y; z.z += p4.z; z.w += p4.w; }
                ((float4*)(Zw + (size_t)(tok0 + r) * DM))[c4] = z; }
            asm volatile("s_waitcnt vmcnt(0)" ::: "memory");
            __syncthreads();
        }
        f32x16 acc[3] = {f32x16{}, f32x16{}, f32x16{}};
        float sq = 0.f;
        const float* zp = Z + (size_t)(tok0 + r32) * DM + kb + 8 * hh;
        const bf16_t* wh = Whi + (size_t)r32 * DM + kb + 8 * hh; const bf16_t* wl = Wlo + (size_t)r32 * DM + kb + 8 * hh;
#pragma unroll 4
        for (int ks = 0; ks < 16; ++ks) {
            const float4 z0 = *(const float4*)(zp + ks * 16), z1 = *(const float4*)(zp + ks * 16 + 4);
            sq += (z0.x * z0.x + z0.y * z0.y + z0.z * z0.z + z0.w * z0.w) + (z1.x * z1.x + z1.y * z1.y + z1.z * z1.z + z1.w * z1.w);
            u32x4 h; h.x = cvtpk_(z0.x, z0.y); h.y = cvtpk_(z0.z, z0.w); h.z = cvtpk_(z1.x, z1.y); h.w = cvtpk_(z1.z, z1.w);
            u32x4 l; l.x = cvtpk_(z0.x - __uint_as_float(h.x << 16), z0.y - __uint_as_float(h.x & 0xffff0000u)); l.y = cvtpk_(z0.z - __uint_as_float(h.y << 16), z0.w - __uint_as_float(h.y & 0xffff0000u));
            l.z = cvtpk_(z1.x - __uint_as_float(h.z << 16), z1.y - __uint_as_float(h.z & 0xffff0000u)); l.w = cvtpk_(z1.z - __uint_as_float(h.w << 16), z1.w - __uint_as_float(h.w & 0xffff0000u));
            const bf16x8 zh = *reinterpret_cast<bf16x8*>(&h), zl = *reinterpret_cast<bf16x8*>(&l);
#pragma unroll
            for (int ct = 0; ct < 3; ++ct) {
                const bf16x8 ah = *(const bf16x8*)(wh + (size_t)ct * 32 * DM + ks * 16), al = *(const bf16x8*)(wl + (size_t)ct * 32 * DM + ks * 16);
                acc[ct] = __builtin_amdgcn_mfma_f32_32x32x16_bf16(ah, zh, acc[ct], 0, 0, 0);
                acc[ct] = __builtin_amdgcn_mfma_f32_32x32x16_bf16(ah, zl, acc[ct], 0, 0, 0);
                acc[ct] = __builtin_amdgcn_mfma_f32_32x32x16_bf16(al, zh, acc[ct], 0, 0, 0);
            }
        }
        { auto rr = __builtin_amdgcn_permlane32_swap(__float_as_uint(sq), __float_as_uint(sq), false, false); sq = __uint_as_float(rr[0]) + __uint_as_float(rr[1]); }
        if (hh == 0) ssqp[wid * 32 + r32] = sq;
#pragma unroll
        for (int ct = 0; ct < 3; ++ct)
#pragma unroll
            for (int rg = 0; rg < 16; ++rg) part[((wid * 3 + ct) * 16 + rg) * 64 + lane] = acc[ct][rg];
        __syncthreads();
        if (tid < 32) { float t = 0.f;
#pragma unroll
            for (int w = 0; w < 8; ++w) t += ssqp[w * 32 + tid];
            rsv[tid] = rsqrtf(t * (1.f / DM) + EPS); }
#pragma unroll
        for (int q = 0; q < 6; ++q) { const int o = tid + NTHR * q, col = o >> 5, tok = o & 31, ct = col >> 5, cl = col & 31, h2 = (cl >> 2) & 1, rg = (cl & 3) + 4 * (cl >> 3);
            float t = 0.f;
#pragma unroll
            for (int w = 0; w < 8; ++w) t += part[((w * 3 + ct) * 16 + rg) * 64 + h2 * 32 + tok];
            lg[tok * 97 + col] = t; }
        __syncthreads();
        if (tid < 32) {
            const int t = tok0 + tid; const float rs = rsv[tid]; const float* l = lg + tid * 97;
            const float* brg = P->brg + layer * 8; const float* bre = P->bre + layer * 64;
            float gl[8];
#pragma unroll
            for (int j = 0; j < 8; ++j) gl[j] = l[j] * rs + brg[j];
            int gs = 0; float gm = gl[0];
#pragma unroll
            for (int j = 1; j < 8; ++j) if (gl[j] > gm) { gm = gl[j]; gs = j; }
            float den = 0.f;
#pragma unroll
            for (int j = 0; j < 8; ++j) den += expf(gl[j] - gm);
            const float pg = 1.f / den;
            float el[8];
#pragma unroll
            for (int j = 0; j < 8; ++j) el[j] = l[8 + gs * 8 + j] * rs + bre[gs * 8 + j];
            int j0 = 0; float v0 = el[0];
#pragma unroll
            for (int j = 1; j < 8; ++j) if (el[j] > v0) { v0 = el[j]; j0 = j; }
            int j1 = -1; float v1 = -INFINITY;
#pragma unroll
            for (int j = 0; j < 8; ++j) if (j != j0 && el[j] > v1) { v1 = el[j]; j1 = j; }
            const float e1 = expf(v1 - v0), g0 = pg / (1.f + e1), g1 = pg * e1 / (1.f + e1);
            const int x0 = gs * 8 + j0, x1 = gs * 8 + j1;
            P->ridx[t * 2] = x0; P->ridx[t * 2 + 1] = x1; P->rgate[t * 2] = g0; P->rgate[t * 2 + 1] = g1;
            const int s0 = atomicAdd(&P->cnt[x0], 1), s1 = atomicAdd(&P->cnt[x1], 1);
            P->rslot[t * 2] = s0; P->rslot[t * 2 + 1] = s1;
            if (s0 < ECAP) P->elist[x0 * ECAP + s0] = t; if (s1 < ECAP) P->elist[x1 * ECAP + s1] = t;
        }
#pragma unroll 1
        for (int q = 0; q < 4; q += 2) { const int tk = wid * 4 + q; const float rs0 = rsv[tk], rs1 = rsv[tk + 1];
            const float4* zr = (const float4*)(Z + (size_t)(tok0 + tk) * DM); const float4* wl4 = (const float4*)(P->ln2_w + layer * DM);
            float4 za[8], zb[8];
#pragma unroll
            for (int j = 0; j < 8; ++j) { za[j] = zr[lane + 64 * j]; zb[j] = zr[DM / 4 + lane + 64 * j]; }
#pragma unroll
            for (int j = 0; j < 8; ++j) { const float4 w = wl4[lane + 64 * j];
                uint2 o; o.x = cvtpk_(za[j].x * rs0 * w.x, za[j].y * rs0 * w.y); o.y = cvtpk_(za[j].z * rs0 * w.z, za[j].w * rs0 * w.w);
                ((uint2*)(P->HN + (size_t)(tok0 + tk) * DM))[lane + 64 * j] = o;
                o.x = cvtpk_(zb[j].x * rs1 * w.x, zb[j].y * rs1 * w.y); o.y = cvtpk_(zb[j].z * rs1 * w.z, zb[j].w * rs1 * w.w);
                ((uint2*)(P->HN + (size_t)(tok0 + tk + 1) * DM))[lane + 64 * j] = o; } }
        __syncthreads();
    }
}
}
__device__ __forceinline__ void ph_combine_norm(KP P, char* lds, int layer) {
    int* base = (int*)lds;
    const int tid = tid_(), lane = tid & 63, gw = bid_() * 8 + (tid >> 6), NGW = gridDim.x * 8;
    if (tid < 64) { const int c = P->cnt[tid]; int inc = c;
#pragma unroll
        for (int o = 1; o < 64; o <<= 1) { const int v = __shfl_up(inc, o); if (lane >= o) inc += v; }
        base[tid] = inc - c; }
    __syncthreads();
    for (int t0 = gw; t0 < TOK; t0 += 2 * NGW) {
        int r0[2], r1[2]; float g0[2], g1[2]; bool ok[2];
#pragma unroll
        for (int q = 0; q < 2; ++q) { const int t = t0 + q * NGW; ok[q] = t < TOK; const int tc = ok[q] ? t : t0;
            const int2 ex = ((const int2*)P->ridx)[tc], sl = ((const int2*)P->rslot)[tc]; const float2 gg = ((const float2*)P->rgate)[tc];
            r0[q] = base[ex.x] + sl.x; r1[q] = base[ex.y] + sl.y; g0[q] = gg.x; g1[q] = gg.y; }
        float4 v[2][8]; uint2 ya[2][8], yb[2][8];
#pragma unroll
        for (int q = 0; q < 2; ++q) { const int t = ok[q] ? t0 + q * NGW : t0;
#pragma unroll
            for (int j = 0; j < 8; ++j) { v[q][j] = ((const float4*)(P->Z + (size_t)t * DM))[lane + 64 * j];
                ya[q][j] = ((const uint2*)(P->Y + (size_t)r0[q] * DM))[lane + 64 * j]; yb[q][j] = ((const uint2*)(P->Y + (size_t)r1[q] * DM))[lane + 64 * j]; } }
#pragma unroll
        for (int q = 0; q < 2; ++q) if (ok[q]) { const int t = t0 + q * NGW;
            float ss = 0.f;
#pragma unroll
            for (int j = 0; j < 8; ++j) { const uint2 a = ya[q][j], b = yb[q][j]; float4& x = v[q][j];
                x.x += g0[q] * __uint_as_float(a.x << 16) + g1[q] * __uint_as_float(b.x << 16); x.y += g0[q] * __uint_as_float(a.x & 0xffff0000u) + g1[q] * __uint_as_float(b.x & 0xffff0000u);
                x.z += g0[q] * __uint_as_float(a.y << 16) + g1[q] * __uint_as_float(b.y << 16); x.w += g0[q] * __uint_as_float(a.y & 0xffff0000u) + g1[q] * __uint_as_float(b.y & 0xffff0000u);
                ss += x.x * x.x + x.y * x.y + x.z * x.z + x.w * x.w; }
            const float rs = rsqrtf(wave_sum(ss) * (1.f / DM) + EPS);
            if (layer == 0) {
#pragma unroll
                for (int j = 0; j < 8; ++j) { ((float4*)(P->Z + (size_t)t * DM))[lane + 64 * j] = v[q][j];
                    const float4 w = ((const float4*)(P->ln1_w + DM))[lane + 64 * j];
                    uint2 o; o.x = cvtpk_(v[q][j].x * rs * w.x, v[q][j].y * rs * w.y); o.y = cvtpk_(v[q][j].z * rs * w.z, v[q][j].w * rs * w.w);
                    ((uint2*)(P->HN + (size_t)t * DM))[lane + 64 * j] = o; }
            } else {
                const int b = t / LL, tt = t % LL;
                if (tt >= NMETA) {
#pragma unroll
                    for (int j = 0; j < 8; ++j) { const float4 w = ((const float4*)P->fnw)[lane + 64 * j];
                        ((float4*)(P->out + ((size_t)b * SEQ + (tt - NMETA)) * DM))[lane + 64 * j] = make_float4(v[q][j].x * rs * w.x, v[q][j].y * rs * w.y, v[q][j].z * rs * w.z, v[q][j].w * rs * w.w); }
                }
            }
        }
    }
    __syncthreads();
}

__global__ void __launch_bounds__(NTHR, 2) mega_fwd(Params P_arg) {
    extern __shared__ __attribute__((aligned(16))) char lds[];
    const int tid = tid_(), G = gridDim.x;
    volatile LAS unsigned* ctlw = (volatile LAS unsigned*)((LAS char*)lds + LDS_CTL);
    if (tid < 64) ctlw[tid] = 0u;
    __syncthreads();
    KP P = kp_();
    XcdBarrier bar = xcd_barrier_post(P->bar, ctlw + 8);
#define GRID_BAR() do { xcd_barrier(bar); P = kp_(); } while (0)

    ph_build_norm(P);
    ph_prep(P);
    ph_weights(P, lds);
    __syncthreads();
    for (int un = bid_(); un < 64; un += G) s5::prep_unit(P, lds, un >> 5, un & 31);
    GRID_BAR();
#pragma unroll
    for (int layer = 0; layer < 2; ++layer) {
        { pg8::Gemm g{P->HN, P->WinT + (size_t)layer * INW * DM, MP, INW, DM, DM}; pg8::StaticOrder S; S.init(MP, INW, G, bid_(), DM / 64); pg8::EpiInProj E{P->PA, P->QKV};
          pg8::gemm_phase<pg8::EpiInProj, pg8::StaticOrder, true, true>((LAS unsigned char*)lds, g, S, E); }
        { const int t2 = tid_(), b2 = bid_(); if (b2 == 0 && t2 < NE) P->cnt[t2] = 0;
 }
        GRID_BAR();
        hg::local_states(P, lds, layer);
        for (int un = bid_(); un < 128; un += G) s5::fused_unit(P, lds, layer, un >> 5, un & 31);
        ph_attention(P, lds);
        GRID_BAR();
        hg::scan_states(P);
        ph_attn_out(P, layer, G > 192 ? 132 : 0);
        __syncthreads();
        { pg8::Gemm g{P->YG, P->WgluT + (size_t)layer * 1024 * 512, MP, 1024, 512, 512}; pg8::StaticOrder S; S.init(MP, 1024, G, bid_(), 512 / 64); pg8::EpiGlu E{P->MIX, P->b_glu + layer * 1024};
          pg8::gemm_phase<pg8::EpiGlu, pg8::StaticOrder, true, true>((LAS unsigned char*)lds, g, S, E); }
        GRID_BAR();
        hg::outputs(P, lds, layer);
        GRID_BAR();
        { pg8::Gemm g{P->MIX, P->WoutT + (size_t)layer * DM * DM, MP, DM, DM, DM}; pg8::StaticOrder S; S.init(MP, DM, G, bid_(), DM / 64); pg8::EpiResidual E{P->Z};
          pg8::gemm_phase<pg8::EpiResidual, pg8::StaticOrder, true, true>((LAS unsigned char*)lds, g, S, E); }
        GRID_BAR();
        rt::norm_router(P, lds, layer);
        GRID_BAR();
        moe::stream_gemm<true>(P, lds, layer);
        GRID_BAR();
        moe::stream_gemm<false>(P, lds, layer);
        GRID_BAR();
        ph_combine_norm(P, lds, layer);
        if (layer == 0) GRID_BAR();
    }
}
}

extern "C" void kernel_launch(void* const* d_in, const int* in_sizes, int n_in, void* d_out, int out_size, void* d_ws, size_t ws_size, hipStream_t stream) {
    static int grid = 0;
    if (grid == 0) {
        int dev = 0, cus = 0;
        if (hipGetDevice(&dev) != hipSuccess || hipDeviceGetAttribute(&cus, hipDeviceAttributeMultiprocessorCount, dev) != hipSuccess) { grid = -1; return; }
        if (hipFuncSetAttribute((const void*)mega_fwd, hipFuncAttributeMaxDynamicSharedMemorySize, LDS_BYTES) != hipSuccess) { grid = -1; return; }
        int per_cu = 0;
        if (hipOccupancyMaxActiveBlocksPerMultiprocessor(&per_cu, (const void*)mega_fwd, NTHR, LDS_BYTES) != hipSuccess || per_cu < 1) { (void)hipGetLastError(); }
        grid = cus;
    }
    if (grid < 0) return;
    Params p{};
    const float** pin = (const float**)&p;
    for (int i = 0; i < 31; ++i) pin[i] = (const float*)d_in[i];
    p.out = (float*)d_out;
    char* ws = (char*)d_ws; size_t off = 0;
    auto alloc = [&](size_t bytes) { char* q = ws + off; off += (bytes + 255) & ~(size_t)255; return q; };
    p.bar = (unsigned*)alloc(XCD_BAR_WORDS * 4);
    p.elist = (int*)alloc((size_t)NE * ECAP * 4);
    p.cnt = (int*)alloc(256); p.blk_e = (int*)alloc(1024); p.base = (int*)alloc(256);
    p.lbtab = (float*)alloc(1024 * 4); p.lam = (float*)alloc(256);
    p.Z = (float*)alloc((size_t)MP * DM * 4);
    p.HN = (bf16_t*)alloc((size_t)MP * DM * 2);
    p.PA = (float*)alloc((size_t)MP * PAW * 4);
    p.QKV = (bf16_t*)alloc((size_t)MP * QKVW * 2);
    p.OA = (float*)alloc((size_t)MP * HW * 4);
    p.ZP = (float*)alloc((size_t)8 * 256 * DM * 4);
    p.WRT = (bf16_t*)alloc((size_t)2 * 2 * 96 * DM * 2);
    p.A16 = (float*)alloc(2 * 32 * 64 * 8); p.S5E = (float*)alloc((size_t)516 * 32 * 128 * 4); p.S5X = (float*)alloc((size_t)516 * 32 * 128 * 4);
    p.BtY = (bf16_t*)alloc((size_t)2 * 32 * 256 * 384 * 2); p.BtE = (bf16_t*)alloc((size_t)2 * 32 * 128 * 256 * 2);
    p.SLOC = (float*)alloc((size_t)528 * 16384 * 4); p.DEC = (float*)alloc((size_t)528 * 128 * 4); p.SPREV = (bf16_t*)alloc((size_t)529 * 16384 * 2);
    p.YG = (bf16_t*)alloc((size_t)MP * 512 * 2);
    p.T = nullptr;
    p.MIX = (bf16_t*)alloc((size_t)MP * DM * 2);
    p.OC = (float*)alloc((size_t)MP * DM * 4);
    p.ridx = (int*)alloc((size_t)NASSIGN * 4); p.rgate = (float*)alloc((size_t)NASSIGN * 4); p.rslot = (int*)alloc((size_t)NASSIGN * 4);
    p.tokrow = (int*)alloc((size_t)NASSIGN * 4); p.rowtok = (int*)alloc((size_t)NRMAX * 4);
    p.H1 = nullptr;
    p.H = (bf16_t*)alloc((size_t)NRMAX * DE * 2);
    p.Y = (bf16_t*)alloc((size_t)NRMAX * DM * 2);
    p.S = nullptr;
    p.WinT = (bf16_t*)alloc((size_t)2 * INW * DM * 2); p.WoutT = (bf16_t*)alloc((size_t)2 * DM * DM * 2); p.WgluT = (bf16_t*)alloc((size_t)2 * 1024 * 512 * 2);
    if (off > ws_size) return;
    if (hipMemsetAsync(p.bar, 0, XCD_BAR_WORDS * 4, stream) != hipSuccess) return;
    hipLaunchKernelGGL(mega_fwd, dim3(grid), dim3(NTHR), LDS_BYTES, stream, p);
}
```

```cpp
#include <hip/hip_runtime.h>
#include <stdint.h>
#include <math.h>

namespace {
typedef unsigned short bf16_t;
constexpr int DM = 2048, NB = 4, SEQ = 2048, NMETA = 16, LL = SEQ + NMETA, TOK = NB * LL, MP = 8448;
constexpr int HW = 512;
constexpr int INW = 5632, PAW = 2560, QKVW = 3072;
constexpr int NE = 64, DE = 512, NASSIGN = TOK * 2;
constexpr int RB = 128;
constexpr int NRMAX = NASSIGN + NE * RB;
constexpr float EPS = 1e-6f;
constexpr int NTHR = 512;
constexpr int ECAP = 1024;
constexpr int LDS_BYTES = 147456;
constexpr int LDS_CTL = 143360;

__device__ __forceinline__ float bf2f(bf16_t h) { return __uint_as_float(((unsigned)h) << 16); }
__device__ __forceinline__ bf16_t f2bf(float f) { unsigned u = __float_as_uint(f); return (bf16_t)((u + 0x7fffu + ((u >> 16) & 1u)) >> 16); }
__device__ __forceinline__ float sigmoidf_(float x) { return 1.f / (1.f + expf(-x)); }
__device__ __forceinline__ int tid_() { int t = threadIdx.x; asm volatile("" : "+v"(t)); return t; }
__device__ __forceinline__ int bid_() { int b = blockIdx.x; asm volatile("" : "+s"(b)); return b; }

#define XB_TMO      128
#define XB_XCNT(j)  (256  + 64 * (j))
#define XB_XSUB(j)  (1280 + 64 * (j))
#define XB_XGEN(j)  (2304 + 64 * (j))
#define XB_TOP      3328
#define XB_TOPGEN   3392
#define XCD_BAR_WORDS 3456
#define XB_SPIN_CAP (1u << 24)
#define LAS __attribute__((address_space(3)))
__device__ __forceinline__ unsigned xb_ld(unsigned* p)              { return __hip_atomic_load(p, __ATOMIC_RELAXED, __HIP_MEMORY_SCOPE_AGENT); }
__device__ __forceinline__ unsigned xb_add(unsigned* p, unsigned v) { return __hip_atomic_fetch_add(p, v, __ATOMIC_RELAXED, __HIP_MEMORY_SCOPE_AGENT); }
__device__ __forceinline__ unsigned xb_xcc_id() { return (unsigned)__builtin_amdgcn_s_getreg((3 << 11) | 20) & 0xFu; }
#define XB_SPIN(cond, bar) do { unsigned _sp = 0; while (cond) { __builtin_amdgcn_s_sleep(1); \
    if ((++_sp & 255u) == 0u) { if (xb_ld(&(bar)[XB_TMO])) break; if (_sp > XB_SPIN_CAP) { atomicAdd(&(bar)[XB_TMO], 1u); break; } } } } while (0)
struct XcdBarrier { unsigned* bar; unsigned x; volatile LAS unsigned* st; };
__device__ __forceinline__ XcdBarrier xcd_barrier_post(unsigned* bar, volatile LAS unsigned* st) {
    XcdBarrier b; b.bar = bar; b.x = xb_xcc_id(); b.st = st;
    if (threadIdx.x == 0) (void)xb_add(&bar[XB_XCNT(b.x)], 1u);
    return b;
}
__device__ __forceinline__ void xcd_barrier_complete(unsigned* bar, unsigned x, unsigned& nloc, unsigned& nx) {
    const unsigned G = gridDim.x * gridDim.y * gridDim.z;
    unsigned sum, cnt, mine, sp = 0u;
    for (;;) {
        sum = 0u; cnt = 0u; mine = 0u;
#pragma unroll
        for (unsigned j = 0; j < 16; ++j) { const unsigned c = xb_ld(&bar[XB_XCNT(j)]); sum += c; cnt += (c > 0u) ? 1u : 0u; mine = (j == x) ? c : mine; }
        if (sum == G) break;
        __builtin_amdgcn_s_sleep(1);
        if ((++sp & 255u) == 0u) { if (xb_ld(&bar[XB_TMO])) break; if (sp > XB_SPIN_CAP) { atomicAdd(&bar[XB_TMO], 1u); break; } }
    }
    nloc = mine > 0u ? mine : 1u; nx = cnt > 0u ? cnt : 1u;
}
__device__ __forceinline__ void xcd_barrier(const XcdBarrier& b) {
    asm volatile("s_waitcnt vmcnt(0)" ::: "memory");
    __syncthreads();
    if (threadIdx.x == 0) {
        unsigned* bar = b.bar;
        const unsigned bx_ = xb_xcc_id();
        __builtin_amdgcn_s_waitcnt(0);
        unsigned nloc = b.st[0], nx = b.st[1];
        if (nloc == 0u) { xcd_barrier_complete(bar, bx_, nloc, nx); b.st[0] = nloc; b.st[1] = nx; }
        const unsigned old = xb_add(&bar[XB_XSUB(bx_)], 1u);
        const unsigned gen = old / nloc;
        if (old + 1u == (gen + 1u) * nloc) {
            __builtin_amdgcn_fence(__ATOMIC_RELEASE, "agent");
            asm volatile("s_waitcnt vmcnt(0)" ::: "memory");
            const unsigned og = xb_add(&bar[XB_TOP], 1u);
            const unsigned tg = og / nx;
            if (og + 1u == (tg + 1u) * nx) xb_add(&bar[XB_TOPGEN], 1u);
            else XB_SPIN(xb_ld(&bar[XB_TOPGEN]) == tg, bar);
            __builtin_amdgcn_fence(__ATOMIC_ACQUIRE, "agent");
            xb_add(&bar[XB_XGEN(bx_)], 1u);
            asm volatile("s_waitcnt vmcnt(0)" ::: "memory");
        } else {
            XB_SPIN(xb_ld(&bar[XB_XGEN(bx_)]) == gen, bar);
            __builtin_amdgcn_fence(__ATOMIC_ACQUIRE, "agent");
            asm volatile("s_waitcnt vmcnt(0)" ::: "memory");
        }
    }
    __syncthreads();
}

struct Params {
    const float *x, *meta, *ln1_w, *w_in, *lbnd, *hnw, *a_re, *a_im, *b_re, *b_im, *c_re, *c_im, *s5d, *log_dt, *w_glu, *b_glu,
                *lq1, *lk1, *lq2, *lk2, *subln, *w_out, *ln2_w, *wrg, *brg, *wre, *bre, *w1, *w3, *w2, *fnw;
    float* out;
    unsigned* bar;
    int *cnt, *blk_e, *ridx, *rslot, *tokrow, *rowtok, *base, *elist;
    float *lbtab, *lam, *Z, *PA, *OA, *T, *OC, *rgate, *H1, *S, *SLOC, *DEC, *A16, *S5E, *S5X, *ZP;
    bf16_t *HN, *QKV, *YG, *MIX, *H, *Y, *WinT, *WoutT, *WgluT, *SPREV, *BtY, *BtE, *WRT;
};
typedef const __attribute__((address_space(4))) Params* KP;
__device__ __forceinline__ KP kp_() { KP p = (KP)__builtin_amdgcn_kernarg_segment_ptr(); asm volatile("" : "+s"(p)); return p; }


namespace pg8 {
#define PG8_LAS __attribute__((address_space(3)))
typedef short bf16x8 __attribute__((ext_vector_type(8)));
typedef float f32x4 __attribute__((ext_vector_type(4)));
typedef unsigned u32x4 __attribute__((ext_vector_type(4)));
constexpr int BM = 256, BK = 64, HALF = 128, HTB = HALF * BK * 2, STAGE_BYTES = 8 * HTB, NXCD = 8, WGM = 8;
__host__ __device__ __forceinline__ int lds_byte(int r, int c) { const int st = (r >> 4) * 2 + (c >> 5), rr = r & 15, cc = c & 31, ob = rr * 64 + cc * 2; return st * 1024 + (ob ^ (((ob >> 9) & 1) << 5)); }
__host__ __device__ __forceinline__ void stage_rc(int b, int& R, int& C) { const int st = b / 1024, sb = b % 1024, swz = sb ^ (((sb >> 9) & 1) << 5); R = (st >> 1) * 16 + swz / 64; C = (st & 1) * 32 + (swz % 64) / 2; }
__host__ __device__ __forceinline__ int perm32(int rho) { const int n = rho >> 4, i = rho & 15; return 8 * (i >> 2) + 4 * n + (i & 3); }
struct Unit { int pm, pn, ko, nt; };
struct Gemm { const bf16_t* A; const bf16_t* Bt; int M, N, K, ld; };
struct StaticOrder {
    static constexpr bool PER_UNIT_K = false;
    int nM, nN, nwg, G, c, nt;
    __host__ __device__ void init(int M, int N, int G_, int c_, int nt_) { nM = M / BM; nN = N / BM; nwg = nM * nN; G = G_; c = c_; nt = nt_; }
    __host__ __device__ bool next(int i, Unit& u) const {
        const long L = (long)i * G + c; if (L >= nwg) return false;
        int wgid = (int)L; { const int q = nwg / NXCD, r = nwg % NXCD, xcd = wgid % NXCD, off = wgid / NXCD; wgid = (xcd < r ? xcd * (q + 1) : r * (q + 1) + (xcd - r) * q) + off; }
        const int nig = WGM * nN, gid = wgid / nig, fm = gid * WGM, gsz = (nM - fm) < WGM ? (nM - fm) : WGM;
        u.pm = fm + ((wgid % nig) % gsz); u.pn = (wgid % nig) / gsz; u.ko = 0; u.nt = nt; return true;
    }
    __device__ __forceinline__ void a_ready(const Unit&) const {}
    __device__ __forceinline__ void done(const Unit&) const {}
};
__device__ __forceinline__ unsigned cvt_pk_bf16(float lo, float hi) { unsigned r; asm volatile("v_cvt_pk_bf16_f32 %0, %1, %2" : "=v"(r) : "v"(lo), "v"(hi)); return r; }

template <class Epi, class Sched, bool ALIGN_EPI = false, bool SP2 = false>
__device__ __forceinline__ void gemm_phase(PG8_LAS unsigned char* lds, const Gemm g, const Sched& S, const Epi& E) {
    const int tid = tid_(), wid = __builtin_amdgcn_readfirstlane(tid >> 6), lane = tid & 63, wr = wid >> 2, wc = wid & 3, fr = lane & 15, fq = lane >> 4;
    const int K = g.ld;
    unsigned voffA[2], voffB[2];
#pragma unroll
    for (int i = 0; i < 2; ++i) { int R, C; stage_rc(tid * 16 + i * 8192, R, C); const int Rb = Epi::PERM ? ((R & ~31) + perm32(R & 31)) : R;
        voffA[i] = (unsigned)(R * K + C) * 2u; voffB[i] = (unsigned)(Rb * K + C) * 2u; }
    const size_t kstep = (size_t)(BK * 2);
    const size_t hstep = (size_t)HALF * K * 2;
    const size_t tstep = 2 * hstep;
    const unsigned ldsw = (unsigned)wid * 1024u;
    const int aoff = lds_byte(wr * 64 + fr, fq * 8), boff = lds_byte(wc * 32 + fr, fq * 8);
#define PG8_SA(b, h) (((b) * 2 + (h)) * HTB)
#define PG8_SB(b, h) ((4 + (b) * 2 + (h)) * HTB)
#define PG8_STAGE(bufoff, gbase, voff) do { _Pragma("unroll") for (int _i = 0; _i < 2; ++_i) \
        __builtin_amdgcn_global_load_lds((const unsigned*)((const char*)(gbase) + (voff)[_i]), (PG8_LAS unsigned*)(lds + (bufoff) + ldsw + _i * 8192), 16, 0, 0); } while (0)
#define PG8_LDA(dst, b, h) do { _Pragma("unroll") for (int m = 0; m < 4; ++m) _Pragma("unroll") for (int k = 0; k < 2; ++k) dst[m][k] = *(const PG8_LAS bf16x8*)(lds + PG8_SA(b, h) + aoff + m * 2048 + k * 1024); } while (0)
#define PG8_LDB(dst, b, h) do { _Pragma("unroll") for (int n = 0; n < 2; ++n) _Pragma("unroll") for (int k = 0; k < 2; ++k) dst[n][k] = *(const PG8_LAS bf16x8*)(lds + PG8_SB(b, h) + boff + n * 2048 + k * 1024); } while (0)
#define PG8_MMA(ai, bj, At, Bt) do { __builtin_amdgcn_s_setprio(1); _Pragma("unroll") for (int m = 0; m < 4; ++m) _Pragma("unroll") for (int n = 0; n < 2; ++n) _Pragma("unroll") for (int k = 0; k < 2; ++k) \
        acc[ai][bj][m][n] = __builtin_amdgcn_mfma_f32_16x16x32_bf16(Bt[n][k], At[m][k], acc[ai][bj][m][n], 0, 0, 0); __builtin_amdgcn_s_setprio(0); } while (0)
#define PG8_WAIT_V(n) asm volatile("s_waitcnt vmcnt(" #n ")" ::: "memory")
#define PG8_WAIT_L(n) asm volatile("s_waitcnt lgkmcnt(" #n ")" ::: "memory")
#define PG8_BAR __builtin_amdgcn_s_barrier()
#define PG8_SCHED __builtin_amdgcn_sched_barrier(0)
    Unit cur, nxt; int ui = 0;
    if (!S.next(0, cur)) return;
    f32x4 acc[2][2][4][2];
#pragma unroll
    for (int a = 0; a < 2; ++a)
#pragma unroll
        for (int b = 0; b < 2; ++b)
#pragma unroll
            for (int m = 0; m < 4; ++m)
#pragma unroll
                for (int n = 0; n < 2; ++n) acc[a][b][m][n] = (f32x4){0.f, 0.f, 0.f, 0.f};
    bf16x8 At[4][2], B0[2][2], B1[2][2];
    const char* cA = (const char*)g.A + (size_t)cur.pm * tstep + (size_t)cur.ko * 2; const char* cB = (const char*)g.Bt + (size_t)cur.pn * tstep + (size_t)cur.ko * 2;
    S.a_ready(cur);
    if constexpr (SP2) {
        PG8_STAGE(PG8_SB(0, 0), cB, voffB); PG8_STAGE(PG8_SB(0, 1), cB + hstep, voffB); PG8_STAGE(PG8_SA(0, 0), cA, voffA); PG8_STAGE(PG8_SA(0, 1), cA + hstep, voffA);
        if (wr == 1) PG8_BAR;
        PG8_WAIT_V(2); PG8_BAR;
        PG8_STAGE(PG8_SB(1, 0), cB + kstep, voffB); PG8_STAGE(PG8_SA(1, 0), cA + kstep, voffA); PG8_STAGE(PG8_SB(1, 1), cB + hstep + kstep, voffB);
        PG8_WAIT_V(6); PG8_BAR;
    } else {
        PG8_STAGE(PG8_SB(0, 0), cB, voffB); PG8_STAGE(PG8_SA(0, 0), cA, voffA); PG8_STAGE(PG8_SB(0, 1), cB + hstep, voffB); PG8_STAGE(PG8_SA(0, 1), cA + hstep, voffA);
        if (wr == 1) PG8_BAR;
        PG8_WAIT_V(4); PG8_BAR;
        PG8_STAGE(PG8_SB(1, 0), cB + kstep, voffB); PG8_STAGE(PG8_SA(1, 0), cA + kstep, voffA); PG8_STAGE(PG8_SB(1, 1), cB + hstep + kstep, voffB);
        PG8_WAIT_V(6); PG8_BAR;
    }
    for (;;) {
        const bool has_next = S.next(ui + 1, nxt);
        const char* nA = has_next ? (const char*)g.A + (size_t)nxt.pm * tstep + (size_t)nxt.ko * 2 : cA; const char* nB = has_next ? (const char*)g.Bt + (size_t)nxt.pn * tstep + (size_t)nxt.ko * 2 : cB;
        const int nt = Sched::PER_UNIT_K ? cur.nt : g.K / BK;
        for (int t = 0; t < nt; t += 2) {
            const bool last = (t == nt - 2);
            const char* a1 = cA + (size_t)(t + 1) * kstep;
            const char* a2 = last ? nA : cA + (size_t)(t + 2) * kstep; const char* b2 = last ? nB : cB + (size_t)(t + 2) * kstep;
            const char* a3 = a2 + kstep; const char* b3 = b2 + kstep;
            if (last && has_next) S.a_ready(nxt);
            if constexpr (SP2) {
            PG8_LDB(B0, 0, 0); PG8_LDB(B1, 0, 1); PG8_SCHED; PG8_LDA(At, 0, 0); PG8_STAGE(PG8_SA(1, 1), a1 + hstep, voffA);
            PG8_WAIT_V(8); PG8_WAIT_L(0); PG8_BAR; PG8_MMA(0, 0, At, B0); PG8_MMA(0, 1, At, B1); PG8_BAR; PG8_SCHED;
            PG8_LDA(At, 0, 1); PG8_STAGE(PG8_SB(0, 0), b2, voffB); PG8_STAGE(PG8_SB(0, 1), b2 + hstep, voffB); PG8_STAGE(PG8_SA(0, 0), a2, voffA);
            PG8_WAIT_V(8); PG8_WAIT_L(0); PG8_BAR; PG8_MMA(1, 0, At, B0); PG8_MMA(1, 1, At, B1); PG8_BAR; PG8_SCHED;
            PG8_LDB(B0, 1, 0); PG8_LDB(B1, 1, 1); PG8_SCHED; PG8_LDA(At, 1, 0); PG8_STAGE(PG8_SA(0, 1), a2 + hstep, voffA);
            PG8_WAIT_V(8); PG8_WAIT_L(0); PG8_BAR; PG8_MMA(0, 0, At, B0); PG8_MMA(0, 1, At, B1); PG8_BAR; PG8_SCHED;
            PG8_LDA(At, 1, 1); PG8_STAGE(PG8_SB(1, 0), b3, voffB); PG8_STAGE(PG8_SB(1, 1), b3 + hstep, voffB); PG8_STAGE(PG8_SA(1, 0), a3, voffA);
            PG8_WAIT_V(8); PG8_WAIT_L(0); PG8_BAR; PG8_MMA(1, 0, At, B0); PG8_MMA(1, 1, At, B1); PG8_BAR; PG8_SCHED;
            } else {
            PG8_LDB(B0, 0, 0); PG8_SCHED; PG8_LDA(At, 0, 0); PG8_STAGE(PG8_SA(1, 1), a1 + hstep, voffA);
            PG8_WAIT_L(8); PG8_BAR; PG8_WAIT_L(0); PG8_MMA(0, 0, At, B0); PG8_BAR; PG8_SCHED;
            PG8_LDB(B1, 0, 1); PG8_STAGE(PG8_SB(0, 0), b2, voffB);
            PG8_BAR; PG8_WAIT_L(0); PG8_MMA(0, 1, At, B1); PG8_BAR;
            PG8_LDA(At, 0, 1); PG8_STAGE(PG8_SA(0, 0), a2, voffA);
            PG8_BAR; PG8_WAIT_L(0); PG8_MMA(1, 0, At, B0); PG8_BAR; PG8_SCHED;
            PG8_STAGE(PG8_SB(0, 1), b2 + hstep, voffB);
            PG8_WAIT_V(6); PG8_BAR; PG8_MMA(1, 1, At, B1); PG8_BAR;
            PG8_LDB(B0, 1, 0); PG8_SCHED; PG8_LDA(At, 1, 0); PG8_STAGE(PG8_SA(0, 1), a2 + hstep, voffA);
            PG8_WAIT_L(8); PG8_BAR; PG8_WAIT_L(0); PG8_MMA(0, 0, At, B0); PG8_BAR; PG8_SCHED;
            PG8_LDB(B1, 1, 1); PG8_STAGE(PG8_SB(1, 0), b3, voffB);
            PG8_BAR; PG8_WAIT_L(0); PG8_MMA(0, 1, At, B1); PG8_BAR;
            PG8_LDA(At, 1, 1); PG8_STAGE(PG8_SA(1, 0), a3, voffA);
            PG8_BAR; PG8_WAIT_L(0); PG8_MMA(1, 0, At, B0); PG8_BAR; PG8_SCHED;
            PG8_STAGE(PG8_SB(1, 1), b3 + hstep, voffB);
            PG8_WAIT_V(6); PG8_BAR; PG8_MMA(1, 1, At, B1); PG8_BAR;
            }
        }
        if constexpr (ALIGN_EPI) { if (wr == 0) PG8_BAR; }
        E(acc, cur, wr, wc, fr, fq);
        if (!has_next) break;
#pragma unroll
        for (int a = 0; a < 2; ++a)
#pragma unroll
            for (int b = 0; b < 2; ++b)
#pragma unroll
                for (int m = 0; m < 4; ++m)
#pragma unroll
                    for (int n = 0; n < 2; ++n) acc[a][b][m][n] = (f32x4){0.f, 0.f, 0.f, 0.f};
        cur = nxt; cA = nA; cB = nB; ++ui;
        if constexpr (ALIGN_EPI) { if (wr == 1) PG8_BAR; }
    }
    PG8_WAIT_V(0);
    if constexpr (!ALIGN_EPI) { if (wr == 0) PG8_BAR; }
    PG8_BAR;
#undef PG8_SA
#undef PG8_SB
#undef PG8_STAGE
#undef PG8_LDA
#undef PG8_LDB
#undef PG8_MMA
#undef PG8_WAIT_V
#undef PG8_WAIT_L
#undef PG8_BAR
#undef PG8_SCHED
}
struct EpiInProj {
    static constexpr bool PERM = true;
    float* PA; bf16_t* QKV;
    __device__ __forceinline__ void operator()(const f32x4 (&acc)[2][2][4][2], const Unit& u, int wr, int wc, int fr, int fq) const {
        const int row0 = u.pm * BM + wr * 64 + fr, colt = u.pn * BM + wc * 32 + 8 * fq;
        if (colt < PAW) {
#pragma unroll
            for (int ai = 0; ai < 2; ++ai)
#pragma unroll
                for (int m = 0; m < 4; ++m) { float* rp = PA + (size_t)(row0 + ai * HALF + m * 16) * PAW + colt;
#pragma unroll
                    for (int bj = 0; bj < 2; ++bj) { *(f32x4*)(rp + bj * HALF) = acc[ai][bj][m][0]; *(f32x4*)(rp + bj * HALF + 4) = acc[ai][bj][m][1]; } }
        } else {
#pragma unroll
            for (int ai = 0; ai < 2; ++ai)
#pragma unroll
                for (int m = 0; m < 4; ++m) { bf16_t* rp = QKV + (size_t)(row0 + ai * HALF + m * 16) * QKVW + (colt - PAW);
#pragma unroll
                    for (int bj = 0; bj < 2; ++bj) { const f32x4 v0 = acc[ai][bj][m][0], v1 = acc[ai][bj][m][1];
                        u32x4 w; w.x = cvt_pk_bf16(v0[0], v0[1]); w.y = cvt_pk_bf16(v0[2], v0[3]); w.z = cvt_pk_bf16(v1[0], v1[1]); w.w = cvt_pk_bf16(v1[2], v1[3]);
                        *(u32x4*)(rp + bj * HALF) = w; } }
        }
    }
};
struct EpiResidual {
    static constexpr bool PERM = true;
    float* Z;
    __device__ __forceinline__ void operator()(const f32x4 (&acc)[2][2][4][2], const Unit& u, int wr, int wc, int fr, int fq) const {
        const int row0 = u.pm * BM + wr * 64 + fr, colt = u.pn * BM + wc * 32 + 8 * fq;
#pragma unroll
        for (int ai = 0; ai < 2; ++ai)
#pragma unroll
            for (int m = 0; m < 4; ++m) { const int row = row0 + ai * HALF + m * 16; if (row < TOK) { float* rp = Z + (size_t)row * DM + colt;
#pragma unroll
                for (int bj = 0; bj < 2; ++bj) { f32x4* p0 = (f32x4*)(rp + bj * HALF); f32x4* p1 = (f32x4*)(rp + bj * HALF + 4);
                    const f32x4 z0 = *p0, z1 = *p1; *p0 = z0 + acc[ai][bj][m][0]; *p1 = z1 + acc[ai][bj][m][1]; } } }
    }
};
struct OutOrder {
    static constexpr bool PER_UNIT_K = true;
    StaticOrder main;
    __device__ bool next(int i, Unit& u) const {
        if (main.next(i, u)) return true;
        const int r0 = (main.nwg + main.G - 1) / main.G;
        const int L = (i - r0) * main.G + main.c; if (i < r0 || L >= 64) return false;
        u.pm = 32; u.pn = L & 7; u.ko = (L >> 3) * 256; u.nt = 4; return true; }
    __device__ __forceinline__ void a_ready(const Unit&) const {}
    __device__ __forceinline__ void done(const Unit&) const {}
};
struct EpiOutProj {
    static constexpr bool PERM = true;
    float* Z; float* ZP;
    __device__ __forceinline__ void operator()(const f32x4 (&acc)[2][2][4][2], const Unit& u, int wr, int wc, int fr, int fq) const {
        const bool tail = u.pm == 32;
        const int row0 = (tail ? (u.ko >> 8) * BM : u.pm * BM) + wr * 64 + fr, colt = u.pn * BM + wc * 32 + 8 * fq;
        float* base = tail ? ZP : Z;
#pragma unroll
        for (int ai = 0; ai < 2; ++ai)
#pragma unroll
            for (int m = 0; m < 4; ++m) { float* rp = base + (size_t)(row0 + ai * HALF + m * 16) * DM + colt;
#pragma unroll
                for (int bj = 0; bj < 2; ++bj) { f32x4* p0 = (f32x4*)(rp + bj * HALF); f32x4* p1 = (f32x4*)(rp + bj * HALF + 4);
                    f32x4 z0 = {0.f, 0.f, 0.f, 0.f}, z1 = {0.f, 0.f, 0.f, 0.f};
                    if (!tail) { z0 = *p0; z1 = *p1; }
                    *p0 = z0 + acc[ai][bj][m][0]; *p1 = z1 + acc[ai][bj][m][1]; } }
    }
};
struct EpiGlu {
    static constexpr bool PERM = true;
    bf16_t* MIX; const float* bias;
    __device__ __forceinline__ void operator()(const f32x4 (&acc)[2][2][4][2], const Unit& u, int wr, int wc, int fr, int fq) const {
        const int row0 = u.pm * BM + wr * 64 + fr, c0 = u.pn * HALF + wc * 32 + 8 * fq;
        const f32x4 bv0 = *(const f32x4*)(bias + c0), bv1 = *(const f32x4*)(bias + c0 + 4), bg0 = *(const f32x4*)(bias + 512 + c0), bg1 = *(const f32x4*)(bias + 512 + c0 + 4);
#pragma unroll
        for (int ai = 0; ai < 2; ++ai)
#pragma unroll
            for (int m = 0; m < 4; ++m) { const f32x4 v0 = acc[ai][0][m][0] + bv0, v1 = acc[ai][0][m][1] + bv1, g0 = acc[ai][1][m][0] + bg0, g1 = acc[ai][1][m][1] + bg1;
                float o[8];
#pragma unroll
                for (int e = 0; e < 4; ++e) { o[e] = v0[e] / (1.f + __expf(-g0[e])); o[4 + e] = v1[e] / (1.f + __expf(-g1[e])); }
                u32x4 w; w.x = cvt_pk_bf16(o[0], o[1]); w.y = cvt_pk_bf16(o[2], o[3]); w.z = cvt_pk_bf16(o[4], o[5]); w.w = cvt_pk_bf16(o[6], o[7]);
                *(u32x4*)(MIX + (size_t)(row0 + ai * HALF + m * 16) * DM + 512 + c0) = w; }
    }
};
}

__device__ __forceinline__ void transpose_item(const float* W, int K, int N, bf16_t* WT, int k0, int n0, int row0, float* scr, int lane) {
#pragma unroll 8
    for (int i = 0; i < 32; ++i) { const int kk = 2 * i + (lane >> 5); scr[kk * 33 + (lane & 31)] = W[(size_t)(k0 + kk) * N + n0 + (lane & 31)]; }
    asm volatile("s_waitcnt lgkmcnt(0)" ::: "memory");
    const int c = lane & 7;
#pragma unroll
    for (int j = 0; j < 4; ++j) { const int n = (lane >> 3) + 8 * j; const float* sp = scr + (8 * c) * 33 + n;
        pg8::u32x4 o; o.x = pg8::cvt_pk_bf16(sp[0 * 33], sp[1 * 33]); o.y = pg8::cvt_pk_bf16(sp[2 * 33], sp[3 * 33]); o.z = pg8::cvt_pk_bf16(sp[4 * 33], sp[5 * 33]); o.w = pg8::cvt_pk_bf16(sp[6 * 33], sp[7 * 33]);
        *(pg8::u32x4*)(WT + (size_t)(row0 + n) * K + k0 + 8 * c) = o; }
    asm volatile("s_waitcnt lgkmcnt(0)" ::: "memory");
}
__device__ __forceinline__ void ph_weights(KP P, char* lds) {
    const int tid = tid_(), lane = tid & 63, wave = tid >> 6;
    float* scr = (float*)lds + wave * (64 * 33);
    const int gw = bid_() * 8 + wave, NGW = gridDim.x * 8;
    constexpr int I_IN = (DM / 64) * (INW / 32), I_OUT = (DM / 64) * (DM / 32), I_GLU = (512 / 64) * (1024 / 32), I_L = I_IN + I_OUT + I_GLU;
    for (int it = gw; it < 2 * I_L; it += NGW) {
        const int layer = it / I_L; int r = it % I_L;
        if (r < I_IN) { const int nb = INW / 32, kb = r / nb, n0 = (r % nb) * 32;
            transpose_item(P->w_in + (size_t)layer * DM * INW, DM, INW, P->WinT + (size_t)layer * INW * DM, kb * 64, n0, n0, scr, lane); continue; }
        r -= I_IN;
        if (r < I_OUT) { const int nb = DM / 32, kb = r / nb, n0 = (r % nb) * 32;
            transpose_item(P->w_out + (size_t)layer * DM * DM, DM, DM, P->WoutT + (size_t)layer * DM * DM, kb * 64, n0, n0, scr, lane); continue; }
        r -= I_OUT;
        { const int nb = 1024 / 32, kb = r / nb, n0 = (r % nb) * 32;
          const int row0 = ((n0 & 511) >> 7) * 256 + (n0 >> 9) * 128 + (n0 & 127);
          transpose_item(P->w_glu + (size_t)layer * 512 * 1024, 512, 1024, P->WgluT + (size_t)layer * 1024 * 512, kb * 64, n0, row0, scr, lane); }
    }
}


namespace fa {
using bf16x8 = __attribute__((ext_vector_type(8))) short;
using s16x4  = __attribute__((ext_vector_type(4))) short;
using f32x16 = __attribute__((ext_vector_type(16))) float;
using u32x4  = __attribute__((ext_vector_type(4))) unsigned;
constexpr int D = 128, NW = 8, QBLK = 32, KVBLK = 64, LDQK = QKVW;
constexpr float SCALE = 0.088388347648318440f, THR = 8.f, NEG = -1e30f;
constexpr size_t SHM_V = KVBLK * D * 2, SHM_K = KVBLK * D * 2, SHM_ATTN = 2 * SHM_V + 2 * SHM_K + NW * 64 * 4;
#define KSWZ(row, colB) ((row) * 256 + ((colB) ^ (((row) & 7) << 4)))
#define SBAR() __builtin_amdgcn_sched_barrier(0)
__device__ __forceinline__ int crow(int r, int hi) { return (r & 3) + 8 * (r >> 2) + 4 * hi; }
__device__ __forceinline__ unsigned cvtpk(float lo, float hi) { unsigned r; asm volatile("v_cvt_pk_bf16_f32 %0, %1, %2" : "=v"(r) : "v"(lo), "v"(hi)); return r; }
__device__ __forceinline__ void partialSM(f32x16& p0, f32x16& p1, float& m_reg, float& mn, float& alpha) {
  constexpr float C = SCALE * 1.4426950408889634f;
  float pmax = p0[0]; for (int r = 1; r < 16; ++r) pmax = fmaxf(pmax, p0[r]); for (int r = 0; r < 16; ++r) pmax = fmaxf(pmax, p1[r]);
  { auto rr = __builtin_amdgcn_permlane32_swap(__float_as_uint(pmax), __float_as_uint(pmax), false, false);
    pmax = fmaxf(__uint_as_float(rr[0]), __uint_as_float(rr[1])); }
  if (__builtin_expect(__all(pmax - m_reg <= THR / SCALE), 1)) { mn = m_reg; alpha = 1.f; }
  else { mn = fmaxf(m_reg, pmax); alpha = __builtin_amdgcn_exp2f((m_reg - mn) * C); m_reg = mn; }
  float mnC = -mn * C;
  for (int r = 0; r < 16; ++r) p0[r] = fmaf(p0[r], C, mnC); for (int r = 0; r < 16; ++r) p1[r] = fmaf(p1[r], C, mnC);
  for (int r = 0; r < 16; ++r) p0[r] = __builtin_amdgcn_exp2f(p0[r]);
}
__device__ __forceinline__ void finishSM(f32x16& p0, f32x16& p1, float alpha, float& l_reg, bf16x8& pa0, bf16x8& pa1, bf16x8& pa2, bf16x8& pa3) {
  for (int r = 0; r < 16; ++r) p1[r] = __builtin_amdgcn_exp2f(p1[r]);
  float ps = 0; for (int r = 0; r < 16; ++r) ps += p0[r]; for (int r = 0; r < 16; ++r) ps += p1[r];
  { auto rr = __builtin_amdgcn_permlane32_swap(__float_as_uint(ps), __float_as_uint(ps), false, false);
    ps = __uint_as_float(rr[0]) + __uint_as_float(rr[1]); }
  l_reg = l_reg * alpha + ps;
#define PK4(P, BASE, OUT) do { unsigned a0 = cvtpk(P[BASE + 0], P[BASE + 1]), a1 = cvtpk(P[BASE + 2], P[BASE + 3]);   \
    unsigned b0 = cvtpk(P[BASE + 4], P[BASE + 5]), b1 = cvtpk(P[BASE + 6], P[BASE + 7]);                              \
    auto r0 = __builtin_amdgcn_permlane32_swap(a0, b0, false, false); auto r1 = __builtin_amdgcn_permlane32_swap(a1, b1, false, false); \
    u32x4 w = {r0[0], r1[0], r0[1], r1[1]}; OUT = *reinterpret_cast<bf16x8*>(&w); } while (0)
  PK4(p0, 0, pa0); PK4(p0, 8, pa1); PK4(p1, 0, pa2); PK4(p1, 8, pa3);
#undef PK4
}
__device__ __forceinline__ void qkt(f32x16& p0, f32x16& p1, const bf16_t* Ks, const bf16x8* qr, int r32, int hi) {
  p0 = f32x16{}; p1 = f32x16{};
  for (int d0 = 0; d0 < 8; ++d0) { int cb = (d0 * 16 + hi * 8) * 2;
    bf16x8 b0 = *reinterpret_cast<const bf16x8*>((const char*)Ks + KSWZ(r32, cb));
    bf16x8 b1 = *reinterpret_cast<const bf16x8*>((const char*)Ks + KSWZ(32 + r32, cb));
    p0 = __builtin_amdgcn_mfma_f32_32x32x16_bf16(b0, qr[d0], p0, 0, 0, 0);
    p1 = __builtin_amdgcn_mfma_f32_32x32x16_bf16(b1, qr[d0], p1, 0, 0, 0); }
}
__device__ __forceinline__ void mask_tile(f32x16& p0, f32x16& p1, int kt, int vis) {
  if (kt > vis) {
    const bool part = (kt == vis + 1);
    for (int r = 0; r < 16; ++r) p1[r] = NEG;
    for (int r = 8; r < 16; ++r) p0[r] = NEG;
    if (!part) for (int r = 0; r < 8; ++r) p0[r] = NEG;
  }
}
__device__ __forceinline__ int v_st(int k, int c) { const int kk = (k & ~0xC) | ((k & 4) << 1) | ((k & 8) >> 1); return ((kk >> 3) * 4 + (c >> 5)) * 512 + ((kk & 7) * 32 + (c & 31)) * 2; }
__device__ __forceinline__ int v_rd_base(int lane) { return ((lane & 3) << 3) | (((lane >> 2) & 3) << 6) | (((lane >> 4) & 1) << 5) | (((lane >> 5) & 1) << 8); }
constexpr int v_rd_off(int d0, int ks, int half) { return d0 * 512 + ks * 4096 + half * 2048; }
template <int OFF> __device__ __forceinline__ s16x4 tr_read(int vb) {
  s16x4 r; asm volatile("ds_read_b64_tr_b16 %0, %1 offset:%2" : "=&v"(r) : "v"(vb), "i"(OFF) : "memory"); return r;
}
template <int D0> __device__ __forceinline__ void pv_one(f32x16& od, int vb, bf16x8 pa0, bf16x8 pa1, bf16x8 pa2, bf16x8 pa3) {
  const s16x4 l0 = tr_read<v_rd_off(D0, 0, 0)>(vb), h0 = tr_read<v_rd_off(D0, 0, 1)>(vb), l1 = tr_read<v_rd_off(D0, 1, 0)>(vb), h1 = tr_read<v_rd_off(D0, 1, 1)>(vb);
  const s16x4 l2 = tr_read<v_rd_off(D0, 2, 0)>(vb), h2 = tr_read<v_rd_off(D0, 2, 1)>(vb), l3 = tr_read<v_rd_off(D0, 3, 0)>(vb), h3 = tr_read<v_rd_off(D0, 3, 1)>(vb);
  asm volatile("s_waitcnt lgkmcnt(0)" ::: "memory"); SBAR();
#define PK(L, H) (bf16x8){L[0], L[1], L[2], L[3], H[0], H[1], H[2], H[3]}
  od = __builtin_amdgcn_mfma_f32_32x32x16_bf16(pa0, PK(l0, h0), od, 0, 0, 0);
  od = __builtin_amdgcn_mfma_f32_32x32x16_bf16(pa1, PK(l1, h1), od, 0, 0, 0);
  od = __builtin_amdgcn_mfma_f32_32x32x16_bf16(pa2, PK(l2, h2), od, 0, 0, 0);
  od = __builtin_amdgcn_mfma_f32_32x32x16_bf16(pa3, PK(l3, h3), od, 0, 0, 0);
#undef PK
}
__device__ __forceinline__ void pv_d0(f32x16* o, int vb, bf16x8 pa0, bf16x8 pa1, bf16x8 pa2, bf16x8 pa3) {
  pv_one<0>(o[0], vb, pa0, pa1, pa2, pa3); pv_one<1>(o[1], vb, pa0, pa1, pa2, pa3); pv_one<2>(o[2], vb, pa0, pa1, pa2, pa3); pv_one<3>(o[3], vb, pa0, pa1, pa2, pa3);
}
__device__ __forceinline__ void attn_unit(const bf16_t* __restrict__ Qb, const bf16_t* __restrict__ Kh, const bf16_t* __restrict__ Vh, float* __restrict__ Ob, int NT, int vis4, char* lds) {
  const int tid = tid_(), wid = tid >> 6, lane = tid & 63, r32 = lane & 31, hi = lane >> 5;
  const int vis = vis4 + (wid >> 1);
  bf16_t* V_lds = (bf16_t*)lds; bf16_t* K_lds = (bf16_t*)(lds + 2 * SHM_V);
  float* ws = (float*)(lds + 2 * SHM_V + 2 * SHM_K) + wid * 64; float* li_l = ws; float* al_l = ws + 32;
  float m_reg = NEG, l_reg = 0; f32x16 o[4] = {}; bf16x8 qr[8];
  const bf16_t* Qw = Qb + (long)(wid * QBLK + r32) * LDQK + hi * 8;
#pragma unroll
  for (int d0 = 0; d0 < 8; ++d0) qr[d0] = *reinterpret_cast<const bf16x8*>(Qw + d0 * 16);
  const int sr = tid >> 4, sc = (tid & 15) * 8, vst0 = v_st(sr, sc), vst1 = v_st(32 + sr, sc);
  const int vb0 = (int)(uintptr_t)V_lds + v_rd_base(lane);
  struct { bf16x8 vs0, vs1, ks0, ks1; } sr_[2];
#define SLOAD(i, k0) do { sr_[i].vs0 = *reinterpret_cast<const bf16x8*>(&Vh[(long)((k0) + sr) * LDQK + sc]); sr_[i].vs1 = *reinterpret_cast<const bf16x8*>(&Vh[(long)((k0) + 32 + sr) * LDQK + sc]); \
    sr_[i].ks0 = *reinterpret_cast<const bf16x8*>(&Kh[(long)((k0) + sr) * LDQK + sc]); sr_[i].ks1 = *reinterpret_cast<const bf16x8*>(&Kh[(long)((k0) + 32 + sr) * LDQK + sc]); } while (0)
#define SWRITE(b, i) do { *(bf16x8*)((char*)V_lds + (b) * SHM_V + vst0) = sr_[i].vs0;          \
    *(bf16x8*)((char*)V_lds + (b) * SHM_V + vst1) = sr_[i].vs1; int kc = sc * 2;               \
    *(bf16x8*)((char*)K_lds + (b) * SHM_K + KSWZ(sr, kc)) = sr_[i].ks0;                       \
    *(bf16x8*)((char*)K_lds + (b) * SHM_K + KSWZ(32 + sr, kc)) = sr_[i].ks1; } while (0)
#define SWAIT() asm volatile("s_waitcnt vmcnt(4)" ::: "memory")
#define RESC(a) do { if (__any((a) < 1.f)) { if (hi == 0) al_l[r32] = (a); asm volatile("s_waitcnt lgkmcnt(0)" ::: "memory"); \
    for (int d = 0; d < 4; ++d) for (int r = 0; r < 16; ++r) o[d][r] *= al_l[crow(r, hi)]; } } while (0)
  f32x16 pA0, pA1, pB0, pB1; float mnA, mnB, alA, alB; bf16x8 pa0, pa1, pa2, pa3;
  constexpr int SE = 0, SO = 1;
  SLOAD(SE, 0); asm volatile("s_waitcnt vmcnt(0)" ::: "memory"); SWRITE(0, SE); __syncthreads();
  qkt(pA0, pA1, K_lds, qr, r32, hi); mask_tile(pA0, pA1, 0, vis); partialSM(pA0, pA1, m_reg, mnA, alA);
  SLOAD(SO, KVBLK); if (2 < NT) SLOAD(SE, 2 * KVBLK);
  SWAIT(); SWRITE(1, SO); __syncthreads();
  for (int j = 1; j + 1 < NT; j += 2) {
    SBAR(); qkt(pB0, pB1, (bf16_t*)((char*)K_lds + SHM_K), qr, r32, hi); mask_tile(pB0, pB1, j, vis);
    finishSM(pA0, pA1, alA, l_reg, pa0, pa1, pa2, pa3); SBAR();
    SLOAD(SO, (j + 2) * KVBLK); SBAR();
    pv_d0(o, vb0, pa0, pa1, pa2, pa3); partialSM(pB0, pB1, m_reg, mnB, alB);
    __syncthreads(); SWAIT(); SWRITE(0, SE);
    RESC(alB); __syncthreads();
    SBAR(); qkt(pA0, pA1, K_lds, qr, r32, hi); mask_tile(pA0, pA1, j + 1, vis);
    finishSM(pB0, pB1, alB, l_reg, pa0, pa1, pa2, pa3); SBAR();
    if (j + 3 < NT) SLOAD(SE, (j + 3) * KVBLK); SBAR();
    pv_d0(o, vb0 + (int)SHM_V, pa0, pa1, pa2, pa3); partialSM(pA0, pA1, m_reg, mnA, alA);
    __syncthreads(); SWAIT(); SWRITE(1, SO);
    RESC(alA); __syncthreads();
  }
  SBAR(); qkt(pB0, pB1, (bf16_t*)((char*)K_lds + SHM_K), qr, r32, hi); mask_tile(pB0, pB1, NT - 1, vis);
  finishSM(pA0, pA1, alA, l_reg, pa0, pa1, pa2, pa3); SBAR();
  pv_d0(o, vb0, pa0, pa1, pa2, pa3); partialSM(pB0, pB1, m_reg, mnB, alB);
  __syncthreads(); RESC(alB);
  finishSM(pB0, pB1, alB, l_reg, pa0, pa1, pa2, pa3); SBAR();
  pv_d0(o, vb0 + (int)SHM_V, pa0, pa1, pa2, pa3);
  if (hi == 0) li_l[r32] = l_reg; asm volatile("s_waitcnt lgkmcnt(0)" ::: "memory");
  float rli[16];
#pragma unroll
  for (int r = 0; r < 16; ++r) rli[r] = __builtin_amdgcn_rcpf(li_l[crow(r, hi)]);
  float* Ow = Ob + (long)(wid * QBLK) * DM;
#pragma unroll
  for (int r = 0; r < 16; ++r) { int orow = crow(r, hi);
    for (int d0 = 0; d0 < 4; ++d0) Ow[(long)orow * DM + d0 * 32 + r32] = o[d0][r] * rli[r]; }
  __syncthreads();
#undef SLOAD
#undef SWRITE
#undef SWAIT
#undef RESC
}
#undef KSWZ
#undef SBAR
}

__device__ __forceinline__ void ph_attention(KP P, char* lds) {
    const bf16_t* QKV = P->QKV; float* OC = P->OC;
#pragma unroll 1
    for (int c = bid_(); c < 256; c += gridDim.x) {
        const int combo = c >> 2, b = combo >> 4, h = (combo >> 2) & 3, i = (combo >> 1) & 1, vh = combo & 1;
        const bf16_t* Kh = QKV + (size_t)(b * LL) * QKVW + 1024 + h * 256 + i * 128;
        const bf16_t* Vh = QKV + (size_t)(b * LL) * QKVW + 2048 + h * 256 + vh * 128;
#pragma unroll 1
        for (int s = 0; s < 2; ++s) {
            const int jb = s == 0 ? (c & 3) : 7 - (c & 3);
            const size_t row0 = (size_t)(b * LL) + NMETA + 256 * jb;
            fa::attn_unit(QKV + row0 * QKVW + h * 256 + i * 128, Kh, Vh, OC + row0 * DM + h * 512 + i * 256 + vh * 128, 4 * jb + 6, 4 * jb, lds);
        }
    }
#pragma unroll 1
    for (int gw0 = bid_() * 8; gw0 < 512; gw0 += gridDim.x * 8) {
        const int tid = tid_(), lane = tid & 63, gw = gw0 + (tid >> 6);
        if (gw < 512) {
            const int b = gw >> 7, h = (gw >> 5) & 3, i = (gw >> 4) & 1, row = gw & 15;
            const bf16_t* q = QKV + (size_t)(b * LL + row) * QKVW + h * 256 + i * 128;
            const int key = lane & 15;
            const bf16_t* k = QKV + (size_t)(b * LL + key) * QKVW + 1024 + h * 256 + i * 128;
            float sc = 0.f;
            for (int d = 0; d < 128; ++d) sc = fmaf(bf2f(q[d]), bf2f(k[d]), sc);
            sc *= 0.08838834764831845f;
            float m = sc;
#pragma unroll
            for (int o = 8; o > 0; o >>= 1) m = fmaxf(m, __shfl_xor(m, o));
            const float e = expf(sc - m);
            float ssum = e;
#pragma unroll
            for (int o = 8; o > 0; o >>= 1) ssum += __shfl_xor(ssum, o);
            const float p = e / ssum;
            float acc[4] = {0.f, 0.f, 0.f, 0.f};
#pragma unroll
            for (int j = 0; j < 16; ++j) {
                const float pj = __int_as_float(__builtin_amdgcn_readlane(__float_as_int(p), j));
                const bf16_t* v = QKV + (size_t)(b * LL + j) * QKVW + 2048 + h * 256 + lane * 4;
#pragma unroll
                for (int e2 = 0; e2 < 4; ++e2) acc[e2] = fmaf(pj, bf2f(v[e2]), acc[e2]);
            }
            float* o = OC + (size_t)(b * LL + row) * DM + h * 512 + i * 256 + lane * 4;
            o[0] = acc[0]; o[1] = acc[1]; o[2] = acc[2]; o[3] = acc[3];
        }
    }
}


namespace hg {
using bf16x8 = __attribute__((ext_vector_type(8))) short;
using s16x4  = __attribute__((ext_vector_type(4))) short;
using f32x16 = __attribute__((ext_vector_type(16))) float;
using u32x4  = __attribute__((ext_vector_type(4))) unsigned;
constexpr int NCH = 33, NU = 16 * NCH;
constexpr int SK = 136;
constexpr int SS = 72;
__device__ __forceinline__ int crow(int r, int hi) { return (r & 3) + 8 * (r >> 2) + 4 * hi; }
__device__ __forceinline__ unsigned cvtpk(float lo, float hi) { unsigned r; asm volatile("v_cvt_pk_bf16_f32 %0, %1, %2" : "=v"(r) : "v"(lo), "v"(hi)); return r; }

__device__ __forceinline__ void prep(const float* PA, const float* lbtab, size_t row0, int c, int h, int k, int tq, float* qsum, float (&b)[16], float (&kk)[16], float& bend, float& r) {
    const float lbv = lbtab[h * 128 + k];
    float run = 0.f;
#pragma unroll
    for (int i = 0; i < 16; ++i) {
        const int t = 16 * tq + i; const bool valid = (c * 64 + t) < LL;
        const float fp = valid ? PA[(row0 + t) * PAW + 512 + h * 128 + k] : 0.f;
        const float kv = valid ? (1.f - lbv) / (1.f + __expf(fp)) : 0.f;
        kk[i] = kv; run += fmaxf(log1pf(-kv), -30.f); b[i] = run;
    }
    qsum[tq * 128 + k] = run;
    __syncthreads();
    const float q0 = qsum[k], q1 = qsum[128 + k], q2 = qsum[256 + k], q3 = qsum[384 + k];
    const float off = tq == 0 ? 0.f : (tq == 1 ? q0 : (tq == 2 ? q0 + q1 : q0 + q1 + q2));
    r = q0 + q1; bend = (q0 + q1) + (q2 + q3);
#pragma unroll
    for (int i = 0; i < 16; ++i) b[i] += off;
}
__device__ __forceinline__ void store16(bf16_t* dst, const float (&x)[16]) {
    u32x4 w0, w1;
    w0.x = cvtpk(x[0], x[1]); w0.y = cvtpk(x[2], x[3]); w0.z = cvtpk(x[4], x[5]); w0.w = cvtpk(x[6], x[7]);
    w1.x = cvtpk(x[8], x[9]); w1.y = cvtpk(x[10], x[11]); w1.z = cvtpk(x[12], x[13]); w1.w = cvtpk(x[14], x[15]);
    *(u32x4*)dst = w0; *(u32x4*)(dst + 8) = w1;
}

__device__ __forceinline__ void local_states(KP P, char* lds, int layer) {
    bf16_t* KhT = (bf16_t*)lds; bf16_t* VT = KhT + 128 * SS; float* qsum = (float*)(VT + 128 * SS);
    const float* PA = P->PA; const float* lbtab = P->lbtab + layer * 512; float* SLOC = P->SLOC; float* DEC = P->DEC;
    const int tid = tid_(), k = tid & 127, tq = tid >> 7, lane = tid & 63, wid = tid >> 6, r32 = lane & 31, hh = lane >> 5;
    for (int u = bid_(); u < NU; u += gridDim.x) {
        const int bh = u / NCH, c = u % NCH, b_ = bh >> 2, h = bh & 3; const size_t row0 = (size_t)b_ * LL + c * 64;
        float b[16], kk[16], bend, r;
        prep(PA, lbtab, row0, c, h, k, tq, qsum, b, kk, bend, r);
        float x[16];
#pragma unroll
        for (int i = 0; i < 16; ++i) x[i] = kk[i] * __expf(bend - b[i]);
        store16(KhT + k * SS + 16 * tq, x);
#pragma unroll
        for (int i = 0; i < 16; ++i) { const int t = 16 * tq + i; x[i] = (c * 64 + t) < LL ? PA[(row0 + t) * PAW + 1024 + h * 128 + k] : 0.f; }
        store16(VT + k * SS + 16 * tq, x);
        if (tq == 0) DEC[u * 128 + k] = __expf(bend);
        __syncthreads();
        const int vt = wid >> 1;
#pragma unroll
        for (int j = 0; j < 2; ++j) {
            const int kt = (wid & 1) * 2 + j;
            f32x16 acc = {};
#pragma unroll
            for (int sg = 0; sg < 4; ++sg) {
                const bf16x8 a = *(const bf16x8*)(VT + (vt * 32 + r32) * SS + sg * 16 + hh * 8);
                const bf16x8 bb = *(const bf16x8*)(KhT + (kt * 32 + r32) * SS + sg * 16 + hh * 8);
                acc = __builtin_amdgcn_mfma_f32_32x32x16_bf16(a, bb, acc, 0, 0, 0);
            }
            float* o = SLOC + (size_t)u * 16384 + kt * 32 + r32;
#pragma unroll
            for (int rg = 0; rg < 16; ++rg) o[(vt * 32 + crow(rg, hh)) * 128] = acc[rg];
        }
        __syncthreads();
    }
}
__device__ __forceinline__ void scan_states(KP P) {
    const float* SLOC = P->SLOC; const float* DEC = P->DEC; bf16_t* SPREV = P->SPREV;
    const int tid = tid_();
    for (int e = bid_() * NTHR + tid; e < 16 * 16384; e += gridDim.x * NTHR) {
        const int bh = e >> 14, vk = e & 16383, k = vk & 127;
        float d[NCH - 1], x[NCH - 1];
#pragma unroll
        for (int c = 0; c < NCH - 1; ++c) { const int u = bh * NCH + c; d[c] = DEC[u * 128 + k]; x[c] = SLOC[(size_t)u * 16384 + vk]; }
        float S = 0.f;
#pragma unroll
        for (int c = 0; c < NCH - 1; ++c) { S = fmaf(d[c], S, x[c]); SPREV[(size_t)(bh * NCH + c + 1) * 16384 + vk] = f2bf(S); }
    }
}
__device__ __forceinline__ void outputs(KP P, char* lds, int layer) {
    bf16_t* Qt = (bf16_t*)lds; bf16_t* Qh = Qt + 64 * SK; bf16_t* Kt = Qh + 64 * SK; bf16_t* VT = Kt + 64 * SK; bf16_t* SpT = VT + 128 * SS;
    float* qsum = (float*)(SpT + 128 * SK); float* part = qsum + 512;
    const float* PA = P->PA; const float* lbtab = P->lbtab + layer * 512; const bf16_t* SPREV = P->SPREV; const float* nw = P->hnw + layer * 128; bf16_t* MIX = P->MIX;
    const int tid = tid_(), k = tid & 127, tq = tid >> 7, lane = tid & 63, wid = tid >> 6, r32 = lane & 31, hh = lane >> 5;
    for (int u = bid_(); u < NU; u += gridDim.x) {
        const int bh = u / NCH, c = u % NCH, b_ = bh >> 2, h = bh & 3; const size_t row0 = (size_t)b_ * LL + c * 64;
        float b[16], kk[16], bend, r;
        prep(PA, lbtab, row0, c, h, k, tq, qsum, b, kk, bend, r);
#pragma unroll
        for (int i = 0; i < 16; ++i) { const int t = 16 * tq + i; const bool valid = (c * 64 + t) < LL;
            const float q = valid ? PA[(row0 + t) * PAW + h * 128 + k] : 0.f;
            Qt[t * SK + k] = f2bf(q * __expf(b[i] - r)); Qh[t * SK + k] = f2bf(q * __expf(b[i])); Kt[t * SK + k] = f2bf(kk[i] * __expf(r - b[i])); }
        { float x[16];
#pragma unroll
          for (int i = 0; i < 16; ++i) { const int t = 16 * tq + i; x[i] = (c * 64 + t) < LL ? PA[(row0 + t) * PAW + 1024 + h * 128 + k] : 0.f; }
          store16(VT + k * SS + 16 * tq, x); }
        if (c > 0) {
#pragma unroll
            for (int j = 0; j < 4; ++j) { const int idx = tid + 512 * j, v = idx >> 4, ch = idx & 15;
                *(u32x4*)(SpT + v * SK + ch * 8) = *(const u32x4*)(SPREV + (size_t)u * 16384 + v * 128 + ch * 8); }
        }
        __syncthreads();
        const int tt = wid & 1, vt = wid >> 1;
        f32x16 oacc = {};
#pragma unroll
        for (int st = 0; st < 2; ++st) {
            if (st <= tt) {
                f32x16 sc = {};
#pragma unroll
                for (int d0 = 0; d0 < 8; ++d0) {
                    const bf16x8 a = *(const bf16x8*)(Kt + (st * 32 + r32) * SK + d0 * 16 + hh * 8);
                    const bf16x8 bq = *(const bf16x8*)(Qt + (tt * 32 + r32) * SK + d0 * 16 + hh * 8);
                    sc = __builtin_amdgcn_mfma_f32_32x32x16_bf16(a, bq, sc, 0, 0, 0);
                }
                if (st == tt) {
#pragma unroll
                    for (int rg = 0; rg < 16; ++rg) sc[rg] = (crow(rg, hh) <= r32) ? sc[rg] : 0.f;
                }
#pragma unroll
                for (int g = 0; g < 2; ++g) {
                    u32x4 w; w.x = cvtpk(sc[8 * g + 0], sc[8 * g + 1]); w.y = cvtpk(sc[8 * g + 2], sc[8 * g + 3]); w.z = cvtpk(sc[8 * g + 4], sc[8 * g + 5]); w.w = cvtpk(sc[8 * g + 6], sc[8 * g + 7]);
                    const bf16x8 pb = *reinterpret_cast<bf16x8*>(&w);
                    const bf16_t* vp = VT + (vt * 32 + r32) * SS + st * 32 + 16 * g + 4 * hh;
                    const s16x4 lo = *(const s16x4*)vp, hi4 = *(const s16x4*)(vp + 8);
                    const bf16x8 a = (bf16x8){lo[0], lo[1], lo[2], lo[3], hi4[0], hi4[1], hi4[2], hi4[3]};
                    oacc = __builtin_amdgcn_mfma_f32_32x32x16_bf16(a, pb, oacc, 0, 0, 0);
                }
            }
        }
        if (c > 0) {
#pragma unroll
            for (int d0 = 0; d0 < 8; ++d0) {
                const bf16x8 a = *(const bf16x8*)(SpT + (vt * 32 + r32) * SK + d0 * 16 + hh * 8);
                const bf16x8 bq = *(const bf16x8*)(Qh + (tt * 32 + r32) * SK + d0 * 16 + hh * 8);
                oacc = __builtin_amdgcn_mfma_f32_32x32x16_bf16(a, bq, oacc, 0, 0, 0);
            }
        }
        float ss = 0.f;
#pragma unroll
        for (int rg = 0; rg < 16; ++rg) ss = fmaf(oacc[rg], oacc[rg], ss);
        { auto rr = __builtin_amdgcn_permlane32_swap(__float_as_uint(ss), __float_as_uint(ss), false, false); ss = __uint_as_float(rr[0]) + __uint_as_float(rr[1]); }
        if (hh == 0) part[vt * 64 + tt * 32 + r32] = ss;
        __syncthreads();
        const int t = tt * 32 + r32;
        const float tot = (part[t] + part[64 + t]) + (part[128 + t] + part[192 + t]);
        const float scale = rsqrtf(tot * (1.f / 128.f) + EPS);
        if ((c * 64 + t) < LL) {
            const float* gp = PA + (row0 + t) * PAW + 1536 + h * 128 + vt * 32;
            bf16_t* op = MIX + (row0 + t) * DM + h * 128 + vt * 32;
#pragma unroll
            for (int g4 = 0; g4 < 4; ++g4) {
                const int v0 = 8 * g4 + 4 * hh;
                const float4 gv = *(const float4*)(gp + v0); const float4 wv = *(const float4*)(nw + vt * 32 + v0);
                const float y0 = oacc[4 * g4 + 0] * scale * wv.x * gv.x / (1.f + __expf(-gv.x)), y1 = oacc[4 * g4 + 1] * scale * wv.y * gv.y / (1.f + __expf(-gv.y));
                const float y2 = oacc[4 * g4 + 2] * scale * wv.z * gv.z / (1.f + __expf(-gv.z)), y3 = oacc[4 * g4 + 3] * scale * wv.w * gv.w / (1.f + __expf(-gv.w));
                uint2 w; w.x = cvtpk(y0, y1); w.y = cvtpk(y2, y3);
                *(uint2*)(op + v0) = w;
            }
        }
        __syncthreads();
    }
}
}


namespace moe {
using bf16x8 = __attribute__((ext_vector_type(8))) short;
using f32x16 = __attribute__((ext_vector_type(16))) float;
using u32x4  = __attribute__((ext_vector_type(4))) unsigned;
constexpr int TW = 5, PROWS = 64 * TW, XS = 144, XBUF = PROWS * XS;
__device__ __forceinline__ unsigned cvtpk(float lo, float hi) { unsigned r; asm volatile("v_cvt_pk_bf16_f32 %0, %1, %2" : "=v"(r) : "v"(lo), "v"(hi)); return r; }
#define MOE_BAR() asm volatile("s_waitcnt lgkmcnt(0)\n\ts_barrier" ::: "memory")
constexpr int WD = 2;
constexpr int ABUF = 4 * 4 * 1024, AOFF = 2 * XBUF, LOFF = AOFF + 2 * ABUF;
template <bool UP>
__device__ __forceinline__ void stream_gemm(KP P, char* lds, int layer) {
    constexpr int KTOT = UP ? DM : DE, NSLAB = KTOT / 64, NCP = UP ? 2 : 4, LDW = UP ? DE : DM;
    static_assert(NSLAB % WD == 0 && NSLAB >= 2 * WD, "slab loop is unrolled by WD");
    const int tid = tid_(), lane = tid & 63, wid = tid >> 6, r32 = lane & 31, hh = lane >> 5, cg = wid & 3, th = wid >> 2;
    const int* cnt_ = P->cnt;
    const bf16_t* X = UP ? P->HN : P->H;
    int* basel = (int*)(lds + LOFF); int* tlist = basel + 64;
    for (int ub = bid_(); ub < 256; ub += gridDim.x) {
        const int u = ((ub & 7) << 5) | (ub >> 3);
        const int e = u >> 2, ns = u & 3;
        const int rot = (u * 11) & (NSLAB - 1);
        __syncthreads();
        if (tid < 64) { const int c = cnt_[tid]; int inc = c;
#pragma unroll
            for (int o = 1; o < 64; o <<= 1) { const int v = __shfl_up(inc, o); if (lane >= o) inc += v; }
            basel[tid] = inc - c; }
        __syncthreads();
        const int cnt = cnt_[e], row0 = basel[e];
        for (int pass0 = 0; pass0 < cnt; pass0 += PROWS) {
            const int cntp = (cnt - pass0) < PROWS ? (cnt - pass0) : PROWS;
            if constexpr (UP) { if (cnt <= ECAP) {
                __syncthreads();
                if (tid < PROWS && pass0 + tid < cnt) tlist[tid] = P->elist[e * ECAP + pass0 + tid];
                __syncthreads();
              } else {
                __syncthreads();
                const int* ridx = P->ridx; const int* rslot = P->rslot;
#pragma unroll 1
                for (int i0 = tid; i0 < NASSIGN; i0 += NTHR * 8) {
                    int ex[8], sl[8];
#pragma unroll
                    for (int q = 0; q < 8; ++q) { const int i = i0 + NTHR * q; ex[q] = i < NASSIGN ? ridx[i] : -1; sl[q] = i < NASSIGN ? rslot[i] : 0; }
#pragma unroll
                    for (int q = 0; q < 8; ++q) { const int sp = sl[q] - pass0; if (ex[q] == e && sp >= 0 && sp < PROWS) tlist[sp] = (i0 + NTHR * q) >> 1; }
                }
                __syncthreads();
            } }
            int xoff[5];
#pragma unroll
            for (int j = 0; j < 5; ++j) { int rho = (tid >> 3) + 64 * j; rho = rho < cntp ? rho : cntp - 1; const int grow = row0 + pass0 + rho;
                xoff[j] = (UP ? tlist[rho] * DM : grow * DE) + (tid & 7) * 8; }
            char* const xw = lds + (tid >> 3) * XS + (tid & 7) * 16;
            char* const aw = lds + AOFF + (cg * 4 + 2 * th) * 1024 + lane * 16;
            const char* const ar = lds + AOFF + cg * 4 * 1024 + lane * 16;
#pragma unroll 1
            for (int cp = 0; cp < NCP; ++cp) {
                const int cgi = cp * 4 + cg;
                const int kkw = wid >> 1, half = wid & 1;
                const float* wp;
                if constexpr (UP) wp = (r32 < 16 ? P->w1 : P->w3) + ((size_t)(layer * NE + e) * DM + kkw * 16 + 8 * hh + 4 * half) * DE + ns * 128 + cp * 64 + 4 * (r32 & 15);
                else wp = P->w2 + ((size_t)(layer * NE + e) * DE + 32 * hh + 2 * th) * DM + ns * 512 + cgi * 32 + r32;
                f32x16 acc[TW];
#pragma unroll
                for (int tl = 0; tl < TW; ++tl) acc[tl] = f32x16{};
                float wreg[WD][16]; u32x4 xs[5];
#define MOE_WLD1(wn_, R, li) do { if constexpr (UP) { if ((li) < 4) { const float4 t_ = *(const float4*)((wn_) + (size_t)(li) * DE); wreg[R][4 * (li)] = t_.x; wreg[R][4 * (li) + 1] = t_.y; wreg[R][4 * (li) + 2] = t_.z; wreg[R][4 * (li) + 3] = t_.w; } } \
                    else { if ((li) < 16) wreg[R][li] = (wn_)[(size_t)(((li) >> 3) + 4 * ((li) & 7)) * DM]; } } while (0)
#define MOE_WLOAD(slab, R) do { const float* wn_ = wp + (size_t)(((slab) + rot) & (NSLAB - 1)) * 64 * LDW; \
                    _Pragma("unroll") for (int li = 0; li < 16; ++li) MOE_WLD1(wn_, R, li); } while (0)
#define MOE_WPARK(R, PAR) do { if constexpr (UP) { _Pragma("unroll") for (int q = 0; q < 4; ++q) { uint2 fw; fw.x = cvtpk(wreg[R][q], wreg[R][4 + q]); fw.y = cvtpk(wreg[R][8 + q], wreg[R][12 + q]); \
                            *(uint2*)(lds + AOFF + (PAR) * ABUF + (q * 4 + kkw) * 1024 + lane * 16 + half * 8) = fw; } } \
                    else { _Pragma("unroll") for (int i = 0; i < 2; ++i) { u32x4 fw; fw.x = cvtpk(wreg[R][8 * i + 0], wreg[R][8 * i + 1]); fw.y = cvtpk(wreg[R][8 * i + 2], wreg[R][8 * i + 3]); \
                            fw.z = cvtpk(wreg[R][8 * i + 4], wreg[R][8 * i + 5]); fw.w = cvtpk(wreg[R][8 * i + 6], wreg[R][8 * i + 7]); *(u32x4*)(aw + (PAR) * ABUF + i * 1024) = fw; } } } while (0)
#pragma unroll
                for (int j = 0; j < 5; ++j) xs[j] = *(const u32x4*)(X + xoff[j] + (rot & (NSLAB - 1)) * 64);
                MOE_WLOAD(0, 0); MOE_WLOAD(1, 1);
#pragma unroll
                for (int j = 0; j < 5; ++j) *(u32x4*)(xw + 64 * j * XS) = xs[j];
                MOE_WPARK(0, 0); MOE_WLOAD(2, 0);
                MOE_BAR();
#define MOE_SLAB(s, PAR, R1) do { \
                    const int sx = ((s) + 1) < NSLAB ? (s) + 1 : NSLAB - 1, sw = ((s) + 1 + WD) < NSLAB ? (s) + 1 + WD : NSLAB - 1;     \
                    { const bf16_t* xn0_ = X + ((sx + rot) & (NSLAB - 1)) * 64; _Pragma("unroll") for (int j = 0; j < 5; ++j) xs[j] = *(const u32x4*)(xn0_ + xoff[j]); } \
                    MOE_WPARK(R1, 1 - (PAR)); \
                    const float* wn_ = wp + (size_t)((sw + rot) & (NSLAB - 1)) * 64 * LDW; \
                    const char* xb = lds + (PAR) * XBUF + (th * TW * 32 + r32) * XS + hh * 16; \
                    bf16x8 xq[4]; bf16x8 fq[2];                                                       \
                    xq[0] = *(const bf16x8*)(xb); xq[1] = *(const bf16x8*)(xb + 32 * XS); xq[2] = *(const bf16x8*)(xb + 64 * XS); \
                    fq[0] = *(const bf16x8*)(ar + (PAR) * ABUF); \
                    _Pragma("unroll") for (int kk = 0; kk < 4; ++kk) { \
                        if (kk < 3) fq[(kk + 1) & 1] = *(const bf16x8*)(ar + (PAR) * ABUF + (kk + 1) * 1024); \
                        _Pragma("unroll") for (int tl = 0; tl < TW; ++tl) { \
                            const int cur = kk * TW + tl, nx = cur + 3, nkk = nx / TW, ntl = nx % TW;       \
                            if (nx < 4 * TW) xq[nx & 3] = *(const bf16x8*)(xb + ntl * 32 * XS + nkk * 32); \
                            acc[tl] = __builtin_amdgcn_mfma_f32_32x32x16_bf16(fq[kk & 1], xq[cur & 3], acc[tl], 0, 0, 0); \
                            const int li = kk * TW + tl; \
                            MOE_WLD1(wn_, R1, li); \
                            __builtin_amdgcn_sched_barrier(0); } } \
                    _Pragma("unroll") for (int j = 0; j < 5; ++j) *(u32x4*)(xw + (1 - (PAR)) * XBUF + 64 * j * XS) = xs[j]; \
                    MOE_BAR(); } while (0)
#pragma unroll 1
                for (int s = 0; s < NSLAB; s += 2) { MOE_SLAB(s, 0, 1); MOE_SLAB(s + 1, 1, 0); }
#undef MOE_SLAB
#undef MOE_WLOAD
#undef MOE_WLD1
#undef MOE_WPARK
                const int T = (cntp + 31) >> 5;
                const int Tw = (T - TW * th) < 0 ? 0 : ((T - TW * th) > TW ? TW : (T - TW * th));
#pragma unroll
                for (int tl = 0; tl < TW; ++tl) if (tl < Tw) {
                    const int rho = (th * TW + tl) * 32 + r32;
                    if (rho < cntp) {
                        const size_t grow = (size_t)(row0 + pass0 + rho);
                        if constexpr (UP) {
                            bf16_t* hp = P->H + grow * DE + ns * 128 + cgi * 16 + 4 * hh;
#pragma unroll
                            for (int g = 0; g < 2; ++g) {
                                float y[4];
#pragma unroll
                                for (int q = 0; q < 4; ++q) { const float a = acc[tl][4 * g + q], b = acc[tl][8 + 4 * g + q]; y[q] = a / (1.f + __expf(-a)) * b; }
                                uint2 w; w.x = cvtpk(y[0], y[1]); w.y = cvtpk(y[2], y[3]);
                                *(uint2*)(hp + 8 * g) = w;
                            }
                        } else {
                            bf16_t* yp = P->Y + grow * DM + ns * 512 + cgi * 32 + 4 * hh;
#pragma unroll
                            for (int g = 0; g < 4; ++g) {
                                uint2 w; w.x = cvtpk(acc[tl][4 * g + 0], acc[tl][4 * g + 1]); w.y = cvtpk(acc[tl][4 * g + 2], acc[tl][4 * g + 3]);
                                *(uint2*)(yp + 8 * g) = w;
                            }
                        }
                    }
                }
            }
        }
    }
}
#undef MOE_BAR
}


namespace s5 {
using bf16x8 = __attribute__((ext_vector_type(8))) short;
using f32x16 = __attribute__((ext_vector_type(16))) float;
using u32x4  = __attribute__((ext_vector_type(4))) unsigned;
constexpr int NCHK = 516, NMT = 17;
__device__ __forceinline__ unsigned cvtpk(float lo, float hi) { unsigned r; asm volatile("v_cvt_pk_bf16_f32 %0, %1, %2" : "=v"(r) : "v"(lo), "v"(hi)); return r; }
__device__ __forceinline__ bf16x8 ld8f(const float* p) {
    const float4 a = *(const float4*)p, b = *(const float4*)(p + 4);
    u32x4 w; w.x = cvtpk(a.x, a.y); w.y = cvtpk(a.z, a.w); w.z = cvtpk(b.x, b.y); w.w = cvtpk(b.z, b.w);
    return *reinterpret_cast<bf16x8*>(&w);
}
__device__ __forceinline__ void prep_unit(KP P, char* lds, int layer, int g) {
    float2* pw = (float2*)lds; float2* bb = pw + 17 * 64; float2* cc = bb + 1024; float* kd = (float*)(cc + 1024);
    const int tid = tid_();
    const float dt = expf(P->log_dt[layer * 32 + g]);
    const float* a_re = P->a_re + (layer * 32 + g) * 64; const float* a_im = P->a_im + (layer * 32 + g) * 64;
    for (int idx = tid; idx < 17 * 64; idx += NTHR) { const int d = idx >> 6, p = idx & 63;
        const float mag = expf(a_re[p] * dt * (float)d), ang = a_im[p] * dt * (float)d; pw[idx] = make_float2(mag * cosf(ang), mag * sinf(ang)); }
    for (int idx = tid; idx < 1024; idx += NTHR) {
        { const int p = idx >> 4, c = idx & 15; const float are = a_re[p], aim = a_im[p];
          const float mag = expf(are * dt), abr = mag * cosf(aim * dt), abi = mag * sinf(aim * dt), den = are * are + aim * aim;
          const float zr = ((abr - 1.f) * are + abi * aim) / den, zi = (abi * are - (abr - 1.f) * aim) / den;
          const float br = P->b_re[((layer * 32 + g) * 64 + p) * 16 + c], bi = P->b_im[((layer * 32 + g) * 64 + p) * 16 + c];
          bb[idx] = make_float2(zr * br - zi * bi, zr * bi + zi * br); }
        { const int c = idx >> 6, p = idx & 63; cc[idx] = make_float2(P->c_re[((layer * 32 + g) * 16 + c) * 64 + p], P->c_im[((layer * 32 + g) * 16 + c) * 64 + p]); }
    }
    __syncthreads();
    if (tid < 64) ((float2*)P->A16)[(layer * 32 + g) * 64 + tid] = pw[16 * 64 + tid];
    for (int idx = tid; idx < 4096; idx += NTHR) { const int d = idx >> 8, c = (idx >> 4) & 15, c2 = idx & 15;
        float acc = 0.f;
        for (int p = 0; p < 64; ++p) { const float2 C = cc[c * 64 + p], W = pw[d * 64 + p], B = bb[p * 16 + c2];
            const float xr = C.x * W.x - C.y * W.y, xi = C.x * W.y + C.y * W.x; acc += xr * B.x - xi * B.y; }
        if (d == 0 && c == c2) acc += P->s5d[layer * 512 + g * 16 + c];
        kd[idx] = acc; }
    __syncthreads();
    bf16_t* BtY = P->BtY + (size_t)(layer * 32 + g) * 256 * 384; bf16_t* BtE = P->BtE + (size_t)(layer * 32 + g) * 128 * 256;
    for (int idx = tid; idx < 256 * 48; idx += NTHR) { const int n = idx / 48, ch = idx % 48, t = n >> 4, c = n & 15;
        float v[8];
        if (ch < 32) { const int s = ch >> 1, c0 = (ch & 1) * 8;
#pragma unroll
            for (int jj = 0; jj < 8; ++jj) v[jj] = (s <= t) ? kd[((t - s) * 16 + c) * 16 + c0 + jj] : 0.f;
        } else {
#pragma unroll
            for (int jj = 0; jj < 8; ++jj) { const int kq = (ch - 32) * 8 + jj, p = kq >> 1; const float2 C = cc[c * 64 + p], W = pw[(t + 1) * 64 + p];
                v[jj] = (kq & 1) ? -(C.x * W.y + C.y * W.x) : (C.x * W.x - C.y * W.y); }
        }
        u32x4 w; w.x = cvtpk(v[0], v[1]); w.y = cvtpk(v[2], v[3]); w.z = cvtpk(v[4], v[5]); w.w = cvtpk(v[6], v[7]);
        *(u32x4*)(BtY + (size_t)n * 384 + ch * 8) = w; }
    for (int idx = tid; idx < 128 * 32; idx += NTHR) { const int n = idx >> 5, ch = idx & 31, p = n >> 1, s = ch >> 1, c0 = (ch & 1) * 8;
        const float2 W = pw[(15 - s) * 64 + p];
        float v[8];
#pragma unroll
        for (int jj = 0; jj < 8; ++jj) { const float2 B = bb[p * 16 + c0 + jj]; v[jj] = (n & 1) ? (W.x * B.y + W.y * B.x) : (W.x * B.x - W.y * B.y); }
        u32x4 w; w.x = cvtpk(v[0], v[1]); w.y = cvtpk(v[2], v[3]); w.z = cvtpk(v[4], v[5]); w.w = cvtpk(v[6], v[7]);
        *(u32x4*)(BtE + (size_t)n * 256 + ch * 8) = w; }
    __syncthreads();
}
__device__ __forceinline__ void local_states(KP P, int layer) {
    const int tid = tid_(), lane = tid & 63, r32 = lane & 31, hh = lane >> 5, gw = bid_() * 8 + (tid >> 6), NGW = gridDim.x * 8;
    const float* PA = P->PA; float* E = P->S5E;
    for (int wu = gw; wu < 32 * NMT; wu += NGW) {
        const int g = wu / NMT, mt = wu % NMT, m = mt * 32 + r32, mc = m < NCHK ? m : NCHK - 1;
        const bf16_t* Bt = P->BtE + ((size_t)(layer * 32 + g) * 128 + r32) * 256 + 8 * hh;
        const float* up = PA + (size_t)(mc * 16) * PAW + 2048 + g * 16 + 8 * hh;
        f32x16 acc[4];
#pragma unroll
        for (int nt = 0; nt < 4; ++nt) acc[nt] = f32x16{};
#pragma unroll 4
        for (int s = 0; s < 16; ++s) {
            const bf16x8 bf = ld8f(up + (size_t)s * PAW);
#pragma unroll
            for (int nt = 0; nt < 4; ++nt) { const bf16x8 af = *(const bf16x8*)(Bt + (size_t)nt * 32 * 256 + s * 16); acc[nt] = __builtin_amdgcn_mfma_f32_32x32x16_bf16(af, bf, acc[nt], 0, 0, 0); }
        }
        if (m < NCHK) { float* ep = E + ((size_t)m * 32 + g) * 128 + 4 * hh;
#pragma unroll
            for (int nt = 0; nt < 4; ++nt)
#pragma unroll
                for (int q = 0; q < 4; ++q) *(float4*)(ep + nt * 32 + 8 * q) = make_float4(acc[nt][4 * q], acc[nt][4 * q + 1], acc[nt][4 * q + 2], acc[nt][4 * q + 3]); }
    }
}
__device__ __forceinline__ void scan_states(KP P, int layer) {
    const int idx = bid_() * NTHR + tid_();
    if (idx >= 8192) return;
    const int b = idx >> 11, g = (idx >> 6) & 31, p = idx & 63;
    const float2 A = ((const float2*)P->A16)[(layer * 32 + g) * 64 + p];
    const float2* E = (const float2*)P->S5E; float2* XP = (float2*)P->S5X;
    float xr = 0.f, xi = 0.f;
    const size_t o0 = ((size_t)(b * 129) * 32 + g) * 64 + p;
    float2 e[16];
#pragma unroll
    for (int i = 0; i < 16; ++i) e[i] = E[o0 + (size_t)i * 2048];
#pragma unroll 1
    for (int jb = 0; jb < 129; jb += 16) {
        float2 en[16];
#pragma unroll
        for (int i = 0; i < 16; ++i) { const int j = jb + 16 + i; en[i] = (j < 129) ? E[o0 + (size_t)j * 2048] : make_float2(0.f, 0.f); }
#pragma unroll
        for (int i = 0; i < 16; ++i) { const int j = jb + i;
            if (j < 129) { XP[o0 + (size_t)j * 2048] = make_float2(xr, xi);
                const float nr = A.x * xr - A.y * xi + e[i].x, ni = A.x * xi + A.y * xr + e[i].y; xr = nr; xi = ni; } }
#pragma unroll
        for (int i = 0; i < 16; ++i) e[i] = en[i];
    }
}
__device__ __forceinline__ float gelu_t(float x) { const float u = 0.7978845608028654f * (x + 0.044715f * x * x * x); const float e = __expf(2.f * u); return x - x / (e + 1.f); }
__device__ __forceinline__ void outputs(KP P, int layer) {
    const int tid = tid_(), lane = tid & 63, r32 = lane & 31, hh = lane >> 5, gw = bid_() * 8 + (tid >> 6), NGW = gridDim.x * 8;
    const float* PA = P->PA; const float* XP = P->S5X; bf16_t* YG = P->YG;
    for (int wu = gw; wu < 32 * NMT; wu += NGW) {
        const int g = wu / NMT, mt = wu % NMT, m = mt * 32 + r32, mc = m < NCHK ? m : NCHK - 1;
        const bf16_t* Bt = P->BtY + ((size_t)(layer * 32 + g) * 256 + r32) * 384 + 8 * hh;
        const float* up = PA + (size_t)(mc * 16) * PAW + 2048 + g * 16 + 8 * hh;
        const float* xp = XP + ((size_t)mc * 32 + g) * 128 + 8 * hh;
        f32x16 acc[8];
#pragma unroll
        for (int nt = 0; nt < 8; ++nt) acc[nt] = f32x16{};
#pragma unroll
        for (int s = 0; s < 16; ++s) {
            const bf16x8 bf = ld8f(up + (size_t)s * PAW);
#pragma unroll
            for (int nt = 0; nt < 8; ++nt) if (2 * nt + 1 >= s) { const bf16x8 af = *(const bf16x8*)(Bt + (size_t)nt * 32 * 384 + s * 16); acc[nt] = __builtin_amdgcn_mfma_f32_32x32x16_bf16(af, bf, acc[nt], 0, 0, 0); }
        }
#pragma unroll
        for (int ks = 0; ks < 8; ++ks) {
            const bf16x8 bf = ld8f(xp + ks * 16);
#pragma unroll
            for (int nt = 0; nt < 8; ++nt) { const bf16x8 af = *(const bf16x8*)(Bt + (size_t)nt * 32 * 384 + 256 + ks * 16); acc[nt] = __builtin_amdgcn_mfma_f32_32x32x16_bf16(af, bf, acc[nt], 0, 0, 0); }
        }
        if (m < NCHK) {
#pragma unroll
            for (int nt = 0; nt < 8; ++nt)
#pragma unroll
                for (int q = 0; q < 4; ++q) { const int t = 2 * nt + (q >> 1);
                    uint2 w; w.x = cvtpk(gelu_t(acc[nt][4 * q]), gelu_t(acc[nt][4 * q + 1])); w.y = cvtpk(gelu_t(acc[nt][4 * q + 2]), gelu_t(acc[nt][4 * q + 3]));
                    *(uint2*)(YG + (size_t)(m * 16 + t) * 512 + g * 16 + 8 * (q & 1) + 4 * hh) = w; }
        }
    }
}
__device__ __forceinline__ void fused_unit(KP P, char* lds, int layer, int b, int g) {
    const int tid = tid_(), lane = tid & 63, wid = tid >> 6, r32 = lane & 31, hh = lane >> 5;
    float* El = (float*)lds;
    const float* PA = P->PA; bf16_t* YG = P->YG;
    const int ml = wid * 32 + r32, mc = b * 129 + (ml < 129 ? ml : 128);
    const float* up = PA + (size_t)(mc * 16) * PAW + 2048 + g * 16 + 8 * hh;
    if (wid < 5) {
        const bf16_t* Bt = P->BtE + ((size_t)(layer * 32 + g) * 128 + r32) * 256 + 8 * hh;
        f32x16 acc[4];
#pragma unroll
        for (int nt = 0; nt < 4; ++nt) acc[nt] = f32x16{};
#pragma unroll 4
        for (int s = 0; s < 16; ++s) {
            const bf16x8 bf = ld8f(up + (size_t)s * PAW);
#pragma unroll
            for (int nt = 0; nt < 4; ++nt) { const bf16x8 af = *(const bf16x8*)(Bt + (size_t)nt * 32 * 256 + s * 16); acc[nt] = __builtin_amdgcn_mfma_f32_32x32x16_bf16(af, bf, acc[nt], 0, 0, 0); }
        }
        float* ep = El + ml * 128 + 4 * hh;
#pragma unroll
        for (int nt = 0; nt < 4; ++nt)
#pragma unroll
            for (int q = 0; q < 4; ++q) *(float4*)(ep + nt * 32 + 8 * q) = make_float4(acc[nt][4 * q], acc[nt][4 * q + 1], acc[nt][4 * q + 2], acc[nt][4 * q + 3]);
    }
    __syncthreads();
    if (tid < 64) {
        const float2 A = ((const float2*)P->A16)[(layer * 32 + g) * 64 + tid];
        float2* e2 = (float2*)El + tid;
        float xr = 0.f, xi = 0.f;
#pragma unroll 4
        for (int j = 0; j < 129; ++j) { const float2 e = e2[j * 64]; e2[j * 64] = make_float2(xr, xi);
            const float nr = A.x * xr - A.y * xi + e.x, ni = A.x * xi + A.y * xr + e.y; xr = nr; xi = ni; }
    }
    __syncthreads();
    if (wid < 5) {
        const bf16_t* Bt = P->BtY + ((size_t)(layer * 32 + g) * 256 + r32) * 384 + 8 * hh;
        const float* xp = El + (ml < 129 ? ml : 128) * 128 + 8 * hh;
        f32x16 acc[8];
#pragma unroll
        for (int nt = 0; nt < 8; ++nt) acc[nt] = f32x16{};
#pragma unroll
        for (int s = 0; s < 16; ++s) {
            const bf16x8 bf = ld8f(up + (size_t)s * PAW);
#pragma unroll
            for (int nt = 0; nt < 8; ++nt) if (2 * nt + 1 >= s) { const bf16x8 af = *(const bf16x8*)(Bt + (size_t)nt * 32 * 384 + s * 16); acc[nt] = __builtin_amdgcn_mfma_f32_32x32x16_bf16(af, bf, acc[nt], 0, 0, 0); }
        }
#pragma unroll
        for (int ks = 0; ks < 8; ++ks) {
            const bf16x8 bf = ld8f(xp + ks * 16);
#pragma unroll
            for (int nt = 0; nt < 8; ++nt) { const bf16x8 af = *(const bf16x8*)(Bt + (size_t)nt * 32 * 384 + 256 + ks * 16); acc[nt] = __builtin_amdgcn_mfma_f32_32x32x16_bf16(af, bf, acc[nt], 0, 0, 0); }
        }
        if (ml < 129) { const int m = b * 129 + ml;
#pragma unroll
            for (int nt = 0; nt < 8; ++nt)
#pragma unroll
                for (int q = 0; q < 4; ++q) { const int t = 2 * nt + (q >> 1);
                    uint2 w; w.x = cvtpk(gelu_t(acc[nt][4 * q]), gelu_t(acc[nt][4 * q + 1])); w.y = cvtpk(gelu_t(acc[nt][4 * q + 2]), gelu_t(acc[nt][4 * q + 3]));
                    *(uint2*)(YG + (size_t)(m * 16 + t) * 512 + g * 16 + 8 * (q & 1) + 4 * hh) = w; }
        }
    }
    __syncthreads();
}
}

__device__ __forceinline__ float wave_sum(float v) {
#pragma unroll
    for (int o = 32; o > 0; o >>= 1) v += __shfl_xor(v, o);
    return v;
}
__device__ __forceinline__ unsigned cvtpk_(float lo, float hi) { unsigned r; asm volatile("v_cvt_pk_bf16_f32 %0, %1, %2" : "=v"(r) : "v"(lo), "v"(hi)); return r; }
__device__ __forceinline__ void ph_attn_out(KP P, int layer, int cu0) {
    const int tid = tid_(), lane = tid & 63, gw = (bid_() - cu0) * 8 + (tid >> 6), NGW = (gridDim.x - cu0) * 8;
    if (gw < 0) return;
    const float scale = 1.f - (0.8f - 0.6f * expf(-0.3f * (float)layer));
    const float lam = P->lam[layer];
    const float4 sw = ((const float4*)(P->subln + layer * 256))[lane];
    const float* OC = P->OC; bf16_t* MIX = P->MIX;
    for (int it0 = gw; it0 < TOK * 4; it0 += NGW * 4) {
        float4 a[4], b[4];
#pragma unroll
        for (int q = 0; q < 4; ++q) { const int it = it0 + NGW * q, itc = it < TOK * 4 ? it : TOK * 4 - 1, r = itc >> 2, h = itc & 3;
            a[q] = *(const float4*)(OC + (size_t)r * DM + h * 512 + lane * 4); b[q] = *(const float4*)(OC + (size_t)r * DM + h * 512 + 256 + lane * 4); }
#pragma unroll
        for (int q = 0; q < 4; ++q) { const int it = it0 + NGW * q; if (it < TOK * 4) { const int r = it >> 2, h = it & 3;
            const float o0 = a[q].x - lam * b[q].x, o1 = a[q].y - lam * b[q].y, o2 = a[q].z - lam * b[q].z, o3 = a[q].w - lam * b[q].w;
            const float ss = wave_sum(o0 * o0 + o1 * o1 + o2 * o2 + o3 * o3);
            const float rs = rsqrtf(ss * (1.f / 256.f) + EPS) * scale;
            uint2 w; w.x = cvtpk_(o0 * rs * sw.x, o1 * rs * sw.y); w.y = cvtpk_(o2 * rs * sw.z, o3 * rs * sw.w);
            *(uint2*)(MIX + (size_t)r * DM + 1024 + h * 256 + lane * 4) = w; } }
    }
}
__device__ __forceinline__ void ph_build_norm(KP P) {
    const int tid = tid_(), lane = tid & 63, gw = bid_() * 8 + (tid >> 6), NGW = gridDim.x * 8;
    for (int r = gw; r < MP; r += NGW) {
        float4 v[8];
        if (r < TOK) { const int b = r / LL, t = r % LL;
            const float4* src = (const float4*)(t < NMETA ? P->meta + (size_t)t * DM : P->x + ((size_t)b * SEQ + (t - NMETA)) * DM);
#pragma unroll
            for (int j = 0; j < 8; ++j) v[j] = src[lane + 64 * j];
        } else {
#pragma unroll
            for (int j = 0; j < 8; ++j) v[j] = make_float4(0.f, 0.f, 0.f, 0.f);
        }
        float ss = 0.f;
#pragma unroll
        for (int j = 0; j < 8; ++j) { ((float4*)(P->Z + (size_t)r * DM))[lane + 64 * j] = v[j]; ss += v[j].x * v[j].x + v[j].y * v[j].y + v[j].z * v[j].z + v[j].w * v[j].w; }
        const float rs = rsqrtf(wave_sum(ss) * (1.f / DM) + EPS);
#pragma unroll
        for (int j = 0; j < 8; ++j) { const float4 w = ((const float4*)P->ln1_w)[lane + 64 * j];
            uint2 o; o.x = cvtpk_(v[j].x * rs * w.x, v[j].y * rs * w.y); o.y = cvtpk_(v[j].z * rs * w.z, v[j].w * rs * w.w);
            ((uint2*)(P->HN + (size_t)r * DM))[lane + 64 * j] = o; }
    }
}
__device__ __forceinline__ void ph_prep(KP P) {
    const int tid = tid_();
    if (bid_() == 0) {
        const int c = tid;
        const float l0 = P->lbnd[c], l1 = P->lbnd[512 + c], m = fmaxf(l0, l1), e0 = expf(l0 - m), e1 = expf(l1 - m);
        P->lbtab[c] = 0.f; P->lbtab[512 + c] = e1 / (e0 + e1);
        if (c < 2) {
            float s1 = 0.f, s2 = 0.f;
            for (int i = 0; i < 128; ++i) { s1 += P->lq1[c * 128 + i] * P->lk1[c * 128 + i]; s2 += P->lq2[c * 128 + i] * P->lk2[c * 128 + i]; }
            const float li = 0.8f - 0.6f * expf(-0.3f * (float)c);
            P->lam[c] = expf(s1) - expf(s2) + li;
        }
    }
    for (int i = bid_() * NTHR + tid; i < 2 * 96 * DM; i += gridDim.x * NTHR) {
        const int layer = i / (96 * DM), jc = (i / DM) % 96, k = i % DM;
        float v = 0.f;
        if (jc < 8) v = P->wrg[((size_t)layer * DM + k) * 8 + jc]; else if (jc < 72) v = P->wre[((size_t)layer * DM + k) * 64 + jc - 8];
        v *= P->ln2_w[layer * DM + k];
        const bf16_t hi = f2bf(v), lo = f2bf(v - bf2f(hi));
        P->WRT[((size_t)(layer * 2 + 0) * 96 + jc) * DM + k] = hi; P->WRT[((size_t)(layer * 2 + 1) * 96 + jc) * DM + k] = lo;
    }
}
namespace rt {
using f32x16 = __attribute__((ext_vector_type(16))) float;
using bf16x8 = __attribute__((ext_vector_type(8))) short;
using u32x4  = __attribute__((ext_vector_type(4))) unsigned;
__device__ __forceinline__ void norm_router(KP P, char* lds, int layer) {
    const int tid = tid_(), lane = tid & 63, wid = tid >> 6, r32 = lane & 31, hh = lane >> 5;
    float* part = (float*)lds;
    float* ssqp = (float*)(lds + 98304);
    float* lg = ssqp + 256;
    float* rsv = lg + 32 * 97;
    const bf16_t* Whi = P->WRT + (size_t)(layer * 2 + 0) * 96 * DM; const bf16_t* Wlo = P->WRT + (size_t)(layer * 2 + 1) * 96 * DM;
    const float* Z = P->Z;
    for (int u = bid_(); u < TOK / 32; u += gridDim.x) {
        const int tok0 = u * 32, kb = wid * 256;
        if (false) {
            float* Zw = P->Z; const float* ZP = P->ZP;
            for (int i = tid; i < 32 * DM / 4; i += NTHR) { const int r = i / (DM / 4), c4 = i % (DM / 4);
                float4 z = ((const float4*)(Zw + (size_t)(tok0 + r) * DM))[c4];
#pragma unroll
                for (int ks = 0; ks < 8; ++ks) { const float4 p4 = ((const float4*)(ZP + ((size_t)ks * 256 + (tok0 - 8192 + r)) * DM))[c4]; z.x += p4.x; z.y += p4.y; z.z += p4.z; z.w += p4.w; }
                ((float4*)(Zw + (size_t)(tok0 + r) * DM))[c4] = z; }
            asm volatile("s_waitcnt vmcnt(0)" ::: "memory");
            __syncthreads();
        }
        f32x16 acc[3] = {f32x16{}, f32x16{}, f32x16{}};
        float sq = 0.f;
        const float* zp = Z + (size_t)(tok0 + r32) * DM + kb + 8 * hh;
        const bf16_t* wh = Whi + (size_t)r32 * DM + kb + 8 * hh; const bf16_t* wl = Wlo + (size_t)r32 * DM + kb + 8 * hh;
#pragma unroll 4
        for (int ks = 0; ks < 16; ++ks) {
            const float4 z0 = *(const float4*)(zp + ks * 16), z1 = *(const float4*)(zp + ks * 16 + 4);
            sq += (z0.x * z0.x + z0.y * z0.y + z0.z * z0.z + z0.w * z0.w) + (z1.x * z1.x + z1.y * z1.y + z1.z * z1.z + z1.w * z1.w);
            u32x4 h; h.x = cvtpk_(z0.x, z0.y); h.y = cvtpk_(z0.z, z0.w); h.z = cvtpk_(z1.x, z1.y); h.w = cvtpk_(z1.z, z1.w);
            u32x4 l; l.x = cvtpk_(z0.x - __uint_as_float(h.x << 16), z0.y - __uint_as_float(h.x & 0xffff0000u)); l.y = cvtpk_(z0.z - __uint_as_float(h.y << 16), z0.w - __uint_as_float(h.y & 0xffff0000u));
            l.z = cvtpk_(z1.x - __uint_as_float(h.z << 16), z1.y - __uint_as_float(h.z & 0xffff0000u)); l.w = cvtpk_(z1.z - __uint_as_float(h.w << 16), z1.w - __uint_as_float(h.w & 0xffff0000u));
            const bf16x8 zh = *reinterpret_cast<bf16x8*>(&h), zl = *reinterpret_cast<bf16x8*>(&l);
#pragma unroll
            for (int ct = 0; ct < 3; ++ct) {
                const bf16x8 ah = *(const bf16x8*)(wh + (size_t)ct * 32 * DM + ks * 16), al = *(const bf16x8*)(wl + (size_t)ct * 32 * DM + ks * 16);
                acc[ct] = __builtin_amdgcn_mfma_f32_32x32x16_bf16(ah, zh, acc[ct], 0, 0, 0);
                acc[ct] = __builtin_amdgcn_mfma_f32_32x32x16_bf16(ah, zl, acc[ct], 0, 0, 0);
                acc[ct] = __builtin_amdgcn_mfma_f32_32x32x16_bf16(al, zh, acc[ct], 0, 0, 0);
            }
        }
        { auto rr = __builtin_amdgcn_permlane32_swap(__float_as_uint(sq), __float_as_uint(sq), false, false); sq = __uint_as_float(rr[0]) + __uint_as_float(rr[1]); }
        if (hh == 0) ssqp[wid * 32 + r32] = sq;
#pragma unroll
        for (int ct = 0; ct < 3; ++ct)
#pragma unroll
            for (int rg = 0; rg < 16; ++rg) part[((wid * 3 + ct) * 16 + rg) * 64 + lane] = acc[ct][rg];
        __syncthreads();
        if (tid < 32) { float t = 0.f;
#pragma unroll
            for (int w = 0; w < 8; ++w) t += ssqp[w * 32 + tid];
            rsv[tid] = rsqrtf(t * (1.f / DM) + EPS); }
#pragma unroll
        for (int q = 0; q < 6; ++q) { const int o = tid + NTHR * q, col = o >> 5, tok = o & 31, ct = col >> 5, cl = col & 31, h2 = (cl >> 2) & 1, rg = (cl & 3) + 4 * (cl >> 3);
            float t = 0.f;
#pragma unroll
            for (int w = 0; w < 8; ++w) t += part[((w * 3 + ct) * 16 + rg) * 64 + h2 * 32 + tok];
            lg[tok * 97 + col] = t; }
        __syncthreads();
        if (tid < 32) {
            const int t = tok0 + tid; const float rs = rsv[tid]; const float* l = lg + tid * 97;
            const float* brg = P->brg + layer * 8; const float* bre = P->bre + layer * 64;
            float gl[8];
#pragma unroll
            for (int j = 0; j < 8; ++j) gl[j] = l[j] * rs + brg[j];
            int gs = 0; float gm = gl[0];
#pragma unroll
            for (int j = 1; j < 8; ++j) if (gl[j] > gm) { gm = gl[j]; gs = j; }
            float den = 0.f;
#pragma unroll
            for (int j = 0; j < 8; ++j) den += expf(gl[j] - gm);
            const float pg = 1.f / den;
            float el[8];
#pragma unroll
            for (int j = 0; j < 8; ++j) el[j] = l[8 + gs * 8 + j] * rs + bre[gs * 8 + j];
            int j0 = 0; float v0 = el[0];
#pragma unroll
            for (int j = 1; j < 8; ++j) if (el[j] > v0) { v0 = el[j]; j0 = j; }
            int j1 = -1; float v1 = -INFINITY;
#pragma unroll
            for (int j = 0; j < 8; ++j) if (j != j0 && el[j] > v1) { v1 = el[j]; j1 = j; }
            const float e1 = expf(v1 - v0), g0 = pg / (1.f + e1), g1 = pg * e1 / (1.f + e1);
            const int x0 = gs * 8 + j0, x1 = gs * 8 + j1;
            P->ridx[t * 2] = x0; P->ridx[t * 2 + 1] = x1; P->rgate[t * 2] = g0; P->rgate[t * 2 + 1] = g1;
            const int s0 = atomicAdd(&P->cnt[x0], 1), s1 = atomicAdd(&P->cnt[x1], 1);
            P->rslot[t * 2] = s0; P->rslot[t * 2 + 1] = s1;
            if (s0 < ECAP) P->elist[x0 * ECAP + s0] = t; if (s1 < ECAP) P->elist[x1 * ECAP + s1] = t;
        }
#pragma unroll 1
        for (int q = 0; q < 4; q += 2) { const int tk = wid * 4 + q; const float rs0 = rsv[tk], rs1 = rsv[tk + 1];
            const float4* zr = (const float4*)(Z + (size_t)(tok0 + tk) * DM); const float4* wl4 = (const float4*)(P->ln2_w + layer * DM);
            float4 za[8], zb[8];
#pragma unroll
            for (int j = 0; j < 8; ++j) { za[j] = zr[lane + 64 * j]; zb[j] = zr[DM / 4 + lane + 64 * j]; }
#pragma unroll
            for (int j = 0; j < 8; ++j) { const float4 w = wl4[lane + 64 * j];
                uint2 o; o.x = cvtpk_(za[j].x * rs0 * w.x, za[j].y * rs0 * w.y); o.y = cvtpk_(za[j].z * rs0 * w.z, za[j].w * rs0 * w.w);
                ((uint2*)(P->HN + (size_t)(tok0 + tk) * DM))[lane + 64 * j] = o;
                o.x = cvtpk_(zb[j].x * rs1 * w.x, zb[j].y * rs1 * w.y); o.y = cvtpk_(zb[j].z * rs1 * w.z, zb[j].w * rs1 * w.w);
                ((uint2*)(P->HN + (size_t)(tok0 + tk + 1) * DM))[lane + 64 * j] = o; } }
        __syncthreads();
    }
}
}
__device__ __forceinline__ void ph_combine_norm(KP P, char* lds, int layer) {
    int* base = (int*)lds;
    const int tid = tid_(), lane = tid & 63, gw = bid_() * 8 + (tid >> 6), NGW = gridDim.x * 8;
    if (tid < 64) { const int c = P->cnt[tid]; int inc = c;
#pragma unroll
        for (int o = 1; o < 64; o <<= 1) { const int v = __shfl_up(inc, o); if (lane >= o) inc += v; }
        base[tid] = inc - c; }
    __syncthreads();
    for (int t0 = gw; t0 < TOK; t0 += 2 * NGW) {
        int r0[2], r1[2]; float g0[2], g1[2]; bool ok[2];
#pragma unroll
        for (int q = 0; q < 2; ++q) { const int t = t0 + q * NGW; ok[q] = t < TOK; const int tc = ok[q] ? t : t0;
            const int2 ex = ((const int2*)P->ridx)[tc], sl = ((const int2*)P->rslot)[tc]; const float2 gg = ((const float2*)P->rgate)[tc];
            r0[q] = base[ex.x] + sl.x; r1[q] = base[ex.y] + sl.y; g0[q] = gg.x; g1[q] = gg.y; }
        float4 v[2][8]; uint2 ya[2][8], yb[2][8];
#pragma unroll
        for (int q = 0; q < 2; ++q) { const int t = ok[q] ? t0 + q * NGW : t0;
#pragma unroll
            for (int j = 0; j < 8; ++j) { v[q][j] = ((const float4*)(P->Z + (size_t)t * DM))[lane + 64 * j];
                ya[q][j] = ((const uint2*)(P->Y + (size_t)r0[q] * DM))[lane + 64 * j]; yb[q][j] = ((const uint2*)(P->Y + (size_t)r1[q] * DM))[lane + 64 * j]; } }
#pragma unroll
        for (int q = 0; q < 2; ++q) if (ok[q]) { const int t = t0 + q * NGW;
            float ss = 0.f;
#pragma unroll
            for (int j = 0; j < 8; ++j) { const uint2 a = ya[q][j], b = yb[q][j]; float4& x = v[q][j];
                x.x += g0[q] * __uint_as_float(a.x << 16) + g1[q] * __uint_as_float(b.x << 16); x.y += g0[q] * __uint_as_float(a.x & 0xffff0000u) + g1[q] * __uint_as_float(b.x & 0xffff0000u);
                x.z += g0[q] * __uint_as_float(a.y << 16) + g1[q] * __uint_as_float(b.y << 16); x.w += g0[q] * __uint_as_float(a.y & 0xffff0000u) + g1[q] * __uint_as_float(b.y & 0xffff0000u);
                ss += x.x * x.x + x.y * x.y + x.z * x.z + x.w * x.w; }
            const float rs = rsqrtf(wave_sum(ss) * (1.f / DM) + EPS);
            if (layer == 0) {
#pragma unroll
                for (int j = 0; j < 8; ++j) { ((float4*)(P->Z + (size_t)t * DM))[lane + 64 * j] = v[q][j];
                    const float4 w = ((const float4*)(P->ln1_w + DM))[lane + 64 * j];
                    uint2 o; o.x = cvtpk_(v[q][j].x * rs * w.x, v[q][j].y * rs * w.y); o.y = cvtpk_(v[q][j].z * rs * w.z, v[q][j].w * rs * w.w);
                    ((uint2*)(P->HN + (size_t)t * DM))[lane + 64 * j] = o; }
            } else {
                const int b = t / LL, tt = t % LL;
                if (tt >= NMETA) {
#pragma unroll
                    for (int j = 0; j < 8; ++j) { const float4 w = ((const float4*)P->fnw)[lane + 64 * j];
                        ((float4*)(P->out + ((size_t)b * SEQ + (tt - NMETA)) * DM))[lane + 64 * j] = make_float4(v[q][j].x * rs * w.x, v[q][j].y * rs * w.y, v[q][j].z * rs * w.z, v[q][j].w * rs * w.w); }
                }
            }
        }
    }
    __syncthreads();
}

__global__ void __launch_bounds__(NTHR, 2) mega_fwd(Params P_arg) {
    extern __shared__ __attribute__((aligned(16))) char lds[];
    const int tid = tid_(), G = gridDim.x;
    volatile LAS unsigned* ctlw = (volatile LAS unsigned*)((LAS char*)lds + LDS_CTL);
    if (tid < 64) ctlw[tid] = 0u;
    __syncthreads();
    KP P = kp_();
    XcdBarrier bar = xcd_barrier_post(P->bar, ctlw + 8);
#define GRID_BAR() do { xcd_barrier(bar); P = kp_(); } while (0)

    ph_build_norm(P);
    ph_prep(P);
    ph_weights(P, lds);
    __syncthreads();
    for (int un = bid_(); un < 64; un += G) s5::prep_unit(P, lds, un >> 5, un & 31);
    GRID_BAR();
#pragma unroll
    for (int layer = 0; layer < 2; ++layer) {
        { pg8::Gemm g{P->HN, P->WinT + (size_t)layer * INW * DM, MP, INW, DM, DM}; pg8::StaticOrder S; S.init(MP, INW, G, bid_(), DM / 64); pg8::EpiInProj E{P->PA, P->QKV};
          pg8::gemm_phase<pg8::EpiInProj, pg8::StaticOrder, true, true>((LAS unsigned char*)lds, g, S, E); }
        { const int t2 = tid_(), b2 = bid_(); if (b2 == 0 && t2 < NE) P->cnt[t2] = 0;
 }
        GRID_BAR();
        hg::local_states(P, lds, layer);
        { const int b0 = bid_(); for (int un = (G == 256) ? ((b0 + 128) & 255) : b0; un < 128; un += G) s5::fused_unit(P, lds, layer, un >> 5, un & 31); }
        ph_attention(P, lds);
        GRID_BAR();
        hg::scan_states(P);
        ph_attn_out(P, layer, G > 192 ? 132 : 0);
        __syncthreads();
        { pg8::Gemm g{P->YG, P->WgluT + (size_t)layer * 1024 * 512, MP, 1024, 512, 512}; pg8::StaticOrder S; S.init(MP, 1024, G, bid_(), 512 / 64); pg8::EpiGlu E{P->MIX, P->b_glu + layer * 1024};
          pg8::gemm_phase<pg8::EpiGlu, pg8::StaticOrder, true, true>((LAS unsigned char*)lds, g, S, E); }
        GRID_BAR();
        hg::outputs(P, lds, layer);
        GRID_BAR();
        { pg8::Gemm g{P->MIX, P->WoutT + (size_t)layer * DM * DM, MP, DM, DM, DM}; pg8::StaticOrder S; S.init(MP, DM, G, bid_(), DM / 64); pg8::EpiResidual E{P->Z};
          pg8::gemm_phase<pg8::EpiResidual, pg8::StaticOrder, true, true>((LAS unsigned char*)lds, g, S, E); }
        GRID_BAR();
        rt::norm_router(P, lds, layer);
        GRID_BAR();
        moe::stream_gemm<true>(P, lds, layer);
        GRID_BAR();
        moe::stream_gemm<false>(P, lds, layer);
        GRID_BAR();
        ph_combine_norm(P, lds, layer);
        if (layer == 0) GRID_BAR();
    }
}
}

extern "C" void kernel_launch(void* const* d_in, const int* in_sizes, int n_in, void* d_out, int out_size, void* d_ws, size_t ws_size, hipStream_t stream) {
    static int grid = 0;
    if (grid == 0) {
        int dev = 0, cus = 0;
        if (hipGetDevice(&dev) != hipSuccess || hipDeviceGetAttribute(&cus, hipDeviceAttributeMultiprocessorCount, dev) != hipSuccess) { grid = -1; return; }
        if (hipFuncSetAttribute((const void*)mega_fwd, hipFuncAttributeMaxDynamicSharedMemorySize, LDS_BYTES) != hipSuccess) { grid = -1; return; }
        int per_cu = 0;
        if (hipOccupancyMaxActiveBlocksPerMultiprocessor(&per_cu, (const void*)mega_fwd, NTHR, LDS_BYTES) != hipSuccess || per_cu < 1) { (void)hipGetLastError(); }
        grid = cus;
    }
    if (grid < 0) return;
    Params p{};
    const float** pin = (const float**)&p;
    for (int i = 0; i < 31; ++i) pin[i] = (const float*)d_in[i];
    p.out = (float*)d_out;
    char* ws = (char*)d_ws; size_t off = 0;
    auto alloc = [&](size_t bytes) { char* q = ws + off; off += (bytes + 255) & ~(size_t)255; return q; };
    p.bar = (unsigned*)alloc(XCD_BAR_WORDS * 4);
    p.elist = (int*)alloc((size_t)NE * ECAP * 4);
    p.cnt = (int*)alloc(256); p.blk_e = (int*)alloc(1024); p.base = (int*)alloc(256);
    p.lbtab = (float*)alloc(1024 * 4); p.lam = (float*)alloc(256);
    p.Z = (float*)alloc((size_t)MP * DM * 4);
    p.HN = (bf16_t*)alloc((size_t)MP * DM * 2);
    p.PA = (float*)alloc((size_t)MP * PAW * 4);
    p.QKV = (bf16_t*)alloc((size_t)MP * QKVW * 2);
    p.OA = (float*)alloc((size_t)MP * HW * 4);
    p.ZP = (float*)alloc((size_t)8 * 256 * DM * 4);
    p.WRT = (bf16_t*)alloc((size_t)2 * 2 * 96 * DM * 2);
    p.A16 = (float*)alloc(2 * 32 * 64 * 8); p.S5E = (float*)alloc((size_t)516 * 32 * 128 * 4); p.S5X = (float*)alloc((size_t)516 * 32 * 128 * 4);
    p.BtY = (bf16_t*)alloc((size_t)2 * 32 * 256 * 384 * 2); p.BtE = (bf16_t*)alloc((size_t)2 * 32 * 128 * 256 * 2);
    p.SLOC = (float*)alloc((size_t)528 * 16384 * 4); p.DEC = (float*)alloc((size_t)528 * 128 * 4); p.SPREV = (bf16_t*)alloc((size_t)529 * 16384 * 2);
    p.YG = (bf16_t*)alloc((size_t)MP * 512 * 2);
    p.T = nullptr;
    p.MIX = (bf16_t*)alloc((size_t)MP * DM * 2);
    p.OC = (float*)alloc((size_t)MP * DM * 4);
    p.ridx = (int*)alloc((size_t)NASSIGN * 4); p.rgate = (float*)alloc((size_t)NASSIGN * 4); p.rslot = (int*)alloc((size_t)NASSIGN * 4);
    p.tokrow = (int*)alloc((size_t)NASSIGN * 4); p.rowtok = (int*)alloc((size_t)NRMAX * 4);
    p.H1 = nullptr;
    p.H = (bf16_t*)alloc((size_t)NRMAX * DE * 2);
    p.Y = (bf16_t*)alloc((size_t)NRMAX * DM * 2);
    p.S = nullptr;
    p.WinT = (bf16_t*)alloc((size_t)2 * INW * DM * 2); p.WoutT = (bf16_t*)alloc((size_t)2 * DM * DM * 2); p.WgluT = (bf16_t*)alloc((size_t)2 * 1024 * 512 * 2);
    if (off > ws_size) return;
    if (hipMemsetAsync(p.bar, 0, XCD_BAR_WORDS * 4, stream) != hipSuccess) return;
    hipLaunchKernelGGL(mega_fwd, dim3(grid), dim3(NTHR), LDS_BYTES, stream, p);
}
```

```cpp
#include <hip/hip_runtime.h>
#include <stdint.h>
#include <math.h>

namespace {
typedef unsigned short bf16_t;
constexpr int DM = 2048, NB = 4, SEQ = 2048, NMETA = 16, LL = SEQ + NMETA, TOK = NB * LL, MP = 8448;
constexpr int HW = 512;
constexpr int INW = 5632, PAW = 2560, QKVW = 3072;
constexpr int NE = 64, DE = 512, NASSIGN = TOK * 2;
constexpr int RB = 128;
constexpr int NRMAX = NASSIGN + NE * RB;
constexpr float EPS = 1e-6f;
constexpr int NTHR = 512;
constexpr int CSTR = 64;
constexpr int ECAP = 1024;
constexpr int LDS_BYTES = 147456;
constexpr int LDS_CTL = 143360;

__device__ __forceinline__ float bf2f(bf16_t h) { return __uint_as_float(((unsigned)h) << 16); }
__device__ __forceinline__ bf16_t f2bf(float f) { unsigned u = __float_as_uint(f); return (bf16_t)((u + 0x7fffu + ((u >> 16) & 1u)) >> 16); }
__device__ __forceinline__ float sigmoidf_(float x) { return 1.f / (1.f + expf(-x)); }
__device__ __forceinline__ int tid_() { int t = threadIdx.x; asm volatile("" : "+v"(t)); return t; }
template <int K> __device__ __forceinline__ float swz_xor(float v) { return __int_as_float(__builtin_amdgcn_ds_swizzle(__float_as_int(v), (K << 10) | 0x1f)); }
__device__ __forceinline__ int bid_() { int b = blockIdx.x; asm volatile("" : "+s"(b)); return b; }

#define XB_TMO      128
#define XB_XCNT(j)  (256  + 64 * (j))
#define XB_XSUB(j)  (1280 + 64 * (j))
#define XB_XGEN(j)  (2304 + 64 * (j))
#define XB_TOP      3328
#define XB_TOPGEN   3392
#define XCD_BAR_WORDS 3456
#define XB_SPIN_CAP (1u << 24)
#define LAS __attribute__((address_space(3)))
__device__ __forceinline__ unsigned xb_ld(unsigned* p)              { return __hip_atomic_load(p, __ATOMIC_RELAXED, __HIP_MEMORY_SCOPE_AGENT); }
__device__ __forceinline__ unsigned xb_add(unsigned* p, unsigned v) { return __hip_atomic_fetch_add(p, v, __ATOMIC_RELAXED, __HIP_MEMORY_SCOPE_AGENT); }
__device__ __forceinline__ unsigned xb_xcc_id() { return (unsigned)__builtin_amdgcn_s_getreg((3 << 11) | 20) & 0xFu; }
#define XB_SPIN(cond, bar) do { unsigned _sp = 0; while (cond) { __builtin_amdgcn_s_sleep(1); \
    if ((++_sp & 255u) == 0u) { if (xb_ld(&(bar)[XB_TMO])) break; if (_sp > XB_SPIN_CAP) { atomicAdd(&(bar)[XB_TMO], 1u); break; } } } } while (0)
struct XcdBarrier { unsigned* bar; unsigned x; volatile LAS unsigned* st; };
__device__ __forceinline__ XcdBarrier xcd_barrier_post(unsigned* bar, volatile LAS unsigned* st) {
    XcdBarrier b; b.bar = bar; b.x = xb_xcc_id(); b.st = st;
    if (threadIdx.x == 0) (void)xb_add(&bar[XB_XCNT(b.x)], 1u);
    return b;
}
__device__ __forceinline__ void xcd_barrier_complete(unsigned* bar, unsigned x, unsigned& nloc, unsigned& nx) {
    const unsigned G = gridDim.x * gridDim.y * gridDim.z;
    unsigned sum, cnt, mine, sp = 0u;
    for (;;) {
        sum = 0u; cnt = 0u; mine = 0u;
#pragma unroll
        for (unsigned j = 0; j < 16; ++j) { const unsigned c = xb_ld(&bar[XB_XCNT(j)]); sum += c; cnt += (c > 0u) ? 1u : 0u; mine = (j == x) ? c : mine; }
        if (sum == G) break;
        __builtin_amdgcn_s_sleep(1);
        if ((++sp & 255u) == 0u) { if (xb_ld(&bar[XB_TMO])) break; if (sp > XB_SPIN_CAP) { atomicAdd(&bar[XB_TMO], 1u); break; } }
    }
    nloc = mine > 0u ? mine : 1u; nx = cnt > 0u ? cnt : 1u;
}
__device__ __forceinline__ void xcd_barrier(const XcdBarrier& b) {
    asm volatile("s_waitcnt vmcnt(0)" ::: "memory");
    __syncthreads();
    if (threadIdx.x == 0) {
        unsigned* bar = b.bar;
        const unsigned bx_ = xb_xcc_id();
        __builtin_amdgcn_s_waitcnt(0);
        unsigned nloc = b.st[0], nx = b.st[1];
        if (nloc == 0u) { xcd_barrier_complete(bar, bx_, nloc, nx); b.st[0] = nloc; b.st[1] = nx; }
        const unsigned old = xb_add(&bar[XB_XSUB(bx_)], 1u);
        const unsigned gen = old / nloc;
        if (old + 1u == (gen + 1u) * nloc) {
            __builtin_amdgcn_fence(__ATOMIC_RELEASE, "agent");
            asm volatile("s_waitcnt vmcnt(0)" ::: "memory");
            const unsigned og = xb_add(&bar[XB_TOP], 1u);
            const unsigned tg = og / nx;
            if (og + 1u == (tg + 1u) * nx) xb_add(&bar[XB_TOPGEN], 1u);
            else XB_SPIN(xb_ld(&bar[XB_TOPGEN]) == tg, bar);
            __builtin_amdgcn_fence(__ATOMIC_ACQUIRE, "agent");
            xb_add(&bar[XB_XGEN(bx_)], 1u);
            asm volatile("s_waitcnt vmcnt(0)" ::: "memory");
        } else {
            XB_SPIN(xb_ld(&bar[XB_XGEN(bx_)]) == gen, bar);
            __builtin_amdgcn_fence(__ATOMIC_ACQUIRE, "agent");
            asm volatile("s_waitcnt vmcnt(0)" ::: "memory");
        }
    }
    __syncthreads();
}

struct Params {
    const float *x, *meta, *ln1_w, *w_in, *lbnd, *hnw, *a_re, *a_im, *b_re, *b_im, *c_re, *c_im, *s5d, *log_dt, *w_glu, *b_glu,
                *lq1, *lk1, *lq2, *lk2, *subln, *w_out, *ln2_w, *wrg, *brg, *wre, *bre, *w1, *w3, *w2, *fnw;
    float* out;
    unsigned* bar;
    int *cnt, *blk_e, *ridx, *rslot, *tokrow, *rowtok, *base, *elist;
    float *lbtab, *lam, *Z, *PA, *OA, *T, *OC, *rgate, *H1, *S, *SLOC, *DEC, *A16, *S5E, *S5X, *ZP;
    bf16_t *HN, *QKV, *YG, *MIX, *H, *Y, *WinT, *WoutT, *WgluT, *SPREV, *BtY, *BtE, *WRT;
};
typedef const __attribute__((address_space(4))) Params* KP;
__device__ __forceinline__ KP kp_() { KP p = (KP)__builtin_amdgcn_kernarg_segment_ptr(); asm volatile("" : "+s"(p)); return p; }


namespace pg8 {
#define PG8_LAS __attribute__((address_space(3)))
typedef short bf16x8 __attribute__((ext_vector_type(8)));
typedef float f32x4 __attribute__((ext_vector_type(4)));
typedef unsigned u32x4 __attribute__((ext_vector_type(4)));
constexpr int BM = 256, BK = 64, HALF = 128, HTB = HALF * BK * 2, STAGE_BYTES = 8 * HTB, NXCD = 8, WGM = 8;
__host__ __device__ __forceinline__ int lds_byte(int r, int c) { const int st = (r >> 4) * 2 + (c >> 5), rr = r & 15, cc = c & 31, ob = rr * 64 + cc * 2; return st * 1024 + (ob ^ (((ob >> 9) & 1) << 5)); }
__host__ __device__ __forceinline__ void stage_rc(int b, int& R, int& C) { const int st = b / 1024, sb = b % 1024, swz = sb ^ (((sb >> 9) & 1) << 5); R = (st >> 1) * 16 + swz / 64; C = (st & 1) * 32 + (swz % 64) / 2; }
__host__ __device__ __forceinline__ int perm32(int rho) { const int n = rho >> 4, i = rho & 15; return 8 * (i >> 2) + 4 * n + (i & 3); }
struct Unit { int pm, pn, ko, nt; };
struct Gemm { const bf16_t* A; const bf16_t* Bt; int M, N, K, ld; };
struct StaticOrder {
    static constexpr bool PER_UNIT_K = false;
    int nM, nN, nwg, G, c, nt;
    __host__ __device__ void init(int M, int N, int G_, int c_, int nt_) { nM = M / BM; nN = N / BM; nwg = nM * nN; G = G_; c = c_; nt = nt_; }
    __host__ __device__ bool next(int i, Unit& u) const {
        const long L = (long)i * G + c; if (L >= nwg) return false;
        int wgid = (int)L; { const int q = nwg / NXCD, r = nwg % NXCD, xcd = wgid % NXCD, off = wgid / NXCD; wgid = (xcd < r ? xcd * (q + 1) : r * (q + 1) + (xcd - r) * q) + off; }
        const int nig = WGM * nN, gid = wgid / nig, fm = gid * WGM, gsz = (nM - fm) < WGM ? (nM - fm) : WGM;
        u.pm = fm + ((wgid % nig) % gsz); u.pn = (wgid % nig) / gsz; u.ko = 0; u.nt = nt; return true;
    }
    __device__ __forceinline__ void a_ready(const Unit&) const {}
    __device__ __forceinline__ void done(const Unit&) const {}
};
__device__ __forceinline__ unsigned cvt_pk_bf16(float lo, float hi) { unsigned r; asm volatile("v_cvt_pk_bf16_f32 %0, %1, %2" : "=v"(r) : "v"(lo), "v"(hi)); return r; }

template <class Epi, class Sched, bool ALIGN_EPI = false, bool SP2 = false>
__device__ __forceinline__ void gemm_phase(PG8_LAS unsigned char* lds, const Gemm g, const Sched& S, const Epi& E) {
    const int tid = tid_(), wid = __builtin_amdgcn_readfirstlane(tid >> 6), lane = tid & 63, wr = wid >> 2, wc = wid & 3, fr = lane & 15, fq = lane >> 4;
    const int K = g.ld;
    unsigned voffA[2], voffB[2];
#pragma unroll
    for (int i = 0; i < 2; ++i) { int R, C; stage_rc(tid * 16 + i * 8192, R, C); const int Rb = Epi::PERM ? ((R & ~31) + perm32(R & 31)) : R;
        voffA[i] = (unsigned)(R * K + C) * 2u; voffB[i] = (unsigned)(Rb * K + C) * 2u; }
    const size_t kstep = (size_t)(BK * 2);
    const size_t hstep = (size_t)HALF * K * 2;
    const size_t tstep = 2 * hstep;
    const unsigned ldsw = (unsigned)wid * 1024u;
    const int aoff = lds_byte(wr * 64 + fr, fq * 8), boff = lds_byte(wc * 32 + fr, fq * 8);
#define PG8_SA(b, h) (((b) * 2 + (h)) * HTB)
#define PG8_SB(b, h) ((4 + (b) * 2 + (h)) * HTB)
#define PG8_STAGE(bufoff, gbase, voff) do { _Pragma("unroll") for (int _i = 0; _i < 2; ++_i) \
        __builtin_amdgcn_global_load_lds((const unsigned*)((const char*)(gbase) + (voff)[_i]), (PG8_LAS unsigned*)(lds + (bufoff) + ldsw + _i * 8192), 16, 0, 0); } while (0)
#define PG8_LDA(dst, b, h) do { _Pragma("unroll") for (int m = 0; m < 4; ++m) _Pragma("unroll") for (int k = 0; k < 2; ++k) dst[m][k] = *(const PG8_LAS bf16x8*)(lds + PG8_SA(b, h) + aoff + m * 2048 + k * 1024); } while (0)
#define PG8_LDB(dst, b, h) do { _Pragma("unroll") for (int n = 0; n < 2; ++n) _Pragma("unroll") for (int k = 0; k < 2; ++k) dst[n][k] = *(const PG8_LAS bf16x8*)(lds + PG8_SB(b, h) + boff + n * 2048 + k * 1024); } while (0)
#define PG8_MMA(ai, bj, At, Bt) do { __builtin_amdgcn_s_setprio(1); _Pragma("unroll") for (int m = 0; m < 4; ++m) _Pragma("unroll") for (int n = 0; n < 2; ++n) _Pragma("unroll") for (int k = 0; k < 2; ++k) \
        acc[ai][bj][m][n] = __builtin_amdgcn_mfma_f32_16x16x32_bf16(Bt[n][k], At[m][k], acc[ai][bj][m][n], 0, 0, 0); __builtin_amdgcn_s_setprio(0); } while (0)
#define PG8_WAIT_V(n) asm volatile("s_waitcnt vmcnt(" #n ")" ::: "memory")
#define PG8_WAIT_L(n) asm volatile("s_waitcnt lgkmcnt(" #n ")" ::: "memory")
#define PG8_BAR __builtin_amdgcn_s_barrier()
#define PG8_SCHED __builtin_amdgcn_sched_barrier(0)
    Unit cur, nxt; int ui = 0;
    if (!S.next(0, cur)) return;
    f32x4 acc[2][2][4][2];
#pragma unroll
    for (int a = 0; a < 2; ++a)
#pragma unroll
        for (int b = 0; b < 2; ++b)
#pragma unroll
            for (int m = 0; m < 4; ++m)
#pragma unroll
                for (int n = 0; n < 2; ++n) acc[a][b][m][n] = (f32x4){0.f, 0.f, 0.f, 0.f};
    bf16x8 At[4][2], B0[2][2], B1[2][2];
    const char* cA = (const char*)g.A + (size_t)cur.pm * tstep + (size_t)cur.ko * 2; const char* cB = (const char*)g.Bt + (size_t)cur.pn * tstep + (size_t)cur.ko * 2;
    S.a_ready(cur);
    if constexpr (SP2) {
        PG8_STAGE(PG8_SB(0, 0), cB, voffB); PG8_STAGE(PG8_SB(0, 1), cB + hstep, voffB); PG8_STAGE(PG8_SA(0, 0), cA, voffA); PG8_STAGE(PG8_SA(0, 1), cA + hstep, voffA);
        if (wr == 1) PG8_BAR;
        PG8_WAIT_V(2); PG8_BAR;
        PG8_STAGE(PG8_SB(1, 0), cB + kstep, voffB); PG8_STAGE(PG8_SA(1, 0), cA + kstep, voffA); PG8_STAGE(PG8_SB(1, 1), cB + hstep + kstep, voffB);
        PG8_WAIT_V(6); PG8_BAR;
    } else {
        PG8_STAGE(PG8_SB(0, 0), cB, voffB); PG8_STAGE(PG8_SA(0, 0), cA, voffA); PG8_STAGE(PG8_SB(0, 1), cB + hstep, voffB); PG8_STAGE(PG8_SA(0, 1), cA + hstep, voffA);
        if (wr == 1) PG8_BAR;
        PG8_WAIT_V(4); PG8_BAR;
        PG8_STAGE(PG8_SB(1, 0), cB + kstep, voffB); PG8_STAGE(PG8_SA(1, 0), cA + kstep, voffA); PG8_STAGE(PG8_SB(1, 1), cB + hstep + kstep, voffB);
        PG8_WAIT_V(6); PG8_BAR;
    }
    for (;;) {
        const bool has_next = S.next(ui + 1, nxt);
        const char* nA = has_next ? (const char*)g.A + (size_t)nxt.pm * tstep + (size_t)nxt.ko * 2 : cA; const char* nB = has_next ? (const char*)g.Bt + (size_t)nxt.pn * tstep + (size_t)nxt.ko * 2 : cB;
        const int nt = Sched::PER_UNIT_K ? cur.nt : g.K / BK;
        for (int t = 0; t < nt; t += 2) {
            const bool last = (t == nt - 2);
            const char* a1 = cA + (size_t)(t + 1) * kstep;
            const char* a2 = last ? nA : cA + (size_t)(t + 2) * kstep; const char* b2 = last ? nB : cB + (size_t)(t + 2) * kstep;
            const char* a3 = a2 + kstep; const char* b3 = b2 + kstep;
            if (last && has_next) S.a_ready(nxt);
            if constexpr (SP2) {
            PG8_LDB(B0, 0, 0); PG8_LDB(B1, 0, 1); PG8_SCHED; PG8_LDA(At, 0, 0); PG8_STAGE(PG8_SA(1, 1), a1 + hstep, voffA);
            PG8_WAIT_V(8); PG8_WAIT_L(0); PG8_BAR; PG8_MMA(0, 0, At, B0); PG8_MMA(0, 1, At, B1); PG8_BAR; PG8_SCHED;
            PG8_LDA(At, 0, 1); PG8_STAGE(PG8_SB(0, 0), b2, voffB); PG8_STAGE(PG8_SB(0, 1), b2 + hstep, voffB); PG8_STAGE(PG8_SA(0, 0), a2, voffA);
            PG8_WAIT_V(8); PG8_WAIT_L(0); PG8_BAR; PG8_MMA(1, 0, At, B0); PG8_MMA(1, 1, At, B1); PG8_BAR; PG8_SCHED;
            PG8_LDB(B0, 1, 0); PG8_LDB(B1, 1, 1); PG8_SCHED; PG8_LDA(At, 1, 0); PG8_STAGE(PG8_SA(0, 1), a2 + hstep, voffA);
            PG8_WAIT_V(8); PG8_WAIT_L(0); PG8_BAR; PG8_MMA(0, 0, At, B0); PG8_MMA(0, 1, At, B1); PG8_BAR; PG8_SCHED;
            PG8_LDA(At, 1, 1); PG8_STAGE(PG8_SB(1, 0), b3, voffB); PG8_STAGE(PG8_SB(1, 1), b3 + hstep, voffB); PG8_STAGE(PG8_SA(1, 0), a3, voffA);
            PG8_WAIT_V(8); PG8_WAIT_L(0); PG8_BAR; PG8_MMA(1, 0, At, B0); PG8_MMA(1, 1, At, B1); PG8_BAR; PG8_SCHED;
            } else {
            PG8_LDB(B0, 0, 0); PG8_SCHED; PG8_LDA(At, 0, 0); PG8_STAGE(PG8_SA(1, 1), a1 + hstep, voffA);
            PG8_WAIT_L(8); PG8_BAR; PG8_WAIT_L(0); PG8_MMA(0, 0, At, B0); PG8_BAR; PG8_SCHED;
            PG8_LDB(B1, 0, 1); PG8_STAGE(PG8_SB(0, 0), b2, voffB);
            PG8_BAR; PG8_WAIT_L(0); PG8_MMA(0, 1, At, B1); PG8_BAR;
            PG8_LDA(At, 0, 1); PG8_STAGE(PG8_SA(0, 0), a2, voffA);
            PG8_BAR; PG8_WAIT_L(0); PG8_MMA(1, 0, At, B0); PG8_BAR; PG8_SCHED;
            PG8_STAGE(PG8_SB(0, 1), b2 + hstep, voffB);
            PG8_WAIT_V(6); PG8_BAR; PG8_MMA(1, 1, At, B1); PG8_BAR;
            PG8_LDB(B0, 1, 0); PG8_SCHED; PG8_LDA(At, 1, 0); PG8_STAGE(PG8_SA(0, 1), a2 + hstep, voffA);
            PG8_WAIT_L(8); PG8_BAR; PG8_WAIT_L(0); PG8_MMA(0, 0, At, B0); PG8_BAR; PG8_SCHED;
            PG8_LDB(B1, 1, 1); PG8_STAGE(PG8_SB(1, 0), b3, voffB);
            PG8_BAR; PG8_WAIT_L(0); PG8_MMA(0, 1, At, B1); PG8_BAR;
            PG8_LDA(At, 1, 1); PG8_STAGE(PG8_SA(1, 0), a3, voffA);
            PG8_BAR; PG8_WAIT_L(0); PG8_MMA(1, 0, At, B0); PG8_BAR; PG8_SCHED;
            PG8_STAGE(PG8_SB(1, 1), b3 + hstep, voffB);
            PG8_WAIT_V(6); PG8_BAR; PG8_MMA(1, 1, At, B1); PG8_BAR;
            }
        }
        if constexpr (ALIGN_EPI) { if (wr == 0) PG8_BAR; }
        E(acc, cur, wr, wc, fr, fq);
        if (!has_next) break;
#pragma unroll
        for (int a = 0; a < 2; ++a)
#pragma unroll
            for (int b = 0; b < 2; ++b)
#pragma unroll
                for (int m = 0; m < 4; ++m)
#pragma unroll
                    for (int n = 0; n < 2; ++n) acc[a][b][m][n] = (f32x4){0.f, 0.f, 0.f, 0.f};
        cur = nxt; cA = nA; cB = nB; ++ui;
        if constexpr (ALIGN_EPI) { if (wr == 1) PG8_BAR; }
    }
    PG8_WAIT_V(0);
    if constexpr (!ALIGN_EPI) { if (wr == 0) PG8_BAR; }
    PG8_BAR;
#undef PG8_SA
#undef PG8_SB
#undef PG8_STAGE
#undef PG8_LDA
#undef PG8_LDB
#undef PG8_MMA
#undef PG8_WAIT_V
#undef PG8_WAIT_L
#undef PG8_BAR
#undef PG8_SCHED
}
struct EpiInProj {
    static constexpr bool PERM = true;
    float* PA; bf16_t* QKV;
    __device__ __forceinline__ void operator()(const f32x4 (&acc)[2][2][4][2], const Unit& u, int wr, int wc, int fr, int fq) const {
        const int row0 = u.pm * BM + wr * 64 + fr, colt = u.pn * BM + wc * 32 + 8 * fq;
        if (colt < PAW) {
#pragma unroll
            for (int ai = 0; ai < 2; ++ai)
#pragma unroll
                for (int m = 0; m < 4; ++m) { float* rp = PA + (size_t)(row0 + ai * HALF + m * 16) * PAW + colt;
#pragma unroll
                    for (int bj = 0; bj < 2; ++bj) { *(f32x4*)(rp + bj * HALF) = acc[ai][bj][m][0]; *(f32x4*)(rp + bj * HALF + 4) = acc[ai][bj][m][1]; } }
        } else {
#pragma unroll
            for (int ai = 0; ai < 2; ++ai)
#pragma unroll
                for (int m = 0; m < 4; ++m) { bf16_t* rp = QKV + (size_t)(row0 + ai * HALF + m * 16) * QKVW + (colt - PAW);
#pragma unroll
                    for (int bj = 0; bj < 2; ++bj) { const f32x4 v0 = acc[ai][bj][m][0], v1 = acc[ai][bj][m][1];
                        u32x4 w; w.x = cvt_pk_bf16(v0[0], v0[1]); w.y = cvt_pk_bf16(v0[2], v0[3]); w.z = cvt_pk_bf16(v1[0], v1[1]); w.w = cvt_pk_bf16(v1[2], v1[3]);
                        *(u32x4*)(rp + bj * HALF) = w; } }
        }
    }
};
struct EpiResidual {
    static constexpr bool PERM = true;
    float* Z;
    __device__ __forceinline__ void operator()(const f32x4 (&acc)[2][2][4][2], const Unit& u, int wr, int wc, int fr, int fq) const {
        const int row0 = u.pm * BM + wr * 64 + fr, colt = u.pn * BM + wc * 32 + 8 * fq;
#pragma unroll
        for (int ai = 0; ai < 2; ++ai)
#pragma unroll
            for (int m = 0; m < 4; ++m) { const int row = row0 + ai * HALF + m * 16; if (row < TOK) { float* rp = Z + (size_t)row * DM + colt;
#pragma unroll
                for (int bj = 0; bj < 2; ++bj) { f32x4* p0 = (f32x4*)(rp + bj * HALF); f32x4* p1 = (f32x4*)(rp + bj * HALF + 4);
                    const f32x4 z0 = *p0, z1 = *p1; *p0 = z0 + acc[ai][bj][m][0]; *p1 = z1 + acc[ai][bj][m][1]; } } }
    }
};
struct OutOrder {
    static constexpr bool PER_UNIT_K = true;
    StaticOrder main;
    __device__ bool next(int i, Unit& u) const {
        if (main.next(i, u)) return true;
        const int r0 = (main.nwg + main.G - 1) / main.G;
        const int L = (i - r0) * main.G + main.c; if (i < r0 || L >= 64) return false;
        u.pm = 32; u.pn = L & 7; u.ko = (L >> 3) * 256; u.nt = 4; return true; }
    __device__ __forceinline__ void a_ready(const Unit&) const {}
    __device__ __forceinline__ void done(const Unit&) const {}
};
struct EpiOutProj {
    static constexpr bool PERM = true;
    float* Z; float* ZP;
    __device__ __forceinline__ void operator()(const f32x4 (&acc)[2][2][4][2], const Unit& u, int wr, int wc, int fr, int fq) const {
        const bool tail = u.pm == 32;
        const int row0 = (tail ? (u.ko >> 8) * BM : u.pm * BM) + wr * 64 + fr, colt = u.pn * BM + wc * 32 + 8 * fq;
        float* base = tail ? ZP : Z;
#pragma unroll
        for (int ai = 0; ai < 2; ++ai)
#pragma unroll
            for (int m = 0; m < 4; ++m) { float* rp = base + (size_t)(row0 + ai * HALF + m * 16) * DM + colt;
#pragma unroll
                for (int bj = 0; bj < 2; ++bj) { f32x4* p0 = (f32x4*)(rp + bj * HALF); f32x4* p1 = (f32x4*)(rp + bj * HALF + 4);
                    f32x4 z0 = {0.f, 0.f, 0.f, 0.f}, z1 = {0.f, 0.f, 0.f, 0.f};
                    if (!tail) { z0 = *p0; z1 = *p1; }
                    *p0 = z0 + acc[ai][bj][m][0]; *p1 = z1 + acc[ai][bj][m][1]; } }
    }
};
struct TailOrder {
    static constexpr bool PER_UNIT_K = false;
    int G, c;
    __device__ bool next(int i, Unit& u) const { const int L = i * G + c; if (L >= 64) return false; u.pm = 32; u.pn = L & 7; u.ko = (L >> 3) * 256; u.nt = 4; return true; }
    __device__ __forceinline__ void a_ready(const Unit&) const {}
    __device__ __forceinline__ void done(const Unit&) const {}
};
struct EpiTailPartial {
    static constexpr bool PERM = true;
    float* ZP;
    __device__ __forceinline__ void operator()(const f32x4 (&acc)[2][2][4][2], const Unit& u, int wr, int wc, int fr, int fq) const {
        const int row0 = (u.ko >> 8) * BM + wr * 64 + fr, colt = u.pn * BM + wc * 32 + 8 * fq;
#pragma unroll
        for (int ai = 0; ai < 2; ++ai)
#pragma unroll
            for (int m = 0; m < 4; ++m) { float* rp = ZP + (size_t)(row0 + ai * HALF + m * 16) * DM + colt;
#pragma unroll
                for (int bj = 0; bj < 2; ++bj) { *(f32x4*)(rp + bj * HALF) = acc[ai][bj][m][0]; *(f32x4*)(rp + bj * HALF + 4) = acc[ai][bj][m][1]; } }
    }
};
struct EpiGlu {
    static constexpr bool PERM = true;
    bf16_t* MIX; const float* bias;
    __device__ __forceinline__ void operator()(const f32x4 (&acc)[2][2][4][2], const Unit& u, int wr, int wc, int fr, int fq) const {
        const int row0 = u.pm * BM + wr * 64 + fr, c0 = u.pn * HALF + wc * 32 + 8 * fq;
        const f32x4 bv0 = *(const f32x4*)(bias + c0), bv1 = *(const f32x4*)(bias + c0 + 4), bg0 = *(const f32x4*)(bias + 512 + c0), bg1 = *(const f32x4*)(bias + 512 + c0 + 4);
        float one = 1.f; asm volatile("" : "+v"(one));
#pragma unroll
        for (int ai = 0; ai < 2; ++ai)
#pragma unroll
            for (int m = 0; m < 4; ++m) { const f32x4 v0 = acc[ai][0][m][0] + bv0, v1 = acc[ai][0][m][1] + bv1, g0 = acc[ai][1][m][0] + bg0, g1 = acc[ai][1][m][1] + bg1;
                float o[8];
#pragma unroll
                for (int e = 0; e < 4; ++e) { o[e] = v0[e] * __builtin_amdgcn_rcpf(one + __expf(-g0[e])); o[4 + e] = v1[e] * __builtin_amdgcn_rcpf(one + __expf(-g1[e])); }
                u32x4 w; w.x = cvt_pk_bf16(o[0], o[1]); w.y = cvt_pk_bf16(o[2], o[3]); w.z = cvt_pk_bf16(o[4], o[5]); w.w = cvt_pk_bf16(o[6], o[7]);
                *(u32x4*)(MIX + (size_t)(row0 + ai * HALF + m * 16) * DM + 512 + c0) = w; }
    }
};
}

__device__ __forceinline__ void transpose_item(const float* W, int K, int N, bf16_t* WT, int k0, int n0, int row0, float* scr, int lane) {
    float tv[32];
#pragma unroll
    for (int i = 0; i < 32; ++i) { const int kk = 2 * i + (lane >> 5); tv[i] = W[(size_t)(k0 + kk) * N + n0 + (lane & 31)]; }
#pragma unroll
    for (int i = 0; i < 32; ++i) { const int kk = 2 * i + (lane >> 5); scr[kk * 33 + (lane & 31)] = tv[i]; }
    asm volatile("s_waitcnt lgkmcnt(0)" ::: "memory");
    const int c = lane & 7;
#pragma unroll
    for (int j = 0; j < 4; ++j) { const int n = (lane >> 3) + 8 * j; const float* sp = scr + (8 * c) * 33 + n;
        pg8::u32x4 o; o.x = pg8::cvt_pk_bf16(sp[0 * 33], sp[1 * 33]); o.y = pg8::cvt_pk_bf16(sp[2 * 33], sp[3 * 33]); o.z = pg8::cvt_pk_bf16(sp[4 * 33], sp[5 * 33]); o.w = pg8::cvt_pk_bf16(sp[6 * 33], sp[7 * 33]);
        *(pg8::u32x4*)(WT + (size_t)(row0 + n) * K + k0 + 8 * c) = o; }
    asm volatile("s_waitcnt lgkmcnt(0)" ::: "memory");
}
__device__ __forceinline__ void ph_weights(KP P, char* lds) {
    const int tid = tid_(), lane = tid & 63, wave = tid >> 6;
    float* scr = (float*)lds + wave * (64 * 33);
    const int gw = bid_() * 8 + wave, NGW = gridDim.x * 8;
    constexpr int I_IN = (DM / 64) * (INW / 32), I_OUT = (DM / 64) * (DM / 32), I_GLU = (512 / 64) * (1024 / 32), I_L = I_IN + I_OUT + I_GLU;
    for (int it = gw; it < 2 * I_L; it += NGW) {
        const int layer = it / I_L; int r = it % I_L;
        if (r < I_IN) { const int nb = INW / 32, kb = r / nb, n0 = (r % nb) * 32;
            transpose_item(P->w_in + (size_t)layer * DM * INW, DM, INW, P->WinT + (size_t)layer * INW * DM, kb * 64, n0, n0, scr, lane); continue; }
        r -= I_IN;
        if (r < I_OUT) { const int nb = DM / 32, kb = r / nb, n0 = (r % nb) * 32;
            transpose_item(P->w_out + (size_t)layer * DM * DM, DM, DM, P->WoutT + (size_t)layer * DM * DM, kb * 64, n0, n0, scr, lane); continue; }
        r -= I_OUT;
        { const int nb = 1024 / 32, kb = r / nb, n0 = (r % nb) * 32;
          const int row0 = ((n0 & 511) >> 7) * 256 + (n0 >> 9) * 128 + (n0 & 127);
          transpose_item(P->w_glu + (size_t)layer * 512 * 1024, 512, 1024, P->WgluT + (size_t)layer * 1024 * 512, kb * 64, n0, row0, scr, lane); }
    }
}


namespace fa {
using bf16x8 = __attribute__((ext_vector_type(8))) short;
using s16x4  = __attribute__((ext_vector_type(4))) short;
using f32x16 = __attribute__((ext_vector_type(16))) float;
using u32x4  = __attribute__((ext_vector_type(4))) unsigned;
constexpr int D = 128, NW = 8, QBLK = 32, KVBLK = 64, LDQK = QKVW;
constexpr float SCALE = 0.088388347648318440f, THR = 8.f, NEG = -1e30f;
constexpr size_t SHM_V = KVBLK * D * 2, SHM_K = KVBLK * D * 2, SHM_ATTN = 2 * SHM_V + 2 * SHM_K + NW * 64 * 4;
#define KSWZ(row, colB) ((row) * 256 + ((colB) ^ (((row) & 7) << 4)))
#define SBAR() __builtin_amdgcn_sched_barrier(0)
__device__ __forceinline__ int crow(int r, int hi) { return (r & 3) + 8 * (r >> 2) + 4 * hi; }
__device__ __forceinline__ unsigned cvtpk(float lo, float hi) { unsigned r; asm volatile("v_cvt_pk_bf16_f32 %0, %1, %2" : "=v"(r) : "v"(lo), "v"(hi)); return r; }
__device__ __forceinline__ void partialSM(f32x16& p0, f32x16& p1, float& m_reg, float& mn, float& alpha) {
  constexpr float C = SCALE * 1.4426950408889634f;
  float pmax = p0[0]; for (int r = 1; r < 16; ++r) pmax = fmaxf(pmax, p0[r]); for (int r = 0; r < 16; ++r) pmax = fmaxf(pmax, p1[r]);
  { auto rr = __builtin_amdgcn_permlane32_swap(__float_as_uint(pmax), __float_as_uint(pmax), false, false);
    pmax = fmaxf(__uint_as_float(rr[0]), __uint_as_float(rr[1])); }
  if (__builtin_expect(__all(pmax - m_reg <= THR / SCALE), 1)) { mn = m_reg; alpha = 1.f; }
  else { mn = fmaxf(m_reg, pmax); alpha = __builtin_amdgcn_exp2f((m_reg - mn) * C); m_reg = mn; }
  float mnC = -mn * C;
  for (int r = 0; r < 16; ++r) p0[r] = fmaf(p0[r], C, mnC); for (int r = 0; r < 16; ++r) p1[r] = fmaf(p1[r], C, mnC);
  for (int r = 0; r < 16; ++r) p0[r] = __builtin_amdgcn_exp2f(p0[r]);
}
__device__ __forceinline__ void finishSM(f32x16& p0, f32x16& p1, float alpha, float& l_reg, bf16x8& pa0, bf16x8& pa1, bf16x8& pa2, bf16x8& pa3) {
  for (int r = 0; r < 16; ++r) p1[r] = __builtin_amdgcn_exp2f(p1[r]);
  float ps = 0; for (int r = 0; r < 16; ++r) ps += p0[r]; for (int r = 0; r < 16; ++r) ps += p1[r];
  { auto rr = __builtin_amdgcn_permlane32_swap(__float_as_uint(ps), __float_as_uint(ps), false, false);
    ps = __uint_as_float(rr[0]) + __uint_as_float(rr[1]); }
  l_reg = l_reg * alpha + ps;
#define PK4(P, BASE, OUT) do { unsigned a0 = cvtpk(P[BASE + 0], P[BASE + 1]), a1 = cvtpk(P[BASE + 2], P[BASE + 3]);   \
    unsigned b0 = cvtpk(P[BASE + 4], P[BASE + 5]), b1 = cvtpk(P[BASE + 6], P[BASE + 7]);                              \
    auto r0 = __builtin_amdgcn_permlane32_swap(a0, b0, false, false); auto r1 = __builtin_amdgcn_permlane32_swap(a1, b1, false, false); \
    u32x4 w = {r0[0], r1[0], r0[1], r1[1]}; OUT = *reinterpret_cast<bf16x8*>(&w); } while (0)
  PK4(p0, 0, pa0); PK4(p0, 8, pa1); PK4(p1, 0, pa2); PK4(p1, 8, pa3);
#undef PK4
}
__device__ __forceinline__ void qkt(f32x16& p0, f32x16& p1, const bf16_t* Ks, const bf16x8* qr, int r32, int hi) {
  p0 = f32x16{}; p1 = f32x16{};
  for (int d0 = 0; d0 < 8; ++d0) { int cb = (d0 * 16 + hi * 8) * 2;
    bf16x8 b0 = *reinterpret_cast<const bf16x8*>((const char*)Ks + KSWZ(r32, cb));
    bf16x8 b1 = *reinterpret_cast<const bf16x8*>((const char*)Ks + KSWZ(32 + r32, cb));
    p0 = __builtin_amdgcn_mfma_f32_32x32x16_bf16(b0, qr[d0], p0, 0, 0, 0);
    p1 = __builtin_amdgcn_mfma_f32_32x32x16_bf16(b1, qr[d0], p1, 0, 0, 0); }
}
__device__ __forceinline__ void mask_tile(f32x16& p0, f32x16& p1, int kt, int vis) {
  if (kt > vis) {
    const bool part = (kt == vis + 1);
    for (int r = 0; r < 16; ++r) p1[r] = NEG;
    for (int r = 8; r < 16; ++r) p0[r] = NEG;
    if (!part) for (int r = 0; r < 8; ++r) p0[r] = NEG;
  }
}
__device__ __forceinline__ int v_st(int k, int c) { const int kk = (k & ~0xC) | ((k & 4) << 1) | ((k & 8) >> 1); return ((kk >> 3) * 4 + (c >> 5)) * 512 + ((kk & 7) * 32 + (c & 31)) * 2; }
__device__ __forceinline__ int v_rd_base(int lane) { return ((lane & 3) << 3) | (((lane >> 2) & 3) << 6) | (((lane >> 4) & 1) << 5) | (((lane >> 5) & 1) << 8); }
constexpr int v_rd_off(int d0, int ks, int half) { return d0 * 512 + ks * 4096 + half * 2048; }
template <int OFF> __device__ __forceinline__ s16x4 tr_read(int vb) {
  s16x4 r; asm volatile("ds_read_b64_tr_b16 %0, %1 offset:%2" : "=&v"(r) : "v"(vb), "i"(OFF) : "memory"); return r;
}
template <int D0> __device__ __forceinline__ void pv_one(f32x16& od, int vb, bf16x8 pa0, bf16x8 pa1, bf16x8 pa2, bf16x8 pa3) {
  const s16x4 l0 = tr_read<v_rd_off(D0, 0, 0)>(vb), h0 = tr_read<v_rd_off(D0, 0, 1)>(vb), l1 = tr_read<v_rd_off(D0, 1, 0)>(vb), h1 = tr_read<v_rd_off(D0, 1, 1)>(vb);
  const s16x4 l2 = tr_read<v_rd_off(D0, 2, 0)>(vb), h2 = tr_read<v_rd_off(D0, 2, 1)>(vb), l3 = tr_read<v_rd_off(D0, 3, 0)>(vb), h3 = tr_read<v_rd_off(D0, 3, 1)>(vb);
  asm volatile("s_waitcnt lgkmcnt(0)" ::: "memory"); SBAR();
#define PK(L, H) (bf16x8){L[0], L[1], L[2], L[3], H[0], H[1], H[2], H[3]}
  od = __builtin_amdgcn_mfma_f32_32x32x16_bf16(pa0, PK(l0, h0), od, 0, 0, 0);
  od = __builtin_amdgcn_mfma_f32_32x32x16_bf16(pa1, PK(l1, h1), od, 0, 0, 0);
  od = __builtin_amdgcn_mfma_f32_32x32x16_bf16(pa2, PK(l2, h2), od, 0, 0, 0);
  od = __builtin_amdgcn_mfma_f32_32x32x16_bf16(pa3, PK(l3, h3), od, 0, 0, 0);
#undef PK
}
__device__ __forceinline__ void pv_d0(f32x16* o, int vb, bf16x8 pa0, bf16x8 pa1, bf16x8 pa2, bf16x8 pa3) {
  pv_one<0>(o[0], vb, pa0, pa1, pa2, pa3); pv_one<1>(o[1], vb, pa0, pa1, pa2, pa3); pv_one<2>(o[2], vb, pa0, pa1, pa2, pa3); pv_one<3>(o[3], vb, pa0, pa1, pa2, pa3);
}
__device__ __forceinline__ void attn_unit(const bf16_t* __restrict__ Qb, const bf16_t* __restrict__ Kh, const bf16_t* __restrict__ Vh, float* __restrict__ Ob, int NT, int vis4, char* lds) {
  const int tid = tid_(), wid = tid >> 6, lane = tid & 63, r32 = lane & 31, hi = lane >> 5;
  const int vis = vis4 + (wid >> 1);
  bf16_t* V_lds = (bf16_t*)lds; bf16_t* K_lds = (bf16_t*)(lds + 2 * SHM_V);
  float* ws = (float*)(lds + 2 * SHM_V + 2 * SHM_K) + wid * 64; float* li_l = ws; float* al_l = ws + 32;
  float m_reg = NEG, l_reg = 0; f32x16 o[4] = {}; bf16x8 qr[8];
  const bf16_t* Qw = Qb + (long)(wid * QBLK + r32) * LDQK + hi * 8;
#pragma unroll
  for (int d0 = 0; d0 < 8; ++d0) qr[d0] = *reinterpret_cast<const bf16x8*>(Qw + d0 * 16);
  const int sr = tid >> 4, sc = (tid & 15) * 8, vst0 = v_st(sr, sc), vst1 = v_st(32 + sr, sc);
  const int vb0 = (int)(uintptr_t)V_lds + v_rd_base(lane);
  struct { bf16x8 vs0, vs1, ks0, ks1; } sr_[2];
#define SLOAD(i, k0) do { sr_[i].vs0 = *reinterpret_cast<const bf16x8*>(&Vh[(long)((k0) + sr) * LDQK + sc]); sr_[i].vs1 = *reinterpret_cast<const bf16x8*>(&Vh[(long)((k0) + 32 + sr) * LDQK + sc]); \
    sr_[i].ks0 = *reinterpret_cast<const bf16x8*>(&Kh[(long)((k0) + sr) * LDQK + sc]); sr_[i].ks1 = *reinterpret_cast<const bf16x8*>(&Kh[(long)((k0) + 32 + sr) * LDQK + sc]); } while (0)
#define SWRITE(b, i) do { *(bf16x8*)((char*)V_lds + (b) * SHM_V + vst0) = sr_[i].vs0;          \
    *(bf16x8*)((char*)V_lds + (b) * SHM_V + vst1) = sr_[i].vs1; int kc = sc * 2;               \
    *(bf16x8*)((char*)K_lds + (b) * SHM_K + KSWZ(sr, kc)) = sr_[i].ks0;                       \
    *(bf16x8*)((char*)K_lds + (b) * SHM_K + KSWZ(32 + sr, kc)) = sr_[i].ks1; } while (0)
#define SWAIT() asm volatile("s_waitcnt vmcnt(4)" ::: "memory")
#define RESC(a) do { if (__any((a) < 1.f)) { if (hi == 0) al_l[r32] = (a); asm volatile("s_waitcnt lgkmcnt(0)" ::: "memory"); \
    for (int d = 0; d < 4; ++d) for (int r = 0; r < 16; ++r) o[d][r] *= al_l[crow(r, hi)]; } } while (0)
  f32x16 pA0, pA1, pB0, pB1; float mnA, mnB, alA, alB; bf16x8 pa0, pa1, pa2, pa3;
  constexpr int SE = 0, SO = 1;
  SLOAD(SE, 0); asm volatile("s_waitcnt vmcnt(0)" ::: "memory"); SWRITE(0, SE); __syncthreads();
  qkt(pA0, pA1, K_lds, qr, r32, hi); mask_tile(pA0, pA1, 0, vis); partialSM(pA0, pA1, m_reg, mnA, alA);
  SLOAD(SO, KVBLK); if (2 < NT) SLOAD(SE, 2 * KVBLK);
  SWAIT(); SWRITE(1, SO); __syncthreads();
  for (int j = 1; j + 1 < NT; j += 2) {
    SBAR(); qkt(pB0, pB1, (bf16_t*)((char*)K_lds + SHM_K), qr, r32, hi); mask_tile(pB0, pB1, j, vis);
    finishSM(pA0, pA1, alA, l_reg, pa0, pa1, pa2, pa3); SBAR();
    SLOAD(SO, (j + 2) * KVBLK); SBAR();
    pv_d0(o, vb0, pa0, pa1, pa2, pa3); partialSM(pB0, pB1, m_reg, mnB, alB);
    __syncthreads(); SWAIT(); SWRITE(0, SE);
    RESC(alB); __syncthreads();
    SBAR(); qkt(pA0, pA1, K_lds, qr, r32, hi); mask_tile(pA0, pA1, j + 1, vis);
    finishSM(pB0, pB1, alB, l_reg, pa0, pa1, pa2, pa3); SBAR();
    if (j + 3 < NT) SLOAD(SE, (j + 3) * KVBLK); SBAR();
    pv_d0(o, vb0 + (int)SHM_V, pa0, pa1, pa2, pa3); partialSM(pA0, pA1, m_reg, mnA, alA);
    __syncthreads(); SWAIT(); SWRITE(1, SO);
    RESC(alA); __syncthreads();
  }
  SBAR(); qkt(pB0, pB1, (bf16_t*)((char*)K_lds + SHM_K), qr, r32, hi); mask_tile(pB0, pB1, NT - 1, vis);
  finishSM(pA0, pA1, alA, l_reg, pa0, pa1, pa2, pa3); SBAR();
  pv_d0(o, vb0, pa0, pa1, pa2, pa3); partialSM(pB0, pB1, m_reg, mnB, alB);
  __syncthreads(); RESC(alB);
  finishSM(pB0, pB1, alB, l_reg, pa0, pa1, pa2, pa3); SBAR();
  pv_d0(o, vb0 + (int)SHM_V, pa0, pa1, pa2, pa3);
  if (hi == 0) li_l[r32] = l_reg; asm volatile("s_waitcnt lgkmcnt(0)" ::: "memory");
  float rli[16];
#pragma unroll
  for (int r = 0; r < 16; ++r) rli[r] = __builtin_amdgcn_rcpf(li_l[crow(r, hi)]);
  float* Ow = Ob + (long)(wid * QBLK) * DM;
#pragma unroll
  for (int r = 0; r < 16; ++r) { int orow = crow(r, hi);
    for (int d0 = 0; d0 < 4; ++d0) Ow[(long)orow * DM + d0 * 32 + r32] = o[d0][r] * rli[r]; }
  __syncthreads();
#undef SLOAD
#undef SWRITE
#undef SWAIT
#undef RESC
}
#undef KSWZ
#undef SBAR
}

__device__ __forceinline__ void ph_attention(KP P, char* lds) {
    const bf16_t* QKV = P->QKV; float* OC = P->OC;
#pragma unroll 1
    for (int c = bid_(); c < 256; c += gridDim.x) {
        const int combo = c >> 2, b = combo >> 4, h = (combo >> 2) & 3, i = (combo >> 1) & 1, vh = combo & 1;
        const bf16_t* Kh = QKV + (size_t)(b * LL) * QKVW + 1024 + h * 256 + i * 128;
        const bf16_t* Vh = QKV + (size_t)(b * LL) * QKVW + 2048 + h * 256 + vh * 128;
#pragma unroll 1
        for (int s = 0; s < 2; ++s) {
            const int jb = s == 0 ? (c & 3) : 7 - (c & 3);
            const size_t row0 = (size_t)(b * LL) + NMETA + 256 * jb;
            fa::attn_unit(QKV + row0 * QKVW + h * 256 + i * 128, Kh, Vh, OC + row0 * DM + h * 512 + i * 256 + vh * 128, 4 * jb + 6, 4 * jb, lds);
        }
    }
#pragma unroll 1
    for (int gw0 = bid_() * 8; gw0 < 512; gw0 += gridDim.x * 8) {
        const int tid = tid_(), lane = tid & 63, gw = gw0 + (tid >> 6);
        if (gw < 512) {
            const int b = gw >> 7, h = (gw >> 5) & 3, i = (gw >> 4) & 1, row = gw & 15;
            const bf16_t* q = QKV + (size_t)(b * LL + row) * QKVW + h * 256 + i * 128;
            const int key = lane & 15;
            const bf16_t* k = QKV + (size_t)(b * LL + key) * QKVW + 1024 + h * 256 + i * 128;
            float sc = 0.f;
            for (int d = 0; d < 128; ++d) sc = fmaf(bf2f(q[d]), bf2f(k[d]), sc);
            sc *= 0.08838834764831845f;
            float m = sc;
            m = fmaxf(m, swz_xor<8>(m)); m = fmaxf(m, swz_xor<4>(m)); m = fmaxf(m, swz_xor<2>(m)); m = fmaxf(m, swz_xor<1>(m));
            const float e = expf(sc - m);
            float ssum = e;
            ssum += swz_xor<8>(ssum); ssum += swz_xor<4>(ssum); ssum += swz_xor<2>(ssum); ssum += swz_xor<1>(ssum);
            const float p = e / ssum;
            float acc[4] = {0.f, 0.f, 0.f, 0.f};
#pragma unroll
            for (int j = 0; j < 16; ++j) {
                const float pj = __int_as_float(__builtin_amdgcn_readlane(__float_as_int(p), j));
                const bf16_t* v = QKV + (size_t)(b * LL + j) * QKVW + 2048 + h * 256 + lane * 4;
#pragma unroll
                for (int e2 = 0; e2 < 4; ++e2) acc[e2] = fmaf(pj, bf2f(v[e2]), acc[e2]);
            }
            float* o = OC + (size_t)(b * LL + row) * DM + h * 512 + i * 256 + lane * 4;
            o[0] = acc[0]; o[1] = acc[1]; o[2] = acc[2]; o[3] = acc[3];
        }
    }
}


namespace hg {
using bf16x8 = __attribute__((ext_vector_type(8))) short;
using s16x4  = __attribute__((ext_vector_type(4))) short;
using f32x16 = __attribute__((ext_vector_type(16))) float;
using u32x4  = __attribute__((ext_vector_type(4))) unsigned;
constexpr int NCH = 33, NU = 16 * NCH;
constexpr int SK = 136;
constexpr int SS = 72;
__device__ __forceinline__ int crow(int r, int hi) { return (r & 3) + 8 * (r >> 2) + 4 * hi; }
__device__ __forceinline__ unsigned cvtpk(float lo, float hi) { unsigned r; asm volatile("v_cvt_pk_bf16_f32 %0, %1, %2" : "=v"(r) : "v"(lo), "v"(hi)); return r; }

__device__ __forceinline__ void prep(const float* PA, const float* lbtab, size_t row0, int c, int h, int k, int tq, float* qsum, float (&b)[16], float (&kk)[16], float& bend, float& r) {
    const float lbv = lbtab[h * 128 + k];
    float run = 0.f;
#pragma unroll
    for (int i = 0; i < 16; ++i) {
        const int t = 16 * tq + i; const bool valid = (c * 64 + t) < LL;
        const float fp = valid ? PA[(row0 + t) * PAW + 512 + h * 128 + k] : 0.f;
        const float kv = valid ? (1.f - lbv) / (1.f + __expf(fp)) : 0.f;
        kk[i] = kv; run += fmaxf(log1pf(-kv), -30.f); b[i] = run;
    }
    qsum[tq * 128 + k] = run;
    __syncthreads();
    const float q0 = qsum[k], q1 = qsum[128 + k], q2 = qsum[256 + k], q3 = qsum[384 + k];
    const float off = tq == 0 ? 0.f : (tq == 1 ? q0 : (tq == 2 ? q0 + q1 : q0 + q1 + q2));
    r = q0 + q1; bend = (q0 + q1) + (q2 + q3);
#pragma unroll
    for (int i = 0; i < 16; ++i) b[i] += off;
}
__device__ __forceinline__ void store16(bf16_t* dst, const float (&x)[16]) {
    u32x4 w0, w1;
    w0.x = cvtpk(x[0], x[1]); w0.y = cvtpk(x[2], x[3]); w0.z = cvtpk(x[4], x[5]); w0.w = cvtpk(x[6], x[7]);
    w1.x = cvtpk(x[8], x[9]); w1.y = cvtpk(x[10], x[11]); w1.z = cvtpk(x[12], x[13]); w1.w = cvtpk(x[14], x[15]);
    *(u32x4*)dst = w0; *(u32x4*)(dst + 8) = w1;
}

__device__ __forceinline__ void local_states(KP P, char* lds, int layer) {
    bf16_t* KhT = (bf16_t*)lds; bf16_t* VT = KhT + 128 * SS; float* qsum = (float*)(VT + 128 * SS);
    const float* PA = P->PA; const float* lbtab = P->lbtab + layer * 512; float* SLOC = P->SLOC; float* DEC = P->DEC;
    const int tid = tid_(), k = tid & 127, tq = tid >> 7, lane = tid & 63, wid = tid >> 6, r32 = lane & 31, hh = lane >> 5;
    for (int u = bid_(); u < NU; u += gridDim.x) {
        const int bh = u / NCH, c = u % NCH, b_ = bh >> 2, h = bh & 3; const size_t row0 = (size_t)b_ * LL + c * 64;
        float b[16], kk[16], bend, r;
        prep(PA, lbtab, row0, c, h, k, tq, qsum, b, kk, bend, r);
        float x[16];
#pragma unroll
        for (int i = 0; i < 16; ++i) x[i] = kk[i] * __expf(bend - b[i]);
        store16(KhT + k * SS + 16 * tq, x);
#pragma unroll
        for (int i = 0; i < 16; ++i) { const int t = 16 * tq + i; x[i] = (c * 64 + t) < LL ? PA[(row0 + t) * PAW + 1024 + h * 128 + k] : 0.f; }
        store16(VT + k * SS + 16 * tq, x);
        if (tq == 0) DEC[u * 128 + k] = __expf(bend);
        __syncthreads();
        const int vt = wid >> 1;
#pragma unroll
        for (int j = 0; j < 2; ++j) {
            const int kt = (wid & 1) * 2 + j;
            f32x16 acc = {};
#pragma unroll
            for (int sg = 0; sg < 4; ++sg) {
                const bf16x8 a = *(const bf16x8*)(VT + (vt * 32 + r32) * SS + sg * 16 + hh * 8);
                const bf16x8 bb = *(const bf16x8*)(KhT + (kt * 32 + r32) * SS + sg * 16 + hh * 8);
                acc = __builtin_amdgcn_mfma_f32_32x32x16_bf16(a, bb, acc, 0, 0, 0);
            }
            float* o = SLOC + (size_t)u * 16384 + kt * 32 + r32;
#pragma unroll
            for (int rg = 0; rg < 16; ++rg) o[(vt * 32 + crow(rg, hh)) * 128] = acc[rg];
        }
        __syncthreads();
    }
}
__device__ __forceinline__ void scan_states(KP P) {
    const float* SLOC = P->SLOC; const float* DEC = P->DEC; bf16_t* SPREV = P->SPREV;
    const int tid = tid_();
    for (int e = bid_() * NTHR + tid; e < 16 * 16384; e += gridDim.x * NTHR) {
        const int bh = e >> 14, vk = e & 16383, k = vk & 127;
        float d[NCH - 1], x[NCH - 1];
#pragma unroll
        for (int c = 0; c < NCH - 1; ++c) { const int u = bh * NCH + c; d[c] = DEC[u * 128 + k]; x[c] = SLOC[(size_t)u * 16384 + vk]; }
        float S = 0.f;
#pragma unroll
        for (int c = 0; c < NCH - 1; ++c) { S = fmaf(d[c], S, x[c]); SPREV[(size_t)(bh * NCH + c + 1) * 16384 + vk] = f2bf(S); }
    }
}
__device__ __forceinline__ void outputs(KP P, char* lds, int layer) {
    bf16_t* Qt = (bf16_t*)lds; bf16_t* Qh = Qt + 64 * SK; bf16_t* Kt = Qh + 64 * SK; bf16_t* VT = Kt + 64 * SK; bf16_t* SpT = VT + 128 * SS;
    float* qsum = (float*)(SpT + 128 * SK); float* part = qsum + 512;
    const float* PA = P->PA; const float* lbtab = P->lbtab + layer * 512; const bf16_t* SPREV = P->SPREV; const float* nw = P->hnw + layer * 128; bf16_t* MIX = P->MIX;
    const int tid = tid_(), k = tid & 127, tq = tid >> 7, lane = tid & 63, wid = tid >> 6, r32 = lane & 31, hh = lane >> 5;
    for (int u = bid_(); u < NU; u += gridDim.x) {
        const int bh = u / NCH, c = u % NCH, b_ = bh >> 2, h = bh & 3; const size_t row0 = (size_t)b_ * LL + c * 64;
        float b[16], kk[16], bend, r;
        prep(PA, lbtab, row0, c, h, k, tq, qsum, b, kk, bend, r);
#pragma unroll
        for (int i = 0; i < 16; ++i) { const int t = 16 * tq + i; const bool valid = (c * 64 + t) < LL;
            const float q = valid ? PA[(row0 + t) * PAW + h * 128 + k] : 0.f;
            Qt[t * SK + k] = f2bf(q * __expf(b[i] - r)); Qh[t * SK + k] = f2bf(q * __expf(b[i])); Kt[t * SK + k] = f2bf(kk[i] * __expf(r - b[i])); }
        { float x[16];
#pragma unroll
          for (int i = 0; i < 16; ++i) { const int t = 16 * tq + i; x[i] = (c * 64 + t) < LL ? PA[(row0 + t) * PAW + 1024 + h * 128 + k] : 0.f; }
          store16(VT + k * SS + 16 * tq, x); }
        if (c > 0) {
#pragma unroll
            for (int j = 0; j < 4; ++j) { const int idx = tid + 512 * j, v = idx >> 4, ch = idx & 15;
                *(u32x4*)(SpT + v * SK + ch * 8) = *(const u32x4*)(SPREV + (size_t)u * 16384 + v * 128 + ch * 8); }
        }
        __syncthreads();
        const int tt = wid & 1, vt = wid >> 1;
        f32x16 oacc = {};
#pragma unroll
        for (int st = 0; st < 2; ++st) {
            if (st <= tt) {
                f32x16 sc = {};
#pragma unroll
                for (int d0 = 0; d0 < 8; ++d0) {
                    const bf16x8 a = *(const bf16x8*)(Kt + (st * 32 + r32) * SK + d0 * 16 + hh * 8);
                    const bf16x8 bq = *(const bf16x8*)(Qt + (tt * 32 + r32) * SK + d0 * 16 + hh * 8);
                    sc = __builtin_amdgcn_mfma_f32_32x32x16_bf16(a, bq, sc, 0, 0, 0);
                }
                if (st == tt) {
#pragma unroll
                    for (int rg = 0; rg < 16; ++rg) sc[rg] = (crow(rg, hh) <= r32) ? sc[rg] : 0.f;
                }
#pragma unroll
                for (int g = 0; g < 2; ++g) {
                    u32x4 w; w.x = cvtpk(sc[8 * g + 0], sc[8 * g + 1]); w.y = cvtpk(sc[8 * g + 2], sc[8 * g + 3]); w.z = cvtpk(sc[8 * g + 4], sc[8 * g + 5]); w.w = cvtpk(sc[8 * g + 6], sc[8 * g + 7]);
                    const bf16x8 pb = *reinterpret_cast<bf16x8*>(&w);
                    const bf16_t* vp = VT + (vt * 32 + r32) * SS + st * 32 + 16 * g + 4 * hh;
                    const s16x4 lo = *(const s16x4*)vp, hi4 = *(const s16x4*)(vp + 8);
                    const bf16x8 a = (bf16x8){lo[0], lo[1], lo[2], lo[3], hi4[0], hi4[1], hi4[2], hi4[3]};
                    oacc = __builtin_amdgcn_mfma_f32_32x32x16_bf16(a, pb, oacc, 0, 0, 0);
                }
            }
        }
        if (c > 0) {
#pragma unroll
            for (int d0 = 0; d0 < 8; ++d0) {
                const bf16x8 a = *(const bf16x8*)(SpT + (vt * 32 + r32) * SK + d0 * 16 + hh * 8);
                const bf16x8 bq = *(const bf16x8*)(Qh + (tt * 32 + r32) * SK + d0 * 16 + hh * 8);
                oacc = __builtin_amdgcn_mfma_f32_32x32x16_bf16(a, bq, oacc, 0, 0, 0);
            }
        }
        float ss = 0.f;
#pragma unroll
        for (int rg = 0; rg < 16; ++rg) ss = fmaf(oacc[rg], oacc[rg], ss);
        { auto rr = __builtin_amdgcn_permlane32_swap(__float_as_uint(ss), __float_as_uint(ss), false, false); ss = __uint_as_float(rr[0]) + __uint_as_float(rr[1]); }
        if (hh == 0) part[vt * 64 + tt * 32 + r32] = ss;
        __syncthreads();
        const int t = tt * 32 + r32;
        const float tot = (part[t] + part[64 + t]) + (part[128 + t] + part[192 + t]);
        const float scale = rsqrtf(tot * (1.f / 128.f) + EPS);
        if ((c * 64 + t) < LL) {
            const float* gp = PA + (row0 + t) * PAW + 1536 + h * 128 + vt * 32;
            bf16_t* op = MIX + (row0 + t) * DM + h * 128 + vt * 32;
#pragma unroll
            for (int g4 = 0; g4 < 4; ++g4) {
                const int v0 = 8 * g4 + 4 * hh;
                const float4 gv = *(const float4*)(gp + v0); const float4 wv = *(const float4*)(nw + vt * 32 + v0);
                const float y0 = oacc[4 * g4 + 0] * scale * wv.x * gv.x / (1.f + __expf(-gv.x)), y1 = oacc[4 * g4 + 1] * scale * wv.y * gv.y / (1.f + __expf(-gv.y));
                const float y2 = oacc[4 * g4 + 2] * scale * wv.z * gv.z / (1.f + __expf(-gv.z)), y3 = oacc[4 * g4 + 3] * scale * wv.w * gv.w / (1.f + __expf(-gv.w));
                uint2 w; w.x = cvtpk(y0, y1); w.y = cvtpk(y2, y3);
                *(uint2*)(op + v0) = w;
            }
        }
        __syncthreads();
    }
}
}


namespace moe {
using bf16x8 = __attribute__((ext_vector_type(8))) short;
using f32x16 = __attribute__((ext_vector_type(16))) float;
using u32x4  = __attribute__((ext_vector_type(4))) unsigned;
constexpr int TW = 5, PROWS = 64 * TW, XS = 144, XBUF = PROWS * XS;
__device__ __forceinline__ unsigned cvtpk(float lo, float hi) { unsigned r; asm volatile("v_cvt_pk_bf16_f32 %0, %1, %2" : "=v"(r) : "v"(lo), "v"(hi)); return r; }
#define MOE_BAR() asm volatile("s_waitcnt lgkmcnt(0)\n\ts_barrier" ::: "memory")
constexpr int WD = 2;
constexpr int ABUF = 4 * 4 * 1024, AOFF = 2 * XBUF, LOFF = AOFF + 2 * ABUF;
template <bool UP>
__device__ __forceinline__ void stream_gemm(KP P, char* lds, int layer) {
    constexpr int KTOT = UP ? DM : DE, NSLAB = KTOT / 64, NCP = UP ? 2 : 4, LDW = UP ? DE : DM;
    static_assert(NSLAB % WD == 0 && NSLAB >= 2 * WD, "slab loop is unrolled by WD");
    const int tid = tid_(), lane = tid & 63, wid = tid >> 6, r32 = lane & 31, hh = lane >> 5, cg = wid & 3, th = wid >> 2;
    const int* cnt_ = P->cnt;
    const bf16_t* X = UP ? P->HN : P->H;
    int* basel = (int*)(lds + LOFF); int* tlist = basel + 64;
    for (int ub = bid_(); ub < 256; ub += gridDim.x) {
        const int u = ((ub & 7) << 5) | (ub >> 3);
        const int e = u >> 2, ns = u & 3;
        const int rot = ((u >> 2) * 11) & (NSLAB - 1);
        __syncthreads();
        if (tid < 64) basel[64 + 320 + tid] = cnt_[tid * CSTR];
        __syncthreads();
        if (tid < 64) { int a = 0; for (int q = 0; q < tid; ++q) a += basel[64 + 320 + q]; basel[tid] = a; }
        __syncthreads();
        const int cnt = cnt_[e * CSTR], row0 = basel[e];
        for (int pass0 = 0; pass0 < cnt; pass0 += PROWS) {
            const int cntp = (cnt - pass0) < PROWS ? (cnt - pass0) : PROWS;
            if constexpr (UP) { if (cnt <= ECAP) {
                __syncthreads();
                if (tid < PROWS && pass0 + tid < cnt) tlist[tid] = P->elist[e * ECAP + pass0 + tid];
                __syncthreads();
              } else {
                __syncthreads();
                const int* ridx = P->ridx; const int* rslot = P->rslot;
#pragma unroll 1
                for (int i0 = tid; i0 < NASSIGN; i0 += NTHR * 8) {
                    int ex[8], sl[8];
#pragma unroll
                    for (int q = 0; q < 8; ++q) { const int i = i0 + NTHR * q; ex[q] = i < NASSIGN ? ridx[i] : -1; sl[q] = i < NASSIGN ? rslot[i] : 0; }
#pragma unroll
                    for (int q = 0; q < 8; ++q) { const int sp = sl[q] - pass0; if (ex[q] == e && sp >= 0 && sp < PROWS) tlist[sp] = (i0 + NTHR * q) >> 1; }
                }
                __syncthreads();
            } }
            int xoff[5];
#pragma unroll
            for (int j = 0; j < 5; ++j) { int rho = (tid >> 3) + 64 * j; rho = rho < cntp ? rho : cntp - 1; const int grow = row0 + pass0 + rho;
                xoff[j] = (UP ? tlist[rho] * DM : grow * DE) + (tid & 7) * 8; }
            char* const xw = lds + (tid >> 3) * XS + (tid & 7) * 16;
            char* const aw = lds + AOFF + (cg * 4 + 2 * th) * 1024 + lane * 16;
            const char* const ar = lds + AOFF + cg * 4 * 1024 + lane * 16;
#pragma unroll 1
            for (int cp = 0; cp < NCP; ++cp) {
                const int cgi = cp * 4 + cg;
                const int kkw = wid >> 1, half = wid & 1;
                const float* wp;
                if constexpr (UP) wp = (r32 < 16 ? P->w1 : P->w3) + ((size_t)(layer * NE + e) * DM + kkw * 16 + 8 * hh + 4 * half) * DE + ns * 128 + cp * 64 + 4 * (r32 & 15);
                else wp = P->w2 + ((size_t)(layer * NE + e) * DE + 32 * hh + 2 * th) * DM + ns * 512 + cgi * 32 + r32;
                f32x16 acc[TW];
#pragma unroll
                for (int tl = 0; tl < TW; ++tl) acc[tl] = f32x16{};
                float wreg[WD][16]; u32x4 xs[5];
#define MOE_WLD1(wn_, R, li) do { if constexpr (UP) { if ((li) < 4) { const float4 t_ = *(const float4*)((wn_) + (size_t)(li) * DE); wreg[R][4 * (li)] = t_.x; wreg[R][4 * (li) + 1] = t_.y; wreg[R][4 * (li) + 2] = t_.z; wreg[R][4 * (li) + 3] = t_.w; } } \
                    else { if ((li) < 16) wreg[R][li] = (wn_)[(size_t)(((li) >> 3) + 4 * ((li) & 7)) * DM]; } } while (0)
#define MOE_WLOAD(slab, R) do { const float* wn_ = wp + (size_t)(((slab) + rot) & (NSLAB - 1)) * 64 * LDW; \
                    _Pragma("unroll") for (int li = 0; li < 16; ++li) MOE_WLD1(wn_, R, li); } while (0)
#define MOE_WPARK(R, PAR) do { if constexpr (UP) { _Pragma("unroll") for (int q = 0; q < 4; ++q) { uint2 fw; fw.x = cvtpk(wreg[R][q], wreg[R][4 + q]); fw.y = cvtpk(wreg[R][8 + q], wreg[R][12 + q]); \
                            *(uint2*)(lds + AOFF + (PAR) * ABUF + (q * 4 + kkw) * 1024 + lane * 16 + half * 8) = fw; } } \
                    else { _Pragma("unroll") for (int i = 0; i < 2; ++i) { u32x4 fw; fw.x = cvtpk(wreg[R][8 * i + 0], wreg[R][8 * i + 1]); fw.y = cvtpk(wreg[R][8 * i + 2], wreg[R][8 * i + 3]); \
                            fw.z = cvtpk(wreg[R][8 * i + 4], wreg[R][8 * i + 5]); fw.w = cvtpk(wreg[R][8 * i + 6], wreg[R][8 * i + 7]); *(u32x4*)(aw + (PAR) * ABUF + i * 1024) = fw; } } } while (0)
#pragma unroll
                for (int j = 0; j < 5; ++j) xs[j] = *(const u32x4*)(X + xoff[j] + (rot & (NSLAB - 1)) * 64);
                MOE_WLOAD(0, 0); MOE_WLOAD(1, 1);
#pragma unroll
                for (int j = 0; j < 5; ++j) *(u32x4*)(xw + 64 * j * XS) = xs[j];
                MOE_WPARK(0, 0); MOE_WLOAD(2, 0);
                MOE_BAR();
#define MOE_SLAB(s, PAR, R1) do { \
                    const int sx = ((s) + 1) < NSLAB ? (s) + 1 : NSLAB - 1, sw = ((s) + 1 + WD) < NSLAB ? (s) + 1 + WD : NSLAB - 1;     \
                    { const bf16_t* xn0_ = X + ((sx + rot) & (NSLAB - 1)) * 64; _Pragma("unroll") for (int j = 0; j < 5; ++j) xs[j] = *(const u32x4*)(xn0_ + xoff[j]); } \
                    MOE_WPARK(R1, 1 - (PAR)); \
                    const float* wn_ = wp + (size_t)((sw + rot) & (NSLAB - 1)) * 64 * LDW; \
                    const char* xb = lds + (PAR) * XBUF + (th * TW * 32 + r32) * XS + hh * 16; \
                    bf16x8 xq[4]; bf16x8 fq[2];                                                       \
                    xq[0] = *(const bf16x8*)(xb); xq[1] = *(const bf16x8*)(xb + 32 * XS); xq[2] = *(const bf16x8*)(xb + 64 * XS); \
                    fq[0] = *(const bf16x8*)(ar + (PAR) * ABUF); \
                    _Pragma("unroll") for (int kk = 0; kk < 4; ++kk) { \
                        if (kk < 3) fq[(kk + 1) & 1] = *(const bf16x8*)(ar + (PAR) * ABUF + (kk + 1) * 1024); \
                        _Pragma("unroll") for (int tl = 0; tl < TW; ++tl) { \
                            const int cur = kk * TW + tl, nx = cur + 3, nkk = nx / TW, ntl = nx % TW;       \
                            if (nx < 4 * TW) xq[nx & 3] = *(const bf16x8*)(xb + ntl * 32 * XS + nkk * 32); \
                            acc[tl] = __builtin_amdgcn_mfma_f32_32x32x16_bf16(fq[kk & 1], xq[cur & 3], acc[tl], 0, 0, 0); \
                            const int li = kk * TW + tl; \
                            MOE_WLD1(wn_, R1, li); \
                            __builtin_amdgcn_sched_barrier(0); } } \
                    _Pragma("unroll") for (int j = 0; j < 5; ++j) *(u32x4*)(xw + (1 - (PAR)) * XBUF + 64 * j * XS) = xs[j]; \
                    MOE_BAR(); } while (0)
#pragma unroll 1
                for (int s = 0; s < NSLAB; s += 2) { MOE_SLAB(s, 0, 1); MOE_SLAB(s + 1, 1, 0); }
#undef MOE_SLAB
#undef MOE_WLOAD
#undef MOE_WLD1
#undef MOE_WPARK
                const int T = (cntp + 31) >> 5;
                const int Tw = (T - TW * th) < 0 ? 0 : ((T - TW * th) > TW ? TW : (T - TW * th));
#pragma unroll
                for (int tl = 0; tl < TW; ++tl) if (tl < Tw) {
                    const int rho = (th * TW + tl) * 32 + r32;
                    if (rho < cntp) {
                        const size_t grow = (size_t)(row0 + pass0 + rho);
                        if constexpr (UP) {
                            bf16_t* hp = P->H + grow * DE + ns * 128 + cgi * 16 + 4 * hh;
#pragma unroll
                            for (int g = 0; g < 2; ++g) {
                                float y[4];
#pragma unroll
                                for (int q = 0; q < 4; ++q) { const float a = acc[tl][4 * g + q], b = acc[tl][8 + 4 * g + q]; y[q] = a / (1.f + __expf(-a)) * b; }
                                uint2 w; w.x = cvtpk(y[0], y[1]); w.y = cvtpk(y[2], y[3]);
                                *(uint2*)(hp + 8 * g) = w;
                            }
                        } else {
                            bf16_t* yp = P->Y + grow * DM + ns * 512 + cgi * 32 + 4 * hh;
#pragma unroll
                            for (int g = 0; g < 4; ++g) {
                                uint2 w; w.x = cvtpk(acc[tl][4 * g + 0], acc[tl][4 * g + 1]); w.y = cvtpk(acc[tl][4 * g + 2], acc[tl][4 * g + 3]);
                                *(uint2*)(yp + 8 * g) = w;
                            }
                        }
                    }
                }
            }
        }
    }
}
#undef MOE_BAR
}


namespace s5 {
using bf16x8 = __attribute__((ext_vector_type(8))) short;
using f32x16 = __attribute__((ext_vector_type(16))) float;
using u32x4  = __attribute__((ext_vector_type(4))) unsigned;
constexpr int NCHK = 516, NMT = 17;
__device__ __forceinline__ unsigned cvtpk(float lo, float hi) { unsigned r; asm volatile("v_cvt_pk_bf16_f32 %0, %1, %2" : "=v"(r) : "v"(lo), "v"(hi)); return r; }
__device__ __forceinline__ bf16x8 ld8f(const float* p) {
    const float4 a = *(const float4*)p, b = *(const float4*)(p + 4);
    u32x4 w; w.x = cvtpk(a.x, a.y); w.y = cvtpk(a.z, a.w); w.z = cvtpk(b.x, b.y); w.w = cvtpk(b.z, b.w);
    return *reinterpret_cast<bf16x8*>(&w);
}
__device__ __forceinline__ void prep_unit(KP P, char* lds, int layer, int g) {
    float2* pw = (float2*)lds; float2* bb = pw + 17 * 64; float2* cc = bb + 1024; float* kd = (float*)(cc + 1024);
    const int tid = tid_();
    const float dt = expf(P->log_dt[layer * 32 + g]);
    const float* a_re = P->a_re + (layer * 32 + g) * 64; const float* a_im = P->a_im + (layer * 32 + g) * 64;
    for (int idx = tid; idx < 17 * 64; idx += NTHR) { const int d = idx >> 6, p = idx & 63;
        const float mag = expf(a_re[p] * dt * (float)d), ang = a_im[p] * dt * (float)d; pw[idx] = make_float2(mag * cosf(ang), mag * sinf(ang)); }
    for (int idx = tid; idx < 1024; idx += NTHR) {
        { const int p = idx >> 4, c = idx & 15; const float are = a_re[p], aim = a_im[p];
          const float mag = expf(are * dt), abr = mag * cosf(aim * dt), abi = mag * sinf(aim * dt), den = are * are + aim * aim;
          const float zr = ((abr - 1.f) * are + abi * aim) / den, zi = (abi * are - (abr - 1.f) * aim) / den;
          const float br = P->b_re[((layer * 32 + g) * 64 + p) * 16 + c], bi = P->b_im[((layer * 32 + g) * 64 + p) * 16 + c];
          bb[idx] = make_float2(zr * br - zi * bi, zr * bi + zi * br); }
        { const int c = idx >> 6, p = idx & 63; cc[idx] = make_float2(P->c_re[((layer * 32 + g) * 16 + c) * 64 + p], P->c_im[((layer * 32 + g) * 16 + c) * 64 + p]); }
    }
    __syncthreads();
    if (tid < 64) ((float2*)P->A16)[(layer * 32 + g) * 64 + tid] = pw[16 * 64 + tid];
    for (int idx = tid; idx < 4096; idx += NTHR) { const int d = idx >> 8, c = (idx >> 4) & 15, c2 = idx & 15;
        float acc = 0.f;
        for (int p = 0; p < 64; ++p) { const float2 C = cc[c * 64 + p], W = pw[d * 64 + p], B = bb[p * 16 + c2];
            const float xr = C.x * W.x - C.y * W.y, xi = C.x * W.y + C.y * W.x; acc += xr * B.x - xi * B.y; }
        if (d == 0 && c == c2) acc += P->s5d[layer * 512 + g * 16 + c];
        kd[idx] = acc; }
    __syncthreads();
    bf16_t* BtY = P->BtY + (size_t)(layer * 32 + g) * 256 * 384; bf16_t* BtE = P->BtE + (size_t)(layer * 32 + g) * 128 * 256;
    for (int idx = tid; idx < 256 * 48; idx += NTHR) { const int n = idx / 48, ch = idx % 48, t = n >> 4, c = n & 15;
        float v[8];
        if (ch < 32) { const int s = ch >> 1, c0 = (ch & 1) * 8;
#pragma unroll
            for (int jj = 0; jj < 8; ++jj) v[jj] = (s <= t) ? kd[((t - s) * 16 + c) * 16 + c0 + jj] : 0.f;
        } else {
#pragma unroll
            for (int jj = 0; jj < 8; ++jj) { const int kq = (ch - 32) * 8 + jj, p = kq >> 1; const float2 C = cc[c * 64 + p], W = pw[(t + 1) * 64 + p];
                v[jj] = (kq & 1) ? -(C.x * W.y + C.y * W.x) : (C.x * W.x - C.y * W.y); }
        }
        u32x4 w; w.x = cvtpk(v[0], v[1]); w.y = cvtpk(v[2], v[3]); w.z = cvtpk(v[4], v[5]); w.w = cvtpk(v[6], v[7]);
        *(u32x4*)(BtY + ((size_t)(((n >> 5) * 24 + (ch >> 1)) * 64 + (ch & 1) * 32 + (n & 31))) * 8) = w; }
    for (int idx = tid; idx < 128 * 32; idx += NTHR) { const int n = idx >> 5, ch = idx & 31, p = n >> 1, s = ch >> 1, c0 = (ch & 1) * 8;
        const float2 W = pw[(15 - s) * 64 + p];
        float v[8];
#pragma unroll
        for (int jj = 0; jj < 8; ++jj) { const float2 B = bb[p * 16 + c0 + jj]; v[jj] = (n & 1) ? (W.x * B.y + W.y * B.x) : (W.x * B.x - W.y * B.y); }
        u32x4 w; w.x = cvtpk(v[0], v[1]); w.y = cvtpk(v[2], v[3]); w.z = cvtpk(v[4], v[5]); w.w = cvtpk(v[6], v[7]);
        *(u32x4*)(BtE + ((size_t)(((n >> 5) * 16 + (ch >> 1)) * 64 + (ch & 1) * 32 + (n & 31))) * 8) = w; }
    __syncthreads();
}
__device__ __forceinline__ float gelu_t(float x) { const float u = 0.7978845608028654f * (x + 0.044715f * x * x * x); const float e = __expf(2.f * u); return x - x / (e + 1.f); }
__device__ __forceinline__ void fused_unit(KP P, char* lds, int layer, int b, int g) {
    const int tid = tid_(), lane = tid & 63, wid = tid >> 6, r32 = lane & 31, hh = lane >> 5;
    constexpr int UCH = 528, UBYTES = 68352;
    char* U16 = lds; float* El = (float*)(lds + UBYTES);
    const float* PA = P->PA; bf16_t* YG = P->YG;
    { const float* ub = PA + (size_t)(b * LL) * PAW + 2048 + g * 16;
#pragma unroll 1
      for (int i0 = 0; i0 < LL * 4; i0 += NTHR * 4) {
          float4 v[4];
#pragma unroll
          for (int q = 0; q < 4; ++q) { const int idx = i0 + q * NTHR + tid, ic = idx < LL * 4 ? idx : LL * 4 - 1; v[q] = *(const float4*)(ub + (size_t)(ic >> 2) * PAW + (ic & 3) * 4); }
#pragma unroll
          for (int q = 0; q < 4; ++q) { const int idx = i0 + q * NTHR + tid; if (idx < LL * 4) { const int r = idx >> 2;
              uint2 w; w.x = cvtpk(v[q].x, v[q].y); w.y = cvtpk(v[q].z, v[q].w); *(uint2*)(U16 + (r >> 4) * UCH + (r & 15) * 32 + (idx & 3) * 8) = w; } }
      } }
    __syncthreads();
    const int ml = wid * 32 + r32, mlc = ml < 129 ? ml : 128;
    const char* uq = U16 + mlc * UCH + hh * 16;
    if (wid < 5) {
        const bf16_t* Bt = P->BtE + (size_t)(layer * 32 + g) * 128 * 256 + (size_t)lane * 8;
        f32x16 acc[4];
#pragma unroll
        for (int nt = 0; nt < 4; ++nt) acc[nt] = f32x16{};
#pragma unroll 4
        for (int s = 0; s < 16; ++s) {
            const bf16x8 bf = *(const bf16x8*)(uq + 32 * s);
#pragma unroll
            for (int nt = 0; nt < 4; ++nt) { const bf16x8 af = *(const bf16x8*)(Bt + (size_t)((nt * 16 + s) * 64) * 8); acc[nt] = __builtin_amdgcn_mfma_f32_32x32x16_bf16(af, bf, acc[nt], 0, 0, 0); }
        }
        if (ml < 129) { float* ep = El + ml * 128 + 4 * hh;
#pragma unroll
            for (int nt = 0; nt < 4; ++nt)
#pragma unroll
                for (int q = 0; q < 4; ++q) *(float4*)(ep + nt * 32 + 8 * q) = make_float4(acc[nt][4 * q], acc[nt][4 * q + 1], acc[nt][4 * q + 2], acc[nt][4 * q + 3]); }
    }
    __syncthreads();
    if (tid < 64) {
        const float2 A = ((const float2*)P->A16)[(layer * 32 + g) * 64 + tid];
        float2* e2 = (float2*)El + tid;
        float xr = 0.f, xi = 0.f;
#pragma unroll 1
        for (int j0 = 0; j0 < 128; j0 += 8) {
            float2 e[8];
#pragma unroll
            for (int i = 0; i < 8; ++i) e[i] = e2[(j0 + i) * 64];
#pragma unroll
            for (int i = 0; i < 8; ++i) { e2[(j0 + i) * 64] = make_float2(xr, xi);
                const float nr = A.x * xr - A.y * xi + e[i].x, ni = A.x * xi + A.y * xr + e[i].y; xr = nr; xi = ni; }
        }
        e2[128 * 64] = make_float2(xr, xi);
    }
    __syncthreads();
    if (wid < 5) {
        const bf16_t* Bt = P->BtY + (size_t)(layer * 32 + g) * 256 * 384 + (size_t)lane * 8;
        const float* xp = El + mlc * 128 + 8 * hh;
        f32x16 acc[8];
#pragma unroll
        for (int nt = 0; nt < 8; ++nt) acc[nt] = f32x16{};
#pragma unroll
        for (int s = 0; s < 16; ++s) {
            const bf16x8 bf = *(const bf16x8*)(uq + 32 * s);
#pragma unroll
            for (int nt = 0; nt < 8; ++nt) if (2 * nt + 1 >= s) { const bf16x8 af = *(const bf16x8*)(Bt + (size_t)((nt * 24 + s) * 64) * 8); acc[nt] = __builtin_amdgcn_mfma_f32_32x32x16_bf16(af, bf, acc[nt], 0, 0, 0); }
        }
#pragma unroll
        for (int ks = 0; ks < 8; ++ks) {
            const bf16x8 bf = ld8f(xp + ks * 16);
#pragma unroll
            for (int nt = 0; nt < 8; ++nt) { const bf16x8 af = *(const bf16x8*)(Bt + (size_t)((nt * 24 + 16 + ks) * 64) * 8); acc[nt] = __builtin_amdgcn_mfma_f32_32x32x16_bf16(af, bf, acc[nt], 0, 0, 0); }
        }
        if (ml < 129) { const int m = b * 129 + ml;
#pragma unroll
            for (int nt = 0; nt < 8; ++nt)
#pragma unroll
                for (int q = 0; q < 4; ++q) { const int t = 2 * nt + (q >> 1);
                    uint2 w; w.x = cvtpk(gelu_t(acc[nt][4 * q]), gelu_t(acc[nt][4 * q + 1])); w.y = cvtpk(gelu_t(acc[nt][4 * q + 2]), gelu_t(acc[nt][4 * q + 3]));
                    *(uint2*)(YG + (size_t)(m * 16 + t) * 512 + g * 16 + 8 * (q & 1) + 4 * hh) = w; }
        }
    }
    __syncthreads();
}
}

__device__ __forceinline__ float wave_sum(float v) {
    v += swz_xor<1>(v); v += swz_xor<2>(v); v += swz_xor<4>(v); v += swz_xor<8>(v); v += swz_xor<16>(v);
    { auto rr = __builtin_amdgcn_permlane32_swap(__float_as_uint(v), __float_as_uint(v), false, false); v = __uint_as_float(rr[0]) + __uint_as_float(rr[1]); }
    return v;
}
__device__ __forceinline__ unsigned cvtpk_(float lo, float hi) { unsigned r; asm volatile("v_cvt_pk_bf16_f32 %0, %1, %2" : "=v"(r) : "v"(lo), "v"(hi)); return r; }
__device__ __forceinline__ void ph_attn_out(KP P, int layer, int cu0) {
    const int tid = tid_(), lane = tid & 63, gw = (bid_() - cu0) * 8 + (tid >> 6), NGW = (gridDim.x - cu0) * 8;
    if (gw < 0) return;
    const float scale = 1.f - (0.8f - 0.6f * expf(-0.3f * (float)layer));
    const float lam = P->lam[layer];
    const float4 sw = ((const float4*)(P->subln + layer * 256))[lane];
    const float* OC = P->OC; bf16_t* MIX = P->MIX;
    for (int it0 = gw; it0 < TOK * 4; it0 += NGW * 4) {
        float4 a[4], b[4];
#pragma unroll
        for (int q = 0; q < 4; ++q) { const int it = it0 + NGW * q, itc = it < TOK * 4 ? it : TOK * 4 - 1, r = itc >> 2, h = itc & 3;
            a[q] = *(const float4*)(OC + (size_t)r * DM + h * 512 + lane * 4); b[q] = *(const float4*)(OC + (size_t)r * DM + h * 512 + 256 + lane * 4); }
#pragma unroll
        for (int q = 0; q < 4; ++q) { const int it = it0 + NGW * q; if (it < TOK * 4) { const int r = it >> 2, h = it & 3;
            const float o0 = a[q].x - lam * b[q].x, o1 = a[q].y - lam * b[q].y, o2 = a[q].z - lam * b[q].z, o3 = a[q].w - lam * b[q].w;
            const float ss = wave_sum(o0 * o0 + o1 * o1 + o2 * o2 + o3 * o3);
            const float rs = rsqrtf(ss * (1.f / 256.f) + EPS) * scale;
            uint2 w; w.x = cvtpk_(o0 * rs * sw.x, o1 * rs * sw.y); w.y = cvtpk_(o2 * rs * sw.z, o3 * rs * sw.w);
            *(uint2*)(MIX + (size_t)r * DM + 1024 + h * 256 + lane * 4) = w; } }
    }
}
__device__ __forceinline__ void ph_build_norm(KP P) {
    const int tid = tid_(), lane = tid & 63, gw = bid_() * 8 + (tid >> 6), NGW = gridDim.x * 8;
    for (int r = gw; r < MP; r += NGW) {
        float4 v[8];
        if (r < TOK) { const int b = r / LL, t = r % LL;
            const float4* src = (const float4*)(t < NMETA ? P->meta + (size_t)t * DM : P->x + ((size_t)b * SEQ + (t - NMETA)) * DM);
#pragma unroll
            for (int j = 0; j < 8; ++j) v[j] = src[lane + 64 * j];
        } else {
#pragma unroll
            for (int j = 0; j < 8; ++j) v[j] = make_float4(0.f, 0.f, 0.f, 0.f);
        }
        float ss = 0.f;
#pragma unroll
        for (int j = 0; j < 8; ++j) { ((float4*)(P->Z + (size_t)r * DM))[lane + 64 * j] = v[j]; ss += v[j].x * v[j].x + v[j].y * v[j].y + v[j].z * v[j].z + v[j].w * v[j].w; }
        const float rs = rsqrtf(wave_sum(ss) * (1.f / DM) + EPS);
#pragma unroll
        for (int j = 0; j < 8; ++j) { const float4 w = ((const float4*)P->ln1_w)[lane + 64 * j];
            uint2 o; o.x = cvtpk_(v[j].x * rs * w.x, v[j].y * rs * w.y); o.y = cvtpk_(v[j].z * rs * w.z, v[j].w * rs * w.w);
            ((uint2*)(P->HN + (size_t)r * DM))[lane + 64 * j] = o; }
    }
}
__device__ __forceinline__ void ph_prep(KP P) {
    const int tid = tid_();
    if (bid_() == 0) {
        const int c = tid;
        const float l0 = P->lbnd[c], l1 = P->lbnd[512 + c], m = fmaxf(l0, l1), e0 = expf(l0 - m), e1 = expf(l1 - m);
        P->lbtab[c] = 0.f; P->lbtab[512 + c] = e1 / (e0 + e1);
        if (c < 2) {
            float s1 = 0.f, s2 = 0.f;
            for (int i = 0; i < 128; ++i) { s1 += P->lq1[c * 128 + i] * P->lk1[c * 128 + i]; s2 += P->lq2[c * 128 + i] * P->lk2[c * 128 + i]; }
            const float li = 0.8f - 0.6f * expf(-0.3f * (float)c);
            P->lam[c] = expf(s1) - expf(s2) + li;
        }
    }
    for (int i = bid_() * NTHR + tid; i < 2 * 128 * 3 * 64 * 8; i += gridDim.x * NTHR) {
        const int jj = i & 7, ln = (i >> 3) & 63, ct = (i >> 9) % 3, ksg = ((i >> 9) / 3) & 127, layer = (i >> 9) / (3 * 128);
        const int jc = ct * 32 + (ln & 31), k = ksg * 16 + 8 * (ln >> 5) + jj;
        float v = 0.f;
        if (jc < 8) v = P->wrg[((size_t)layer * DM + k) * 8 + jc]; else if (jc < 72) v = P->wre[((size_t)layer * DM + k) * 64 + jc - 8];
        v *= P->ln2_w[layer * DM + k];
        const bf16_t hi = f2bf(v), lo = f2bf(v - bf2f(hi));
        const size_t o = ((size_t)((ksg * 3 + ct) * 64 + ln)) * 8 + jj;
        P->WRT[(size_t)(layer * 2 + 0) * 96 * DM + o] = hi; P->WRT[(size_t)(layer * 2 + 1) * 96 * DM + o] = lo;
    }
}
namespace rt {
using f32x16 = __attribute__((ext_vector_type(16))) float;
using bf16x8 = __attribute__((ext_vector_type(8))) short;
using u32x4  = __attribute__((ext_vector_type(4))) unsigned;
__device__ __forceinline__ void norm_router(KP P, char* lds, int layer) {
    const int tid = tid_(), lane = tid & 63, wid = tid >> 6, r32 = lane & 31, hh = lane >> 5;
    float* part = (float*)lds;
    float* ssqp = (float*)(lds + 98304);
    float* lg = ssqp + 256;
    float* rsv = lg + 32 * 97;
    const bf16_t* Whi = P->WRT + (size_t)(layer * 2 + 0) * 96 * DM; const bf16_t* Wlo = P->WRT + (size_t)(layer * 2 + 1) * 96 * DM;
    const float* Z = P->Z;
    float* st = (float*)lds + wid * (32 * 68);
    const int nunits = layer == 1 ? (NB * SEQ) / 32 : TOK / 32;
    for (int u = bid_(); u < nunits; u += gridDim.x) {
        const int tok0 = layer == 1 ? (u >> 6) * LL + NMETA + (u & 63) * 32 : u * 32, kb = wid * 256;
        if (false) {
            float* Zw = P->Z; const float* ZP = P->ZP;
            for (int i = tid; i < 32 * DM / 4; i += NTHR) { const int r = i / (DM / 4), c4 = i % (DM / 4);
                float4 z = ((const float4*)(Zw + (size_t)(tok0 + r) * DM))[c4];
#pragma unroll
                for (int ks = 0; ks < 8; ++ks) { const float4 p4 = ((const float4*)(ZP + ((size_t)ks * 256 + (tok0 - 8192 + r)) * DM))[c4]; z.x += p4.x; z.y += p4.y; z.z += p4.z; z.w += p4.w; }
                ((float4*)(Zw + (size_t)(tok0 + r) * DM))[c4] = z; }
            asm volatile("s_waitcnt vmcnt(0)" ::: "memory");
            __syncthreads();
        }
        f32x16 acc[3] = {f32x16{}, f32x16{}, f32x16{}};
        float sq8[8];
#pragma unroll
        for (int j = 0; j < 8; ++j) sq8[j] = 0.f;
        const float* zg = Z + (size_t)(tok0 + (lane >> 4)) * DM + kb + (lane & 15) * 4;
        float4 zs[8];
#pragma unroll
        for (int j = 0; j < 8; ++j) zs[j] = *(const float4*)(zg + (size_t)(4 * j) * DM);
#pragma unroll 1
        for (int sc = 0; sc < 4; ++sc) {
#pragma unroll
            for (int j = 0; j < 8; ++j) { const float4 z = zs[j]; sq8[j] += z.x * z.x + z.y * z.y + z.z * z.z + z.w * z.w;
                *(float4*)(st + ((lane >> 4) + 4 * j) * 68 + (lane & 15) * 4) = z; }
            const int scn = sc < 3 ? sc + 1 : 3;
#pragma unroll
            for (int j = 0; j < 8; ++j) zs[j] = *(const float4*)(zg + (size_t)(4 * j) * DM + scn * 64);
            asm volatile("s_waitcnt lgkmcnt(0)" ::: "memory");
            const bf16_t* wh = Whi + ((size_t)((wid * 16 + sc * 4) * 3) * 64 + lane) * 8; const bf16_t* wl = Wlo + ((size_t)((wid * 16 + sc * 4) * 3) * 64 + lane) * 8;
#pragma unroll
            for (int ks = 0; ks < 4; ++ks) {
                const float4 z0 = *(const float4*)(st + r32 * 68 + ks * 16 + 8 * hh), z1 = *(const float4*)(st + r32 * 68 + ks * 16 + 8 * hh + 4);
                u32x4 h; h.x = cvtpk_(z0.x, z0.y); h.y = cvtpk_(z0.z, z0.w); h.z = cvtpk_(z1.x, z1.y); h.w = cvtpk_(z1.z, z1.w);
                u32x4 l; l.x = cvtpk_(z0.x - __uint_as_float(h.x << 16), z0.y - __uint_as_float(h.x & 0xffff0000u)); l.y = cvtpk_(z0.z - __uint_as_float(h.y << 16), z0.w - __uint_as_float(h.y & 0xffff0000u));
                l.z = cvtpk_(z1.x - __uint_as_float(h.z << 16), z1.y - __uint_as_float(h.z & 0xffff0000u)); l.w = cvtpk_(z1.z - __uint_as_float(h.w << 16), z1.w - __uint_as_float(h.w & 0xffff0000u));
                const bf16x8 zh = *reinterpret_cast<bf16x8*>(&h), zl = *reinterpret_cast<bf16x8*>(&l);
#pragma unroll
                for (int ct = 0; ct < 3; ++ct) {
                    const bf16x8 ah = *(const bf16x8*)(wh + (size_t)((ks * 3 + ct) * 64) * 8), al = *(const bf16x8*)(wl + (size_t)((ks * 3 + ct) * 64) * 8);
                    acc[ct] = __builtin_amdgcn_mfma_f32_32x32x16_bf16(ah, zh, acc[ct], 0, 0, 0);
                    acc[ct] = __builtin_amdgcn_mfma_f32_32x32x16_bf16(ah, zl, acc[ct], 0, 0, 0);
                    acc[ct] = __builtin_amdgcn_mfma_f32_32x32x16_bf16(al, zh, acc[ct], 0, 0, 0);
                }
            }
            asm volatile("s_waitcnt lgkmcnt(0)" ::: "memory");
        }
#pragma unroll
        for (int j = 0; j < 8; ++j) { float v = sq8[j]; v += swz_xor<1>(v); v += swz_xor<2>(v); v += swz_xor<4>(v); v += swz_xor<8>(v); sq8[j] = v; }
        __syncthreads();
        if ((lane & 15) == 0) {
#pragma unroll
            for (int j = 0; j < 8; ++j) ssqp[wid * 32 + (lane >> 4) + 4 * j] = sq8[j];
        }

#pragma unroll
        for (int ct = 0; ct < 3; ++ct)
#pragma unroll
            for (int rg = 0; rg < 16; ++rg) part[((wid * 3 + ct) * 16 + rg) * 64 + lane] = acc[ct][rg];
        __syncthreads();
        if (tid < 32) { float t = 0.f;
#pragma unroll
            for (int w = 0; w < 8; ++w) t += ssqp[w * 32 + tid];
            rsv[tid] = rsqrtf(t * (1.f / DM) + EPS); }
#pragma unroll
        for (int q = 0; q < 6; ++q) { const int o = tid + NTHR * q, col = o >> 5, tok = o & 31, ct = col >> 5, cl = col & 31, h2 = (cl >> 2) & 1, rg = (cl & 3) + 4 * (cl >> 3);
            float t = 0.f;
#pragma unroll
            for (int w = 0; w < 8; ++w) t += part[((w * 3 + ct) * 16 + rg) * 64 + h2 * 32 + tok];
            lg[tok * 97 + col] = t; }
        __syncthreads();
        if (tid < 32) {
            const int t = tok0 + tid; const float rs = rsv[tid]; const float* l = lg + tid * 97;
            const float* brg = P->brg + layer * 8; const float* bre = P->bre + layer * 64;
            float gl[8];
#pragma unroll
            for (int j = 0; j < 8; ++j) gl[j] = l[j] * rs + brg[j];
            int gs = 0; float gm = gl[0];
#pragma unroll
            for (int j = 1; j < 8; ++j) if (gl[j] > gm) { gm = gl[j]; gs = j; }
            float den = 0.f;
#pragma unroll
            for (int j = 0; j < 8; ++j) den += expf(gl[j] - gm);
            const float pg = 1.f / den;
            float el[8];
#pragma unroll
            for (int j = 0; j < 8; ++j) el[j] = l[8 + gs * 8 + j] * rs + bre[gs * 8 + j];
            int j0 = 0; float v0 = el[0];
#pragma unroll
            for (int j = 1; j < 8; ++j) if (el[j] > v0) { v0 = el[j]; j0 = j; }
            int j1 = -1; float v1 = -INFINITY;
#pragma unroll
            for (int j = 0; j < 8; ++j) if (j != j0 && el[j] > v1) { v1 = el[j]; j1 = j; }
            const float e1 = expf(v1 - v0), g0 = pg / (1.f + e1), g1 = pg * e1 / (1.f + e1);
            const int x0 = gs * 8 + j0, x1 = gs * 8 + j1;
            P->ridx[t * 2] = x0; P->ridx[t * 2 + 1] = x1; P->rgate[t * 2] = g0; P->rgate[t * 2 + 1] = g1;
            const int s0 = atomicAdd(&P->cnt[x0 * CSTR], 1), s1 = atomicAdd(&P->cnt[x1 * CSTR], 1);
            P->rslot[t * 2] = s0; P->rslot[t * 2 + 1] = s1;
            if (s0 < ECAP) P->elist[x0 * ECAP + s0] = t; if (s1 < ECAP) P->elist[x1 * ECAP + s1] = t;
        }
#pragma unroll 1
        for (int q = 0; q < 4; q += 2) { const int tk = wid * 4 + q; const float rs0 = rsv[tk], rs1 = rsv[tk + 1];
            const float4* zr = (const float4*)(Z + (size_t)(tok0 + tk) * DM); const float4* wl4 = (const float4*)(P->ln2_w + layer * DM);
            float4 za[8], zb[8];
#pragma unroll
            for (int j = 0; j < 8; ++j) { za[j] = zr[lane + 64 * j]; zb[j] = zr[DM / 4 + lane + 64 * j]; }
#pragma unroll
            for (int j = 0; j < 8; ++j) { const float4 w = wl4[lane + 64 * j];
                uint2 o; o.x = cvtpk_(za[j].x * rs0 * w.x, za[j].y * rs0 * w.y); o.y = cvtpk_(za[j].z * rs0 * w.z, za[j].w * rs0 * w.w);
                ((uint2*)(P->HN + (size_t)(tok0 + tk) * DM))[lane + 64 * j] = o;
                o.x = cvtpk_(zb[j].x * rs1 * w.x, zb[j].y * rs1 * w.y); o.y = cvtpk_(zb[j].z * rs1 * w.z, zb[j].w * rs1 * w.w);
                ((uint2*)(P->HN + (size_t)(tok0 + tk + 1) * DM))[lane + 64 * j] = o; } }
        __syncthreads();
    }
}
}
__device__ __forceinline__ void ph_combine_norm(KP P, char* lds, int layer) {
    int* base = (int*)lds;
    const int tid = tid_(), lane = tid & 63, gw = bid_() * 8 + (tid >> 6), NGW = gridDim.x * 8;
    if (tid < 64) base[64 + tid] = P->cnt[tid * CSTR];
    __syncthreads();
    if (tid < 64) { int a = 0; for (int q = 0; q < tid; ++q) a += base[64 + q]; base[tid] = a; }
    __syncthreads();
    for (int t0 = gw; t0 < TOK; t0 += 2 * NGW) {
        int r0[2], r1[2]; float g0[2], g1[2]; bool ok[2];
#pragma unroll
        for (int q = 0; q < 2; ++q) { const int t = t0 + q * NGW; ok[q] = t < TOK && !(layer == 1 && (t % LL) < NMETA); const int tc = ok[q] ? t : (layer == 1 ? NMETA : t0);
            const int2 ex = ((const int2*)P->ridx)[tc], sl = ((const int2*)P->rslot)[tc]; const float2 gg = ((const float2*)P->rgate)[tc];
            r0[q] = base[ex.x] + sl.x; r1[q] = base[ex.y] + sl.y; g0[q] = gg.x; g1[q] = gg.y; }
        float4 v[2][8]; uint2 ya[2][8], yb[2][8];
#pragma unroll
        for (int q = 0; q < 2; ++q) { const int t = ok[q] ? t0 + q * NGW : (layer == 1 ? NMETA : t0);
#pragma unroll
            for (int j = 0; j < 8; ++j) { v[q][j] = ((const float4*)(P->Z + (size_t)t * DM))[lane + 64 * j];
                ya[q][j] = ((const uint2*)(P->Y + (size_t)r0[q] * DM))[lane + 64 * j]; yb[q][j] = ((const uint2*)(P->Y + (size_t)r1[q] * DM))[lane + 64 * j]; } }
#pragma unroll
        for (int q = 0; q < 2; ++q) if (ok[q]) { const int t = t0 + q * NGW;
            float ss = 0.f;
#pragma unroll
            for (int j = 0; j < 8; ++j) { const uint2 a = ya[q][j], b = yb[q][j]; float4& x = v[q][j];
                x.x += g0[q] * __uint_as_float(a.x << 16) + g1[q] * __uint_as_float(b.x << 16); x.y += g0[q] * __uint_as_float(a.x & 0xffff0000u) + g1[q] * __uint_as_float(b.x & 0xffff0000u);
                x.z += g0[q] * __uint_as_float(a.y << 16) + g1[q] * __uint_as_float(b.y << 16); x.w += g0[q] * __uint_as_float(a.y & 0xffff0000u) + g1[q] * __uint_as_float(b.y & 0xffff0000u);
                ss += x.x * x.x + x.y * x.y + x.z * x.z + x.w * x.w; }
            const float rs = rsqrtf(wave_sum(ss) * (1.f / DM) + EPS);
            if (layer == 0) {
#pragma unroll
                for (int j = 0; j < 8; ++j) { ((float4*)(P->Z + (size_t)t * DM))[lane + 64 * j] = v[q][j];
                    const float4 w = ((const float4*)(P->ln1_w + DM))[lane + 64 * j];
                    uint2 o; o.x = cvtpk_(v[q][j].x * rs * w.x, v[q][j].y * rs * w.y); o.y = cvtpk_(v[q][j].z * rs * w.z, v[q][j].w * rs * w.w);
                    ((uint2*)(P->HN + (size_t)t * DM))[lane + 64 * j] = o; }
            } else {
                const int b = t / LL, tt = t % LL;
                if (tt >= NMETA) {
#pragma unroll
                    for (int j = 0; j < 8; ++j) { const float4 w = ((const float4*)P->fnw)[lane + 64 * j];
                        ((float4*)(P->out + ((size_t)b * SEQ + (tt - NMETA)) * DM))[lane + 64 * j] = make_float4(v[q][j].x * rs * w.x, v[q][j].y * rs * w.y, v[q][j].z * rs * w.z, v[q][j].w * rs * w.w); }
                }
            }
        }
    }
    __syncthreads();
}

__global__ void __launch_bounds__(NTHR, 2) mega_fwd(Params P_arg) {
    extern __shared__ __attribute__((aligned(16))) char lds[];
    const int tid = tid_(), G = gridDim.x;
    volatile LAS unsigned* ctlw = (volatile LAS unsigned*)((LAS char*)lds + LDS_CTL);
    if (tid < 64) ctlw[tid] = 0u;
    __syncthreads();
    KP P = kp_();
    XcdBarrier bar = xcd_barrier_post(P->bar, ctlw + 8);
#define GRID_BAR() do { xcd_barrier(bar); P = kp_(); } while (0)

    ph_build_norm(P);
    ph_prep(P);
    ph_weights(P, lds);
    __syncthreads();
    for (int un = bid_(); un < 64; un += G) s5::prep_unit(P, lds, un >> 5, un & 31);
    GRID_BAR();
#pragma unroll
    for (int layer = 0; layer < 2; ++layer) {
        { pg8::Gemm g{P->HN, P->WinT + (size_t)layer * INW * DM, MP, INW, DM, DM}; pg8::StaticOrder S; S.init(MP, INW, G, bid_(), DM / 64); pg8::EpiInProj E{P->PA, P->QKV};
          pg8::gemm_phase<pg8::EpiInProj, pg8::StaticOrder, true, true>((LAS unsigned char*)lds, g, S, E); }
        { const int t2 = tid_(), b2 = bid_(); if (b2 == 0 && t2 < NE) P->cnt[t2 * CSTR] = 0;
 }
        GRID_BAR();
        hg::local_states(P, lds, layer);
        { const int b0 = bid_(); for (int un = (G == 256) ? ((b0 + 128) & 255) : b0; un < 128; un += G) s5::fused_unit(P, lds, layer, un >> 5, un & 31); }
        ph_attention(P, lds);
        GRID_BAR();
        hg::scan_states(P);
        ph_attn_out(P, layer, G > 192 ? 132 : 0);
        __syncthreads();
        { pg8::Gemm g{P->YG, P->WgluT + (size_t)layer * 1024 * 512, MP, 1024, 512, 512}; pg8::StaticOrder S; S.init(MP, 1024, G, bid_(), 512 / 64); pg8::EpiGlu E{P->MIX, P->b_glu + layer * 1024};
          pg8::gemm_phase<pg8::EpiGlu, pg8::StaticOrder, true, true>((LAS unsigned char*)lds, g, S, E); }
        GRID_BAR();
        hg::outputs(P, lds, layer);
        GRID_BAR();
        { pg8::Gemm g{P->MIX, P->WoutT + (size_t)layer * DM * DM, MP, DM, DM, DM}; pg8::StaticOrder S; S.init(MP, DM, G, bid_(), DM / 64); pg8::EpiResidual E{P->Z};
          pg8::gemm_phase<pg8::EpiResidual, pg8::StaticOrder, true, true>((LAS unsigned char*)lds, g, S, E); }
        GRID_BAR();
        rt::norm_router(P, lds, layer);
        GRID_BAR();
        moe::stream_gemm<true>(P, lds, layer);
        GRID_BAR();
        moe::stream_gemm<false>(P, lds, layer);
        GRID_BAR();
        ph_combine_norm(P, lds, layer);
        if (layer == 0) GRID_BAR();
    }
}
}

extern "C" void kernel_launch(void* const* d_in, const int* in_sizes, int n_in, void* d_out, int out_size, void* d_ws, size_t ws_size, hipStream_t stream) {
    static int grid = 0;
    if (grid == 0) {
        int dev = 0, cus = 0;
        if (hipGetDevice(&dev) != hipSuccess || hipDeviceGetAttribute(&cus, hipDeviceAttributeMultiprocessorCount, dev) != hipSuccess) { grid = -1; return; }
        if (hipFuncSetAttribute((const void*)mega_fwd, hipFuncAttributeMaxDynamicSharedMemorySize, LDS_BYTES) != hipSuccess) { grid = -1; return; }
        int per_cu = 0;
        if (hipOccupancyMaxActiveBlocksPerMultiprocessor(&per_cu, (const void*)mega_fwd, NTHR, LDS_BYTES) != hipSuccess || per_cu < 1) { (void)hipGetLastError(); }
        grid = cus;
    }
    if (grid < 0) return;
    Params p{};
    const float** pin = (const float**)&p;
    for (int i = 0; i < 31; ++i) pin[i] = (const float*)d_in[i];
    p.out = (float*)d_out;
    char* ws = (char*)d_ws; size_t off = 0;
    auto alloc = [&](size_t bytes) { char* q = ws + off; off += (bytes + 255) & ~(size_t)255; return q; };
    p.bar = (unsigned*)alloc(XCD_BAR_WORDS * 4);
    p.elist = (int*)alloc((size_t)NE * ECAP * 4);
    p.cnt = (int*)alloc((size_t)NE * CSTR * 4); p.blk_e = (int*)alloc(1024); p.base = (int*)alloc(256);
    p.lbtab = (float*)alloc(1024 * 4); p.lam = (float*)alloc(256);
    p.Z = (float*)alloc((size_t)MP * DM * 4);
    p.HN = (bf16_t*)alloc((size_t)MP * DM * 2);
    p.PA = (float*)alloc((size_t)MP * PAW * 4);
    p.QKV = (bf16_t*)alloc((size_t)MP * QKVW * 2);
    p.OA = (float*)alloc((size_t)MP * HW * 4);
    p.ZP = (float*)alloc((size_t)8 * 256 * DM * 4);
    p.WRT = (bf16_t*)alloc((size_t)2 * 2 * 96 * DM * 2);
    p.A16 = (float*)alloc(2 * 32 * 64 * 8); p.S5E = (float*)alloc((size_t)516 * 32 * 128 * 4); p.S5X = (float*)alloc((size_t)516 * 32 * 128 * 4);
    p.BtY = (bf16_t*)alloc((size_t)2 * 32 * 256 * 384 * 2); p.BtE = (bf16_t*)alloc((size_t)2 * 32 * 128 * 256 * 2);
    p.SLOC = (float*)alloc((size_t)528 * 16384 * 4); p.DEC = (float*)alloc((size_t)528 * 128 * 4); p.SPREV = (bf16_t*)alloc((size_t)529 * 16384 * 2);
    p.YG = (bf16_t*)alloc((size_t)MP * 512 * 2);
    p.T = nullptr;
    p.MIX = (bf16_t*)alloc((size_t)MP * DM * 2);
    p.OC = (float*)alloc((size_t)MP * DM * 4);
    p.ridx = (int*)alloc((size_t)NASSIGN * 4); p.rgate = (float*)alloc((size_t)NASSIGN * 4); p.rslot = (int*)alloc((size_t)NASSIGN * 4);
    p.tokrow = (int*)alloc((size_t)NASSIGN * 4); p.rowtok = (int*)alloc((size_t)NRMAX * 4);
    p.H1 = nullptr;
    p.H = (bf16_t*)alloc((size_t)NRMAX * DE * 2);
    p.Y = (bf16_t*)alloc((size_t)NRMAX * DM * 2);
    p.S = nullptr;
    p.WinT = (bf16_t*)alloc((size_t)2 * INW * DM * 2); p.WoutT = (bf16_t*)alloc((size_t)2 * DM * DM * 2); p.WgluT = (bf16_t*)alloc((size_t)2 * 1024 * 512 * 2);
    if (off > ws_size) return;
    if (hipMemsetAsync(p.bar, 0, XCD_BAR_WORDS * 4, stream) != hipSuccess) return;
    hipLaunchKernelGGL(mega_fwd, dim3(grid), dim3(NTHR), LDS_BYTES, stream, p);
}
```

```cpp
#include <hip/hip_runtime.h>
#include <stdint.h>
#include <math.h>

namespace {
typedef unsigned short bf16_t;
constexpr int DM = 2048, NB = 4, SEQ = 2048, NMETA = 16, LL = SEQ + NMETA, TOK = NB * LL, MP = 8448;
constexpr int HW = 512;
constexpr int INW = 5632, PAW = 2560, QKVW = 3072;
constexpr int NE = 64, DE = 512, NASSIGN = TOK * 2;
constexpr int RB = 128;
constexpr int NRMAX = NASSIGN + NE * RB;
constexpr float EPS = 1e-6f;
constexpr int NTHR = 512;
constexpr int CSTR = 64;
constexpr int ECAP = 1024;
constexpr int LDS_BYTES = 147456;
constexpr int LDS_CTL = 143360;

__device__ __forceinline__ float bf2f(bf16_t h) { return __uint_as_float(((unsigned)h) << 16); }
__device__ __forceinline__ bf16_t f2bf(float f) { unsigned u = __float_as_uint(f); return (bf16_t)((u + 0x7fffu + ((u >> 16) & 1u)) >> 16); }
__device__ __forceinline__ float sigmoidf_(float x) { return 1.f / (1.f + expf(-x)); }
__device__ __forceinline__ int tid_() { int t = threadIdx.x; asm volatile("" : "+v"(t)); return t; }
template <int K> __device__ __forceinline__ float swz_xor(float v) { return __int_as_float(__builtin_amdgcn_ds_swizzle(__float_as_int(v), (K << 10) | 0x1f)); }
__device__ __forceinline__ int bid_() { int b = blockIdx.x; asm volatile("" : "+s"(b)); return b; }

#define XB_TMO      128
#define XB_XCNT(j)  (256  + 64 * (j))
#define XB_XSUB(j)  (1280 + 64 * (j))
#define XB_XGEN(j)  (2304 + 64 * (j))
#define XB_TOP      3328
#define XB_TOPGEN   3392
#define XCD_BAR_WORDS 3456
#define XB_SPIN_CAP (1u << 24)
#define LAS __attribute__((address_space(3)))
__device__ __forceinline__ unsigned xb_ld(unsigned* p)              { return __hip_atomic_load(p, __ATOMIC_RELAXED, __HIP_MEMORY_SCOPE_AGENT); }
__device__ __forceinline__ unsigned xb_add(unsigned* p, unsigned v) { return __hip_atomic_fetch_add(p, v, __ATOMIC_RELAXED, __HIP_MEMORY_SCOPE_AGENT); }
__device__ __forceinline__ unsigned xb_xcc_id() { return (unsigned)__builtin_amdgcn_s_getreg((3 << 11) | 20) & 0xFu; }
#define XB_SPIN(cond, bar) do { unsigned _sp = 0; while (cond) { __builtin_amdgcn_s_sleep(1); \
    if ((++_sp & 255u) == 0u) { if (xb_ld(&(bar)[XB_TMO])) break; if (_sp > XB_SPIN_CAP) { atomicAdd(&(bar)[XB_TMO], 1u); break; } } } } while (0)
struct XcdBarrier { unsigned* bar; unsigned x; volatile LAS unsigned* st; };
__device__ __forceinline__ XcdBarrier xcd_barrier_post(unsigned* bar, volatile LAS unsigned* st) {
    XcdBarrier b; b.bar = bar; b.x = xb_xcc_id(); b.st = st;
    if (threadIdx.x == 0) (void)xb_add(&bar[XB_XCNT(b.x)], 1u);
    return b;
}
__device__ __forceinline__ void xcd_barrier_complete(unsigned* bar, unsigned x, unsigned& nloc, unsigned& nx) {
    const unsigned G = gridDim.x * gridDim.y * gridDim.z;
    unsigned sum, cnt, mine, sp = 0u;
    for (;;) {
        sum = 0u; cnt = 0u; mine = 0u;
#pragma unroll
        for (unsigned j = 0; j < 16; ++j) { const unsigned c = xb_ld(&bar[XB_XCNT(j)]); sum += c; cnt += (c > 0u) ? 1u : 0u; mine = (j == x) ? c : mine; }
        if (sum == G) break;
        __builtin_amdgcn_s_sleep(1);
        if ((++sp & 255u) == 0u) { if (xb_ld(&bar[XB_TMO])) break; if (sp > XB_SPIN_CAP) { atomicAdd(&bar[XB_TMO], 1u); break; } }
    }
    nloc = mine > 0u ? mine : 1u; nx = cnt > 0u ? cnt : 1u;
}
__device__ __forceinline__ void xcd_barrier(const XcdBarrier& b) {
    asm volatile("s_waitcnt vmcnt(0)" ::: "memory");
    __syncthreads();
    if (threadIdx.x == 0) {
        unsigned* bar = b.bar;
        const unsigned bx_ = xb_xcc_id();
        __builtin_amdgcn_s_waitcnt(0);
        unsigned nloc = b.st[0], nx = b.st[1];
        if (nloc == 0u) { xcd_barrier_complete(bar, bx_, nloc, nx); b.st[0] = nloc; b.st[1] = nx; }
        const unsigned old = xb_add(&bar[XB_XSUB(bx_)], 1u);
        const unsigned gen = old / nloc;
        if (old + 1u == (gen + 1u) * nloc) {
            __builtin_amdgcn_fence(__ATOMIC_RELEASE, "agent");
            asm volatile("s_waitcnt vmcnt(0)" ::: "memory");
            const unsigned og = xb_add(&bar[XB_TOP], 1u);
            const unsigned tg = og / nx;
            if (og + 1u == (tg + 1u) * nx) xb_add(&bar[XB_TOPGEN], 1u);
            else XB_SPIN(xb_ld(&bar[XB_TOPGEN]) == tg, bar);
            __builtin_amdgcn_fence(__ATOMIC_ACQUIRE, "agent");
            xb_add(&bar[XB_XGEN(bx_)], 1u);
            asm volatile("s_waitcnt vmcnt(0)" ::: "memory");
        } else {
            XB_SPIN(xb_ld(&bar[XB_XGEN(bx_)]) == gen, bar);
            __builtin_amdgcn_fence(__ATOMIC_ACQUIRE, "agent");
            asm volatile("s_waitcnt vmcnt(0)" ::: "memory");
        }
    }
    __syncthreads();
}

struct Params {
    const float *x, *meta, *ln1_w, *w_in, *lbnd, *hnw, *a_re, *a_im, *b_re, *b_im, *c_re, *c_im, *s5d, *log_dt, *w_glu, *b_glu,
                *lq1, *lk1, *lq2, *lk2, *subln, *w_out, *ln2_w, *wrg, *brg, *wre, *bre, *w1, *w3, *w2, *fnw;
    float* out;
    unsigned* bar;
    int *cnt, *blk_e, *ridx, *rslot, *tokrow, *rowtok, *base, *elist;
    float *lbtab, *lam, *Z, *PA, *OA, *T, *OC, *rgate, *H1, *S, *SLOC, *DEC, *A16, *S5E, *S5X, *ZP;
    bf16_t *HN, *QKV, *YG, *MIX, *H, *Y, *WinT, *WoutT, *WgluT, *SPREV, *BtY, *BtE, *WRT;
};
typedef const __attribute__((address_space(4))) Params* KP;
__device__ __forceinline__ KP kp_() { KP p = (KP)__builtin_amdgcn_kernarg_segment_ptr(); asm volatile("" : "+s"(p)); return p; }


namespace pg8 {
#define PG8_LAS __attribute__((address_space(3)))
typedef short bf16x8 __attribute__((ext_vector_type(8)));
typedef float f32x4 __attribute__((ext_vector_type(4)));
typedef unsigned u32x4 __attribute__((ext_vector_type(4)));
constexpr int BM = 256, BK = 64, HALF = 128, HTB = HALF * BK * 2, STAGE_BYTES = 8 * HTB, NXCD = 8, WGM = 8;
__host__ __device__ __forceinline__ int lds_byte(int r, int c) { const int st = (r >> 4) * 2 + (c >> 5), rr = r & 15, cc = c & 31, ob = rr * 64 + cc * 2; return st * 1024 + (ob ^ (((ob >> 9) & 1) << 5)); }
__host__ __device__ __forceinline__ void stage_rc(int b, int& R, int& C) { const int st = b / 1024, sb = b % 1024, swz = sb ^ (((sb >> 9) & 1) << 5); R = (st >> 1) * 16 + swz / 64; C = (st & 1) * 32 + (swz % 64) / 2; }
__host__ __device__ __forceinline__ int perm32(int rho) { const int n = rho >> 4, i = rho & 15; return 8 * (i >> 2) + 4 * n + (i & 3); }
struct Unit { int pm, pn, ko, nt; };
struct Gemm { const bf16_t* A; const bf16_t* Bt; int M, N, K, ld; };
struct StaticOrder {
    static constexpr bool PER_UNIT_K = false;
    int nM, nN, nwg, G, c, nt;
    __host__ __device__ void init(int M, int N, int G_, int c_, int nt_) { nM = M / BM; nN = N / BM; nwg = nM * nN; G = G_; c = c_; nt = nt_; }
    __host__ __device__ bool next(int i, Unit& u) const {
        const long L = (long)i * G + c; if (L >= nwg) return false;
        int wgid = (int)L; { const int q = nwg / NXCD, r = nwg % NXCD, xcd = wgid % NXCD, off = wgid / NXCD; wgid = (xcd < r ? xcd * (q + 1) : r * (q + 1) + (xcd - r) * q) + off; }
        const int nig = WGM * nN, gid = wgid / nig, fm = gid * WGM, gsz = (nM - fm) < WGM ? (nM - fm) : WGM;
        u.pm = fm + ((wgid % nig) % gsz); u.pn = (wgid % nig) / gsz; u.ko = 0; u.nt = nt; return true;
    }
    __device__ __forceinline__ void a_ready(const Unit&) const {}
    __device__ __forceinline__ void done(const Unit&) const {}
};
__device__ __forceinline__ unsigned cvt_pk_bf16(float lo, float hi) { unsigned r; asm volatile("v_cvt_pk_bf16_f32 %0, %1, %2" : "=v"(r) : "v"(lo), "v"(hi)); return r; }

template <class Epi, class Sched, bool ALIGN_EPI = false, bool SP2 = false>
__device__ __forceinline__ void gemm_phase(PG8_LAS unsigned char* lds, const Gemm g, const Sched& S, const Epi& E) {
    const int tid = tid_(), wid = __builtin_amdgcn_readfirstlane(tid >> 6), lane = tid & 63, wr = wid >> 2, wc = wid & 3, fr = lane & 15, fq = lane >> 4;
    const int K = g.ld;
    unsigned voffA[2], voffB[2];
#pragma unroll
    for (int i = 0; i < 2; ++i) { int R, C; stage_rc(tid * 16 + i * 8192, R, C); const int Rb = Epi::PERM ? ((R & ~31) + perm32(R & 31)) : R;
        voffA[i] = (unsigned)(R * K + C) * 2u; voffB[i] = (unsigned)(Rb * K + C) * 2u; }
    const size_t kstep = (size_t)(BK * 2);
    const size_t hstep = (size_t)HALF * K * 2;
    const size_t tstep = 2 * hstep;
    const unsigned ldsw = (unsigned)wid * 1024u;
    const int aoff = lds_byte(wr * 64 + fr, fq * 8), boff = lds_byte(wc * 32 + fr, fq * 8);
#define PG8_SA(b, h) (((b) * 2 + (h)) * HTB)
#define PG8_SB(b, h) ((4 + (b) * 2 + (h)) * HTB)
#define PG8_STAGE(bufoff, gbase, voff) do { _Pragma("unroll") for (int _i = 0; _i < 2; ++_i) \
        __builtin_amdgcn_global_load_lds((const unsigned*)((const char*)(gbase) + (voff)[_i]), (PG8_LAS unsigned*)(lds + (bufoff) + ldsw + _i * 8192), 16, 0, 0); } while (0)
#define PG8_LDA(dst, b, h) do { _Pragma("unroll") for (int m = 0; m < 4; ++m) _Pragma("unroll") for (int k = 0; k < 2; ++k) dst[m][k] = *(const PG8_LAS bf16x8*)(lds + PG8_SA(b, h) + aoff + m * 2048 + k * 1024); } while (0)
#define PG8_LDB(dst, b, h) do { _Pragma("unroll") for (int n = 0; n < 2; ++n) _Pragma("unroll") for (int k = 0; k < 2; ++k) dst[n][k] = *(const PG8_LAS bf16x8*)(lds + PG8_SB(b, h) + boff + n * 2048 + k * 1024); } while (0)
#define PG8_MMA(ai, bj, At, Bt) do { __builtin_amdgcn_s_setprio(1); _Pragma("unroll") for (int m = 0; m < 4; ++m) _Pragma("unroll") for (int n = 0; n < 2; ++n) _Pragma("unroll") for (int k = 0; k < 2; ++k) \
        acc[ai][bj][m][n] = __builtin_amdgcn_mfma_f32_16x16x32_bf16(Bt[n][k], At[m][k], acc[ai][bj][m][n], 0, 0, 0); __builtin_amdgcn_s_setprio(0); } while (0)
#define PG8_WAIT_V(n) asm volatile("s_waitcnt vmcnt(" #n ")" ::: "memory")
#define PG8_WAIT_L(n) asm volatile("s_waitcnt lgkmcnt(" #n ")" ::: "memory")
#define PG8_BAR __builtin_amdgcn_s_barrier()
#define PG8_SCHED __builtin_amdgcn_sched_barrier(0)
    Unit cur, nxt; int ui = 0;
    if (!S.next(0, cur)) return;
    f32x4 acc[2][2][4][2];
#pragma unroll
    for (int a = 0; a < 2; ++a)
#pragma unroll
        for (int b = 0; b < 2; ++b)
#pragma unroll
            for (int m = 0; m < 4; ++m)
#pragma unroll
                for (int n = 0; n < 2; ++n) acc[a][b][m][n] = (f32x4){0.f, 0.f, 0.f, 0.f};
    bf16x8 At[4][2], B0[2][2], B1[2][2];
    const char* cA = (const char*)g.A + (size_t)cur.pm * tstep + (size_t)cur.ko * 2; const char* cB = (const char*)g.Bt + (size_t)cur.pn * tstep + (size_t)cur.ko * 2;
    S.a_ready(cur);
    if constexpr (SP2) {
        PG8_STAGE(PG8_SB(0, 0), cB, voffB); PG8_STAGE(PG8_SB(0, 1), cB + hstep, voffB); PG8_STAGE(PG8_SA(0, 0), cA, voffA); PG8_STAGE(PG8_SA(0, 1), cA + hstep, voffA);
        if (wr == 1) PG8_BAR;
        PG8_WAIT_V(2); PG8_BAR;
        PG8_STAGE(PG8_SB(1, 0), cB + kstep, voffB); PG8_STAGE(PG8_SA(1, 0), cA + kstep, voffA); PG8_STAGE(PG8_SB(1, 1), cB + hstep + kstep, voffB);
        PG8_WAIT_V(6); PG8_BAR;
    } else {
        PG8_STAGE(PG8_SB(0, 0), cB, voffB); PG8_STAGE(PG8_SA(0, 0), cA, voffA); PG8_STAGE(PG8_SB(0, 1), cB + hstep, voffB); PG8_STAGE(PG8_SA(0, 1), cA + hstep, voffA);
        if (wr == 1) PG8_BAR;
        PG8_WAIT_V(4); PG8_BAR;
        PG8_STAGE(PG8_SB(1, 0), cB + kstep, voffB); PG8_STAGE(PG8_SA(1, 0), cA + kstep, voffA); PG8_STAGE(PG8_SB(1, 1), cB + hstep + kstep, voffB);
        PG8_WAIT_V(6); PG8_BAR;
    }
    for (;;) {
        const bool has_next = S.next(ui + 1, nxt);
        const char* nA = has_next ? (const char*)g.A + (size_t)nxt.pm * tstep + (size_t)nxt.ko * 2 : cA; const char* nB = has_next ? (const char*)g.Bt + (size_t)nxt.pn * tstep + (size_t)nxt.ko * 2 : cB;
        const int nt = Sched::PER_UNIT_K ? cur.nt : g.K / BK;
        for (int t = 0; t < nt; t += 2) {
            const bool last = (t == nt - 2);
            const char* a1 = cA + (size_t)(t + 1) * kstep;
            const char* a2 = last ? nA : cA + (size_t)(t + 2) * kstep; const char* b2 = last ? nB : cB + (size_t)(t + 2) * kstep;
            const char* a3 = a2 + kstep; const char* b3 = b2 + kstep;
            if (last && has_next) S.a_ready(nxt);
            if constexpr (SP2) {
            PG8_LDB(B0, 0, 0); PG8_LDB(B1, 0, 1); PG8_SCHED; PG8_LDA(At, 0, 0); PG8_STAGE(PG8_SA(1, 1), a1 + hstep, voffA);
            PG8_WAIT_V(8); PG8_WAIT_L(0); PG8_BAR; PG8_MMA(0, 0, At, B0); PG8_MMA(0, 1, At, B1); PG8_BAR; PG8_SCHED;
            PG8_LDA(At, 0, 1); PG8_STAGE(PG8_SB(0, 0), b2, voffB); PG8_STAGE(PG8_SB(0, 1), b2 + hstep, voffB); PG8_STAGE(PG8_SA(0, 0), a2, voffA);
            PG8_WAIT_V(8); PG8_WAIT_L(0); PG8_BAR; PG8_MMA(1, 0, At, B0); PG8_MMA(1, 1, At, B1); PG8_BAR; PG8_SCHED;
            PG8_LDB(B0, 1, 0); PG8_LDB(B1, 1, 1); PG8_SCHED; PG8_LDA(At, 1, 0); PG8_STAGE(PG8_SA(0, 1), a2 + hstep, voffA);
            PG8_WAIT_V(8); PG8_WAIT_L(0); PG8_BAR; PG8_MMA(0, 0, At, B0); PG8_MMA(0, 1, At, B1); PG8_BAR; PG8_SCHED;
            PG8_LDA(At, 1, 1); PG8_STAGE(PG8_SB(1, 0), b3, voffB); PG8_STAGE(PG8_SB(1, 1), b3 + hstep, voffB); PG8_STAGE(PG8_SA(1, 0), a3, voffA);
            PG8_WAIT_V(8); PG8_WAIT_L(0); PG8_BAR; PG8_MMA(1, 0, At, B0); PG8_MMA(1, 1, At, B1); PG8_BAR; PG8_SCHED;
            } else {
            PG8_LDB(B0, 0, 0); PG8_SCHED; PG8_LDA(At, 0, 0); PG8_STAGE(PG8_SA(1, 1), a1 + hstep, voffA);
            PG8_WAIT_L(8); PG8_BAR; PG8_WAIT_L(0); PG8_MMA(0, 0, At, B0); PG8_BAR; PG8_SCHED;
            PG8_LDB(B1, 0, 1); PG8_STAGE(PG8_SB(0, 0), b2, voffB);
            PG8_BAR; PG8_WAIT_L(0); PG8_MMA(0, 1, At, B1); PG8_BAR;
            PG8_LDA(At, 0, 1); PG8_STAGE(PG8_SA(0, 0), a2, voffA);
            PG8_BAR; PG8_WAIT_L(0); PG8_MMA(1, 0, At, B0); PG8_BAR; PG8_SCHED;
            PG8_STAGE(PG8_SB(0, 1), b2 + hstep, voffB);
            PG8_WAIT_V(6); PG8_BAR; PG8_MMA(1, 1, At, B1); PG8_BAR;
            PG8_LDB(B0, 1, 0); PG8_SCHED; PG8_LDA(At, 1, 0); PG8_STAGE(PG8_SA(0, 1), a2 + hstep, voffA);
            PG8_WAIT_L(8); PG8_BAR; PG8_WAIT_L(0); PG8_MMA(0, 0, At, B0); PG8_BAR; PG8_SCHED;
            PG8_LDB(B1, 1, 1); PG8_STAGE(PG8_SB(1, 0), b3, voffB);
            PG8_BAR; PG8_WAIT_L(0); PG8_MMA(0, 1, At, B1); PG8_BAR;
            PG8_LDA(At, 1, 1); PG8_STAGE(PG8_SA(1, 0), a3, voffA);
            PG8_BAR; PG8_WAIT_L(0); PG8_MMA(1, 0, At, B0); PG8_BAR; PG8_SCHED;
            PG8_STAGE(PG8_SB(1, 1), b3 + hstep, voffB);
            PG8_WAIT_V(6); PG8_BAR; PG8_MMA(1, 1, At, B1); PG8_BAR;
            }
        }
        if constexpr (ALIGN_EPI) { if (wr == 0) PG8_BAR; }
        E(acc, cur, wr, wc, fr, fq);
        if (!has_next) break;
#pragma unroll
        for (int a = 0; a < 2; ++a)
#pragma unroll
            for (int b = 0; b < 2; ++b)
#pragma unroll
                for (int m = 0; m < 4; ++m)
#pragma unroll
                    for (int n = 0; n < 2; ++n) acc[a][b][m][n] = (f32x4){0.f, 0.f, 0.f, 0.f};
        cur = nxt; cA = nA; cB = nB; ++ui;
        if constexpr (ALIGN_EPI) { if (wr == 1) PG8_BAR; }
    }
    PG8_WAIT_V(0);
    if constexpr (!ALIGN_EPI) { if (wr == 0) PG8_BAR; }
    PG8_BAR;
#undef PG8_SA
#undef PG8_SB
#undef PG8_STAGE
#undef PG8_LDA
#undef PG8_LDB
#undef PG8_MMA
#undef PG8_WAIT_V
#undef PG8_WAIT_L
#undef PG8_BAR
#undef PG8_SCHED
}
struct EpiInProj {
    static constexpr bool PERM = true;
    float* PA; bf16_t* QKV;
    __device__ __forceinline__ void operator()(const f32x4 (&acc)[2][2][4][2], const Unit& u, int wr, int wc, int fr, int fq) const {
        const int row0 = u.pm * BM + wr * 64 + fr, colt = u.pn * BM + wc * 32 + 8 * fq;
        if (colt < PAW) {
#pragma unroll
            for (int ai = 0; ai < 2; ++ai)
#pragma unroll
                for (int m = 0; m < 4; ++m) { float* rp = PA + (size_t)(row0 + ai * HALF + m * 16) * PAW + colt;
#pragma unroll
                    for (int bj = 0; bj < 2; ++bj) { *(f32x4*)(rp + bj * HALF) = acc[ai][bj][m][0]; *(f32x4*)(rp + bj * HALF + 4) = acc[ai][bj][m][1]; } }
        } else {
#pragma unroll
            for (int ai = 0; ai < 2; ++ai)
#pragma unroll
                for (int m = 0; m < 4; ++m) { bf16_t* rp = QKV + (size_t)(row0 + ai * HALF + m * 16) * QKVW + (colt - PAW);
#pragma unroll
                    for (int bj = 0; bj < 2; ++bj) { const f32x4 v0 = acc[ai][bj][m][0], v1 = acc[ai][bj][m][1];
                        u32x4 w; w.x = cvt_pk_bf16(v0[0], v0[1]); w.y = cvt_pk_bf16(v0[2], v0[3]); w.z = cvt_pk_bf16(v1[0], v1[1]); w.w = cvt_pk_bf16(v1[2], v1[3]);
                        *(u32x4*)(rp + bj * HALF) = w; } }
        }
    }
};
struct EpiResidual {
    static constexpr bool PERM = true;
    float* Z;
    __device__ __forceinline__ void operator()(const f32x4 (&acc)[2][2][4][2], const Unit& u, int wr, int wc, int fr, int fq) const {
        const int row0 = u.pm * BM + wr * 64 + fr, colt = u.pn * BM + wc * 32 + 8 * fq;
#pragma unroll
        for (int ai = 0; ai < 2; ++ai)
#pragma unroll
            for (int m = 0; m < 4; ++m) { const int row = row0 + ai * HALF + m * 16; if (row < TOK) { float* rp = Z + (size_t)row * DM + colt;
#pragma unroll
                for (int bj = 0; bj < 2; ++bj) { f32x4* p0 = (f32x4*)(rp + bj * HALF); f32x4* p1 = (f32x4*)(rp + bj * HALF + 4);
                    const f32x4 z0 = *p0, z1 = *p1; *p0 = z0 + acc[ai][bj][m][0]; *p1 = z1 + acc[ai][bj][m][1]; } } }
    }
};
struct OutOrder {
    static constexpr bool PER_UNIT_K = true;
    StaticOrder main;
    __device__ bool next(int i, Unit& u) const {
        if (main.next(i, u)) return true;
        const int r0 = (main.nwg + main.G - 1) / main.G;
        const int L = (i - r0) * main.G + main.c; if (i < r0 || L >= 64) return false;
        u.pm = 32; u.pn = L & 7; u.ko = (L >> 3) * 256; u.nt = 4; return true; }
    __device__ __forceinline__ void a_ready(const Unit&) const {}
    __device__ __forceinline__ void done(const Unit&) const {}
};
struct EpiOutProj {
    static constexpr bool PERM = true;
    float* Z; float* ZP;
    __device__ __forceinline__ void operator()(const f32x4 (&acc)[2][2][4][2], const Unit& u, int wr, int wc, int fr, int fq) const {
        const bool tail = u.pm == 32;
        const int row0 = (tail ? (u.ko >> 8) * BM : u.pm * BM) + wr * 64 + fr, colt = u.pn * BM + wc * 32 + 8 * fq;
        float* base = tail ? ZP : Z;
#pragma unroll
        for (int ai = 0; ai < 2; ++ai)
#pragma unroll
            for (int m = 0; m < 4; ++m) { float* rp = base + (size_t)(row0 + ai * HALF + m * 16) * DM + colt;
#pragma unroll
                for (int bj = 0; bj < 2; ++bj) { f32x4* p0 = (f32x4*)(rp + bj * HALF); f32x4* p1 = (f32x4*)(rp + bj * HALF + 4);
                    f32x4 z0 = {0.f, 0.f, 0.f, 0.f}, z1 = {0.f, 0.f, 0.f, 0.f};
                    if (!tail) { z0 = *p0; z1 = *p1; }
                    *p0 = z0 + acc[ai][bj][m][0]; *p1 = z1 + acc[ai][bj][m][1]; } }
    }
};
struct TailOrder {
    static constexpr bool PER_UNIT_K = false;
    int G, c;
    __device__ bool next(int i, Unit& u) const { const int L = i * G + c; if (L >= 64) return false; u.pm = 32; u.pn = L & 7; u.ko = (L >> 3) * 256; u.nt = 4; return true; }
    __device__ __forceinline__ void a_ready(const Unit&) const {}
    __device__ __forceinline__ void done(const Unit&) const {}
};
struct EpiTailPartial {
    static constexpr bool PERM = true;
    float* ZP;
    __device__ __forceinline__ void operator()(const f32x4 (&acc)[2][2][4][2], const Unit& u, int wr, int wc, int fr, int fq) const {
        const int row0 = (u.ko >> 8) * BM + wr * 64 + fr, colt = u.pn * BM + wc * 32 + 8 * fq;
#pragma unroll
        for (int ai = 0; ai < 2; ++ai)
#pragma unroll
            for (int m = 0; m < 4; ++m) { float* rp = ZP + (size_t)(row0 + ai * HALF + m * 16) * DM + colt;
#pragma unroll
                for (int bj = 0; bj < 2; ++bj) { *(f32x4*)(rp + bj * HALF) = acc[ai][bj][m][0]; *(f32x4*)(rp + bj * HALF + 4) = acc[ai][bj][m][1]; } }
    }
};
struct EpiGlu {
    static constexpr bool PERM = true;
    bf16_t* MIX; const float* bias;
    __device__ __forceinline__ void operator()(const f32x4 (&acc)[2][2][4][2], const Unit& u, int wr, int wc, int fr, int fq) const {
        const int row0 = u.pm * BM + wr * 64 + fr, c0 = u.pn * HALF + wc * 32 + 8 * fq;
        const f32x4 bv0 = *(const f32x4*)(bias + c0), bv1 = *(const f32x4*)(bias + c0 + 4), bg0 = *(const f32x4*)(bias + 512 + c0), bg1 = *(const f32x4*)(bias + 512 + c0 + 4);
        float one = 1.f; asm volatile("" : "+v"(one));
#pragma unroll
        for (int ai = 0; ai < 2; ++ai)
#pragma unroll
            for (int m = 0; m < 4; ++m) { const f32x4 v0 = acc[ai][0][m][0] + bv0, v1 = acc[ai][0][m][1] + bv1, g0 = acc[ai][1][m][0] + bg0, g1 = acc[ai][1][m][1] + bg1;
                float o[8];
#pragma unroll
                for (int e = 0; e < 4; ++e) { o[e] = v0[e] * __builtin_amdgcn_rcpf(one + __expf(-g0[e])); o[4 + e] = v1[e] * __builtin_amdgcn_rcpf(one + __expf(-g1[e])); }
                u32x4 w; w.x = cvt_pk_bf16(o[0], o[1]); w.y = cvt_pk_bf16(o[2], o[3]); w.z = cvt_pk_bf16(o[4], o[5]); w.w = cvt_pk_bf16(o[6], o[7]);
                *(u32x4*)(MIX + (size_t)(row0 + ai * HALF + m * 16) * DM + 512 + c0) = w; }
    }
};
}

__device__ __forceinline__ void transpose_item(const float* W, int K, int N, bf16_t* WT, int k0, int n0, int row0, float* scr, int lane) {
    float tv[32];
#pragma unroll
    for (int i = 0; i < 32; ++i) { const int kk = 2 * i + (lane >> 5); tv[i] = W[(size_t)(k0 + kk) * N + n0 + (lane & 31)]; }
#pragma unroll
    for (int i = 0; i < 32; ++i) { const int kk = 2 * i + (lane >> 5); scr[kk * 33 + (lane & 31)] = tv[i]; }
    asm volatile("s_waitcnt lgkmcnt(0)" ::: "memory");
    const int c = lane & 7;
#pragma unroll
    for (int j = 0; j < 4; ++j) { const int n = (lane >> 3) + 8 * j; const float* sp = scr + (8 * c) * 33 + n;
        pg8::u32x4 o; o.x = pg8::cvt_pk_bf16(sp[0 * 33], sp[1 * 33]); o.y = pg8::cvt_pk_bf16(sp[2 * 33], sp[3 * 33]); o.z = pg8::cvt_pk_bf16(sp[4 * 33], sp[5 * 33]); o.w = pg8::cvt_pk_bf16(sp[6 * 33], sp[7 * 33]);
        *(pg8::u32x4*)(WT + (size_t)(row0 + n) * K + k0 + 8 * c) = o; }
    asm volatile("s_waitcnt lgkmcnt(0)" ::: "memory");
}
__device__ __forceinline__ void ph_weights(KP P, char* lds) {
    const int tid = tid_(), lane = tid & 63, wave = tid >> 6;
    float* scr = (float*)lds + wave * (64 * 33);
    const int cu0 = gridDim.x == 256 ? 64 : 0, gw = (bid_() - cu0) * 8 + wave, NGW = (gridDim.x - cu0) * 8;
    if (gw < 0) return;
    constexpr int I_IN = (DM / 64) * (INW / 32), I_OUT = (DM / 64) * (DM / 32), I_GLU = (512 / 64) * (1024 / 32), I_L = I_IN + I_OUT + I_GLU;
    for (int it = gw; it < 2 * I_L; it += NGW) {
        const int layer = it / I_L; int r = it % I_L;
        if (r < I_IN) { const int nb = INW / 32, kb = r / nb, n0 = (r % nb) * 32;
            transpose_item(P->w_in + (size_t)layer * DM * INW, DM, INW, P->WinT + (size_t)layer * INW * DM, kb * 64, n0, n0, scr, lane); continue; }
        r -= I_IN;
        if (r < I_OUT) { const int nb = DM / 32, kb = r / nb, n0 = (r % nb) * 32;
            transpose_item(P->w_out + (size_t)layer * DM * DM, DM, DM, P->WoutT + (size_t)layer * DM * DM, kb * 64, n0, n0, scr, lane); continue; }
        r -= I_OUT;
        { const int nb = 1024 / 32, kb = r / nb, n0 = (r % nb) * 32;
          const int row0 = ((n0 & 511) >> 7) * 256 + (n0 >> 9) * 128 + (n0 & 127);
          transpose_item(P->w_glu + (size_t)layer * 512 * 1024, 512, 1024, P->WgluT + (size_t)layer * 1024 * 512, kb * 64, n0, row0, scr, lane); }
    }
}


namespace fa {
using bf16x8 = __attribute__((ext_vector_type(8))) short;
using s16x4  = __attribute__((ext_vector_type(4))) short;
using f32x16 = __attribute__((ext_vector_type(16))) float;
using u32x4  = __attribute__((ext_vector_type(4))) unsigned;
constexpr int D = 128, NW = 8, QBLK = 32, KVBLK = 64, LDQK = QKVW;
constexpr float SCALE = 0.088388347648318440f, THR = 8.f, NEG = -1e30f;
constexpr size_t SHM_V = KVBLK * D * 2, SHM_K = KVBLK * D * 2, SHM_ATTN = 2 * SHM_V + 2 * SHM_K + NW * 64 * 4;
#define KSWZ(row, colB) ((row) * 256 + ((colB) ^ (((row) & 7) << 4)))
#define SBAR() __builtin_amdgcn_sched_barrier(0)
__device__ __forceinline__ int crow(int r, int hi) { return (r & 3) + 8 * (r >> 2) + 4 * hi; }
__device__ __forceinline__ unsigned cvtpk(float lo, float hi) { unsigned r; asm volatile("v_cvt_pk_bf16_f32 %0, %1, %2" : "=v"(r) : "v"(lo), "v"(hi)); return r; }
__device__ __forceinline__ void partialSM(f32x16& p0, f32x16& p1, float& m_reg, float& mn, float& alpha) {
  constexpr float C = SCALE * 1.4426950408889634f;
  float pmax = p0[0]; for (int r = 1; r < 16; ++r) pmax = fmaxf(pmax, p0[r]); for (int r = 0; r < 16; ++r) pmax = fmaxf(pmax, p1[r]);
  { auto rr = __builtin_amdgcn_permlane32_swap(__float_as_uint(pmax), __float_as_uint(pmax), false, false);
    pmax = fmaxf(__uint_as_float(rr[0]), __uint_as_float(rr[1])); }
  if (__builtin_expect(__all(pmax - m_reg <= THR / SCALE), 1)) { mn = m_reg; alpha = 1.f; }
  else { mn = fmaxf(m_reg, pmax); alpha = __builtin_amdgcn_exp2f((m_reg - mn) * C); m_reg = mn; }
  float mnC = -mn * C;
  for (int r = 0; r < 16; ++r) p0[r] = fmaf(p0[r], C, mnC); for (int r = 0; r < 16; ++r) p1[r] = fmaf(p1[r], C, mnC);
  for (int r = 0; r < 16; ++r) p0[r] = __builtin_amdgcn_exp2f(p0[r]);
}
__device__ __forceinline__ void finishSM(f32x16& p0, f32x16& p1, float alpha, float& l_reg, bf16x8& pa0, bf16x8& pa1, bf16x8& pa2, bf16x8& pa3) {
  for (int r = 0; r < 16; ++r) p1[r] = __builtin_amdgcn_exp2f(p1[r]);
  float ps = 0; for (int r = 0; r < 16; ++r) ps += p0[r]; for (int r = 0; r < 16; ++r) ps += p1[r];
  { auto rr = __builtin_amdgcn_permlane32_swap(__float_as_uint(ps), __float_as_uint(ps), false, false);
    ps = __uint_as_float(rr[0]) + __uint_as_float(rr[1]); }
  l_reg = l_reg * alpha + ps;
#define PK4(P, BASE, OUT) do { unsigned a0 = cvtpk(P[BASE + 0], P[BASE + 1]), a1 = cvtpk(P[BASE + 2], P[BASE + 3]);   \
    unsigned b0 = cvtpk(P[BASE + 4], P[BASE + 5]), b1 = cvtpk(P[BASE + 6], P[BASE + 7]);                              \
    auto r0 = __builtin_amdgcn_permlane32_swap(a0, b0, false, false); auto r1 = __builtin_amdgcn_permlane32_swap(a1, b1, false, false); \
    u32x4 w = {r0[0], r1[0], r0[1], r1[1]}; OUT = *reinterpret_cast<bf16x8*>(&w); } while (0)
  PK4(p0, 0, pa0); PK4(p0, 8, pa1); PK4(p1, 0, pa2); PK4(p1, 8, pa3);
#undef PK4
}
__device__ __forceinline__ void qkt(f32x16& p0, f32x16& p1, const bf16_t* Ks, const bf16x8* qr, int r32, int hi) {
  p0 = f32x16{}; p1 = f32x16{};
  for (int d0 = 0; d0 < 8; ++d0) { int cb = (d0 * 16 + hi * 8) * 2;
    bf16x8 b0 = *reinterpret_cast<const bf16x8*>((const char*)Ks + KSWZ(r32, cb));
    bf16x8 b1 = *reinterpret_cast<const bf16x8*>((const char*)Ks + KSWZ(32 + r32, cb));
    p0 = __builtin_amdgcn_mfma_f32_32x32x16_bf16(b0, qr[d0], p0, 0, 0, 0);
    p1 = __builtin_amdgcn_mfma_f32_32x32x16_bf16(b1, qr[d0], p1, 0, 0, 0); }
}
__device__ __forceinline__ void mask_tile(f32x16& p0, f32x16& p1, int kt, int vis) {
  if (kt > vis) {
    const bool part = (kt == vis + 1);
    for (int r = 0; r < 16; ++r) p1[r] = NEG;
    for (int r = 8; r < 16; ++r) p0[r] = NEG;
    if (!part) for (int r = 0; r < 8; ++r) p0[r] = NEG;
  }
}
__device__ __forceinline__ int v_st(int k, int c) { const int kk = (k & ~0xC) | ((k & 4) << 1) | ((k & 8) >> 1); return ((kk >> 3) * 4 + (c >> 5)) * 512 + ((kk & 7) * 32 + (c & 31)) * 2; }
__device__ __forceinline__ int v_rd_base(int lane) { return ((lane & 3) << 3) | (((lane >> 2) & 3) << 6) | (((lane >> 4) & 1) << 5) | (((lane >> 5) & 1) << 8); }
constexpr int v_rd_off(int d0, int ks, int half) { return d0 * 512 + ks * 4096 + half * 2048; }
template <int OFF> __device__ __forceinline__ s16x4 tr_read(int vb) {
  s16x4 r; asm volatile("ds_read_b64_tr_b16 %0, %1 offset:%2" : "=&v"(r) : "v"(vb), "i"(OFF) : "memory"); return r;
}
template <int D0> __device__ __forceinline__ void pv_one(f32x16& od, int vb, bf16x8 pa0, bf16x8 pa1, bf16x8 pa2, bf16x8 pa3) {
  const s16x4 l0 = tr_read<v_rd_off(D0, 0, 0)>(vb), h0 = tr_read<v_rd_off(D0, 0, 1)>(vb), l1 = tr_read<v_rd_off(D0, 1, 0)>(vb), h1 = tr_read<v_rd_off(D0, 1, 1)>(vb);
  const s16x4 l2 = tr_read<v_rd_off(D0, 2, 0)>(vb), h2 = tr_read<v_rd_off(D0, 2, 1)>(vb), l3 = tr_read<v_rd_off(D0, 3, 0)>(vb), h3 = tr_read<v_rd_off(D0, 3, 1)>(vb);
  asm volatile("s_waitcnt lgkmcnt(0)" ::: "memory"); SBAR();
#define PK(L, H) (bf16x8){L[0], L[1], L[2], L[3], H[0], H[1], H[2], H[3]}
  od = __builtin_amdgcn_mfma_f32_32x32x16_bf16(pa0, PK(l0, h0), od, 0, 0, 0);
  od = __builtin_amdgcn_mfma_f32_32x32x16_bf16(pa1, PK(l1, h1), od, 0, 0, 0);
  od = __builtin_amdgcn_mfma_f32_32x32x16_bf16(pa2, PK(l2, h2), od, 0, 0, 0);
  od = __builtin_amdgcn_mfma_f32_32x32x16_bf16(pa3, PK(l3, h3), od, 0, 0, 0);
#undef PK
}
__device__ __forceinline__ void pv_d0(f32x16* o, int vb, bf16x8 pa0, bf16x8 pa1, bf16x8 pa2, bf16x8 pa3) {
  pv_one<0>(o[0], vb, pa0, pa1, pa2, pa3); pv_one<1>(o[1], vb, pa0, pa1, pa2, pa3); pv_one<2>(o[2], vb, pa0, pa1, pa2, pa3); pv_one<3>(o[3], vb, pa0, pa1, pa2, pa3);
}
__device__ __forceinline__ void attn_unit(const bf16_t* __restrict__ Qb, const bf16_t* __restrict__ Kh, const bf16_t* __restrict__ Vh, float* __restrict__ Ob, int NT, int vis4, char* lds) {
  const int tid = tid_(), wid = tid >> 6, lane = tid & 63, r32 = lane & 31, hi = lane >> 5;
  const int vis = vis4 + (wid >> 1);
  bf16_t* V_lds = (bf16_t*)lds; bf16_t* K_lds = (bf16_t*)(lds + 2 * SHM_V);
  float* ws = (float*)(lds + 2 * SHM_V + 2 * SHM_K) + wid * 64; float* li_l = ws; float* al_l = ws + 32;
  float m_reg = NEG, l_reg = 0; f32x16 o[4] = {}; bf16x8 qr[8];
  const bf16_t* Qw = Qb + (long)(wid * QBLK + r32) * LDQK + hi * 8;
#pragma unroll
  for (int d0 = 0; d0 < 8; ++d0) qr[d0] = *reinterpret_cast<const bf16x8*>(Qw + d0 * 16);
  const int sr = tid >> 4, sc = (tid & 15) * 8, vst0 = v_st(sr, sc), vst1 = v_st(32 + sr, sc);
  const int vb0 = (int)(uintptr_t)V_lds + v_rd_base(lane);
  struct { bf16x8 vs0, vs1, ks0, ks1; } sr_[2];
#define SLOAD(i, k0) do { sr_[i].vs0 = *reinterpret_cast<const bf16x8*>(&Vh[(long)((k0) + sr) * LDQK + sc]); sr_[i].vs1 = *reinterpret_cast<const bf16x8*>(&Vh[(long)((k0) + 32 + sr) * LDQK + sc]); \
    sr_[i].ks0 = *reinterpret_cast<const bf16x8*>(&Kh[(long)((k0) + sr) * LDQK + sc]); sr_[i].ks1 = *reinterpret_cast<const bf16x8*>(&Kh[(long)((k0) + 32 + sr) * LDQK + sc]); } while (0)
#define SWRITE(b, i) do { *(bf16x8*)((char*)V_lds + (b) * SHM_V + vst0) = sr_[i].vs0;          \
    *(bf16x8*)((char*)V_lds + (b) * SHM_V + vst1) = sr_[i].vs1; int kc = sc * 2;               \
    *(bf16x8*)((char*)K_lds + (b) * SHM_K + KSWZ(sr, kc)) = sr_[i].ks0;                       \
    *(bf16x8*)((char*)K_lds + (b) * SHM_K + KSWZ(32 + sr, kc)) = sr_[i].ks1; } while (0)
#define SWAIT() asm volatile("s_waitcnt vmcnt(4)" ::: "memory")
#define RESC(a) do { if (__any((a) < 1.f)) { if (hi == 0) al_l[r32] = (a); asm volatile("s_waitcnt lgkmcnt(0)" ::: "memory"); \
    for (int d = 0; d < 4; ++d) for (int r = 0; r < 16; ++r) o[d][r] *= al_l[crow(r, hi)]; } } while (0)
  f32x16 pA0, pA1, pB0, pB1; float mnA, mnB, alA, alB; bf16x8 pa0, pa1, pa2, pa3;
  constexpr int SE = 0, SO = 1;
  SLOAD(SE, 0); asm volatile("s_waitcnt vmcnt(0)" ::: "memory"); SWRITE(0, SE); __syncthreads();
  qkt(pA0, pA1, K_lds, qr, r32, hi); mask_tile(pA0, pA1, 0, vis); partialSM(pA0, pA1, m_reg, mnA, alA);
  SLOAD(SO, KVBLK); if (2 < NT) SLOAD(SE, 2 * KVBLK);
  SWAIT(); SWRITE(1, SO); __syncthreads();
  for (int j = 1; j + 1 < NT; j += 2) {
    SBAR(); qkt(pB0, pB1, (bf16_t*)((char*)K_lds + SHM_K), qr, r32, hi); mask_tile(pB0, pB1, j, vis);
    finishSM(pA0, pA1, alA, l_reg, pa0, pa1, pa2, pa3); SBAR();
    SLOAD(SO, (j + 2) * KVBLK); SBAR();
    pv_d0(o, vb0, pa0, pa1, pa2, pa3); partialSM(pB0, pB1, m_reg, mnB, alB);
    __syncthreads(); SWAIT(); SWRITE(0, SE);
    RESC(alB); __syncthreads();
    SBAR(); qkt(pA0, pA1, K_lds, qr, r32, hi); mask_tile(pA0, pA1, j + 1, vis);
    finishSM(pB0, pB1, alB, l_reg, pa0, pa1, pa2, pa3); SBAR();
    if (j + 3 < NT) SLOAD(SE, (j + 3) * KVBLK); SBAR();
    pv_d0(o, vb0 + (int)SHM_V, pa0, pa1, pa2, pa3); partialSM(pA0, pA1, m_reg, mnA, alA);
    __syncthreads(); SWAIT(); SWRITE(1, SO);
    RESC(alA); __syncthreads();
  }
  SBAR(); qkt(pB0, pB1, (bf16_t*)((char*)K_lds + SHM_K), qr, r32, hi); mask_tile(pB0, pB1, NT - 1, vis);
  finishSM(pA0, pA1, alA, l_reg, pa0, pa1, pa2, pa3); SBAR();
  pv_d0(o, vb0, pa0, pa1, pa2, pa3); partialSM(pB0, pB1, m_reg, mnB, alB);
  __syncthreads(); RESC(alB);
  finishSM(pB0, pB1, alB, l_reg, pa0, pa1, pa2, pa3); SBAR();
  pv_d0(o, vb0 + (int)SHM_V, pa0, pa1, pa2, pa3);
  if (hi == 0) li_l[r32] = l_reg; asm volatile("s_waitcnt lgkmcnt(0)" ::: "memory");
  float rli[16];
#pragma unroll
  for (int r = 0; r < 16; ++r) rli[r] = __builtin_amdgcn_rcpf(li_l[crow(r, hi)]);
  float* Ow = Ob + (long)(wid * QBLK) * DM;
#pragma unroll
  for (int r = 0; r < 16; ++r) { int orow = crow(r, hi);
    for (int d0 = 0; d0 < 4; ++d0) Ow[(long)orow * DM + d0 * 32 + r32] = o[d0][r] * rli[r]; }
  __syncthreads();
#undef SLOAD
#undef SWRITE
#undef SWAIT
#undef RESC
}
#undef KSWZ
#undef SBAR
}

__device__ __forceinline__ void ph_attention(KP P, char* lds) {
    const bf16_t* QKV = P->QKV; float* OC = P->OC;
#pragma unroll 1
    for (int c = bid_(); c < 256; c += gridDim.x) {
        const int combo = c >> 2, b = combo >> 4, h = (combo >> 2) & 3, i = (combo >> 1) & 1, vh = combo & 1;
        const bf16_t* Kh = QKV + (size_t)(b * LL) * QKVW + 1024 + h * 256 + i * 128;
        const bf16_t* Vh = QKV + (size_t)(b * LL) * QKVW + 2048 + h * 256 + vh * 128;
#pragma unroll 1
        for (int s = 0; s < 2; ++s) {
            const int jb = s == 0 ? (c & 3) : 7 - (c & 3);
            const size_t row0 = (size_t)(b * LL) + NMETA + 256 * jb;
            fa::attn_unit(QKV + row0 * QKVW + h * 256 + i * 128, Kh, Vh, OC + row0 * DM + h * 512 + i * 256 + vh * 128, 4 * jb + 6, 4 * jb, lds);
        }
    }
#pragma unroll 1
    for (int gw0 = bid_() * 8; gw0 < 512; gw0 += gridDim.x * 8) {
        const int tid = tid_(), lane = tid & 63, gw = gw0 + (tid >> 6);
        if (gw < 512) {
            const int b = gw >> 7, h = (gw >> 5) & 3, i = (gw >> 4) & 1, row = gw & 15;
            const bf16_t* q = QKV + (size_t)(b * LL + row) * QKVW + h * 256 + i * 128;
            const int key = lane & 15;
            const bf16_t* k = QKV + (size_t)(b * LL + key) * QKVW + 1024 + h * 256 + i * 128;
            float sc = 0.f;
            { pg8::u32x4 qv[16], kv[16];
#pragma unroll
              for (int c8 = 0; c8 < 16; ++c8) { qv[c8] = *(const pg8::u32x4*)(q + c8 * 8); kv[c8] = *(const pg8::u32x4*)(k + c8 * 8); }
#pragma unroll
              for (int c8 = 0; c8 < 16; ++c8)
#pragma unroll
                  for (int w2 = 0; w2 < 4; ++w2) { const unsigned a = qv[c8][w2], bq = kv[c8][w2];
                      sc = fmaf(__uint_as_float(a << 16), __uint_as_float(bq << 16), sc); sc = fmaf(__uint_as_float(a & 0xffff0000u), __uint_as_float(bq & 0xffff0000u), sc); } }
            sc *= 0.08838834764831845f;
            float m = sc;
            m = fmaxf(m, swz_xor<8>(m)); m = fmaxf(m, swz_xor<4>(m)); m = fmaxf(m, swz_xor<2>(m)); m = fmaxf(m, swz_xor<1>(m));
            const float e = expf(sc - m);
            float ssum = e;
            ssum += swz_xor<8>(ssum); ssum += swz_xor<4>(ssum); ssum += swz_xor<2>(ssum); ssum += swz_xor<1>(ssum);
            const float p = e / ssum;
            float acc[4] = {0.f, 0.f, 0.f, 0.f};
#pragma unroll
            for (int j = 0; j < 16; ++j) {
                const float pj = __int_as_float(__builtin_amdgcn_readlane(__float_as_int(p), j));
                const uint2 v2 = *(const uint2*)(QKV + (size_t)(b * LL + j) * QKVW + 2048 + h * 256 + lane * 4);
                acc[0] = fmaf(pj, __uint_as_float(v2.x << 16), acc[0]); acc[1] = fmaf(pj, __uint_as_float(v2.x & 0xffff0000u), acc[1]);
                acc[2] = fmaf(pj, __uint_as_float(v2.y << 16), acc[2]); acc[3] = fmaf(pj, __uint_as_float(v2.y & 0xffff0000u), acc[3]);
            }
            float* o = OC + (size_t)(b * LL + row) * DM + h * 512 + i * 256 + lane * 4;
            *(float4*)o = make_float4(acc[0], acc[1], acc[2], acc[3]);
        }
    }
}


namespace hg {
using bf16x8 = __attribute__((ext_vector_type(8))) short;
using s16x4  = __attribute__((ext_vector_type(4))) short;
using f32x16 = __attribute__((ext_vector_type(16))) float;
using u32x4  = __attribute__((ext_vector_type(4))) unsigned;
constexpr int NCH = 33, NU = 16 * NCH;
constexpr int SK = 136;
constexpr int SS = 72;
__device__ __forceinline__ int crow(int r, int hi) { return (r & 3) + 8 * (r >> 2) + 4 * hi; }
__device__ __forceinline__ unsigned cvtpk(float lo, float hi) { unsigned r; asm volatile("v_cvt_pk_bf16_f32 %0, %1, %2" : "=v"(r) : "v"(lo), "v"(hi)); return r; }

__device__ __forceinline__ void prep(const float (&fpv)[16], float lbv, int c, int k, int tq, float* qsum, float (&b)[16], float (&kk)[16], float& bend, float& r) {
    float run = 0.f;
#pragma unroll
    for (int i = 0; i < 16; ++i) {
        const int t = 16 * tq + i; const bool valid = (c * 64 + t) < LL;
        const float kv = valid ? (1.f - lbv) * __builtin_amdgcn_rcpf(1.f + __expf(fpv[i])) : 0.f;
        kk[i] = kv; run += fmaxf(__logf(1.f - kv), -30.f); b[i] = run;
    }
    qsum[tq * 128 + k] = run;
    __syncthreads();
    const float q0 = qsum[k], q1 = qsum[128 + k], q2 = qsum[256 + k], q3 = qsum[384 + k];
    const float off = tq == 0 ? 0.f : (tq == 1 ? q0 : (tq == 2 ? q0 + q1 : q0 + q1 + q2));
    r = q0 + q1; bend = (q0 + q1) + (q2 + q3);
#pragma unroll
    for (int i = 0; i < 16; ++i) b[i] += off;
}
__device__ __forceinline__ void store16(bf16_t* dst, const float (&x)[16]) {
    u32x4 w0, w1;
    w0.x = cvtpk(x[0], x[1]); w0.y = cvtpk(x[2], x[3]); w0.z = cvtpk(x[4], x[5]); w0.w = cvtpk(x[6], x[7]);
    w1.x = cvtpk(x[8], x[9]); w1.y = cvtpk(x[10], x[11]); w1.z = cvtpk(x[12], x[13]); w1.w = cvtpk(x[14], x[15]);
    *(u32x4*)dst = w0; *(u32x4*)(dst + 8) = w1;
}

__device__ __forceinline__ void local_states(KP P, char* lds, int layer) {
    bf16_t* KhT = (bf16_t*)lds; bf16_t* VT = KhT + 128 * SS; float* qsum = (float*)(VT + 128 * SS);
    const float* PA = P->PA; const float* lbtab = P->lbtab + layer * 512; float* SLOC = P->SLOC; float* DEC = P->DEC;
    const int tid = tid_(), k = tid & 127, tq = tid >> 7, lane = tid & 63, wid = tid >> 6, r32 = lane & 31, hh = lane >> 5;
    for (int u = bid_(); u < NU; u += gridDim.x) {
        const int bh = u / NCH, c = u % NCH, b_ = bh >> 2, h = bh & 3; const size_t row0 = (size_t)b_ * LL + c * 64;
        float fpv[16], vv[16];
#pragma unroll
        for (int i = 0; i < 16; ++i) { const int t = 16 * tq + i; const bool valid = (c * 64 + t) < LL; const float* rp = PA + (row0 + (valid ? t : 0)) * PAW + h * 128 + k;
            fpv[i] = rp[512]; vv[i] = valid ? rp[1024] : 0.f; }
        float b[16], kk[16], bend, r;
        prep(fpv, lbtab[h * 128 + k], c, k, tq, qsum, b, kk, bend, r);
        float x[16];
#pragma unroll
        for (int i = 0; i < 16; ++i) x[i] = kk[i] * __expf(bend - b[i]);
        store16(KhT + k * SS + 16 * tq, x);
        store16(VT + k * SS + 16 * tq, vv);
        if (tq == 0) DEC[u * 128 + k] = __expf(bend);
        __syncthreads();
        const int vt = wid >> 1;
#pragma unroll
        for (int j = 0; j < 2; ++j) {
            const int kt = (wid & 1) * 2 + j;
            f32x16 acc = {};
#pragma unroll
            for (int sg = 0; sg < 4; ++sg) {
                const bf16x8 a = *(const bf16x8*)(VT + (vt * 32 + r32) * SS + sg * 16 + hh * 8);
                const bf16x8 bb = *(const bf16x8*)(KhT + (kt * 32 + r32) * SS + sg * 16 + hh * 8);
                acc = __builtin_amdgcn_mfma_f32_32x32x16_bf16(a, bb, acc, 0, 0, 0);
            }
            float* o = SLOC + (size_t)u * 16384 + kt * 32 + r32;
#pragma unroll
            for (int rg = 0; rg < 16; ++rg) o[(vt * 32 + crow(rg, hh)) * 128] = acc[rg];
        }
        __syncthreads();
    }
}
__device__ __forceinline__ void scan_states(KP P) {
    const float* SLOC = P->SLOC; const float* DEC = P->DEC; bf16_t* SPREV = P->SPREV;
    const int tid = tid_();
    for (int e = bid_() * NTHR + tid; e < 16 * 16384; e += gridDim.x * NTHR) {
        const int bh = e >> 14, vk = e & 16383, k = vk & 127;
        float d[NCH - 1], x[NCH - 1];
#pragma unroll
        for (int c = 0; c < NCH - 1; ++c) { const int u = bh * NCH + c; d[c] = DEC[u * 128 + k]; x[c] = SLOC[(size_t)u * 16384 + vk]; }
        float S = 0.f;
#pragma unroll
        for (int c = 0; c < NCH - 1; ++c) { S = fmaf(d[c], S, x[c]); SPREV[(size_t)(bh * NCH + c + 1) * 16384 + vk] = f2bf(S); }
    }
}
__device__ __forceinline__ void outputs(KP P, char* lds, int layer) {
    bf16_t* Qt = (bf16_t*)lds; bf16_t* Qh = Qt + 64 * SK; bf16_t* Kt = Qh + 64 * SK; bf16_t* VT = Kt + 64 * SK; bf16_t* SpT = VT + 128 * SS;
    float* qsum = (float*)(SpT + 128 * SK); float* part = qsum + 512;
    const float* PA = P->PA; const float* lbtab = P->lbtab + layer * 512; const bf16_t* SPREV = P->SPREV; const float* nw = P->hnw + layer * 128; bf16_t* MIX = P->MIX;
    const int tid = tid_(), k = tid & 127, tq = tid >> 7, lane = tid & 63, wid = tid >> 6, r32 = lane & 31, hh = lane >> 5;
    for (int u = bid_(); u < NU; u += gridDim.x) {
        const int bh = u / NCH, c = u % NCH, b_ = bh >> 2, h = bh & 3; const size_t row0 = (size_t)b_ * LL + c * 64;
        const int tt = wid & 1, vt = wid >> 1;
        float fpv[16], qv[16], vv[16]; u32x4 sp[4]; float4 gv[4];
#pragma unroll
        for (int i = 0; i < 16; ++i) { const int t = 16 * tq + i; const bool valid = (c * 64 + t) < LL; const float* rp = PA + (row0 + (valid ? t : 0)) * PAW + h * 128 + k;
            fpv[i] = rp[512]; qv[i] = valid ? rp[0] : 0.f; vv[i] = valid ? rp[1024] : 0.f; }
#pragma unroll
        for (int j = 0; j < 4; ++j) { const int idx = tid + 512 * j, v = idx >> 4, ch = idx & 15; sp[j] = *(const u32x4*)(SPREV + (size_t)(c > 0 ? u : u + 1) * 16384 + v * 128 + ch * 8); }
        { const int te = tt * 32 + r32; const float* gp = PA + (row0 + ((c * 64 + te) < LL ? te : 0)) * PAW + 1536 + h * 128 + vt * 32 + 4 * hh;
#pragma unroll
          for (int g4 = 0; g4 < 4; ++g4) gv[g4] = *(const float4*)(gp + 8 * g4); }
        float b[16], kk[16], bend, r;
        prep(fpv, lbtab[h * 128 + k], c, k, tq, qsum, b, kk, bend, r);
#pragma unroll
        for (int i = 0; i < 16; ++i) { const int t = 16 * tq + i; const float q = qv[i];
            Qt[t * SK + k] = f2bf(q * __expf(b[i] - r)); Qh[t * SK + k] = f2bf(q * __expf(b[i])); Kt[t * SK + k] = f2bf(kk[i] * __expf(r - b[i])); }
        store16(VT + k * SS + 16 * tq, vv);
        if (c > 0) {
#pragma unroll
            for (int j = 0; j < 4; ++j) { const int idx = tid + 512 * j, v = idx >> 4, ch = idx & 15; *(u32x4*)(SpT + v * SK + ch * 8) = sp[j]; }
        }
        __syncthreads();
        f32x16 oacc = {};
#pragma unroll
        for (int st = 0; st < 2; ++st) {
            if (st <= tt) {
                f32x16 sc = {};
#pragma unroll
                for (int d0 = 0; d0 < 8; ++d0) {
                    const bf16x8 a = *(const bf16x8*)(Kt + (st * 32 + r32) * SK + d0 * 16 + hh * 8);
                    const bf16x8 bq = *(const bf16x8*)(Qt + (tt * 32 + r32) * SK + d0 * 16 + hh * 8);
                    sc = __builtin_amdgcn_mfma_f32_32x32x16_bf16(a, bq, sc, 0, 0, 0);
                }
                if (st == tt) {
#pragma unroll
                    for (int rg = 0; rg < 16; ++rg) sc[rg] = (crow(rg, hh) <= r32) ? sc[rg] : 0.f;
                }
#pragma unroll
                for (int g = 0; g < 2; ++g) {
                    u32x4 w; w.x = cvtpk(sc[8 * g + 0], sc[8 * g + 1]); w.y = cvtpk(sc[8 * g + 2], sc[8 * g + 3]); w.z = cvtpk(sc[8 * g + 4], sc[8 * g + 5]); w.w = cvtpk(sc[8 * g + 6], sc[8 * g + 7]);
                    const bf16x8 pb = *reinterpret_cast<bf16x8*>(&w);
                    const bf16_t* vp = VT + (vt * 32 + r32) * SS + st * 32 + 16 * g + 4 * hh;
                    const s16x4 lo = *(const s16x4*)vp, hi4 = *(const s16x4*)(vp + 8);
                    const bf16x8 a = (bf16x8){lo[0], lo[1], lo[2], lo[3], hi4[0], hi4[1], hi4[2], hi4[3]};
                    oacc = __builtin_amdgcn_mfma_f32_32x32x16_bf16(a, pb, oacc, 0, 0, 0);
                }
            }
        }
        if (c > 0) {
#pragma unroll
            for (int d0 = 0; d0 < 8; ++d0) {
                const bf16x8 a = *(const bf16x8*)(SpT + (vt * 32 + r32) * SK + d0 * 16 + hh * 8);
                const bf16x8 bq = *(const bf16x8*)(Qh + (tt * 32 + r32) * SK + d0 * 16 + hh * 8);
                oacc = __builtin_amdgcn_mfma_f32_32x32x16_bf16(a, bq, oacc, 0, 0, 0);
            }
        }
        float ss = 0.f;
#pragma unroll
        for (int rg = 0; rg < 16; ++rg) ss = fmaf(oacc[rg], oacc[rg], ss);
        { auto rr = __builtin_amdgcn_permlane32_swap(__float_as_uint(ss), __float_as_uint(ss), false, false); ss = __uint_as_float(rr[0]) + __uint_as_float(rr[1]); }
        if (hh == 0) part[vt * 64 + tt * 32 + r32] = ss;
        __syncthreads();
        const int t = tt * 32 + r32;
        const float tot = (part[t] + part[64 + t]) + (part[128 + t] + part[192 + t]);
        const float scale = rsqrtf(tot * (1.f / 128.f) + EPS);
        if ((c * 64 + t) < LL) {
            bf16_t* op = MIX + (row0 + t) * DM + h * 128 + vt * 32;
#pragma unroll
            for (int g4 = 0; g4 < 4; ++g4) {
                const int v0 = 8 * g4 + 4 * hh;
                const float4 gg = gv[g4]; const float4 wv = *(const float4*)(nw + vt * 32 + v0);
                const float y0 = oacc[4 * g4 + 0] * scale * wv.x * gg.x / (1.f + __expf(-gg.x)), y1 = oacc[4 * g4 + 1] * scale * wv.y * gg.y / (1.f + __expf(-gg.y));
                const float y2 = oacc[4 * g4 + 2] * scale * wv.z * gg.z / (1.f + __expf(-gg.z)), y3 = oacc[4 * g4 + 3] * scale * wv.w * gg.w / (1.f + __expf(-gg.w));
                uint2 w; w.x = cvtpk(y0, y1); w.y = cvtpk(y2, y3);
                *(uint2*)(op + v0) = w;
            }
        }
        __syncthreads();
    }
}
}


namespace moe {
using bf16x8 = __attribute__((ext_vector_type(8))) short;
using f32x16 = __attribute__((ext_vector_type(16))) float;
using u32x4  = __attribute__((ext_vector_type(4))) unsigned;
constexpr int TW = 5, PROWS = 64 * TW, XS = 144, XBUF = PROWS * XS;
__device__ __forceinline__ unsigned cvtpk(float lo, float hi) { unsigned r; asm volatile("v_cvt_pk_bf16_f32 %0, %1, %2" : "=v"(r) : "v"(lo), "v"(hi)); return r; }
#define MOE_BAR() asm volatile("s_waitcnt lgkmcnt(0)\n\ts_barrier" ::: "memory")
constexpr int WD = 2;
constexpr int ABUF = 4 * 4 * 1024, AOFF = 2 * XBUF, LOFF = AOFF + 2 * ABUF;
template <bool UP>
__device__ __forceinline__ void stream_gemm(KP P, char* lds, int layer) {
    constexpr int KTOT = UP ? DM : DE, NSLAB = KTOT / 64, NCP = UP ? 2 : 4, LDW = UP ? DE : DM;
    static_assert(NSLAB % WD == 0 && NSLAB >= 2 * WD, "slab loop is unrolled by WD");
    const int tid = tid_(), lane = tid & 63, wid = tid >> 6, r32 = lane & 31, hh = lane >> 5, cg = wid & 3, th = wid >> 2;
    const int* cnt_ = P->cnt;
    const bf16_t* X = UP ? P->HN : P->H;
    int* basel = (int*)(lds + LOFF); int* tlist = basel + 64;
    for (int ub = bid_(); ub < 256; ub += gridDim.x) {
        const int u = ((ub & 7) << 5) | (ub >> 3);
        const int e = u >> 2, ns = u & 3;
        const int rot = ((u >> 2) * 11) & (NSLAB - 1);
        __syncthreads();
        if (tid < 64) basel[64 + 320 + tid] = cnt_[tid * CSTR];
        __syncthreads();
        if (tid < 64) { int a = 0; for (int q = 0; q < tid; ++q) a += basel[64 + 320 + q]; basel[tid] = a; }
        __syncthreads();
        const int cnt = cnt_[e * CSTR], row0 = basel[e];
        for (int pass0 = 0; pass0 < cnt; pass0 += PROWS) {
            const int cntp = (cnt - pass0) < PROWS ? (cnt - pass0) : PROWS;
            if constexpr (UP) { if (cnt <= ECAP) {
                __syncthreads();
                if (tid < PROWS && pass0 + tid < cnt) tlist[tid] = P->elist[e * ECAP + pass0 + tid];
                __syncthreads();
              } else {
                __syncthreads();
                const int* ridx = P->ridx; const int* rslot = P->rslot;
#pragma unroll 1
                for (int i0 = tid; i0 < NASSIGN; i0 += NTHR * 8) {
                    int ex[8], sl[8];
#pragma unroll
                    for (int q = 0; q < 8; ++q) { const int i = i0 + NTHR * q; ex[q] = i < NASSIGN ? ridx[i] : -1; sl[q] = i < NASSIGN ? rslot[i] : 0; }
#pragma unroll
                    for (int q = 0; q < 8; ++q) { const int sp = sl[q] - pass0; if (ex[q] == e && sp >= 0 && sp < PROWS) tlist[sp] = (i0 + NTHR * q) >> 1; }
                }
                __syncthreads();
            } }
            int xoff[5];
#pragma unroll
            for (int j = 0; j < 5; ++j) { int rho = (tid >> 3) + 64 * j; rho = rho < cntp ? rho : cntp - 1; const int grow = row0 + pass0 + rho;
                xoff[j] = (UP ? tlist[rho] * DM : grow * DE) + (tid & 7) * 8; }
            char* const xw = lds + (tid >> 3) * XS + (tid & 7) * 16;
            char* const aw = lds + AOFF + (cg * 4 + 2 * th) * 1024 + lane * 16;
            const char* const ar = lds + AOFF + cg * 4 * 1024 + lane * 16;
#pragma unroll 1
            for (int cp = 0; cp < NCP; ++cp) {
                const int cgi = cp * 4 + cg;
                const int kkw = wid >> 1, half = wid & 1;
                const float* wp;
                if constexpr (UP) wp = (r32 < 16 ? P->w1 : P->w3) + ((size_t)(layer * NE + e) * DM + kkw * 16 + 8 * hh + 4 * half) * DE + ns * 128 + cp * 64 + 4 * (r32 & 15);
                else wp = P->w2 + ((size_t)(layer * NE + e) * DE + 32 * hh + 2 * th) * DM + ns * 512 + cgi * 32 + r32;
                f32x16 acc[TW];
#pragma unroll
                for (int tl = 0; tl < TW; ++tl) acc[tl] = f32x16{};
                float wreg[WD][16]; u32x4 xs[5];
#define MOE_WLD1(wn_, R, li) do { if constexpr (UP) { if ((li) < 4) { const float4 t_ = *(const float4*)((wn_) + (size_t)(li) * DE); wreg[R][4 * (li)] = t_.x; wreg[R][4 * (li) + 1] = t_.y; wreg[R][4 * (li) + 2] = t_.z; wreg[R][4 * (li) + 3] = t_.w; } } \
                    else { if ((li) < 16) wreg[R][li] = (wn_)[(size_t)(((li) >> 3) + 4 * ((li) & 7)) * DM]; } } while (0)
#define MOE_WLOAD(slab, R) do { const float* wn_ = wp + (size_t)(((slab) + rot) & (NSLAB - 1)) * 64 * LDW; \
                    _Pragma("unroll") for (int li = 0; li < 16; ++li) MOE_WLD1(wn_, R, li); } while (0)
#define MOE_WPARK(R, PAR) do { if constexpr (UP) { _Pragma("unroll") for (int q = 0; q < 4; ++q) { uint2 fw; fw.x = cvtpk(wreg[R][q], wreg[R][4 + q]); fw.y = cvtpk(wreg[R][8 + q], wreg[R][12 + q]); \
                            *(uint2*)(lds + AOFF + (PAR) * ABUF + (q * 4 + kkw) * 1024 + lane * 16 + half * 8) = fw; } } \
                    else { _Pragma("unroll") for (int i = 0; i < 2; ++i) { u32x4 fw; fw.x = cvtpk(wreg[R][8 * i + 0], wreg[R][8 * i + 1]); fw.y = cvtpk(wreg[R][8 * i + 2], wreg[R][8 * i + 3]); \
                            fw.z = cvtpk(wreg[R][8 * i + 4], wreg[R][8 * i + 5]); fw.w = cvtpk(wreg[R][8 * i + 6], wreg[R][8 * i + 7]); *(u32x4*)(aw + (PAR) * ABUF + i * 1024) = fw; } } } while (0)
#pragma unroll
                for (int j = 0; j < 5; ++j) xs[j] = *(const u32x4*)(X + xoff[j] + (rot & (NSLAB - 1)) * 64);
                MOE_WLOAD(0, 0); MOE_WLOAD(1, 1);
#pragma unroll
                for (int j = 0; j < 5; ++j) *(u32x4*)(xw + 64 * j * XS) = xs[j];
                MOE_WPARK(0, 0); MOE_WLOAD(2, 0);
                MOE_BAR();
#define MOE_SLAB(s, PAR, R1) do { \
                    const int sx = ((s) + 1) < NSLAB ? (s) + 1 : NSLAB - 1, sw = ((s) + 1 + WD) < NSLAB ? (s) + 1 + WD : NSLAB - 1;     \
                    { const bf16_t* xn0_ = X + ((sx + rot) & (NSLAB - 1)) * 64; _Pragma("unroll") for (int j = 0; j < 5; ++j) xs[j] = *(const u32x4*)(xn0_ + xoff[j]); } \
                    MOE_WPARK(R1, 1 - (PAR)); \
                    const float* wn_ = wp + (size_t)((sw + rot) & (NSLAB - 1)) * 64 * LDW; \
                    const char* xb = lds + (PAR) * XBUF + (th * TW * 32 + r32) * XS + hh * 16; \
                    bf16x8 xq[4]; bf16x8 fq[2];                                                       \
                    xq[0] = *(const bf16x8*)(xb); xq[1] = *(const bf16x8*)(xb + 32 * XS); xq[2] = *(const bf16x8*)(xb + 64 * XS); \
                    fq[0] = *(const bf16x8*)(ar + (PAR) * ABUF); \
                    _Pragma("unroll") for (int kk = 0; kk < 4; ++kk) { \
                        if (kk < 3) fq[(kk + 1) & 1] = *(const bf16x8*)(ar + (PAR) * ABUF + (kk + 1) * 1024); \
                        _Pragma("unroll") for (int tl = 0; tl < TW; ++tl) { \
                            const int cur = kk * TW + tl, nx = cur + 3, nkk = nx / TW, ntl = nx % TW;       \
                            if (nx < 4 * TW) xq[nx & 3] = *(const bf16x8*)(xb + ntl * 32 * XS + nkk * 32); \
                            acc[tl] = __builtin_amdgcn_mfma_f32_32x32x16_bf16(fq[kk & 1], xq[cur & 3], acc[tl], 0, 0, 0); \
                            const int li = kk * TW + tl; \
                            MOE_WLD1(wn_, R1, li); \
                            __builtin_amdgcn_sched_barrier(0); } } \
                    _Pragma("unroll") for (int j = 0; j < 5; ++j) *(u32x4*)(xw + (1 - (PAR)) * XBUF + 64 * j * XS) = xs[j]; \
                    MOE_BAR(); } while (0)
#pragma unroll 1
                for (int s = 0; s < NSLAB; s += 2) { MOE_SLAB(s, 0, 1); MOE_SLAB(s + 1, 1, 0); }
#undef MOE_SLAB
#undef MOE_WLOAD
#undef MOE_WLD1
#undef MOE_WPARK
                const int T = (cntp + 31) >> 5;
                const int Tw = (T - TW * th) < 0 ? 0 : ((T - TW * th) > TW ? TW : (T - TW * th));
#pragma unroll
                for (int tl = 0; tl < TW; ++tl) if (tl < Tw) {
                    const int rho = (th * TW + tl) * 32 + r32;
                    if (rho < cntp) {
                        const size_t grow = (size_t)(row0 + pass0 + rho);
                        if constexpr (UP) {
                            bf16_t* hp = P->H + grow * DE + ns * 128 + cgi * 16 + 4 * hh;
#pragma unroll
                            for (int g = 0; g < 2; ++g) {
                                float y[4];
#pragma unroll
                                for (int q = 0; q < 4; ++q) { const float a = acc[tl][4 * g + q], b = acc[tl][8 + 4 * g + q]; y[q] = a / (1.f + __expf(-a)) * b; }
                                uint2 w; w.x = cvtpk(y[0], y[1]); w.y = cvtpk(y[2], y[3]);
                                *(uint2*)(hp + 8 * g) = w;
                            }
                        } else {
                            bf16_t* yp = P->Y + grow * DM + ns * 512 + cgi * 32 + 4 * hh;
#pragma unroll
                            for (int g = 0; g < 4; ++g) {
                                uint2 w; w.x = cvtpk(acc[tl][4 * g + 0], acc[tl][4 * g + 1]); w.y = cvtpk(acc[tl][4 * g + 2], acc[tl][4 * g + 3]);
                                *(uint2*)(yp + 8 * g) = w;
                            }
                        }
                    }
                }
            }
        }
    }
}
#undef MOE_BAR
}


namespace s5 {
using bf16x8 = __attribute__((ext_vector_type(8))) short;
using f32x16 = __attribute__((ext_vector_type(16))) float;
using u32x4  = __attribute__((ext_vector_type(4))) unsigned;
constexpr int NCHK = 516, NMT = 17;
__device__ __forceinline__ unsigned cvtpk(float lo, float hi) { unsigned r; asm volatile("v_cvt_pk_bf16_f32 %0, %1, %2" : "=v"(r) : "v"(lo), "v"(hi)); return r; }
__device__ __forceinline__ bf16x8 ld8f(const float* p) {
    const float4 a = *(const float4*)p, b = *(const float4*)(p + 4);
    u32x4 w; w.x = cvtpk(a.x, a.y); w.y = cvtpk(a.z, a.w); w.z = cvtpk(b.x, b.y); w.w = cvtpk(b.z, b.w);
    return *reinterpret_cast<bf16x8*>(&w);
}
__device__ __forceinline__ void prep_unit(KP P, char* lds, int layer, int g) {
    float2* pw = (float2*)lds; float2* bb = pw + 17 * 64; float2* cc = bb + 1024; float* kd = (float*)(cc + 1024);
    const int tid = tid_();
    const float dt = expf(P->log_dt[layer * 32 + g]);
    const float* a_re = P->a_re + (layer * 32 + g) * 64; const float* a_im = P->a_im + (layer * 32 + g) * 64;
    for (int idx = tid; idx < 17 * 64; idx += NTHR) { const int d = idx >> 6, p = idx & 63;
        const float mag = expf(a_re[p] * dt * (float)d), ang = a_im[p] * dt * (float)d; pw[idx] = make_float2(mag * cosf(ang), mag * sinf(ang)); }
    for (int idx = tid; idx < 1024; idx += NTHR) {
        { const int p = idx >> 4, c = idx & 15; const float are = a_re[p], aim = a_im[p];
          const float mag = expf(are * dt), abr = mag * cosf(aim * dt), abi = mag * sinf(aim * dt), den = are * are + aim * aim;
          const float zr = ((abr - 1.f) * are + abi * aim) / den, zi = (abi * are - (abr - 1.f) * aim) / den;
          const float br = P->b_re[((layer * 32 + g) * 64 + p) * 16 + c], bi = P->b_im[((layer * 32 + g) * 64 + p) * 16 + c];
          bb[idx] = make_float2(zr * br - zi * bi, zr * bi + zi * br); }
        { const int c = idx >> 6, p = idx & 63; cc[idx] = make_float2(P->c_re[((layer * 32 + g) * 16 + c) * 64 + p], P->c_im[((layer * 32 + g) * 16 + c) * 64 + p]); }
    }
    __syncthreads();
    if (tid < 64) ((float2*)P->A16)[(layer * 32 + g) * 64 + tid] = pw[16 * 64 + tid];
    for (int idx = tid; idx < 4096; idx += NTHR) { const int d = idx >> 8, c = (idx >> 4) & 15, c2 = idx & 15;
        float acc = 0.f;
        for (int p = 0; p < 64; ++p) { const float2 C = cc[c * 64 + p], W = pw[d * 64 + p], B = bb[p * 16 + c2];
            const float xr = C.x * W.x - C.y * W.y, xi = C.x * W.y + C.y * W.x; acc += xr * B.x - xi * B.y; }
        if (d == 0 && c == c2) acc += P->s5d[layer * 512 + g * 16 + c];
        kd[idx] = acc; }
    __syncthreads();
    bf16_t* BtY = P->BtY + (size_t)(layer * 32 + g) * 256 * 384; bf16_t* BtE = P->BtE + (size_t)(layer * 32 + g) * 128 * 256;
    for (int idx = tid; idx < 256 * 48; idx += NTHR) { const int n = idx / 48, ch = idx % 48, t = n >> 4, c = n & 15;
        float v[8];
        if (ch < 32) { const int s = ch >> 1, c0 = (ch & 1) * 8;
#pragma unroll
            for (int jj = 0; jj < 8; ++jj) v[jj] = (s <= t) ? kd[((t - s) * 16 + c) * 16 + c0 + jj] : 0.f;
        } else {
#pragma unroll
            for (int jj = 0; jj < 8; ++jj) { const int kq = (ch - 32) * 8 + jj, p = kq >> 1; const float2 C = cc[c * 64 + p], W = pw[(t + 1) * 64 + p];
                v[jj] = (kq & 1) ? -(C.x * W.y + C.y * W.x) : (C.x * W.x - C.y * W.y); }
        }
        u32x4 w; w.x = cvtpk(v[0], v[1]); w.y = cvtpk(v[2], v[3]); w.z = cvtpk(v[4], v[5]); w.w = cvtpk(v[6], v[7]);
        *(u32x4*)(BtY + ((size_t)(((n >> 5) * 24 + (ch >> 1)) * 64 + (ch & 1) * 32 + (n & 31))) * 8) = w; }
    for (int idx = tid; idx < 128 * 32; idx += NTHR) { const int n = idx >> 5, ch = idx & 31, p = n >> 1, s = ch >> 1, c0 = (ch & 1) * 8;
        const float2 W = pw[(15 - s) * 64 + p];
        float v[8];
#pragma unroll
        for (int jj = 0; jj < 8; ++jj) { const float2 B = bb[p * 16 + c0 + jj]; v[jj] = (n & 1) ? (W.x * B.y + W.y * B.x) : (W.x * B.x - W.y * B.y); }
        u32x4 w; w.x = cvtpk(v[0], v[1]); w.y = cvtpk(v[2], v[3]); w.z = cvtpk(v[4], v[5]); w.w = cvtpk(v[6], v[7]);
        *(u32x4*)(BtE + ((size_t)(((n >> 5) * 16 + (ch >> 1)) * 64 + (ch & 1) * 32 + (n & 31))) * 8) = w; }
    __syncthreads();
}
__device__ __forceinline__ float gelu_t(float x) { const float u = 0.7978845608028654f * (x + 0.044715f * x * x * x); const float e = __expf(2.f * u); return x - x / (e + 1.f); }
__device__ __forceinline__ void fused_unit(KP P, char* lds, int layer, int b, int g) {
    const int tid = tid_(), lane = tid & 63, wid = tid >> 6, r32 = lane & 31, hh = lane >> 5;
    constexpr int UCH = 528, UBYTES = 68352;
    char* U16 = lds; float* El = (float*)(lds + UBYTES);
    const float* PA = P->PA; bf16_t* YG = P->YG;
    { const float* ub = PA + (size_t)(b * LL) * PAW + 2048 + g * 16;
#pragma unroll 1
      for (int i0 = 0; i0 < LL * 4; i0 += NTHR * 4) {
          float4 v[4];
#pragma unroll
          for (int q = 0; q < 4; ++q) { const int idx = i0 + q * NTHR + tid, ic = idx < LL * 4 ? idx : LL * 4 - 1; v[q] = *(const float4*)(ub + (size_t)(ic >> 2) * PAW + (ic & 3) * 4); }
#pragma unroll
          for (int q = 0; q < 4; ++q) { const int idx = i0 + q * NTHR + tid; if (idx < LL * 4) { const int r = idx >> 2;
              uint2 w; w.x = cvtpk(v[q].x, v[q].y); w.y = cvtpk(v[q].z, v[q].w); *(uint2*)(U16 + (r >> 4) * UCH + (r & 15) * 32 + (idx & 3) * 8) = w; } }
      } }
    __syncthreads();
    int mrow[5];
#pragma unroll
    for (int mt = 0; mt < 5; ++mt) { const int m = mt * 32 + r32; mrow[mt] = m < 129 ? m : 128; }
    if (wid < 4) {
        const bf16_t* Bt = P->BtE + (size_t)(layer * 32 + g) * 128 * 256 + ((size_t)(wid * 16) * 64 + lane) * 8;
        f32x16 acc[5];
#pragma unroll
        for (int mt = 0; mt < 5; ++mt) acc[mt] = f32x16{};
#pragma unroll 4
        for (int s = 0; s < 16; ++s) {
            const bf16x8 af = *(const bf16x8*)(Bt + (size_t)(s * 64) * 8);
#pragma unroll
            for (int mt = 0; mt < 5; ++mt) { const bf16x8 bf = *(const bf16x8*)(U16 + mrow[mt] * UCH + hh * 16 + 32 * s); acc[mt] = __builtin_amdgcn_mfma_f32_32x32x16_bf16(af, bf, acc[mt], 0, 0, 0); }
        }
#pragma unroll
        for (int mt = 0; mt < 5; ++mt) { const int m = mt * 32 + r32; if (m < 129) { float* ep = El + m * 128 + wid * 32 + 4 * hh;
#pragma unroll
            for (int q = 0; q < 4; ++q) *(float4*)(ep + 8 * q) = make_float4(acc[mt][4 * q], acc[mt][4 * q + 1], acc[mt][4 * q + 2], acc[mt][4 * q + 3]); } }
    }
    __syncthreads();
    if (tid < 64) {
        const float2 A = ((const float2*)P->A16)[(layer * 32 + g) * 64 + tid];
        float2* e2 = (float2*)El + tid;
        float xr = 0.f, xi = 0.f;
#pragma unroll 1
        for (int j0 = 0; j0 < 128; j0 += 8) {
            float2 e[8];
#pragma unroll
            for (int i = 0; i < 8; ++i) e[i] = e2[(j0 + i) * 64];
#pragma unroll
            for (int i = 0; i < 8; ++i) { e2[(j0 + i) * 64] = make_float2(xr, xi);
                const float nr = A.x * xr - A.y * xi + e[i].x, ni = A.x * xi + A.y * xr + e[i].y; xr = nr; xi = ni; }
        }
        e2[128 * 64] = make_float2(xr, xi);
    }
    __syncthreads();
    {
        const bf16_t* Bt = P->BtY + (size_t)(layer * 32 + g) * 256 * 384 + ((size_t)(wid * 24) * 64 + lane) * 8;
        f32x16 acc[5];
#pragma unroll
        for (int mt = 0; mt < 5; ++mt) acc[mt] = f32x16{};
#pragma unroll 4
        for (int s = 0; s < 16; ++s) if (2 * wid + 1 >= s) {
            const bf16x8 af = *(const bf16x8*)(Bt + (size_t)(s * 64) * 8);
#pragma unroll
            for (int mt = 0; mt < 5; ++mt) { const bf16x8 bf = *(const bf16x8*)(U16 + mrow[mt] * UCH + hh * 16 + 32 * s); acc[mt] = __builtin_amdgcn_mfma_f32_32x32x16_bf16(af, bf, acc[mt], 0, 0, 0); }
        }
#pragma unroll 4
        for (int ks = 0; ks < 8; ++ks) {
            const bf16x8 af = *(const bf16x8*)(Bt + (size_t)((16 + ks) * 64) * 8);
#pragma unroll
            for (int mt = 0; mt < 5; ++mt) { const bf16x8 bf = ld8f(El + mrow[mt] * 128 + 8 * hh + ks * 16); acc[mt] = __builtin_amdgcn_mfma_f32_32x32x16_bf16(af, bf, acc[mt], 0, 0, 0); }
        }
#pragma unroll
        for (int mt = 0; mt < 5; ++mt) { const int ml = mt * 32 + r32; if (ml < 129) { const int m = b * 129 + ml;
#pragma unroll
            for (int q = 0; q < 4; ++q) { const int t = 2 * wid + (q >> 1);
                uint2 w; w.x = cvtpk(gelu_t(acc[mt][4 * q]), gelu_t(acc[mt][4 * q + 1])); w.y = cvtpk(gelu_t(acc[mt][4 * q + 2]), gelu_t(acc[mt][4 * q + 3]));
                *(uint2*)(YG + (size_t)(m * 16 + t) * 512 + g * 16 + 8 * (q & 1) + 4 * hh) = w; } } }
    }
    __syncthreads();
}
}

__device__ __forceinline__ float wave_sum(float v) {
    v += swz_xor<1>(v); v += swz_xor<2>(v); v += swz_xor<4>(v); v += swz_xor<8>(v); v += swz_xor<16>(v);
    { auto rr = __builtin_amdgcn_permlane32_swap(__float_as_uint(v), __float_as_uint(v), false, false); v = __uint_as_float(rr[0]) + __uint_as_float(rr[1]); }
    return v;
}
__device__ __forceinline__ unsigned cvtpk_(float lo, float hi) { unsigned r; asm volatile("v_cvt_pk_bf16_f32 %0, %1, %2" : "=v"(r) : "v"(lo), "v"(hi)); return r; }
__device__ __forceinline__ void ph_attn_out(KP P, int layer, int cu0) {
    const int tid = tid_(), lane = tid & 63, gw = (bid_() - cu0) * 8 + (tid >> 6), NGW = (gridDim.x - cu0) * 8;
    if (gw < 0) return;
    const float scale = 1.f - (0.8f - 0.6f * expf(-0.3f * (float)layer));
    const float lam = P->lam[layer];
    const float4 sw = ((const float4*)(P->subln + layer * 256))[lane];
    const float* OC = P->OC; bf16_t* MIX = P->MIX;
    for (int it0 = gw; it0 < TOK * 4; it0 += NGW * 4) {
        float4 a[4], b[4];
#pragma unroll
        for (int q = 0; q < 4; ++q) { const int it = it0 + NGW * q, itc = it < TOK * 4 ? it : TOK * 4 - 1, r = itc >> 2, h = itc & 3;
            a[q] = *(const float4*)(OC + (size_t)r * DM + h * 512 + lane * 4); b[q] = *(const float4*)(OC + (size_t)r * DM + h * 512 + 256 + lane * 4); }
#pragma unroll
        for (int q = 0; q < 4; ++q) { const int it = it0 + NGW * q; if (it < TOK * 4) { const int r = it >> 2, h = it & 3;
            const float o0 = a[q].x - lam * b[q].x, o1 = a[q].y - lam * b[q].y, o2 = a[q].z - lam * b[q].z, o3 = a[q].w - lam * b[q].w;
            const float ss = wave_sum(o0 * o0 + o1 * o1 + o2 * o2 + o3 * o3);
            const float rs = rsqrtf(ss * (1.f / 256.f) + EPS) * scale;
            uint2 w; w.x = cvtpk_(o0 * rs * sw.x, o1 * rs * sw.y); w.y = cvtpk_(o2 * rs * sw.z, o3 * rs * sw.w);
            *(uint2*)(MIX + (size_t)r * DM + 1024 + h * 256 + lane * 4) = w; } }
    }
}
__device__ __forceinline__ void ph_build_norm(KP P) {
    const int tid = tid_(), lane = tid & 63, gw = bid_() * 8 + (tid >> 6), NGW = gridDim.x * 8;
    for (int r = gw; r < MP; r += NGW) {
        float4 v[8];
        if (r < TOK) { const int b = r / LL, t = r % LL;
            const float4* src = (const float4*)(t < NMETA ? P->meta + (size_t)t * DM : P->x + ((size_t)b * SEQ + (t - NMETA)) * DM);
#pragma unroll
            for (int j = 0; j < 8; ++j) v[j] = src[lane + 64 * j];
        } else {
#pragma unroll
            for (int j = 0; j < 8; ++j) v[j] = make_float4(0.f, 0.f, 0.f, 0.f);
        }
        float ss = 0.f;
#pragma unroll
        for (int j = 0; j < 8; ++j) { ((float4*)(P->Z + (size_t)r * DM))[lane + 64 * j] = v[j]; ss += v[j].x * v[j].x + v[j].y * v[j].y + v[j].z * v[j].z + v[j].w * v[j].w; }
        const float rs = rsqrtf(wave_sum(ss) * (1.f / DM) + EPS);
#pragma unroll
        for (int j = 0; j < 8; ++j) { const float4 w = ((const float4*)P->ln1_w)[lane + 64 * j];
            uint2 o; o.x = cvtpk_(v[j].x * rs * w.x, v[j].y * rs * w.y); o.y = cvtpk_(v[j].z * rs * w.z, v[j].w * rs * w.w);
            ((uint2*)(P->HN + (size_t)r * DM))[lane + 64 * j] = o; }
    }
}
__device__ __forceinline__ void ph_prep(KP P) {
    const int tid = tid_();
    if (bid_() == 0) {
        const int c = tid;
        const float l0 = P->lbnd[c], l1 = P->lbnd[512 + c], m = fmaxf(l0, l1), e0 = expf(l0 - m), e1 = expf(l1 - m);
        P->lbtab[c] = 0.f; P->lbtab[512 + c] = e1 / (e0 + e1);
        if (c < 2) {
            float s1 = 0.f, s2 = 0.f;
            for (int i = 0; i < 128; ++i) { s1 += P->lq1[c * 128 + i] * P->lk1[c * 128 + i]; s2 += P->lq2[c * 128 + i] * P->lk2[c * 128 + i]; }
            const float li = 0.8f - 0.6f * expf(-0.3f * (float)c);
            P->lam[c] = expf(s1) - expf(s2) + li;
        }
    }
    for (int i = bid_() * NTHR + tid; i < 2 * 128 * 3 * 64 * 8; i += gridDim.x * NTHR) {
        const int jj = i & 7, ln = (i >> 3) & 63, ct = (i >> 9) % 3, ksg = ((i >> 9) / 3) & 127, layer = (i >> 9) / (3 * 128);
        const int jc = ct * 32 + (ln & 31), k = ksg * 16 + 8 * (ln >> 5) + jj;
        float v = 0.f;
        if (jc < 8) v = P->wrg[((size_t)layer * DM + k) * 8 + jc]; else if (jc < 72) v = P->wre[((size_t)layer * DM + k) * 64 + jc - 8];
        v *= P->ln2_w[layer * DM + k];
        const bf16_t hi = f2bf(v), lo = f2bf(v - bf2f(hi));
        const size_t o = ((size_t)((ksg * 3 + ct) * 64 + ln)) * 8 + jj;
        P->WRT[(size_t)(layer * 2 + 0) * 96 * DM + o] = hi; P->WRT[(size_t)(layer * 2 + 1) * 96 * DM + o] = lo;
    }
}
namespace rt {
using f32x16 = __attribute__((ext_vector_type(16))) float;
using bf16x8 = __attribute__((ext_vector_type(8))) short;
using u32x4  = __attribute__((ext_vector_type(4))) unsigned;
__device__ __forceinline__ void norm_router(KP P, char* lds, int layer) {
    const int tid = tid_(), lane = tid & 63, wid = tid >> 6, r32 = lane & 31, hh = lane >> 5;
    float* part = (float*)lds;
    float* ssqp = (float*)(lds + 98304);
    float* lg = ssqp + 256;
    float* rsv = lg + 32 * 97;
    const bf16_t* Whi = P->WRT + (size_t)(layer * 2 + 0) * 96 * DM; const bf16_t* Wlo = P->WRT + (size_t)(layer * 2 + 1) * 96 * DM;
    const float* Z = P->Z;
    float* st = (float*)lds + wid * (32 * 68);
    const int nunits = layer == 1 ? (NB * SEQ) / 32 : TOK / 32;
    for (int u = bid_(); u < nunits; u += gridDim.x) {
        const int tok0 = layer == 1 ? (u >> 6) * LL + NMETA + (u & 63) * 32 : u * 32, kb = wid * 256;
        if (false) {
            float* Zw = P->Z; const float* ZP = P->ZP;
            for (int i = tid; i < 32 * DM / 4; i += NTHR) { const int r = i / (DM / 4), c4 = i % (DM / 4);
                float4 z = ((const float4*)(Zw + (size_t)(tok0 + r) * DM))[c4];
#pragma unroll
                for (int ks = 0; ks < 8; ++ks) { const float4 p4 = ((const float4*)(ZP + ((size_t)ks * 256 + (tok0 - 8192 + r)) * DM))[c4]; z.x += p4.x; z.y += p4.y; z.z += p4.z; z.w += p4.w; }
                ((float4*)(Zw + (size_t)(tok0 + r) * DM))[c4] = z; }
            asm volatile("s_waitcnt vmcnt(0)" ::: "memory");
            __syncthreads();
        }
        f32x16 acc[3] = {f32x16{}, f32x16{}, f32x16{}};
        float sq8[8];
#pragma unroll
        for (int j = 0; j < 8; ++j) sq8[j] = 0.f;
        const float* zg = Z + (size_t)(tok0 + (lane >> 4)) * DM + kb + (lane & 15) * 4;
        float4 zs[8];
#pragma unroll
        for (int j = 0; j < 8; ++j) zs[j] = *(const float4*)(zg + (size_t)(4 * j) * DM);
#pragma unroll 1
        for (int sc = 0; sc < 4; ++sc) {
#pragma unroll
            for (int j = 0; j < 8; ++j) { const float4 z = zs[j]; sq8[j] += z.x * z.x + z.y * z.y + z.z * z.z + z.w * z.w;
                *(float4*)(st + ((lane >> 4) + 4 * j) * 68 + (lane & 15) * 4) = z; }
            const int scn = sc < 3 ? sc + 1 : 3;
#pragma unroll
            for (int j = 0; j < 8; ++j) zs[j] = *(const float4*)(zg + (size_t)(4 * j) * DM + scn * 64);
            asm volatile("s_waitcnt lgkmcnt(0)" ::: "memory");
            const bf16_t* wh = Whi + ((size_t)((wid * 16 + sc * 4) * 3) * 64 + lane) * 8; const bf16_t* wl = Wlo + ((size_t)((wid * 16 + sc * 4) * 3) * 64 + lane) * 8;
#pragma unroll
            for (int ks = 0; ks < 4; ++ks) {
                const float4 z0 = *(const float4*)(st + r32 * 68 + ks * 16 + 8 * hh), z1 = *(const float4*)(st + r32 * 68 + ks * 16 + 8 * hh + 4);
                u32x4 h; h.x = cvtpk_(z0.x, z0.y); h.y = cvtpk_(z0.z, z0.w); h.z = cvtpk_(z1.x, z1.y); h.w = cvtpk_(z1.z, z1.w);
                u32x4 l; l.x = cvtpk_(z0.x - __uint_as_float(h.x << 16), z0.y - __uint_as_float(h.x & 0xffff0000u)); l.y = cvtpk_(z0.z - __uint_as_float(h.y << 16), z0.w - __uint_as_float(h.y & 0xffff0000u));
                l.z = cvtpk_(z1.x - __uint_as_float(h.z << 16), z1.y - __uint_as_float(h.z & 0xffff0000u)); l.w = cvtpk_(z1.z - __uint_as_float(h.w << 16), z1.w - __uint_as_float(h.w & 0xffff0000u));
                const bf16x8 zh = *reinterpret_cast<bf16x8*>(&h), zl = *reinterpret_cast<bf16x8*>(&l);
#pragma unroll
                for (int ct = 0; ct < 3; ++ct) {
                    const bf16x8 ah = *(const bf16x8*)(wh + (size_t)((ks * 3 + ct) * 64) * 8), al = *(const bf16x8*)(wl + (size_t)((ks * 3 + ct) * 64) * 8);
                    acc[ct] = __builtin_amdgcn_mfma_f32_32x32x16_bf16(ah, zh, acc[ct], 0, 0, 0);
                    acc[ct] = __builtin_amdgcn_mfma_f32_32x32x16_bf16(ah, zl, acc[ct], 0, 0, 0);
                    acc[ct] = __builtin_amdgcn_mfma_f32_32x32x16_bf16(al, zh, acc[ct], 0, 0, 0);
                }
            }
            asm volatile("s_waitcnt lgkmcnt(0)" ::: "memory");
        }
#pragma unroll
        for (int j = 0; j < 8; ++j) { float v = sq8[j]; v += swz_xor<1>(v); v += swz_xor<2>(v); v += swz_xor<4>(v); v += swz_xor<8>(v); sq8[j] = v; }
        __syncthreads();
        if ((lane & 15) == 0) {
#pragma unroll
            for (int j = 0; j < 8; ++j) ssqp[wid * 32 + (lane >> 4) + 4 * j] = sq8[j];
        }

#pragma unroll
        for (int ct = 0; ct < 3; ++ct)
#pragma unroll
            for (int rg = 0; rg < 16; ++rg) part[((wid * 3 + ct) * 16 + rg) * 64 + lane] = acc[ct][rg];
        __syncthreads();
        if (tid < 32) { float t = 0.f;
#pragma unroll
            for (int w = 0; w < 8; ++w) t += ssqp[w * 32 + tid];
            rsv[tid] = rsqrtf(t * (1.f / DM) + EPS); }
#pragma unroll
        for (int q = 0; q < 6; ++q) { const int o = tid + NTHR * q, col = o >> 5, tok = o & 31, ct = col >> 5, cl = col & 31, h2 = (cl >> 2) & 1, rg = (cl & 3) + 4 * (cl >> 3);
            float t = 0.f;
#pragma unroll
            for (int w = 0; w < 8; ++w) t += part[((w * 3 + ct) * 16 + rg) * 64 + h2 * 32 + tok];
            lg[tok * 97 + col] = t; }
        __syncthreads();
        if (tid < 32) {
            const int t = tok0 + tid; const float rs = rsv[tid]; const float* l = lg + tid * 97;
            const float* brg = P->brg + layer * 8; const float* bre = P->bre + layer * 64;
            float gl[8];
#pragma unroll
            for (int j = 0; j < 8; ++j) gl[j] = l[j] * rs + brg[j];
            int gs = 0; float gm = gl[0];
#pragma unroll
            for (int j = 1; j < 8; ++j) if (gl[j] > gm) { gm = gl[j]; gs = j; }
            float den = 0.f;
#pragma unroll
            for (int j = 0; j < 8; ++j) den += expf(gl[j] - gm);
            const float pg = 1.f / den;
            float el[8];
#pragma unroll
            for (int j = 0; j < 8; ++j) el[j] = l[8 + gs * 8 + j] * rs + bre[gs * 8 + j];
            int j0 = 0; float v0 = el[0];
#pragma unroll
            for (int j = 1; j < 8; ++j) if (el[j] > v0) { v0 = el[j]; j0 = j; }
            int j1 = -1; float v1 = -INFINITY;
#pragma unroll
            for (int j = 0; j < 8; ++j) if (j != j0 && el[j] > v1) { v1 = el[j]; j1 = j; }
            const float e1 = expf(v1 - v0), g0 = pg / (1.f + e1), g1 = pg * e1 / (1.f + e1);
            const int x0 = gs * 8 + j0, x1 = gs * 8 + j1;
            P->ridx[t * 2] = x0; P->ridx[t * 2 + 1] = x1; P->rgate[t * 2] = g0; P->rgate[t * 2 + 1] = g1;
            const int s0 = atomicAdd(&P->cnt[x0 * CSTR], 1), s1 = atomicAdd(&P->cnt[x1 * CSTR], 1);
            P->rslot[t * 2] = s0; P->rslot[t * 2 + 1] = s1;
            if (s0 < ECAP) P->elist[x0 * ECAP + s0] = t; if (s1 < ECAP) P->elist[x1 * ECAP + s1] = t;
        }
#pragma unroll 1
        for (int q = 0; q < 4; q += 2) { const int tk = wid * 4 + q; const float rs0 = rsv[tk], rs1 = rsv[tk + 1];
            const float4* zr = (const float4*)(Z + (size_t)(tok0 + tk) * DM); const float4* wl4 = (const float4*)(P->ln2_w + layer * DM);
            float4 za[8], zb[8];
#pragma unroll
            for (int j = 0; j < 8; ++j) { za[j] = zr[lane + 64 * j]; zb[j] = zr[DM / 4 + lane + 64 * j]; }
#pragma unroll
            for (int j = 0; j < 8; ++j) { const float4 w = wl4[lane + 64 * j];
                uint2 o; o.x = cvtpk_(za[j].x * rs0 * w.x, za[j].y * rs0 * w.y); o.y = cvtpk_(za[j].z * rs0 * w.z, za[j].w * rs0 * w.w);
                ((uint2*)(P->HN + (size_t)(tok0 + tk) * DM))[lane + 64 * j] = o;
                o.x = cvtpk_(zb[j].x * rs1 * w.x, zb[j].y * rs1 * w.y); o.y = cvtpk_(zb[j].z * rs1 * w.z, zb[j].w * rs1 * w.w);
                ((uint2*)(P->HN + (size_t)(tok0 + tk + 1) * DM))[lane + 64 * j] = o; } }
        __syncthreads();
    }
}
}
__device__ __forceinline__ void ph_combine_norm(KP P, char* lds, int layer) {
    int* base = (int*)lds;
    const int tid = tid_(), lane = tid & 63, gw = bid_() * 8 + (tid >> 6), NGW = gridDim.x * 8;
    if (tid < 64) base[64 + tid] = P->cnt[tid * CSTR];
    __syncthreads();
    if (tid < 64) { int a = 0; for (int q = 0; q < tid; ++q) a += base[64 + q]; base[tid] = a; }
    __syncthreads();
    for (int t0 = gw; t0 < TOK; t0 += 2 * NGW) {
        int r0[2], r1[2]; float g0[2], g1[2]; bool ok[2]; int tcs[2];
        int2 ex[2], sl[2]; float2 gg[2];
        float4 v[2][8]; uint2 ya[2][8], yb[2][8];
#pragma unroll
        for (int q = 0; q < 2; ++q) { const int t = t0 + q * NGW; ok[q] = t < TOK && !(layer == 1 && (t % LL) < NMETA); tcs[q] = ok[q] ? t : (layer == 1 ? NMETA : t0);
            ex[q] = ((const int2*)P->ridx)[tcs[q]]; sl[q] = ((const int2*)P->rslot)[tcs[q]]; gg[q] = ((const float2*)P->rgate)[tcs[q]];
#pragma unroll
            for (int j = 0; j < 8; ++j) v[q][j] = ((const float4*)(P->Z + (size_t)tcs[q] * DM))[lane + 64 * j]; }
#pragma unroll
        for (int q = 0; q < 2; ++q) { r0[q] = base[ex[q].x] + sl[q].x; r1[q] = base[ex[q].y] + sl[q].y; g0[q] = gg[q].x; g1[q] = gg[q].y;
#pragma unroll
            for (int j = 0; j < 8; ++j) { ya[q][j] = ((const uint2*)(P->Y + (size_t)r0[q] * DM))[lane + 64 * j]; yb[q][j] = ((const uint2*)(P->Y + (size_t)r1[q] * DM))[lane + 64 * j]; } }
#pragma unroll
        for (int q = 0; q < 2; ++q) if (ok[q]) { const int t = t0 + q * NGW;
            float ss = 0.f;
#pragma unroll
            for (int j = 0; j < 8; ++j) { const uint2 a = ya[q][j], b = yb[q][j]; float4& x = v[q][j];
                x.x += g0[q] * __uint_as_float(a.x << 16) + g1[q] * __uint_as_float(b.x << 16); x.y += g0[q] * __uint_as_float(a.x & 0xffff0000u) + g1[q] * __uint_as_float(b.x & 0xffff0000u);
                x.z += g0[q] * __uint_as_float(a.y << 16) + g1[q] * __uint_as_float(b.y << 16); x.w += g0[q] * __uint_as_float(a.y & 0xffff0000u) + g1[q] * __uint_as_float(b.y & 0xffff0000u);
                ss += x.x * x.x + x.y * x.y + x.z * x.z + x.w * x.w; }
            const float rs = rsqrtf(wave_sum(ss) * (1.f / DM) + EPS);
            if (layer == 0) {
#pragma unroll
                for (int j = 0; j < 8; ++j) { ((float4*)(P->Z + (size_t)t * DM))[lane + 64 * j] = v[q][j];
                    const float4 w = ((const float4*)(P->ln1_w + DM))[lane + 64 * j];
                    uint2 o; o.x = cvtpk_(v[q][j].x * rs * w.x, v[q][j].y * rs * w.y); o.y = cvtpk_(v[q][j].z * rs * w.z, v[q][j].w * rs * w.w);
                    ((uint2*)(P->HN + (size_t)t * DM))[lane + 64 * j] = o; }
            } else {
                const int b = t / LL, tt = t % LL;
                if (tt >= NMETA) {
#pragma unroll
                    for (int j = 0; j < 8; ++j) { const float4 w = ((const float4*)P->fnw)[lane + 64 * j];
                        ((float4*)(P->out + ((size_t)b * SEQ + (tt - NMETA)) * DM))[lane + 64 * j] = make_float4(v[q][j].x * rs * w.x, v[q][j].y * rs * w.y, v[q][j].z * rs * w.z, v[q][j].w * rs * w.w); }
                }
            }
        }
    }
    __syncthreads();
}

__global__ void __launch_bounds__(NTHR, 2) mega_fwd(Params P_arg) {
    extern __shared__ __attribute__((aligned(16))) char lds[];
    const int tid = tid_(), G = gridDim.x;
    volatile LAS unsigned* ctlw = (volatile LAS unsigned*)((LAS char*)lds + LDS_CTL);
    if (tid < 64) ctlw[tid] = 0u;
    __syncthreads();
    KP P = kp_();
    XcdBarrier bar = xcd_barrier_post(P->bar, ctlw + 8);
#define GRID_BAR() do { xcd_barrier(bar); P = kp_(); } while (0)

    ph_build_norm(P);
    ph_prep(P);
    ph_weights(P, lds);
    __syncthreads();
    for (int un = bid_(); un < 64; un += G) s5::prep_unit(P, lds, un >> 5, un & 31);
    GRID_BAR();
#pragma unroll
    for (int layer = 0; layer < 2; ++layer) {
        { pg8::Gemm g{P->HN, P->WinT + (size_t)layer * INW * DM, MP, INW, DM, DM}; pg8::StaticOrder S; S.init(MP, INW, G, bid_(), DM / 64); pg8::EpiInProj E{P->PA, P->QKV};
          pg8::gemm_phase<pg8::EpiInProj, pg8::StaticOrder, true, true>((LAS unsigned char*)lds, g, S, E); }
        { const int t2 = tid_(), b2 = bid_(); if (b2 == 0 && t2 < NE) P->cnt[t2 * CSTR] = 0;
 }
        GRID_BAR();
        hg::local_states(P, lds, layer);
        { const int b0 = bid_(); for (int un = (G == 256) ? ((b0 + 128) & 255) : b0; un < 128; un += G) s5::fused_unit(P, lds, layer, un >> 5, un & 31); }
        ph_attention(P, lds);
        GRID_BAR();
        hg::scan_states(P);
        ph_attn_out(P, layer, G > 192 ? 132 : 0);
        __syncthreads();
        { pg8::Gemm g{P->YG, P->WgluT + (size_t)layer * 1024 * 512, MP, 1024, 512, 512}; pg8::StaticOrder S; S.init(MP, 1024, G, bid_(), 512 / 64); pg8::EpiGlu E{P->MIX, P->b_glu + layer * 1024};
          pg8::gemm_phase<pg8::EpiGlu, pg8::StaticOrder, true, true>((LAS unsigned char*)lds, g, S, E); }
        GRID_BAR();
        hg::outputs(P, lds, layer);
        GRID_BAR();
        { pg8::Gemm g{P->MIX, P->WoutT + (size_t)layer * DM * DM, MP, DM, DM, DM}; pg8::StaticOrder S; S.init(MP, DM, G, bid_(), DM / 64); pg8::EpiResidual E{P->Z};
          pg8::gemm_phase<pg8::EpiResidual, pg8::StaticOrder, true, true>((LAS unsigned char*)lds, g, S, E); }
        GRID_BAR();
        rt::norm_router(P, lds, layer);
        GRID_BAR();
        moe::stream_gemm<true>(P, lds, layer);
        GRID_BAR();
        moe::stream_gemm<false>(P, lds, layer);
        GRID_BAR();
        ph_combine_norm(P, lds, layer);
        if (layer == 0) GRID_BAR();
    }
}
}

extern "C" void kernel_launch(void* const* d_in, const int* in_sizes, int n_in, void* d_out, int out_size, void* d_ws, size_t ws_size, hipStream_t stream) {
    static int grid = 0;
    if (grid == 0) {
        int dev = 0, cus = 0;
        if (hipGetDevice(&dev) != hipSuccess || hipDeviceGetAttribute(&cus, hipDeviceAttributeMultiprocessorCount, dev) != hipSuccess) { grid = -1; return; }
        if (hipFuncSetAttribute((const void*)mega_fwd, hipFuncAttributeMaxDynamicSharedMemorySize, LDS_BYTES) != hipSuccess) { grid = -1; return; }
        int per_cu = 0;
        if (hipOccupancyMaxActiveBlocksPerMultiprocessor(&per_cu, (const void*)mega_fwd, NTHR, LDS_BYTES) != hipSuccess || per_cu < 1) { (void)hipGetLastError(); }
        grid = cus;
    }
    if (grid < 0) return;
    Params p{};
    const float** pin = (const float**)&p;
    for (int i = 0; i < 31; ++i) pin[i] = (const float*)d_in[i];
    p.out = (float*)d_out;
    char* ws = (char*)d_ws; size_t off = 0;
    auto alloc = [&](size_t bytes) { char* q = ws + off; off += (bytes + 255) & ~(size_t)255; return q; };
    p.bar = (unsigned*)alloc(XCD_BAR_WORDS * 4);
    p.elist = (int*)alloc((size_t)NE * ECAP * 4);
    p.cnt = (int*)alloc((size_t)NE * CSTR * 4); p.blk_e = (int*)alloc(1024); p.base = (int*)alloc(256);
    p.lbtab = (float*)alloc(1024 * 4); p.lam = (float*)alloc(256);
    p.Z = (float*)alloc((size_t)MP * DM * 4);
    p.HN = (bf16_t*)alloc((size_t)MP * DM * 2);
    p.PA = (float*)alloc((size_t)MP * PAW * 4);
    p.QKV = (bf16_t*)alloc((size_t)MP * QKVW * 2);
    p.OA = (float*)alloc((size_t)MP * HW * 4);
    p.ZP = (float*)alloc((size_t)8 * 256 * DM * 4);
    p.WRT = (bf16_t*)alloc((size_t)2 * 2 * 96 * DM * 2);
    p.A16 = (float*)alloc(2 * 32 * 64 * 8); p.S5E = (float*)alloc((size_t)516 * 32 * 128 * 4); p.S5X = (float*)alloc((size_t)516 * 32 * 128 * 4);
    p.BtY = (bf16_t*)alloc((size_t)2 * 32 * 256 * 384 * 2); p.BtE = (bf16_t*)alloc((size_t)2 * 32 * 128 * 256 * 2);
    p.SLOC = (float*)alloc((size_t)528 * 16384 * 4); p.DEC = (float*)alloc((size_t)528 * 128 * 4); p.SPREV = (bf16_t*)alloc((size_t)529 * 16384 * 2);
    p.YG = (bf16_t*)alloc((size_t)MP * 512 * 2);
    p.T = nullptr;
    p.MIX = (bf16_t*)alloc((size_t)MP * DM * 2);
    p.OC = (float*)alloc((size_t)MP * DM * 4);
    p.ridx = (int*)alloc((size_t)NASSIGN * 4); p.rgate = (float*)alloc((size_t)NASSIGN * 4); p.rslot = (int*)alloc((size_t)NASSIGN * 4);
    p.tokrow = (int*)alloc((size_t)NASSIGN * 4); p.rowtok = (int*)alloc((size_t)NRMAX * 4);
    p.H1 = nullptr;
    p.H = (bf16_t*)alloc((size_t)NRMAX * DE * 2);
    p.Y = (bf16_t*)alloc((size_t)NRMAX * DM * 2);
    p.S = nullptr;
    p.WinT = (bf16_t*)alloc((size_t)2 * INW * DM * 2); p.WoutT = (bf16_t*)alloc((size_t)2 * DM * DM * 2); p.WgluT = (bf16_t*)alloc((size_t)2 * 1024 * 512 * 2);
    if (off > ws_size) return;
    if (hipMemsetAsync(p.bar, 0, XCD_BAR_WORDS * 4, stream) != hipSuccess) return;
    hipLaunchKernelGGL(mega_fwd, dim3(grid), dim3(NTHR), LDS_BYTES, stream, p);
}
```

```cpp
#include <hip/hip_runtime.h>
#include <stdint.h>
#include <math.h>

namespace {
typedef unsigned short bf16_t;
constexpr int DM = 2048, NB = 4, SEQ = 2048, NMETA = 16, LL = SEQ + NMETA, TOK = NB * LL, MP = 8448;
constexpr int HW = 512;
constexpr int INW = 5632, PAW = 2560, QKVW = 3072;
constexpr int NE = 64, DE = 512, NASSIGN = TOK * 2;
constexpr int RB = 128;
constexpr int NRMAX = NASSIGN + NE * RB;
constexpr float EPS = 1e-6f;
constexpr int NTHR = 512;
constexpr int CSTR = 64;
constexpr int ECAP = 1024;
constexpr int LDS_BYTES = 147456;
constexpr int LDS_CTL = 143360;

__device__ __forceinline__ float bf2f(bf16_t h) { return __uint_as_float(((unsigned)h) << 16); }
__device__ __forceinline__ bf16_t f2bf(float f) { unsigned u = __float_as_uint(f); return (bf16_t)((u + 0x7fffu + ((u >> 16) & 1u)) >> 16); }
__device__ __forceinline__ float sigmoidf_(float x) { return 1.f / (1.f + expf(-x)); }
__device__ __forceinline__ int tid_() { int t = threadIdx.x; asm volatile("" : "+v"(t)); return t; }
template <int K> __device__ __forceinline__ float swz_xor(float v) { return __int_as_float(__builtin_amdgcn_ds_swizzle(__float_as_int(v), (K << 10) | 0x1f)); }
__device__ __forceinline__ int bid_() { int b = blockIdx.x; asm volatile("" : "+s"(b)); return b; }

#define XB_TMO      128
#define XB_XCNT(j)  (256  + 64 * (j))
#define XB_XSUB(j)  (1280 + 64 * (j))
#define XB_XGEN(j)  (2304 + 64 * (j))
#define XB_TOP      3328
#define XB_TOPGEN   3392
#define XCD_BAR_WORDS 3456
#define XB_SPIN_CAP (1u << 24)
#define LAS __attribute__((address_space(3)))
__device__ __forceinline__ unsigned xb_ld(unsigned* p)              { return __hip_atomic_load(p, __ATOMIC_RELAXED, __HIP_MEMORY_SCOPE_AGENT); }
__device__ __forceinline__ unsigned xb_add(unsigned* p, unsigned v) { return __hip_atomic_fetch_add(p, v, __ATOMIC_RELAXED, __HIP_MEMORY_SCOPE_AGENT); }
__device__ __forceinline__ unsigned xb_xcc_id() { return (unsigned)__builtin_amdgcn_s_getreg((3 << 11) | 20) & 0xFu; }
#define XB_SPIN(cond, bar) do { unsigned _sp = 0; while (cond) { __builtin_amdgcn_s_sleep(1); \
    if ((++_sp & 255u) == 0u) { if (xb_ld(&(bar)[XB_TMO])) break; if (_sp > XB_SPIN_CAP) { atomicAdd(&(bar)[XB_TMO], 1u); break; } } } } while (0)
struct XcdBarrier { unsigned* bar; unsigned x; volatile LAS unsigned* st; };
__device__ __forceinline__ XcdBarrier xcd_barrier_post(unsigned* bar, volatile LAS unsigned* st) {
    XcdBarrier b; b.bar = bar; b.x = xb_xcc_id(); b.st = st;
    if (threadIdx.x == 0) (void)xb_add(&bar[XB_XCNT(b.x)], 1u);
    return b;
}
__device__ __forceinline__ void xcd_barrier_complete(unsigned* bar, unsigned x, unsigned& nloc, unsigned& nx) {
    const unsigned G = gridDim.x * gridDim.y * gridDim.z;
    unsigned sum, cnt, mine, sp = 0u;
    for (;;) {
        sum = 0u; cnt = 0u; mine = 0u;
#pragma unroll
        for (unsigned j = 0; j < 16; ++j) { const unsigned c = xb_ld(&bar[XB_XCNT(j)]); sum += c; cnt += (c > 0u) ? 1u : 0u; mine = (j == x) ? c : mine; }
        if (sum == G) break;
        __builtin_amdgcn_s_sleep(1);
        if ((++sp & 255u) == 0u) { if (xb_ld(&bar[XB_TMO])) break; if (sp > XB_SPIN_CAP) { atomicAdd(&bar[XB_TMO], 1u); break; } }
    }
    nloc = mine > 0u ? mine : 1u; nx = cnt > 0u ? cnt : 1u;
}
__device__ __forceinline__ void xcd_barrier(const XcdBarrier& b) {
    asm volatile("s_waitcnt vmcnt(0)" ::: "memory");
    __syncthreads();
    if (threadIdx.x == 0) {
        unsigned* bar = b.bar;
        const unsigned bx_ = xb_xcc_id();
        __builtin_amdgcn_s_waitcnt(0);
        unsigned nloc = b.st[0], nx = b.st[1];
        if (nloc == 0u) { xcd_barrier_complete(bar, bx_, nloc, nx); b.st[0] = nloc; b.st[1] = nx; }
        const unsigned old = xb_add(&bar[XB_XSUB(bx_)], 1u);
        const unsigned gen = old / nloc;
        if (old + 1u == (gen + 1u) * nloc) {
            __builtin_amdgcn_fence(__ATOMIC_RELEASE, "agent");
            asm volatile("s_waitcnt vmcnt(0)" ::: "memory");
            const unsigned og = xb_add(&bar[XB_TOP], 1u);
            const unsigned tg = og / nx;
            if (og + 1u == (tg + 1u) * nx) xb_add(&bar[XB_TOPGEN], 1u);
            else XB_SPIN(xb_ld(&bar[XB_TOPGEN]) == tg, bar);
            __builtin_amdgcn_fence(__ATOMIC_ACQUIRE, "agent");
            xb_add(&bar[XB_XGEN(bx_)], 1u);
            asm volatile("s_waitcnt vmcnt(0)" ::: "memory");
        } else {
            XB_SPIN(xb_ld(&bar[XB_XGEN(bx_)]) == gen, bar);
            __builtin_amdgcn_fence(__ATOMIC_ACQUIRE, "agent");
            asm volatile("s_waitcnt vmcnt(0)" ::: "memory");
        }
    }
    __syncthreads();
}

struct Params {
    const float *x, *meta, *ln1_w, *w_in, *lbnd, *hnw, *a_re, *a_im, *b_re, *b_im, *c_re, *c_im, *s5d, *log_dt, *w_glu, *b_glu,
                *lq1, *lk1, *lq2, *lk2, *subln, *w_out, *ln2_w, *wrg, *brg, *wre, *bre, *w1, *w3, *w2, *fnw;
    float* out;
    unsigned* bar;
    int *cnt, *blk_e, *ridx, *rslot, *tokrow, *rowtok, *base, *elist;
    float *lbtab, *lam, *Z, *PA, *OA, *T, *OC, *rgate, *H1, *S, *SLOC, *DEC, *A16, *S5E, *S5X, *ZP;
    bf16_t *HN, *QKV, *YG, *MIX, *H, *Y, *WinT, *WoutT, *WgluT, *SPREV, *BtY, *BtE, *WRT;
};
typedef const __attribute__((address_space(4))) Params* KP;
__device__ __forceinline__ KP kp_() { KP p = (KP)__builtin_amdgcn_kernarg_segment_ptr(); asm volatile("" : "+s"(p)); return p; }


namespace pg8 {
#define PG8_LAS __attribute__((address_space(3)))
typedef short bf16x8 __attribute__((ext_vector_type(8)));
typedef float f32x4 __attribute__((ext_vector_type(4)));
typedef unsigned u32x4 __attribute__((ext_vector_type(4)));
constexpr int BM = 256, BK = 64, HALF = 128, HTB = HALF * BK * 2, STAGE_BYTES = 8 * HTB, NXCD = 8, WGM = 8;
__host__ __device__ __forceinline__ int lds_byte(int r, int c) { const int st = (r >> 4) * 2 + (c >> 5), rr = r & 15, cc = c & 31, ob = rr * 64 + cc * 2; return st * 1024 + (ob ^ (((ob >> 9) & 1) << 5)); }
__host__ __device__ __forceinline__ void stage_rc(int b, int& R, int& C) { const int st = b / 1024, sb = b % 1024, swz = sb ^ (((sb >> 9) & 1) << 5); R = (st >> 1) * 16 + swz / 64; C = (st & 1) * 32 + (swz % 64) / 2; }
__host__ __device__ __forceinline__ int perm32(int rho) { const int n = rho >> 4, i = rho & 15; return 8 * (i >> 2) + 4 * n + (i & 3); }
struct Unit { int pm, pn, ko, nt; };
struct Gemm { const bf16_t* A; const bf16_t* Bt; int M, N, K, ld; };
struct StaticOrder {
    static constexpr bool PER_UNIT_K = false;
    int nM, nN, nwg, G, c, nt;
    __host__ __device__ void init(int M, int N, int G_, int c_, int nt_) { nM = M / BM; nN = N / BM; nwg = nM * nN; G = G_; c = c_; nt = nt_; }
    __host__ __device__ bool next(int i, Unit& u) const {
        const long L = (long)i * G + c; if (L >= nwg) return false;
        int wgid = (int)L; { const int q = nwg / NXCD, r = nwg % NXCD, xcd = wgid % NXCD, off = wgid / NXCD; wgid = (xcd < r ? xcd * (q + 1) : r * (q + 1) + (xcd - r) * q) + off; }
        const int nig = WGM * nN, gid = wgid / nig, fm = gid * WGM, gsz = (nM - fm) < WGM ? (nM - fm) : WGM;
        u.pm = fm + ((wgid % nig) % gsz); u.pn = (wgid % nig) / gsz; u.ko = 0; u.nt = nt; return true;
    }
    __device__ __forceinline__ void a_ready(const Unit&) const {}
    __device__ __forceinline__ void done(const Unit&) const {}
};
__device__ __forceinline__ unsigned cvt_pk_bf16(float lo, float hi) { unsigned r; asm volatile("v_cvt_pk_bf16_f32 %0, %1, %2" : "=v"(r) : "v"(lo), "v"(hi)); return r; }

template <class Epi, class Sched, bool ALIGN_EPI = false, bool SP2 = false>
__device__ __forceinline__ void gemm_phase(PG8_LAS unsigned char* lds, const Gemm g, const Sched& S, const Epi& E) {
    const int tid = tid_(), wid = __builtin_amdgcn_readfirstlane(tid >> 6), lane = tid & 63, wr = wid >> 2, wc = wid & 3, fr = lane & 15, fq = lane >> 4;
    const int K = g.ld;
    unsigned voffA[2], voffB[2];
#pragma unroll
    for (int i = 0; i < 2; ++i) { int R, C; stage_rc(tid * 16 + i * 8192, R, C); const int Rb = Epi::PERM ? ((R & ~31) + perm32(R & 31)) : R;
        voffA[i] = (unsigned)(R * K + C) * 2u; voffB[i] = (unsigned)(Rb * K + C) * 2u; }
    const size_t kstep = (size_t)(BK * 2);
    const size_t hstep = (size_t)HALF * K * 2;
    const size_t tstep = 2 * hstep;
    const unsigned ldsw = (unsigned)wid * 1024u;
    const int aoff = lds_byte(wr * 64 + fr, fq * 8), boff = lds_byte(wc * 32 + fr, fq * 8);
#define PG8_SA(b, h) (((b) * 2 + (h)) * HTB)
#define PG8_SB(b, h) ((4 + (b) * 2 + (h)) * HTB)
#define PG8_STAGE(bufoff, gbase, voff) do { _Pragma("unroll") for (int _i = 0; _i < 2; ++_i) \
        __builtin_amdgcn_global_load_lds((const unsigned*)((const char*)(gbase) + (voff)[_i]), (PG8_LAS unsigned*)(lds + (bufoff) + ldsw + _i * 8192), 16, 0, 0); } while (0)
#define PG8_LDA(dst, b, h) do { _Pragma("unroll") for (int m = 0; m < 4; ++m) _Pragma("unroll") for (int k = 0; k < 2; ++k) dst[m][k] = *(const PG8_LAS bf16x8*)(lds + PG8_SA(b, h) + aoff + m * 2048 + k * 1024); } while (0)
#define PG8_LDB(dst, b, h) do { _Pragma("unroll") for (int n = 0; n < 2; ++n) _Pragma("unroll") for (int k = 0; k < 2; ++k) dst[n][k] = *(const PG8_LAS bf16x8*)(lds + PG8_SB(b, h) + boff + n * 2048 + k * 1024); } while (0)
#define PG8_MMA(ai, bj, At, Bt) do { __builtin_amdgcn_s_setprio(1); _Pragma("unroll") for (int m = 0; m < 4; ++m) _Pragma("unroll") for (int n = 0; n < 2; ++n) _Pragma("unroll") for (int k = 0; k < 2; ++k) \
        acc[ai][bj][m][n] = __builtin_amdgcn_mfma_f32_16x16x32_bf16(Bt[n][k], At[m][k], acc[ai][bj][m][n], 0, 0, 0); __builtin_amdgcn_s_setprio(0); } while (0)
#define PG8_WAIT_V(n) asm volatile("s_waitcnt vmcnt(" #n ")" ::: "memory")
#define PG8_WAIT_L(n) asm volatile("s_waitcnt lgkmcnt(" #n ")" ::: "memory")
#define PG8_BAR __builtin_amdgcn_s_barrier()
#define PG8_SCHED __builtin_amdgcn_sched_barrier(0)
    Unit cur, nxt; int ui = 0;
    if (!S.next(0, cur)) return;
    f32x4 acc[2][2][4][2];
#pragma unroll
    for (int a = 0; a < 2; ++a)
#pragma unroll
        for (int b = 0; b < 2; ++b)
#pragma unroll
            for (int m = 0; m < 4; ++m)
#pragma unroll
                for (int n = 0; n < 2; ++n) acc[a][b][m][n] = (f32x4){0.f, 0.f, 0.f, 0.f};
    bf16x8 At[4][2], B0[2][2], B1[2][2];
    const char* cA = (const char*)g.A + (size_t)cur.pm * tstep + (size_t)cur.ko * 2; const char* cB = (const char*)g.Bt + (size_t)cur.pn * tstep + (size_t)cur.ko * 2;
    S.a_ready(cur);
    if constexpr (SP2) {
        PG8_STAGE(PG8_SB(0, 0), cB, voffB); PG8_STAGE(PG8_SB(0, 1), cB + hstep, voffB); PG8_STAGE(PG8_SA(0, 0), cA, voffA); PG8_STAGE(PG8_SA(0, 1), cA + hstep, voffA);
        if (wr == 1) PG8_BAR;
        PG8_WAIT_V(2); PG8_BAR;
        PG8_STAGE(PG8_SB(1, 0), cB + kstep, voffB); PG8_STAGE(PG8_SA(1, 0), cA + kstep, voffA); PG8_STAGE(PG8_SB(1, 1), cB + hstep + kstep, voffB);
        PG8_WAIT_V(6); PG8_BAR;
    } else {
        PG8_STAGE(PG8_SB(0, 0), cB, voffB); PG8_STAGE(PG8_SA(0, 0), cA, voffA); PG8_STAGE(PG8_SB(0, 1), cB + hstep, voffB); PG8_STAGE(PG8_SA(0, 1), cA + hstep, voffA);
        if (wr == 1) PG8_BAR;
        PG8_WAIT_V(4); PG8_BAR;
        PG8_STAGE(PG8_SB(1, 0), cB + kstep, voffB); PG8_STAGE(PG8_SA(1, 0), cA + kstep, voffA); PG8_STAGE(PG8_SB(1, 1), cB + hstep + kstep, voffB);
        PG8_WAIT_V(6); PG8_BAR;
    }
    for (;;) {
        const bool has_next = S.next(ui + 1, nxt);
        const char* nA = has_next ? (const char*)g.A + (size_t)nxt.pm * tstep + (size_t)nxt.ko * 2 : cA; const char* nB = has_next ? (const char*)g.Bt + (size_t)nxt.pn * tstep + (size_t)nxt.ko * 2 : cB;
        const int nt = Sched::PER_UNIT_K ? cur.nt : g.K / BK;
        for (int t = 0; t < nt; t += 2) {
            const bool last = (t == nt - 2);
            const char* a1 = cA + (size_t)(t + 1) * kstep;
            const char* a2 = last ? nA : cA + (size_t)(t + 2) * kstep; const char* b2 = last ? nB : cB + (size_t)(t + 2) * kstep;
            const char* a3 = a2 + kstep; const char* b3 = b2 + kstep;
            if (last && has_next) S.a_ready(nxt);
            if constexpr (SP2) {
            PG8_LDB(B0, 0, 0); PG8_LDB(B1, 0, 1); PG8_SCHED; PG8_LDA(At, 0, 0); PG8_STAGE(PG8_SA(1, 1), a1 + hstep, voffA);
            PG8_WAIT_V(8); PG8_WAIT_L(0); PG8_BAR; PG8_MMA(0, 0, At, B0); PG8_MMA(0, 1, At, B1); PG8_BAR; PG8_SCHED;
            PG8_LDA(At, 0, 1); PG8_STAGE(PG8_SB(0, 0), b2, voffB); PG8_STAGE(PG8_SB(0, 1), b2 + hstep, voffB); PG8_STAGE(PG8_SA(0, 0), a2, voffA);
            PG8_WAIT_V(8); PG8_WAIT_L(0); PG8_BAR; PG8_MMA(1, 0, At, B0); PG8_MMA(1, 1, At, B1); PG8_BAR; PG8_SCHED;
            PG8_LDB(B0, 1, 0); PG8_LDB(B1, 1, 1); PG8_SCHED; PG8_LDA(At, 1, 0); PG8_STAGE(PG8_SA(0, 1), a2 + hstep, voffA);
            PG8_WAIT_V(8); PG8_WAIT_L(0); PG8_BAR; PG8_MMA(0, 0, At, B0); PG8_MMA(0, 1, At, B1); PG8_BAR; PG8_SCHED;
            PG8_LDA(At, 1, 1); PG8_STAGE(PG8_SB(1, 0), b3, voffB); PG8_STAGE(PG8_SB(1, 1), b3 + hstep, voffB); PG8_STAGE(PG8_SA(1, 0), a3, voffA);
            PG8_WAIT_V(8); PG8_WAIT_L(0); PG8_BAR; PG8_MMA(1, 0, At, B0); PG8_MMA(1, 1, At, B1); PG8_BAR; PG8_SCHED;
            } else {
            PG8_LDB(B0, 0, 0); PG8_SCHED; PG8_LDA(At, 0, 0); PG8_STAGE(PG8_SA(1, 1), a1 + hstep, voffA);
            PG8_WAIT_L(8); PG8_BAR; PG8_WAIT_L(0); PG8_MMA(0, 0, At, B0); PG8_BAR; PG8_SCHED;
            PG8_LDB(B1, 0, 1); PG8_STAGE(PG8_SB(0, 0), b2, voffB);
            PG8_BAR; PG8_WAIT_L(0); PG8_MMA(0, 1, At, B1); PG8_BAR;
            PG8_LDA(At, 0, 1); PG8_STAGE(PG8_SA(0, 0), a2, voffA);
            PG8_BAR; PG8_WAIT_L(0); PG8_MMA(1, 0, At, B0); PG8_BAR; PG8_SCHED;
            PG8_STAGE(PG8_SB(0, 1), b2 + hstep, voffB);
            PG8_WAIT_V(6); PG8_BAR; PG8_MMA(1, 1, At, B1); PG8_BAR;
            PG8_LDB(B0, 1, 0); PG8_SCHED; PG8_LDA(At, 1, 0); PG8_STAGE(PG8_SA(0, 1), a2 + hstep, voffA);
            PG8_WAIT_L(8); PG8_BAR; PG8_WAIT_L(0); PG8_MMA(0, 0, At, B0); PG8_BAR; PG8_SCHED;
            PG8_LDB(B1, 1, 1); PG8_STAGE(PG8_SB(1, 0), b3, voffB);
            PG8_BAR; PG8_WAIT_L(0); PG8_MMA(0, 1, At, B1); PG8_BAR;
            PG8_LDA(At, 1, 1); PG8_STAGE(PG8_SA(1, 0), a3, voffA);
            PG8_BAR; PG8_WAIT_L(0); PG8_MMA(1, 0, At, B0); PG8_BAR; PG8_SCHED;
            PG8_STAGE(PG8_SB(1, 1), b3 + hstep, voffB);
            PG8_WAIT_V(6); PG8_BAR; PG8_MMA(1, 1, At, B1); PG8_BAR;
            }
        }
        if constexpr (ALIGN_EPI) { if (wr == 0) PG8_BAR; }
        E(acc, cur, wr, wc, fr, fq);
        if (!has_next) break;
#pragma unroll
        for (int a = 0; a < 2; ++a)
#pragma unroll
            for (int b = 0; b < 2; ++b)
#pragma unroll
                for (int m = 0; m < 4; ++m)
#pragma unroll
                    for (int n = 0; n < 2; ++n) acc[a][b][m][n] = (f32x4){0.f, 0.f, 0.f, 0.f};
        cur = nxt; cA = nA; cB = nB; ++ui;
        if constexpr (ALIGN_EPI) { if (wr == 1) PG8_BAR; }
    }
    PG8_WAIT_V(0);
    if constexpr (!ALIGN_EPI) { if (wr == 0) PG8_BAR; }
    PG8_BAR;
#undef PG8_SA
#undef PG8_SB
#undef PG8_STAGE
#undef PG8_LDA
#undef PG8_LDB
#undef PG8_MMA
#undef PG8_WAIT_V
#undef PG8_WAIT_L
#undef PG8_BAR
#undef PG8_SCHED
}
struct EpiInProj {
    static constexpr bool PERM = true;
    float* PA; bf16_t* QKV;
    __device__ __forceinline__ void operator()(const f32x4 (&acc)[2][2][4][2], const Unit& u, int wr, int wc, int fr, int fq) const {
        const int row0 = u.pm * BM + wr * 64 + fr, colt = u.pn * BM + wc * 32 + 8 * fq;
        if (colt < PAW) {
#pragma unroll
            for (int ai = 0; ai < 2; ++ai)
#pragma unroll
                for (int m = 0; m < 4; ++m) { float* rp = PA + (size_t)(row0 + ai * HALF + m * 16) * PAW + colt;
#pragma unroll
                    for (int bj = 0; bj < 2; ++bj) { *(f32x4*)(rp + bj * HALF) = acc[ai][bj][m][0]; *(f32x4*)(rp + bj * HALF + 4) = acc[ai][bj][m][1]; } }
        } else {
#pragma unroll
            for (int ai = 0; ai < 2; ++ai)
#pragma unroll
                for (int m = 0; m < 4; ++m) { bf16_t* rp = QKV + (size_t)(row0 + ai * HALF + m * 16) * QKVW + (colt - PAW);
#pragma unroll
                    for (int bj = 0; bj < 2; ++bj) { const f32x4 v0 = acc[ai][bj][m][0], v1 = acc[ai][bj][m][1];
                        u32x4 w; w.x = cvt_pk_bf16(v0[0], v0[1]); w.y = cvt_pk_bf16(v0[2], v0[3]); w.z = cvt_pk_bf16(v1[0], v1[1]); w.w = cvt_pk_bf16(v1[2], v1[3]);
                        *(u32x4*)(rp + bj * HALF) = w; } }
        }
    }
};
struct EpiResidual {
    static constexpr bool PERM = true;
    float* Z;
    __device__ __forceinline__ void operator()(const f32x4 (&acc)[2][2][4][2], const Unit& u, int wr, int wc, int fr, int fq) const {
        const int row0 = u.pm * BM + wr * 64 + fr, colt = u.pn * BM + wc * 32 + 8 * fq;
#pragma unroll
        for (int ai = 0; ai < 2; ++ai)
#pragma unroll
            for (int m = 0; m < 4; ++m) { const int row = row0 + ai * HALF + m * 16; if (row < TOK) { float* rp = Z + (size_t)row * DM + colt;
#pragma unroll
                for (int bj = 0; bj < 2; ++bj) { f32x4* p0 = (f32x4*)(rp + bj * HALF); f32x4* p1 = (f32x4*)(rp + bj * HALF + 4);
                    const f32x4 z0 = *p0, z1 = *p1; *p0 = z0 + acc[ai][bj][m][0]; *p1 = z1 + acc[ai][bj][m][1]; } } }
    }
};
struct OutOrder {
    static constexpr bool PER_UNIT_K = true;
    StaticOrder main;
    __device__ bool next(int i, Unit& u) const {
        if (main.next(i, u)) return true;
        const int r0 = (main.nwg + main.G - 1) / main.G;
        const int L = (i - r0) * main.G + main.c; if (i < r0 || L >= 64) return false;
        u.pm = 32; u.pn = L & 7; u.ko = (L >> 3) * 256; u.nt = 4; return true; }
    __device__ __forceinline__ void a_ready(const Unit&) const {}
    __device__ __forceinline__ void done(const Unit&) const {}
};
struct EpiOutProj {
    static constexpr bool PERM = true;
    float* Z; float* ZP;
    __device__ __forceinline__ void operator()(const f32x4 (&acc)[2][2][4][2], const Unit& u, int wr, int wc, int fr, int fq) const {
        const bool tail = u.pm == 32;
        const int row0 = (tail ? (u.ko >> 8) * BM : u.pm * BM) + wr * 64 + fr, colt = u.pn * BM + wc * 32 + 8 * fq;
        float* base = tail ? ZP : Z;
#pragma unroll
        for (int ai = 0; ai < 2; ++ai)
#pragma unroll
            for (int m = 0; m < 4; ++m) { float* rp = base + (size_t)(row0 + ai * HALF + m * 16) * DM + colt;
#pragma unroll
                for (int bj = 0; bj < 2; ++bj) { f32x4* p0 = (f32x4*)(rp + bj * HALF); f32x4* p1 = (f32x4*)(rp + bj * HALF + 4);
                    f32x4 z0 = {0.f, 0.f, 0.f, 0.f}, z1 = {0.f, 0.f, 0.f, 0.f};
                    if (!tail) { z0 = *p0; z1 = *p1; }
                    *p0 = z0 + acc[ai][bj][m][0]; *p1 = z1 + acc[ai][bj][m][1]; } }
    }
};
struct TailOrder {
    static constexpr bool PER_UNIT_K = false;
    int G, c;
    __device__ bool next(int i, Unit& u) const { const int L = i * G + c; if (L >= 64) return false; u.pm = 32; u.pn = L & 7; u.ko = (L >> 3) * 256; u.nt = 4; return true; }
    __device__ __forceinline__ void a_ready(const Unit&) const {}
    __device__ __forceinline__ void done(const Unit&) const {}
};
struct EpiTailPartial {
    static constexpr bool PERM = true;
    float* ZP;
    __device__ __forceinline__ void operator()(const f32x4 (&acc)[2][2][4][2], const Unit& u, int wr, int wc, int fr, int fq) const {
        const int row0 = (u.ko >> 8) * BM + wr * 64 + fr, colt = u.pn * BM + wc * 32 + 8 * fq;
#pragma unroll
        for (int ai = 0; ai < 2; ++ai)
#pragma unroll
            for (int m = 0; m < 4; ++m) { float* rp = ZP + (size_t)(row0 + ai * HALF + m * 16) * DM + colt;
#pragma unroll
                for (int bj = 0; bj < 2; ++bj) { *(f32x4*)(rp + bj * HALF) = acc[ai][bj][m][0]; *(f32x4*)(rp + bj * HALF + 4) = acc[ai][bj][m][1]; } }
    }
};
struct EpiGlu {
    static constexpr bool PERM = true;
    bf16_t* MIX; const float* bias;
    __device__ __forceinline__ void operator()(const f32x4 (&acc)[2][2][4][2], const Unit& u, int wr, int wc, int fr, int fq) const {
        const int row0 = u.pm * BM + wr * 64 + fr, c0 = u.pn * HALF + wc * 32 + 8 * fq;
        const f32x4 bv0 = *(const f32x4*)(bias + c0), bv1 = *(const f32x4*)(bias + c0 + 4), bg0 = *(const f32x4*)(bias + 512 + c0), bg1 = *(const f32x4*)(bias + 512 + c0 + 4);
        float one = 1.f; asm volatile("" : "+v"(one));
#pragma unroll
        for (int ai = 0; ai < 2; ++ai)
#pragma unroll
            for (int m = 0; m < 4; ++m) { const f32x4 v0 = acc[ai][0][m][0] + bv0, v1 = acc[ai][0][m][1] + bv1, g0 = acc[ai][1][m][0] + bg0, g1 = acc[ai][1][m][1] + bg1;
                float o[8];
#pragma unroll
                for (int e = 0; e < 4; ++e) { o[e] = v0[e] * __builtin_amdgcn_rcpf(one + __expf(-g0[e])); o[4 + e] = v1[e] * __builtin_amdgcn_rcpf(one + __expf(-g1[e])); }
                u32x4 w; w.x = cvt_pk_bf16(o[0], o[1]); w.y = cvt_pk_bf16(o[2], o[3]); w.z = cvt_pk_bf16(o[4], o[5]); w.w = cvt_pk_bf16(o[6], o[7]);
                *(u32x4*)(MIX + (size_t)(row0 + ai * HALF + m * 16) * DM + 512 + c0) = w; }
    }
};
}

__device__ __forceinline__ void transpose_item(const float* W, int K, int N, bf16_t* WT, int k0, int n0, int row0, float* scr, int lane) {
    float tv[32];
#pragma unroll
    for (int i = 0; i < 32; ++i) { const int kk = 2 * i + (lane >> 5); tv[i] = W[(size_t)(k0 + kk) * N + n0 + (lane & 31)]; }
#pragma unroll
    for (int i = 0; i < 32; ++i) { const int kk = 2 * i + (lane >> 5); scr[kk * 33 + (lane & 31)] = tv[i]; }
    asm volatile("s_waitcnt lgkmcnt(0)" ::: "memory");
    const int c = lane & 7;
#pragma unroll
    for (int j = 0; j < 4; ++j) { const int n = (lane >> 3) + 8 * j; const float* sp = scr + (8 * c) * 33 + n;
        pg8::u32x4 o; o.x = pg8::cvt_pk_bf16(sp[0 * 33], sp[1 * 33]); o.y = pg8::cvt_pk_bf16(sp[2 * 33], sp[3 * 33]); o.z = pg8::cvt_pk_bf16(sp[4 * 33], sp[5 * 33]); o.w = pg8::cvt_pk_bf16(sp[6 * 33], sp[7 * 33]);
        *(pg8::u32x4*)(WT + (size_t)(row0 + n) * K + k0 + 8 * c) = o; }
    asm volatile("s_waitcnt lgkmcnt(0)" ::: "memory");
}
__device__ __forceinline__ void ph_weights(KP P, char* lds) {
    const int tid = tid_(), lane = tid & 63, wave = tid >> 6;
    float* scr = (float*)lds + wave * (64 * 33);
    const int cu0 = gridDim.x == 256 ? 64 : 0, gw = (bid_() - cu0) * 8 + wave, NGW = (gridDim.x - cu0) * 8;
    if (gw < 0) return;
    constexpr int I_IN = (DM / 64) * (INW / 32), I_OUT = (DM / 64) * (DM / 32), I_GLU = (512 / 64) * (1024 / 32), I_L = I_IN + I_OUT + I_GLU;
    for (int it = gw; it < 2 * I_L; it += NGW) {
        const int layer = it / I_L; int r = it % I_L;
        if (r < I_IN) { const int nb = INW / 32, kb = r / nb, n0 = (r % nb) * 32;
            transpose_item(P->w_in + (size_t)layer * DM * INW, DM, INW, P->WinT + (size_t)layer * INW * DM, kb * 64, n0, n0, scr, lane); continue; }
        r -= I_IN;
        if (r < I_OUT) { const int nb = DM / 32, kb = r / nb, n0 = (r % nb) * 32;
            transpose_item(P->w_out + (size_t)layer * DM * DM, DM, DM, P->WoutT + (size_t)layer * DM * DM, kb * 64, n0, n0, scr, lane); continue; }
        r -= I_OUT;
        { const int nb = 1024 / 32, kb = r / nb, n0 = (r % nb) * 32;
          const int row0 = ((n0 & 511) >> 7) * 256 + (n0 >> 9) * 128 + (n0 & 127);
          transpose_item(P->w_glu + (size_t)layer * 512 * 1024, 512, 1024, P->WgluT + (size_t)layer * 1024 * 512, kb * 64, n0, row0, scr, lane); }
    }
}


namespace fa {
using bf16x8 = __attribute__((ext_vector_type(8))) short;
using s16x4  = __attribute__((ext_vector_type(4))) short;
using f32x16 = __attribute__((ext_vector_type(16))) float;
using u32x4  = __attribute__((ext_vector_type(4))) unsigned;
constexpr int D = 128, NW = 8, QBLK = 32, KVBLK = 64, LDQK = QKVW;
constexpr float SCALE = 0.088388347648318440f, THR = 8.f, NEG = -1e30f;
constexpr size_t SHM_V = KVBLK * D * 2, SHM_K = KVBLK * D * 2, SHM_ATTN = 2 * SHM_V + 2 * SHM_K + NW * 64 * 4;
#define KSWZ(row, colB) ((row) * 256 + ((colB) ^ (((row) & 7) << 4)))
#define SBAR() __builtin_amdgcn_sched_barrier(0)
__device__ __forceinline__ int crow(int r, int hi) { return (r & 3) + 8 * (r >> 2) + 4 * hi; }
__device__ __forceinline__ unsigned cvtpk(float lo, float hi) { unsigned r; asm volatile("v_cvt_pk_bf16_f32 %0, %1, %2" : "=v"(r) : "v"(lo), "v"(hi)); return r; }
__device__ __forceinline__ void partialSM(f32x16& p0, f32x16& p1, float& m_reg, float& mn, float& alpha) {
  constexpr float C = SCALE * 1.4426950408889634f;
  float pmax = p0[0]; for (int r = 1; r < 16; ++r) pmax = fmaxf(pmax, p0[r]); for (int r = 0; r < 16; ++r) pmax = fmaxf(pmax, p1[r]);
  { auto rr = __builtin_amdgcn_permlane32_swap(__float_as_uint(pmax), __float_as_uint(pmax), false, false);
    pmax = fmaxf(__uint_as_float(rr[0]), __uint_as_float(rr[1])); }
  if (__builtin_expect(__all(pmax - m_reg <= THR / SCALE), 1)) { mn = m_reg; alpha = 1.f; }
  else { mn = fmaxf(m_reg, pmax); alpha = __builtin_amdgcn_exp2f((m_reg - mn) * C); m_reg = mn; }
  float mnC = -mn * C;
  for (int r = 0; r < 16; ++r) p0[r] = fmaf(p0[r], C, mnC); for (int r = 0; r < 16; ++r) p1[r] = fmaf(p1[r], C, mnC);
  for (int r = 0; r < 16; ++r) p0[r] = __builtin_amdgcn_exp2f(p0[r]);
}
__device__ __forceinline__ void finishSM(f32x16& p0, f32x16& p1, float alpha, float& l_reg, bf16x8& pa0, bf16x8& pa1, bf16x8& pa2, bf16x8& pa3) {
  for (int r = 0; r < 16; ++r) p1[r] = __builtin_amdgcn_exp2f(p1[r]);
  float ps = 0; for (int r = 0; r < 16; ++r) ps += p0[r]; for (int r = 0; r < 16; ++r) ps += p1[r];
  { auto rr = __builtin_amdgcn_permlane32_swap(__float_as_uint(ps), __float_as_uint(ps), false, false);
    ps = __uint_as_float(rr[0]) + __uint_as_float(rr[1]); }
  l_reg = l_reg * alpha + ps;
#define PK4(P, BASE, OUT) do { unsigned a0 = cvtpk(P[BASE + 0], P[BASE + 1]), a1 = cvtpk(P[BASE + 2], P[BASE + 3]);   \
    unsigned b0 = cvtpk(P[BASE + 4], P[BASE + 5]), b1 = cvtpk(P[BASE + 6], P[BASE + 7]);                              \
    auto r0 = __builtin_amdgcn_permlane32_swap(a0, b0, false, false); auto r1 = __builtin_amdgcn_permlane32_swap(a1, b1, false, false); \
    u32x4 w = {r0[0], r1[0], r0[1], r1[1]}; OUT = *reinterpret_cast<bf16x8*>(&w); } while (0)
  PK4(p0, 0, pa0); PK4(p0, 8, pa1); PK4(p1, 0, pa2); PK4(p1, 8, pa3);
#undef PK4
}
__device__ __forceinline__ void qkt(f32x16& p0, f32x16& p1, const bf16_t* Ks, const bf16x8* qr, int r32, int hi) {
  p0 = f32x16{}; p1 = f32x16{};
  for (int d0 = 0; d0 < 8; ++d0) { int cb = (d0 * 16 + hi * 8) * 2;
    bf16x8 b0 = *reinterpret_cast<const bf16x8*>((const char*)Ks + KSWZ(r32, cb));
    bf16x8 b1 = *reinterpret_cast<const bf16x8*>((const char*)Ks + KSWZ(32 + r32, cb));
    p0 = __builtin_amdgcn_mfma_f32_32x32x16_bf16(b0, qr[d0], p0, 0, 0, 0);
    p1 = __builtin_amdgcn_mfma_f32_32x32x16_bf16(b1, qr[d0], p1, 0, 0, 0); }
}
__device__ __forceinline__ void mask_tile(f32x16& p0, f32x16& p1, int kt, int vis) {
  if (kt > vis) {
    const bool part = (kt == vis + 1);
    for (int r = 0; r < 16; ++r) p1[r] = NEG;
    for (int r = 8; r < 16; ++r) p0[r] = NEG;
    if (!part) for (int r = 0; r < 8; ++r) p0[r] = NEG;
  }
}
__device__ __forceinline__ int v_st(int k, int c) { const int kk = (k & ~0xC) | ((k & 4) << 1) | ((k & 8) >> 1); return ((kk >> 3) * 4 + (c >> 5)) * 512 + ((kk & 7) * 32 + (c & 31)) * 2; }
__device__ __forceinline__ int v_rd_base(int lane) { return ((lane & 3) << 3) | (((lane >> 2) & 3) << 6) | (((lane >> 4) & 1) << 5) | (((lane >> 5) & 1) << 8); }
constexpr int v_rd_off(int d0, int ks, int half) { return d0 * 512 + ks * 4096 + half * 2048; }
template <int OFF> __device__ __forceinline__ s16x4 tr_read(int vb) {
  s16x4 r; asm volatile("ds_read_b64_tr_b16 %0, %1 offset:%2" : "=&v"(r) : "v"(vb), "i"(OFF) : "memory"); return r;
}
template <int D0> __device__ __forceinline__ void pv_one(f32x16& od, int vb, bf16x8 pa0, bf16x8 pa1, bf16x8 pa2, bf16x8 pa3) {
  const s16x4 l0 = tr_read<v_rd_off(D0, 0, 0)>(vb), h0 = tr_read<v_rd_off(D0, 0, 1)>(vb), l1 = tr_read<v_rd_off(D0, 1, 0)>(vb), h1 = tr_read<v_rd_off(D0, 1, 1)>(vb);
  const s16x4 l2 = tr_read<v_rd_off(D0, 2, 0)>(vb), h2 = tr_read<v_rd_off(D0, 2, 1)>(vb), l3 = tr_read<v_rd_off(D0, 3, 0)>(vb), h3 = tr_read<v_rd_off(D0, 3, 1)>(vb);
  asm volatile("s_waitcnt lgkmcnt(0)" ::: "memory"); SBAR();
#define PK(L, H) (bf16x8){L[0], L[1], L[2], L[3], H[0], H[1], H[2], H[3]}
  od = __builtin_amdgcn_mfma_f32_32x32x16_bf16(pa0, PK(l0, h0), od, 0, 0, 0);
  od = __builtin_amdgcn_mfma_f32_32x32x16_bf16(pa1, PK(l1, h1), od, 0, 0, 0);
  od = __builtin_amdgcn_mfma_f32_32x32x16_bf16(pa2, PK(l2, h2), od, 0, 0, 0);
  od = __builtin_amdgcn_mfma_f32_32x32x16_bf16(pa3, PK(l3, h3), od, 0, 0, 0);
#undef PK
}
__device__ __forceinline__ void pv_d0(f32x16* o, int vb, bf16x8 pa0, bf16x8 pa1, bf16x8 pa2, bf16x8 pa3) {
  pv_one<0>(o[0], vb, pa0, pa1, pa2, pa3); pv_one<1>(o[1], vb, pa0, pa1, pa2, pa3); pv_one<2>(o[2], vb, pa0, pa1, pa2, pa3); pv_one<3>(o[3], vb, pa0, pa1, pa2, pa3);
}
__device__ __forceinline__ void attn_unit(const bf16_t* __restrict__ Qb, const bf16_t* __restrict__ Kh, const bf16_t* __restrict__ Vh, float* __restrict__ Ob, int NT, int vis4, char* lds) {
  const int tid = tid_(), wid = tid >> 6, lane = tid & 63, r32 = lane & 31, hi = lane >> 5;
  const int vis = vis4 + (wid >> 1);
  bf16_t* V_lds = (bf16_t*)lds; bf16_t* K_lds = (bf16_t*)(lds + 2 * SHM_V);
  float* ws = (float*)(lds + 2 * SHM_V + 2 * SHM_K) + wid * 64; float* li_l = ws; float* al_l = ws + 32;
  float m_reg = NEG, l_reg = 0; f32x16 o[4] = {}; bf16x8 qr[8];
  const bf16_t* Qw = Qb + (long)(wid * QBLK + r32) * LDQK + hi * 8;
#pragma unroll
  for (int d0 = 0; d0 < 8; ++d0) qr[d0] = *reinterpret_cast<const bf16x8*>(Qw + d0 * 16);
  const int sr = tid >> 4, sc = (tid & 15) * 8, vst0 = v_st(sr, sc), vst1 = v_st(32 + sr, sc);
  const int vb0 = (int)(uintptr_t)V_lds + v_rd_base(lane);
  struct { bf16x8 vs0, vs1, ks0, ks1; } sr_[2];
#define SLOAD(i, k0) do { sr_[i].vs0 = *reinterpret_cast<const bf16x8*>(&Vh[(long)((k0) + sr) * LDQK + sc]); sr_[i].vs1 = *reinterpret_cast<const bf16x8*>(&Vh[(long)((k0) + 32 + sr) * LDQK + sc]); \
    sr_[i].ks0 = *reinterpret_cast<const bf16x8*>(&Kh[(long)((k0) + sr) * LDQK + sc]); sr_[i].ks1 = *reinterpret_cast<const bf16x8*>(&Kh[(long)((k0) + 32 + sr) * LDQK + sc]); } while (0)
#define SWRITE(b, i) do { *(bf16x8*)((char*)V_lds + (b) * SHM_V + vst0) = sr_[i].vs0;          \
    *(bf16x8*)((char*)V_lds + (b) * SHM_V + vst1) = sr_[i].vs1; int kc = sc * 2;               \
    *(bf16x8*)((char*)K_lds + (b) * SHM_K + KSWZ(sr, kc)) = sr_[i].ks0;                       \
    *(bf16x8*)((char*)K_lds + (b) * SHM_K + KSWZ(32 + sr, kc)) = sr_[i].ks1; } while (0)
#define SWAIT() asm volatile("s_waitcnt vmcnt(4)" ::: "memory")
#define RESC(a) do { if (__any((a) < 1.f)) { if (hi == 0) al_l[r32] = (a); asm volatile("s_waitcnt lgkmcnt(0)" ::: "memory"); \
    for (int d = 0; d < 4; ++d) for (int r = 0; r < 16; ++r) o[d][r] *= al_l[crow(r, hi)]; } } while (0)
  f32x16 pA0, pA1, pB0, pB1; float mnA, mnB, alA, alB; bf16x8 pa0, pa1, pa2, pa3;
  constexpr int SE = 0, SO = 1;
  SLOAD(SE, 0); asm volatile("s_waitcnt vmcnt(0)" ::: "memory"); SWRITE(0, SE); __syncthreads();
  qkt(pA0, pA1, K_lds, qr, r32, hi); mask_tile(pA0, pA1, 0, vis); partialSM(pA0, pA1, m_reg, mnA, alA);
  SLOAD(SO, KVBLK); if (2 < NT) SLOAD(SE, 2 * KVBLK);
  SWAIT(); SWRITE(1, SO); __syncthreads();
  for (int j = 1; j + 1 < NT; j += 2) {
    SBAR(); qkt(pB0, pB1, (bf16_t*)((char*)K_lds + SHM_K), qr, r32, hi); mask_tile(pB0, pB1, j, vis);
    finishSM(pA0, pA1, alA, l_reg, pa0, pa1, pa2, pa3); SBAR();
    SLOAD(SO, (j + 2) * KVBLK); SBAR();
    pv_d0(o, vb0, pa0, pa1, pa2, pa3); partialSM(pB0, pB1, m_reg, mnB, alB);
    __syncthreads(); SWAIT(); SWRITE(0, SE);
    RESC(alB); __syncthreads();
    SBAR(); qkt(pA0, pA1, K_lds, qr, r32, hi); mask_tile(pA0, pA1, j + 1, vis);
    finishSM(pB0, pB1, alB, l_reg, pa0, pa1, pa2, pa3); SBAR();
    if (j + 3 < NT) SLOAD(SE, (j + 3) * KVBLK); SBAR();
    pv_d0(o, vb0 + (int)SHM_V, pa0, pa1, pa2, pa3); partialSM(pA0, pA1, m_reg, mnA, alA);
    __syncthreads(); SWAIT(); SWRITE(1, SO);
    RESC(alA); __syncthreads();
  }
  SBAR(); qkt(pB0, pB1, (bf16_t*)((char*)K_lds + SHM_K), qr, r32, hi); mask_tile(pB0, pB1, NT - 1, vis);
  finishSM(pA0, pA1, alA, l_reg, pa0, pa1, pa2, pa3); SBAR();
  pv_d0(o, vb0, pa0, pa1, pa2, pa3); partialSM(pB0, pB1, m_reg, mnB, alB);
  __syncthreads(); RESC(alB);
  finishSM(pB0, pB1, alB, l_reg, pa0, pa1, pa2, pa3); SBAR();
  pv_d0(o, vb0 + (int)SHM_V, pa0, pa1, pa2, pa3);
  if (hi == 0) li_l[r32] = l_reg; asm volatile("s_waitcnt lgkmcnt(0)" ::: "memory");
  float rli[16];
#pragma unroll
  for (int r = 0; r < 16; ++r) rli[r] = __builtin_amdgcn_rcpf(li_l[crow(r, hi)]);
  float* Ow = Ob + (long)(wid * QBLK) * DM;
#pragma unroll
  for (int r = 0; r < 16; ++r) { int orow = crow(r, hi);
    for (int d0 = 0; d0 < 4; ++d0) Ow[(long)orow * DM + d0 * 32 + r32] = o[d0][r] * rli[r]; }
  __syncthreads();
#undef SLOAD
#undef SWRITE
#undef SWAIT
#undef RESC
}
#undef KSWZ
#undef SBAR
}

__device__ __forceinline__ void ph_attention(KP P, char* lds) {
    const bf16_t* QKV = P->QKV; float* OC = P->OC;
#pragma unroll 1
    for (int c = bid_(); c < 256; c += gridDim.x) {
        const int combo = c >> 2, b = combo >> 4, h = (combo >> 2) & 3, i = (combo >> 1) & 1, vh = combo & 1;
        const bf16_t* Kh = QKV + (size_t)(b * LL) * QKVW + 1024 + h * 256 + i * 128;
        const bf16_t* Vh = QKV + (size_t)(b * LL) * QKVW + 2048 + h * 256 + vh * 128;
#pragma unroll 1
        for (int s = 0; s < 2; ++s) {
            const int jb = s == 0 ? (c & 3) : 7 - (c & 3);
            const size_t row0 = (size_t)(b * LL) + NMETA + 256 * jb;
            fa::attn_unit(QKV + row0 * QKVW + h * 256 + i * 128, Kh, Vh, OC + row0 * DM + h * 512 + i * 256 + vh * 128, 4 * jb + 6, 4 * jb, lds);
        }
    }
#pragma unroll 1
    for (int gw0 = bid_() * 8; gw0 < 512; gw0 += gridDim.x * 8) {
        const int tid = tid_(), lane = tid & 63, gw = gw0 + (tid >> 6);
        if (gw < 512) {
            const int b = gw >> 7, h = (gw >> 5) & 3, i = (gw >> 4) & 1, row = gw & 15;
            const bf16_t* q = QKV + (size_t)(b * LL + row) * QKVW + h * 256 + i * 128;
            const int key = lane & 15;
            const bf16_t* k = QKV + (size_t)(b * LL + key) * QKVW + 1024 + h * 256 + i * 128;
            float sc = 0.f;
            { pg8::u32x4 qv[16], kv[16];
#pragma unroll
              for (int c8 = 0; c8 < 16; ++c8) { qv[c8] = *(const pg8::u32x4*)(q + c8 * 8); kv[c8] = *(const pg8::u32x4*)(k + c8 * 8); }
#pragma unroll
              for (int c8 = 0; c8 < 16; ++c8)
#pragma unroll
                  for (int w2 = 0; w2 < 4; ++w2) { const unsigned a = qv[c8][w2], bq = kv[c8][w2];
                      sc = fmaf(__uint_as_float(a << 16), __uint_as_float(bq << 16), sc); sc = fmaf(__uint_as_float(a & 0xffff0000u), __uint_as_float(bq & 0xffff0000u), sc); } }
            sc *= 0.08838834764831845f;
            float m = sc;
            m = fmaxf(m, swz_xor<8>(m)); m = fmaxf(m, swz_xor<4>(m)); m = fmaxf(m, swz_xor<2>(m)); m = fmaxf(m, swz_xor<1>(m));
            const float e = expf(sc - m);
            float ssum = e;
            ssum += swz_xor<8>(ssum); ssum += swz_xor<4>(ssum); ssum += swz_xor<2>(ssum); ssum += swz_xor<1>(ssum);
            const float p = e / ssum;
            float acc[4] = {0.f, 0.f, 0.f, 0.f};
#pragma unroll
            for (int j = 0; j < 16; ++j) {
                const float pj = __int_as_float(__builtin_amdgcn_readlane(__float_as_int(p), j));
                const uint2 v2 = *(const uint2*)(QKV + (size_t)(b * LL + j) * QKVW + 2048 + h * 256 + lane * 4);
                acc[0] = fmaf(pj, __uint_as_float(v2.x << 16), acc[0]); acc[1] = fmaf(pj, __uint_as_float(v2.x & 0xffff0000u), acc[1]);
                acc[2] = fmaf(pj, __uint_as_float(v2.y << 16), acc[2]); acc[3] = fmaf(pj, __uint_as_float(v2.y & 0xffff0000u), acc[3]);
            }
            float* o = OC + (size_t)(b * LL + row) * DM + h * 512 + i * 256 + lane * 4;
            *(float4*)o = make_float4(acc[0], acc[1], acc[2], acc[3]);
        }
    }
}


namespace hg {
using bf16x8 = __attribute__((ext_vector_type(8))) short;
using s16x4  = __attribute__((ext_vector_type(4))) short;
using f32x16 = __attribute__((ext_vector_type(16))) float;
using u32x4  = __attribute__((ext_vector_type(4))) unsigned;
constexpr int NCH = 33, NU = 16 * NCH;
constexpr int SK = 136;
constexpr int SS = 72;
__device__ __forceinline__ int crow(int r, int hi) { return (r & 3) + 8 * (r >> 2) + 4 * hi; }
__device__ __forceinline__ unsigned cvtpk(float lo, float hi) { unsigned r; asm volatile("v_cvt_pk_bf16_f32 %0, %1, %2" : "=v"(r) : "v"(lo), "v"(hi)); return r; }

__device__ __forceinline__ void prep(const float (&fpv)[16], float lbv, int c, int k, int tq, float* qsum, float (&b)[16], float (&kk)[16], float& bend, float& r) {
    float run = 0.f;
#pragma unroll
    for (int i = 0; i < 16; ++i) {
        const int t = 16 * tq + i; const bool valid = (c * 64 + t) < LL;
        const float kv = valid ? (1.f - lbv) * __builtin_amdgcn_rcpf(1.f + __expf(fpv[i])) : 0.f;
        kk[i] = kv; run += fmaxf(__logf(1.f - kv), -30.f); b[i] = run;
    }
    qsum[tq * 128 + k] = run;
    __syncthreads();
    const float q0 = qsum[k], q1 = qsum[128 + k], q2 = qsum[256 + k], q3 = qsum[384 + k];
    const float off = tq == 0 ? 0.f : (tq == 1 ? q0 : (tq == 2 ? q0 + q1 : q0 + q1 + q2));
    r = q0 + q1; bend = (q0 + q1) + (q2 + q3);
#pragma unroll
    for (int i = 0; i < 16; ++i) b[i] += off;
}
__device__ __forceinline__ void store16(bf16_t* dst, const float (&x)[16]) {
    u32x4 w0, w1;
    w0.x = cvtpk(x[0], x[1]); w0.y = cvtpk(x[2], x[3]); w0.z = cvtpk(x[4], x[5]); w0.w = cvtpk(x[6], x[7]);
    w1.x = cvtpk(x[8], x[9]); w1.y = cvtpk(x[10], x[11]); w1.z = cvtpk(x[12], x[13]); w1.w = cvtpk(x[14], x[15]);
    *(u32x4*)dst = w0; *(u32x4*)(dst + 8) = w1;
}

__device__ __forceinline__ void local_states(KP P, char* lds, int layer) {
    bf16_t* KhT = (bf16_t*)lds; bf16_t* VT = KhT + 128 * SS; float* qsum = (float*)(VT + 128 * SS);
    const float* PA = P->PA; const float* lbtab = P->lbtab + layer * 512; float* SLOC = P->SLOC; float* DEC = P->DEC;
    const int tid = tid_(), k = tid & 127, tq = tid >> 7, lane = tid & 63, wid = tid >> 6, r32 = lane & 31, hh = lane >> 5;
    for (int u = bid_(); u < NU; u += gridDim.x) {
        const int bh = u / NCH, c = u % NCH, b_ = bh >> 2, h = bh & 3; const size_t row0 = (size_t)b_ * LL + c * 64;
        float fpv[16], vv[16];
#pragma unroll
        for (int i = 0; i < 16; ++i) { const int t = 16 * tq + i; const bool valid = (c * 64 + t) < LL; const float* rp = PA + (row0 + (valid ? t : 0)) * PAW + h * 128 + k;
            fpv[i] = rp[512]; vv[i] = valid ? rp[1024] : 0.f; }
        float b[16], kk[16], bend, r;
        prep(fpv, lbtab[h * 128 + k], c, k, tq, qsum, b, kk, bend, r);
        float x[16];
#pragma unroll
        for (int i = 0; i < 16; ++i) x[i] = kk[i] * __expf(bend - b[i]);
        store16(KhT + k * SS + 16 * tq, x);
        store16(VT + k * SS + 16 * tq, vv);
        if (tq == 0) DEC[u * 128 + k] = __expf(bend);
        __syncthreads();
        const int vt = wid >> 1;
#pragma unroll
        for (int j = 0; j < 2; ++j) {
            const int kt = (wid & 1) * 2 + j;
            f32x16 acc = {};
#pragma unroll
            for (int sg = 0; sg < 4; ++sg) {
                const bf16x8 a = *(const bf16x8*)(VT + (vt * 32 + r32) * SS + sg * 16 + hh * 8);
                const bf16x8 bb = *(const bf16x8*)(KhT + (kt * 32 + r32) * SS + sg * 16 + hh * 8);
                acc = __builtin_amdgcn_mfma_f32_32x32x16_bf16(a, bb, acc, 0, 0, 0);
            }
            float* o = SLOC + (size_t)u * 16384 + kt * 32 + r32;
#pragma unroll
            for (int rg = 0; rg < 16; ++rg) o[(vt * 32 + crow(rg, hh)) * 128] = acc[rg];
        }
        __syncthreads();
    }
}
__device__ __forceinline__ void scan_states(KP P) {
    const float* SLOC = P->SLOC; const float* DEC = P->DEC; bf16_t* SPREV = P->SPREV;
    const int tid = tid_();
    for (int e = bid_() * NTHR + tid; e < 16 * 16384; e += gridDim.x * NTHR) {
        const int bh = e >> 14, vk = e & 16383, k = vk & 127;
        float d[NCH - 1], x[NCH - 1];
#pragma unroll
        for (int c = 0; c < NCH - 1; ++c) { const int u = bh * NCH + c; d[c] = DEC[u * 128 + k]; x[c] = SLOC[(size_t)u * 16384 + vk]; }
        float S = 0.f;
#pragma unroll
        for (int c = 0; c < NCH - 1; ++c) { S = fmaf(d[c], S, x[c]); SPREV[(size_t)(bh * NCH + c + 1) * 16384 + vk] = f2bf(S); }
    }
}
__device__ __forceinline__ void outputs(KP P, char* lds, int layer) {
    bf16_t* Qt = (bf16_t*)lds; bf16_t* Qh = Qt + 64 * SK; bf16_t* Kt = Qh + 64 * SK; bf16_t* VT = Kt + 64 * SK; bf16_t* SpT = VT + 128 * SS;
    float* qsum = (float*)(SpT + 128 * SK); float* part = qsum + 512;
    const float* PA = P->PA; const float* lbtab = P->lbtab + layer * 512; const bf16_t* SPREV = P->SPREV; const float* nw = P->hnw + layer * 128; bf16_t* MIX = P->MIX;
    const int tid = tid_(), k = tid & 127, tq = tid >> 7, lane = tid & 63, wid = tid >> 6, r32 = lane & 31, hh = lane >> 5;
    for (int u = bid_(); u < NU; u += gridDim.x) {
        const int bh = u / NCH, c = u % NCH, b_ = bh >> 2, h = bh & 3; const size_t row0 = (size_t)b_ * LL + c * 64;
        const int tt = wid & 1, vt = wid >> 1;
        float fpv[16], qv[16], vv[16]; u32x4 sp[4]; float4 gv[4];
#pragma unroll
        for (int i = 0; i < 16; ++i) { const int t = 16 * tq + i; const bool valid = (c * 64 + t) < LL; const float* rp = PA + (row0 + (valid ? t : 0)) * PAW + h * 128 + k;
            fpv[i] = rp[512]; qv[i] = valid ? rp[0] : 0.f; vv[i] = valid ? rp[1024] : 0.f; }
#pragma unroll
        for (int j = 0; j < 4; ++j) { const int idx = tid + 512 * j, v = idx >> 4, ch = idx & 15; sp[j] = *(const u32x4*)(SPREV + (size_t)(c > 0 ? u : u + 1) * 16384 + v * 128 + ch * 8); }
        { const int te = tt * 32 + r32; const float* gp = PA + (row0 + ((c * 64 + te) < LL ? te : 0)) * PAW + 1536 + h * 128 + vt * 32 + 4 * hh;
#pragma unroll
          for (int g4 = 0; g4 < 4; ++g4) gv[g4] = *(const float4*)(gp + 8 * g4); }
        float b[16], kk[16], bend, r;
        prep(fpv, lbtab[h * 128 + k], c, k, tq, qsum, b, kk, bend, r);
#pragma unroll
        for (int i = 0; i < 16; ++i) { const int t = 16 * tq + i; const float q = qv[i];
            Qt[t * SK + k] = f2bf(q * __expf(b[i] - r)); Qh[t * SK + k] = f2bf(q * __expf(b[i])); Kt[t * SK + k] = f2bf(kk[i] * __expf(r - b[i])); }
        store16(VT + k * SS + 16 * tq, vv);
        if (c > 0) {
#pragma unroll
            for (int j = 0; j < 4; ++j) { const int idx = tid + 512 * j, v = idx >> 4, ch = idx & 15; *(u32x4*)(SpT + v * SK + ch * 8) = sp[j]; }
        }
        __syncthreads();
        f32x16 oacc = {};
#pragma unroll
        for (int st = 0; st < 2; ++st) {
            if (st <= tt) {
                f32x16 sc = {};
#pragma unroll
                for (int d0 = 0; d0 < 8; ++d0) {
                    const bf16x8 a = *(const bf16x8*)(Kt + (st * 32 + r32) * SK + d0 * 16 + hh * 8);
                    const bf16x8 bq = *(const bf16x8*)(Qt + (tt * 32 + r32) * SK + d0 * 16 + hh * 8);
                    sc = __builtin_amdgcn_mfma_f32_32x32x16_bf16(a, bq, sc, 0, 0, 0);
                }
                if (st == tt) {
#pragma unroll
                    for (int rg = 0; rg < 16; ++rg) sc[rg] = (crow(rg, hh) <= r32) ? sc[rg] : 0.f;
                }
#pragma unroll
                for (int g = 0; g < 2; ++g) {
                    u32x4 w; w.x = cvtpk(sc[8 * g + 0], sc[8 * g + 1]); w.y = cvtpk(sc[8 * g + 2], sc[8 * g + 3]); w.z = cvtpk(sc[8 * g + 4], sc[8 * g + 5]); w.w = cvtpk(sc[8 * g + 6], sc[8 * g + 7]);
                    const bf16x8 pb = *reinterpret_cast<bf16x8*>(&w);
                    const bf16_t* vp = VT + (vt * 32 + r32) * SS + st * 32 + 16 * g + 4 * hh;
                    const s16x4 lo = *(const s16x4*)vp, hi4 = *(const s16x4*)(vp + 8);
                    const bf16x8 a = (bf16x8){lo[0], lo[1], lo[2], lo[3], hi4[0], hi4[1], hi4[2], hi4[3]};
                    oacc = __builtin_amdgcn_mfma_f32_32x32x16_bf16(a, pb, oacc, 0, 0, 0);
                }
            }
        }
        if (c > 0) {
#pragma unroll
            for (int d0 = 0; d0 < 8; ++d0) {
                const bf16x8 a = *(const bf16x8*)(SpT + (vt * 32 + r32) * SK + d0 * 16 + hh * 8);
                const bf16x8 bq = *(const bf16x8*)(Qh + (tt * 32 + r32) * SK + d0 * 16 + hh * 8);
                oacc = __builtin_amdgcn_mfma_f32_32x32x16_bf16(a, bq, oacc, 0, 0, 0);
            }
        }
        float ss = 0.f;
#pragma unroll
        for (int rg = 0; rg < 16; ++rg) ss = fmaf(oacc[rg], oacc[rg], ss);
        { auto rr = __builtin_amdgcn_permlane32_swap(__float_as_uint(ss), __float_as_uint(ss), false, false); ss = __uint_as_float(rr[0]) + __uint_as_float(rr[1]); }
        if (hh == 0) part[vt * 64 + tt * 32 + r32] = ss;
        __syncthreads();
        const int t = tt * 32 + r32;
        const float tot = (part[t] + part[64 + t]) + (part[128 + t] + part[192 + t]);
        const float scale = rsqrtf(tot * (1.f / 128.f) + EPS);
        if ((c * 64 + t) < LL) {
            bf16_t* op = MIX + (row0 + t) * DM + h * 128 + vt * 32;
#pragma unroll
            for (int g4 = 0; g4 < 4; ++g4) {
                const int v0 = 8 * g4 + 4 * hh;
                const float4 gg = gv[g4]; const float4 wv = *(const float4*)(nw + vt * 32 + v0);
                const float y0 = oacc[4 * g4 + 0] * scale * wv.x * gg.x / (1.f + __expf(-gg.x)), y1 = oacc[4 * g4 + 1] * scale * wv.y * gg.y / (1.f + __expf(-gg.y));
                const float y2 = oacc[4 * g4 + 2] * scale * wv.z * gg.z / (1.f + __expf(-gg.z)), y3 = oacc[4 * g4 + 3] * scale * wv.w * gg.w / (1.f + __expf(-gg.w));
                uint2 w; w.x = cvtpk(y0, y1); w.y = cvtpk(y2, y3);
                *(uint2*)(op + v0) = w;
            }
        }
        __syncthreads();
    }
}
}


namespace moe {
using bf16x8 = __attribute__((ext_vector_type(8))) short;
using f32x16 = __attribute__((ext_vector_type(16))) float;
using u32x4  = __attribute__((ext_vector_type(4))) unsigned;
constexpr int TW = 5, PROWS = 64 * TW, XS = 144, XBUF = PROWS * XS;
__device__ __forceinline__ unsigned cvtpk(float lo, float hi) { unsigned r; asm volatile("v_cvt_pk_bf16_f32 %0, %1, %2" : "=v"(r) : "v"(lo), "v"(hi)); return r; }
#define MOE_BAR() asm volatile("s_waitcnt lgkmcnt(0)\n\ts_barrier" ::: "memory")
constexpr int WD = 2;
constexpr int ABUF = 4 * 4 * 1024, AOFF = 2 * XBUF, LOFF = AOFF + 2 * ABUF;
template <bool UP>
__device__ __forceinline__ void stream_gemm(KP P, char* lds, int layer) {
    constexpr int KTOT = UP ? DM : DE, NSLAB = KTOT / 64, NCP = UP ? 2 : 4, LDW = UP ? DE : DM, CPSTRIDE = UP ? 64 : 128;
    static_assert(NSLAB % WD == 0 && NSLAB >= 2 * WD, "slab loop is unrolled by WD");
    const int tid = tid_(), lane = tid & 63, wid = tid >> 6, r32 = lane & 31, hh = lane >> 5, cg = wid & 3, th = wid >> 2;
    const int* cnt_ = P->cnt;
    const bf16_t* X = UP ? P->HN : P->H;
    int* basel = (int*)(lds + LOFF); int* tlist = basel + 64;
    for (int ub = bid_(); ub < 256; ub += gridDim.x) {
        const int u = ((ub & 7) << 5) | (ub >> 3);
        const int e = u >> 2, ns = u & 3;
        const int rot = ((u >> 2) * 11) & (NSLAB - 1);
        __syncthreads();
        if (tid < 64) basel[64 + 320 + tid] = cnt_[tid * CSTR];
        __syncthreads();
        if (tid < 64) { int a = 0; for (int q = 0; q < tid; ++q) a += basel[64 + 320 + q]; basel[tid] = a; }
        __syncthreads();
        const int cnt = cnt_[e * CSTR], row0 = basel[e];
        for (int pass0 = 0; pass0 < cnt; pass0 += PROWS) {
            const int cntp = (cnt - pass0) < PROWS ? (cnt - pass0) : PROWS;
            if constexpr (UP) { if (cnt <= ECAP) {
                __syncthreads();
                if (tid < PROWS && pass0 + tid < cnt) tlist[tid] = P->elist[e * ECAP + pass0 + tid];
                __syncthreads();
              } else {
                __syncthreads();
                const int* ridx = P->ridx; const int* rslot = P->rslot;
#pragma unroll 1
                for (int i0 = tid; i0 < NASSIGN; i0 += NTHR * 8) {
                    int ex[8], sl[8];
#pragma unroll
                    for (int q = 0; q < 8; ++q) { const int i = i0 + NTHR * q; ex[q] = i < NASSIGN ? ridx[i] : -1; sl[q] = i < NASSIGN ? rslot[i] : 0; }
#pragma unroll
                    for (int q = 0; q < 8; ++q) { const int sp = sl[q] - pass0; if (ex[q] == e && sp >= 0 && sp < PROWS) tlist[sp] = (i0 + NTHR * q) >> 1; }
                }
                __syncthreads();
            } }
            int xoff[5];
#pragma unroll
            for (int j = 0; j < 5; ++j) { int rho = (tid >> 3) + 64 * j; rho = rho < cntp ? rho : cntp - 1; const int grow = row0 + pass0 + rho;
                xoff[j] = (UP ? tlist[rho] * DM : grow * DE) + (tid & 7) * 8; }
            char* const xw = lds + (tid >> 3) * XS + (tid & 7) * 16;
            char* const aw = lds + AOFF + (cg * 4 + 2 * th) * 1024 + lane * 16;
            const char* const ar = lds + AOFF + cg * 4 * 1024 + lane * 16;
            float wreg[WD][16]; u32x4 xs[5];
#pragma unroll 1
            for (int cp = 0; cp < NCP; ++cp) {
                const int cgi = cp * 4 + cg;
                const int kkw = wid >> 1, half = wid & 1;
                const float* wp;
                if constexpr (UP) wp = (r32 < 16 ? P->w1 : P->w3) + ((size_t)(layer * NE + e) * DM + kkw * 16 + 8 * hh + 4 * half) * DE + ns * 128 + cp * 64 + 4 * (r32 & 15);
                else wp = P->w2 + ((size_t)(layer * NE + e) * DE + 32 * hh + 2 * th) * DM + ns * 512 + cgi * 32 + r32;
                f32x16 acc[TW];
#pragma unroll
                for (int tl = 0; tl < TW; ++tl) acc[tl] = f32x16{};
#define MOE_WLD1(wn_, R, li) do { if constexpr (UP) { if ((li) < 4) { const float4 t_ = *(const float4*)((wn_) + (size_t)(li) * DE); wreg[R][4 * (li)] = t_.x; wreg[R][4 * (li) + 1] = t_.y; wreg[R][4 * (li) + 2] = t_.z; wreg[R][4 * (li) + 3] = t_.w; } } \
                    else { if ((li) < 16) wreg[R][li] = (wn_)[(size_t)(((li) >> 3) + 4 * ((li) & 7)) * DM]; } } while (0)
#define MOE_WLOAD(slab, R) do { const float* wn_ = wp + (size_t)(((slab) + rot) & (NSLAB - 1)) * 64 * LDW; \
                    _Pragma("unroll") for (int li = 0; li < 16; ++li) MOE_WLD1(wn_, R, li); } while (0)
#define MOE_WPARK(R, PAR) do { if constexpr (UP) { _Pragma("unroll") for (int q = 0; q < 4; ++q) { uint2 fw; fw.x = cvtpk(wreg[R][q], wreg[R][4 + q]); fw.y = cvtpk(wreg[R][8 + q], wreg[R][12 + q]); \
                            *(uint2*)(lds + AOFF + (PAR) * ABUF + (q * 4 + kkw) * 1024 + lane * 16 + half * 8) = fw; } } \
                    else { _Pragma("unroll") for (int i = 0; i < 2; ++i) { u32x4 fw; fw.x = cvtpk(wreg[R][8 * i + 0], wreg[R][8 * i + 1]); fw.y = cvtpk(wreg[R][8 * i + 2], wreg[R][8 * i + 3]); \
                            fw.z = cvtpk(wreg[R][8 * i + 4], wreg[R][8 * i + 5]); fw.w = cvtpk(wreg[R][8 * i + 6], wreg[R][8 * i + 7]); *(u32x4*)(aw + (PAR) * ABUF + i * 1024) = fw; } } } while (0)
                if (cp == 0) {
#pragma unroll
                    for (int j = 0; j < 5; ++j) xs[j] = *(const u32x4*)(X + xoff[j] + (rot & (NSLAB - 1)) * 64);
                    MOE_WLOAD(0, 0); MOE_WLOAD(1, 1);
#pragma unroll
                    for (int j = 0; j < 5; ++j) *(u32x4*)(xw + 64 * j * XS) = xs[j];
                    MOE_WPARK(0, 0); MOE_WLOAD(2, 0);
                    MOE_BAR();
                }
#define MOE_SLAB(s, PAR, R1) do { \
                    const int sx = ((s) + 1) & (NSLAB - 1); const int swr = (s) + 1 + WD; const bool wnext = swr >= NSLAB && cp + 1 < NCP;     \
                    const int sw = swr < NSLAB ? swr : (wnext ? swr - NSLAB : NSLAB - 1); \
                    { const bf16_t* xn0_ = X + ((sx + rot) & (NSLAB - 1)) * 64; _Pragma("unroll") for (int j = 0; j < 5; ++j) xs[j] = *(const u32x4*)(xn0_ + xoff[j]); } \
                    MOE_WPARK(R1, 1 - (PAR)); \
                    const float* wn_ = wp + (wnext ? CPSTRIDE : 0) + (size_t)((sw + rot) & (NSLAB - 1)) * 64 * LDW; \
                    const char* xb = lds + (PAR) * XBUF + (th * TW * 32 + r32) * XS + hh * 16; \
                    bf16x8 xq[4]; bf16x8 fq[2];                                                       \
                    xq[0] = *(const bf16x8*)(xb); xq[1] = *(const bf16x8*)(xb + 32 * XS); xq[2] = *(const bf16x8*)(xb + 64 * XS); \
                    fq[0] = *(const bf16x8*)(ar + (PAR) * ABUF); \
                    _Pragma("unroll") for (int kk = 0; kk < 4; ++kk) { \
                        if (kk < 3) fq[(kk + 1) & 1] = *(const bf16x8*)(ar + (PAR) * ABUF + (kk + 1) * 1024); \
                        _Pragma("unroll") for (int tl = 0; tl < TW; ++tl) { \
                            const int cur = kk * TW + tl, nx = cur + 3, nkk = nx / TW, ntl = nx % TW;       \
                            if (nx < 4 * TW) xq[nx & 3] = *(const bf16x8*)(xb + ntl * 32 * XS + nkk * 32); \
                            acc[tl] = __builtin_amdgcn_mfma_f32_32x32x16_bf16(fq[kk & 1], xq[cur & 3], acc[tl], 0, 0, 0); \
                            const int li = kk * TW + tl; \
                            MOE_WLD1(wn_, R1, li); \
                            __builtin_amdgcn_sched_barrier(0); } } \
                    _Pragma("unroll") for (int j = 0; j < 5; ++j) *(u32x4*)(xw + (1 - (PAR)) * XBUF + 64 * j * XS) = xs[j]; \
                    MOE_BAR(); } while (0)
#pragma unroll 1
                for (int s = 0; s < NSLAB; s += 2) { MOE_SLAB(s, 0, 1); MOE_SLAB(s + 1, 1, 0); }
#undef MOE_SLAB
#undef MOE_WLOAD
#undef MOE_WLD1
#undef MOE_WPARK
                const int T = (cntp + 31) >> 5;
                const int Tw = (T - TW * th) < 0 ? 0 : ((T - TW * th) > TW ? TW : (T - TW * th));
#pragma unroll
                for (int tl = 0; tl < TW; ++tl) if (tl < Tw) {
                    const int rho = (th * TW + tl) * 32 + r32;
                    if (rho < cntp) {
                        const size_t grow = (size_t)(row0 + pass0 + rho);
                        if constexpr (UP) {
                            bf16_t* hp = P->H + grow * DE + ns * 128 + cgi * 16 + 4 * hh;
#pragma unroll
                            for (int g = 0; g < 2; ++g) {
                                float y[4];
#pragma unroll
                                for (int q = 0; q < 4; ++q) { const float a = acc[tl][4 * g + q], b = acc[tl][8 + 4 * g + q]; y[q] = a / (1.f + __expf(-a)) * b; }
                                uint2 w; w.x = cvtpk(y[0], y[1]); w.y = cvtpk(y[2], y[3]);
                                *(uint2*)(hp + 8 * g) = w;
                            }
                        } else {
                            bf16_t* yp = P->Y + grow * DM + ns * 512 + cgi * 32 + 4 * hh;
#pragma unroll
                            for (int g = 0; g < 4; ++g) {
                                uint2 w; w.x = cvtpk(acc[tl][4 * g + 0], acc[tl][4 * g + 1]); w.y = cvtpk(acc[tl][4 * g + 2], acc[tl][4 * g + 3]);
                                *(uint2*)(yp + 8 * g) = w;
                            }
                        }
                    }
                }
            }
        }
    }
}
#undef MOE_BAR
}


namespace s5 {
using bf16x8 = __attribute__((ext_vector_type(8))) short;
using f32x16 = __attribute__((ext_vector_type(16))) float;
using u32x4  = __attribute__((ext_vector_type(4))) unsigned;
constexpr int NCHK = 516, NMT = 17;
__device__ __forceinline__ unsigned cvtpk(float lo, float hi) { unsigned r; asm volatile("v_cvt_pk_bf16_f32 %0, %1, %2" : "=v"(r) : "v"(lo), "v"(hi)); return r; }
__device__ __forceinline__ bf16x8 ld8f(const float* p) {
    const float4 a = *(const float4*)p, b = *(const float4*)(p + 4);
    u32x4 w; w.x = cvtpk(a.x, a.y); w.y = cvtpk(a.z, a.w); w.z = cvtpk(b.x, b.y); w.w = cvtpk(b.z, b.w);
    return *reinterpret_cast<bf16x8*>(&w);
}
__device__ __forceinline__ void prep_unit(KP P, char* lds, int layer, int g) {
    float2* pw = (float2*)lds; float2* bb = pw + 17 * 64; float2* cc = bb + 1024; float* kd = (float*)(cc + 1024);
    const int tid = tid_();
    const float dt = expf(P->log_dt[layer * 32 + g]);
    const float* a_re = P->a_re + (layer * 32 + g) * 64; const float* a_im = P->a_im + (layer * 32 + g) * 64;
    for (int idx = tid; idx < 17 * 64; idx += NTHR) { const int d = idx >> 6, p = idx & 63;
        const float mag = expf(a_re[p] * dt * (float)d), ang = a_im[p] * dt * (float)d; pw[idx] = make_float2(mag * cosf(ang), mag * sinf(ang)); }
    for (int idx = tid; idx < 1024; idx += NTHR) {
        { const int p = idx >> 4, c = idx & 15; const float are = a_re[p], aim = a_im[p];
          const float mag = expf(are * dt), abr = mag * cosf(aim * dt), abi = mag * sinf(aim * dt), den = are * are + aim * aim;
          const float zr = ((abr - 1.f) * are + abi * aim) / den, zi = (abi * are - (abr - 1.f) * aim) / den;
          const float br = P->b_re[((layer * 32 + g) * 64 + p) * 16 + c], bi = P->b_im[((layer * 32 + g) * 64 + p) * 16 + c];
          bb[idx] = make_float2(zr * br - zi * bi, zr * bi + zi * br); }
        { const int c = idx >> 6, p = idx & 63; cc[idx] = make_float2(P->c_re[((layer * 32 + g) * 16 + c) * 64 + p], P->c_im[((layer * 32 + g) * 16 + c) * 64 + p]); }
    }
    __syncthreads();
    if (tid < 64) ((float2*)P->A16)[(layer * 32 + g) * 64 + tid] = pw[16 * 64 + tid];
    for (int idx = tid; idx < 4096; idx += NTHR) { const int d = idx >> 8, c = (idx >> 4) & 15, c2 = idx & 15;
        float acc = 0.f;
        for (int p = 0; p < 64; ++p) { const float2 C = cc[c * 64 + p], W = pw[d * 64 + p], B = bb[p * 16 + c2];
            const float xr = C.x * W.x - C.y * W.y, xi = C.x * W.y + C.y * W.x; acc += xr * B.x - xi * B.y; }
        if (d == 0 && c == c2) acc += P->s5d[layer * 512 + g * 16 + c];
        kd[idx] = acc; }
    __syncthreads();
    bf16_t* BtY = P->BtY + (size_t)(layer * 32 + g) * 256 * 384; bf16_t* BtE = P->BtE + (size_t)(layer * 32 + g) * 128 * 256;
    for (int idx = tid; idx < 256 * 48; idx += NTHR) { const int n = idx / 48, ch = idx % 48, t = n >> 4, c = n & 15;
        float v[8];
        if (ch < 32) { const int s = ch >> 1, c0 = (ch & 1) * 8;
#pragma unroll
            for (int jj = 0; jj < 8; ++jj) v[jj] = (s <= t) ? kd[((t - s) * 16 + c) * 16 + c0 + jj] : 0.f;
        } else {
#pragma unroll
            for (int jj = 0; jj < 8; ++jj) { const int kq = (ch - 32) * 8 + jj, p = kq >> 1; const float2 C = cc[c * 64 + p], W = pw[(t + 1) * 64 + p];
                v[jj] = (kq & 1) ? -(C.x * W.y + C.y * W.x) : (C.x * W.x - C.y * W.y); }
        }
        u32x4 w; w.x = cvtpk(v[0], v[1]); w.y = cvtpk(v[2], v[3]); w.z = cvtpk(v[4], v[5]); w.w = cvtpk(v[6], v[7]);
        *(u32x4*)(BtY + ((size_t)(((n >> 5) * 24 + (ch >> 1)) * 64 + (ch & 1) * 32 + (n & 31))) * 8) = w; }
    for (int idx = tid; idx < 128 * 32; idx += NTHR) { const int n = idx >> 5, ch = idx & 31, p = n >> 1, s = ch >> 1, c0 = (ch & 1) * 8;
        const float2 W = pw[(15 - s) * 64 + p];
        float v[8];
#pragma unroll
        for (int jj = 0; jj < 8; ++jj) { const float2 B = bb[p * 16 + c0 + jj]; v[jj] = (n & 1) ? (W.x * B.y + W.y * B.x) : (W.x * B.x - W.y * B.y); }
        u32x4 w; w.x = cvtpk(v[0], v[1]); w.y = cvtpk(v[2], v[3]); w.z = cvtpk(v[4], v[5]); w.w = cvtpk(v[6], v[7]);
        *(u32x4*)(BtE + ((size_t)(((n >> 5) * 16 + (ch >> 1)) * 64 + (ch & 1) * 32 + (n & 31))) * 8) = w; }
    __syncthreads();
}
__device__ __forceinline__ float gelu_t(float x) { const float u = 0.7978845608028654f * (x + 0.044715f * x * x * x); const float e = __expf(2.f * u); return x - x / (e + 1.f); }
__device__ __forceinline__ void fused_unit(KP P, char* lds, int layer, int b, int g) {
    const int tid = tid_(), lane = tid & 63, wid = tid >> 6, r32 = lane & 31, hh = lane >> 5;
    constexpr int UCH = 528, UBYTES = 68352;
    char* U16 = lds; float* El = (float*)(lds + UBYTES);
    const float* PA = P->PA; bf16_t* YG = P->YG;
    { const float* ub = PA + (size_t)(b * LL) * PAW + 2048 + g * 16;
#pragma unroll 1
      for (int i0 = 0; i0 < LL * 4; i0 += NTHR * 4) {
          float4 v[4];
#pragma unroll
          for (int q = 0; q < 4; ++q) { const int idx = i0 + q * NTHR + tid, ic = idx < LL * 4 ? idx : LL * 4 - 1; v[q] = *(const float4*)(ub + (size_t)(ic >> 2) * PAW + (ic & 3) * 4); }
#pragma unroll
          for (int q = 0; q < 4; ++q) { const int idx = i0 + q * NTHR + tid; if (idx < LL * 4) { const int r = idx >> 2;
              uint2 w; w.x = cvtpk(v[q].x, v[q].y); w.y = cvtpk(v[q].z, v[q].w); *(uint2*)(U16 + (r >> 4) * UCH + (r & 15) * 32 + (idx & 3) * 8) = w; } }
      } }
    __syncthreads();
    int mrow[5];
#pragma unroll
    for (int mt = 0; mt < 5; ++mt) { const int m = mt * 32 + r32; mrow[mt] = m < 129 ? m : 128; }
    if (wid < 4) {
        const bf16_t* Bt = P->BtE + (size_t)(layer * 32 + g) * 128 * 256 + ((size_t)(wid * 16) * 64 + lane) * 8;
        f32x16 acc[5];
#pragma unroll
        for (int mt = 0; mt < 5; ++mt) acc[mt] = f32x16{};
#pragma unroll 4
        for (int s = 0; s < 16; ++s) {
            const bf16x8 af = *(const bf16x8*)(Bt + (size_t)(s * 64) * 8);
#pragma unroll
            for (int mt = 0; mt < 5; ++mt) { const bf16x8 bf = *(const bf16x8*)(U16 + mrow[mt] * UCH + hh * 16 + 32 * s); acc[mt] = __builtin_amdgcn_mfma_f32_32x32x16_bf16(af, bf, acc[mt], 0, 0, 0); }
        }
#pragma unroll
        for (int mt = 0; mt < 5; ++mt) { const int m = mt * 32 + r32; if (m < 129) { float* ep = El + m * 128 + wid * 32 + 4 * hh;
#pragma unroll
            for (int q = 0; q < 4; ++q) *(float4*)(ep + 8 * q) = make_float4(acc[mt][4 * q], acc[mt][4 * q + 1], acc[mt][4 * q + 2], acc[mt][4 * q + 3]); } }
    }
    __syncthreads();
    if (tid < 64) {
        const float2 A = ((const float2*)P->A16)[(layer * 32 + g) * 64 + tid];
        float2* e2 = (float2*)El + tid;
        float xr = 0.f, xi = 0.f;
#pragma unroll 1
        for (int j0 = 0; j0 < 128; j0 += 8) {
            float2 e[8];
#pragma unroll
            for (int i = 0; i < 8; ++i) e[i] = e2[(j0 + i) * 64];
#pragma unroll
            for (int i = 0; i < 8; ++i) { e2[(j0 + i) * 64] = make_float2(xr, xi);
                const float nr = A.x * xr - A.y * xi + e[i].x, ni = A.x * xi + A.y * xr + e[i].y; xr = nr; xi = ni; }
        }
        e2[128 * 64] = make_float2(xr, xi);
    }
    __syncthreads();
    {
        const bf16_t* Bt = P->BtY + (size_t)(layer * 32 + g) * 256 * 384 + ((size_t)(wid * 24) * 64 + lane) * 8;
        f32x16 acc[5];
#pragma unroll
        for (int mt = 0; mt < 5; ++mt) acc[mt] = f32x16{};
#pragma unroll 4
        for (int s = 0; s < 16; ++s) if (2 * wid + 1 >= s) {
            const bf16x8 af = *(const bf16x8*)(Bt + (size_t)(s * 64) * 8);
#pragma unroll
            for (int mt = 0; mt < 5; ++mt) { const bf16x8 bf = *(const bf16x8*)(U16 + mrow[mt] * UCH + hh * 16 + 32 * s); acc[mt] = __builtin_amdgcn_mfma_f32_32x32x16_bf16(af, bf, acc[mt], 0, 0, 0); }
        }
#pragma unroll 4
        for (int ks = 0; ks < 8; ++ks) {
            const bf16x8 af = *(const bf16x8*)(Bt + (size_t)((16 + ks) * 64) * 8);
#pragma unroll
            for (int mt = 0; mt < 5; ++mt) { const bf16x8 bf = ld8f(El + mrow[mt] * 128 + 8 * hh + ks * 16); acc[mt] = __builtin_amdgcn_mfma_f32_32x32x16_bf16(af, bf, acc[mt], 0, 0, 0); }
        }
#pragma unroll
        for (int mt = 0; mt < 5; ++mt) { const int ml = mt * 32 + r32; if (ml < 129) { const int m = b * 129 + ml;
#pragma unroll
            for (int q = 0; q < 4; ++q) { const int t = 2 * wid + (q >> 1);
                uint2 w; w.x = cvtpk(gelu_t(acc[mt][4 * q]), gelu_t(acc[mt][4 * q + 1])); w.y = cvtpk(gelu_t(acc[mt][4 * q + 2]), gelu_t(acc[mt][4 * q + 3]));
                *(uint2*)(YG + (size_t)(m * 16 + t) * 512 + g * 16 + 8 * (q & 1) + 4 * hh) = w; } } }
    }
    __syncthreads();
}
}

__device__ __forceinline__ float wave_sum(float v) {
    v += swz_xor<1>(v); v += swz_xor<2>(v); v += swz_xor<4>(v); v += swz_xor<8>(v); v += swz_xor<16>(v);
    { auto rr = __builtin_amdgcn_permlane32_swap(__float_as_uint(v), __float_as_uint(v), false, false); v = __uint_as_float(rr[0]) + __uint_as_float(rr[1]); }
    return v;
}
__device__ __forceinline__ unsigned cvtpk_(float lo, float hi) { unsigned r; asm volatile("v_cvt_pk_bf16_f32 %0, %1, %2" : "=v"(r) : "v"(lo), "v"(hi)); return r; }
__device__ __forceinline__ void ph_attn_out(KP P, int layer, int cu0) {
    const int tid = tid_(), lane = tid & 63, gw = (bid_() - cu0) * 8 + (tid >> 6), NGW = (gridDim.x - cu0) * 8;
    if (gw < 0) return;
    const float scale = 1.f - (0.8f - 0.6f * expf(-0.3f * (float)layer));
    const float lam = P->lam[layer];
    const float4 sw = ((const float4*)(P->subln + layer * 256))[lane];
    const float* OC = P->OC; bf16_t* MIX = P->MIX;
    for (int it0 = gw; it0 < TOK * 4; it0 += NGW * 4) {
        float4 a[4], b[4];
#pragma unroll
        for (int q = 0; q < 4; ++q) { const int it = it0 + NGW * q, itc = it < TOK * 4 ? it : TOK * 4 - 1, r = itc >> 2, h = itc & 3;
            a[q] = *(const float4*)(OC + (size_t)r * DM + h * 512 + lane * 4); b[q] = *(const float4*)(OC + (size_t)r * DM + h * 512 + 256 + lane * 4); }
#pragma unroll
        for (int q = 0; q < 4; ++q) { const int it = it0 + NGW * q; if (it < TOK * 4) { const int r = it >> 2, h = it & 3;
            const float o0 = a[q].x - lam * b[q].x, o1 = a[q].y - lam * b[q].y, o2 = a[q].z - lam * b[q].z, o3 = a[q].w - lam * b[q].w;
            const float ss = wave_sum(o0 * o0 + o1 * o1 + o2 * o2 + o3 * o3);
            const float rs = rsqrtf(ss * (1.f / 256.f) + EPS) * scale;
            uint2 w; w.x = cvtpk_(o0 * rs * sw.x, o1 * rs * sw.y); w.y = cvtpk_(o2 * rs * sw.z, o3 * rs * sw.w);
            *(uint2*)(MIX + (size_t)r * DM + 1024 + h * 256 + lane * 4) = w; } }
    }
}
__device__ __forceinline__ void ph_build_norm(KP P) {
    const int tid = tid_(), lane = tid & 63, gw = bid_() * 8 + (tid >> 6), NGW = gridDim.x * 8;
    for (int r = gw; r < MP; r += NGW) {
        float4 v[8];
        if (r < TOK) { const int b = r / LL, t = r % LL;
            const float4* src = (const float4*)(t < NMETA ? P->meta + (size_t)t * DM : P->x + ((size_t)b * SEQ + (t - NMETA)) * DM);
#pragma unroll
            for (int j = 0; j < 8; ++j) v[j] = src[lane + 64 * j];
        } else {
#pragma unroll
            for (int j = 0; j < 8; ++j) v[j] = make_float4(0.f, 0.f, 0.f, 0.f);
        }
        float ss = 0.f;
#pragma unroll
        for (int j = 0; j < 8; ++j) { ((float4*)(P->Z + (size_t)r * DM))[lane + 64 * j] = v[j]; ss += v[j].x * v[j].x + v[j].y * v[j].y + v[j].z * v[j].z + v[j].w * v[j].w; }
        const float rs = rsqrtf(wave_sum(ss) * (1.f / DM) + EPS);
#pragma unroll
        for (int j = 0; j < 8; ++j) { const float4 w = ((const float4*)P->ln1_w)[lane + 64 * j];
            uint2 o; o.x = cvtpk_(v[j].x * rs * w.x, v[j].y * rs * w.y); o.y = cvtpk_(v[j].z * rs * w.z, v[j].w * rs * w.w);
            ((uint2*)(P->HN + (size_t)r * DM))[lane + 64 * j] = o; }
    }
}
__device__ __forceinline__ void ph_prep(KP P) {
    const int tid = tid_();
    if (bid_() == 0) {
        const int c = tid;
        const float l0 = P->lbnd[c], l1 = P->lbnd[512 + c], m = fmaxf(l0, l1), e0 = expf(l0 - m), e1 = expf(l1 - m);
        P->lbtab[c] = 0.f; P->lbtab[512 + c] = e1 / (e0 + e1);
        if (c < 2) {
            float s1 = 0.f, s2 = 0.f;
            for (int i = 0; i < 128; ++i) { s1 += P->lq1[c * 128 + i] * P->lk1[c * 128 + i]; s2 += P->lq2[c * 128 + i] * P->lk2[c * 128 + i]; }
            const float li = 0.8f - 0.6f * expf(-0.3f * (float)c);
            P->lam[c] = expf(s1) - expf(s2) + li;
        }
    }
    for (int i = bid_() * NTHR + tid; i < 2 * 128 * 3 * 64 * 8; i += gridDim.x * NTHR) {
        const int jj = i & 7, ln = (i >> 3) & 63, ct = (i >> 9) % 3, ksg = ((i >> 9) / 3) & 127, layer = (i >> 9) / (3 * 128);
        const int jc = ct * 32 + (ln & 31), k = ksg * 16 + 8 * (ln >> 5) + jj;
        float v = 0.f;
        if (jc < 8) v = P->wrg[((size_t)layer * DM + k) * 8 + jc]; else if (jc < 72) v = P->wre[((size_t)layer * DM + k) * 64 + jc - 8];
        v *= P->ln2_w[layer * DM + k];
        const bf16_t hi = f2bf(v), lo = f2bf(v - bf2f(hi));
        const size_t o = ((size_t)((ksg * 3 + ct) * 64 + ln)) * 8 + jj;
        P->WRT[(size_t)(layer * 2 + 0) * 96 * DM + o] = hi; P->WRT[(size_t)(layer * 2 + 1) * 96 * DM + o] = lo;
    }
}
namespace rt {
using f32x16 = __attribute__((ext_vector_type(16))) float;
using bf16x8 = __attribute__((ext_vector_type(8))) short;
using u32x4  = __attribute__((ext_vector_type(4))) unsigned;
__device__ __forceinline__ void norm_router(KP P, char* lds, int layer) {
    const int tid = tid_(), lane = tid & 63, wid = tid >> 6, r32 = lane & 31, hh = lane >> 5;
    float* part = (float*)lds;
    float* ssqp = (float*)(lds + 98304);
    float* lg = ssqp + 256;
    float* rsv = lg + 32 * 97;
    const bf16_t* Whi = P->WRT + (size_t)(layer * 2 + 0) * 96 * DM; const bf16_t* Wlo = P->WRT + (size_t)(layer * 2 + 1) * 96 * DM;
    const float* Z = P->Z;
    float* st = (float*)lds + wid * (32 * 68);
    const int nunits = layer == 1 ? (NB * SEQ) / 32 : TOK / 32;
    for (int u = bid_(); u < nunits; u += gridDim.x) {
        const int tok0 = layer == 1 ? (u >> 6) * LL + NMETA + (u & 63) * 32 : u * 32, kb = wid * 256;
        if (false) {
            float* Zw = P->Z; const float* ZP = P->ZP;
            for (int i = tid; i < 32 * DM / 4; i += NTHR) { const int r = i / (DM / 4), c4 = i % (DM / 4);
                float4 z = ((const float4*)(Zw + (size_t)(tok0 + r) * DM))[c4];
#pragma unroll
                for (int ks = 0; ks < 8; ++ks) { const float4 p4 = ((const float4*)(ZP + ((size_t)ks * 256 + (tok0 - 8192 + r)) * DM))[c4]; z.x += p4.x; z.y += p4.y; z.z += p4.z; z.w += p4.w; }
                ((float4*)(Zw + (size_t)(tok0 + r) * DM))[c4] = z; }
            asm volatile("s_waitcnt vmcnt(0)" ::: "memory");
            __syncthreads();
        }
        f32x16 acc[3] = {f32x16{}, f32x16{}, f32x16{}};
        float sq8[8];
#pragma unroll
        for (int j = 0; j < 8; ++j) sq8[j] = 0.f;
        const float* zg = Z + (size_t)(tok0 + (lane >> 4)) * DM + kb + (lane & 15) * 4;
        float4 zs[8];
#pragma unroll
        for (int j = 0; j < 8; ++j) zs[j] = *(const float4*)(zg + (size_t)(4 * j) * DM);
#pragma unroll 1
        for (int sc = 0; sc < 4; ++sc) {
#pragma unroll
            for (int j = 0; j < 8; ++j) { const float4 z = zs[j]; sq8[j] += z.x * z.x + z.y * z.y + z.z * z.z + z.w * z.w;
                *(float4*)(st + ((lane >> 4) + 4 * j) * 68 + (lane & 15) * 4) = z; }
            const int scn = sc < 3 ? sc + 1 : 3;
#pragma unroll
            for (int j = 0; j < 8; ++j) zs[j] = *(const float4*)(zg + (size_t)(4 * j) * DM + scn * 64);
            asm volatile("s_waitcnt lgkmcnt(0)" ::: "memory");
            const bf16_t* wh = Whi + ((size_t)((wid * 16 + sc * 4) * 3) * 64 + lane) * 8; const bf16_t* wl = Wlo + ((size_t)((wid * 16 + sc * 4) * 3) * 64 + lane) * 8;
#pragma unroll
            for (int ks = 0; ks < 4; ++ks) {
                const float4 z0 = *(const float4*)(st + r32 * 68 + ks * 16 + 8 * hh), z1 = *(const float4*)(st + r32 * 68 + ks * 16 + 8 * hh + 4);
                u32x4 h; h.x = cvtpk_(z0.x, z0.y); h.y = cvtpk_(z0.z, z0.w); h.z = cvtpk_(z1.x, z1.y); h.w = cvtpk_(z1.z, z1.w);
                u32x4 l; l.x = cvtpk_(z0.x - __uint_as_float(h.x << 16), z0.y - __uint_as_float(h.x & 0xffff0000u)); l.y = cvtpk_(z0.z - __uint_as_float(h.y << 16), z0.w - __uint_as_float(h.y & 0xffff0000u));
                l.z = cvtpk_(z1.x - __uint_as_float(h.z << 16), z1.y - __uint_as_float(h.z & 0xffff0000u)); l.w = cvtpk_(z1.z - __uint_as_float(h.w << 16), z1.w - __uint_as_float(h.w & 0xffff0000u));
                const bf16x8 zh = *reinterpret_cast<bf16x8*>(&h), zl = *reinterpret_cast<bf16x8*>(&l);
#pragma unroll
                for (int ct = 0; ct < 3; ++ct) {
                    const bf16x8 ah = *(const bf16x8*)(wh + (size_t)((ks * 3 + ct) * 64) * 8), al = *(const bf16x8*)(wl + (size_t)((ks * 3 + ct) * 64) * 8);
                    acc[ct] = __builtin_amdgcn_mfma_f32_32x32x16_bf16(ah, zh, acc[ct], 0, 0, 0);
                    acc[ct] = __builtin_amdgcn_mfma_f32_32x32x16_bf16(ah, zl, acc[ct], 0, 0, 0);
                    acc[ct] = __builtin_amdgcn_mfma_f32_32x32x16_bf16(al, zh, acc[ct], 0, 0, 0);
                }
            }
            asm volatile("s_waitcnt lgkmcnt(0)" ::: "memory");
        }
#pragma unroll
        for (int j = 0; j < 8; ++j) { float v = sq8[j]; v += swz_xor<1>(v); v += swz_xor<2>(v); v += swz_xor<4>(v); v += swz_xor<8>(v); sq8[j] = v; }
        __syncthreads();
        if ((lane & 15) == 0) {
#pragma unroll
            for (int j = 0; j < 8; ++j) ssqp[wid * 32 + (lane >> 4) + 4 * j] = sq8[j];
        }

#pragma unroll
        for (int ct = 0; ct < 3; ++ct)
#pragma unroll
            for (int rg = 0; rg < 16; ++rg) part[((wid * 3 + ct) * 16 + rg) * 64 + lane] = acc[ct][rg];
        __syncthreads();
        if (tid < 32) { float t = 0.f;
#pragma unroll
            for (int w = 0; w < 8; ++w) t += ssqp[w * 32 + tid];
            rsv[tid] = rsqrtf(t * (1.f / DM) + EPS); }
#pragma unroll
        for (int q = 0; q < 6; ++q) { const int o = tid + NTHR * q, col = o >> 5, tok = o & 31, ct = col >> 5, cl = col & 31, h2 = (cl >> 2) & 1, rg = (cl & 3) + 4 * (cl >> 3);
            float t = 0.f;
#pragma unroll
            for (int w = 0; w < 8; ++w) t += part[((w * 3 + ct) * 16 + rg) * 64 + h2 * 32 + tok];
            lg[tok * 97 + col] = t; }
        __syncthreads();
        if (tid < 32) {
            const int t = tok0 + tid; const float rs = rsv[tid]; const float* l = lg + tid * 97;
            const float* brg = P->brg + layer * 8; const float* bre = P->bre + layer * 64;
            float gl[8];
#pragma unroll
            for (int j = 0; j < 8; ++j) gl[j] = l[j] * rs + brg[j];
            int gs = 0; float gm = gl[0];
#pragma unroll
            for (int j = 1; j < 8; ++j) if (gl[j] > gm) { gm = gl[j]; gs = j; }
            float den = 0.f;
#pragma unroll
            for (int j = 0; j < 8; ++j) den += expf(gl[j] - gm);
            const float pg = 1.f / den;
            float el[8];
#pragma unroll
            for (int j = 0; j < 8; ++j) el[j] = l[8 + gs * 8 + j] * rs + bre[gs * 8 + j];
            int j0 = 0; float v0 = el[0];
#pragma unroll
            for (int j = 1; j < 8; ++j) if (el[j] > v0) { v0 = el[j]; j0 = j; }
            int j1 = -1; float v1 = -INFINITY;
#pragma unroll
            for (int j = 0; j < 8; ++j) if (j != j0 && el[j] > v1) { v1 = el[j]; j1 = j; }
            const float e1 = expf(v1 - v0), g0 = pg / (1.f + e1), g1 = pg * e1 / (1.f + e1);
            const int x0 = gs * 8 + j0, x1 = gs * 8 + j1;
            P->ridx[t * 2] = x0; P->ridx[t * 2 + 1] = x1; P->rgate[t * 2] = g0; P->rgate[t * 2 + 1] = g1;
            const int s0 = atomicAdd(&P->cnt[x0 * CSTR], 1), s1 = atomicAdd(&P->cnt[x1 * CSTR], 1);
            P->rslot[t * 2] = s0; P->rslot[t * 2 + 1] = s1;
            if (s0 < ECAP) P->elist[x0 * ECAP + s0] = t; if (s1 < ECAP) P->elist[x1 * ECAP + s1] = t;
        }
#pragma unroll 1
        for (int q = 0; q < 4; q += 2) { const int tk = wid * 4 + q; const float rs0 = rsv[tk], rs1 = rsv[tk + 1];
            const float4* zr = (const float4*)(Z + (size_t)(tok0 + tk) * DM); const float4* wl4 = (const float4*)(P->ln2_w + layer * DM);
            float4 za[8], zb[8];
#pragma unroll
            for (int j = 0; j < 8; ++j) { za[j] = zr[lane + 64 * j]; zb[j] = zr[DM / 4 + lane + 64 * j]; }
#pragma unroll
            for (int j = 0; j < 8; ++j) { const float4 w = wl4[lane + 64 * j];
                uint2 o; o.x = cvtpk_(za[j].x * rs0 * w.x, za[j].y * rs0 * w.y); o.y = cvtpk_(za[j].z * rs0 * w.z, za[j].w * rs0 * w.w);
                ((uint2*)(P->HN + (size_t)(tok0 + tk) * DM))[lane + 64 * j] = o;
                o.x = cvtpk_(zb[j].x * rs1 * w.x, zb[j].y * rs1 * w.y); o.y = cvtpk_(zb[j].z * rs1 * w.z, zb[j].w * rs1 * w.w);
                ((uint2*)(P->HN + (size_t)(tok0 + tk + 1) * DM))[lane + 64 * j] = o; } }
        __syncthreads();
    }
}
}
__device__ __forceinline__ void ph_combine_norm(KP P, char* lds, int layer) {
    int* base = (int*)lds;
    const int tid = tid_(), lane = tid & 63, gw = bid_() * 8 + (tid >> 6), NGW = gridDim.x * 8;
    if (tid < 64) base[64 + tid] = P->cnt[tid * CSTR];
    __syncthreads();
    if (tid < 64) { int a = 0; for (int q = 0; q < tid; ++q) a += base[64 + q]; base[tid] = a; }
    __syncthreads();
    for (int t0 = gw; t0 < TOK; t0 += 2 * NGW) {
        int r0[2], r1[2]; float g0[2], g1[2]; bool ok[2]; int tcs[2];
        int2 ex[2], sl[2]; float2 gg[2];
        float4 v[2][8]; uint2 ya[2][8], yb[2][8];
#pragma unroll
        for (int q = 0; q < 2; ++q) { const int t = t0 + q * NGW; ok[q] = t < TOK && !(layer == 1 && (t % LL) < NMETA); tcs[q] = ok[q] ? t : (layer == 1 ? NMETA : t0);
            ex[q] = ((const int2*)P->ridx)[tcs[q]]; sl[q] = ((const int2*)P->rslot)[tcs[q]]; gg[q] = ((const float2*)P->rgate)[tcs[q]];
#pragma unroll
            for (int j = 0; j < 8; ++j) v[q][j] = ((const float4*)(P->Z + (size_t)tcs[q] * DM))[lane + 64 * j]; }
#pragma unroll
        for (int q = 0; q < 2; ++q) { r0[q] = base[ex[q].x] + sl[q].x; r1[q] = base[ex[q].y] + sl[q].y; g0[q] = gg[q].x; g1[q] = gg[q].y;
#pragma unroll
            for (int j = 0; j < 8; ++j) { ya[q][j] = ((const uint2*)(P->Y + (size_t)r0[q] * DM))[lane + 64 * j]; yb[q][j] = ((const uint2*)(P->Y + (size_t)r1[q] * DM))[lane + 64 * j]; } }
#pragma unroll
        for (int q = 0; q < 2; ++q) if (ok[q]) { const int t = t0 + q * NGW;
            float ss = 0.f;
#pragma unroll
            for (int j = 0; j < 8; ++j) { const uint2 a = ya[q][j], b = yb[q][j]; float4& x = v[q][j];
                x.x += g0[q] * __uint_as_float(a.x << 16) + g1[q] * __uint_as_float(b.x << 16); x.y += g0[q] * __uint_as_float(a.x & 0xffff0000u) + g1[q] * __uint_as_float(b.x & 0xffff0000u);
                x.z += g0[q] * __uint_as_float(a.y << 16) + g1[q] * __uint_as_float(b.y << 16); x.w += g0[q] * __uint_as_float(a.y & 0xffff0000u) + g1[q] * __uint_as_float(b.y & 0xffff0000u);
                ss += x.x * x.x + x.y * x.y + x.z * x.z + x.w * x.w; }
            const float rs = rsqrtf(wave_sum(ss) * (1.f / DM) + EPS);
            if (layer == 0) {
#pragma unroll
                for (int j = 0; j < 8; ++j) { ((float4*)(P->Z + (size_t)t * DM))[lane + 64 * j] = v[q][j];
                    const float4 w = ((const float4*)(P->ln1_w + DM))[lane + 64 * j];
                    uint2 o; o.x = cvtpk_(v[q][j].x * rs * w.x, v[q][j].y * rs * w.y); o.y = cvtpk_(v[q][j].z * rs * w.z, v[q][j].w * rs * w.w);
                    ((uint2*)(P->HN + (size_t)t * DM))[lane + 64 * j] = o; }
            } else {
                const int b = t / LL, tt = t % LL;
                if (tt >= NMETA) {
#pragma unroll
                    for (int j = 0; j < 8; ++j) { const float4 w = ((const float4*)P->fnw)[lane + 64 * j];
                        ((float4*)(P->out + ((size_t)b * SEQ + (tt - NMETA)) * DM))[lane + 64 * j] = make_float4(v[q][j].x * rs * w.x, v[q][j].y * rs * w.y, v[q][j].z * rs * w.z, v[q][j].w * rs * w.w); }
                }
            }
        }
    }
    __syncthreads();
}

__global__ void __launch_bounds__(NTHR, 2) mega_fwd(Params P_arg) {
    extern __shared__ __attribute__((aligned(16))) char lds[];
    const int tid = tid_(), G = gridDim.x;
    volatile LAS unsigned* ctlw = (volatile LAS unsigned*)((LAS char*)lds + LDS_CTL);
    if (tid < 64) ctlw[tid] = 0u;
    __syncthreads();
    KP P = kp_();
    XcdBarrier bar = xcd_barrier_post(P->bar, ctlw + 8);
#define GRID_BAR() do { xcd_barrier(bar); P = kp_(); } while (0)

    ph_build_norm(P);
    ph_prep(P);
    ph_weights(P, lds);
    __syncthreads();
    for (int un = bid_(); un < 64; un += G) s5::prep_unit(P, lds, un >> 5, un & 31);
    GRID_BAR();
#pragma unroll
    for (int layer = 0; layer < 2; ++layer) {
        { pg8::Gemm g{P->HN, P->WinT + (size_t)layer * INW * DM, MP, INW, DM, DM}; pg8::StaticOrder S; S.init(MP, INW, G, bid_(), DM / 64); pg8::EpiInProj E{P->PA, P->QKV};
          pg8::gemm_phase<pg8::EpiInProj, pg8::StaticOrder, true, true>((LAS unsigned char*)lds, g, S, E); }
        { const int t2 = tid_(), b2 = bid_(); if (b2 == 0 && t2 < NE) P->cnt[t2 * CSTR] = 0;
 }
        GRID_BAR();
        hg::local_states(P, lds, layer);
        { const int b0 = bid_(); for (int un = (G == 256) ? ((b0 + 128) & 255) : b0; un < 128; un += G) s5::fused_unit(P, lds, layer, un >> 5, un & 31); }
        ph_attention(P, lds);
        GRID_BAR();
        hg::scan_states(P);
        ph_attn_out(P, layer, G > 192 ? 132 : 0);
        __syncthreads();
        { pg8::Gemm g{P->YG, P->WgluT + (size_t)layer * 1024 * 512, MP, 1024, 512, 512}; pg8::StaticOrder S; S.init(MP, 1024, G, bid_(), 512 / 64); pg8::EpiGlu E{P->MIX, P->b_glu + layer * 1024};
          pg8::gemm_phase<pg8::EpiGlu, pg8::StaticOrder, true, true>((LAS unsigned char*)lds, g, S, E); }
        GRID_BAR();
        hg::outputs(P, lds, layer);
        GRID_BAR();
        { pg8::Gemm g{P->MIX, P->WoutT + (size_t)layer * DM * DM, MP, DM, DM, DM}; pg8::StaticOrder S; S.init(MP, DM, G, bid_(), DM / 64); pg8::EpiResidual E{P->Z};
          pg8::gemm_phase<pg8::EpiResidual, pg8::StaticOrder, true, true>((LAS unsigned char*)lds, g, S, E); }
        GRID_BAR();
        rt::norm_router(P, lds, layer);
        GRID_BAR();
        moe::stream_gemm<true>(P, lds, layer);
        GRID_BAR();
        moe::stream_gemm<false>(P, lds, layer);
        GRID_BAR();
        ph_combine_norm(P, lds, layer);
        if (layer == 0) GRID_BAR();
    }
}
}

extern "C" void kernel_launch(void* const* d_in, const int* in_sizes, int n_in, void* d_out, int out_size, void* d_ws, size_t ws_size, hipStream_t stream) {
    static int grid = 0;
    if (grid == 0) {
        int dev = 0, cus = 0;
        if (hipGetDevice(&dev) != hipSuccess || hipDeviceGetAttribute(&cus, hipDeviceAttributeMultiprocessorCount, dev) != hipSuccess) { grid = -1; return; }
        if (hipFuncSetAttribute((const void*)mega_fwd, hipFuncAttributeMaxDynamicSharedMemorySize, LDS_BYTES) != hipSuccess) { grid = -1; return; }
        int per_cu = 0;
        if (hipOccupancyMaxActiveBlocksPerMultiprocessor(&per_cu, (const void*)mega_fwd, NTHR, LDS_BYTES) != hipSuccess || per_cu < 1) { (void)hipGetLastError(); }
        grid = cus;
    }
    if (grid < 0) return;
    Params p{};
    const float** pin = (const float**)&p;
    for (int i = 0; i < 31; ++i) pin[i] = (const float*)d_in[i];
    p.out = (float*)d_out;
    char* ws = (char*)d_ws; size_t off = 0;
    auto alloc = [&](size_t bytes) { char* q = ws + off; off += (bytes + 255) & ~(size_t)255; return q; };
    p.bar = (unsigned*)alloc(XCD_BAR_WORDS * 4);
    p.elist = (int*)alloc((size_t)NE * ECAP * 4);
    p.cnt = (int*)alloc((size_t)NE * CSTR * 4); p.blk_e = (int*)alloc(1024); p.base = (int*)alloc(256);
    p.lbtab = (float*)alloc(1024 * 4); p.lam = (float*)alloc(256);
    p.Z = (float*)alloc((size_t)MP * DM * 4);
    p.HN = (bf16_t*)alloc((size_t)MP * DM * 2);
    p.PA = (float*)alloc((size_t)MP * PAW * 4);
    p.QKV = (bf16_t*)alloc((size_t)MP * QKVW * 2);
    p.OA = (float*)alloc((size_t)MP * HW * 4);
    p.ZP = (float*)alloc((size_t)8 * 256 * DM * 4);
    p.WRT = (bf16_t*)alloc((size_t)2 * 2 * 96 * DM * 2);
    p.A16 = (float*)alloc(2 * 32 * 64 * 8); p.S5E = (float*)alloc((size_t)516 * 32 * 128 * 4); p.S5X = (float*)alloc((size_t)516 * 32 * 128 * 4);
    p.BtY = (bf16_t*)alloc((size_t)2 * 32 * 256 * 384 * 2); p.BtE = (bf16_t*)alloc((size_t)2 * 32 * 128 * 256 * 2);
    p.SLOC = (float*)alloc((size_t)528 * 16384 * 4); p.DEC = (float*)alloc((size_t)528 * 128 * 4); p.SPREV = (bf16_t*)alloc((size_t)529 * 16384 * 2);
    p.YG = (bf16_t*)alloc((size_t)MP * 512 * 2);
    p.T = nullptr;
    p.MIX = (bf16_t*)alloc((size_t)MP * DM * 2);
    p.OC = (float*)alloc((size_t)MP * DM * 4);
    p.ridx = (int*)alloc((size_t)NASSIGN * 4); p.rgate = (float*)alloc((size_t)NASSIGN * 4); p.rslot = (int*)alloc((size_t)NASSIGN * 4);
    p.tokrow = (int*)alloc((size_t)NASSIGN * 4); p.rowtok = (int*)alloc((size_t)NRMAX * 4);
    p.H1 = nullptr;
    p.H = (bf16_t*)alloc((size_t)NRMAX * DE * 2);
    p.Y = (bf16_t*)alloc((size_t)NRMAX * DM * 2);
    p.S = nullptr;
    p.WinT = (bf16_t*)alloc((size_t)2 * INW * DM * 2); p.WoutT = (bf16_t*)alloc((size_t)2 * DM * DM * 2); p.WgluT = (bf16_t*)alloc((size_t)2 * 1024 * 512 * 2);
    if (off > ws_size) return;
    if (hipMemsetAsync(p.bar, 0, XCD_BAR_WORDS * 4, stream) != hipSuccess) return;
    hipLaunchKernelGGL(mega_fwd, dim3(grid), dim3(NTHR), LDS_BYTES, stream, p);
}
```

```cpp
#include <hip/hip_runtime.h>
#include <stdint.h>
#include <math.h>

namespace {
typedef unsigned short bf16_t;
constexpr int DM = 2048, NB = 4, SEQ = 2048, NMETA = 16, LL = SEQ + NMETA, TOK = NB * LL, MP = 8448;
constexpr int HW = 512;
constexpr int INW = 5632, PAW = 2560, QKVW = 3072;
constexpr int NE = 64, DE = 512, NASSIGN = TOK * 2;
constexpr int RB = 128;
constexpr int NRMAX = NASSIGN + NE * RB;
constexpr float EPS = 1e-6f;
constexpr int NTHR = 512;
constexpr int CSTR = 64;
constexpr int ECAP = 1024;
constexpr int LDS_BYTES = 147456;
constexpr int LDS_CTL = 143360;

__device__ __forceinline__ float bf2f(bf16_t h) { return __uint_as_float(((unsigned)h) << 16); }
__device__ __forceinline__ bf16_t f2bf(float f) { unsigned u = __float_as_uint(f); return (bf16_t)((u + 0x7fffu + ((u >> 16) & 1u)) >> 16); }
__device__ __forceinline__ float sigmoidf_(float x) { return 1.f / (1.f + expf(-x)); }
__device__ __forceinline__ int tid_() { int t = threadIdx.x; asm volatile("" : "+v"(t)); return t; }
template <int K> __device__ __forceinline__ float swz_xor(float v) { return __int_as_float(__builtin_amdgcn_ds_swizzle(__float_as_int(v), (K << 10) | 0x1f)); }
__device__ __forceinline__ int bid_() { int b = blockIdx.x; asm volatile("" : "+s"(b)); return b; }

#define XB_TMO      128
#define XB_XCNT(j)  (256  + 64 * (j))
#define XB_XSUB(j)  (1280 + 64 * (j))
#define XB_XGEN(j)  (2304 + 64 * (j))
#define XB_TOP      3328
#define XB_TOPGEN   3392
#define XCD_BAR_WORDS 3456
#define XB_SPIN_CAP (1u << 24)
#define LAS __attribute__((address_space(3)))
__device__ __forceinline__ unsigned xb_ld(unsigned* p)              { return __hip_atomic_load(p, __ATOMIC_RELAXED, __HIP_MEMORY_SCOPE_AGENT); }
__device__ __forceinline__ unsigned xb_add(unsigned* p, unsigned v) { return __hip_atomic_fetch_add(p, v, __ATOMIC_RELAXED, __HIP_MEMORY_SCOPE_AGENT); }
__device__ __forceinline__ unsigned xb_xcc_id() { return (unsigned)__builtin_amdgcn_s_getreg((3 << 11) | 20) & 0xFu; }
#define XB_SPIN(cond, bar) do { unsigned _sp = 0; while (cond) { __builtin_amdgcn_s_sleep(1); \
    if ((++_sp & 255u) == 0u) { if (xb_ld(&(bar)[XB_TMO])) break; if (_sp > XB_SPIN_CAP) { atomicAdd(&(bar)[XB_TMO], 1u); break; } } } } while (0)
struct XcdBarrier { unsigned* bar; unsigned x; volatile LAS unsigned* st; };
__device__ __forceinline__ XcdBarrier xcd_barrier_post(unsigned* bar, volatile LAS unsigned* st) {
    XcdBarrier b; b.bar = bar; b.x = xb_xcc_id(); b.st = st;
    if (threadIdx.x == 0) (void)xb_add(&bar[XB_XCNT(b.x)], 1u);
    return b;
}
__device__ __forceinline__ void xcd_barrier_complete(unsigned* bar, unsigned x, unsigned& nloc, unsigned& nx) {
    const unsigned G = gridDim.x * gridDim.y * gridDim.z;
    unsigned sum, cnt, mine, sp = 0u;
    for (;;) {
        sum = 0u; cnt = 0u; mine = 0u;
#pragma unroll
        for (unsigned j = 0; j < 16; ++j) { const unsigned c = xb_ld(&bar[XB_XCNT(j)]); sum += c; cnt += (c > 0u) ? 1u : 0u; mine = (j == x) ? c : mine; }
        if (sum == G) break;
        __builtin_amdgcn_s_sleep(1);
        if ((++sp & 255u) == 0u) { if (xb_ld(&bar[XB_TMO])) break; if (sp > XB_SPIN_CAP) { atomicAdd(&bar[XB_TMO], 1u); break; } }
    }
    nloc = mine > 0u ? mine : 1u; nx = cnt > 0u ? cnt : 1u;
}
__device__ __forceinline__ void xcd_barrier(const XcdBarrier& b) {
    asm volatile("s_waitcnt vmcnt(0)" ::: "memory");
    __syncthreads();
    if (threadIdx.x == 0) {
        unsigned* bar = b.bar;
        const unsigned bx_ = xb_xcc_id();
        __builtin_amdgcn_s_waitcnt(0);
        unsigned nloc = b.st[0], nx = b.st[1];
        if (nloc == 0u) { xcd_barrier_complete(bar, bx_, nloc, nx); b.st[0] = nloc; b.st[1] = nx; }
        const unsigned old = xb_add(&bar[XB_XSUB(bx_)], 1u);
        const unsigned gen = old / nloc;
        if (old + 1u == (gen + 1u) * nloc) {
            __builtin_amdgcn_fence(__ATOMIC_RELEASE, "agent");
            asm volatile("s_waitcnt vmcnt(0)" ::: "memory");
            const unsigned og = xb_add(&bar[XB_TOP], 1u);
            const unsigned tg = og / nx;
            if (og + 1u == (tg + 1u) * nx) xb_add(&bar[XB_TOPGEN], 1u);
            else XB_SPIN(xb_ld(&bar[XB_TOPGEN]) == tg, bar);
            __builtin_amdgcn_fence(__ATOMIC_ACQUIRE, "agent");
            xb_add(&bar[XB_XGEN(bx_)], 1u);
            asm volatile("s_waitcnt vmcnt(0)" ::: "memory");
        } else {
            XB_SPIN(xb_ld(&bar[XB_XGEN(bx_)]) == gen, bar);
            __builtin_amdgcn_fence(__ATOMIC_ACQUIRE, "agent");
            asm volatile("s_waitcnt vmcnt(0)" ::: "memory");
        }
    }
    __syncthreads();
}

struct Params {
    const float *x, *meta, *ln1_w, *w_in, *lbnd, *hnw, *a_re, *a_im, *b_re, *b_im, *c_re, *c_im, *s5d, *log_dt, *w_glu, *b_glu,
                *lq1, *lk1, *lq2, *lk2, *subln, *w_out, *ln2_w, *wrg, *brg, *wre, *bre, *w1, *w3, *w2, *fnw;
    float* out;
    unsigned* bar;
    int *cnt, *blk_e, *ridx, *rslot, *tokrow, *rowtok, *base, *elist;
    float *lbtab, *lam, *Z, *PA, *OA, *T, *OC, *rgate, *H1, *S, *SLOC, *DEC, *A16, *S5E, *S5X, *ZP;
    bf16_t *HN, *QKV, *YG, *MIX, *H, *Y, *WinT, *WoutT, *WgluT, *SPREV, *BtY, *BtE, *WRT, *DLT;
};
typedef const __attribute__((address_space(4))) Params* KP;
__device__ __forceinline__ KP kp_() { KP p = (KP)__builtin_amdgcn_kernarg_segment_ptr(); asm volatile("" : "+s"(p)); return p; }


namespace pg8 {
#define PG8_LAS __attribute__((address_space(3)))
typedef short bf16x8 __attribute__((ext_vector_type(8)));
typedef float f32x4 __attribute__((ext_vector_type(4)));
typedef unsigned u32x4 __attribute__((ext_vector_type(4)));
constexpr int BM = 256, BK = 64, HALF = 128, HTB = HALF * BK * 2, STAGE_BYTES = 8 * HTB, NXCD = 8, WGM = 8;
__host__ __device__ __forceinline__ int lds_byte(int r, int c) { const int st = (r >> 4) * 2 + (c >> 5), rr = r & 15, cc = c & 31, ob = rr * 64 + cc * 2; return st * 1024 + (ob ^ (((ob >> 9) & 1) << 5)); }
__host__ __device__ __forceinline__ void stage_rc(int b, int& R, int& C) { const int st = b / 1024, sb = b % 1024, swz = sb ^ (((sb >> 9) & 1) << 5); R = (st >> 1) * 16 + swz / 64; C = (st & 1) * 32 + (swz % 64) / 2; }
__host__ __device__ __forceinline__ int perm32(int rho) { const int n = rho >> 4, i = rho & 15; return 8 * (i >> 2) + 4 * n + (i & 3); }
struct Unit { int pm, pn, ko, nt; };
struct Gemm { const bf16_t* A; const bf16_t* Bt; int M, N, K, ld; };
struct StaticOrder {
    static constexpr bool PER_UNIT_K = false;
    int nM, nN, nwg, G, c, nt;
    __host__ __device__ void init(int M, int N, int G_, int c_, int nt_) { nM = M / BM; nN = N / BM; nwg = nM * nN; G = G_; c = c_; nt = nt_; }
    __host__ __device__ bool next(int i, Unit& u) const {
        const long L = (long)i * G + c; if (L >= nwg) return false;
        int wgid = (int)L; { const int q = nwg / NXCD, r = nwg % NXCD, xcd = wgid % NXCD, off = wgid / NXCD; wgid = (xcd < r ? xcd * (q + 1) : r * (q + 1) + (xcd - r) * q) + off; }
        const int nig = WGM * nN, gid = wgid / nig, fm = gid * WGM, gsz = (nM - fm) < WGM ? (nM - fm) : WGM;
        u.pm = fm + ((wgid % nig) % gsz); u.pn = (wgid % nig) / gsz; u.ko = 0; u.nt = nt; return true;
    }
    __device__ __forceinline__ void a_ready(const Unit&) const {}
    __device__ __forceinline__ void done(const Unit&) const {}
};
__device__ __forceinline__ unsigned cvt_pk_bf16(float lo, float hi) { unsigned r; asm volatile("v_cvt_pk_bf16_f32 %0, %1, %2" : "=v"(r) : "v"(lo), "v"(hi)); return r; }

template <class Epi, class Sched, bool ALIGN_EPI = false, bool SP2 = false>
__device__ __forceinline__ void gemm_phase(PG8_LAS unsigned char* lds, const Gemm g, const Sched& S, const Epi& E) {
    const int tid = tid_(), wid = __builtin_amdgcn_readfirstlane(tid >> 6), lane = tid & 63, wr = wid >> 2, wc = wid & 3, fr = lane & 15, fq = lane >> 4;
    const int K = g.ld;
    unsigned voffA[2], voffB[2];
#pragma unroll
    for (int i = 0; i < 2; ++i) { int R, C; stage_rc(tid * 16 + i * 8192, R, C); const int Rb = Epi::PERM ? ((R & ~31) + perm32(R & 31)) : R;
        voffA[i] = (unsigned)(R * K + C) * 2u; voffB[i] = (unsigned)(Rb * K + C) * 2u; }
    const size_t kstep = (size_t)(BK * 2);
    const size_t hstep = (size_t)HALF * K * 2;
    const size_t tstep = 2 * hstep;
    const unsigned ldsw = (unsigned)wid * 1024u;
    const int aoff = lds_byte(wr * 64 + fr, fq * 8), boff = lds_byte(wc * 32 + fr, fq * 8);
#define PG8_SA(b, h) (((b) * 2 + (h)) * HTB)
#define PG8_SB(b, h) ((4 + (b) * 2 + (h)) * HTB)
#define PG8_STAGE(bufoff, gbase, voff) do { _Pragma("unroll") for (int _i = 0; _i < 2; ++_i) \
        __builtin_amdgcn_global_load_lds((const unsigned*)((const char*)(gbase) + (voff)[_i]), (PG8_LAS unsigned*)(lds + (bufoff) + ldsw + _i * 8192), 16, 0, 0); } while (0)
#define PG8_LDA(dst, b, h) do { _Pragma("unroll") for (int m = 0; m < 4; ++m) _Pragma("unroll") for (int k = 0; k < 2; ++k) dst[m][k] = *(const PG8_LAS bf16x8*)(lds + PG8_SA(b, h) + aoff + m * 2048 + k * 1024); } while (0)
#define PG8_LDB(dst, b, h) do { _Pragma("unroll") for (int n = 0; n < 2; ++n) _Pragma("unroll") for (int k = 0; k < 2; ++k) dst[n][k] = *(const PG8_LAS bf16x8*)(lds + PG8_SB(b, h) + boff + n * 2048 + k * 1024); } while (0)
#define PG8_MMA(ai, bj, At, Bt) do { __builtin_amdgcn_s_setprio(1); _Pragma("unroll") for (int m = 0; m < 4; ++m) _Pragma("unroll") for (int n = 0; n < 2; ++n) _Pragma("unroll") for (int k = 0; k < 2; ++k) \
        acc[ai][bj][m][n] = __builtin_amdgcn_mfma_f32_16x16x32_bf16(Bt[n][k], At[m][k], acc[ai][bj][m][n], 0, 0, 0); __builtin_amdgcn_s_setprio(0); } while (0)
#define PG8_WAIT_V(n) asm volatile("s_waitcnt vmcnt(" #n ")" ::: "memory")
#define PG8_WAIT_L(n) asm volatile("s_waitcnt lgkmcnt(" #n ")" ::: "memory")
#define PG8_BAR __builtin_amdgcn_s_barrier()
#define PG8_SCHED __builtin_amdgcn_sched_barrier(0)
    Unit cur, nxt; int ui = 0;
    if (!S.next(0, cur)) return;
    f32x4 acc[2][2][4][2];
#pragma unroll
    for (int a = 0; a < 2; ++a)
#pragma unroll
        for (int b = 0; b < 2; ++b)
#pragma unroll
            for (int m = 0; m < 4; ++m)
#pragma unroll
                for (int n = 0; n < 2; ++n) acc[a][b][m][n] = (f32x4){0.f, 0.f, 0.f, 0.f};
    bf16x8 At[4][2], B0[2][2], B1[2][2];
    const char* cA = (const char*)g.A + (size_t)cur.pm * tstep + (size_t)cur.ko * 2; const char* cB = (const char*)g.Bt + (size_t)cur.pn * tstep + (size_t)cur.ko * 2;
    S.a_ready(cur);
    if constexpr (SP2) {
        PG8_STAGE(PG8_SB(0, 0), cB, voffB); PG8_STAGE(PG8_SB(0, 1), cB + hstep, voffB); PG8_STAGE(PG8_SA(0, 0), cA, voffA); PG8_STAGE(PG8_SA(0, 1), cA + hstep, voffA);
        if (wr == 1) PG8_BAR;
        PG8_WAIT_V(2); PG8_BAR;
        PG8_STAGE(PG8_SB(1, 0), cB + kstep, voffB); PG8_STAGE(PG8_SA(1, 0), cA + kstep, voffA); PG8_STAGE(PG8_SB(1, 1), cB + hstep + kstep, voffB);
        PG8_WAIT_V(6); PG8_BAR;
    } else {
        PG8_STAGE(PG8_SB(0, 0), cB, voffB); PG8_STAGE(PG8_SA(0, 0), cA, voffA); PG8_STAGE(PG8_SB(0, 1), cB + hstep, voffB); PG8_STAGE(PG8_SA(0, 1), cA + hstep, voffA);
        if (wr == 1) PG8_BAR;
        PG8_WAIT_V(4); PG8_BAR;
        PG8_STAGE(PG8_SB(1, 0), cB + kstep, voffB); PG8_STAGE(PG8_SA(1, 0), cA + kstep, voffA); PG8_STAGE(PG8_SB(1, 1), cB + hstep + kstep, voffB);
        PG8_WAIT_V(6); PG8_BAR;
    }
    for (;;) {
        const bool has_next = S.next(ui + 1, nxt);
        const char* nA = has_next ? (const char*)g.A + (size_t)nxt.pm * tstep + (size_t)nxt.ko * 2 : cA; const char* nB = has_next ? (const char*)g.Bt + (size_t)nxt.pn * tstep + (size_t)nxt.ko * 2 : cB;
        const int nt = Sched::PER_UNIT_K ? cur.nt : g.K / BK;
        for (int t = 0; t < nt; t += 2) {
            const bool last = (t == nt - 2);
            const char* a1 = cA + (size_t)(t + 1) * kstep;
            const char* a2 = last ? nA : cA + (size_t)(t + 2) * kstep; const char* b2 = last ? nB : cB + (size_t)(t + 2) * kstep;
            const char* a3 = a2 + kstep; const char* b3 = b2 + kstep;
            if (last && has_next) S.a_ready(nxt);
            if constexpr (SP2) {
            PG8_LDB(B0, 0, 0); PG8_LDB(B1, 0, 1); PG8_SCHED; PG8_LDA(At, 0, 0); PG8_STAGE(PG8_SA(1, 1), a1 + hstep, voffA);
            PG8_WAIT_V(8); PG8_WAIT_L(0); PG8_BAR; PG8_MMA(0, 0, At, B0); PG8_MMA(0, 1, At, B1); PG8_BAR; PG8_SCHED;
            PG8_LDA(At, 0, 1); PG8_STAGE(PG8_SB(0, 0), b2, voffB); PG8_STAGE(PG8_SB(0, 1), b2 + hstep, voffB); PG8_STAGE(PG8_SA(0, 0), a2, voffA);
            PG8_WAIT_V(8); PG8_WAIT_L(0); PG8_BAR; PG8_MMA(1, 0, At, B0); PG8_MMA(1, 1, At, B1); PG8_BAR; PG8_SCHED;
            PG8_LDB(B0, 1, 0); PG8_LDB(B1, 1, 1); PG8_SCHED; PG8_LDA(At, 1, 0); PG8_STAGE(PG8_SA(0, 1), a2 + hstep, voffA);
            PG8_WAIT_V(8); PG8_WAIT_L(0); PG8_BAR; PG8_MMA(0, 0, At, B0); PG8_MMA(0, 1, At, B1); PG8_BAR; PG8_SCHED;
            PG8_LDA(At, 1, 1); PG8_STAGE(PG8_SB(1, 0), b3, voffB); PG8_STAGE(PG8_SB(1, 1), b3 + hstep, voffB); PG8_STAGE(PG8_SA(1, 0), a3, voffA);
            PG8_WAIT_V(8); PG8_WAIT_L(0); PG8_BAR; PG8_MMA(1, 0, At, B0); PG8_MMA(1, 1, At, B1); PG8_BAR; PG8_SCHED;
            } else {
            PG8_LDB(B0, 0, 0); PG8_SCHED; PG8_LDA(At, 0, 0); PG8_STAGE(PG8_SA(1, 1), a1 + hstep, voffA);
            PG8_WAIT_L(8); PG8_BAR; PG8_WAIT_L(0); PG8_MMA(0, 0, At, B0); PG8_BAR; PG8_SCHED;
            PG8_LDB(B1, 0, 1); PG8_STAGE(PG8_SB(0, 0), b2, voffB);
            PG8_BAR; PG8_WAIT_L(0); PG8_MMA(0, 1, At, B1); PG8_BAR;
            PG8_LDA(At, 0, 1); PG8_STAGE(PG8_SA(0, 0), a2, voffA);
            PG8_BAR; PG8_WAIT_L(0); PG8_MMA(1, 0, At, B0); PG8_BAR; PG8_SCHED;
            PG8_STAGE(PG8_SB(0, 1), b2 + hstep, voffB);
            PG8_WAIT_V(6); PG8_BAR; PG8_MMA(1, 1, At, B1); PG8_BAR;
            PG8_LDB(B0, 1, 0); PG8_SCHED; PG8_LDA(At, 1, 0); PG8_STAGE(PG8_SA(0, 1), a2 + hstep, voffA);
            PG8_WAIT_L(8); PG8_BAR; PG8_WAIT_L(0); PG8_MMA(0, 0, At, B0); PG8_BAR; PG8_SCHED;
            PG8_LDB(B1, 1, 1); PG8_STAGE(PG8_SB(1, 0), b3, voffB);
            PG8_BAR; PG8_WAIT_L(0); PG8_MMA(0, 1, At, B1); PG8_BAR;
            PG8_LDA(At, 1, 1); PG8_STAGE(PG8_SA(1, 0), a3, voffA);
            PG8_BAR; PG8_WAIT_L(0); PG8_MMA(1, 0, At, B0); PG8_BAR; PG8_SCHED;
            PG8_STAGE(PG8_SB(1, 1), b3 + hstep, voffB);
            PG8_WAIT_V(6); PG8_BAR; PG8_MMA(1, 1, At, B1); PG8_BAR;
            }
        }
        if constexpr (ALIGN_EPI) { if (wr == 0) PG8_BAR; }
        E(acc, cur, wr, wc, fr, fq);
        if (!has_next) break;
#pragma unroll
        for (int a = 0; a < 2; ++a)
#pragma unroll
            for (int b = 0; b < 2; ++b)
#pragma unroll
                for (int m = 0; m < 4; ++m)
#pragma unroll
                    for (int n = 0; n < 2; ++n) acc[a][b][m][n] = (f32x4){0.f, 0.f, 0.f, 0.f};
        cur = nxt; cA = nA; cB = nB; ++ui;
        if constexpr (ALIGN_EPI) { if (wr == 1) PG8_BAR; }
    }
    PG8_WAIT_V(0);
    if constexpr (!ALIGN_EPI) { if (wr == 0) PG8_BAR; }
    PG8_BAR;
#undef PG8_SA
#undef PG8_SB
#undef PG8_STAGE
#undef PG8_LDA
#undef PG8_LDB
#undef PG8_MMA
#undef PG8_WAIT_V
#undef PG8_WAIT_L
#undef PG8_BAR
#undef PG8_SCHED
}
struct EpiInProj {
    static constexpr bool PERM = true;
    float* PA; bf16_t* QKV;
    __device__ __forceinline__ void operator()(const f32x4 (&acc)[2][2][4][2], const Unit& u, int wr, int wc, int fr, int fq) const {
        const int row0 = u.pm * BM + wr * 64 + fr, colt = u.pn * BM + wc * 32 + 8 * fq;
        if (colt < PAW) {
#pragma unroll
            for (int ai = 0; ai < 2; ++ai)
#pragma unroll
                for (int m = 0; m < 4; ++m) { float* rp = PA + (size_t)(row0 + ai * HALF + m * 16) * PAW + colt;
#pragma unroll
                    for (int bj = 0; bj < 2; ++bj) { *(f32x4*)(rp + bj * HALF) = acc[ai][bj][m][0]; *(f32x4*)(rp + bj * HALF + 4) = acc[ai][bj][m][1]; } }
        } else {
#pragma unroll
            for (int ai = 0; ai < 2; ++ai)
#pragma unroll
                for (int m = 0; m < 4; ++m) { bf16_t* rp = QKV + (size_t)(row0 + ai * HALF + m * 16) * QKVW + (colt - PAW);
#pragma unroll
                    for (int bj = 0; bj < 2; ++bj) { const f32x4 v0 = acc[ai][bj][m][0], v1 = acc[ai][bj][m][1];
                        u32x4 w; w.x = cvt_pk_bf16(v0[0], v0[1]); w.y = cvt_pk_bf16(v0[2], v0[3]); w.z = cvt_pk_bf16(v1[0], v1[1]); w.w = cvt_pk_bf16(v1[2], v1[3]);
                        *(u32x4*)(rp + bj * HALF) = w; } }
        }
    }
};
struct EpiResidual {
    static constexpr bool PERM = true;
    bf16_t* D;
    __device__ __forceinline__ void operator()(const f32x4 (&acc)[2][2][4][2], const Unit& u, int wr, int wc, int fr, int fq) const {
        const int row0 = u.pm * BM + wr * 64 + fr, colt = u.pn * BM + wc * 32 + 8 * fq;
#pragma unroll
        for (int ai = 0; ai < 2; ++ai)
#pragma unroll
            for (int m = 0; m < 4; ++m) { const int row = row0 + ai * HALF + m * 16; if (row < TOK) { bf16_t* rp = D + (size_t)row * DM + colt;
#pragma unroll
                for (int bj = 0; bj < 2; ++bj) { const f32x4 v0 = acc[ai][bj][m][0], v1 = acc[ai][bj][m][1];
                    u32x4 w; w.x = cvt_pk_bf16(v0[0], v0[1]); w.y = cvt_pk_bf16(v0[2], v0[3]); w.z = cvt_pk_bf16(v1[0], v1[1]); w.w = cvt_pk_bf16(v1[2], v1[3]);
                    *(u32x4*)(rp + bj * HALF) = w; } } }
    }
};
struct OutOrder {
    static constexpr bool PER_UNIT_K = true;
    StaticOrder main;
    __device__ bool next(int i, Unit& u) const {
        if (main.next(i, u)) return true;
        const int r0 = (main.nwg + main.G - 1) / main.G;
        const int L = (i - r0) * main.G + main.c; if (i < r0 || L >= 64) return false;
        u.pm = 32; u.pn = L & 7; u.ko = (L >> 3) * 256; u.nt = 4; return true; }
    __device__ __forceinline__ void a_ready(const Unit&) const {}
    __device__ __forceinline__ void done(const Unit&) const {}
};
struct EpiOutProj {
    static constexpr bool PERM = true;
    float* Z; float* ZP;
    __device__ __forceinline__ void operator()(const f32x4 (&acc)[2][2][4][2], const Unit& u, int wr, int wc, int fr, int fq) const {
        const bool tail = u.pm == 32;
        const int row0 = (tail ? (u.ko >> 8) * BM : u.pm * BM) + wr * 64 + fr, colt = u.pn * BM + wc * 32 + 8 * fq;
        float* base = tail ? ZP : Z;
#pragma unroll
        for (int ai = 0; ai < 2; ++ai)
#pragma unroll
            for (int m = 0; m < 4; ++m) { float* rp = base + (size_t)(row0 + ai * HALF + m * 16) * DM + colt;
#pragma unroll
                for (int bj = 0; bj < 2; ++bj) { f32x4* p0 = (f32x4*)(rp + bj * HALF); f32x4* p1 = (f32x4*)(rp + bj * HALF + 4);
                    f32x4 z0 = {0.f, 0.f, 0.f, 0.f}, z1 = {0.f, 0.f, 0.f, 0.f};
                    if (!tail) { z0 = *p0; z1 = *p1; }
                    *p0 = z0 + acc[ai][bj][m][0]; *p1 = z1 + acc[ai][bj][m][1]; } }
    }
};
struct TailOrder {
    static constexpr bool PER_UNIT_K = false;
    int G, c;
    __device__ bool next(int i, Unit& u) const { const int L = i * G + c; if (L >= 64) return false; u.pm = 32; u.pn = L & 7; u.ko = (L >> 3) * 256; u.nt = 4; return true; }
    __device__ __forceinline__ void a_ready(const Unit&) const {}
    __device__ __forceinline__ void done(const Unit&) const {}
};
struct EpiTailPartial {
    static constexpr bool PERM = true;
    float* ZP;
    __device__ __forceinline__ void operator()(const f32x4 (&acc)[2][2][4][2], const Unit& u, int wr, int wc, int fr, int fq) const {
        const int row0 = (u.ko >> 8) * BM + wr * 64 + fr, colt = u.pn * BM + wc * 32 + 8 * fq;
#pragma unroll
        for (int ai = 0; ai < 2; ++ai)
#pragma unroll
            for (int m = 0; m < 4; ++m) { float* rp = ZP + (size_t)(row0 + ai * HALF + m * 16) * DM + colt;
#pragma unroll
                for (int bj = 0; bj < 2; ++bj) { *(f32x4*)(rp + bj * HALF) = acc[ai][bj][m][0]; *(f32x4*)(rp + bj * HALF + 4) = acc[ai][bj][m][1]; } }
    }
};
struct EpiGlu {
    static constexpr bool PERM = true;
    bf16_t* MIX; const float* bias;
    __device__ __forceinline__ void operator()(const f32x4 (&acc)[2][2][4][2], const Unit& u, int wr, int wc, int fr, int fq) const {
        const int row0 = u.pm * BM + wr * 64 + fr, c0 = u.pn * HALF + wc * 32 + 8 * fq;
        const f32x4 bv0 = *(const f32x4*)(bias + c0), bv1 = *(const f32x4*)(bias + c0 + 4), bg0 = *(const f32x4*)(bias + 512 + c0), bg1 = *(const f32x4*)(bias + 512 + c0 + 4);
        float one = 1.f; asm volatile("" : "+v"(one));
#pragma unroll
        for (int ai = 0; ai < 2; ++ai)
#pragma unroll
            for (int m = 0; m < 4; ++m) { const f32x4 v0 = acc[ai][0][m][0] + bv0, v1 = acc[ai][0][m][1] + bv1, g0 = acc[ai][1][m][0] + bg0, g1 = acc[ai][1][m][1] + bg1;
                float o[8];
#pragma unroll
                for (int e = 0; e < 4; ++e) { o[e] = v0[e] * __builtin_amdgcn_rcpf(one + __expf(-g0[e])); o[4 + e] = v1[e] * __builtin_amdgcn_rcpf(one + __expf(-g1[e])); }
                u32x4 w; w.x = cvt_pk_bf16(o[0], o[1]); w.y = cvt_pk_bf16(o[2], o[3]); w.z = cvt_pk_bf16(o[4], o[5]); w.w = cvt_pk_bf16(o[6], o[7]);
                *(u32x4*)(MIX + (size_t)(row0 + ai * HALF + m * 16) * DM + 512 + c0) = w; }
    }
};
}

__device__ __forceinline__ void transpose_item(const float* W, int K, int N, bf16_t* WT, int k0, int n0, int row0, float* scr, int lane) {
    float tv[32];
#pragma unroll
    for (int i = 0; i < 32; ++i) { const int kk = 2 * i + (lane >> 5); tv[i] = W[(size_t)(k0 + kk) * N + n0 + (lane & 31)]; }
#pragma unroll
    for (int i = 0; i < 32; ++i) { const int kk = 2 * i + (lane >> 5); scr[kk * 33 + (lane & 31)] = tv[i]; }
    asm volatile("s_waitcnt lgkmcnt(0)" ::: "memory");
    const int c = lane & 7;
#pragma unroll
    for (int j = 0; j < 4; ++j) { const int n = (lane >> 3) + 8 * j; const float* sp = scr + (8 * c) * 33 + n;
        pg8::u32x4 o; o.x = pg8::cvt_pk_bf16(sp[0 * 33], sp[1 * 33]); o.y = pg8::cvt_pk_bf16(sp[2 * 33], sp[3 * 33]); o.z = pg8::cvt_pk_bf16(sp[4 * 33], sp[5 * 33]); o.w = pg8::cvt_pk_bf16(sp[6 * 33], sp[7 * 33]);
        *(pg8::u32x4*)(WT + (size_t)(row0 + n) * K + k0 + 8 * c) = o; }
    asm volatile("s_waitcnt lgkmcnt(0)" ::: "memory");
}
__device__ __forceinline__ void ph_weights(KP P, char* lds) {
    const int tid = tid_(), lane = tid & 63, wave = tid >> 6;
    float* scr = (float*)lds + wave * (64 * 33);
    const int cu0 = gridDim.x == 256 ? 64 : 0, gw = (bid_() - cu0) * 8 + wave, NGW = (gridDim.x - cu0) * 8;
    if (gw < 0) return;
    constexpr int I_IN = (DM / 64) * (INW / 32), I_OUT = (DM / 64) * (DM / 32), I_GLU = (512 / 64) * (1024 / 32), I_L = I_IN + I_OUT + I_GLU;
    for (int it = gw; it < 2 * I_L; it += NGW) {
        const int layer = it / I_L; int r = it % I_L;
        if (r < I_IN) { const int nb = INW / 32, kb = r / nb, n0 = (r % nb) * 32;
            transpose_item(P->w_in + (size_t)layer * DM * INW, DM, INW, P->WinT + (size_t)layer * INW * DM, kb * 64, n0, n0, scr, lane); continue; }
        r -= I_IN;
        if (r < I_OUT) { const int nb = DM / 32, kb = r / nb, n0 = (r % nb) * 32;
            transpose_item(P->w_out + (size_t)layer * DM * DM, DM, DM, P->WoutT + (size_t)layer * DM * DM, kb * 64, n0, n0, scr, lane); continue; }
        r -= I_OUT;
        { const int nb = 1024 / 32, kb = r / nb, n0 = (r % nb) * 32;
          const int row0 = ((n0 & 511) >> 7) * 256 + (n0 >> 9) * 128 + (n0 & 127);
          transpose_item(P->w_glu + (size_t)layer * 512 * 1024, 512, 1024, P->WgluT + (size_t)layer * 1024 * 512, kb * 64, n0, row0, scr, lane); }
    }
}


namespace fa {
using bf16x8 = __attribute__((ext_vector_type(8))) short;
using s16x4  = __attribute__((ext_vector_type(4))) short;
using f32x16 = __attribute__((ext_vector_type(16))) float;
using u32x4  = __attribute__((ext_vector_type(4))) unsigned;
constexpr int D = 128, NW = 8, QBLK = 32, KVBLK = 64, LDQK = QKVW;
constexpr float SCALE = 0.088388347648318440f, THR = 8.f, NEG = -1e30f;
constexpr size_t SHM_V = KVBLK * D * 2, SHM_K = KVBLK * D * 2, SHM_ATTN = 2 * SHM_V + 2 * SHM_K + NW * 64 * 4;
#define KSWZ(row, colB) ((row) * 256 + ((colB) ^ (((row) & 7) << 4)))
#define SBAR() __builtin_amdgcn_sched_barrier(0)
__device__ __forceinline__ int crow(int r, int hi) { return (r & 3) + 8 * (r >> 2) + 4 * hi; }
__device__ __forceinline__ unsigned cvtpk(float lo, float hi) { unsigned r; asm volatile("v_cvt_pk_bf16_f32 %0, %1, %2" : "=v"(r) : "v"(lo), "v"(hi)); return r; }
__device__ __forceinline__ void partialSM(f32x16& p0, f32x16& p1, float& m_reg, float& mn, float& alpha) {
  constexpr float C = SCALE * 1.4426950408889634f;
  float pmax = p0[0]; for (int r = 1; r < 16; ++r) pmax = fmaxf(pmax, p0[r]); for (int r = 0; r < 16; ++r) pmax = fmaxf(pmax, p1[r]);
  { auto rr = __builtin_amdgcn_permlane32_swap(__float_as_uint(pmax), __float_as_uint(pmax), false, false);
    pmax = fmaxf(__uint_as_float(rr[0]), __uint_as_float(rr[1])); }
  if (__builtin_expect(__all(pmax - m_reg <= THR / SCALE), 1)) { mn = m_reg; alpha = 1.f; }
  else { mn = fmaxf(m_reg, pmax); alpha = __builtin_amdgcn_exp2f((m_reg - mn) * C); m_reg = mn; }
  float mnC = -mn * C;
  for (int r = 0; r < 16; ++r) p0[r] = fmaf(p0[r], C, mnC); for (int r = 0; r < 16; ++r) p1[r] = fmaf(p1[r], C, mnC);
  for (int r = 0; r < 16; ++r) p0[r] = __builtin_amdgcn_exp2f(p0[r]);
}
__device__ __forceinline__ void finishSM(f32x16& p0, f32x16& p1, float alpha, float& l_reg, bf16x8& pa0, bf16x8& pa1, bf16x8& pa2, bf16x8& pa3) {
  for (int r = 0; r < 16; ++r) p1[r] = __builtin_amdgcn_exp2f(p1[r]);
  float ps = 0; for (int r = 0; r < 16; ++r) ps += p0[r]; for (int r = 0; r < 16; ++r) ps += p1[r];
  { auto rr = __builtin_amdgcn_permlane32_swap(__float_as_uint(ps), __float_as_uint(ps), false, false);
    ps = __uint_as_float(rr[0]) + __uint_as_float(rr[1]); }
  l_reg = l_reg * alpha + ps;
#define PK4(P, BASE, OUT) do { unsigned a0 = cvtpk(P[BASE + 0], P[BASE + 1]), a1 = cvtpk(P[BASE + 2], P[BASE + 3]);   \
    unsigned b0 = cvtpk(P[BASE + 4], P[BASE + 5]), b1 = cvtpk(P[BASE + 6], P[BASE + 7]);                              \
    auto r0 = __builtin_amdgcn_permlane32_swap(a0, b0, false, false); auto r1 = __builtin_amdgcn_permlane32_swap(a1, b1, false, false); \
    u32x4 w = {r0[0], r1[0], r0[1], r1[1]}; OUT = *reinterpret_cast<bf16x8*>(&w); } while (0)
  PK4(p0, 0, pa0); PK4(p0, 8, pa1); PK4(p1, 0, pa2); PK4(p1, 8, pa3);
#undef PK4
}
__device__ __forceinline__ void qkt(f32x16& p0, f32x16& p1, const bf16_t* Ks, const bf16x8* qr, int r32, int hi) {
  p0 = f32x16{}; p1 = f32x16{};
  for (int d0 = 0; d0 < 8; ++d0) { int cb = (d0 * 16 + hi * 8) * 2;
    bf16x8 b0 = *reinterpret_cast<const bf16x8*>((const char*)Ks + KSWZ(r32, cb));
    bf16x8 b1 = *reinterpret_cast<const bf16x8*>((const char*)Ks + KSWZ(32 + r32, cb));
    p0 = __builtin_amdgcn_mfma_f32_32x32x16_bf16(b0, qr[d0], p0, 0, 0, 0);
    p1 = __builtin_amdgcn_mfma_f32_32x32x16_bf16(b1, qr[d0], p1, 0, 0, 0); }
}
__device__ __forceinline__ void mask_tile(f32x16& p0, f32x16& p1, int kt, int vis) {
  if (kt > vis) {
    const bool part = (kt == vis + 1);
    for (int r = 0; r < 16; ++r) p1[r] = NEG;
    for (int r = 8; r < 16; ++r) p0[r] = NEG;
    if (!part) for (int r = 0; r < 8; ++r) p0[r] = NEG;
  }
}
__device__ __forceinline__ int v_st(int k, int c) { const int kk = (k & ~0xC) | ((k & 4) << 1) | ((k & 8) >> 1); return ((kk >> 3) * 4 + (c >> 5)) * 512 + ((kk & 7) * 32 + (c & 31)) * 2; }
__device__ __forceinline__ int v_rd_base(int lane) { return ((lane & 3) << 3) | (((lane >> 2) & 3) << 6) | (((lane >> 4) & 1) << 5) | (((lane >> 5) & 1) << 8); }
constexpr int v_rd_off(int d0, int ks, int half) { return d0 * 512 + ks * 4096 + half * 2048; }
template <int OFF> __device__ __forceinline__ s16x4 tr_read(int vb) {
  s16x4 r; asm volatile("ds_read_b64_tr_b16 %0, %1 offset:%2" : "=&v"(r) : "v"(vb), "i"(OFF) : "memory"); return r;
}
template <int D0> __device__ __forceinline__ void pv_one(f32x16& od, int vb, bf16x8 pa0, bf16x8 pa1, bf16x8 pa2, bf16x8 pa3) {
  const s16x4 l0 = tr_read<v_rd_off(D0, 0, 0)>(vb), h0 = tr_read<v_rd_off(D0, 0, 1)>(vb), l1 = tr_read<v_rd_off(D0, 1, 0)>(vb), h1 = tr_read<v_rd_off(D0, 1, 1)>(vb);
  const s16x4 l2 = tr_read<v_rd_off(D0, 2, 0)>(vb), h2 = tr_read<v_rd_off(D0, 2, 1)>(vb), l3 = tr_read<v_rd_off(D0, 3, 0)>(vb), h3 = tr_read<v_rd_off(D0, 3, 1)>(vb);
  asm volatile("s_waitcnt lgkmcnt(0)" ::: "memory"); SBAR();
#define PK(L, H) (bf16x8){L[0], L[1], L[2], L[3], H[0], H[1], H[2], H[3]}
  od = __builtin_amdgcn_mfma_f32_32x32x16_bf16(pa0, PK(l0, h0), od, 0, 0, 0);
  od = __builtin_amdgcn_mfma_f32_32x32x16_bf16(pa1, PK(l1, h1), od, 0, 0, 0);
  od = __builtin_amdgcn_mfma_f32_32x32x16_bf16(pa2, PK(l2, h2), od, 0, 0, 0);
  od = __builtin_amdgcn_mfma_f32_32x32x16_bf16(pa3, PK(l3, h3), od, 0, 0, 0);
#undef PK
}
__device__ __forceinline__ void pv_d0(f32x16* o, int vb, bf16x8 pa0, bf16x8 pa1, bf16x8 pa2, bf16x8 pa3) {
  pv_one<0>(o[0], vb, pa0, pa1, pa2, pa3); pv_one<1>(o[1], vb, pa0, pa1, pa2, pa3); pv_one<2>(o[2], vb, pa0, pa1, pa2, pa3); pv_one<3>(o[3], vb, pa0, pa1, pa2, pa3);
}
__device__ __forceinline__ void attn_unit(const bf16_t* __restrict__ Qb, const bf16_t* __restrict__ Kh, const bf16_t* __restrict__ Vh, float* __restrict__ Ob, int NT, int vis4, char* lds) {
  const int tid = tid_(), wid = tid >> 6, lane = tid & 63, r32 = lane & 31, hi = lane >> 5;
  const int vis = vis4 + (wid >> 1);
  bf16_t* V_lds = (bf16_t*)lds; bf16_t* K_lds = (bf16_t*)(lds + 2 * SHM_V);
  float* ws = (float*)(lds + 2 * SHM_V + 2 * SHM_K) + wid * 64; float* li_l = ws; float* al_l = ws + 32;
  float m_reg = NEG, l_reg = 0; f32x16 o[4] = {}; bf16x8 qr[8];
  const bf16_t* Qw = Qb + (long)(wid * QBLK + r32) * LDQK + hi * 8;
#pragma unroll
  for (int d0 = 0; d0 < 8; ++d0) qr[d0] = *reinterpret_cast<const bf16x8*>(Qw + d0 * 16);
  const int sr = tid >> 4, sc = (tid & 15) * 8, vst0 = v_st(sr, sc), vst1 = v_st(32 + sr, sc);
  const int vb0 = (int)(uintptr_t)V_lds + v_rd_base(lane);
  struct { bf16x8 vs0, vs1, ks0, ks1; } sr_[2];
#define SLOAD(i, k0) do { sr_[i].vs0 = *reinterpret_cast<const bf16x8*>(&Vh[(long)((k0) + sr) * LDQK + sc]); sr_[i].vs1 = *reinterpret_cast<const bf16x8*>(&Vh[(long)((k0) + 32 + sr) * LDQK + sc]); \
    sr_[i].ks0 = *reinterpret_cast<const bf16x8*>(&Kh[(long)((k0) + sr) * LDQK + sc]); sr_[i].ks1 = *reinterpret_cast<const bf16x8*>(&Kh[(long)((k0) + 32 + sr) * LDQK + sc]); } while (0)
#define SWRITE(b, i) do { *(bf16x8*)((char*)V_lds + (b) * SHM_V + vst0) = sr_[i].vs0;          \
    *(bf16x8*)((char*)V_lds + (b) * SHM_V + vst1) = sr_[i].vs1; int kc = sc * 2;               \
    *(bf16x8*)((char*)K_lds + (b) * SHM_K + KSWZ(sr, kc)) = sr_[i].ks0;                       \
    *(bf16x8*)((char*)K_lds + (b) * SHM_K + KSWZ(32 + sr, kc)) = sr_[i].ks1; } while (0)
#define SWAIT() asm volatile("s_waitcnt vmcnt(4)" ::: "memory")
#define RESC(a) do { if (__any((a) < 1.f)) { if (hi == 0) al_l[r32] = (a); asm volatile("s_waitcnt lgkmcnt(0)" ::: "memory"); \
    for (int d = 0; d < 4; ++d) for (int r = 0; r < 16; ++r) o[d][r] *= al_l[crow(r, hi)]; } } while (0)
  f32x16 pA0, pA1, pB0, pB1; float mnA, mnB, alA, alB; bf16x8 pa0, pa1, pa2, pa3;
  constexpr int SE = 0, SO = 1;
  SLOAD(SE, 0); asm volatile("s_waitcnt vmcnt(0)" ::: "memory"); SWRITE(0, SE); __syncthreads();
  qkt(pA0, pA1, K_lds, qr, r32, hi); mask_tile(pA0, pA1, 0, vis); partialSM(pA0, pA1, m_reg, mnA, alA);
  SLOAD(SO, KVBLK); if (2 < NT) SLOAD(SE, 2 * KVBLK);
  SWAIT(); SWRITE(1, SO); __syncthreads();
  for (int j = 1; j + 1 < NT; j += 2) {
    SBAR(); qkt(pB0, pB1, (bf16_t*)((char*)K_lds + SHM_K), qr, r32, hi); mask_tile(pB0, pB1, j, vis);
    finishSM(pA0, pA1, alA, l_reg, pa0, pa1, pa2, pa3); SBAR();
    SLOAD(SO, (j + 2) * KVBLK); SBAR();
    pv_d0(o, vb0, pa0, pa1, pa2, pa3); partialSM(pB0, pB1, m_reg, mnB, alB);
    __syncthreads(); SWAIT(); SWRITE(0, SE);
    RESC(alB); __syncthreads();
    SBAR(); qkt(pA0, pA1, K_lds, qr, r32, hi); mask_tile(pA0, pA1, j + 1, vis);
    finishSM(pB0, pB1, alB, l_reg, pa0, pa1, pa2, pa3); SBAR();
    if (j + 3 < NT) SLOAD(SE, (j + 3) * KVBLK); SBAR();
    pv_d0(o, vb0 + (int)SHM_V, pa0, pa1, pa2, pa3); partialSM(pA0, pA1, m_reg, mnA, alA);
    __syncthreads(); SWAIT(); SWRITE(1, SO);
    RESC(alA); __syncthreads();
  }
  SBAR(); qkt(pB0, pB1, (bf16_t*)((char*)K_lds + SHM_K), qr, r32, hi); mask_tile(pB0, pB1, NT - 1, vis);
  finishSM(pA0, pA1, alA, l_reg, pa0, pa1, pa2, pa3); SBAR();
  pv_d0(o, vb0, pa0, pa1, pa2, pa3); partialSM(pB0, pB1, m_reg, mnB, alB);
  __syncthreads(); RESC(alB);
  finishSM(pB0, pB1, alB, l_reg, pa0, pa1, pa2, pa3); SBAR();
  pv_d0(o, vb0 + (int)SHM_V, pa0, pa1, pa2, pa3);
  if (hi == 0) li_l[r32] = l_reg; asm volatile("s_waitcnt lgkmcnt(0)" ::: "memory");
  float rli[16];
#pragma unroll
  for (int r = 0; r < 16; ++r) rli[r] = __builtin_amdgcn_rcpf(li_l[crow(r, hi)]);
  float* Ow = Ob + (long)(wid * QBLK) * DM;
#pragma unroll
  for (int r = 0; r < 16; ++r) { int orow = crow(r, hi);
    for (int d0 = 0; d0 < 4; ++d0) Ow[(long)orow * DM + d0 * 32 + r32] = o[d0][r] * rli[r]; }
  __syncthreads();
#undef SLOAD
#undef SWRITE
#undef SWAIT
#undef RESC
}
#undef KSWZ
#undef SBAR
}

__device__ __forceinline__ void ph_attention(KP P, char* lds) {
    const bf16_t* QKV = P->QKV; float* OC = P->OC;
#pragma unroll 1
    for (int c = bid_(); c < 256; c += gridDim.x) {
        const int combo = c >> 2, b = combo >> 4, h = (combo >> 2) & 3, i = (combo >> 1) & 1, vh = combo & 1;
        const bf16_t* Kh = QKV + (size_t)(b * LL) * QKVW + 1024 + h * 256 + i * 128;
        const bf16_t* Vh = QKV + (size_t)(b * LL) * QKVW + 2048 + h * 256 + vh * 128;
#pragma unroll 1
        for (int s = 0; s < 2; ++s) {
            const int jb = s == 0 ? (c & 3) : 7 - (c & 3);
            const size_t row0 = (size_t)(b * LL) + NMETA + 256 * jb;
            fa::attn_unit(QKV + row0 * QKVW + h * 256 + i * 128, Kh, Vh, OC + row0 * DM + h * 512 + i * 256 + vh * 128, 4 * jb + 6, 4 * jb, lds);
        }
    }
#pragma unroll 1
    for (int gw0 = bid_() * 8; gw0 < 512; gw0 += gridDim.x * 8) {
        const int tid = tid_(), lane = tid & 63, gw = gw0 + (tid >> 6);
        if (gw < 512) {
            const int b = gw >> 7, h = (gw >> 5) & 3, i = (gw >> 4) & 1, row = gw & 15;
            const bf16_t* q = QKV + (size_t)(b * LL + row) * QKVW + h * 256 + i * 128;
            const int key = lane & 15;
            const bf16_t* k = QKV + (size_t)(b * LL + key) * QKVW + 1024 + h * 256 + i * 128;
            float sc = 0.f;
            { pg8::u32x4 qv[16], kv[16];
#pragma unroll
              for (int c8 = 0; c8 < 16; ++c8) { qv[c8] = *(const pg8::u32x4*)(q + c8 * 8); kv[c8] = *(const pg8::u32x4*)(k + c8 * 8); }
#pragma unroll
              for (int c8 = 0; c8 < 16; ++c8)
#pragma unroll
                  for (int w2 = 0; w2 < 4; ++w2) { const unsigned a = qv[c8][w2], bq = kv[c8][w2];
                      sc = fmaf(__uint_as_float(a << 16), __uint_as_float(bq << 16), sc); sc = fmaf(__uint_as_float(a & 0xffff0000u), __uint_as_float(bq & 0xffff0000u), sc); } }
            sc *= 0.08838834764831845f;
            float m = sc;
            m = fmaxf(m, swz_xor<8>(m)); m = fmaxf(m, swz_xor<4>(m)); m = fmaxf(m, swz_xor<2>(m)); m = fmaxf(m, swz_xor<1>(m));
            const float e = expf(sc - m);
            float ssum = e;
            ssum += swz_xor<8>(ssum); ssum += swz_xor<4>(ssum); ssum += swz_xor<2>(ssum); ssum += swz_xor<1>(ssum);
            const float p = e / ssum;
            float acc[4] = {0.f, 0.f, 0.f, 0.f};
#pragma unroll
            for (int j = 0; j < 16; ++j) {
                const float pj = __int_as_float(__builtin_amdgcn_readlane(__float_as_int(p), j));
                const uint2 v2 = *(const uint2*)(QKV + (size_t)(b * LL + j) * QKVW + 2048 + h * 256 + lane * 4);
                acc[0] = fmaf(pj, __uint_as_float(v2.x << 16), acc[0]); acc[1] = fmaf(pj, __uint_as_float(v2.x & 0xffff0000u), acc[1]);
                acc[2] = fmaf(pj, __uint_as_float(v2.y << 16), acc[2]); acc[3] = fmaf(pj, __uint_as_float(v2.y & 0xffff0000u), acc[3]);
            }
            float* o = OC + (size_t)(b * LL + row) * DM + h * 512 + i * 256 + lane * 4;
            *(float4*)o = make_float4(acc[0], acc[1], acc[2], acc[3]);
        }
    }
}


namespace hg {
using bf16x8 = __attribute__((ext_vector_type(8))) short;
using s16x4  = __attribute__((ext_vector_type(4))) short;
using f32x16 = __attribute__((ext_vector_type(16))) float;
using u32x4  = __attribute__((ext_vector_type(4))) unsigned;
constexpr int NCH = 33, NU = 16 * NCH;
constexpr int SK = 136;
constexpr int SS = 72;
__device__ __forceinline__ int crow(int r, int hi) { return (r & 3) + 8 * (r >> 2) + 4 * hi; }
__device__ __forceinline__ unsigned cvtpk(float lo, float hi) { unsigned r; asm volatile("v_cvt_pk_bf16_f32 %0, %1, %2" : "=v"(r) : "v"(lo), "v"(hi)); return r; }

__device__ __forceinline__ void prep(const float (&fpv)[16], float lbv, int c, int k, int tq, float* qsum, float (&b)[16], float (&kk)[16], float& bend, float& r) {
    float run = 0.f;
#pragma unroll
    for (int i = 0; i < 16; ++i) {
        const int t = 16 * tq + i; const bool valid = (c * 64 + t) < LL;
        const float kv = valid ? (1.f - lbv) * __builtin_amdgcn_rcpf(1.f + __expf(fpv[i])) : 0.f;
        kk[i] = kv; run += fmaxf(__logf(1.f - kv), -30.f); b[i] = run;
    }
    qsum[tq * 128 + k] = run;
    __syncthreads();
    const float q0 = qsum[k], q1 = qsum[128 + k], q2 = qsum[256 + k], q3 = qsum[384 + k];
    const float off = tq == 0 ? 0.f : (tq == 1 ? q0 : (tq == 2 ? q0 + q1 : q0 + q1 + q2));
    r = q0 + q1; bend = (q0 + q1) + (q2 + q3);
#pragma unroll
    for (int i = 0; i < 16; ++i) b[i] += off;
}
__device__ __forceinline__ void store16(bf16_t* dst, const float (&x)[16]) {
    u32x4 w0, w1;
    w0.x = cvtpk(x[0], x[1]); w0.y = cvtpk(x[2], x[3]); w0.z = cvtpk(x[4], x[5]); w0.w = cvtpk(x[6], x[7]);
    w1.x = cvtpk(x[8], x[9]); w1.y = cvtpk(x[10], x[11]); w1.z = cvtpk(x[12], x[13]); w1.w = cvtpk(x[14], x[15]);
    *(u32x4*)dst = w0; *(u32x4*)(dst + 8) = w1;
}

__device__ __forceinline__ void local_states(KP P, char* lds, int layer) {
    bf16_t* KhT = (bf16_t*)lds; bf16_t* VT = KhT + 128 * SS; float* qsum = (float*)(VT + 128 * SS);
    const float* PA = P->PA; const float* lbtab = P->lbtab + layer * 512; float* SLOC = P->SLOC; float* DEC = P->DEC;
    const int tid = tid_(), k = tid & 127, tq = tid >> 7, lane = tid & 63, wid = tid >> 6, r32 = lane & 31, hh = lane >> 5;
    for (int u = bid_(); u < NU; u += gridDim.x) {
        const int bh = u / NCH, c = u % NCH, b_ = bh >> 2, h = bh & 3; const size_t row0 = (size_t)b_ * LL + c * 64;
        float fpv[16], vv[16];
#pragma unroll
        for (int i = 0; i < 16; ++i) { const int t = 16 * tq + i; const bool valid = (c * 64 + t) < LL; const float* rp = PA + (row0 + (valid ? t : 0)) * PAW + h * 128 + k;
            fpv[i] = rp[512]; vv[i] = valid ? rp[1024] : 0.f; }
        float b[16], kk[16], bend, r;
        prep(fpv, lbtab[h * 128 + k], c, k, tq, qsum, b, kk, bend, r);
        float x[16];
#pragma unroll
        for (int i = 0; i < 16; ++i) x[i] = kk[i] * __expf(bend - b[i]);
        store16(KhT + k * SS + 16 * tq, x);
        store16(VT + k * SS + 16 * tq, vv);
        if (tq == 0) DEC[u * 128 + k] = __expf(bend);
        __syncthreads();
        const int vt = wid >> 1;
#pragma unroll
        for (int j = 0; j < 2; ++j) {
            const int kt = (wid & 1) * 2 + j;
            f32x16 acc = {};
#pragma unroll
            for (int sg = 0; sg < 4; ++sg) {
                const bf16x8 a = *(const bf16x8*)(VT + (vt * 32 + r32) * SS + sg * 16 + hh * 8);
                const bf16x8 bb = *(const bf16x8*)(KhT + (kt * 32 + r32) * SS + sg * 16 + hh * 8);
                acc = __builtin_amdgcn_mfma_f32_32x32x16_bf16(a, bb, acc, 0, 0, 0);
            }
            float* o = SLOC + (size_t)u * 16384 + kt * 32 + r32;
#pragma unroll
            for (int rg = 0; rg < 16; ++rg) o[(vt * 32 + crow(rg, hh)) * 128] = acc[rg];
        }
        __syncthreads();
    }
}
__device__ __forceinline__ void scan_states(KP P) {
    const float* SLOC = P->SLOC; const float* DEC = P->DEC; bf16_t* SPREV = P->SPREV;
    const int tid = tid_();
    for (int e = bid_() * NTHR + tid; e < 16 * 16384; e += gridDim.x * NTHR) {
        const int bh = e >> 14, vk = e & 16383, k = vk & 127;
        float d[NCH - 1], x[NCH - 1];
#pragma unroll
        for (int c = 0; c < NCH - 1; ++c) { const int u = bh * NCH + c; d[c] = DEC[u * 128 + k]; x[c] = SLOC[(size_t)u * 16384 + vk]; }
        float S = 0.f;
#pragma unroll
        for (int c = 0; c < NCH - 1; ++c) { S = fmaf(d[c], S, x[c]); SPREV[(size_t)(bh * NCH + c + 1) * 16384 + vk] = f2bf(S); }
    }
}
__device__ __forceinline__ void outputs(KP P, char* lds, int layer) {
    bf16_t* Qt = (bf16_t*)lds; bf16_t* Qh = Qt + 64 * SK; bf16_t* Kt = Qh + 64 * SK; bf16_t* VT = Kt + 64 * SK; bf16_t* SpT = VT + 128 * SS;
    float* qsum = (float*)(SpT + 128 * SK); float* part = qsum + 512;
    const float* PA = P->PA; const float* lbtab = P->lbtab + layer * 512; const bf16_t* SPREV = P->SPREV; const float* nw = P->hnw + layer * 128; bf16_t* MIX = P->MIX;
    const int tid = tid_(), k = tid & 127, tq = tid >> 7, lane = tid & 63, wid = tid >> 6, r32 = lane & 31, hh = lane >> 5;
    for (int u = bid_(); u < NU; u += gridDim.x) {
        const int bh = u / NCH, c = u % NCH, b_ = bh >> 2, h = bh & 3; const size_t row0 = (size_t)b_ * LL + c * 64;
        const int tt = wid & 1, vt = wid >> 1;
        float fpv[16], qv[16], vv[16]; u32x4 sp[4]; float4 gv[4];
#pragma unroll
        for (int i = 0; i < 16; ++i) { const int t = 16 * tq + i; const bool valid = (c * 64 + t) < LL; const float* rp = PA + (row0 + (valid ? t : 0)) * PAW + h * 128 + k;
            fpv[i] = rp[512]; qv[i] = valid ? rp[0] : 0.f; vv[i] = valid ? rp[1024] : 0.f; }
#pragma unroll
        for (int j = 0; j < 4; ++j) { const int idx = tid + 512 * j, v = idx >> 4, ch = idx & 15; sp[j] = *(const u32x4*)(SPREV + (size_t)(c > 0 ? u : u + 1) * 16384 + v * 128 + ch * 8); }
        { const int te = tt * 32 + r32; const float* gp = PA + (row0 + ((c * 64 + te) < LL ? te : 0)) * PAW + 1536 + h * 128 + vt * 32 + 4 * hh;
#pragma unroll
          for (int g4 = 0; g4 < 4; ++g4) gv[g4] = *(const float4*)(gp + 8 * g4); }
        float b[16], kk[16], bend, r;
        prep(fpv, lbtab[h * 128 + k], c, k, tq, qsum, b, kk, bend, r);
#pragma unroll
        for (int i = 0; i < 16; ++i) { const int t = 16 * tq + i; const float q = qv[i];
            Qt[t * SK + k] = f2bf(q * __expf(b[i] - r)); Qh[t * SK + k] = f2bf(q * __expf(b[i])); Kt[t * SK + k] = f2bf(kk[i] * __expf(r - b[i])); }
        store16(VT + k * SS + 16 * tq, vv);
        if (c > 0) {
#pragma unroll
            for (int j = 0; j < 4; ++j) { const int idx = tid + 512 * j, v = idx >> 4, ch = idx & 15; *(u32x4*)(SpT + v * SK + ch * 8) = sp[j]; }
        }
        __syncthreads();
        f32x16 oacc = {};
#pragma unroll
        for (int st = 0; st < 2; ++st) {
            if (st <= tt) {
                f32x16 sc = {};
#pragma unroll
                for (int d0 = 0; d0 < 8; ++d0) {
                    const bf16x8 a = *(const bf16x8*)(Kt + (st * 32 + r32) * SK + d0 * 16 + hh * 8);
                    const bf16x8 bq = *(const bf16x8*)(Qt + (tt * 32 + r32) * SK + d0 * 16 + hh * 8);
                    sc = __builtin_amdgcn_mfma_f32_32x32x16_bf16(a, bq, sc, 0, 0, 0);
                }
                if (st == tt) {
#pragma unroll
                    for (int rg = 0; rg < 16; ++rg) sc[rg] = (crow(rg, hh) <= r32) ? sc[rg] : 0.f;
                }
#pragma unroll
                for (int g = 0; g < 2; ++g) {
                    u32x4 w; w.x = cvtpk(sc[8 * g + 0], sc[8 * g + 1]); w.y = cvtpk(sc[8 * g + 2], sc[8 * g + 3]); w.z = cvtpk(sc[8 * g + 4], sc[8 * g + 5]); w.w = cvtpk(sc[8 * g + 6], sc[8 * g + 7]);
                    const bf16x8 pb = *reinterpret_cast<bf16x8*>(&w);
                    const bf16_t* vp = VT + (vt * 32 + r32) * SS + st * 32 + 16 * g + 4 * hh;
                    const s16x4 lo = *(const s16x4*)vp, hi4 = *(const s16x4*)(vp + 8);
                    const bf16x8 a = (bf16x8){lo[0], lo[1], lo[2], lo[3], hi4[0], hi4[1], hi4[2], hi4[3]};
                    oacc = __builtin_amdgcn_mfma_f32_32x32x16_bf16(a, pb, oacc, 0, 0, 0);
                }
            }
        }
        if (c > 0) {
#pragma unroll
            for (int d0 = 0; d0 < 8; ++d0) {
                const bf16x8 a = *(const bf16x8*)(SpT + (vt * 32 + r32) * SK + d0 * 16 + hh * 8);
                const bf16x8 bq = *(const bf16x8*)(Qh + (tt * 32 + r32) * SK + d0 * 16 + hh * 8);
                oacc = __builtin_amdgcn_mfma_f32_32x32x16_bf16(a, bq, oacc, 0, 0, 0);
            }
        }
        float ss = 0.f;
#pragma unroll
        for (int rg = 0; rg < 16; ++rg) ss = fmaf(oacc[rg], oacc[rg], ss);
        { auto rr = __builtin_amdgcn_permlane32_swap(__float_as_uint(ss), __float_as_uint(ss), false, false); ss = __uint_as_float(rr[0]) + __uint_as_float(rr[1]); }
        if (hh == 0) part[vt * 64 + tt * 32 + r32] = ss;
        __syncthreads();
        const int t = tt * 32 + r32;
        const float tot = (part[t] + part[64 + t]) + (part[128 + t] + part[192 + t]);
        const float scale = rsqrtf(tot * (1.f / 128.f) + EPS);
        if ((c * 64 + t) < LL) {
            bf16_t* op = MIX + (row0 + t) * DM + h * 128 + vt * 32;
#pragma unroll
            for (int g4 = 0; g4 < 4; ++g4) {
                const int v0 = 8 * g4 + 4 * hh;
                const float4 gg = gv[g4]; const float4 wv = *(const float4*)(nw + vt * 32 + v0);
                const float y0 = oacc[4 * g4 + 0] * scale * wv.x * gg.x / (1.f + __expf(-gg.x)), y1 = oacc[4 * g4 + 1] * scale * wv.y * gg.y / (1.f + __expf(-gg.y));
                const float y2 = oacc[4 * g4 + 2] * scale * wv.z * gg.z / (1.f + __expf(-gg.z)), y3 = oacc[4 * g4 + 3] * scale * wv.w * gg.w / (1.f + __expf(-gg.w));
                uint2 w; w.x = cvtpk(y0, y1); w.y = cvtpk(y2, y3);
                *(uint2*)(op + v0) = w;
            }
        }
        __syncthreads();
    }
}
}


namespace moe {
using bf16x8 = __attribute__((ext_vector_type(8))) short;
using f32x16 = __attribute__((ext_vector_type(16))) float;
using u32x4  = __attribute__((ext_vector_type(4))) unsigned;
constexpr int TW = 5, PROWS = 64 * TW, XS = 144, XBUF = PROWS * XS;
__device__ __forceinline__ unsigned cvtpk(float lo, float hi) { unsigned r; asm volatile("v_cvt_pk_bf16_f32 %0, %1, %2" : "=v"(r) : "v"(lo), "v"(hi)); return r; }
#define MOE_BAR() asm volatile("s_waitcnt lgkmcnt(0)\n\ts_barrier" ::: "memory")
constexpr int WD = 2;
constexpr int ABUF = 4 * 4 * 1024, AOFF = 2 * XBUF, LOFF = AOFF + 2 * ABUF;
template <bool UP>
__device__ __forceinline__ void stream_gemm(KP P, char* lds, int layer) {
    constexpr int KTOT = UP ? DM : DE, NSLAB = KTOT / 64, NCP = UP ? 2 : 4, LDW = UP ? DE : DM, CPSTRIDE = UP ? 64 : 128;
    static_assert(NSLAB % WD == 0 && NSLAB >= 2 * WD, "slab loop is unrolled by WD");
    const int tid = tid_(), lane = tid & 63, wid = tid >> 6, r32 = lane & 31, hh = lane >> 5, cg = wid & 3, th = wid >> 2;
    const int* cnt_ = P->cnt;
    const bf16_t* X = UP ? P->HN : P->H;
    int* basel = (int*)(lds + LOFF); int* tlist = basel + 64;
    for (int ub = bid_(); ub < 256; ub += gridDim.x) {
        const int u = ((ub & 7) << 5) | (ub >> 3);
        const int e = u >> 2, ns = u & 3;
        const int rot = ((u >> 2) * 11) & (NSLAB - 1);
        __syncthreads();
        if (tid < 64) basel[64 + 320 + tid] = cnt_[tid * CSTR];
        __syncthreads();
        if (tid < 64) { int a = 0; for (int q = 0; q < tid; ++q) a += basel[64 + 320 + q]; basel[tid] = a; }
        __syncthreads();
        const int cnt = cnt_[e * CSTR], row0 = basel[e];
        for (int pass0 = 0; pass0 < cnt; pass0 += PROWS) {
            const int cntp = (cnt - pass0) < PROWS ? (cnt - pass0) : PROWS;
            if constexpr (UP) { if (cnt <= ECAP) {
                __syncthreads();
                if (tid < PROWS && pass0 + tid < cnt) tlist[tid] = P->elist[e * ECAP + pass0 + tid];
                __syncthreads();
              } else {
                __syncthreads();
                const int* ridx = P->ridx; const int* rslot = P->rslot;
#pragma unroll 1
                for (int i0 = tid; i0 < NASSIGN; i0 += NTHR * 8) {
                    int ex[8], sl[8];
#pragma unroll
                    for (int q = 0; q < 8; ++q) { const int i = i0 + NTHR * q; ex[q] = i < NASSIGN ? ridx[i] : -1; sl[q] = i < NASSIGN ? rslot[i] : 0; }
#pragma unroll
                    for (int q = 0; q < 8; ++q) { const int sp = sl[q] - pass0; if (ex[q] == e && sp >= 0 && sp < PROWS) tlist[sp] = (i0 + NTHR * q) >> 1; }
                }
                __syncthreads();
            } }
            int xoff[5];
#pragma unroll
            for (int j = 0; j < 5; ++j) { int rho = (tid >> 3) + 64 * j; rho = rho < cntp ? rho : cntp - 1; const int grow = row0 + pass0 + rho;
                xoff[j] = (UP ? tlist[rho] * DM : grow * DE) + (tid & 7) * 8; }
            char* const xw = lds + (tid >> 3) * XS + (tid & 7) * 16;
            char* const aw = lds + AOFF + (cg * 4 + 2 * th) * 1024 + lane * 16;
            const char* const ar = lds + AOFF + cg * 4 * 1024 + lane * 16;
            float wreg[WD][16]; u32x4 xs[5];
#pragma unroll 1
            for (int cp = 0; cp < NCP; ++cp) {
                const int cgi = cp * 4 + cg;
                const int kkw = wid >> 1, half = wid & 1;
                const float* wp;
                if constexpr (UP) wp = (r32 < 16 ? P->w1 : P->w3) + ((size_t)(layer * NE + e) * DM + kkw * 16 + 8 * hh + 4 * half) * DE + ns * 128 + cp * 64 + 4 * (r32 & 15);
                else wp = P->w2 + ((size_t)(layer * NE + e) * DE + 32 * hh + 2 * th) * DM + ns * 512 + cgi * 32 + r32;
                f32x16 acc[TW];
#pragma unroll
                for (int tl = 0; tl < TW; ++tl) acc[tl] = f32x16{};
#define MOE_WLD1(wn_, R, li) do { if constexpr (UP) { if ((li) < 4) { const float4 t_ = *(const float4*)((wn_) + (size_t)(li) * DE); wreg[R][4 * (li)] = t_.x; wreg[R][4 * (li) + 1] = t_.y; wreg[R][4 * (li) + 2] = t_.z; wreg[R][4 * (li) + 3] = t_.w; } } \
                    else { if ((li) < 16) wreg[R][li] = (wn_)[(size_t)(((li) >> 3) + 4 * ((li) & 7)) * DM]; } } while (0)
#define MOE_WLOAD(slab, R) do { const float* wn_ = wp + (size_t)(((slab) + rot) & (NSLAB - 1)) * 64 * LDW; \
                    _Pragma("unroll") for (int li = 0; li < 16; ++li) MOE_WLD1(wn_, R, li); } while (0)
#define MOE_WPARK(R, PAR) do { if constexpr (UP) { _Pragma("unroll") for (int q = 0; q < 4; ++q) { uint2 fw; fw.x = cvtpk(wreg[R][q], wreg[R][4 + q]); fw.y = cvtpk(wreg[R][8 + q], wreg[R][12 + q]); \
                            *(uint2*)(lds + AOFF + (PAR) * ABUF + (q * 4 + kkw) * 1024 + lane * 16 + half * 8) = fw; } } \
                    else { _Pragma("unroll") for (int i = 0; i < 2; ++i) { u32x4 fw; fw.x = cvtpk(wreg[R][8 * i + 0], wreg[R][8 * i + 1]); fw.y = cvtpk(wreg[R][8 * i + 2], wreg[R][8 * i + 3]); \
                            fw.z = cvtpk(wreg[R][8 * i + 4], wreg[R][8 * i + 5]); fw.w = cvtpk(wreg[R][8 * i + 6], wreg[R][8 * i + 7]); *(u32x4*)(aw + (PAR) * ABUF + i * 1024) = fw; } } } while (0)
                if (cp == 0) {
#pragma unroll
                    for (int j = 0; j < 5; ++j) xs[j] = *(const u32x4*)(X + xoff[j] + (rot & (NSLAB - 1)) * 64);
                    MOE_WLOAD(0, 0); MOE_WLOAD(1, 1);
#pragma unroll
                    for (int j = 0; j < 5; ++j) *(u32x4*)(xw + 64 * j * XS) = xs[j];
                    MOE_WPARK(0, 0); MOE_WLOAD(2, 0);
                    MOE_BAR();
                }
#define MOE_SLAB(s, PAR, R1) do { \
                    const int sx = ((s) + 1) & (NSLAB - 1); const int swr = (s) + 1 + WD; const bool wnext = swr >= NSLAB && cp + 1 < NCP;     \
                    const int sw = swr < NSLAB ? swr : (wnext ? swr - NSLAB : NSLAB - 1); \
                    { const bf16_t* xn0_ = X + ((sx + rot) & (NSLAB - 1)) * 64; _Pragma("unroll") for (int j = 0; j < 5; ++j) xs[j] = *(const u32x4*)(xn0_ + xoff[j]); } \
                    MOE_WPARK(R1, 1 - (PAR)); \
                    const float* wn_ = wp + (wnext ? CPSTRIDE : 0) + (size_t)((sw + rot) & (NSLAB - 1)) * 64 * LDW; \
                    const char* xb = lds + (PAR) * XBUF + (th * TW * 32 + r32) * XS + hh * 16; \
                    bf16x8 xq[4]; bf16x8 fq[2];                                                       \
                    xq[0] = *(const bf16x8*)(xb); xq[1] = *(const bf16x8*)(xb + 32 * XS); xq[2] = *(const bf16x8*)(xb + 64 * XS); \
                    fq[0] = *(const bf16x8*)(ar + (PAR) * ABUF); \
                    _Pragma("unroll") for (int kk = 0; kk < 4; ++kk) { \
                        if (kk < 3) fq[(kk + 1) & 1] = *(const bf16x8*)(ar + (PAR) * ABUF + (kk + 1) * 1024); \
                        _Pragma("unroll") for (int tl = 0; tl < TW; ++tl) { \
                            const int cur = kk * TW + tl, nx = cur + 3, nkk = nx / TW, ntl = nx % TW;       \
                            if (nx < 4 * TW) xq[nx & 3] = *(const bf16x8*)(xb + ntl * 32 * XS + nkk * 32); \
                            acc[tl] = __builtin_amdgcn_mfma_f32_32x32x16_bf16(fq[kk & 1], xq[cur & 3], acc[tl], 0, 0, 0); \
                            const int li = kk * TW + tl; \
                            MOE_WLD1(wn_, R1, li); \
                            __builtin_amdgcn_sched_barrier(0); } } \
                    _Pragma("unroll") for (int j = 0; j < 5; ++j) *(u32x4*)(xw + (1 - (PAR)) * XBUF + 64 * j * XS) = xs[j]; \
                    MOE_BAR(); } while (0)
#pragma unroll 1
                for (int s = 0; s < NSLAB; s += 2) { MOE_SLAB(s, 0, 1); MOE_SLAB(s + 1, 1, 0); }
#undef MOE_SLAB
#undef MOE_WLOAD
#undef MOE_WLD1
#undef MOE_WPARK
                const int T = (cntp + 31) >> 5;
                const int Tw = (T - TW * th) < 0 ? 0 : ((T - TW * th) > TW ? TW : (T - TW * th));
#pragma unroll
                for (int tl = 0; tl < TW; ++tl) if (tl < Tw) {
                    const int rho = (th * TW + tl) * 32 + r32;
                    if (rho < cntp) {
                        const size_t grow = (size_t)(row0 + pass0 + rho);
                        if constexpr (UP) {
                            bf16_t* hp = P->H + grow * DE + ns * 128 + cgi * 16 + 4 * hh;
#pragma unroll
                            for (int g = 0; g < 2; ++g) {
                                float y[4];
#pragma unroll
                                for (int q = 0; q < 4; ++q) { const float a = acc[tl][4 * g + q], b = acc[tl][8 + 4 * g + q]; y[q] = a / (1.f + __expf(-a)) * b; }
                                uint2 w; w.x = cvtpk(y[0], y[1]); w.y = cvtpk(y[2], y[3]);
                                *(uint2*)(hp + 8 * g) = w;
                            }
                        } else {
                            bf16_t* yp = P->Y + grow * DM + ns * 512 + cgi * 32 + 4 * hh;
#pragma unroll
                            for (int g = 0; g < 4; ++g) {
                                uint2 w; w.x = cvtpk(acc[tl][4 * g + 0], acc[tl][4 * g + 1]); w.y = cvtpk(acc[tl][4 * g + 2], acc[tl][4 * g + 3]);
                                *(uint2*)(yp + 8 * g) = w;
                            }
                        }
                    }
                }
            }
        }
    }
}
#undef MOE_BAR
}


namespace s5 {
using bf16x8 = __attribute__((ext_vector_type(8))) short;
using f32x16 = __attribute__((ext_vector_type(16))) float;
using u32x4  = __attribute__((ext_vector_type(4))) unsigned;
constexpr int NCHK = 516, NMT = 17;
__device__ __forceinline__ unsigned cvtpk(float lo, float hi) { unsigned r; asm volatile("v_cvt_pk_bf16_f32 %0, %1, %2" : "=v"(r) : "v"(lo), "v"(hi)); return r; }
__device__ __forceinline__ bf16x8 ld8f(const float* p) {
    const float4 a = *(const float4*)p, b = *(const float4*)(p + 4);
    u32x4 w; w.x = cvtpk(a.x, a.y); w.y = cvtpk(a.z, a.w); w.z = cvtpk(b.x, b.y); w.w = cvtpk(b.z, b.w);
    return *reinterpret_cast<bf16x8*>(&w);
}
__device__ __forceinline__ void prep_unit(KP P, char* lds, int layer, int g) {
    float2* pw = (float2*)lds; float2* bb = pw + 17 * 64; float2* cc = bb + 1024; float* kd = (float*)(cc + 1024);
    const int tid = tid_();
    const float dt = expf(P->log_dt[layer * 32 + g]);
    const float* a_re = P->a_re + (layer * 32 + g) * 64; const float* a_im = P->a_im + (layer * 32 + g) * 64;
    for (int idx = tid; idx < 17 * 64; idx += NTHR) { const int d = idx >> 6, p = idx & 63;
        const float mag = expf(a_re[p] * dt * (float)d), ang = a_im[p] * dt * (float)d; pw[idx] = make_float2(mag * cosf(ang), mag * sinf(ang)); }
    for (int idx = tid; idx < 1024; idx += NTHR) {
        { const int p = idx >> 4, c = idx & 15; const float are = a_re[p], aim = a_im[p];
          const float mag = expf(are * dt), abr = mag * cosf(aim * dt), abi = mag * sinf(aim * dt), den = are * are + aim * aim;
          const float zr = ((abr - 1.f) * are + abi * aim) / den, zi = (abi * are - (abr - 1.f) * aim) / den;
          const float br = P->b_re[((layer * 32 + g) * 64 + p) * 16 + c], bi = P->b_im[((layer * 32 + g) * 64 + p) * 16 + c];
          bb[idx] = make_float2(zr * br - zi * bi, zr * bi + zi * br); }
        { const int c = idx >> 6, p = idx & 63; cc[idx] = make_float2(P->c_re[((layer * 32 + g) * 16 + c) * 64 + p], P->c_im[((layer * 32 + g) * 16 + c) * 64 + p]); }
    }
    __syncthreads();
    if (tid < 64) ((float2*)P->A16)[(layer * 32 + g) * 64 + tid] = pw[16 * 64 + tid];
    for (int idx = tid; idx < 4096; idx += NTHR) { const int d = idx >> 8, c = (idx >> 4) & 15, c2 = idx & 15;
        float acc = 0.f;
        for (int p = 0; p < 64; ++p) { const float2 C = cc[c * 64 + p], W = pw[d * 64 + p], B = bb[p * 16 + c2];
            const float xr = C.x * W.x - C.y * W.y, xi = C.x * W.y + C.y * W.x; acc += xr * B.x - xi * B.y; }
        if (d == 0 && c == c2) acc += P->s5d[layer * 512 + g * 16 + c];
        kd[idx] = acc; }
    __syncthreads();
    bf16_t* BtY = P->BtY + (size_t)(layer * 32 + g) * 256 * 384; bf16_t* BtE = P->BtE + (size_t)(layer * 32 + g) * 128 * 256;
    for (int idx = tid; idx < 256 * 48; idx += NTHR) { const int n = idx / 48, ch = idx % 48, t = n >> 4, c = n & 15;
        float v[8];
        if (ch < 32) { const int s = ch >> 1, c0 = (ch & 1) * 8;
#pragma unroll
            for (int jj = 0; jj < 8; ++jj) v[jj] = (s <= t) ? kd[((t - s) * 16 + c) * 16 + c0 + jj] : 0.f;
        } else {
#pragma unroll
            for (int jj = 0; jj < 8; ++jj) { const int kq = (ch - 32) * 8 + jj, p = kq >> 1; const float2 C = cc[c * 64 + p], W = pw[(t + 1) * 64 + p];
                v[jj] = (kq & 1) ? -(C.x * W.y + C.y * W.x) : (C.x * W.x - C.y * W.y); }
        }
        u32x4 w; w.x = cvtpk(v[0], v[1]); w.y = cvtpk(v[2], v[3]); w.z = cvtpk(v[4], v[5]); w.w = cvtpk(v[6], v[7]);
        *(u32x4*)(BtY + ((size_t)(((n >> 5) * 24 + (ch >> 1)) * 64 + (ch & 1) * 32 + (n & 31))) * 8) = w; }
    for (int idx = tid; idx < 128 * 32; idx += NTHR) { const int n = idx >> 5, ch = idx & 31, p = n >> 1, s = ch >> 1, c0 = (ch & 1) * 8;
        const float2 W = pw[(15 - s) * 64 + p];
        float v[8];
#pragma unroll
        for (int jj = 0; jj < 8; ++jj) { const float2 B = bb[p * 16 + c0 + jj]; v[jj] = (n & 1) ? (W.x * B.y + W.y * B.x) : (W.x * B.x - W.y * B.y); }
        u32x4 w; w.x = cvtpk(v[0], v[1]); w.y = cvtpk(v[2], v[3]); w.z = cvtpk(v[4], v[5]); w.w = cvtpk(v[6], v[7]);
        *(u32x4*)(BtE + ((size_t)(((n >> 5) * 16 + (ch >> 1)) * 64 + (ch & 1) * 32 + (n & 31))) * 8) = w; }
    __syncthreads();
}
__device__ __forceinline__ float gelu_t(float x) { const float u = 0.7978845608028654f * (x + 0.044715f * x * x * x); const float e = __expf(2.f * u); return x - x / (e + 1.f); }
__device__ __forceinline__ void fused_unit(KP P, char* lds, int layer, int b, int g) {
    const int tid = tid_(), lane = tid & 63, wid = tid >> 6, r32 = lane & 31, hh = lane >> 5;
    constexpr int UCH = 528, UBYTES = 68352;
    char* U16 = lds; float* El = (float*)(lds + UBYTES);
    const float* PA = P->PA; bf16_t* YG = P->YG;
    { const float* ub = PA + (size_t)(b * LL) * PAW + 2048 + g * 16;
#pragma unroll 1
      for (int i0 = 0; i0 < LL * 4; i0 += NTHR * 4) {
          float4 v[4];
#pragma unroll
          for (int q = 0; q < 4; ++q) { const int idx = i0 + q * NTHR + tid, ic = idx < LL * 4 ? idx : LL * 4 - 1; v[q] = *(const float4*)(ub + (size_t)(ic >> 2) * PAW + (ic & 3) * 4); }
#pragma unroll
          for (int q = 0; q < 4; ++q) { const int idx = i0 + q * NTHR + tid; if (idx < LL * 4) { const int r = idx >> 2;
              uint2 w; w.x = cvtpk(v[q].x, v[q].y); w.y = cvtpk(v[q].z, v[q].w); *(uint2*)(U16 + (r >> 4) * UCH + (r & 15) * 32 + (idx & 3) * 8) = w; } }
      } }
    __syncthreads();
    int mrow[5];
#pragma unroll
    for (int mt = 0; mt < 5; ++mt) { const int m = mt * 32 + r32; mrow[mt] = m < 129 ? m : 128; }
    if (wid < 4) {
        const bf16_t* Bt = P->BtE + (size_t)(layer * 32 + g) * 128 * 256 + ((size_t)(wid * 16) * 64 + lane) * 8;
        f32x16 acc[5];
#pragma unroll
        for (int mt = 0; mt < 5; ++mt) acc[mt] = f32x16{};
#pragma unroll 4
        for (int s = 0; s < 16; ++s) {
            const bf16x8 af = *(const bf16x8*)(Bt + (size_t)(s * 64) * 8);
#pragma unroll
            for (int mt = 0; mt < 5; ++mt) { const bf16x8 bf = *(const bf16x8*)(U16 + mrow[mt] * UCH + hh * 16 + 32 * s); acc[mt] = __builtin_amdgcn_mfma_f32_32x32x16_bf16(af, bf, acc[mt], 0, 0, 0); }
        }
#pragma unroll
        for (int mt = 0; mt < 5; ++mt) { const int m = mt * 32 + r32; if (m < 129) { float* ep = El + m * 128 + wid * 32 + 4 * hh;
#pragma unroll
            for (int q = 0; q < 4; ++q) *(float4*)(ep + 8 * q) = make_float4(acc[mt][4 * q], acc[mt][4 * q + 1], acc[mt][4 * q + 2], acc[mt][4 * q + 3]); } }
    }
    __syncthreads();
    if (tid < 64) {
        const float2 A = ((const float2*)P->A16)[(layer * 32 + g) * 64 + tid];
        float2* e2 = (float2*)El + tid;
        float xr = 0.f, xi = 0.f;
#pragma unroll 1
        for (int j0 = 0; j0 < 128; j0 += 8) {
            float2 e[8];
#pragma unroll
            for (int i = 0; i < 8; ++i) e[i] = e2[(j0 + i) * 64];
#pragma unroll
            for (int i = 0; i < 8; ++i) { e2[(j0 + i) * 64] = make_float2(xr, xi);
                const float nr = A.x * xr - A.y * xi + e[i].x, ni = A.x * xi + A.y * xr + e[i].y; xr = nr; xi = ni; }
        }
        e2[128 * 64] = make_float2(xr, xi);
    }
    __syncthreads();
    {
        const bf16_t* Bt = P->BtY + (size_t)(layer * 32 + g) * 256 * 384 + ((size_t)(wid * 24) * 64 + lane) * 8;
        f32x16 acc[5];
#pragma unroll
        for (int mt = 0; mt < 5; ++mt) acc[mt] = f32x16{};
#pragma unroll 4
        for (int s = 0; s < 16; ++s) if (2 * wid + 1 >= s) {
            const bf16x8 af = *(const bf16x8*)(Bt + (size_t)(s * 64) * 8);
#pragma unroll
            for (int mt = 0; mt < 5; ++mt) { const bf16x8 bf = *(const bf16x8*)(U16 + mrow[mt] * UCH + hh * 16 + 32 * s); acc[mt] = __builtin_amdgcn_mfma_f32_32x32x16_bf16(af, bf, acc[mt], 0, 0, 0); }
        }
#pragma unroll 4
        for (int ks = 0; ks < 8; ++ks) {
            const bf16x8 af = *(const bf16x8*)(Bt + (size_t)((16 + ks) * 64) * 8);
#pragma unroll
            for (int mt = 0; mt < 5; ++mt) { const bf16x8 bf = ld8f(El + mrow[mt] * 128 + 8 * hh + ks * 16); acc[mt] = __builtin_amdgcn_mfma_f32_32x32x16_bf16(af, bf, acc[mt], 0, 0, 0); }
        }
#pragma unroll
        for (int mt = 0; mt < 5; ++mt) { const int ml = mt * 32 + r32; if (ml < 129) { const int m = b * 129 + ml;
#pragma unroll
            for (int q = 0; q < 4; ++q) { const int t = 2 * wid + (q >> 1);
                uint2 w; w.x = cvtpk(gelu_t(acc[mt][4 * q]), gelu_t(acc[mt][4 * q + 1])); w.y = cvtpk(gelu_t(acc[mt][4 * q + 2]), gelu_t(acc[mt][4 * q + 3]));
                *(uint2*)(YG + (size_t)(m * 16 + t) * 512 + g * 16 + 8 * (q & 1) + 4 * hh) = w; } } }
    }
    __syncthreads();
}
}

__device__ __forceinline__ float wave_sum(float v) {
    v += swz_xor<1>(v); v += swz_xor<2>(v); v += swz_xor<4>(v); v += swz_xor<8>(v); v += swz_xor<16>(v);
    { auto rr = __builtin_amdgcn_permlane32_swap(__float_as_uint(v), __float_as_uint(v), false, false); v = __uint_as_float(rr[0]) + __uint_as_float(rr[1]); }
    return v;
}
__device__ __forceinline__ unsigned cvtpk_(float lo, float hi) { unsigned r; asm volatile("v_cvt_pk_bf16_f32 %0, %1, %2" : "=v"(r) : "v"(lo), "v"(hi)); return r; }
__device__ __forceinline__ void ph_attn_out(KP P, int layer, int cu0) {
    const int tid = tid_(), lane = tid & 63, gw = (bid_() - cu0) * 8 + (tid >> 6), NGW = (gridDim.x - cu0) * 8;
    if (gw < 0) return;
    const float scale = 1.f - (0.8f - 0.6f * expf(-0.3f * (float)layer));
    const float lam = P->lam[layer];
    const float4 sw = ((const float4*)(P->subln + layer * 256))[lane];
    const float* OC = P->OC; bf16_t* MIX = P->MIX;
    for (int it0 = gw; it0 < TOK * 4; it0 += NGW * 4) {
        float4 a[4], b[4];
#pragma unroll
        for (int q = 0; q < 4; ++q) { const int it = it0 + NGW * q, itc = it < TOK * 4 ? it : TOK * 4 - 1, r = itc >> 2, h = itc & 3;
            a[q] = *(const float4*)(OC + (size_t)r * DM + h * 512 + lane * 4); b[q] = *(const float4*)(OC + (size_t)r * DM + h * 512 + 256 + lane * 4); }
#pragma unroll
        for (int q = 0; q < 4; ++q) { const int it = it0 + NGW * q; if (it < TOK * 4) { const int r = it >> 2, h = it & 3;
            const float o0 = a[q].x - lam * b[q].x, o1 = a[q].y - lam * b[q].y, o2 = a[q].z - lam * b[q].z, o3 = a[q].w - lam * b[q].w;
            const float ss = wave_sum(o0 * o0 + o1 * o1 + o2 * o2 + o3 * o3);
            const float rs = rsqrtf(ss * (1.f / 256.f) + EPS) * scale;
            uint2 w; w.x = cvtpk_(o0 * rs * sw.x, o1 * rs * sw.y); w.y = cvtpk_(o2 * rs * sw.z, o3 * rs * sw.w);
            *(uint2*)(MIX + (size_t)r * DM + 1024 + h * 256 + lane * 4) = w; } }
    }
}
__device__ __forceinline__ void ph_build_norm(KP P) {
    const int tid = tid_(), lane = tid & 63, gw = bid_() * 8 + (tid >> 6), NGW = gridDim.x * 8;
    for (int r = gw; r < MP; r += NGW) {
        float4 v[8];
        if (r < TOK) { const int b = r / LL, t = r % LL;
            const float4* src = (const float4*)(t < NMETA ? P->meta + (size_t)t * DM : P->x + ((size_t)b * SEQ + (t - NMETA)) * DM);
#pragma unroll
            for (int j = 0; j < 8; ++j) v[j] = src[lane + 64 * j];
        } else {
#pragma unroll
            for (int j = 0; j < 8; ++j) v[j] = make_float4(0.f, 0.f, 0.f, 0.f);
        }
        float ss = 0.f;
#pragma unroll
        for (int j = 0; j < 8; ++j) { ((float4*)(P->Z + (size_t)r * DM))[lane + 64 * j] = v[j]; ss += v[j].x * v[j].x + v[j].y * v[j].y + v[j].z * v[j].z + v[j].w * v[j].w; }
        const float rs = rsqrtf(wave_sum(ss) * (1.f / DM) + EPS);
#pragma unroll
        for (int j = 0; j < 8; ++j) { const float4 w = ((const float4*)P->ln1_w)[lane + 64 * j];
            uint2 o; o.x = cvtpk_(v[j].x * rs * w.x, v[j].y * rs * w.y); o.y = cvtpk_(v[j].z * rs * w.z, v[j].w * rs * w.w);
            ((uint2*)(P->HN + (size_t)r * DM))[lane + 64 * j] = o; }
    }
}
__device__ __forceinline__ void ph_prep(KP P) {
    const int tid = tid_();
    if (bid_() == 0) {
        const int c = tid;
        const float l0 = P->lbnd[c], l1 = P->lbnd[512 + c], m = fmaxf(l0, l1), e0 = expf(l0 - m), e1 = expf(l1 - m);
        P->lbtab[c] = 0.f; P->lbtab[512 + c] = e1 / (e0 + e1);
        if (c < 2) {
            float s1 = 0.f, s2 = 0.f;
            for (int i = 0; i < 128; ++i) { s1 += P->lq1[c * 128 + i] * P->lk1[c * 128 + i]; s2 += P->lq2[c * 128 + i] * P->lk2[c * 128 + i]; }
            const float li = 0.8f - 0.6f * expf(-0.3f * (float)c);
            P->lam[c] = expf(s1) - expf(s2) + li;
        }
    }
    for (int i = bid_() * NTHR + tid; i < 2 * 128 * 3 * 64 * 8; i += gridDim.x * NTHR) {
        const int jj = i & 7, ln = (i >> 3) & 63, ct = (i >> 9) % 3, ksg = ((i >> 9) / 3) & 127, layer = (i >> 9) / (3 * 128);
        const int jc = ct * 32 + (ln & 31), k = ksg * 16 + 8 * (ln >> 5) + jj;
        float v = 0.f;
        if (jc < 8) v = P->wrg[((size_t)layer * DM + k) * 8 + jc]; else if (jc < 72) v = P->wre[((size_t)layer * DM + k) * 64 + jc - 8];
        v *= P->ln2_w[layer * DM + k];
        const bf16_t hi = f2bf(v), lo = f2bf(v - bf2f(hi));
        const size_t o = ((size_t)((ksg * 3 + ct) * 64 + ln)) * 8 + jj;
        P->WRT[(size_t)(layer * 2 + 0) * 96 * DM + o] = hi; P->WRT[(size_t)(layer * 2 + 1) * 96 * DM + o] = lo;
    }
}
namespace rt {
using f32x16 = __attribute__((ext_vector_type(16))) float;
using bf16x8 = __attribute__((ext_vector_type(8))) short;
using u32x4  = __attribute__((ext_vector_type(4))) unsigned;
__device__ __forceinline__ void norm_router(KP P, char* lds, int layer) {
    const int tid = tid_(), lane = tid & 63, wid = tid >> 6, r32 = lane & 31, hh = lane >> 5;
    float* part = (float*)lds;
    float* ssqp = (float*)(lds + 98304);
    float* lg = ssqp + 256;
    float* rsv = lg + 32 * 97;
    const bf16_t* Whi = P->WRT + (size_t)(layer * 2 + 0) * 96 * DM; const bf16_t* Wlo = P->WRT + (size_t)(layer * 2 + 1) * 96 * DM;
    const float* Z = P->Z;
    float* st = (float*)lds + wid * (32 * 68);
    const int nunits = layer == 1 ? (NB * SEQ) / 32 : TOK / 32;
    for (int u = bid_(); u < nunits; u += gridDim.x) {
        const int tok0 = layer == 1 ? (u >> 6) * LL + NMETA + (u & 63) * 32 : u * 32, kb = wid * 256;
        if (false) {
            float* Zw = P->Z; const float* ZP = P->ZP;
            for (int i = tid; i < 32 * DM / 4; i += NTHR) { const int r = i / (DM / 4), c4 = i % (DM / 4);
                float4 z = ((const float4*)(Zw + (size_t)(tok0 + r) * DM))[c4];
#pragma unroll
                for (int ks = 0; ks < 8; ++ks) { const float4 p4 = ((const float4*)(ZP + ((size_t)ks * 256 + (tok0 - 8192 + r)) * DM))[c4]; z.x += p4.x; z.y += p4.y; z.z += p4.z; z.w += p4.w; }
                ((float4*)(Zw + (size_t)(tok0 + r) * DM))[c4] = z; }
            asm volatile("s_waitcnt vmcnt(0)" ::: "memory");
            __syncthreads();
        }
        f32x16 acc[3] = {f32x16{}, f32x16{}, f32x16{}};
        float sq8[8];
#pragma unroll
        for (int j = 0; j < 8; ++j) sq8[j] = 0.f;
        const float* zg = Z + (size_t)(tok0 + (lane >> 4)) * DM + kb + (lane & 15) * 4;
        const bf16_t* dg = P->DLT + (size_t)(tok0 + (lane >> 4)) * DM + kb + (lane & 15) * 4;
        float4 zs[8]; uint2 ds[8];
#pragma unroll
        for (int j = 0; j < 8; ++j) { zs[j] = *(const float4*)(zg + (size_t)(4 * j) * DM); ds[j] = *(const uint2*)(dg + (size_t)(4 * j) * DM); }
#pragma unroll 1
        for (int sc = 0; sc < 4; ++sc) {
#pragma unroll
            for (int j = 0; j < 8; ++j) { float4 z = zs[j]; z.x += __uint_as_float(ds[j].x << 16); z.y += __uint_as_float(ds[j].x & 0xffff0000u); z.z += __uint_as_float(ds[j].y << 16); z.w += __uint_as_float(ds[j].y & 0xffff0000u);
                sq8[j] += z.x * z.x + z.y * z.y + z.z * z.z + z.w * z.w;
                *(float4*)(st + ((lane >> 4) + 4 * j) * 68 + (lane & 15) * 4) = z; }
            const int scn = sc < 3 ? sc + 1 : 3;
#pragma unroll
            for (int j = 0; j < 8; ++j) { zs[j] = *(const float4*)(zg + (size_t)(4 * j) * DM + scn * 64); ds[j] = *(const uint2*)(dg + (size_t)(4 * j) * DM + scn * 64); }
            asm volatile("s_waitcnt lgkmcnt(0)" ::: "memory");
            const bf16_t* wh = Whi + ((size_t)((wid * 16 + sc * 4) * 3) * 64 + lane) * 8; const bf16_t* wl = Wlo + ((size_t)((wid * 16 + sc * 4) * 3) * 64 + lane) * 8;
#pragma unroll
            for (int ks = 0; ks < 4; ++ks) {
                const float4 z0 = *(const float4*)(st + r32 * 68 + ks * 16 + 8 * hh), z1 = *(const float4*)(st + r32 * 68 + ks * 16 + 8 * hh + 4);
                u32x4 h; h.x = cvtpk_(z0.x, z0.y); h.y = cvtpk_(z0.z, z0.w); h.z = cvtpk_(z1.x, z1.y); h.w = cvtpk_(z1.z, z1.w);
                u32x4 l; l.x = cvtpk_(z0.x - __uint_as_float(h.x << 16), z0.y - __uint_as_float(h.x & 0xffff0000u)); l.y = cvtpk_(z0.z - __uint_as_float(h.y << 16), z0.w - __uint_as_float(h.y & 0xffff0000u));
                l.z = cvtpk_(z1.x - __uint_as_float(h.z << 16), z1.y - __uint_as_float(h.z & 0xffff0000u)); l.w = cvtpk_(z1.z - __uint_as_float(h.w << 16), z1.w - __uint_as_float(h.w & 0xffff0000u));
                const bf16x8 zh = *reinterpret_cast<bf16x8*>(&h), zl = *reinterpret_cast<bf16x8*>(&l);
#pragma unroll
                for (int ct = 0; ct < 3; ++ct) {
                    const bf16x8 ah = *(const bf16x8*)(wh + (size_t)((ks * 3 + ct) * 64) * 8), al = *(const bf16x8*)(wl + (size_t)((ks * 3 + ct) * 64) * 8);
                    acc[ct] = __builtin_amdgcn_mfma_f32_32x32x16_bf16(ah, zh, acc[ct], 0, 0, 0);
                    acc[ct] = __builtin_amdgcn_mfma_f32_32x32x16_bf16(ah, zl, acc[ct], 0, 0, 0);
                    acc[ct] = __builtin_amdgcn_mfma_f32_32x32x16_bf16(al, zh, acc[ct], 0, 0, 0);
                }
            }
            asm volatile("s_waitcnt lgkmcnt(0)" ::: "memory");
        }
#pragma unroll
        for (int j = 0; j < 8; ++j) { float v = sq8[j]; v += swz_xor<1>(v); v += swz_xor<2>(v); v += swz_xor<4>(v); v += swz_xor<8>(v); sq8[j] = v; }
        __syncthreads();
        if ((lane & 15) == 0) {
#pragma unroll
            for (int j = 0; j < 8; ++j) ssqp[wid * 32 + (lane >> 4) + 4 * j] = sq8[j];
        }

#pragma unroll
        for (int ct = 0; ct < 3; ++ct)
#pragma unroll
            for (int rg = 0; rg < 16; ++rg) part[((wid * 3 + ct) * 16 + rg) * 64 + lane] = acc[ct][rg];
        __syncthreads();
        if (tid < 32) { float t = 0.f;
#pragma unroll
            for (int w = 0; w < 8; ++w) t += ssqp[w * 32 + tid];
            rsv[tid] = rsqrtf(t * (1.f / DM) + EPS); }
#pragma unroll
        for (int q = 0; q < 6; ++q) { const int o = tid + NTHR * q, col = o >> 5, tok = o & 31, ct = col >> 5, cl = col & 31, h2 = (cl >> 2) & 1, rg = (cl & 3) + 4 * (cl >> 3);
            float t = 0.f;
#pragma unroll
            for (int w = 0; w < 8; ++w) t += part[((w * 3 + ct) * 16 + rg) * 64 + h2 * 32 + tok];
            lg[tok * 97 + col] = t; }
        __syncthreads();
        if (tid < 32) {
            const int t = tok0 + tid; const float rs = rsv[tid]; const float* l = lg + tid * 97;
            const float* brg = P->brg + layer * 8; const float* bre = P->bre + layer * 64;
            float gl[8];
#pragma unroll
            for (int j = 0; j < 8; ++j) gl[j] = l[j] * rs + brg[j];
            int gs = 0; float gm = gl[0];
#pragma unroll
            for (int j = 1; j < 8; ++j) if (gl[j] > gm) { gm = gl[j]; gs = j; }
            float den = 0.f;
#pragma unroll
            for (int j = 0; j < 8; ++j) den += expf(gl[j] - gm);
            const float pg = 1.f / den;
            float el[8];
#pragma unroll
            for (int j = 0; j < 8; ++j) el[j] = l[8 + gs * 8 + j] * rs + bre[gs * 8 + j];
            int j0 = 0; float v0 = el[0];
#pragma unroll
            for (int j = 1; j < 8; ++j) if (el[j] > v0) { v0 = el[j]; j0 = j; }
            int j1 = -1; float v1 = -INFINITY;
#pragma unroll
            for (int j = 0; j < 8; ++j) if (j != j0 && el[j] > v1) { v1 = el[j]; j1 = j; }
            const float e1 = expf(v1 - v0), g0 = pg / (1.f + e1), g1 = pg * e1 / (1.f + e1);
            const int x0 = gs * 8 + j0, x1 = gs * 8 + j1;
            P->ridx[t * 2] = x0; P->ridx[t * 2 + 1] = x1; P->rgate[t * 2] = g0; P->rgate[t * 2 + 1] = g1;
            const int s0 = atomicAdd(&P->cnt[x0 * CSTR], 1), s1 = atomicAdd(&P->cnt[x1 * CSTR], 1);
            P->rslot[t * 2] = s0; P->rslot[t * 2 + 1] = s1;
            if (s0 < ECAP) P->elist[x0 * ECAP + s0] = t; if (s1 < ECAP) P->elist[x1 * ECAP + s1] = t;
        }
#pragma unroll 1
        for (int q = 0; q < 4; q += 2) { const int tk = wid * 4 + q; const float rs0 = rsv[tk], rs1 = rsv[tk + 1];
            const float4* zr = (const float4*)(Z + (size_t)(tok0 + tk) * DM); const float4* wl4 = (const float4*)(P->ln2_w + layer * DM);
            const uint2* dr = (const uint2*)(P->DLT + (size_t)(tok0 + tk) * DM);
            float4 za[8], zb[8]; uint2 da[8], db[8];
#pragma unroll
            for (int j = 0; j < 8; ++j) { za[j] = zr[lane + 64 * j]; zb[j] = zr[DM / 4 + lane + 64 * j]; da[j] = dr[lane + 64 * j]; db[j] = dr[DM / 4 + lane + 64 * j]; }
#pragma unroll
            for (int j = 0; j < 8; ++j) { za[j].x += __uint_as_float(da[j].x << 16); za[j].y += __uint_as_float(da[j].x & 0xffff0000u); za[j].z += __uint_as_float(da[j].y << 16); za[j].w += __uint_as_float(da[j].y & 0xffff0000u);
                zb[j].x += __uint_as_float(db[j].x << 16); zb[j].y += __uint_as_float(db[j].x & 0xffff0000u); zb[j].z += __uint_as_float(db[j].y << 16); zb[j].w += __uint_as_float(db[j].y & 0xffff0000u); }
#pragma unroll
            for (int j = 0; j < 8; ++j) { const float4 w = wl4[lane + 64 * j];
                uint2 o; o.x = cvtpk_(za[j].x * rs0 * w.x, za[j].y * rs0 * w.y); o.y = cvtpk_(za[j].z * rs0 * w.z, za[j].w * rs0 * w.w);
                ((uint2*)(P->HN + (size_t)(tok0 + tk) * DM))[lane + 64 * j] = o;
                o.x = cvtpk_(zb[j].x * rs1 * w.x, zb[j].y * rs1 * w.y); o.y = cvtpk_(zb[j].z * rs1 * w.z, zb[j].w * rs1 * w.w);
                ((uint2*)(P->HN + (size_t)(tok0 + tk + 1) * DM))[lane + 64 * j] = o; } }
        __syncthreads();
    }
}
}
__device__ __forceinline__ void ph_combine_norm(KP P, char* lds, int layer) {
    int* base = (int*)lds;
    const int tid = tid_(), lane = tid & 63, gw = bid_() * 8 + (tid >> 6), NGW = gridDim.x * 8;
    if (tid < 64) base[64 + tid] = P->cnt[tid * CSTR];
    __syncthreads();
    if (tid < 64) { int a = 0; for (int q = 0; q < tid; ++q) a += base[64 + q]; base[tid] = a; }
    __syncthreads();
    for (int t0 = gw; t0 < TOK; t0 += 2 * NGW) {
        int r0[2], r1[2]; float g0[2], g1[2]; bool ok[2]; int tcs[2];
        int2 ex[2], sl[2]; float2 gg[2];
        float4 v[2][8]; uint2 ya[2][8], yb[2][8], dl[2][8];
#pragma unroll
        for (int q = 0; q < 2; ++q) { const int t = t0 + q * NGW; ok[q] = t < TOK && !(layer == 1 && (t % LL) < NMETA); tcs[q] = ok[q] ? t : (layer == 1 ? NMETA : t0);
            ex[q] = ((const int2*)P->ridx)[tcs[q]]; sl[q] = ((const int2*)P->rslot)[tcs[q]]; gg[q] = ((const float2*)P->rgate)[tcs[q]];
#pragma unroll
            for (int j = 0; j < 8; ++j) { v[q][j] = ((const float4*)(P->Z + (size_t)tcs[q] * DM))[lane + 64 * j]; dl[q][j] = ((const uint2*)(P->DLT + (size_t)tcs[q] * DM))[lane + 64 * j]; } }
#pragma unroll
        for (int q = 0; q < 2; ++q) { r0[q] = base[ex[q].x] + sl[q].x; r1[q] = base[ex[q].y] + sl[q].y; g0[q] = gg[q].x; g1[q] = gg[q].y;
#pragma unroll
            for (int j = 0; j < 8; ++j) { ya[q][j] = ((const uint2*)(P->Y + (size_t)r0[q] * DM))[lane + 64 * j]; yb[q][j] = ((const uint2*)(P->Y + (size_t)r1[q] * DM))[lane + 64 * j]; } }
#pragma unroll
        for (int q = 0; q < 2; ++q) if (ok[q]) { const int t = t0 + q * NGW;
            float ss = 0.f;
#pragma unroll
            for (int j = 0; j < 8; ++j) { const uint2 a = ya[q][j], b = yb[q][j], d = dl[q][j]; float4& x = v[q][j];
                x.x += __uint_as_float(d.x << 16); x.y += __uint_as_float(d.x & 0xffff0000u); x.z += __uint_as_float(d.y << 16); x.w += __uint_as_float(d.y & 0xffff0000u);
                x.x += g0[q] * __uint_as_float(a.x << 16) + g1[q] * __uint_as_float(b.x << 16); x.y += g0[q] * __uint_as_float(a.x & 0xffff0000u) + g1[q] * __uint_as_float(b.x & 0xffff0000u);
                x.z += g0[q] * __uint_as_float(a.y << 16) + g1[q] * __uint_as_float(b.y << 16); x.w += g0[q] * __uint_as_float(a.y & 0xffff0000u) + g1[q] * __uint_as_float(b.y & 0xffff0000u);
                ss += x.x * x.x + x.y * x.y + x.z * x.z + x.w * x.w; }
            const float rs = rsqrtf(wave_sum(ss) * (1.f / DM) + EPS);
            if (layer == 0) {
#pragma unroll
                for (int j = 0; j < 8; ++j) { ((float4*)(P->Z + (size_t)t * DM))[lane + 64 * j] = v[q][j];
                    const float4 w = ((const float4*)(P->ln1_w + DM))[lane + 64 * j];
                    uint2 o; o.x = cvtpk_(v[q][j].x * rs * w.x, v[q][j].y * rs * w.y); o.y = cvtpk_(v[q][j].z * rs * w.z, v[q][j].w * rs * w.w);
                    ((uint2*)(P->HN + (size_t)t * DM))[lane + 64 * j] = o; }
            } else {
                const int b = t / LL, tt = t % LL;
                if (tt >= NMETA) {
#pragma unroll
                    for (int j = 0; j < 8; ++j) { const float4 w = ((const float4*)P->fnw)[lane + 64 * j];
                        ((float4*)(P->out + ((size_t)b * SEQ + (tt - NMETA)) * DM))[lane + 64 * j] = make_float4(v[q][j].x * rs * w.x, v[q][j].y * rs * w.y, v[q][j].z * rs * w.z, v[q][j].w * rs * w.w); }
                }
            }
        }
    }
    __syncthreads();
}

__global__ void __launch_bounds__(NTHR, 2) mega_fwd(Params P_arg) {
    extern __shared__ __attribute__((aligned(16))) char lds[];
    const int tid = tid_(), G = gridDim.x;
    volatile LAS unsigned* ctlw = (volatile LAS unsigned*)((LAS char*)lds + LDS_CTL);
    if (tid < 64) ctlw[tid] = 0u;
    __syncthreads();
    KP P = kp_();
    XcdBarrier bar = xcd_barrier_post(P->bar, ctlw + 8);
#define GRID_BAR() do { xcd_barrier(bar); P = kp_(); } while (0)

    ph_build_norm(P);
    ph_prep(P);
    ph_weights(P, lds);
    __syncthreads();
    for (int un = bid_(); un < 64; un += G) s5::prep_unit(P, lds, un >> 5, un & 31);
    GRID_BAR();
#pragma unroll
    for (int layer = 0; layer < 2; ++layer) {
        { pg8::Gemm g{P->HN, P->WinT + (size_t)layer * INW * DM, MP, INW, DM, DM}; pg8::StaticOrder S; S.init(MP, INW, G, bid_(), DM / 64); pg8::EpiInProj E{P->PA, P->QKV};
          pg8::gemm_phase<pg8::EpiInProj, pg8::StaticOrder, true, true>((LAS unsigned char*)lds, g, S, E); }
        { const int t2 = tid_(), b2 = bid_(); if (b2 == 0 && t2 < NE) P->cnt[t2 * CSTR] = 0;
 }
        GRID_BAR();
        hg::local_states(P, lds, layer);
        { const int b0 = bid_(); for (int un = (G == 256) ? ((b0 + 128) & 255) : b0; un < 128; un += G) s5::fused_unit(P, lds, layer, un >> 5, un & 31); }
        ph_attention(P, lds);
        GRID_BAR();
        hg::scan_states(P);
        ph_attn_out(P, layer, G > 192 ? 132 : 0);
        __syncthreads();
        { pg8::Gemm g{P->YG, P->WgluT + (size_t)layer * 1024 * 512, MP, 1024, 512, 512}; pg8::StaticOrder S; S.init(MP, 1024, G, bid_(), 512 / 64); pg8::EpiGlu E{P->MIX, P->b_glu + layer * 1024};
          pg8::gemm_phase<pg8::EpiGlu, pg8::StaticOrder, true, true>((LAS unsigned char*)lds, g, S, E); }
        GRID_BAR();
        hg::outputs(P, lds, layer);
        GRID_BAR();
        { pg8::Gemm g{P->MIX, P->WoutT + (size_t)layer * DM * DM, MP, DM, DM, DM}; pg8::StaticOrder S; S.init(MP, DM, G, bid_(), DM / 64); pg8::EpiResidual E{P->DLT};
          pg8::gemm_phase<pg8::EpiResidual, pg8::StaticOrder, true, true>((LAS unsigned char*)lds, g, S, E); }
        GRID_BAR();
        rt::norm_router(P, lds, layer);
        GRID_BAR();
        moe::stream_gemm<true>(P, lds, layer);
        GRID_BAR();
        moe::stream_gemm<false>(P, lds, layer);
        GRID_BAR();
        ph_combine_norm(P, lds, layer);
        if (layer == 0) GRID_BAR();
    }
}
}

extern "C" void kernel_launch(void* const* d_in, const int* in_sizes, int n_in, void* d_out, int out_size, void* d_ws, size_t ws_size, hipStream_t stream) {
    static int grid = 0;
    if (grid == 0) {
        int dev = 0, cus = 0;
        if (hipGetDevice(&dev) != hipSuccess || hipDeviceGetAttribute(&cus, hipDeviceAttributeMultiprocessorCount, dev) != hipSuccess) { grid = -1; return; }
        if (hipFuncSetAttribute((const void*)mega_fwd, hipFuncAttributeMaxDynamicSharedMemorySize, LDS_BYTES) != hipSuccess) { grid = -1; return; }
        int per_cu = 0;
        if (hipOccupancyMaxActiveBlocksPerMultiprocessor(&per_cu, (const void*)mega_fwd, NTHR, LDS_BYTES) != hipSuccess || per_cu < 1) { (void)hipGetLastError(); }
        grid = cus;
    }
    if (grid < 0) return;
    Params p{};
    const float** pin = (const float**)&p;
    for (int i = 0; i < 31; ++i) pin[i] = (const float*)d_in[i];
    p.out = (float*)d_out;
    char* ws = (char*)d_ws; size_t off = 0;
    auto alloc = [&](size_t bytes) { char* q = ws + off; off += (bytes + 255) & ~(size_t)255; return q; };
    p.bar = (unsigned*)alloc(XCD_BAR_WORDS * 4);
    p.elist = (int*)alloc((size_t)NE * ECAP * 4);
    p.cnt = (int*)alloc((size_t)NE * CSTR * 4); p.blk_e = (int*)alloc(1024); p.base = (int*)alloc(256);
    p.lbtab = (float*)alloc(1024 * 4); p.lam = (float*)alloc(256);
    p.Z = (float*)alloc((size_t)MP * DM * 4);
    p.HN = (bf16_t*)alloc((size_t)MP * DM * 2);
    p.PA = (float*)alloc((size_t)MP * PAW * 4);
    p.QKV = (bf16_t*)alloc((size_t)MP * QKVW * 2);
    p.OA = (float*)alloc((size_t)MP * HW * 4);
    p.ZP = (float*)alloc((size_t)8 * 256 * DM * 4);
    p.WRT = (bf16_t*)alloc((size_t)2 * 2 * 96 * DM * 2);
    p.A16 = (float*)alloc(2 * 32 * 64 * 8); p.S5E = (float*)alloc((size_t)516 * 32 * 128 * 4); p.S5X = (float*)alloc((size_t)516 * 32 * 128 * 4);
    p.BtY = (bf16_t*)alloc((size_t)2 * 32 * 256 * 384 * 2); p.BtE = (bf16_t*)alloc((size_t)2 * 32 * 128 * 256 * 2);
    p.SLOC = (float*)alloc((size_t)528 * 16384 * 4); p.DEC = (float*)alloc((size_t)528 * 128 * 4); p.SPREV = (bf16_t*)alloc((size_t)529 * 16384 * 2);
    p.YG = (bf16_t*)alloc((size_t)MP * 512 * 2); p.DLT = (bf16_t*)alloc((size_t)MP * DM * 2);
    p.T = nullptr;
    p.MIX = (bf16_t*)alloc((size_t)MP * DM * 2);
    p.OC = (float*)alloc((size_t)MP * DM * 4);
    p.ridx = (int*)alloc((size_t)NASSIGN * 4); p.rgate = (float*)alloc((size_t)NASSIGN * 4); p.rslot = (int*)alloc((size_t)NASSIGN * 4);
    p.tokrow = (int*)alloc((size_t)NASSIGN * 4); p.rowtok = (int*)alloc((size_t)NRMAX * 4);
    p.H1 = nullptr;
    p.H = (bf16_t*)alloc((size_t)NRMAX * DE * 2);
    p.Y = (bf16_t*)alloc((size_t)NRMAX * DM * 2);
    p.S = nullptr;
    p.WinT = (bf16_t*)alloc((size_t)2 * INW * DM * 2); p.WoutT = (bf16_t*)alloc((size_t)2 * DM * DM * 2); p.WgluT = (bf16_t*)alloc((size_t)2 * 1024 * 512 * 2);
    if (off > ws_size) return;
    if (hipMemsetAsync(p.bar, 0, XCD_BAR_WORDS * 4, stream) != hipSuccess) return;
    hipLaunchKernelGGL(mega_fwd, dim3(grid), dim3(NTHR), LDS_BYTES, stream, p);
}
```

```cpp
#include <hip/hip_runtime.h>
#include <stdint.h>
#include <math.h>

namespace {
typedef unsigned short bf16_t;
constexpr int DM = 2048, NB = 4, SEQ = 2048, NMETA = 16, LL = SEQ + NMETA, TOK = NB * LL, MP = 8448;
constexpr int HW = 512;
constexpr int INW = 5632, PAW = 2560, QKVW = 3072;
constexpr int NE = 64, DE = 512, NASSIGN = TOK * 2;
constexpr int RB = 128;
constexpr int NRMAX = NASSIGN + NE * RB;
constexpr float EPS = 1e-6f;
constexpr int NTHR = 512;
constexpr int CSTR = 64;
constexpr int ECAP = 1024;
constexpr int LDS_BYTES = 147456;
constexpr int LDS_CTL = 143360;

__device__ __forceinline__ float bf2f(bf16_t h) { return __uint_as_float(((unsigned)h) << 16); }
__device__ __forceinline__ bf16_t f2bf(float f) { unsigned u = __float_as_uint(f); return (bf16_t)((u + 0x7fffu + ((u >> 16) & 1u)) >> 16); }
__device__ __forceinline__ float sigmoidf_(float x) { return 1.f / (1.f + expf(-x)); }
__device__ __forceinline__ int tid_() { int t = threadIdx.x; asm volatile("" : "+v"(t)); return t; }
template <int K> __device__ __forceinline__ float swz_xor(float v) { return __int_as_float(__builtin_amdgcn_ds_swizzle(__float_as_int(v), (K << 10) | 0x1f)); }
__device__ __forceinline__ int bid_() { int b = blockIdx.x; asm volatile("" : "+s"(b)); return b; }

#define XB_TMO      128
#define XB_XCNT(j)  (256  + 64 * (j))
#define XB_XSUB(j)  (1280 + 64 * (j))
#define XB_XGEN(j)  (2304 + 64 * (j))
#define XB_TOP      3328
#define XB_TOPGEN   3392
#define XCD_BAR_WORDS 3456
#define XB_SPIN_CAP (1u << 24)
#define LAS __attribute__((address_space(3)))
__device__ __forceinline__ unsigned xb_ld(unsigned* p)              { return __hip_atomic_load(p, __ATOMIC_RELAXED, __HIP_MEMORY_SCOPE_AGENT); }
__device__ __forceinline__ unsigned xb_add(unsigned* p, unsigned v) { return __hip_atomic_fetch_add(p, v, __ATOMIC_RELAXED, __HIP_MEMORY_SCOPE_AGENT); }
__device__ __forceinline__ unsigned xb_xcc_id() { return (unsigned)__builtin_amdgcn_s_getreg((3 << 11) | 20) & 0xFu; }
#define XB_SPIN(cond, bar) do { unsigned _sp = 0; while (cond) { __builtin_amdgcn_s_sleep(1); \
    if ((++_sp & 255u) == 0u) { if (xb_ld(&(bar)[XB_TMO])) break; if (_sp > XB_SPIN_CAP) { atomicAdd(&(bar)[XB_TMO], 1u); break; } } } } while (0)
struct XcdBarrier { unsigned* bar; unsigned x; volatile LAS unsigned* st; };
__device__ __forceinline__ XcdBarrier xcd_barrier_post(unsigned* bar, volatile LAS unsigned* st) {
    XcdBarrier b; b.bar = bar; b.x = xb_xcc_id(); b.st = st;
    if (threadIdx.x == 0) (void)xb_add(&bar[XB_XCNT(b.x)], 1u);
    return b;
}
__device__ __forceinline__ void xcd_barrier_complete(unsigned* bar, unsigned x, unsigned& nloc, unsigned& nx) {
    const unsigned G = gridDim.x * gridDim.y * gridDim.z;
    unsigned sum, cnt, mine, sp = 0u;
    for (;;) {
        sum = 0u; cnt = 0u; mine = 0u;
#pragma unroll
        for (unsigned j = 0; j < 16; ++j) { const unsigned c = xb_ld(&bar[XB_XCNT(j)]); sum += c; cnt += (c > 0u) ? 1u : 0u; mine = (j == x) ? c : mine; }
        if (sum == G) break;
        __builtin_amdgcn_s_sleep(1);
        if ((++sp & 255u) == 0u) { if (xb_ld(&bar[XB_TMO])) break; if (sp > XB_SPIN_CAP) { atomicAdd(&bar[XB_TMO], 1u); break; } }
    }
    nloc = mine > 0u ? mine : 1u; nx = cnt > 0u ? cnt : 1u;
}
__device__ __forceinline__ void xcd_barrier(const XcdBarrier& b) {
    asm volatile("s_waitcnt vmcnt(0)" ::: "memory");
    __syncthreads();
    if (threadIdx.x == 0) {
        unsigned* bar = b.bar;
        const unsigned bx_ = xb_xcc_id();
        __builtin_amdgcn_s_waitcnt(0);
        unsigned nloc = b.st[0], nx = b.st[1];
        if (nloc == 0u) { xcd_barrier_complete(bar, bx_, nloc, nx); b.st[0] = nloc; b.st[1] = nx; }
        const unsigned old = xb_add(&bar[XB_XSUB(bx_)], 1u);
        const unsigned gen = old / nloc;
        if (old + 1u == (gen + 1u) * nloc) {
            __builtin_amdgcn_fence(__ATOMIC_RELEASE, "agent");
            asm volatile("s_waitcnt vmcnt(0)" ::: "memory");
            const unsigned og = xb_add(&bar[XB_TOP], 1u);
            const unsigned tg = og / nx;
            if (og + 1u == (tg + 1u) * nx) xb_add(&bar[XB_TOPGEN], 1u);
            else XB_SPIN(xb_ld(&bar[XB_TOPGEN]) == tg, bar);
            __builtin_amdgcn_fence(__ATOMIC_ACQUIRE, "agent");
            xb_add(&bar[XB_XGEN(bx_)], 1u);
            asm volatile("s_waitcnt vmcnt(0)" ::: "memory");
        } else {
            XB_SPIN(xb_ld(&bar[XB_XGEN(bx_)]) == gen, bar);
            __builtin_amdgcn_fence(__ATOMIC_ACQUIRE, "agent");
            asm volatile("s_waitcnt vmcnt(0)" ::: "memory");
        }
    }
    __syncthreads();
}

struct Params {
    const float *x, *meta, *ln1_w, *w_in, *lbnd, *hnw, *a_re, *a_im, *b_re, *b_im, *c_re, *c_im, *s5d, *log_dt, *w_glu, *b_glu,
                *lq1, *lk1, *lq2, *lk2, *subln, *w_out, *ln2_w, *wrg, *brg, *wre, *bre, *w1, *w3, *w2, *fnw;
    float* out;
    unsigned* bar;
    int *cnt, *blk_e, *ridx, *rslot, *tokrow, *rowtok, *base, *elist;
    float *lbtab, *lam, *Z, *PA, *OA, *T, *OC, *rgate, *H1, *S, *SLOC, *DEC, *A16, *S5E, *S5X, *ZP, *ers, *rsn;
    bf16_t *HN, *QKV, *YG, *MIX, *H, *Y, *WinT, *WoutT, *WgluT, *SPREV, *BtY, *BtE, *WRT, *DLT;
};
typedef const __attribute__((address_space(4))) Params* KP;
__device__ __forceinline__ KP kp_() { KP p = (KP)__builtin_amdgcn_kernarg_segment_ptr(); asm volatile("" : "+s"(p)); return p; }


namespace pg8 {
#define PG8_LAS __attribute__((address_space(3)))
typedef short bf16x8 __attribute__((ext_vector_type(8)));
typedef float f32x4 __attribute__((ext_vector_type(4)));
typedef unsigned u32x4 __attribute__((ext_vector_type(4)));
constexpr int BM = 256, BK = 64, HALF = 128, HTB = HALF * BK * 2, STAGE_BYTES = 8 * HTB, NXCD = 8, WGM = 8;
__host__ __device__ __forceinline__ int lds_byte(int r, int c) { const int st = (r >> 4) * 2 + (c >> 5), rr = r & 15, cc = c & 31, ob = rr * 64 + cc * 2; return st * 1024 + (ob ^ (((ob >> 9) & 1) << 5)); }
__host__ __device__ __forceinline__ void stage_rc(int b, int& R, int& C) { const int st = b / 1024, sb = b % 1024, swz = sb ^ (((sb >> 9) & 1) << 5); R = (st >> 1) * 16 + swz / 64; C = (st & 1) * 32 + (swz % 64) / 2; }
__host__ __device__ __forceinline__ int perm32(int rho) { const int n = rho >> 4, i = rho & 15; return 8 * (i >> 2) + 4 * n + (i & 3); }
struct Unit { int pm, pn, ko, nt; };
struct Gemm { const bf16_t* A; const bf16_t* Bt; int M, N, K, ld; };
struct StaticOrder {
    static constexpr bool PER_UNIT_K = false;
    int nM, nN, nwg, G, c, nt;
    __host__ __device__ void init(int M, int N, int G_, int c_, int nt_) { nM = M / BM; nN = N / BM; nwg = nM * nN; G = G_; c = c_; nt = nt_; }
    __host__ __device__ bool next(int i, Unit& u) const {
        const long L = (long)i * G + c; if (L >= nwg) return false;
        int wgid = (int)L; { const int q = nwg / NXCD, r = nwg % NXCD, xcd = wgid % NXCD, off = wgid / NXCD; wgid = (xcd < r ? xcd * (q + 1) : r * (q + 1) + (xcd - r) * q) + off; }
        const int nig = WGM * nN, gid = wgid / nig, fm = gid * WGM, gsz = (nM - fm) < WGM ? (nM - fm) : WGM;
        u.pm = fm + ((wgid % nig) % gsz); u.pn = (wgid % nig) / gsz; u.ko = 0; u.nt = nt; return true;
    }
    __device__ __forceinline__ void a_ready(const Unit&) const {}
    __device__ __forceinline__ void done(const Unit&) const {}
};
__device__ __forceinline__ unsigned cvt_pk_bf16(float lo, float hi) { unsigned r; asm volatile("v_cvt_pk_bf16_f32 %0, %1, %2" : "=v"(r) : "v"(lo), "v"(hi)); return r; }

template <class Epi, class Sched, bool ALIGN_EPI = false, bool SP2 = false>
__device__ __forceinline__ void gemm_phase(PG8_LAS unsigned char* lds, const Gemm g, const Sched& S, const Epi& E) {
    const int tid = tid_(), wid = __builtin_amdgcn_readfirstlane(tid >> 6), lane = tid & 63, wr = wid >> 2, wc = wid & 3, fr = lane & 15, fq = lane >> 4;
    const int K = g.ld;
    unsigned voffA[2], voffB[2];
#pragma unroll
    for (int i = 0; i < 2; ++i) { int R, C; stage_rc(tid * 16 + i * 8192, R, C); const int Rb = Epi::PERM ? ((R & ~31) + perm32(R & 31)) : R;
        voffA[i] = (unsigned)(R * K + C) * 2u; voffB[i] = (unsigned)(Rb * K + C) * 2u; }
    const size_t kstep = (size_t)(BK * 2);
    const size_t hstep = (size_t)HALF * K * 2;
    const size_t tstep = 2 * hstep;
    const unsigned ldsw = (unsigned)wid * 1024u;
    const int aoff = lds_byte(wr * 64 + fr, fq * 8), boff = lds_byte(wc * 32 + fr, fq * 8);
#define PG8_SA(b, h) (((b) * 2 + (h)) * HTB)
#define PG8_SB(b, h) ((4 + (b) * 2 + (h)) * HTB)
#define PG8_STAGE(bufoff, gbase, voff) do { _Pragma("unroll") for (int _i = 0; _i < 2; ++_i) \
        __builtin_amdgcn_global_load_lds((const unsigned*)((const char*)(gbase) + (voff)[_i]), (PG8_LAS unsigned*)(lds + (bufoff) + ldsw + _i * 8192), 16, 0, 0); } while (0)
#define PG8_LDA(dst, b, h) do { _Pragma("unroll") for (int m = 0; m < 4; ++m) _Pragma("unroll") for (int k = 0; k < 2; ++k) dst[m][k] = *(const PG8_LAS bf16x8*)(lds + PG8_SA(b, h) + aoff + m * 2048 + k * 1024); } while (0)
#define PG8_LDB(dst, b, h) do { _Pragma("unroll") for (int n = 0; n < 2; ++n) _Pragma("unroll") for (int k = 0; k < 2; ++k) dst[n][k] = *(const PG8_LAS bf16x8*)(lds + PG8_SB(b, h) + boff + n * 2048 + k * 1024); } while (0)
#define PG8_MMA(ai, bj, At, Bt) do { __builtin_amdgcn_s_setprio(1); _Pragma("unroll") for (int m = 0; m < 4; ++m) _Pragma("unroll") for (int n = 0; n < 2; ++n) _Pragma("unroll") for (int k = 0; k < 2; ++k) \
        acc[ai][bj][m][n] = __builtin_amdgcn_mfma_f32_16x16x32_bf16(Bt[n][k], At[m][k], acc[ai][bj][m][n], 0, 0, 0); __builtin_amdgcn_s_setprio(0); } while (0)
#define PG8_WAIT_V(n) asm volatile("s_waitcnt vmcnt(" #n ")" ::: "memory")
#define PG8_WAIT_L(n) asm volatile("s_waitcnt lgkmcnt(" #n ")" ::: "memory")
#define PG8_BAR __builtin_amdgcn_s_barrier()
#define PG8_SCHED __builtin_amdgcn_sched_barrier(0)
    Unit cur, nxt; int ui = 0;
    if (!S.next(0, cur)) return;
    f32x4 acc[2][2][4][2];
#pragma unroll
    for (int a = 0; a < 2; ++a)
#pragma unroll
        for (int b = 0; b < 2; ++b)
#pragma unroll
            for (int m = 0; m < 4; ++m)
#pragma unroll
                for (int n = 0; n < 2; ++n) acc[a][b][m][n] = (f32x4){0.f, 0.f, 0.f, 0.f};
    bf16x8 At[4][2], B0[2][2], B1[2][2];
    const char* cA = (const char*)g.A + (size_t)cur.pm * tstep + (size_t)cur.ko * 2; const char* cB = (const char*)g.Bt + (size_t)cur.pn * tstep + (size_t)cur.ko * 2;
    S.a_ready(cur);
    if constexpr (SP2) {
        PG8_STAGE(PG8_SB(0, 0), cB, voffB); PG8_STAGE(PG8_SB(0, 1), cB + hstep, voffB); PG8_STAGE(PG8_SA(0, 0), cA, voffA); PG8_STAGE(PG8_SA(0, 1), cA + hstep, voffA);
        if (wr == 1) PG8_BAR;
        PG8_WAIT_V(2); PG8_BAR;
        PG8_STAGE(PG8_SB(1, 0), cB + kstep, voffB); PG8_STAGE(PG8_SA(1, 0), cA + kstep, voffA); PG8_STAGE(PG8_SB(1, 1), cB + hstep + kstep, voffB);
        PG8_WAIT_V(6); PG8_BAR;
    } else {
        PG8_STAGE(PG8_SB(0, 0), cB, voffB); PG8_STAGE(PG8_SA(0, 0), cA, voffA); PG8_STAGE(PG8_SB(0, 1), cB + hstep, voffB); PG8_STAGE(PG8_SA(0, 1), cA + hstep, voffA);
        if (wr == 1) PG8_BAR;
        PG8_WAIT_V(4); PG8_BAR;
        PG8_STAGE(PG8_SB(1, 0), cB + kstep, voffB); PG8_STAGE(PG8_SA(1, 0), cA + kstep, voffA); PG8_STAGE(PG8_SB(1, 1), cB + hstep + kstep, voffB);
        PG8_WAIT_V(6); PG8_BAR;
    }
    for (;;) {
        const bool has_next = S.next(ui + 1, nxt);
        const char* nA = has_next ? (const char*)g.A + (size_t)nxt.pm * tstep + (size_t)nxt.ko * 2 : cA; const char* nB = has_next ? (const char*)g.Bt + (size_t)nxt.pn * tstep + (size_t)nxt.ko * 2 : cB;
        const int nt = Sched::PER_UNIT_K ? cur.nt : g.K / BK;
        for (int t = 0; t < nt; t += 2) {
            const bool last = (t == nt - 2);
            const char* a1 = cA + (size_t)(t + 1) * kstep;
            const char* a2 = last ? nA : cA + (size_t)(t + 2) * kstep; const char* b2 = last ? nB : cB + (size_t)(t + 2) * kstep;
            const char* a3 = a2 + kstep; const char* b3 = b2 + kstep;
            if (last && has_next) S.a_ready(nxt);
            if constexpr (SP2) {
            PG8_LDB(B0, 0, 0); PG8_LDB(B1, 0, 1); PG8_SCHED; PG8_LDA(At, 0, 0); PG8_STAGE(PG8_SA(1, 1), a1 + hstep, voffA);
            PG8_WAIT_V(8); PG8_WAIT_L(0); PG8_BAR; PG8_MMA(0, 0, At, B0); PG8_MMA(0, 1, At, B1); PG8_BAR; PG8_SCHED;
            PG8_LDA(At, 0, 1); PG8_STAGE(PG8_SB(0, 0), b2, voffB); PG8_STAGE(PG8_SB(0, 1), b2 + hstep, voffB); PG8_STAGE(PG8_SA(0, 0), a2, voffA);
            PG8_WAIT_V(8); PG8_WAIT_L(0); PG8_BAR; PG8_MMA(1, 0, At, B0); PG8_MMA(1, 1, At, B1); PG8_BAR; PG8_SCHED;
            PG8_LDB(B0, 1, 0); PG8_LDB(B1, 1, 1); PG8_SCHED; PG8_LDA(At, 1, 0); PG8_STAGE(PG8_SA(0, 1), a2 + hstep, voffA);
            PG8_WAIT_V(8); PG8_WAIT_L(0); PG8_BAR; PG8_MMA(0, 0, At, B0); PG8_MMA(0, 1, At, B1); PG8_BAR; PG8_SCHED;
            PG8_LDA(At, 1, 1); PG8_STAGE(PG8_SB(1, 0), b3, voffB); PG8_STAGE(PG8_SB(1, 1), b3 + hstep, voffB); PG8_STAGE(PG8_SA(1, 0), a3, voffA);
            PG8_WAIT_V(8); PG8_WAIT_L(0); PG8_BAR; PG8_MMA(1, 0, At, B0); PG8_MMA(1, 1, At, B1); PG8_BAR; PG8_SCHED;
            } else {
            PG8_LDB(B0, 0, 0); PG8_SCHED; PG8_LDA(At, 0, 0); PG8_STAGE(PG8_SA(1, 1), a1 + hstep, voffA);
            PG8_WAIT_L(8); PG8_BAR; PG8_WAIT_L(0); PG8_MMA(0, 0, At, B0); PG8_BAR; PG8_SCHED;
            PG8_LDB(B1, 0, 1); PG8_STAGE(PG8_SB(0, 0), b2, voffB);
            PG8_BAR; PG8_WAIT_L(0); PG8_MMA(0, 1, At, B1); PG8_BAR;
            PG8_LDA(At, 0, 1); PG8_STAGE(PG8_SA(0, 0), a2, voffA);
            PG8_BAR; PG8_WAIT_L(0); PG8_MMA(1, 0, At, B0); PG8_BAR; PG8_SCHED;
            PG8_STAGE(PG8_SB(0, 1), b2 + hstep, voffB);
            PG8_WAIT_V(6); PG8_BAR; PG8_MMA(1, 1, At, B1); PG8_BAR;
            PG8_LDB(B0, 1, 0); PG8_SCHED; PG8_LDA(At, 1, 0); PG8_STAGE(PG8_SA(0, 1), a2 + hstep, voffA);
            PG8_WAIT_L(8); PG8_BAR; PG8_WAIT_L(0); PG8_MMA(0, 0, At, B0); PG8_BAR; PG8_SCHED;
            PG8_LDB(B1, 1, 1); PG8_STAGE(PG8_SB(1, 0), b3, voffB);
            PG8_BAR; PG8_WAIT_L(0); PG8_MMA(0, 1, At, B1); PG8_BAR;
            PG8_LDA(At, 1, 1); PG8_STAGE(PG8_SA(1, 0), a3, voffA);
            PG8_BAR; PG8_WAIT_L(0); PG8_MMA(1, 0, At, B0); PG8_BAR; PG8_SCHED;
            PG8_STAGE(PG8_SB(1, 1), b3 + hstep, voffB);
            PG8_WAIT_V(6); PG8_BAR; PG8_MMA(1, 1, At, B1); PG8_BAR;
            }
        }
        if constexpr (ALIGN_EPI) { if (wr == 0) PG8_BAR; }
        E(acc, cur, wr, wc, fr, fq);
        if (!has_next) break;
#pragma unroll
        for (int a = 0; a < 2; ++a)
#pragma unroll
            for (int b = 0; b < 2; ++b)
#pragma unroll
                for (int m = 0; m < 4; ++m)
#pragma unroll
                    for (int n = 0; n < 2; ++n) acc[a][b][m][n] = (f32x4){0.f, 0.f, 0.f, 0.f};
        cur = nxt; cA = nA; cB = nB; ++ui;
        if constexpr (ALIGN_EPI) { if (wr == 1) PG8_BAR; }
    }
    PG8_WAIT_V(0);
    if constexpr (!ALIGN_EPI) { if (wr == 0) PG8_BAR; }
    PG8_BAR;
#undef PG8_SA
#undef PG8_SB
#undef PG8_STAGE
#undef PG8_LDA
#undef PG8_LDB
#undef PG8_MMA
#undef PG8_WAIT_V
#undef PG8_WAIT_L
#undef PG8_BAR
#undef PG8_SCHED
}
struct EpiInProj {
    static constexpr bool PERM = true;
    float* PA; bf16_t* QKV;
    __device__ __forceinline__ void operator()(const f32x4 (&acc)[2][2][4][2], const Unit& u, int wr, int wc, int fr, int fq) const {
        const int row0 = u.pm * BM + wr * 64 + fr, colt = u.pn * BM + wc * 32 + 8 * fq;
        if (colt < PAW) {
#pragma unroll
            for (int ai = 0; ai < 2; ++ai)
#pragma unroll
                for (int m = 0; m < 4; ++m) { float* rp = PA + (size_t)(row0 + ai * HALF + m * 16) * PAW + colt;
#pragma unroll
                    for (int bj = 0; bj < 2; ++bj) { *(f32x4*)(rp + bj * HALF) = acc[ai][bj][m][0]; *(f32x4*)(rp + bj * HALF + 4) = acc[ai][bj][m][1]; } }
        } else {
#pragma unroll
            for (int ai = 0; ai < 2; ++ai)
#pragma unroll
                for (int m = 0; m < 4; ++m) { bf16_t* rp = QKV + (size_t)(row0 + ai * HALF + m * 16) * QKVW + (colt - PAW);
#pragma unroll
                    for (int bj = 0; bj < 2; ++bj) { const f32x4 v0 = acc[ai][bj][m][0], v1 = acc[ai][bj][m][1];
                        u32x4 w; w.x = cvt_pk_bf16(v0[0], v0[1]); w.y = cvt_pk_bf16(v0[2], v0[3]); w.z = cvt_pk_bf16(v1[0], v1[1]); w.w = cvt_pk_bf16(v1[2], v1[3]);
                        *(u32x4*)(rp + bj * HALF) = w; } }
        }
    }
};
struct EpiResidual {
    static constexpr bool PERM = true;
    bf16_t* D;
    __device__ __forceinline__ void operator()(const f32x4 (&acc)[2][2][4][2], const Unit& u, int wr, int wc, int fr, int fq) const {
        const int row0 = u.pm * BM + wr * 64 + fr, colt = u.pn * BM + wc * 32 + 8 * fq;
#pragma unroll
        for (int ai = 0; ai < 2; ++ai)
#pragma unroll
            for (int m = 0; m < 4; ++m) { const int row = row0 + ai * HALF + m * 16; if (row < TOK) { bf16_t* rp = D + (size_t)row * DM + colt;
#pragma unroll
                for (int bj = 0; bj < 2; ++bj) { const f32x4 v0 = acc[ai][bj][m][0], v1 = acc[ai][bj][m][1];
                    u32x4 w; w.x = cvt_pk_bf16(v0[0], v0[1]); w.y = cvt_pk_bf16(v0[2], v0[3]); w.z = cvt_pk_bf16(v1[0], v1[1]); w.w = cvt_pk_bf16(v1[2], v1[3]);
                    *(u32x4*)(rp + bj * HALF) = w; } } }
    }
};
struct OutOrder {
    static constexpr bool PER_UNIT_K = true;
    StaticOrder main;
    __device__ bool next(int i, Unit& u) const {
        if (main.next(i, u)) return true;
        const int r0 = (main.nwg + main.G - 1) / main.G;
        const int L = (i - r0) * main.G + main.c; if (i < r0 || L >= 64) return false;
        u.pm = 32; u.pn = L & 7; u.ko = (L >> 3) * 256; u.nt = 4; return true; }
    __device__ __forceinline__ void a_ready(const Unit&) const {}
    __device__ __forceinline__ void done(const Unit&) const {}
};
struct EpiOutProj {
    static constexpr bool PERM = true;
    float* Z; float* ZP;
    __device__ __forceinline__ void operator()(const f32x4 (&acc)[2][2][4][2], const Unit& u, int wr, int wc, int fr, int fq) const {
        const bool tail = u.pm == 32;
        const int row0 = (tail ? (u.ko >> 8) * BM : u.pm * BM) + wr * 64 + fr, colt = u.pn * BM + wc * 32 + 8 * fq;
        float* base = tail ? ZP : Z;
#pragma unroll
        for (int ai = 0; ai < 2; ++ai)
#pragma unroll
            for (int m = 0; m < 4; ++m) { float* rp = base + (size_t)(row0 + ai * HALF + m * 16) * DM + colt;
#pragma unroll
                for (int bj = 0; bj < 2; ++bj) { f32x4* p0 = (f32x4*)(rp + bj * HALF); f32x4* p1 = (f32x4*)(rp + bj * HALF + 4);
                    f32x4 z0 = {0.f, 0.f, 0.f, 0.f}, z1 = {0.f, 0.f, 0.f, 0.f};
                    if (!tail) { z0 = *p0; z1 = *p1; }
                    *p0 = z0 + acc[ai][bj][m][0]; *p1 = z1 + acc[ai][bj][m][1]; } }
    }
};
struct TailOrder {
    static constexpr bool PER_UNIT_K = false;
    int G, c;
    __device__ bool next(int i, Unit& u) const { const int L = i * G + c; if (L >= 64) return false; u.pm = 32; u.pn = L & 7; u.ko = (L >> 3) * 256; u.nt = 4; return true; }
    __device__ __forceinline__ void a_ready(const Unit&) const {}
    __device__ __forceinline__ void done(const Unit&) const {}
};
struct EpiTailPartial {
    static constexpr bool PERM = true;
    float* ZP;
    __device__ __forceinline__ void operator()(const f32x4 (&acc)[2][2][4][2], const Unit& u, int wr, int wc, int fr, int fq) const {
        const int row0 = (u.ko >> 8) * BM + wr * 64 + fr, colt = u.pn * BM + wc * 32 + 8 * fq;
#pragma unroll
        for (int ai = 0; ai < 2; ++ai)
#pragma unroll
            for (int m = 0; m < 4; ++m) { float* rp = ZP + (size_t)(row0 + ai * HALF + m * 16) * DM + colt;
#pragma unroll
                for (int bj = 0; bj < 2; ++bj) { *(f32x4*)(rp + bj * HALF) = acc[ai][bj][m][0]; *(f32x4*)(rp + bj * HALF + 4) = acc[ai][bj][m][1]; } }
    }
};
struct EpiGlu {
    static constexpr bool PERM = true;
    bf16_t* MIX; const float* bias;
    __device__ __forceinline__ void operator()(const f32x4 (&acc)[2][2][4][2], const Unit& u, int wr, int wc, int fr, int fq) const {
        const int row0 = u.pm * BM + wr * 64 + fr, c0 = u.pn * HALF + wc * 32 + 8 * fq;
        const f32x4 bv0 = *(const f32x4*)(bias + c0), bv1 = *(const f32x4*)(bias + c0 + 4), bg0 = *(const f32x4*)(bias + 512 + c0), bg1 = *(const f32x4*)(bias + 512 + c0 + 4);
        float one = 1.f; asm volatile("" : "+v"(one));
#pragma unroll
        for (int ai = 0; ai < 2; ++ai)
#pragma unroll
            for (int m = 0; m < 4; ++m) { const f32x4 v0 = acc[ai][0][m][0] + bv0, v1 = acc[ai][0][m][1] + bv1, g0 = acc[ai][1][m][0] + bg0, g1 = acc[ai][1][m][1] + bg1;
                float o[8];
#pragma unroll
                for (int e = 0; e < 4; ++e) { o[e] = v0[e] * __builtin_amdgcn_rcpf(one + __expf(-g0[e])); o[4 + e] = v1[e] * __builtin_amdgcn_rcpf(one + __expf(-g1[e])); }
                u32x4 w; w.x = cvt_pk_bf16(o[0], o[1]); w.y = cvt_pk_bf16(o[2], o[3]); w.z = cvt_pk_bf16(o[4], o[5]); w.w = cvt_pk_bf16(o[6], o[7]);
                *(u32x4*)(MIX + (size_t)(row0 + ai * HALF + m * 16) * DM + 512 + c0) = w; }
    }
};
}

__device__ __forceinline__ void transpose_item(const float* W, int K, int N, bf16_t* WT, int k0, int n0, int row0, float* scr, int lane) {
    float tv[32];
#pragma unroll
    for (int i = 0; i < 32; ++i) { const int kk = 2 * i + (lane >> 5); tv[i] = W[(size_t)(k0 + kk) * N + n0 + (lane & 31)]; }
#pragma unroll
    for (int i = 0; i < 32; ++i) { const int kk = 2 * i + (lane >> 5); scr[kk * 33 + (lane & 31)] = tv[i]; }
    asm volatile("s_waitcnt lgkmcnt(0)" ::: "memory");
    const int c = lane & 7;
#pragma unroll
    for (int j = 0; j < 4; ++j) { const int n = (lane >> 3) + 8 * j; const float* sp = scr + (8 * c) * 33 + n;
        pg8::u32x4 o; o.x = pg8::cvt_pk_bf16(sp[0 * 33], sp[1 * 33]); o.y = pg8::cvt_pk_bf16(sp[2 * 33], sp[3 * 33]); o.z = pg8::cvt_pk_bf16(sp[4 * 33], sp[5 * 33]); o.w = pg8::cvt_pk_bf16(sp[6 * 33], sp[7 * 33]);
        *(pg8::u32x4*)(WT + (size_t)(row0 + n) * K + k0 + 8 * c) = o; }
    asm volatile("s_waitcnt lgkmcnt(0)" ::: "memory");
}
__device__ __forceinline__ void ph_weights(KP P, char* lds) {
    const int tid = tid_(), lane = tid & 63, wave = tid >> 6;
    float* scr = (float*)lds + wave * (64 * 33);
    const int cu0 = gridDim.x == 256 ? 64 : 0, gw = (bid_() - cu0) * 8 + wave, NGW = (gridDim.x - cu0) * 8;
    if (gw < 0) return;
    constexpr int I_IN = (DM / 64) * (INW / 32), I_OUT = (DM / 64) * (DM / 32), I_GLU = (512 / 64) * (1024 / 32), I_L = I_IN + I_OUT + I_GLU;
    for (int it = gw; it < 2 * I_L; it += NGW) {
        const int layer = it / I_L; int r = it % I_L;
        if (r < I_IN) { const int nb = INW / 32, kb = r / nb, n0 = (r % nb) * 32;
            transpose_item(P->w_in + (size_t)layer * DM * INW, DM, INW, P->WinT + (size_t)layer * INW * DM, kb * 64, n0, n0, scr, lane); continue; }
        r -= I_IN;
        if (r < I_OUT) { const int nb = DM / 32, kb = r / nb, n0 = (r % nb) * 32;
            transpose_item(P->w_out + (size_t)layer * DM * DM, DM, DM, P->WoutT + (size_t)layer * DM * DM, kb * 64, n0, n0, scr, lane); continue; }
        r -= I_OUT;
        { const int nb = 1024 / 32, kb = r / nb, n0 = (r % nb) * 32;
          const int row0 = ((n0 & 511) >> 7) * 256 + (n0 >> 9) * 128 + (n0 & 127);
          transpose_item(P->w_glu + (size_t)layer * 512 * 1024, 512, 1024, P->WgluT + (size_t)layer * 1024 * 512, kb * 64, n0, row0, scr, lane); }
    }
}


namespace fa {
using bf16x8 = __attribute__((ext_vector_type(8))) short;
using s16x4  = __attribute__((ext_vector_type(4))) short;
using f32x16 = __attribute__((ext_vector_type(16))) float;
using u32x4  = __attribute__((ext_vector_type(4))) unsigned;
constexpr int D = 128, NW = 8, QBLK = 32, KVBLK = 64, LDQK = QKVW;
constexpr float SCALE = 0.088388347648318440f, THR = 8.f, NEG = -1e30f;
constexpr size_t SHM_V = KVBLK * D * 2, SHM_K = KVBLK * D * 2, SHM_ATTN = 2 * SHM_V + 2 * SHM_K + NW * 64 * 4;
#define KSWZ(row, colB) ((row) * 256 + ((colB) ^ (((row) & 7) << 4)))
#define SBAR() __builtin_amdgcn_sched_barrier(0)
__device__ __forceinline__ int crow(int r, int hi) { return (r & 3) + 8 * (r >> 2) + 4 * hi; }
__device__ __forceinline__ unsigned cvtpk(float lo, float hi) { unsigned r; asm volatile("v_cvt_pk_bf16_f32 %0, %1, %2" : "=v"(r) : "v"(lo), "v"(hi)); return r; }
__device__ __forceinline__ void partialSM(f32x16& p0, f32x16& p1, float& m_reg, float& mn, float& alpha) {
  constexpr float C = SCALE * 1.4426950408889634f;
  float pmax = p0[0]; for (int r = 1; r < 16; ++r) pmax = fmaxf(pmax, p0[r]); for (int r = 0; r < 16; ++r) pmax = fmaxf(pmax, p1[r]);
  { auto rr = __builtin_amdgcn_permlane32_swap(__float_as_uint(pmax), __float_as_uint(pmax), false, false);
    pmax = fmaxf(__uint_as_float(rr[0]), __uint_as_float(rr[1])); }
  if (__builtin_expect(__all(pmax - m_reg <= THR / SCALE), 1)) { mn = m_reg; alpha = 1.f; }
  else { mn = fmaxf(m_reg, pmax); alpha = __builtin_amdgcn_exp2f((m_reg - mn) * C); m_reg = mn; }
  float mnC = -mn * C;
  for (int r = 0; r < 16; ++r) p0[r] = fmaf(p0[r], C, mnC); for (int r = 0; r < 16; ++r) p1[r] = fmaf(p1[r], C, mnC);
  for (int r = 0; r < 16; ++r) p0[r] = __builtin_amdgcn_exp2f(p0[r]);
}
__device__ __forceinline__ void finishSM(f32x16& p0, f32x16& p1, float alpha, float& l_reg, bf16x8& pa0, bf16x8& pa1, bf16x8& pa2, bf16x8& pa3) {
  for (int r = 0; r < 16; ++r) p1[r] = __builtin_amdgcn_exp2f(p1[r]);
  float ps = 0; for (int r = 0; r < 16; ++r) ps += p0[r]; for (int r = 0; r < 16; ++r) ps += p1[r];
  { auto rr = __builtin_amdgcn_permlane32_swap(__float_as_uint(ps), __float_as_uint(ps), false, false);
    ps = __uint_as_float(rr[0]) + __uint_as_float(rr[1]); }
  l_reg = l_reg * alpha + ps;
#define PK4(P, BASE, OUT) do { unsigned a0 = cvtpk(P[BASE + 0], P[BASE + 1]), a1 = cvtpk(P[BASE + 2], P[BASE + 3]);   \
    unsigned b0 = cvtpk(P[BASE + 4], P[BASE + 5]), b1 = cvtpk(P[BASE + 6], P[BASE + 7]);                              \
    auto r0 = __builtin_amdgcn_permlane32_swap(a0, b0, false, false); auto r1 = __builtin_amdgcn_permlane32_swap(a1, b1, false, false); \
    u32x4 w = {r0[0], r1[0], r0[1], r1[1]}; OUT = *reinterpret_cast<bf16x8*>(&w); } while (0)
  PK4(p0, 0, pa0); PK4(p0, 8, pa1); PK4(p1, 0, pa2); PK4(p1, 8, pa3);
#undef PK4
}
__device__ __forceinline__ void qkt(f32x16& p0, f32x16& p1, const bf16_t* Ks, const bf16x8* qr, int r32, int hi) {
  p0 = f32x16{}; p1 = f32x16{};
  for (int d0 = 0; d0 < 8; ++d0) { int cb = (d0 * 16 + hi * 8) * 2;
    bf16x8 b0 = *reinterpret_cast<const bf16x8*>((const char*)Ks + KSWZ(r32, cb));
    bf16x8 b1 = *reinterpret_cast<const bf16x8*>((const char*)Ks + KSWZ(32 + r32, cb));
    p0 = __builtin_amdgcn_mfma_f32_32x32x16_bf16(b0, qr[d0], p0, 0, 0, 0);
    p1 = __builtin_amdgcn_mfma_f32_32x32x16_bf16(b1, qr[d0], p1, 0, 0, 0); }
}
__device__ __forceinline__ void mask_tile(f32x16& p0, f32x16& p1, int kt, int vis) {
  if (kt > vis) {
    const bool part = (kt == vis + 1);
    for (int r = 0; r < 16; ++r) p1[r] = NEG;
    for (int r = 8; r < 16; ++r) p0[r] = NEG;
    if (!part) for (int r = 0; r < 8; ++r) p0[r] = NEG;
  }
}
__device__ __forceinline__ int v_st(int k, int c) { const int kk = (k & ~0xC) | ((k & 4) << 1) | ((k & 8) >> 1); return ((kk >> 3) * 4 + (c >> 5)) * 512 + ((kk & 7) * 32 + (c & 31)) * 2; }
__device__ __forceinline__ int v_rd_base(int lane) { return ((lane & 3) << 3) | (((lane >> 2) & 3) << 6) | (((lane >> 4) & 1) << 5) | (((lane >> 5) & 1) << 8); }
constexpr int v_rd_off(int d0, int ks, int half) { return d0 * 512 + ks * 4096 + half * 2048; }
template <int OFF> __device__ __forceinline__ s16x4 tr_read(int vb) {
  s16x4 r; asm volatile("ds_read_b64_tr_b16 %0, %1 offset:%2" : "=&v"(r) : "v"(vb), "i"(OFF) : "memory"); return r;
}
template <int D0> __device__ __forceinline__ void pv_one(f32x16& od, int vb, bf16x8 pa0, bf16x8 pa1, bf16x8 pa2, bf16x8 pa3) {
  const s16x4 l0 = tr_read<v_rd_off(D0, 0, 0)>(vb), h0 = tr_read<v_rd_off(D0, 0, 1)>(vb), l1 = tr_read<v_rd_off(D0, 1, 0)>(vb), h1 = tr_read<v_rd_off(D0, 1, 1)>(vb);
  const s16x4 l2 = tr_read<v_rd_off(D0, 2, 0)>(vb), h2 = tr_read<v_rd_off(D0, 2, 1)>(vb), l3 = tr_read<v_rd_off(D0, 3, 0)>(vb), h3 = tr_read<v_rd_off(D0, 3, 1)>(vb);
  asm volatile("s_waitcnt lgkmcnt(0)" ::: "memory"); SBAR();
#define PK(L, H) (bf16x8){L[0], L[1], L[2], L[3], H[0], H[1], H[2], H[3]}
  od = __builtin_amdgcn_mfma_f32_32x32x16_bf16(pa0, PK(l0, h0), od, 0, 0, 0);
  od = __builtin_amdgcn_mfma_f32_32x32x16_bf16(pa1, PK(l1, h1), od, 0, 0, 0);
  od = __builtin_amdgcn_mfma_f32_32x32x16_bf16(pa2, PK(l2, h2), od, 0, 0, 0);
  od = __builtin_amdgcn_mfma_f32_32x32x16_bf16(pa3, PK(l3, h3), od, 0, 0, 0);
#undef PK
}
__device__ __forceinline__ void pv_d0(f32x16* o, int vb, bf16x8 pa0, bf16x8 pa1, bf16x8 pa2, bf16x8 pa3) {
  pv_one<0>(o[0], vb, pa0, pa1, pa2, pa3); pv_one<1>(o[1], vb, pa0, pa1, pa2, pa3); pv_one<2>(o[2], vb, pa0, pa1, pa2, pa3); pv_one<3>(o[3], vb, pa0, pa1, pa2, pa3);
}
__device__ __forceinline__ void attn_unit(const bf16_t* __restrict__ Qb, const bf16_t* __restrict__ Kh, const bf16_t* __restrict__ Vh, float* __restrict__ Ob, int NT, int vis4, char* lds) {
  const int tid = tid_(), wid = tid >> 6, lane = tid & 63, r32 = lane & 31, hi = lane >> 5;
  const int vis = vis4 + (wid >> 1);
  bf16_t* V_lds = (bf16_t*)lds; bf16_t* K_lds = (bf16_t*)(lds + 2 * SHM_V);
  float* ws = (float*)(lds + 2 * SHM_V + 2 * SHM_K) + wid * 64; float* li_l = ws; float* al_l = ws + 32;
  float m_reg = NEG, l_reg = 0; f32x16 o[4] = {}; bf16x8 qr[8];
  const bf16_t* Qw = Qb + (long)(wid * QBLK + r32) * LDQK + hi * 8;
#pragma unroll
  for (int d0 = 0; d0 < 8; ++d0) qr[d0] = *reinterpret_cast<const bf16x8*>(Qw + d0 * 16);
  const int sr = tid >> 4, sc = (tid & 15) * 8, vst0 = v_st(sr, sc), vst1 = v_st(32 + sr, sc);
  const int vb0 = (int)(uintptr_t)V_lds + v_rd_base(lane);
  struct { bf16x8 vs0, vs1, ks0, ks1; } sr_[2];
#define SLOAD(i, k0) do { sr_[i].vs0 = *reinterpret_cast<const bf16x8*>(&Vh[(long)((k0) + sr) * LDQK + sc]); sr_[i].vs1 = *reinterpret_cast<const bf16x8*>(&Vh[(long)((k0) + 32 + sr) * LDQK + sc]); \
    sr_[i].ks0 = *reinterpret_cast<const bf16x8*>(&Kh[(long)((k0) + sr) * LDQK + sc]); sr_[i].ks1 = *reinterpret_cast<const bf16x8*>(&Kh[(long)((k0) + 32 + sr) * LDQK + sc]); } while (0)
#define SWRITE(b, i) do { *(bf16x8*)((char*)V_lds + (b) * SHM_V + vst0) = sr_[i].vs0;          \
    *(bf16x8*)((char*)V_lds + (b) * SHM_V + vst1) = sr_[i].vs1; int kc = sc * 2;               \
    *(bf16x8*)((char*)K_lds + (b) * SHM_K + KSWZ(sr, kc)) = sr_[i].ks0;                       \
    *(bf16x8*)((char*)K_lds + (b) * SHM_K + KSWZ(32 + sr, kc)) = sr_[i].ks1; } while (0)
#define SWAIT() asm volatile("s_waitcnt vmcnt(4)" ::: "memory")
#define RESC(a) do { if (__any((a) < 1.f)) { if (hi == 0) al_l[r32] = (a); asm volatile("s_waitcnt lgkmcnt(0)" ::: "memory"); \
    for (int d = 0; d < 4; ++d) for (int r = 0; r < 16; ++r) o[d][r] *= al_l[crow(r, hi)]; } } while (0)
  f32x16 pA0, pA1, pB0, pB1; float mnA, mnB, alA, alB; bf16x8 pa0, pa1, pa2, pa3;
  constexpr int SE = 0, SO = 1;
  SLOAD(SE, 0); asm volatile("s_waitcnt vmcnt(0)" ::: "memory"); SWRITE(0, SE); __syncthreads();
  qkt(pA0, pA1, K_lds, qr, r32, hi); mask_tile(pA0, pA1, 0, vis); partialSM(pA0, pA1, m_reg, mnA, alA);
  SLOAD(SO, KVBLK); if (2 < NT) SLOAD(SE, 2 * KVBLK);
  SWAIT(); SWRITE(1, SO); __syncthreads();
  for (int j = 1; j + 1 < NT; j += 2) {
    SBAR(); qkt(pB0, pB1, (bf16_t*)((char*)K_lds + SHM_K), qr, r32, hi); mask_tile(pB0, pB1, j, vis);
    finishSM(pA0, pA1, alA, l_reg, pa0, pa1, pa2, pa3); SBAR();
    SLOAD(SO, (j + 2) * KVBLK); SBAR();
    pv_d0(o, vb0, pa0, pa1, pa2, pa3); partialSM(pB0, pB1, m_reg, mnB, alB);
    __syncthreads(); SWAIT(); SWRITE(0, SE);
    RESC(alB); __syncthreads();
    SBAR(); qkt(pA0, pA1, K_lds, qr, r32, hi); mask_tile(pA0, pA1, j + 1, vis);
    finishSM(pB0, pB1, alB, l_reg, pa0, pa1, pa2, pa3); SBAR();
    if (j + 3 < NT) SLOAD(SE, (j + 3) * KVBLK); SBAR();
    pv_d0(o, vb0 + (int)SHM_V, pa0, pa1, pa2, pa3); partialSM(pA0, pA1, m_reg, mnA, alA);
    __syncthreads(); SWAIT(); SWRITE(1, SO);
    RESC(alA); __syncthreads();
  }
  SBAR(); qkt(pB0, pB1, (bf16_t*)((char*)K_lds + SHM_K), qr, r32, hi); mask_tile(pB0, pB1, NT - 1, vis);
  finishSM(pA0, pA1, alA, l_reg, pa0, pa1, pa2, pa3); SBAR();
  pv_d0(o, vb0, pa0, pa1, pa2, pa3); partialSM(pB0, pB1, m_reg, mnB, alB);
  __syncthreads(); RESC(alB);
  finishSM(pB0, pB1, alB, l_reg, pa0, pa1, pa2, pa3); SBAR();
  pv_d0(o, vb0 + (int)SHM_V, pa0, pa1, pa2, pa3);
  if (hi == 0) li_l[r32] = l_reg; asm volatile("s_waitcnt lgkmcnt(0)" ::: "memory");
  float rli[16];
#pragma unroll
  for (int r = 0; r < 16; ++r) rli[r] = __builtin_amdgcn_rcpf(li_l[crow(r, hi)]);
  float* Ow = Ob + (long)(wid * QBLK) * DM;
#pragma unroll
  for (int r = 0; r < 16; ++r) { int orow = crow(r, hi);
    for (int d0 = 0; d0 < 4; ++d0) Ow[(long)orow * DM + d0 * 32 + r32] = o[d0][r] * rli[r]; }
  __syncthreads();
#undef SLOAD
#undef SWRITE
#undef SWAIT
#undef RESC
}
#undef KSWZ
#undef SBAR
}

__device__ __forceinline__ void ph_attention(KP P, char* lds) {
    const bf16_t* QKV = P->QKV; float* OC = P->OC;
#pragma unroll 1
    for (int c = bid_(); c < 256; c += gridDim.x) {
        const int combo = c >> 2, b = combo >> 4, h = (combo >> 2) & 3, i = (combo >> 1) & 1, vh = combo & 1;
        const bf16_t* Kh = QKV + (size_t)(b * LL) * QKVW + 1024 + h * 256 + i * 128;
        const bf16_t* Vh = QKV + (size_t)(b * LL) * QKVW + 2048 + h * 256 + vh * 128;
#pragma unroll 1
        for (int s = 0; s < 2; ++s) {
            const int jb = s == 0 ? (c & 3) : 7 - (c & 3);
            const size_t row0 = (size_t)(b * LL) + NMETA + 256 * jb;
            fa::attn_unit(QKV + row0 * QKVW + h * 256 + i * 128, Kh, Vh, OC + row0 * DM + h * 512 + i * 256 + vh * 128, 4 * jb + 6, 4 * jb, lds);
        }
    }
#pragma unroll 1
    for (int gw0 = bid_() * 8; gw0 < 512; gw0 += gridDim.x * 8) {
        const int tid = tid_(), lane = tid & 63, gw = gw0 + (tid >> 6);
        if (gw < 512) {
            const int b = gw >> 7, h = (gw >> 5) & 3, i = (gw >> 4) & 1, row = gw & 15;
            const bf16_t* q = QKV + (size_t)(b * LL + row) * QKVW + h * 256 + i * 128;
            const int key = lane & 15;
            const bf16_t* k = QKV + (size_t)(b * LL + key) * QKVW + 1024 + h * 256 + i * 128;
            float sc = 0.f;
            { pg8::u32x4 qv[16], kv[16];
#pragma unroll
              for (int c8 = 0; c8 < 16; ++c8) { qv[c8] = *(const pg8::u32x4*)(q + c8 * 8); kv[c8] = *(const pg8::u32x4*)(k + c8 * 8); }
#pragma unroll
              for (int c8 = 0; c8 < 16; ++c8)
#pragma unroll
                  for (int w2 = 0; w2 < 4; ++w2) { const unsigned a = qv[c8][w2], bq = kv[c8][w2];
                      sc = fmaf(__uint_as_float(a << 16), __uint_as_float(bq << 16), sc); sc = fmaf(__uint_as_float(a & 0xffff0000u), __uint_as_float(bq & 0xffff0000u), sc); } }
            sc *= 0.08838834764831845f;
            float m = sc;
            m = fmaxf(m, swz_xor<8>(m)); m = fmaxf(m, swz_xor<4>(m)); m = fmaxf(m, swz_xor<2>(m)); m = fmaxf(m, swz_xor<1>(m));
            const float e = expf(sc - m);
            float ssum = e;
            ssum += swz_xor<8>(ssum); ssum += swz_xor<4>(ssum); ssum += swz_xor<2>(ssum); ssum += swz_xor<1>(ssum);
            const float p = e / ssum;
            float acc[4] = {0.f, 0.f, 0.f, 0.f};
#pragma unroll
            for (int j = 0; j < 16; ++j) {
                const float pj = __int_as_float(__builtin_amdgcn_readlane(__float_as_int(p), j));
                const uint2 v2 = *(const uint2*)(QKV + (size_t)(b * LL + j) * QKVW + 2048 + h * 256 + lane * 4);
                acc[0] = fmaf(pj, __uint_as_float(v2.x << 16), acc[0]); acc[1] = fmaf(pj, __uint_as_float(v2.x & 0xffff0000u), acc[1]);
                acc[2] = fmaf(pj, __uint_as_float(v2.y << 16), acc[2]); acc[3] = fmaf(pj, __uint_as_float(v2.y & 0xffff0000u), acc[3]);
            }
            float* o = OC + (size_t)(b * LL + row) * DM + h * 512 + i * 256 + lane * 4;
            *(float4*)o = make_float4(acc[0], acc[1], acc[2], acc[3]);
        }
    }
}


namespace hg {
using bf16x8 = __attribute__((ext_vector_type(8))) short;
using s16x4  = __attribute__((ext_vector_type(4))) short;
using f32x16 = __attribute__((ext_vector_type(16))) float;
using u32x4  = __attribute__((ext_vector_type(4))) unsigned;
constexpr int NCH = 33, NU = 16 * NCH;
constexpr int SK = 136;
constexpr int SS = 72;
__device__ __forceinline__ int crow(int r, int hi) { return (r & 3) + 8 * (r >> 2) + 4 * hi; }
__device__ __forceinline__ unsigned cvtpk(float lo, float hi) { unsigned r; asm volatile("v_cvt_pk_bf16_f32 %0, %1, %2" : "=v"(r) : "v"(lo), "v"(hi)); return r; }

__device__ __forceinline__ void prep(const float (&fpv)[16], float lbv, int c, int k, int tq, float* qsum, float (&b)[16], float (&kk)[16], float& bend, float& r) {
    float run = 0.f;
#pragma unroll
    for (int i = 0; i < 16; ++i) {
        const int t = 16 * tq + i; const bool valid = (c * 64 + t) < LL;
        const float kv = valid ? (1.f - lbv) * __builtin_amdgcn_rcpf(1.f + __expf(fpv[i])) : 0.f;
        kk[i] = kv; run += fmaxf(__logf(1.f - kv), -30.f); b[i] = run;
    }
    qsum[tq * 128 + k] = run;
    __syncthreads();
    const float q0 = qsum[k], q1 = qsum[128 + k], q2 = qsum[256 + k], q3 = qsum[384 + k];
    const float off = tq == 0 ? 0.f : (tq == 1 ? q0 : (tq == 2 ? q0 + q1 : q0 + q1 + q2));
    r = q0 + q1; bend = (q0 + q1) + (q2 + q3);
#pragma unroll
    for (int i = 0; i < 16; ++i) b[i] += off;
}
__device__ __forceinline__ void store16(bf16_t* dst, const float (&x)[16]) {
    u32x4 w0, w1;
    w0.x = cvtpk(x[0], x[1]); w0.y = cvtpk(x[2], x[3]); w0.z = cvtpk(x[4], x[5]); w0.w = cvtpk(x[6], x[7]);
    w1.x = cvtpk(x[8], x[9]); w1.y = cvtpk(x[10], x[11]); w1.z = cvtpk(x[12], x[13]); w1.w = cvtpk(x[14], x[15]);
    *(u32x4*)dst = w0; *(u32x4*)(dst + 8) = w1;
}

__device__ __forceinline__ void local_states(KP P, char* lds, int layer) {
    bf16_t* KhT = (bf16_t*)lds; bf16_t* VT = KhT + 128 * SS; float* qsum = (float*)(VT + 128 * SS);
    const float* PA = P->PA; const float* lbtab = P->lbtab + layer * 512; float* SLOC = P->SLOC; float* DEC = P->DEC;
    const int tid = tid_(), k = tid & 127, tq = tid >> 7, lane = tid & 63, wid = tid >> 6, r32 = lane & 31, hh = lane >> 5;
    for (int u = bid_(); u < NU; u += gridDim.x) {
        const int bh = u / NCH, c = u % NCH, b_ = bh >> 2, h = bh & 3; const size_t row0 = (size_t)b_ * LL + c * 64;
        float fpv[16], vv[16];
#pragma unroll
        for (int i = 0; i < 16; ++i) { const int t = 16 * tq + i; const bool valid = (c * 64 + t) < LL; const float* rp = PA + (row0 + (valid ? t : 0)) * PAW + h * 128 + k;
            fpv[i] = rp[512]; vv[i] = valid ? rp[1024] : 0.f; }
        float b[16], kk[16], bend, r;
        prep(fpv, lbtab[h * 128 + k], c, k, tq, qsum, b, kk, bend, r);
        float x[16];
#pragma unroll
        for (int i = 0; i < 16; ++i) x[i] = kk[i] * __expf(bend - b[i]);
        store16(KhT + k * SS + 16 * tq, x);
        store16(VT + k * SS + 16 * tq, vv);
        if (tq == 0) DEC[u * 128 + k] = __expf(bend);
        __syncthreads();
        const int vt = wid >> 1;
#pragma unroll
        for (int j = 0; j < 2; ++j) {
            const int kt = (wid & 1) * 2 + j;
            f32x16 acc = {};
#pragma unroll
            for (int sg = 0; sg < 4; ++sg) {
                const bf16x8 a = *(const bf16x8*)(VT + (vt * 32 + r32) * SS + sg * 16 + hh * 8);
                const bf16x8 bb = *(const bf16x8*)(KhT + (kt * 32 + r32) * SS + sg * 16 + hh * 8);
                acc = __builtin_amdgcn_mfma_f32_32x32x16_bf16(a, bb, acc, 0, 0, 0);
            }
            float* o = SLOC + (size_t)u * 16384 + kt * 32 + r32;
#pragma unroll
            for (int rg = 0; rg < 16; ++rg) o[(vt * 32 + crow(rg, hh)) * 128] = acc[rg];
        }
        __syncthreads();
    }
}
__device__ __forceinline__ void scan_states(KP P) {
    const float* SLOC = P->SLOC; const float* DEC = P->DEC; bf16_t* SPREV = P->SPREV;
    const int tid = tid_();
    for (int e = bid_() * NTHR + tid; e < 16 * 16384; e += gridDim.x * NTHR) {
        const int bh = e >> 14, vk = e & 16383, k = vk & 127;
        float d[NCH - 1], x[NCH - 1];
#pragma unroll
        for (int c = 0; c < NCH - 1; ++c) { const int u = bh * NCH + c; d[c] = DEC[u * 128 + k]; x[c] = SLOC[(size_t)u * 16384 + vk]; }
        float S = 0.f;
#pragma unroll
        for (int c = 0; c < NCH - 1; ++c) { S = fmaf(d[c], S, x[c]); SPREV[(size_t)(bh * NCH + c + 1) * 16384 + vk] = f2bf(S); }
    }
}
__device__ __forceinline__ void outputs(KP P, char* lds, int layer) {
    bf16_t* Qt = (bf16_t*)lds; bf16_t* Qh = Qt + 64 * SK; bf16_t* Kt = Qh + 64 * SK; bf16_t* VT = Kt + 64 * SK; bf16_t* SpT = VT + 128 * SS;
    float* qsum = (float*)(SpT + 128 * SK); float* part = qsum + 512;
    const float* PA = P->PA; const float* lbtab = P->lbtab + layer * 512; const bf16_t* SPREV = P->SPREV; const float* nw = P->hnw + layer * 128; bf16_t* MIX = P->MIX;
    const int tid = tid_(), k = tid & 127, tq = tid >> 7, lane = tid & 63, wid = tid >> 6, r32 = lane & 31, hh = lane >> 5;
    for (int u = bid_(); u < NU; u += gridDim.x) {
        const int bh = u / NCH, c = u % NCH, b_ = bh >> 2, h = bh & 3; const size_t row0 = (size_t)b_ * LL + c * 64;
        const int tt = wid & 1, vt = wid >> 1;
        float fpv[16], qv[16], vv[16]; u32x4 sp[4]; float4 gv[4];
#pragma unroll
        for (int i = 0; i < 16; ++i) { const int t = 16 * tq + i; const bool valid = (c * 64 + t) < LL; const float* rp = PA + (row0 + (valid ? t : 0)) * PAW + h * 128 + k;
            fpv[i] = rp[512]; qv[i] = valid ? rp[0] : 0.f; vv[i] = valid ? rp[1024] : 0.f; }
#pragma unroll
        for (int j = 0; j < 4; ++j) { const int idx = tid + 512 * j, v = idx >> 4, ch = idx & 15; sp[j] = *(const u32x4*)(SPREV + (size_t)(c > 0 ? u : u + 1) * 16384 + v * 128 + ch * 8); }
        { const int te = tt * 32 + r32; const float* gp = PA + (row0 + ((c * 64 + te) < LL ? te : 0)) * PAW + 1536 + h * 128 + vt * 32 + 4 * hh;
#pragma unroll
          for (int g4 = 0; g4 < 4; ++g4) gv[g4] = *(const float4*)(gp + 8 * g4); }
        float b[16], kk[16], bend, r;
        prep(fpv, lbtab[h * 128 + k], c, k, tq, qsum, b, kk, bend, r);
#pragma unroll
        for (int i = 0; i < 16; ++i) { const int t = 16 * tq + i; const float q = qv[i];
            Qt[t * SK + k] = f2bf(q * __expf(b[i] - r)); Qh[t * SK + k] = f2bf(q * __expf(b[i])); Kt[t * SK + k] = f2bf(kk[i] * __expf(r - b[i])); }
        store16(VT + k * SS + 16 * tq, vv);
        if (c > 0) {
#pragma unroll
            for (int j = 0; j < 4; ++j) { const int idx = tid + 512 * j, v = idx >> 4, ch = idx & 15; *(u32x4*)(SpT + v * SK + ch * 8) = sp[j]; }
        }
        __syncthreads();
        f32x16 oacc = {};
#pragma unroll
        for (int st = 0; st < 2; ++st) {
            if (st <= tt) {
                f32x16 sc = {};
#pragma unroll
                for (int d0 = 0; d0 < 8; ++d0) {
                    const bf16x8 a = *(const bf16x8*)(Kt + (st * 32 + r32) * SK + d0 * 16 + hh * 8);
                    const bf16x8 bq = *(const bf16x8*)(Qt + (tt * 32 + r32) * SK + d0 * 16 + hh * 8);
                    sc = __builtin_amdgcn_mfma_f32_32x32x16_bf16(a, bq, sc, 0, 0, 0);
                }
                if (st == tt) {
#pragma unroll
                    for (int rg = 0; rg < 16; ++rg) sc[rg] = (crow(rg, hh) <= r32) ? sc[rg] : 0.f;
                }
#pragma unroll
                for (int g = 0; g < 2; ++g) {
                    u32x4 w; w.x = cvtpk(sc[8 * g + 0], sc[8 * g + 1]); w.y = cvtpk(sc[8 * g + 2], sc[8 * g + 3]); w.z = cvtpk(sc[8 * g + 4], sc[8 * g + 5]); w.w = cvtpk(sc[8 * g + 6], sc[8 * g + 7]);
                    const bf16x8 pb = *reinterpret_cast<bf16x8*>(&w);
                    const bf16_t* vp = VT + (vt * 32 + r32) * SS + st * 32 + 16 * g + 4 * hh;
                    const s16x4 lo = *(const s16x4*)vp, hi4 = *(const s16x4*)(vp + 8);
                    const bf16x8 a = (bf16x8){lo[0], lo[1], lo[2], lo[3], hi4[0], hi4[1], hi4[2], hi4[3]};
                    oacc = __builtin_amdgcn_mfma_f32_32x32x16_bf16(a, pb, oacc, 0, 0, 0);
                }
            }
        }
        if (c > 0) {
#pragma unroll
            for (int d0 = 0; d0 < 8; ++d0) {
                const bf16x8 a = *(const bf16x8*)(SpT + (vt * 32 + r32) * SK + d0 * 16 + hh * 8);
                const bf16x8 bq = *(const bf16x8*)(Qh + (tt * 32 + r32) * SK + d0 * 16 + hh * 8);
                oacc = __builtin_amdgcn_mfma_f32_32x32x16_bf16(a, bq, oacc, 0, 0, 0);
            }
        }
        float ss = 0.f;
#pragma unroll
        for (int rg = 0; rg < 16; ++rg) ss = fmaf(oacc[rg], oacc[rg], ss);
        { auto rr = __builtin_amdgcn_permlane32_swap(__float_as_uint(ss), __float_as_uint(ss), false, false); ss = __uint_as_float(rr[0]) + __uint_as_float(rr[1]); }
        if (hh == 0) part[vt * 64 + tt * 32 + r32] = ss;
        __syncthreads();
        const int t = tt * 32 + r32;
        const float tot = (part[t] + part[64 + t]) + (part[128 + t] + part[192 + t]);
        const float scale = rsqrtf(tot * (1.f / 128.f) + EPS);
        if ((c * 64 + t) < LL) {
            bf16_t* op = MIX + (row0 + t) * DM + h * 128 + vt * 32;
#pragma unroll
            for (int g4 = 0; g4 < 4; ++g4) {
                const int v0 = 8 * g4 + 4 * hh;
                const float4 gg = gv[g4]; const float4 wv = *(const float4*)(nw + vt * 32 + v0);
                const float y0 = oacc[4 * g4 + 0] * scale * wv.x * gg.x / (1.f + __expf(-gg.x)), y1 = oacc[4 * g4 + 1] * scale * wv.y * gg.y / (1.f + __expf(-gg.y));
                const float y2 = oacc[4 * g4 + 2] * scale * wv.z * gg.z / (1.f + __expf(-gg.z)), y3 = oacc[4 * g4 + 3] * scale * wv.w * gg.w / (1.f + __expf(-gg.w));
                uint2 w; w.x = cvtpk(y0, y1); w.y = cvtpk(y2, y3);
                *(uint2*)(op + v0) = w;
            }
        }
        __syncthreads();
    }
}
}


namespace moe {
using bf16x8 = __attribute__((ext_vector_type(8))) short;
using f32x16 = __attribute__((ext_vector_type(16))) float;
using u32x4  = __attribute__((ext_vector_type(4))) unsigned;
constexpr int TW = 5, PROWS = 64 * TW, XS = 144, XBUF = PROWS * XS;
__device__ __forceinline__ unsigned cvtpk(float lo, float hi) { unsigned r; asm volatile("v_cvt_pk_bf16_f32 %0, %1, %2" : "=v"(r) : "v"(lo), "v"(hi)); return r; }
#define MOE_BAR() asm volatile("s_waitcnt lgkmcnt(0)\n\ts_barrier" ::: "memory")
constexpr int WD = 2;
constexpr int ABUF = 4 * 4 * 1024, AOFF = 2 * XBUF, LOFF = AOFF + 2 * ABUF;
template <bool UP>
__device__ __forceinline__ void stream_gemm(KP P, char* lds, int layer) {
    constexpr int KTOT = UP ? DM : DE, NSLAB = KTOT / 64, NCP = UP ? 2 : 4, LDW = UP ? DE : DM, CPSTRIDE = UP ? 64 : 128;
    static_assert(NSLAB % WD == 0 && NSLAB >= 2 * WD, "slab loop is unrolled by WD");
    const int tid = tid_(), lane = tid & 63, wid = tid >> 6, r32 = lane & 31, hh = lane >> 5, cg = wid & 3, th = wid >> 2;
    const int* cnt_ = P->cnt;
    const bf16_t* X = UP ? P->HN : P->H;
    int* basel = (int*)(lds + LOFF); int* tlist = basel + 64; float* rsl = (float*)(basel + 64 + 320 + 64);
    for (int ub = bid_(); ub < 256; ub += gridDim.x) {
        const int u = ((ub & 7) << 5) | (ub >> 3);
        const int e = u >> 2, ns = u & 3;
        const int rot = ((u >> 2) * 11) & (NSLAB - 1);
        __syncthreads();
        if (tid < 64) basel[64 + 320 + tid] = cnt_[tid * CSTR];
        __syncthreads();
        if (tid < 64) { int a = 0; for (int q = 0; q < tid; ++q) a += basel[64 + 320 + q]; basel[tid] = a; }
        __syncthreads();
        const int cnt = cnt_[e * CSTR], row0 = basel[e];
        for (int pass0 = 0; pass0 < cnt; pass0 += PROWS) {
            const int cntp = (cnt - pass0) < PROWS ? (cnt - pass0) : PROWS;
            if constexpr (UP) { if (cnt <= ECAP) {
                __syncthreads();
                if (tid < PROWS && pass0 + tid < cnt) { tlist[tid] = P->elist[e * ECAP + pass0 + tid]; rsl[tid] = P->ers[e * ECAP + pass0 + tid]; }
                __syncthreads();
              } else {
                __syncthreads();
                const int* ridx = P->ridx; const int* rslot = P->rslot;
#pragma unroll 1
                for (int i0 = tid; i0 < NASSIGN; i0 += NTHR * 8) {
                    int ex[8], sl[8];
#pragma unroll
                    for (int q = 0; q < 8; ++q) { const int i = i0 + NTHR * q; ex[q] = i < NASSIGN ? ridx[i] : -1; sl[q] = i < NASSIGN ? rslot[i] : 0; }
#pragma unroll
                    for (int q = 0; q < 8; ++q) { const int sp = sl[q] - pass0; if (ex[q] == e && sp >= 0 && sp < PROWS) { tlist[sp] = (i0 + NTHR * q) >> 1; rsl[sp] = P->rsn[(i0 + NTHR * q) >> 1]; } }
                }
                __syncthreads();
            } }
            int xoff[5];
#pragma unroll
            for (int j = 0; j < 5; ++j) { int rho = (tid >> 3) + 64 * j; rho = rho < cntp ? rho : cntp - 1; const int grow = row0 + pass0 + rho;
                xoff[j] = (UP ? tlist[rho] * DM : grow * DE) + (tid & 7) * 8; }
            char* const xw = lds + (tid >> 3) * XS + (tid & 7) * 16;
            char* const aw = lds + AOFF + (cg * 4 + 2 * th) * 1024 + lane * 16;
            const char* const ar = lds + AOFF + cg * 4 * 1024 + lane * 16;
            float wreg[WD][16]; u32x4 xs[5];
#pragma unroll 1
            for (int cp = 0; cp < NCP; ++cp) {
                const int cgi = cp * 4 + cg;
                const int kkw = wid >> 1, half = wid & 1;
                const float* wp;
                if constexpr (UP) wp = (r32 < 16 ? P->w1 : P->w3) + ((size_t)(layer * NE + e) * DM + kkw * 16 + 8 * hh + 4 * half) * DE + ns * 128 + cp * 64 + 4 * (r32 & 15);
                else wp = P->w2 + ((size_t)(layer * NE + e) * DE + 32 * hh + 2 * th) * DM + ns * 512 + cgi * 32 + r32;
                f32x16 acc[TW];
#pragma unroll
                for (int tl = 0; tl < TW; ++tl) acc[tl] = f32x16{};
#define MOE_WLD1(wn_, R, li) do { if constexpr (UP) { if ((li) < 4) { const float4 t_ = *(const float4*)((wn_) + (size_t)(li) * DE); wreg[R][4 * (li)] = t_.x; wreg[R][4 * (li) + 1] = t_.y; wreg[R][4 * (li) + 2] = t_.z; wreg[R][4 * (li) + 3] = t_.w; } } \
                    else { if ((li) < 16) wreg[R][li] = (wn_)[(size_t)(((li) >> 3) + 4 * ((li) & 7)) * DM]; } } while (0)
#define MOE_WLOAD(slab, R) do { const float* wn_ = wp + (size_t)(((slab) + rot) & (NSLAB - 1)) * 64 * LDW; \
                    _Pragma("unroll") for (int li = 0; li < 16; ++li) MOE_WLD1(wn_, R, li); } while (0)
#define MOE_WPARK(R, PAR) do { if constexpr (UP) { _Pragma("unroll") for (int q = 0; q < 4; ++q) { uint2 fw; fw.x = cvtpk(wreg[R][q], wreg[R][4 + q]); fw.y = cvtpk(wreg[R][8 + q], wreg[R][12 + q]); \
                            *(uint2*)(lds + AOFF + (PAR) * ABUF + (q * 4 + kkw) * 1024 + lane * 16 + half * 8) = fw; } } \
                    else { _Pragma("unroll") for (int i = 0; i < 2; ++i) { u32x4 fw; fw.x = cvtpk(wreg[R][8 * i + 0], wreg[R][8 * i + 1]); fw.y = cvtpk(wreg[R][8 * i + 2], wreg[R][8 * i + 3]); \
                            fw.z = cvtpk(wreg[R][8 * i + 4], wreg[R][8 * i + 5]); fw.w = cvtpk(wreg[R][8 * i + 6], wreg[R][8 * i + 7]); *(u32x4*)(aw + (PAR) * ABUF + i * 1024) = fw; } } } while (0)
                if (cp == 0) {
#pragma unroll
                    for (int j = 0; j < 5; ++j) xs[j] = *(const u32x4*)(X + xoff[j] + (rot & (NSLAB - 1)) * 64);
                    MOE_WLOAD(0, 0); MOE_WLOAD(1, 1);
#pragma unroll
                    for (int j = 0; j < 5; ++j) *(u32x4*)(xw + 64 * j * XS) = xs[j];
                    MOE_WPARK(0, 0); MOE_WLOAD(2, 0);
                    MOE_BAR();
                }
#define MOE_SLAB(s, PAR, R1) do { \
                    const int sx = ((s) + 1) & (NSLAB - 1); const int swr = (s) + 1 + WD; const bool wnext = swr >= NSLAB && cp + 1 < NCP;     \
                    const int sw = swr < NSLAB ? swr : (wnext ? swr - NSLAB : NSLAB - 1); \
                    { const bf16_t* xn0_ = X + ((sx + rot) & (NSLAB - 1)) * 64; _Pragma("unroll") for (int j = 0; j < 5; ++j) xs[j] = *(const u32x4*)(xn0_ + xoff[j]); } \
                    MOE_WPARK(R1, 1 - (PAR)); \
                    const float* wn_ = wp + (wnext ? CPSTRIDE : 0) + (size_t)((sw + rot) & (NSLAB - 1)) * 64 * LDW; \
                    const char* xb = lds + (PAR) * XBUF + (th * TW * 32 + r32) * XS + hh * 16; \
                    bf16x8 xq[4]; bf16x8 fq[2];                                                       \
                    xq[0] = *(const bf16x8*)(xb); xq[1] = *(const bf16x8*)(xb + 32 * XS); xq[2] = *(const bf16x8*)(xb + 64 * XS); \
                    fq[0] = *(const bf16x8*)(ar + (PAR) * ABUF); \
                    _Pragma("unroll") for (int kk = 0; kk < 4; ++kk) { \
                        if (kk < 3) fq[(kk + 1) & 1] = *(const bf16x8*)(ar + (PAR) * ABUF + (kk + 1) * 1024); \
                        _Pragma("unroll") for (int tl = 0; tl < TW; ++tl) { \
                            const int cur = kk * TW + tl, nx = cur + 3, nkk = nx / TW, ntl = nx % TW;       \
                            if (nx < 4 * TW) xq[nx & 3] = *(const bf16x8*)(xb + ntl * 32 * XS + nkk * 32); \
                            acc[tl] = __builtin_amdgcn_mfma_f32_32x32x16_bf16(fq[kk & 1], xq[cur & 3], acc[tl], 0, 0, 0); \
                            const int li = kk * TW + tl; \
                            MOE_WLD1(wn_, R1, li); \
                            __builtin_amdgcn_sched_barrier(0); } } \
                    _Pragma("unroll") for (int j = 0; j < 5; ++j) *(u32x4*)(xw + (1 - (PAR)) * XBUF + 64 * j * XS) = xs[j]; \
                    MOE_BAR(); } while (0)
#pragma unroll 1
                for (int s = 0; s < NSLAB; s += 2) { MOE_SLAB(s, 0, 1); MOE_SLAB(s + 1, 1, 0); }
#undef MOE_SLAB
#undef MOE_WLOAD
#undef MOE_WLD1
#undef MOE_WPARK
                const int T = (cntp + 31) >> 5;
                const int Tw = (T - TW * th) < 0 ? 0 : ((T - TW * th) > TW ? TW : (T - TW * th));
#pragma unroll
                for (int tl = 0; tl < TW; ++tl) if (tl < Tw) {
                    const int rho = (th * TW + tl) * 32 + r32;
                    if (rho < cntp) {
                        const size_t grow = (size_t)(row0 + pass0 + rho);
                        if constexpr (UP) {
                            bf16_t* hp = P->H + grow * DE + ns * 128 + cgi * 16 + 4 * hh; const float rs = rsl[rho];
#pragma unroll
                            for (int g = 0; g < 2; ++g) {
                                float y[4];
#pragma unroll
                                for (int q = 0; q < 4; ++q) { const float a = acc[tl][4 * g + q] * rs, b = acc[tl][8 + 4 * g + q] * rs; y[q] = a / (1.f + __expf(-a)) * b; }
                                uint2 w; w.x = cvtpk(y[0], y[1]); w.y = cvtpk(y[2], y[3]);
                                *(uint2*)(hp + 8 * g) = w;
                            }
                        } else {
                            bf16_t* yp = P->Y + grow * DM + ns * 512 + cgi * 32 + 4 * hh;
#pragma unroll
                            for (int g = 0; g < 4; ++g) {
                                uint2 w; w.x = cvtpk(acc[tl][4 * g + 0], acc[tl][4 * g + 1]); w.y = cvtpk(acc[tl][4 * g + 2], acc[tl][4 * g + 3]);
                                *(uint2*)(yp + 8 * g) = w;
                            }
                        }
                    }
                }
            }
        }
    }
}
#undef MOE_BAR
}


namespace s5 {
using bf16x8 = __attribute__((ext_vector_type(8))) short;
using f32x16 = __attribute__((ext_vector_type(16))) float;
using u32x4  = __attribute__((ext_vector_type(4))) unsigned;
constexpr int NCHK = 516, NMT = 17;
__device__ __forceinline__ unsigned cvtpk(float lo, float hi) { unsigned r; asm volatile("v_cvt_pk_bf16_f32 %0, %1, %2" : "=v"(r) : "v"(lo), "v"(hi)); return r; }
__device__ __forceinline__ bf16x8 ld8f(const float* p) {
    const float4 a = *(const float4*)p, b = *(const float4*)(p + 4);
    u32x4 w; w.x = cvtpk(a.x, a.y); w.y = cvtpk(a.z, a.w); w.z = cvtpk(b.x, b.y); w.w = cvtpk(b.z, b.w);
    return *reinterpret_cast<bf16x8*>(&w);
}
__device__ __forceinline__ void prep_unit(KP P, char* lds, int layer, int g) {
    float2* pw = (float2*)lds; float2* bb = pw + 17 * 64; float2* cc = bb + 1024; float* kd = (float*)(cc + 1024);
    const int tid = tid_();
    const float dt = expf(P->log_dt[layer * 32 + g]);
    const float* a_re = P->a_re + (layer * 32 + g) * 64; const float* a_im = P->a_im + (layer * 32 + g) * 64;
    for (int idx = tid; idx < 17 * 64; idx += NTHR) { const int d = idx >> 6, p = idx & 63;
        const float mag = expf(a_re[p] * dt * (float)d), ang = a_im[p] * dt * (float)d; pw[idx] = make_float2(mag * cosf(ang), mag * sinf(ang)); }
    for (int idx = tid; idx < 1024; idx += NTHR) {
        { const int p = idx >> 4, c = idx & 15; const float are = a_re[p], aim = a_im[p];
          const float mag = expf(are * dt), abr = mag * cosf(aim * dt), abi = mag * sinf(aim * dt), den = are * are + aim * aim;
          const float zr = ((abr - 1.f) * are + abi * aim) / den, zi = (abi * are - (abr - 1.f) * aim) / den;
          const float br = P->b_re[((layer * 32 + g) * 64 + p) * 16 + c], bi = P->b_im[((layer * 32 + g) * 64 + p) * 16 + c];
          bb[idx] = make_float2(zr * br - zi * bi, zr * bi + zi * br); }
        { const int c = idx >> 6, p = idx & 63; cc[idx] = make_float2(P->c_re[((layer * 32 + g) * 16 + c) * 64 + p], P->c_im[((layer * 32 + g) * 16 + c) * 64 + p]); }
    }
    __syncthreads();
    if (tid < 64) ((float2*)P->A16)[(layer * 32 + g) * 64 + tid] = pw[16 * 64 + tid];
    for (int idx = tid; idx < 4096; idx += NTHR) { const int d = idx >> 8, c = (idx >> 4) & 15, c2 = idx & 15;
        float acc = 0.f;
        for (int p = 0; p < 64; ++p) { const float2 C = cc[c * 64 + p], W = pw[d * 64 + p], B = bb[p * 16 + c2];
            const float xr = C.x * W.x - C.y * W.y, xi = C.x * W.y + C.y * W.x; acc += xr * B.x - xi * B.y; }
        if (d == 0 && c == c2) acc += P->s5d[layer * 512 + g * 16 + c];
        kd[idx] = acc; }
    __syncthreads();
    bf16_t* BtY = P->BtY + (size_t)(layer * 32 + g) * 256 * 384; bf16_t* BtE = P->BtE + (size_t)(layer * 32 + g) * 128 * 256;
    for (int idx = tid; idx < 256 * 48; idx += NTHR) { const int n = idx / 48, ch = idx % 48, t = n >> 4, c = n & 15;
        float v[8];
        if (ch < 32) { const int s = ch >> 1, c0 = (ch & 1) * 8;
#pragma unroll
            for (int jj = 0; jj < 8; ++jj) v[jj] = (s <= t) ? kd[((t - s) * 16 + c) * 16 + c0 + jj] : 0.f;
        } else {
#pragma unroll
            for (int jj = 0; jj < 8; ++jj) { const int kq = (ch - 32) * 8 + jj, p = kq >> 1; const float2 C = cc[c * 64 + p], W = pw[(t + 1) * 64 + p];
                v[jj] = (kq & 1) ? -(C.x * W.y + C.y * W.x) : (C.x * W.x - C.y * W.y); }
        }
        u32x4 w; w.x = cvtpk(v[0], v[1]); w.y = cvtpk(v[2], v[3]); w.z = cvtpk(v[4], v[5]); w.w = cvtpk(v[6], v[7]);
        *(u32x4*)(BtY + ((size_t)(((n >> 5) * 24 + (ch >> 1)) * 64 + (ch & 1) * 32 + (n & 31))) * 8) = w; }
    for (int idx = tid; idx < 128 * 32; idx += NTHR) { const int n = idx >> 5, ch = idx & 31, p = n >> 1, s = ch >> 1, c0 = (ch & 1) * 8;
        const float2 W = pw[(15 - s) * 64 + p];
        float v[8];
#pragma unroll
        for (int jj = 0; jj < 8; ++jj) { const float2 B = bb[p * 16 + c0 + jj]; v[jj] = (n & 1) ? (W.x * B.y + W.y * B.x) : (W.x * B.x - W.y * B.y); }
        u32x4 w; w.x = cvtpk(v[0], v[1]); w.y = cvtpk(v[2], v[3]); w.z = cvtpk(v[4], v[5]); w.w = cvtpk(v[6], v[7]);
        *(u32x4*)(BtE + ((size_t)(((n >> 5) * 16 + (ch >> 1)) * 64 + (ch & 1) * 32 + (n & 31))) * 8) = w; }
    __syncthreads();
}
__device__ __forceinline__ float gelu_t(float x) { const float u = 0.7978845608028654f * (x + 0.044715f * x * x * x); const float e = __expf(2.f * u); return x - x / (e + 1.f); }
__device__ __forceinline__ void fused_unit(KP P, char* lds, int layer, int b, int g) {
    const int tid = tid_(), lane = tid & 63, wid = tid >> 6, r32 = lane & 31, hh = lane >> 5;
    constexpr int UCH = 528, UBYTES = 68352;
    char* U16 = lds; float* El = (float*)(lds + UBYTES);
    const float* PA = P->PA; bf16_t* YG = P->YG;
    { const float* ub = PA + (size_t)(b * LL) * PAW + 2048 + g * 16;
#pragma unroll 1
      for (int i0 = 0; i0 < LL * 4; i0 += NTHR * 4) {
          float4 v[4];
#pragma unroll
          for (int q = 0; q < 4; ++q) { const int idx = i0 + q * NTHR + tid, ic = idx < LL * 4 ? idx : LL * 4 - 1; v[q] = *(const float4*)(ub + (size_t)(ic >> 2) * PAW + (ic & 3) * 4); }
#pragma unroll
          for (int q = 0; q < 4; ++q) { const int idx = i0 + q * NTHR + tid; if (idx < LL * 4) { const int r = idx >> 2;
              uint2 w; w.x = cvtpk(v[q].x, v[q].y); w.y = cvtpk(v[q].z, v[q].w); *(uint2*)(U16 + (r >> 4) * UCH + (r & 15) * 32 + (idx & 3) * 8) = w; } }
      } }
    __syncthreads();
    int mrow[5];
#pragma unroll
    for (int mt = 0; mt < 5; ++mt) { const int m = mt * 32 + r32; mrow[mt] = m < 129 ? m : 128; }
    if (wid < 4) {
        const bf16_t* Bt = P->BtE + (size_t)(layer * 32 + g) * 128 * 256 + ((size_t)(wid * 16) * 64 + lane) * 8;
        f32x16 acc[5];
#pragma unroll
        for (int mt = 0; mt < 5; ++mt) acc[mt] = f32x16{};
#pragma unroll 4
        for (int s = 0; s < 16; ++s) {
            const bf16x8 af = *(const bf16x8*)(Bt + (size_t)(s * 64) * 8);
#pragma unroll
            for (int mt = 0; mt < 5; ++mt) { const bf16x8 bf = *(const bf16x8*)(U16 + mrow[mt] * UCH + hh * 16 + 32 * s); acc[mt] = __builtin_amdgcn_mfma_f32_32x32x16_bf16(af, bf, acc[mt], 0, 0, 0); }
        }
#pragma unroll
        for (int mt = 0; mt < 5; ++mt) { const int m = mt * 32 + r32; if (m < 129) { float* ep = El + m * 128 + wid * 32 + 4 * hh;
#pragma unroll
            for (int q = 0; q < 4; ++q) *(float4*)(ep + 8 * q) = make_float4(acc[mt][4 * q], acc[mt][4 * q + 1], acc[mt][4 * q + 2], acc[mt][4 * q + 3]); } }
    }
    __syncthreads();
    if (tid < 64) {
        const float2 A = ((const float2*)P->A16)[(layer * 32 + g) * 64 + tid];
        float2* e2 = (float2*)El + tid;
        float xr = 0.f, xi = 0.f;
#pragma unroll 1
        for (int j0 = 0; j0 < 128; j0 += 8) {
            float2 e[8];
#pragma unroll
            for (int i = 0; i < 8; ++i) e[i] = e2[(j0 + i) * 64];
#pragma unroll
            for (int i = 0; i < 8; ++i) { e2[(j0 + i) * 64] = make_float2(xr, xi);
                const float nr = A.x * xr - A.y * xi + e[i].x, ni = A.x * xi + A.y * xr + e[i].y; xr = nr; xi = ni; }
        }
        e2[128 * 64] = make_float2(xr, xi);
    }
    __syncthreads();
    {
        const bf16_t* Bt = P->BtY + (size_t)(layer * 32 + g) * 256 * 384 + ((size_t)(wid * 24) * 64 + lane) * 8;
        f32x16 acc[5];
#pragma unroll
        for (int mt = 0; mt < 5; ++mt) acc[mt] = f32x16{};
#pragma unroll 4
        for (int s = 0; s < 16; ++s) if (2 * wid + 1 >= s) {
            const bf16x8 af = *(const bf16x8*)(Bt + (size_t)(s * 64) * 8);
#pragma unroll
            for (int mt = 0; mt < 5; ++mt) { const bf16x8 bf = *(const bf16x8*)(U16 + mrow[mt] * UCH + hh * 16 + 32 * s); acc[mt] = __builtin_amdgcn_mfma_f32_32x32x16_bf16(af, bf, acc[mt], 0, 0, 0); }
        }
#pragma unroll 4
        for (int ks = 0; ks < 8; ++ks) {
            const bf16x8 af = *(const bf16x8*)(Bt + (size_t)((16 + ks) * 64) * 8);
#pragma unroll
            for (int mt = 0; mt < 5; ++mt) { const bf16x8 bf = ld8f(El + mrow[mt] * 128 + 8 * hh + ks * 16); acc[mt] = __builtin_amdgcn_mfma_f32_32x32x16_bf16(af, bf, acc[mt], 0, 0, 0); }
        }
#pragma unroll
        for (int mt = 0; mt < 5; ++mt) { const int ml = mt * 32 + r32; if (ml < 129) { const int m = b * 129 + ml;
#pragma unroll
            for (int q = 0; q < 4; ++q) { const int t = 2 * wid + (q >> 1);
                uint2 w; w.x = cvtpk(gelu_t(acc[mt][4 * q]), gelu_t(acc[mt][4 * q + 1])); w.y = cvtpk(gelu_t(acc[mt][4 * q + 2]), gelu_t(acc[mt][4 * q + 3]));
                *(uint2*)(YG + (size_t)(m * 16 + t) * 512 + g * 16 + 8 * (q & 1) + 4 * hh) = w; } } }
    }
    __syncthreads();
}
}

__device__ __forceinline__ float wave_sum(float v) {
    v += swz_xor<1>(v); v += swz_xor<2>(v); v += swz_xor<4>(v); v += swz_xor<8>(v); v += swz_xor<16>(v);
    { auto rr = __builtin_amdgcn_permlane32_swap(__float_as_uint(v), __float_as_uint(v), false, false); v = __uint_as_float(rr[0]) + __uint_as_float(rr[1]); }
    return v;
}
__device__ __forceinline__ unsigned cvtpk_(float lo, float hi) { unsigned r; asm volatile("v_cvt_pk_bf16_f32 %0, %1, %2" : "=v"(r) : "v"(lo), "v"(hi)); return r; }
__device__ __forceinline__ void ph_attn_out(KP P, int layer, int cu0) {
    const int tid = tid_(), lane = tid & 63, gw = (bid_() - cu0) * 8 + (tid >> 6), NGW = (gridDim.x - cu0) * 8;
    if (gw < 0) return;
    const float scale = 1.f - (0.8f - 0.6f * expf(-0.3f * (float)layer));
    const float lam = P->lam[layer];
    const float4 sw = ((const float4*)(P->subln + layer * 256))[lane];
    const float* OC = P->OC; bf16_t* MIX = P->MIX;
    for (int it0 = gw; it0 < TOK * 4; it0 += NGW * 4) {
        float4 a[4], b[4];
#pragma unroll
        for (int q = 0; q < 4; ++q) { const int it = it0 + NGW * q, itc = it < TOK * 4 ? it : TOK * 4 - 1, r = itc >> 2, h = itc & 3;
            a[q] = *(const float4*)(OC + (size_t)r * DM + h * 512 + lane * 4); b[q] = *(const float4*)(OC + (size_t)r * DM + h * 512 + 256 + lane * 4); }
#pragma unroll
        for (int q = 0; q < 4; ++q) { const int it = it0 + NGW * q; if (it < TOK * 4) { const int r = it >> 2, h = it & 3;
            const float o0 = a[q].x - lam * b[q].x, o1 = a[q].y - lam * b[q].y, o2 = a[q].z - lam * b[q].z, o3 = a[q].w - lam * b[q].w;
            const float ss = wave_sum(o0 * o0 + o1 * o1 + o2 * o2 + o3 * o3);
            const float rs = rsqrtf(ss * (1.f / 256.f) + EPS) * scale;
            uint2 w; w.x = cvtpk_(o0 * rs * sw.x, o1 * rs * sw.y); w.y = cvtpk_(o2 * rs * sw.z, o3 * rs * sw.w);
            *(uint2*)(MIX + (size_t)r * DM + 1024 + h * 256 + lane * 4) = w; } }
    }
}
__device__ __forceinline__ void ph_build_norm(KP P) {
    const int tid = tid_(), lane = tid & 63, gw = bid_() * 8 + (tid >> 6), NGW = gridDim.x * 8;
    for (int r = gw; r < MP; r += NGW) {
        float4 v[8];
        if (r < TOK) { const int b = r / LL, t = r % LL;
            const float4* src = (const float4*)(t < NMETA ? P->meta + (size_t)t * DM : P->x + ((size_t)b * SEQ + (t - NMETA)) * DM);
#pragma unroll
            for (int j = 0; j < 8; ++j) v[j] = src[lane + 64 * j];
        } else {
#pragma unroll
            for (int j = 0; j < 8; ++j) v[j] = make_float4(0.f, 0.f, 0.f, 0.f);
        }
        float ss = 0.f;
#pragma unroll
        for (int j = 0; j < 8; ++j) { ((float4*)(P->Z + (size_t)r * DM))[lane + 64 * j] = v[j]; ss += v[j].x * v[j].x + v[j].y * v[j].y + v[j].z * v[j].z + v[j].w * v[j].w; }
        const float rs = rsqrtf(wave_sum(ss) * (1.f / DM) + EPS);
#pragma unroll
        for (int j = 0; j < 8; ++j) { const float4 w = ((const float4*)P->ln1_w)[lane + 64 * j];
            uint2 o; o.x = cvtpk_(v[j].x * rs * w.x, v[j].y * rs * w.y); o.y = cvtpk_(v[j].z * rs * w.z, v[j].w * rs * w.w);
            ((uint2*)(P->HN + (size_t)r * DM))[lane + 64 * j] = o; }
    }
}
__device__ __forceinline__ void ph_prep(KP P) {
    const int tid = tid_();
    if (bid_() == 0) {
        const int c = tid;
        const float l0 = P->lbnd[c], l1 = P->lbnd[512 + c], m = fmaxf(l0, l1), e0 = expf(l0 - m), e1 = expf(l1 - m);
        P->lbtab[c] = 0.f; P->lbtab[512 + c] = e1 / (e0 + e1);
        if (c < 2) {
            float s1 = 0.f, s2 = 0.f;
            for (int i = 0; i < 128; ++i) { s1 += P->lq1[c * 128 + i] * P->lk1[c * 128 + i]; s2 += P->lq2[c * 128 + i] * P->lk2[c * 128 + i]; }
            const float li = 0.8f - 0.6f * expf(-0.3f * (float)c);
            P->lam[c] = expf(s1) - expf(s2) + li;
        }
    }
    for (int i = bid_() * NTHR + tid; i < 2 * 128 * 3 * 64 * 8; i += gridDim.x * NTHR) {
        const int jj = i & 7, ln = (i >> 3) & 63, ct = (i >> 9) % 3, ksg = ((i >> 9) / 3) & 127, layer = (i >> 9) / (3 * 128);
        const int jc = ct * 32 + (ln & 31), k = ksg * 16 + 8 * (ln >> 5) + jj;
        float v = 0.f;
        if (jc < 8) v = P->wrg[((size_t)layer * DM + k) * 8 + jc]; else if (jc < 72) v = P->wre[((size_t)layer * DM + k) * 64 + jc - 8];
        v *= P->ln2_w[layer * DM + k];
        const bf16_t hi = f2bf(v), lo = f2bf(v - bf2f(hi));
        const size_t o = ((size_t)((ksg * 3 + ct) * 64 + ln)) * 8 + jj;
        P->WRT[(size_t)(layer * 2 + 0) * 96 * DM + o] = hi; P->WRT[(size_t)(layer * 2 + 1) * 96 * DM + o] = lo;
    }
}
namespace rt {
using f32x16 = __attribute__((ext_vector_type(16))) float;
using bf16x8 = __attribute__((ext_vector_type(8))) short;
using u32x4  = __attribute__((ext_vector_type(4))) unsigned;
__device__ __forceinline__ void norm_router(KP P, char* lds, int layer) {
    const int tid = tid_(), lane = tid & 63, wid = tid >> 6, r32 = lane & 31, hh = lane >> 5;
    float* part = (float*)lds;
    float* ssqp = (float*)(lds + 98304);
    float* lg = ssqp + 256;
    float* rsv = lg + 32 * 97;
    const bf16_t* Whi = P->WRT + (size_t)(layer * 2 + 0) * 96 * DM; const bf16_t* Wlo = P->WRT + (size_t)(layer * 2 + 1) * 96 * DM;
    const float* Z = P->Z;
    float* st = (float*)lds + wid * (32 * 68);
    const int nunits = layer == 1 ? (NB * SEQ) / 32 : TOK / 32;
    for (int u = bid_(); u < nunits; u += gridDim.x) {
        const int tok0 = layer == 1 ? (u >> 6) * LL + NMETA + (u & 63) * 32 : u * 32, kb = wid * 256;
        if (false) {
            float* Zw = P->Z; const float* ZP = P->ZP;
            for (int i = tid; i < 32 * DM / 4; i += NTHR) { const int r = i / (DM / 4), c4 = i % (DM / 4);
                float4 z = ((const float4*)(Zw + (size_t)(tok0 + r) * DM))[c4];
#pragma unroll
                for (int ks = 0; ks < 8; ++ks) { const float4 p4 = ((const float4*)(ZP + ((size_t)ks * 256 + (tok0 - 8192 + r)) * DM))[c4]; z.x += p4.x; z.y += p4.y; z.z += p4.z; z.w += p4.w; }
                ((float4*)(Zw + (size_t)(tok0 + r) * DM))[c4] = z; }
            asm volatile("s_waitcnt vmcnt(0)" ::: "memory");
            __syncthreads();
        }
        f32x16 acc[3] = {f32x16{}, f32x16{}, f32x16{}};
        float sq8[8];
#pragma unroll
        for (int j = 0; j < 8; ++j) sq8[j] = 0.f;
        const float* zg = Z + (size_t)(tok0 + (lane >> 4)) * DM + kb + (lane & 15) * 4;
        const bf16_t* dg = P->DLT + (size_t)(tok0 + (lane >> 4)) * DM + kb + (lane & 15) * 4;
        bf16_t* hg_ = P->HN + (size_t)(tok0 + (lane >> 4)) * DM + kb + (lane & 15) * 4;
        float4 zs[8]; uint2 ds[8];
#pragma unroll
        for (int j = 0; j < 8; ++j) { zs[j] = *(const float4*)(zg + (size_t)(4 * j) * DM); ds[j] = *(const uint2*)(dg + (size_t)(4 * j) * DM); }
#pragma unroll 1
        for (int sc = 0; sc < 4; ++sc) {
            const float4 lw = *(const float4*)(P->ln2_w + layer * DM + kb + (lane & 15) * 4 + sc * 64);
#pragma unroll
            for (int j = 0; j < 8; ++j) { float4 z = zs[j]; z.x += __uint_as_float(ds[j].x << 16); z.y += __uint_as_float(ds[j].x & 0xffff0000u); z.z += __uint_as_float(ds[j].y << 16); z.w += __uint_as_float(ds[j].y & 0xffff0000u);
                sq8[j] += z.x * z.x + z.y * z.y + z.z * z.z + z.w * z.w;
                *(float4*)(st + ((lane >> 4) + 4 * j) * 68 + (lane & 15) * 4) = z;
                uint2 o; o.x = cvtpk_(z.x * lw.x, z.y * lw.y); o.y = cvtpk_(z.z * lw.z, z.w * lw.w);
                *(uint2*)(hg_ + (size_t)(4 * j) * DM + sc * 64) = o; }
            const int scn = sc < 3 ? sc + 1 : 3;
#pragma unroll
            for (int j = 0; j < 8; ++j) { zs[j] = *(const float4*)(zg + (size_t)(4 * j) * DM + scn * 64); ds[j] = *(const uint2*)(dg + (size_t)(4 * j) * DM + scn * 64); }
            asm volatile("s_waitcnt lgkmcnt(0)" ::: "memory");
            const bf16_t* wh = Whi + ((size_t)((wid * 16 + sc * 4) * 3) * 64 + lane) * 8; const bf16_t* wl = Wlo + ((size_t)((wid * 16 + sc * 4) * 3) * 64 + lane) * 8;
#pragma unroll
            for (int ks = 0; ks < 4; ++ks) {
                const float4 z0 = *(const float4*)(st + r32 * 68 + ks * 16 + 8 * hh), z1 = *(const float4*)(st + r32 * 68 + ks * 16 + 8 * hh + 4);
                u32x4 h; h.x = cvtpk_(z0.x, z0.y); h.y = cvtpk_(z0.z, z0.w); h.z = cvtpk_(z1.x, z1.y); h.w = cvtpk_(z1.z, z1.w);
                u32x4 l; l.x = cvtpk_(z0.x - __uint_as_float(h.x << 16), z0.y - __uint_as_float(h.x & 0xffff0000u)); l.y = cvtpk_(z0.z - __uint_as_float(h.y << 16), z0.w - __uint_as_float(h.y & 0xffff0000u));
                l.z = cvtpk_(z1.x - __uint_as_float(h.z << 16), z1.y - __uint_as_float(h.z & 0xffff0000u)); l.w = cvtpk_(z1.z - __uint_as_float(h.w << 16), z1.w - __uint_as_float(h.w & 0xffff0000u));
                const bf16x8 zh = *reinterpret_cast<bf16x8*>(&h), zl = *reinterpret_cast<bf16x8*>(&l);
#pragma unroll
                for (int ct = 0; ct < 3; ++ct) {
                    const bf16x8 ah = *(const bf16x8*)(wh + (size_t)((ks * 3 + ct) * 64) * 8), al = *(const bf16x8*)(wl + (size_t)((ks * 3 + ct) * 64) * 8);
                    acc[ct] = __builtin_amdgcn_mfma_f32_32x32x16_bf16(ah, zh, acc[ct], 0, 0, 0);
                    acc[ct] = __builtin_amdgcn_mfma_f32_32x32x16_bf16(ah, zl, acc[ct], 0, 0, 0);
                    acc[ct] = __builtin_amdgcn_mfma_f32_32x32x16_bf16(al, zh, acc[ct], 0, 0, 0);
                }
            }
            asm volatile("s_waitcnt lgkmcnt(0)" ::: "memory");
        }
#pragma unroll
        for (int j = 0; j < 8; ++j) { float v = sq8[j]; v += swz_xor<1>(v); v += swz_xor<2>(v); v += swz_xor<4>(v); v += swz_xor<8>(v); sq8[j] = v; }
        __syncthreads();
        if ((lane & 15) == 0) {
#pragma unroll
            for (int j = 0; j < 8; ++j) ssqp[wid * 32 + (lane >> 4) + 4 * j] = sq8[j];
        }

#pragma unroll
        for (int ct = 0; ct < 3; ++ct)
#pragma unroll
            for (int rg = 0; rg < 16; ++rg) part[((wid * 3 + ct) * 16 + rg) * 64 + lane] = acc[ct][rg];
        __syncthreads();
        if (tid < 32) { float t = 0.f;
#pragma unroll
            for (int w = 0; w < 8; ++w) t += ssqp[w * 32 + tid];
            rsv[tid] = rsqrtf(t * (1.f / DM) + EPS); }
#pragma unroll
        for (int q = 0; q < 6; ++q) { const int o = tid + NTHR * q, col = o >> 5, tok = o & 31, ct = col >> 5, cl = col & 31, h2 = (cl >> 2) & 1, rg = (cl & 3) + 4 * (cl >> 3);
            float t = 0.f;
#pragma unroll
            for (int w = 0; w < 8; ++w) t += part[((w * 3 + ct) * 16 + rg) * 64 + h2 * 32 + tok];
            lg[tok * 97 + col] = t; }
        __syncthreads();
        if (tid < 32) {
            const int t = tok0 + tid; const float rs = rsv[tid]; const float* l = lg + tid * 97;
            const float* brg = P->brg + layer * 8; const float* bre = P->bre + layer * 64;
            float gl[8];
#pragma unroll
            for (int j = 0; j < 8; ++j) gl[j] = l[j] * rs + brg[j];
            int gs = 0; float gm = gl[0];
#pragma unroll
            for (int j = 1; j < 8; ++j) if (gl[j] > gm) { gm = gl[j]; gs = j; }
            float den = 0.f;
#pragma unroll
            for (int j = 0; j < 8; ++j) den += expf(gl[j] - gm);
            const float pg = 1.f / den;
            float el[8];
#pragma unroll
            for (int j = 0; j < 8; ++j) el[j] = l[8 + gs * 8 + j] * rs + bre[gs * 8 + j];
            int j0 = 0; float v0 = el[0];
#pragma unroll
            for (int j = 1; j < 8; ++j) if (el[j] > v0) { v0 = el[j]; j0 = j; }
            int j1 = -1; float v1 = -INFINITY;
#pragma unroll
            for (int j = 0; j < 8; ++j) if (j != j0 && el[j] > v1) { v1 = el[j]; j1 = j; }
            const float e1 = expf(v1 - v0), g0 = pg / (1.f + e1), g1 = pg * e1 / (1.f + e1);
            const int x0 = gs * 8 + j0, x1 = gs * 8 + j1;
            P->ridx[t * 2] = x0; P->ridx[t * 2 + 1] = x1; P->rgate[t * 2] = g0; P->rgate[t * 2 + 1] = g1;
            const int s0 = atomicAdd(&P->cnt[x0 * CSTR], 1), s1 = atomicAdd(&P->cnt[x1 * CSTR], 1);
            P->rslot[t * 2] = s0; P->rslot[t * 2 + 1] = s1;
            P->rsn[t] = rs;
            if (s0 < ECAP) { P->elist[x0 * ECAP + s0] = t; P->ers[x0 * ECAP + s0] = rs; } if (s1 < ECAP) { P->elist[x1 * ECAP + s1] = t; P->ers[x1 * ECAP + s1] = rs; }
        }
        __syncthreads();
    }
}
}
__device__ __forceinline__ void ph_combine_norm(KP P, char* lds, int layer) {
    int* base = (int*)lds;
    const int tid = tid_(), lane = tid & 63, gw = bid_() * 8 + (tid >> 6), NGW = gridDim.x * 8;
    if (tid < 64) base[64 + tid] = P->cnt[tid * CSTR];
    __syncthreads();
    if (tid < 64) { int a = 0; for (int q = 0; q < tid; ++q) a += base[64 + q]; base[tid] = a; }
    __syncthreads();
    for (int t0 = gw; t0 < TOK; t0 += 2 * NGW) {
        int r0[2], r1[2]; float g0[2], g1[2]; bool ok[2]; int tcs[2];
        int2 ex[2], sl[2]; float2 gg[2];
        float4 v[2][8]; uint2 ya[2][8], yb[2][8], dl[2][8];
#pragma unroll
        for (int q = 0; q < 2; ++q) { const int t = t0 + q * NGW; ok[q] = t < TOK && !(layer == 1 && (t % LL) < NMETA); tcs[q] = ok[q] ? t : (layer == 1 ? NMETA : t0);
            ex[q] = ((const int2*)P->ridx)[tcs[q]]; sl[q] = ((const int2*)P->rslot)[tcs[q]]; gg[q] = ((const float2*)P->rgate)[tcs[q]];
#pragma unroll
            for (int j = 0; j < 8; ++j) { v[q][j] = ((const float4*)(P->Z + (size_t)tcs[q] * DM))[lane + 64 * j]; dl[q][j] = ((const uint2*)(P->DLT + (size_t)tcs[q] * DM))[lane + 64 * j]; } }
#pragma unroll
        for (int q = 0; q < 2; ++q) { r0[q] = base[ex[q].x] + sl[q].x; r1[q] = base[ex[q].y] + sl[q].y; g0[q] = gg[q].x; g1[q] = gg[q].y;
#pragma unroll
            for (int j = 0; j < 8; ++j) { ya[q][j] = ((const uint2*)(P->Y + (size_t)r0[q] * DM))[lane + 64 * j]; yb[q][j] = ((const uint2*)(P->Y + (size_t)r1[q] * DM))[lane + 64 * j]; } }
#pragma unroll
        for (int q = 0; q < 2; ++q) if (ok[q]) { const int t = t0 + q * NGW;
            float ss = 0.f;
#pragma unroll
            for (int j = 0; j < 8; ++j) { const uint2 a = ya[q][j], b = yb[q][j], d = dl[q][j]; float4& x = v[q][j];
                x.x += __uint_as_float(d.x << 16); x.y += __uint_as_float(d.x & 0xffff0000u); x.z += __uint_as_float(d.y << 16); x.w += __uint_as_float(d.y & 0xffff0000u);
                x.x += g0[q] * __uint_as_float(a.x << 16) + g1[q] * __uint_as_float(b.x << 16); x.y += g0[q] * __uint_as_float(a.x & 0xffff0000u) + g1[q] * __uint_as_float(b.x & 0xffff0000u);
                x.z += g0[q] * __uint_as_float(a.y << 16) + g1[q] * __uint_as_float(b.y << 16); x.w += g0[q] * __uint_as_float(a.y & 0xffff0000u) + g1[q] * __uint_as_float(b.y & 0xffff0000u);
                ss += x.x * x.x + x.y * x.y + x.z * x.z + x.w * x.w; }
            const float rs = rsqrtf(wave_sum(ss) * (1.f / DM) + EPS);
            if (layer == 0) {
#pragma unroll
                for (int j = 0; j < 8; ++j) { ((float4*)(P->Z + (size_t)t * DM))[lane + 64 * j] = v[q][j];
                    const float4 w = ((const float4*)(P->ln1_w + DM))[lane + 64 * j];
                    uint2 o; o.x = cvtpk_(v[q][j].x * rs * w.x, v[q][j].y * rs * w.y); o.y = cvtpk_(v[q][j].z * rs * w.z, v[q][j].w * rs * w.w);
                    ((uint2*)(P->HN + (size_t)t * DM))[lane + 64 * j] = o; }
            } else {
                const int b = t / LL, tt = t % LL;
                if (tt >= NMETA) {
#pragma unroll
                    for (int j = 0; j < 8; ++j) { const float4 w = ((const float4*)P->fnw)[lane + 64 * j];
                        ((float4*)(P->out + ((size_t)b * SEQ + (tt - NMETA)) * DM))[lane + 64 * j] = make_float4(v[q][j].x * rs * w.x, v[q][j].y * rs * w.y, v[q][j].z * rs * w.z, v[q][j].w * rs * w.w); }
                }
            }
        }
    }
    __syncthreads();
}

__global__ void __launch_bounds__(NTHR, 2) mega_fwd(Params P_arg) {
    extern __shared__ __attribute__((aligned(16))) char lds[];
    const int tid = tid_(), G = gridDim.x;
    volatile LAS unsigned* ctlw = (volatile LAS unsigned*)((LAS char*)lds + LDS_CTL);
    if (tid < 64) ctlw[tid] = 0u;
    __syncthreads();
    KP P = kp_();
    XcdBarrier bar = xcd_barrier_post(P->bar, ctlw + 8);
#define GRID_BAR() do { xcd_barrier(bar); P = kp_(); } while (0)

    ph_build_norm(P);
    ph_prep(P);
    ph_weights(P, lds);
    __syncthreads();
    for (int un = bid_(); un < 64; un += G) s5::prep_unit(P, lds, un >> 5, un & 31);
    GRID_BAR();
#pragma unroll
    for (int layer = 0; layer < 2; ++layer) {
        { pg8::Gemm g{P->HN, P->WinT + (size_t)layer * INW * DM, MP, INW, DM, DM}; pg8::StaticOrder S; S.init(MP, INW, G, bid_(), DM / 64); pg8::EpiInProj E{P->PA, P->QKV};
          pg8::gemm_phase<pg8::EpiInProj, pg8::StaticOrder, true, true>((LAS unsigned char*)lds, g, S, E); }
        { const int t2 = tid_(), b2 = bid_(); if (b2 == 0 && t2 < NE) P->cnt[t2 * CSTR] = 0;
 }
        GRID_BAR();
        hg::local_states(P, lds, layer);
        { const int b0 = bid_(); for (int un = (G == 256) ? ((b0 + 128) & 255) : b0; un < 128; un += G) s5::fused_unit(P, lds, layer, un >> 5, un & 31); }
        ph_attention(P, lds);
        GRID_BAR();
        hg::scan_states(P);
        ph_attn_out(P, layer, G > 192 ? 132 : 0);
        __syncthreads();
        { pg8::Gemm g{P->YG, P->WgluT + (size_t)layer * 1024 * 512, MP, 1024, 512, 512}; pg8::StaticOrder S; S.init(MP, 1024, G, bid_(), 512 / 64); pg8::EpiGlu E{P->MIX, P->b_glu + layer * 1024};
          pg8::gemm_phase<pg8::EpiGlu, pg8::StaticOrder, true, true>((LAS unsigned char*)lds, g, S, E); }
        GRID_BAR();
        hg::outputs(P, lds, layer);
        GRID_BAR();
        { pg8::Gemm g{P->MIX, P->WoutT + (size_t)layer * DM * DM, MP, DM, DM, DM}; pg8::StaticOrder S; S.init(MP, DM, G, bid_(), DM / 64); pg8::EpiResidual E{P->DLT};
          pg8::gemm_phase<pg8::EpiResidual, pg8::StaticOrder, true, true>((LAS unsigned char*)lds, g, S, E); }
        GRID_BAR();
        rt::norm_router(P, lds, layer);
        GRID_BAR();
        moe::stream_gemm<true>(P, lds, layer);
        GRID_BAR();
        moe::stream_gemm<false>(P, lds, layer);
        GRID_BAR();
        ph_combine_norm(P, lds, layer);
        if (layer == 0) GRID_BAR();
    }
}
}

extern "C" void kernel_launch(void* const* d_in, const int* in_sizes, int n_in, void* d_out, int out_size, void* d_ws, size_t ws_size, hipStream_t stream) {
    static int grid = 0;
    if (grid == 0) {
        int dev = 0, cus = 0;
        if (hipGetDevice(&dev) != hipSuccess || hipDeviceGetAttribute(&cus, hipDeviceAttributeMultiprocessorCount, dev) != hipSuccess) { grid = -1; return; }
        if (hipFuncSetAttribute((const void*)mega_fwd, hipFuncAttributeMaxDynamicSharedMemorySize, LDS_BYTES) != hipSuccess) { grid = -1; return; }
        int per_cu = 0;
        if (hipOccupancyMaxActiveBlocksPerMultiprocessor(&per_cu, (const void*)mega_fwd, NTHR, LDS_BYTES) != hipSuccess || per_cu < 1) { (void)hipGetLastError(); }
        grid = cus;
    }
    if (grid < 0) return;
    Params p{};
    const float** pin = (const float**)&p;
    for (int i = 0; i < 31; ++i) pin[i] = (const float*)d_in[i];
    p.out = (float*)d_out;
    char* ws = (char*)d_ws; size_t off = 0;
    auto alloc = [&](size_t bytes) { char* q = ws + off; off += (bytes + 255) & ~(size_t)255; return q; };
    p.bar = (unsigned*)alloc(XCD_BAR_WORDS * 4);
    p.elist = (int*)alloc((size_t)NE * ECAP * 4); p.ers = (float*)alloc((size_t)NE * ECAP * 4); p.rsn = (float*)alloc((size_t)MP * 4);
    p.cnt = (int*)alloc((size_t)NE * CSTR * 4); p.blk_e = (int*)alloc(1024); p.base = (int*)alloc(256);
    p.lbtab = (float*)alloc(1024 * 4); p.lam = (float*)alloc(256);
    p.Z = (float*)alloc((size_t)MP * DM * 4);
    p.HN = (bf16_t*)alloc((size_t)MP * DM * 2);
    p.PA = (float*)alloc((size_t)MP * PAW * 4);
    p.QKV = (bf16_t*)alloc((size_t)MP * QKVW * 2);
    p.OA = (float*)alloc((size_t)MP * HW * 4);
    p.ZP = (float*)alloc((size_t)8 * 256 * DM * 4);
    p.WRT = (bf16_t*)alloc((size_t)2 * 2 * 96 * DM * 2);
    p.A16 = (float*)alloc(2 * 32 * 64 * 8); p.S5E = (float*)alloc((size_t)516 * 32 * 128 * 4); p.S5X = (float*)alloc((size_t)516 * 32 * 128 * 4);
    p.BtY = (bf16_t*)alloc((size_t)2 * 32 * 256 * 384 * 2); p.BtE = (bf16_t*)alloc((size_t)2 * 32 * 128 * 256 * 2);
    p.SLOC = (float*)alloc((size_t)528 * 16384 * 4); p.DEC = (float*)alloc((size_t)528 * 128 * 4); p.SPREV = (bf16_t*)alloc((size_t)529 * 16384 * 2);
    p.YG = (bf16_t*)alloc((size_t)MP * 512 * 2); p.DLT = (bf16_t*)alloc((size_t)MP * DM * 2);
    p.T = nullptr;
    p.MIX = (bf16_t*)alloc((size_t)MP * DM * 2);
    p.OC = (float*)alloc((size_t)MP * DM * 4);
    p.ridx = (int*)alloc((size_t)NASSIGN * 4); p.rgate = (float*)alloc((size_t)NASSIGN * 4); p.rslot = (int*)alloc((size_t)NASSIGN * 4);
    p.tokrow = (int*)alloc((size_t)NASSIGN * 4); p.rowtok = (int*)alloc((size_t)NRMAX * 4);
    p.H1 = nullptr;
    p.H = (bf16_t*)alloc((size_t)NRMAX * DE * 2);
    p.Y = (bf16_t*)alloc((size_t)NRMAX * DM * 2);
    p.S = nullptr;
    p.WinT = (bf16_t*)alloc((size_t)2 * INW * DM * 2); p.WoutT = (bf16_t*)alloc((size_t)2 * DM * DM * 2); p.WgluT = (bf16_t*)alloc((size_t)2 * 1024 * 512 * 2);
    if (off > ws_size) return;
    if (hipMemsetAsync(p.bar, 0, XCD_BAR_WORDS * 4, stream) != hipSuccess) return;
    hipLaunchKernelGGL(mega_fwd, dim3(grid), dim3(NTHR), LDS_BYTES, stream, p);
}
```

```cpp
#include <hip/hip_runtime.h>
#include <stdint.h>
#include <math.h>

namespace {
typedef unsigned short bf16_t;
constexpr int DM = 2048, NB = 4, SEQ = 2048, NMETA = 16, LL = SEQ + NMETA, TOK = NB * LL, MP = 8448;
constexpr int HW = 512;
constexpr int INW = 5632, PAW = 2560, QKVW = 3072;
constexpr int NE = 64, DE = 512, NASSIGN = TOK * 2;
constexpr int RB = 128;
constexpr int NRMAX = NASSIGN + NE * RB;
constexpr float EPS = 1e-6f;
constexpr int NTHR = 512;
constexpr int CSTR = 64;
constexpr int ECAP = 1024;
constexpr int LDS_BYTES = 163840;
constexpr int LDS_CTL = 159744;

__device__ __forceinline__ float bf2f(bf16_t h) { return __uint_as_float(((unsigned)h) << 16); }
__device__ __forceinline__ bf16_t f2bf(float f) { unsigned u = __float_as_uint(f); return (bf16_t)((u + 0x7fffu + ((u >> 16) & 1u)) >> 16); }
__device__ __forceinline__ float sigmoidf_(float x) { return 1.f / (1.f + expf(-x)); }
__device__ __forceinline__ int tid_() { int t = threadIdx.x; asm volatile("" : "+v"(t)); return t; }
template <int K> __device__ __forceinline__ float swz_xor(float v) { return __int_as_float(__builtin_amdgcn_ds_swizzle(__float_as_int(v), (K << 10) | 0x1f)); }
__device__ __forceinline__ int bid_() { int b = blockIdx.x; asm volatile("" : "+s"(b)); return b; }

#define XB_TMO      128
#define XB_XCNT(j)  (256  + 64 * (j))
#define XB_XSUB(j)  (1280 + 64 * (j))
#define XB_XGEN(j)  (2304 + 64 * (j))
#define XB_TOP      3328
#define XB_TOPGEN   3392
#define XCD_BAR_WORDS 3456
#define XB_SPIN_CAP (1u << 24)
#define LAS __attribute__((address_space(3)))
__device__ __forceinline__ unsigned xb_ld(unsigned* p)              { return __hip_atomic_load(p, __ATOMIC_RELAXED, __HIP_MEMORY_SCOPE_AGENT); }
__device__ __forceinline__ unsigned xb_add(unsigned* p, unsigned v) { return __hip_atomic_fetch_add(p, v, __ATOMIC_RELAXED, __HIP_MEMORY_SCOPE_AGENT); }
__device__ __forceinline__ unsigned xb_xcc_id() { return (unsigned)__builtin_amdgcn_s_getreg((3 << 11) | 20) & 0xFu; }
#define XB_SPIN(cond, bar) do { unsigned _sp = 0; while (cond) { __builtin_amdgcn_s_sleep(1); \
    if ((++_sp & 255u) == 0u) { if (xb_ld(&(bar)[XB_TMO])) break; if (_sp > XB_SPIN_CAP) { atomicAdd(&(bar)[XB_TMO], 1u); break; } } } } while (0)
struct XcdBarrier { unsigned* bar; unsigned x; volatile LAS unsigned* st; };
__device__ __forceinline__ XcdBarrier xcd_barrier_post(unsigned* bar, volatile LAS unsigned* st) {
    XcdBarrier b; b.bar = bar; b.x = xb_xcc_id(); b.st = st;
    if (threadIdx.x == 0) (void)xb_add(&bar[XB_XCNT(b.x)], 1u);
    return b;
}
__device__ __forceinline__ void xcd_barrier_complete(unsigned* bar, unsigned x, unsigned& nloc, unsigned& nx) {
    const unsigned G = gridDim.x * gridDim.y * gridDim.z;
    unsigned sum, cnt, mine, sp = 0u;
    for (;;) {
        sum = 0u; cnt = 0u; mine = 0u;
#pragma unroll
        for (unsigned j = 0; j < 16; ++j) { const unsigned c = xb_ld(&bar[XB_XCNT(j)]); sum += c; cnt += (c > 0u) ? 1u : 0u; mine = (j == x) ? c : mine; }
        if (sum == G) break;
        __builtin_amdgcn_s_sleep(1);
        if ((++sp & 255u) == 0u) { if (xb_ld(&bar[XB_TMO])) break; if (sp > XB_SPIN_CAP) { atomicAdd(&bar[XB_TMO], 1u); break; } }
    }
    nloc = mine > 0u ? mine : 1u; nx = cnt > 0u ? cnt : 1u;
}
__device__ __forceinline__ void xcd_barrier(const XcdBarrier& b) {
    asm volatile("s_waitcnt vmcnt(0)" ::: "memory");
    __syncthreads();
    if (threadIdx.x == 0) {
        unsigned* bar = b.bar;
        const unsigned bx_ = xb_xcc_id();
        __builtin_amdgcn_s_waitcnt(0);
        unsigned nloc = b.st[0], nx = b.st[1];
        if (nloc == 0u) { xcd_barrier_complete(bar, bx_, nloc, nx); b.st[0] = nloc; b.st[1] = nx; }
        const unsigned old = xb_add(&bar[XB_XSUB(bx_)], 1u);
        const unsigned gen = old / nloc;
        if (old + 1u == (gen + 1u) * nloc) {
            __builtin_amdgcn_fence(__ATOMIC_RELEASE, "agent");
            asm volatile("s_waitcnt vmcnt(0)" ::: "memory");
            const unsigned og = xb_add(&bar[XB_TOP], 1u);
            const unsigned tg = og / nx;
            if (og + 1u == (tg + 1u) * nx) xb_add(&bar[XB_TOPGEN], 1u);
            else XB_SPIN(xb_ld(&bar[XB_TOPGEN]) == tg, bar);
            __builtin_amdgcn_fence(__ATOMIC_ACQUIRE, "agent");
            xb_add(&bar[XB_XGEN(bx_)], 1u);
            asm volatile("s_waitcnt vmcnt(0)" ::: "memory");
        } else {
            XB_SPIN(xb_ld(&bar[XB_XGEN(bx_)]) == gen, bar);
            __builtin_amdgcn_fence(__ATOMIC_ACQUIRE, "agent");
            asm volatile("s_waitcnt vmcnt(0)" ::: "memory");
        }
    }
    __syncthreads();
}

struct Params {
    const float *x, *meta, *ln1_w, *w_in, *lbnd, *hnw, *a_re, *a_im, *b_re, *b_im, *c_re, *c_im, *s5d, *log_dt, *w_glu, *b_glu,
                *lq1, *lk1, *lq2, *lk2, *subln, *w_out, *ln2_w, *wrg, *brg, *wre, *bre, *w1, *w3, *w2, *fnw;
    float* out;
    unsigned* bar;
    int *cnt, *blk_e, *ridx, *rslot, *tokrow, *rowtok, *base, *elist;
    float *lbtab, *lam, *Z, *PA, *OA, *T, *OC, *rgate, *H1, *S, *SLOC, *DEC, *A16, *S5E, *S5X, *ZP, *ers, *rsn;
    bf16_t *HN, *QKV, *YG, *MIX, *H, *Y, *WinT, *WoutT, *WgluT, *SPREV, *BtY, *BtE, *WRT, *DLT;
};
typedef const __attribute__((address_space(4))) Params* KP;
__device__ __forceinline__ KP kp_() { KP p = (KP)__builtin_amdgcn_kernarg_segment_ptr(); asm volatile("" : "+s"(p)); return p; }


namespace pg8 {
#define PG8_LAS __attribute__((address_space(3)))
typedef short bf16x8 __attribute__((ext_vector_type(8)));
typedef float f32x4 __attribute__((ext_vector_type(4)));
typedef unsigned u32x4 __attribute__((ext_vector_type(4)));
constexpr int BM = 256, BK = 64, HALF = 128, HTB = HALF * BK * 2, STAGE_BYTES = 8 * HTB, NXCD = 8, WGM = 8;
__host__ __device__ __forceinline__ int lds_byte(int r, int c) { const int st = (r >> 4) * 2 + (c >> 5), rr = r & 15, cc = c & 31, ob = rr * 64 + cc * 2; return st * 1024 + (ob ^ (((ob >> 9) & 1) << 5)); }
__host__ __device__ __forceinline__ void stage_rc(int b, int& R, int& C) { const int st = b / 1024, sb = b % 1024, swz = sb ^ (((sb >> 9) & 1) << 5); R = (st >> 1) * 16 + swz / 64; C = (st & 1) * 32 + (swz % 64) / 2; }
__host__ __device__ __forceinline__ int perm32(int rho) { const int n = rho >> 4, i = rho & 15; return 8 * (i >> 2) + 4 * n + (i & 3); }
struct Unit { int pm, pn, ko, nt; };
struct Gemm { const bf16_t* A; const bf16_t* Bt; int M, N, K, ld; };
struct StaticOrder {
    static constexpr bool PER_UNIT_K = false;
    int nM, nN, nwg, G, c, nt;
    __host__ __device__ void init(int M, int N, int G_, int c_, int nt_) { nM = M / BM; nN = N / BM; nwg = nM * nN; G = G_; c = c_; nt = nt_; }
    __host__ __device__ bool next(int i, Unit& u) const {
        const long L = (long)i * G + c; if (L >= nwg) return false;
        int wgid = (int)L; { const int q = nwg / NXCD, r = nwg % NXCD, xcd = wgid % NXCD, off = wgid / NXCD; wgid = (xcd < r ? xcd * (q + 1) : r * (q + 1) + (xcd - r) * q) + off; }
        const int nig = WGM * nN, gid = wgid / nig, fm = gid * WGM, gsz = (nM - fm) < WGM ? (nM - fm) : WGM;
        u.pm = fm + ((wgid % nig) % gsz); u.pn = (wgid % nig) / gsz; u.ko = 0; u.nt = nt; return true;
    }
    __device__ __forceinline__ void a_ready(const Unit&) const {}
    __device__ __forceinline__ void done(const Unit&) const {}
};
__device__ __forceinline__ unsigned cvt_pk_bf16(float lo, float hi) { unsigned r; asm volatile("v_cvt_pk_bf16_f32 %0, %1, %2" : "=v"(r) : "v"(lo), "v"(hi)); return r; }

template <class Epi, class Sched, bool ALIGN_EPI = false, bool SP2 = false>
__device__ __forceinline__ void gemm_phase(PG8_LAS unsigned char* lds, const Gemm g, const Sched& S, const Epi& E) {
    const int tid = tid_(), wid = __builtin_amdgcn_readfirstlane(tid >> 6), lane = tid & 63, wr = wid >> 2, wc = wid & 3, fr = lane & 15, fq = lane >> 4;
    const int K = g.ld;
    unsigned voffA[2], voffB[2];
#pragma unroll
    for (int i = 0; i < 2; ++i) { int R, C; stage_rc(tid * 16 + i * 8192, R, C); const int Rb = Epi::PERM ? ((R & ~31) + perm32(R & 31)) : R;
        voffA[i] = (unsigned)(R * K + C) * 2u; voffB[i] = (unsigned)(Rb * K + C) * 2u; }
    const size_t kstep = (size_t)(BK * 2);
    const size_t hstep = (size_t)HALF * K * 2;
    const size_t tstep = 2 * hstep;
    const unsigned ldsw = (unsigned)wid * 1024u;
    const int aoff = lds_byte(wr * 64 + fr, fq * 8), boff = lds_byte(wc * 32 + fr, fq * 8);
#define PG8_SA(b, h) (((b) * 2 + (h)) * HTB)
#define PG8_SB(b, h) ((4 + (b) * 2 + (h)) * HTB)
#define PG8_STAGE(bufoff, gbase, voff) do { _Pragma("unroll") for (int _i = 0; _i < 2; ++_i) \
        __builtin_amdgcn_global_load_lds((const unsigned*)((const char*)(gbase) + (voff)[_i]), (PG8_LAS unsigned*)(lds + (bufoff) + ldsw + _i * 8192), 16, 0, 0); } while (0)
#define PG8_LDA(dst, b, h) do { _Pragma("unroll") for (int m = 0; m < 4; ++m) _Pragma("unroll") for (int k = 0; k < 2; ++k) dst[m][k] = *(const PG8_LAS bf16x8*)(lds + PG8_SA(b, h) + aoff + m * 2048 + k * 1024); } while (0)
#define PG8_LDB(dst, b, h) do { _Pragma("unroll") for (int n = 0; n < 2; ++n) _Pragma("unroll") for (int k = 0; k < 2; ++k) dst[n][k] = *(const PG8_LAS bf16x8*)(lds + PG8_SB(b, h) + boff + n * 2048 + k * 1024); } while (0)
#define PG8_MMA(ai, bj, At, Bt) do { __builtin_amdgcn_s_setprio(1); _Pragma("unroll") for (int m = 0; m < 4; ++m) _Pragma("unroll") for (int n = 0; n < 2; ++n) _Pragma("unroll") for (int k = 0; k < 2; ++k) \
        acc[ai][bj][m][n] = __builtin_amdgcn_mfma_f32_16x16x32_bf16(Bt[n][k], At[m][k], acc[ai][bj][m][n], 0, 0, 0); __builtin_amdgcn_s_setprio(0); } while (0)
#define PG8_WAIT_V(n) asm volatile("s_waitcnt vmcnt(" #n ")" ::: "memory")
#define PG8_WAIT_L(n) asm volatile("s_waitcnt lgkmcnt(" #n ")" ::: "memory")
#define PG8_BAR __builtin_amdgcn_s_barrier()
#define PG8_SCHED __builtin_amdgcn_sched_barrier(0)
    Unit cur, nxt; int ui = 0;
    if (!S.next(0, cur)) return;
    f32x4 acc[2][2][4][2];
#pragma unroll
    for (int a = 0; a < 2; ++a)
#pragma unroll
        for (int b = 0; b < 2; ++b)
#pragma unroll
            for (int m = 0; m < 4; ++m)
#pragma unroll
                for (int n = 0; n < 2; ++n) acc[a][b][m][n] = (f32x4){0.f, 0.f, 0.f, 0.f};
    bf16x8 At[4][2], B0[2][2], B1[2][2];
    const char* cA = (const char*)g.A + (size_t)cur.pm * tstep + (size_t)cur.ko * 2; const char* cB = (const char*)g.Bt + (size_t)cur.pn * tstep + (size_t)cur.ko * 2;
    S.a_ready(cur);
    if constexpr (SP2) {
        PG8_STAGE(PG8_SB(0, 0), cB, voffB); PG8_STAGE(PG8_SB(0, 1), cB + hstep, voffB); PG8_STAGE(PG8_SA(0, 0), cA, voffA); PG8_STAGE(PG8_SA(0, 1), cA + hstep, voffA);
        if (wr == 1) PG8_BAR;
        PG8_WAIT_V(2); PG8_BAR;
        PG8_STAGE(PG8_SB(1, 0), cB + kstep, voffB); PG8_STAGE(PG8_SA(1, 0), cA + kstep, voffA); PG8_STAGE(PG8_SB(1, 1), cB + hstep + kstep, voffB);
        PG8_WAIT_V(6); PG8_BAR;
    } else {
        PG8_STAGE(PG8_SB(0, 0), cB, voffB); PG8_STAGE(PG8_SA(0, 0), cA, voffA); PG8_STAGE(PG8_SB(0, 1), cB + hstep, voffB); PG8_STAGE(PG8_SA(0, 1), cA + hstep, voffA);
        if (wr == 1) PG8_BAR;
        PG8_WAIT_V(4); PG8_BAR;
        PG8_STAGE(PG8_SB(1, 0), cB + kstep, voffB); PG8_STAGE(PG8_SA(1, 0), cA + kstep, voffA); PG8_STAGE(PG8_SB(1, 1), cB + hstep + kstep, voffB);
        PG8_WAIT_V(6); PG8_BAR;
    }
    for (;;) {
        const bool has_next = S.next(ui + 1, nxt);
        const char* nA = has_next ? (const char*)g.A + (size_t)nxt.pm * tstep + (size_t)nxt.ko * 2 : cA; const char* nB = has_next ? (const char*)g.Bt + (size_t)nxt.pn * tstep + (size_t)nxt.ko * 2 : cB;
        const int nt = Sched::PER_UNIT_K ? cur.nt : g.K / BK;
        for (int t = 0; t < nt; t += 2) {
            const bool last = (t == nt - 2);
            const char* a1 = cA + (size_t)(t + 1) * kstep;
            const char* a2 = last ? nA : cA + (size_t)(t + 2) * kstep; const char* b2 = last ? nB : cB + (size_t)(t + 2) * kstep;
            const char* a3 = a2 + kstep; const char* b3 = b2 + kstep;
            if (last && has_next) S.a_ready(nxt);
            if constexpr (SP2) {
            PG8_LDB(B0, 0, 0); PG8_LDB(B1, 0, 1); PG8_SCHED; PG8_LDA(At, 0, 0); PG8_STAGE(PG8_SA(1, 1), a1 + hstep, voffA);
            PG8_WAIT_V(8); PG8_WAIT_L(0); PG8_BAR; PG8_MMA(0, 0, At, B0); PG8_MMA(0, 1, At, B1); PG8_BAR; PG8_SCHED;
            PG8_LDA(At, 0, 1); PG8_STAGE(PG8_SB(0, 0), b2, voffB); PG8_STAGE(PG8_SB(0, 1), b2 + hstep, voffB); PG8_STAGE(PG8_SA(0, 0), a2, voffA);
            PG8_WAIT_V(8); PG8_WAIT_L(0); PG8_BAR; PG8_MMA(1, 0, At, B0); PG8_MMA(1, 1, At, B1); PG8_BAR; PG8_SCHED;
            PG8_LDB(B0, 1, 0); PG8_LDB(B1, 1, 1); PG8_SCHED; PG8_LDA(At, 1, 0); PG8_STAGE(PG8_SA(0, 1), a2 + hstep, voffA);
            PG8_WAIT_V(8); PG8_WAIT_L(0); PG8_BAR; PG8_MMA(0, 0, At, B0); PG8_MMA(0, 1, At, B1); PG8_BAR; PG8_SCHED;
            PG8_LDA(At, 1, 1); PG8_STAGE(PG8_SB(1, 0), b3, voffB); PG8_STAGE(PG8_SB(1, 1), b3 + hstep, voffB); PG8_STAGE(PG8_SA(1, 0), a3, voffA);
            PG8_WAIT_V(8); PG8_WAIT_L(0); PG8_BAR; PG8_MMA(1, 0, At, B0); PG8_MMA(1, 1, At, B1); PG8_BAR; PG8_SCHED;
            } else {
            PG8_LDB(B0, 0, 0); PG8_SCHED; PG8_LDA(At, 0, 0); PG8_STAGE(PG8_SA(1, 1), a1 + hstep, voffA);
            PG8_WAIT_L(8); PG8_BAR; PG8_WAIT_L(0); PG8_MMA(0, 0, At, B0); PG8_BAR; PG8_SCHED;
            PG8_LDB(B1, 0, 1); PG8_STAGE(PG8_SB(0, 0), b2, voffB);
            PG8_BAR; PG8_WAIT_L(0); PG8_MMA(0, 1, At, B1); PG8_BAR;
            PG8_LDA(At, 0, 1); PG8_STAGE(PG8_SA(0, 0), a2, voffA);
            PG8_BAR; PG8_WAIT_L(0); PG8_MMA(1, 0, At, B0); PG8_BAR; PG8_SCHED;
            PG8_STAGE(PG8_SB(0, 1), b2 + hstep, voffB);
            PG8_WAIT_V(6); PG8_BAR; PG8_MMA(1, 1, At, B1); PG8_BAR;
            PG8_LDB(B0, 1, 0); PG8_SCHED; PG8_LDA(At, 1, 0); PG8_STAGE(PG8_SA(0, 1), a2 + hstep, voffA);
            PG8_WAIT_L(8); PG8_BAR; PG8_WAIT_L(0); PG8_MMA(0, 0, At, B0); PG8_BAR; PG8_SCHED;
            PG8_LDB(B1, 1, 1); PG8_STAGE(PG8_SB(1, 0), b3, voffB);
            PG8_BAR; PG8_WAIT_L(0); PG8_MMA(0, 1, At, B1); PG8_BAR;
            PG8_LDA(At, 1, 1); PG8_STAGE(PG8_SA(1, 0), a3, voffA);
            PG8_BAR; PG8_WAIT_L(0); PG8_MMA(1, 0, At, B0); PG8_BAR; PG8_SCHED;
            PG8_STAGE(PG8_SB(1, 1), b3 + hstep, voffB);
            PG8_WAIT_V(6); PG8_BAR; PG8_MMA(1, 1, At, B1); PG8_BAR;
            }
        }
        if constexpr (ALIGN_EPI) { if (wr == 0) PG8_BAR; }
        E(acc, cur, wr, wc, fr, fq);
        if (!has_next) break;
#pragma unroll
        for (int a = 0; a < 2; ++a)
#pragma unroll
            for (int b = 0; b < 2; ++b)
#pragma unroll
                for (int m = 0; m < 4; ++m)
#pragma unroll
                    for (int n = 0; n < 2; ++n) acc[a][b][m][n] = (f32x4){0.f, 0.f, 0.f, 0.f};
        cur = nxt; cA = nA; cB = nB; ++ui;
        if constexpr (ALIGN_EPI) { if (wr == 1) PG8_BAR; }
    }
    PG8_WAIT_V(0);
    if constexpr (!ALIGN_EPI) { if (wr == 0) PG8_BAR; }
    PG8_BAR;
#undef PG8_SA
#undef PG8_SB
#undef PG8_STAGE
#undef PG8_LDA
#undef PG8_LDB
#undef PG8_MMA
#undef PG8_WAIT_V
#undef PG8_WAIT_L
#undef PG8_BAR
#undef PG8_SCHED
}
struct EpiInProj {
    static constexpr bool PERM = true;
    float* PA; bf16_t* QKV;
    __device__ __forceinline__ void operator()(const f32x4 (&acc)[2][2][4][2], const Unit& u, int wr, int wc, int fr, int fq) const {
        const int row0 = u.pm * BM + wr * 64 + fr, colt = u.pn * BM + wc * 32 + 8 * fq;
        if (colt < PAW) {
#pragma unroll
            for (int ai = 0; ai < 2; ++ai)
#pragma unroll
                for (int m = 0; m < 4; ++m) { float* rp = PA + (size_t)(row0 + ai * HALF + m * 16) * PAW + colt;
#pragma unroll
                    for (int bj = 0; bj < 2; ++bj) { *(f32x4*)(rp + bj * HALF) = acc[ai][bj][m][0]; *(f32x4*)(rp + bj * HALF + 4) = acc[ai][bj][m][1]; } }
        } else {
#pragma unroll
            for (int ai = 0; ai < 2; ++ai)
#pragma unroll
                for (int m = 0; m < 4; ++m) { bf16_t* rp = QKV + (size_t)(row0 + ai * HALF + m * 16) * QKVW + (colt - PAW);
#pragma unroll
                    for (int bj = 0; bj < 2; ++bj) { const f32x4 v0 = acc[ai][bj][m][0], v1 = acc[ai][bj][m][1];
                        u32x4 w; w.x = cvt_pk_bf16(v0[0], v0[1]); w.y = cvt_pk_bf16(v0[2], v0[3]); w.z = cvt_pk_bf16(v1[0], v1[1]); w.w = cvt_pk_bf16(v1[2], v1[3]);
                        *(u32x4*)(rp + bj * HALF) = w; } }
        }
    }
};
struct EpiResidual {
    static constexpr bool PERM = true;
    bf16_t* D;
    __device__ __forceinline__ void operator()(const f32x4 (&acc)[2][2][4][2], const Unit& u, int wr, int wc, int fr, int fq) const {
        const int row0 = u.pm * BM + wr * 64 + fr, colt = u.pn * BM + wc * 32 + 8 * fq;
#pragma unroll
        for (int ai = 0; ai < 2; ++ai)
#pragma unroll
            for (int m = 0; m < 4; ++m) { const int row = row0 + ai * HALF + m * 16; if (row < TOK) { bf16_t* rp = D + (size_t)row * DM + colt;
#pragma unroll
                for (int bj = 0; bj < 2; ++bj) { const f32x4 v0 = acc[ai][bj][m][0], v1 = acc[ai][bj][m][1];
                    u32x4 w; w.x = cvt_pk_bf16(v0[0], v0[1]); w.y = cvt_pk_bf16(v0[2], v0[3]); w.z = cvt_pk_bf16(v1[0], v1[1]); w.w = cvt_pk_bf16(v1[2], v1[3]);
                    *(u32x4*)(rp + bj * HALF) = w; } } }
    }
};
struct OutOrder {
    static constexpr bool PER_UNIT_K = true;
    StaticOrder main;
    __device__ bool next(int i, Unit& u) const {
        if (main.next(i, u)) return true;
        const int r0 = (main.nwg + main.G - 1) / main.G;
        const int L = (i - r0) * main.G + main.c; if (i < r0 || L >= 64) return false;
        u.pm = 32; u.pn = L & 7; u.ko = (L >> 3) * 256; u.nt = 4; return true; }
    __device__ __forceinline__ void a_ready(const Unit&) const {}
    __device__ __forceinline__ void done(const Unit&) const {}
};
struct EpiOutProj {
    static constexpr bool PERM = true;
    float* Z; float* ZP;
    __device__ __forceinline__ void operator()(const f32x4 (&acc)[2][2][4][2], const Unit& u, int wr, int wc, int fr, int fq) const {
        const bool tail = u.pm == 32;
        const int row0 = (tail ? (u.ko >> 8) * BM : u.pm * BM) + wr * 64 + fr, colt = u.pn * BM + wc * 32 + 8 * fq;
        float* base = tail ? ZP : Z;
#pragma unroll
        for (int ai = 0; ai < 2; ++ai)
#pragma unroll
            for (int m = 0; m < 4; ++m) { float* rp = base + (size_t)(row0 + ai * HALF + m * 16) * DM + colt;
#pragma unroll
                for (int bj = 0; bj < 2; ++bj) { f32x4* p0 = (f32x4*)(rp + bj * HALF); f32x4* p1 = (f32x4*)(rp + bj * HALF + 4);
                    f32x4 z0 = {0.f, 0.f, 0.f, 0.f}, z1 = {0.f, 0.f, 0.f, 0.f};
                    if (!tail) { z0 = *p0; z1 = *p1; }
                    *p0 = z0 + acc[ai][bj][m][0]; *p1 = z1 + acc[ai][bj][m][1]; } }
    }
};
struct TailOrder {
    static constexpr bool PER_UNIT_K = false;
    int G, c;
    __device__ bool next(int i, Unit& u) const { const int L = i * G + c; if (L >= 64) return false; u.pm = 32; u.pn = L & 7; u.ko = (L >> 3) * 256; u.nt = 4; return true; }
    __device__ __forceinline__ void a_ready(const Unit&) const {}
    __device__ __forceinline__ void done(const Unit&) const {}
};
struct EpiTailPartial {
    static constexpr bool PERM = true;
    float* ZP;
    __device__ __forceinline__ void operator()(const f32x4 (&acc)[2][2][4][2], const Unit& u, int wr, int wc, int fr, int fq) const {
        const int row0 = (u.ko >> 8) * BM + wr * 64 + fr, colt = u.pn * BM + wc * 32 + 8 * fq;
#pragma unroll
        for (int ai = 0; ai < 2; ++ai)
#pragma unroll
            for (int m = 0; m < 4; ++m) { float* rp = ZP + (size_t)(row0 + ai * HALF + m * 16) * DM + colt;
#pragma unroll
                for (int bj = 0; bj < 2; ++bj) { *(f32x4*)(rp + bj * HALF) = acc[ai][bj][m][0]; *(f32x4*)(rp + bj * HALF + 4) = acc[ai][bj][m][1]; } }
    }
};
struct EpiGlu {
    static constexpr bool PERM = true;
    bf16_t* MIX; const float* bias;
    __device__ __forceinline__ void operator()(const f32x4 (&acc)[2][2][4][2], const Unit& u, int wr, int wc, int fr, int fq) const {
        const int row0 = u.pm * BM + wr * 64 + fr, c0 = u.pn * HALF + wc * 32 + 8 * fq;
        const f32x4 bv0 = *(const f32x4*)(bias + c0), bv1 = *(const f32x4*)(bias + c0 + 4), bg0 = *(const f32x4*)(bias + 512 + c0), bg1 = *(const f32x4*)(bias + 512 + c0 + 4);
        float one = 1.f; asm volatile("" : "+v"(one));
#pragma unroll
        for (int ai = 0; ai < 2; ++ai)
#pragma unroll
            for (int m = 0; m < 4; ++m) { const f32x4 v0 = acc[ai][0][m][0] + bv0, v1 = acc[ai][0][m][1] + bv1, g0 = acc[ai][1][m][0] + bg0, g1 = acc[ai][1][m][1] + bg1;
                float o[8];
#pragma unroll
                for (int e = 0; e < 4; ++e) { o[e] = v0[e] * __builtin_amdgcn_rcpf(one + __expf(-g0[e])); o[4 + e] = v1[e] * __builtin_amdgcn_rcpf(one + __expf(-g1[e])); }
                u32x4 w; w.x = cvt_pk_bf16(o[0], o[1]); w.y = cvt_pk_bf16(o[2], o[3]); w.z = cvt_pk_bf16(o[4], o[5]); w.w = cvt_pk_bf16(o[6], o[7]);
                *(u32x4*)(MIX + (size_t)(row0 + ai * HALF + m * 16) * DM + 512 + c0) = w; }
    }
};
}

__device__ __forceinline__ void transpose_item(const float* W, int K, int N, bf16_t* WT, int k0, int n0, int row0, float* scr, int lane) {
    float tv[32];
#pragma unroll
    for (int i = 0; i < 32; ++i) { const int kk = 2 * i + (lane >> 5); tv[i] = W[(size_t)(k0 + kk) * N + n0 + (lane & 31)]; }
#pragma unroll
    for (int i = 0; i < 32; ++i) { const int kk = 2 * i + (lane >> 5); scr[kk * 33 + (lane & 31)] = tv[i]; }
    asm volatile("s_waitcnt lgkmcnt(0)" ::: "memory");
    const int c = lane & 7;
#pragma unroll
    for (int j = 0; j < 4; ++j) { const int n = (lane >> 3) + 8 * j; const float* sp = scr + (8 * c) * 33 + n;
        pg8::u32x4 o; o.x = pg8::cvt_pk_bf16(sp[0 * 33], sp[1 * 33]); o.y = pg8::cvt_pk_bf16(sp[2 * 33], sp[3 * 33]); o.z = pg8::cvt_pk_bf16(sp[4 * 33], sp[5 * 33]); o.w = pg8::cvt_pk_bf16(sp[6 * 33], sp[7 * 33]);
        *(pg8::u32x4*)(WT + (size_t)(row0 + n) * K + k0 + 8 * c) = o; }
    asm volatile("s_waitcnt lgkmcnt(0)" ::: "memory");
}
__device__ __forceinline__ void ph_weights(KP P, char* lds) {
    const int tid = tid_(), lane = tid & 63, wave = tid >> 6;
    float* scr = (float*)lds + wave * (64 * 33);
    const int cu0 = gridDim.x == 256 ? 64 : 0, gw = (bid_() - cu0) * 8 + wave, NGW = (gridDim.x - cu0) * 8;
    if (gw < 0) return;
    constexpr int I_IN = (DM / 64) * (INW / 32), I_OUT = (DM / 64) * (DM / 32), I_GLU = (512 / 64) * (1024 / 32), I_L = I_IN + I_OUT + I_GLU;
    for (int it = gw; it < 2 * I_L; it += NGW) {
        const int layer = it / I_L; int r = it % I_L;
        if (r < I_IN) { const int nb = INW / 32, kb = r / nb, n0 = (r % nb) * 32;
            transpose_item(P->w_in + (size_t)layer * DM * INW, DM, INW, P->WinT + (size_t)layer * INW * DM, kb * 64, n0, n0, scr, lane); continue; }
        r -= I_IN;
        if (r < I_OUT) { const int nb = DM / 32, kb = r / nb, n0 = (r % nb) * 32;
            transpose_item(P->w_out + (size_t)layer * DM * DM, DM, DM, P->WoutT + (size_t)layer * DM * DM, kb * 64, n0, n0, scr, lane); continue; }
        r -= I_OUT;
        { const int nb = 1024 / 32, kb = r / nb, n0 = (r % nb) * 32;
          const int row0 = ((n0 & 511) >> 7) * 256 + (n0 >> 9) * 128 + (n0 & 127);
          transpose_item(P->w_glu + (size_t)layer * 512 * 1024, 512, 1024, P->WgluT + (size_t)layer * 1024 * 512, kb * 64, n0, row0, scr, lane); }
    }
}


namespace fa {
using bf16x8 = __attribute__((ext_vector_type(8))) short;
using s16x4  = __attribute__((ext_vector_type(4))) short;
using f32x16 = __attribute__((ext_vector_type(16))) float;
using u32x4  = __attribute__((ext_vector_type(4))) unsigned;
constexpr int D = 128, NW = 8, QBLK = 32, KVBLK = 64, LDQK = QKVW;
constexpr float SCALE = 0.088388347648318440f, THR = 8.f, NEG = -1e30f;
constexpr size_t SHM_V = KVBLK * D * 2, SHM_K = KVBLK * D * 2, SHM_ATTN = 2 * SHM_V + 2 * SHM_K + NW * 64 * 4;
#define KSWZ(row, colB) ((row) * 256 + ((colB) ^ (((row) & 7) << 4)))
#define SBAR() __builtin_amdgcn_sched_barrier(0)
__device__ __forceinline__ int crow(int r, int hi) { return (r & 3) + 8 * (r >> 2) + 4 * hi; }
__device__ __forceinline__ unsigned cvtpk(float lo, float hi) { unsigned r; asm volatile("v_cvt_pk_bf16_f32 %0, %1, %2" : "=v"(r) : "v"(lo), "v"(hi)); return r; }
__device__ __forceinline__ void partialSM(f32x16& p0, f32x16& p1, float& m_reg, float& mn, float& alpha) {
  constexpr float C = SCALE * 1.4426950408889634f;
  float pmax = p0[0]; for (int r = 1; r < 16; ++r) pmax = fmaxf(pmax, p0[r]); for (int r = 0; r < 16; ++r) pmax = fmaxf(pmax, p1[r]);
  { auto rr = __builtin_amdgcn_permlane32_swap(__float_as_uint(pmax), __float_as_uint(pmax), false, false);
    pmax = fmaxf(__uint_as_float(rr[0]), __uint_as_float(rr[1])); }
  if (__builtin_expect(__all(pmax - m_reg <= THR / SCALE), 1)) { mn = m_reg; alpha = 1.f; }
  else { mn = fmaxf(m_reg, pmax); alpha = __builtin_amdgcn_exp2f((m_reg - mn) * C); m_reg = mn; }
  float mnC = -mn * C;
  for (int r = 0; r < 16; ++r) p0[r] = fmaf(p0[r], C, mnC); for (int r = 0; r < 16; ++r) p1[r] = fmaf(p1[r], C, mnC);
  for (int r = 0; r < 16; ++r) p0[r] = __builtin_amdgcn_exp2f(p0[r]);
}
__device__ __forceinline__ void finishSM(f32x16& p0, f32x16& p1, float alpha, float& l_reg, bf16x8& pa0, bf16x8& pa1, bf16x8& pa2, bf16x8& pa3) {
  for (int r = 0; r < 16; ++r) p1[r] = __builtin_amdgcn_exp2f(p1[r]);
  float ps = 0; for (int r = 0; r < 16; ++r) ps += p0[r]; for (int r = 0; r < 16; ++r) ps += p1[r];
  { auto rr = __builtin_amdgcn_permlane32_swap(__float_as_uint(ps), __float_as_uint(ps), false, false);
    ps = __uint_as_float(rr[0]) + __uint_as_float(rr[1]); }
  l_reg = l_reg * alpha + ps;
#define PK4(P, BASE, OUT) do { unsigned a0 = cvtpk(P[BASE + 0], P[BASE + 1]), a1 = cvtpk(P[BASE + 2], P[BASE + 3]);   \
    unsigned b0 = cvtpk(P[BASE + 4], P[BASE + 5]), b1 = cvtpk(P[BASE + 6], P[BASE + 7]);                              \
    auto r0 = __builtin_amdgcn_permlane32_swap(a0, b0, false, false); auto r1 = __builtin_amdgcn_permlane32_swap(a1, b1, false, false); \
    u32x4 w = {r0[0], r1[0], r0[1], r1[1]}; OUT = *reinterpret_cast<bf16x8*>(&w); } while (0)
  PK4(p0, 0, pa0); PK4(p0, 8, pa1); PK4(p1, 0, pa2); PK4(p1, 8, pa3);
#undef PK4
}
__device__ __forceinline__ void qkt(f32x16& p0, f32x16& p1, const bf16_t* Ks, const bf16x8* qr, int r32, int hi) {
  p0 = f32x16{}; p1 = f32x16{};
  for (int d0 = 0; d0 < 8; ++d0) { int cb = (d0 * 16 + hi * 8) * 2;
    bf16x8 b0 = *reinterpret_cast<const bf16x8*>((const char*)Ks + KSWZ(r32, cb));
    bf16x8 b1 = *reinterpret_cast<const bf16x8*>((const char*)Ks + KSWZ(32 + r32, cb));
    p0 = __builtin_amdgcn_mfma_f32_32x32x16_bf16(b0, qr[d0], p0, 0, 0, 0);
    p1 = __builtin_amdgcn_mfma_f32_32x32x16_bf16(b1, qr[d0], p1, 0, 0, 0); }
}
__device__ __forceinline__ void mask_tile(f32x16& p0, f32x16& p1, int kt, int vis) {
  if (kt > vis) {
    const bool part = (kt == vis + 1);
    for (int r = 0; r < 16; ++r) p1[r] = NEG;
    for (int r = 8; r < 16; ++r) p0[r] = NEG;
    if (!part) for (int r = 0; r < 8; ++r) p0[r] = NEG;
  }
}
__device__ __forceinline__ int v_st(int k, int c) { const int kk = (k & ~0xC) | ((k & 4) << 1) | ((k & 8) >> 1); return ((kk >> 3) * 4 + (c >> 5)) * 512 + ((kk & 7) * 32 + (c & 31)) * 2; }
__device__ __forceinline__ int v_rd_base(int lane) { return ((lane & 3) << 3) | (((lane >> 2) & 3) << 6) | (((lane >> 4) & 1) << 5) | (((lane >> 5) & 1) << 8); }
constexpr int v_rd_off(int d0, int ks, int half) { return d0 * 512 + ks * 4096 + half * 2048; }
template <int OFF> __device__ __forceinline__ s16x4 tr_read(int vb) {
  s16x4 r; asm volatile("ds_read_b64_tr_b16 %0, %1 offset:%2" : "=&v"(r) : "v"(vb), "i"(OFF) : "memory"); return r;
}
template <int D0> __device__ __forceinline__ void pv_one(f32x16& od, int vb, bf16x8 pa0, bf16x8 pa1, bf16x8 pa2, bf16x8 pa3) {
  const s16x4 l0 = tr_read<v_rd_off(D0, 0, 0)>(vb), h0 = tr_read<v_rd_off(D0, 0, 1)>(vb), l1 = tr_read<v_rd_off(D0, 1, 0)>(vb), h1 = tr_read<v_rd_off(D0, 1, 1)>(vb);
  const s16x4 l2 = tr_read<v_rd_off(D0, 2, 0)>(vb), h2 = tr_read<v_rd_off(D0, 2, 1)>(vb), l3 = tr_read<v_rd_off(D0, 3, 0)>(vb), h3 = tr_read<v_rd_off(D0, 3, 1)>(vb);
  asm volatile("s_waitcnt lgkmcnt(0)" ::: "memory"); SBAR();
#define PK(L, H) (bf16x8){L[0], L[1], L[2], L[3], H[0], H[1], H[2], H[3]}
  od = __builtin_amdgcn_mfma_f32_32x32x16_bf16(pa0, PK(l0, h0), od, 0, 0, 0);
  od = __builtin_amdgcn_mfma_f32_32x32x16_bf16(pa1, PK(l1, h1), od, 0, 0, 0);
  od = __builtin_amdgcn_mfma_f32_32x32x16_bf16(pa2, PK(l2, h2), od, 0, 0, 0);
  od = __builtin_amdgcn_mfma_f32_32x32x16_bf16(pa3, PK(l3, h3), od, 0, 0, 0);
#undef PK
}
__device__ __forceinline__ void pv_d0(f32x16* o, int vb, bf16x8 pa0, bf16x8 pa1, bf16x8 pa2, bf16x8 pa3) {
  pv_one<0>(o[0], vb, pa0, pa1, pa2, pa3); pv_one<1>(o[1], vb, pa0, pa1, pa2, pa3); pv_one<2>(o[2], vb, pa0, pa1, pa2, pa3); pv_one<3>(o[3], vb, pa0, pa1, pa2, pa3);
}
__device__ __forceinline__ void attn_unit(const bf16_t* __restrict__ Qb, const bf16_t* __restrict__ Kh, const bf16_t* __restrict__ Vh, float* __restrict__ Ob, int NT, int vis4, char* lds) {
  const int tid = tid_(), wid = tid >> 6, lane = tid & 63, r32 = lane & 31, hi = lane >> 5;
  const int vis = vis4 + (wid >> 1);
  bf16_t* V_lds = (bf16_t*)lds; bf16_t* K_lds = (bf16_t*)(lds + 2 * SHM_V);
  float* ws = (float*)(lds + 2 * SHM_V + 2 * SHM_K) + wid * 64; float* li_l = ws; float* al_l = ws + 32;
  float m_reg = NEG, l_reg = 0; f32x16 o[4] = {}; bf16x8 qr[8];
  const bf16_t* Qw = Qb + (long)(wid * QBLK + r32) * LDQK + hi * 8;
#pragma unroll
  for (int d0 = 0; d0 < 8; ++d0) qr[d0] = *reinterpret_cast<const bf16x8*>(Qw + d0 * 16);
  const int sr = tid >> 4, sc = (tid & 15) * 8, vst0 = v_st(sr, sc), vst1 = v_st(32 + sr, sc);
  const int vb0 = (int)(uintptr_t)V_lds + v_rd_base(lane);
  struct { bf16x8 vs0, vs1, ks0, ks1; } sr_[2];
#define SLOAD(i, k0) do { sr_[i].vs0 = *reinterpret_cast<const bf16x8*>(&Vh[(long)((k0) + sr) * LDQK + sc]); sr_[i].vs1 = *reinterpret_cast<const bf16x8*>(&Vh[(long)((k0) + 32 + sr) * LDQK + sc]); \
    sr_[i].ks0 = *reinterpret_cast<const bf16x8*>(&Kh[(long)((k0) + sr) * LDQK + sc]); sr_[i].ks1 = *reinterpret_cast<const bf16x8*>(&Kh[(long)((k0) + 32 + sr) * LDQK + sc]); } while (0)
#define SWRITE(b, i) do { *(bf16x8*)((char*)V_lds + (b) * SHM_V + vst0) = sr_[i].vs0;          \
    *(bf16x8*)((char*)V_lds + (b) * SHM_V + vst1) = sr_[i].vs1; int kc = sc * 2;               \
    *(bf16x8*)((char*)K_lds + (b) * SHM_K + KSWZ(sr, kc)) = sr_[i].ks0;                       \
    *(bf16x8*)((char*)K_lds + (b) * SHM_K + KSWZ(32 + sr, kc)) = sr_[i].ks1; } while (0)
#define SWAIT() asm volatile("s_waitcnt vmcnt(4)" ::: "memory")
#define RESC(a) do { if (__any((a) < 1.f)) { if (hi == 0) al_l[r32] = (a); asm volatile("s_waitcnt lgkmcnt(0)" ::: "memory"); \
    for (int d = 0; d < 4; ++d) for (int r = 0; r < 16; ++r) o[d][r] *= al_l[crow(r, hi)]; } } while (0)
  f32x16 pA0, pA1, pB0, pB1; float mnA, mnB, alA, alB; bf16x8 pa0, pa1, pa2, pa3;
  constexpr int SE = 0, SO = 1;
  SLOAD(SE, 0); asm volatile("s_waitcnt vmcnt(0)" ::: "memory"); SWRITE(0, SE); __syncthreads();
  qkt(pA0, pA1, K_lds, qr, r32, hi); mask_tile(pA0, pA1, 0, vis); partialSM(pA0, pA1, m_reg, mnA, alA);
  SLOAD(SO, KVBLK); if (2 < NT) SLOAD(SE, 2 * KVBLK);
  SWAIT(); SWRITE(1, SO); __syncthreads();
  for (int j = 1; j + 1 < NT; j += 2) {
    SBAR(); qkt(pB0, pB1, (bf16_t*)((char*)K_lds + SHM_K), qr, r32, hi); mask_tile(pB0, pB1, j, vis);
    finishSM(pA0, pA1, alA, l_reg, pa0, pa1, pa2, pa3); SBAR();
    SLOAD(SO, (j + 2) * KVBLK); SBAR();
    pv_d0(o, vb0, pa0, pa1, pa2, pa3); partialSM(pB0, pB1, m_reg, mnB, alB);
    __syncthreads(); SWAIT(); SWRITE(0, SE);
    RESC(alB); __syncthreads();
    SBAR(); qkt(pA0, pA1, K_lds, qr, r32, hi); mask_tile(pA0, pA1, j + 1, vis);
    finishSM(pB0, pB1, alB, l_reg, pa0, pa1, pa2, pa3); SBAR();
    if (j + 3 < NT) SLOAD(SE, (j + 3) * KVBLK); SBAR();
    pv_d0(o, vb0 + (int)SHM_V, pa0, pa1, pa2, pa3); partialSM(pA0, pA1, m_reg, mnA, alA);
    __syncthreads(); SWAIT(); SWRITE(1, SO);
    RESC(alA); __syncthreads();
  }
  SBAR(); qkt(pB0, pB1, (bf16_t*)((char*)K_lds + SHM_K), qr, r32, hi); mask_tile(pB0, pB1, NT - 1, vis);
  finishSM(pA0, pA1, alA, l_reg, pa0, pa1, pa2, pa3); SBAR();
  pv_d0(o, vb0, pa0, pa1, pa2, pa3); partialSM(pB0, pB1, m_reg, mnB, alB);
  __syncthreads(); RESC(alB);
  finishSM(pB0, pB1, alB, l_reg, pa0, pa1, pa2, pa3); SBAR();
  pv_d0(o, vb0 + (int)SHM_V, pa0, pa1, pa2, pa3);
  if (hi == 0) li_l[r32] = l_reg; asm volatile("s_waitcnt lgkmcnt(0)" ::: "memory");
  float rli[16];
#pragma unroll
  for (int r = 0; r < 16; ++r) rli[r] = __builtin_amdgcn_rcpf(li_l[crow(r, hi)]);
  float* Ow = Ob + (long)(wid * QBLK) * DM;
#pragma unroll
  for (int r = 0; r < 16; ++r) { int orow = crow(r, hi);
    for (int d0 = 0; d0 < 4; ++d0) Ow[(long)orow * DM + d0 * 32 + r32] = o[d0][r] * rli[r]; }
  __syncthreads();
#undef SLOAD
#undef SWRITE
#undef SWAIT
#undef RESC
}
#undef KSWZ
#undef SBAR
}

__device__ __forceinline__ void ph_attention(KP P, char* lds) {
    const bf16_t* QKV = P->QKV; float* OC = P->OC;
#pragma unroll 1
    for (int c = bid_(); c < 256; c += gridDim.x) {
        const int combo = c >> 2, b = combo >> 4, h = (combo >> 2) & 3, i = (combo >> 1) & 1, vh = combo & 1;
        const bf16_t* Kh = QKV + (size_t)(b * LL) * QKVW + 1024 + h * 256 + i * 128;
        const bf16_t* Vh = QKV + (size_t)(b * LL) * QKVW + 2048 + h * 256 + vh * 128;
#pragma unroll 1
        for (int s = 0; s < 2; ++s) {
            const int jb = s == 0 ? (c & 3) : 7 - (c & 3);
            const size_t row0 = (size_t)(b * LL) + NMETA + 256 * jb;
            fa::attn_unit(QKV + row0 * QKVW + h * 256 + i * 128, Kh, Vh, OC + row0 * DM + h * 512 + i * 256 + vh * 128, 4 * jb + 6, 4 * jb, lds);
        }
    }
#pragma unroll 1
    for (int gw0 = bid_() * 8; gw0 < 512; gw0 += gridDim.x * 8) {
        const int tid = tid_(), lane = tid & 63, gw = gw0 + (tid >> 6);
        if (gw < 512) {
            const int b = gw >> 7, h = (gw >> 5) & 3, i = (gw >> 4) & 1, row = gw & 15;
            const bf16_t* q = QKV + (size_t)(b * LL + row) * QKVW + h * 256 + i * 128;
            const int key = lane & 15;
            const bf16_t* k = QKV + (size_t)(b * LL + key) * QKVW + 1024 + h * 256 + i * 128;
            float sc = 0.f;
            { pg8::u32x4 qv[16], kv[16];
#pragma unroll
              for (int c8 = 0; c8 < 16; ++c8) { qv[c8] = *(const pg8::u32x4*)(q + c8 * 8); kv[c8] = *(const pg8::u32x4*)(k + c8 * 8); }
#pragma unroll
              for (int c8 = 0; c8 < 16; ++c8)
#pragma unroll
                  for (int w2 = 0; w2 < 4; ++w2) { const unsigned a = qv[c8][w2], bq = kv[c8][w2];
                      sc = fmaf(__uint_as_float(a << 16), __uint_as_float(bq << 16), sc); sc = fmaf(__uint_as_float(a & 0xffff0000u), __uint_as_float(bq & 0xffff0000u), sc); } }
            sc *= 0.08838834764831845f;
            float m = sc;
            m = fmaxf(m, swz_xor<8>(m)); m = fmaxf(m, swz_xor<4>(m)); m = fmaxf(m, swz_xor<2>(m)); m = fmaxf(m, swz_xor<1>(m));
            const float e = expf(sc - m);
            float ssum = e;
            ssum += swz_xor<8>(ssum); ssum += swz_xor<4>(ssum); ssum += swz_xor<2>(ssum); ssum += swz_xor<1>(ssum);
            const float p = e / ssum;
            float acc[4] = {0.f, 0.f, 0.f, 0.f};
#pragma unroll
            for (int j = 0; j < 16; ++j) {
                const float pj = __int_as_float(__builtin_amdgcn_readlane(__float_as_int(p), j));
                const uint2 v2 = *(const uint2*)(QKV + (size_t)(b * LL + j) * QKVW + 2048 + h * 256 + lane * 4);
                acc[0] = fmaf(pj, __uint_as_float(v2.x << 16), acc[0]); acc[1] = fmaf(pj, __uint_as_float(v2.x & 0xffff0000u), acc[1]);
                acc[2] = fmaf(pj, __uint_as_float(v2.y << 16), acc[2]); acc[3] = fmaf(pj, __uint_as_float(v2.y & 0xffff0000u), acc[3]);
            }
            float* o = OC + (size_t)(b * LL + row) * DM + h * 512 + i * 256 + lane * 4;
            *(float4*)o = make_float4(acc[0], acc[1], acc[2], acc[3]);
        }
    }
}


namespace hg {
using bf16x8 = __attribute__((ext_vector_type(8))) short;
using s16x4  = __attribute__((ext_vector_type(4))) short;
using f32x16 = __attribute__((ext_vector_type(16))) float;
using u32x4  = __attribute__((ext_vector_type(4))) unsigned;
constexpr int NCH = 33, NU = 16 * NCH;
constexpr int SK = 136;
constexpr int SS = 72;
__device__ __forceinline__ int crow(int r, int hi) { return (r & 3) + 8 * (r >> 2) + 4 * hi; }
__device__ __forceinline__ unsigned cvtpk(float lo, float hi) { unsigned r; asm volatile("v_cvt_pk_bf16_f32 %0, %1, %2" : "=v"(r) : "v"(lo), "v"(hi)); return r; }

__device__ __forceinline__ void prep(const float (&fpv)[16], float lbv, int c, int k, int tq, float* qsum, float (&b)[16], float (&kk)[16], float& bend, float& r) {
    float run = 0.f;
#pragma unroll
    for (int i = 0; i < 16; ++i) {
        const int t = 16 * tq + i; const bool valid = (c * 64 + t) < LL;
        const float kv = valid ? (1.f - lbv) * __builtin_amdgcn_rcpf(1.f + __expf(fpv[i])) : 0.f;
        kk[i] = kv; run += fmaxf(__logf(1.f - kv), -30.f); b[i] = run;
    }
    qsum[tq * 128 + k] = run;
    __syncthreads();
    const float q0 = qsum[k], q1 = qsum[128 + k], q2 = qsum[256 + k], q3 = qsum[384 + k];
    const float off = tq == 0 ? 0.f : (tq == 1 ? q0 : (tq == 2 ? q0 + q1 : q0 + q1 + q2));
    r = q0 + q1; bend = (q0 + q1) + (q2 + q3);
#pragma unroll
    for (int i = 0; i < 16; ++i) b[i] += off;
}
__device__ __forceinline__ void store16(bf16_t* dst, const float (&x)[16]) {
    u32x4 w0, w1;
    w0.x = cvtpk(x[0], x[1]); w0.y = cvtpk(x[2], x[3]); w0.z = cvtpk(x[4], x[5]); w0.w = cvtpk(x[6], x[7]);
    w1.x = cvtpk(x[8], x[9]); w1.y = cvtpk(x[10], x[11]); w1.z = cvtpk(x[12], x[13]); w1.w = cvtpk(x[14], x[15]);
    *(u32x4*)dst = w0; *(u32x4*)(dst + 8) = w1;
}

__device__ __forceinline__ void local_states(KP P, char* lds, int layer) {
    bf16_t* KhT = (bf16_t*)lds; bf16_t* VT = KhT + 128 * SS; float* qsum = (float*)(VT + 128 * SS);
    const float* PA = P->PA; const float* lbtab = P->lbtab + layer * 512; float* SLOC = P->SLOC; float* DEC = P->DEC;
    const int tid = tid_(), k = tid & 127, tq = tid >> 7, lane = tid & 63, wid = tid >> 6, r32 = lane & 31, hh = lane >> 5;
    for (int u = bid_(); u < NU; u += gridDim.x) {
        const int bh = u / NCH, c = u % NCH, b_ = bh >> 2, h = bh & 3; const size_t row0 = (size_t)b_ * LL + c * 64;
        float fpv[16], vv[16];
#pragma unroll
        for (int i = 0; i < 16; ++i) { const int t = 16 * tq + i; const bool valid = (c * 64 + t) < LL; const float* rp = PA + (row0 + (valid ? t : 0)) * PAW + h * 128 + k;
            fpv[i] = rp[512]; vv[i] = valid ? rp[1024] : 0.f; }
        float b[16], kk[16], bend, r;
        prep(fpv, lbtab[h * 128 + k], c, k, tq, qsum, b, kk, bend, r);
        float x[16];
#pragma unroll
        for (int i = 0; i < 16; ++i) x[i] = kk[i] * __expf(bend - b[i]);
        store16(KhT + k * SS + 16 * tq, x);
        store16(VT + k * SS + 16 * tq, vv);
        if (tq == 0) DEC[u * 128 + k] = __expf(bend);
        __syncthreads();
        const int vt = wid >> 1;
#pragma unroll
        for (int j = 0; j < 2; ++j) {
            const int kt = (wid & 1) * 2 + j;
            f32x16 acc = {};
#pragma unroll
            for (int sg = 0; sg < 4; ++sg) {
                const bf16x8 a = *(const bf16x8*)(VT + (vt * 32 + r32) * SS + sg * 16 + hh * 8);
                const bf16x8 bb = *(const bf16x8*)(KhT + (kt * 32 + r32) * SS + sg * 16 + hh * 8);
                acc = __builtin_amdgcn_mfma_f32_32x32x16_bf16(a, bb, acc, 0, 0, 0);
            }
            float* o = SLOC + (size_t)u * 16384 + kt * 32 + r32;
#pragma unroll
            for (int rg = 0; rg < 16; ++rg) o[(vt * 32 + crow(rg, hh)) * 128] = acc[rg];
        }
        __syncthreads();
    }
}
__device__ __forceinline__ void scan_states(KP P) {
    const float* SLOC = P->SLOC; const float* DEC = P->DEC; bf16_t* SPREV = P->SPREV;
    const int tid = tid_();
    for (int e = bid_() * NTHR + tid; e < 16 * 16384; e += gridDim.x * NTHR) {
        const int bh = e >> 14, vk = e & 16383, k = vk & 127;
        float d[NCH - 1], x[NCH - 1];
#pragma unroll
        for (int c = 0; c < NCH - 1; ++c) { const int u = bh * NCH + c; d[c] = DEC[u * 128 + k]; x[c] = SLOC[(size_t)u * 16384 + vk]; }
        float S = 0.f;
#pragma unroll
        for (int c = 0; c < NCH - 1; ++c) { S = fmaf(d[c], S, x[c]); SPREV[(size_t)(bh * NCH + c + 1) * 16384 + vk] = f2bf(S); }
    }
}
__device__ __forceinline__ void outputs(KP P, char* lds, int layer) {
    bf16_t* Qt = (bf16_t*)lds; bf16_t* Qh = Qt + 64 * SK; bf16_t* Kt = Qh + 64 * SK; bf16_t* VT = Kt + 64 * SK; bf16_t* SpT = VT + 128 * SS;
    float* qsum = (float*)(SpT + 128 * SK); float* part = qsum + 512;
    const float* PA = P->PA; const float* lbtab = P->lbtab + layer * 512; const bf16_t* SPREV = P->SPREV; const float* nw = P->hnw + layer * 128; bf16_t* MIX = P->MIX;
    const int tid = tid_(), k = tid & 127, tq = tid >> 7, lane = tid & 63, wid = tid >> 6, r32 = lane & 31, hh = lane >> 5;
    for (int u = bid_(); u < NU; u += gridDim.x) {
        const int bh = u / NCH, c = u % NCH, b_ = bh >> 2, h = bh & 3; const size_t row0 = (size_t)b_ * LL + c * 64;
        const int tt = wid & 1, vt = wid >> 1;
        float fpv[16], qv[16], vv[16]; u32x4 sp[4]; float4 gv[4];
#pragma unroll
        for (int i = 0; i < 16; ++i) { const int t = 16 * tq + i; const bool valid = (c * 64 + t) < LL; const float* rp = PA + (row0 + (valid ? t : 0)) * PAW + h * 128 + k;
            fpv[i] = rp[512]; qv[i] = valid ? rp[0] : 0.f; vv[i] = valid ? rp[1024] : 0.f; }
#pragma unroll
        for (int j = 0; j < 4; ++j) { const int idx = tid + 512 * j, v = idx >> 4, ch = idx & 15; sp[j] = *(const u32x4*)(SPREV + (size_t)(c > 0 ? u : u + 1) * 16384 + v * 128 + ch * 8); }
        { const int te = tt * 32 + r32; const float* gp = PA + (row0 + ((c * 64 + te) < LL ? te : 0)) * PAW + 1536 + h * 128 + vt * 32 + 4 * hh;
#pragma unroll
          for (int g4 = 0; g4 < 4; ++g4) gv[g4] = *(const float4*)(gp + 8 * g4); }
        float b[16], kk[16], bend, r;
        prep(fpv, lbtab[h * 128 + k], c, k, tq, qsum, b, kk, bend, r);
#pragma unroll
        for (int i = 0; i < 16; ++i) { const int t = 16 * tq + i; const float q = qv[i];
            Qt[t * SK + k] = f2bf(q * __expf(b[i] - r)); Qh[t * SK + k] = f2bf(q * __expf(b[i])); Kt[t * SK + k] = f2bf(kk[i] * __expf(r - b[i])); }
        store16(VT + k * SS + 16 * tq, vv);
        if (c > 0) {
#pragma unroll
            for (int j = 0; j < 4; ++j) { const int idx = tid + 512 * j, v = idx >> 4, ch = idx & 15; *(u32x4*)(SpT + v * SK + ch * 8) = sp[j]; }
        }
        __syncthreads();
        f32x16 oacc = {};
#pragma unroll
        for (int st = 0; st < 2; ++st) {
            if (st <= tt) {
                f32x16 sc = {};
#pragma unroll
                for (int d0 = 0; d0 < 8; ++d0) {
                    const bf16x8 a = *(const bf16x8*)(Kt + (st * 32 + r32) * SK + d0 * 16 + hh * 8);
                    const bf16x8 bq = *(const bf16x8*)(Qt + (tt * 32 + r32) * SK + d0 * 16 + hh * 8);
                    sc = __builtin_amdgcn_mfma_f32_32x32x16_bf16(a, bq, sc, 0, 0, 0);
                }
                if (st == tt) {
#pragma unroll
                    for (int rg = 0; rg < 16; ++rg) sc[rg] = (crow(rg, hh) <= r32) ? sc[rg] : 0.f;
                }
#pragma unroll
                for (int g = 0; g < 2; ++g) {
                    u32x4 w; w.x = cvtpk(sc[8 * g + 0], sc[8 * g + 1]); w.y = cvtpk(sc[8 * g + 2], sc[8 * g + 3]); w.z = cvtpk(sc[8 * g + 4], sc[8 * g + 5]); w.w = cvtpk(sc[8 * g + 6], sc[8 * g + 7]);
                    const bf16x8 pb = *reinterpret_cast<bf16x8*>(&w);
                    const bf16_t* vp = VT + (vt * 32 + r32) * SS + st * 32 + 16 * g + 4 * hh;
                    const s16x4 lo = *(const s16x4*)vp, hi4 = *(const s16x4*)(vp + 8);
                    const bf16x8 a = (bf16x8){lo[0], lo[1], lo[2], lo[3], hi4[0], hi4[1], hi4[2], hi4[3]};
                    oacc = __builtin_amdgcn_mfma_f32_32x32x16_bf16(a, pb, oacc, 0, 0, 0);
                }
            }
        }
        if (c > 0) {
#pragma unroll
            for (int d0 = 0; d0 < 8; ++d0) {
                const bf16x8 a = *(const bf16x8*)(SpT + (vt * 32 + r32) * SK + d0 * 16 + hh * 8);
                const bf16x8 bq = *(const bf16x8*)(Qh + (tt * 32 + r32) * SK + d0 * 16 + hh * 8);
                oacc = __builtin_amdgcn_mfma_f32_32x32x16_bf16(a, bq, oacc, 0, 0, 0);
            }
        }
        float ss = 0.f;
#pragma unroll
        for (int rg = 0; rg < 16; ++rg) ss = fmaf(oacc[rg], oacc[rg], ss);
        { auto rr = __builtin_amdgcn_permlane32_swap(__float_as_uint(ss), __float_as_uint(ss), false, false); ss = __uint_as_float(rr[0]) + __uint_as_float(rr[1]); }
        if (hh == 0) part[vt * 64 + tt * 32 + r32] = ss;
        __syncthreads();
        const int t = tt * 32 + r32;
        const float tot = (part[t] + part[64 + t]) + (part[128 + t] + part[192 + t]);
        const float scale = rsqrtf(tot * (1.f / 128.f) + EPS);
        if ((c * 64 + t) < LL) {
            bf16_t* op = MIX + (row0 + t) * DM + h * 128 + vt * 32;
#pragma unroll
            for (int g4 = 0; g4 < 4; ++g4) {
                const int v0 = 8 * g4 + 4 * hh;
                const float4 gg = gv[g4]; const float4 wv = *(const float4*)(nw + vt * 32 + v0);
                const float y0 = oacc[4 * g4 + 0] * scale * wv.x * gg.x / (1.f + __expf(-gg.x)), y1 = oacc[4 * g4 + 1] * scale * wv.y * gg.y / (1.f + __expf(-gg.y));
                const float y2 = oacc[4 * g4 + 2] * scale * wv.z * gg.z / (1.f + __expf(-gg.z)), y3 = oacc[4 * g4 + 3] * scale * wv.w * gg.w / (1.f + __expf(-gg.w));
                uint2 w; w.x = cvtpk(y0, y1); w.y = cvtpk(y2, y3);
                *(uint2*)(op + v0) = w;
            }
        }
        __syncthreads();
    }
}
}


namespace moe {
using bf16x8 = __attribute__((ext_vector_type(8))) short;
using f32x16 = __attribute__((ext_vector_type(16))) float;
using u32x4  = __attribute__((ext_vector_type(4))) unsigned;
constexpr int TW = 5, PROWS = 64 * TW, XS = 128, XBUF = PROWS * XS;
__device__ __forceinline__ unsigned cvtpk(float lo, float hi) { unsigned r; asm volatile("v_cvt_pk_bf16_f32 %0, %1, %2" : "=v"(r) : "v"(lo), "v"(hi)); return r; }
#define MOE_BAR() asm volatile("s_waitcnt lgkmcnt(0)\n\ts_barrier" ::: "memory")
constexpr int WD = 2;
constexpr int ABUF = 4 * 4 * 1024, AOFF = 3 * XBUF, LOFF = AOFF + 2 * ABUF;
template <bool UP>
__device__ __forceinline__ void stream_gemm(KP P, char* lds, int layer) {
    constexpr int KTOT = UP ? DM : DE, NSLAB = KTOT / 64, NCP = UP ? 2 : 4, LDW = UP ? DE : DM, CPSTRIDE = UP ? 64 : 128;
    static_assert(NSLAB % WD == 0 && NSLAB >= 2 * WD, "slab loop is unrolled by WD");
    const int tid = tid_(), lane = tid & 63, wid = tid >> 6, r32 = lane & 31, hh = lane >> 5, cg = wid & 3, th = wid >> 2;
    const int* cnt_ = P->cnt;
    const bf16_t* X = UP ? P->HN : P->H;
    int* basel = (int*)(lds + LOFF); int* tlist = basel + 64; float* rsl = (float*)(basel + 64 + 320 + 64);
    for (int ub = bid_(); ub < 256; ub += gridDim.x) {
        const int u = ((ub & 7) << 5) | (ub >> 3);
        const int e = u >> 2, ns = u & 3;
        const int rot = ((u >> 2) * 11) & (NSLAB - 1);
        __syncthreads();
        if (tid < 64) basel[64 + 320 + tid] = cnt_[tid * CSTR];
        __syncthreads();
        if (tid < 64) { int a = 0; for (int q = 0; q < tid; ++q) a += basel[64 + 320 + q]; basel[tid] = a; }
        __syncthreads();
        const int cnt = cnt_[e * CSTR], row0 = basel[e];
        for (int pass0 = 0; pass0 < cnt; pass0 += PROWS) {
            const int cntp = (cnt - pass0) < PROWS ? (cnt - pass0) : PROWS;
            if constexpr (UP) { if (cnt <= ECAP) {
                __syncthreads();
                if (tid < PROWS && pass0 + tid < cnt) { tlist[tid] = P->elist[e * ECAP + pass0 + tid]; rsl[tid] = P->ers[e * ECAP + pass0 + tid]; }
                __syncthreads();
              } else {
                __syncthreads();
                const int* ridx = P->ridx; const int* rslot = P->rslot;
#pragma unroll 1
                for (int i0 = tid; i0 < NASSIGN; i0 += NTHR * 8) {
                    int ex[8], sl[8];
#pragma unroll
                    for (int q = 0; q < 8; ++q) { const int i = i0 + NTHR * q; ex[q] = i < NASSIGN ? ridx[i] : -1; sl[q] = i < NASSIGN ? rslot[i] : 0; }
#pragma unroll
                    for (int q = 0; q < 8; ++q) { const int sp = sl[q] - pass0; if (ex[q] == e && sp >= 0 && sp < PROWS) { tlist[sp] = (i0 + NTHR * q) >> 1; rsl[sp] = P->rsn[(i0 + NTHR * q) >> 1]; } }
                }
                __syncthreads();
            } }
            int xoff[5];
#pragma unroll
            for (int j = 0; j < 5; ++j) { int rho = (tid >> 3) + 64 * j; rho = rho < cntp ? rho : cntp - 1; const int grow = row0 + pass0 + rho;
                xoff[j] = (UP ? tlist[rho] * DM : grow * DE) + ((tid & 7) ^ ((tid >> 4) & 7)) * 8; }
            const int xdma = __builtin_amdgcn_readfirstlane(wid) * 8 * XS;
            int xrd[4];
#pragma unroll
            for (int kk = 0; kk < 4; ++kk) xrd[kk] = (th * TW * 32 + r32) * XS + (((2 * kk + hh) ^ ((r32 >> 1) & 7)) << 4);
            const unsigned ldsb = (unsigned)(size_t)(LAS char*)lds;
            int xb0 = 0, xb1 = XBUF, xb2 = 2 * XBUF;
            char* const aw = lds + AOFF + (cg * 4 + 2 * th) * 1024 + lane * 16;
            const char* const ar = lds + AOFF + cg * 4 * 1024 + lane * 16;
            float wreg[WD][16];
#pragma unroll 1
            for (int cp = 0; cp < NCP; ++cp) {
                const int cgi = cp * 4 + cg;
                const int kkw = wid >> 1, half = wid & 1;
                const float* wp;
                if constexpr (UP) wp = (r32 < 16 ? P->w1 : P->w3) + ((size_t)(layer * NE + e) * DM + kkw * 16 + 8 * hh + 4 * half) * DE + ns * 128 + cp * 64 + 4 * (r32 & 15);
                else wp = P->w2 + ((size_t)(layer * NE + e) * DE + 32 * hh + 2 * th) * DM + ns * 512 + cgi * 32 + r32;
                f32x16 acc[TW];
#pragma unroll
                for (int tl = 0; tl < TW; ++tl) acc[tl] = f32x16{};
#define MOE_WLD1(wn_, R, li) do { if constexpr (UP) { if ((li) < 4) { const float4 t_ = *(const float4*)((wn_) + (size_t)(li) * DE); wreg[R][4 * (li)] = t_.x; wreg[R][4 * (li) + 1] = t_.y; wreg[R][4 * (li) + 2] = t_.z; wreg[R][4 * (li) + 3] = t_.w; } } \
                    else { if ((li) < 16) wreg[R][li] = (wn_)[(size_t)(((li) >> 3) + 4 * ((li) & 7)) * DM]; } } while (0)
#define MOE_WLOAD(slab, R) do { const float* wn_ = wp + (size_t)(((slab) + rot) & (NSLAB - 1)) * 64 * LDW; \
                    _Pragma("unroll") for (int li = 0; li < 16; ++li) MOE_WLD1(wn_, R, li); } while (0)
#define MOE_WPARK(R, PAR) do { if constexpr (UP) { _Pragma("unroll") for (int q = 0; q < 4; ++q) { uint2 fw; fw.x = cvtpk(wreg[R][q], wreg[R][4 + q]); fw.y = cvtpk(wreg[R][8 + q], wreg[R][12 + q]); \
                            *(uint2*)(lds + AOFF + (PAR) * ABUF + (q * 4 + kkw) * 1024 + lane * 16 + half * 8) = fw; } } \
                    else { _Pragma("unroll") for (int i = 0; i < 2; ++i) { u32x4 fw; fw.x = cvtpk(wreg[R][8 * i + 0], wreg[R][8 * i + 1]); fw.y = cvtpk(wreg[R][8 * i + 2], wreg[R][8 * i + 3]); \
                            fw.z = cvtpk(wreg[R][8 * i + 4], wreg[R][8 * i + 5]); fw.w = cvtpk(wreg[R][8 * i + 6], wreg[R][8 * i + 7]); *(u32x4*)(aw + (PAR) * ABUF + i * 1024) = fw; } } } while (0)
#define MOE_XDMA(slab, bo) do { const bf16_t* xn0_ = X + ((((slab) & (NSLAB - 1)) + rot) & (NSLAB - 1)) * 64; \
                    _Pragma("unroll") for (int j = 0; j < TW; ++j) { const unsigned la_ = ldsb + (unsigned)((bo) + xdma + 64 * j * XS); const bf16_t* gp_ = xn0_ + xoff[j]; \
                        asm volatile("s_mov_b32 m0, %1\n\ts_nop 0\n\tglobal_load_lds_dwordx4 %0, off" :: "v"(gp_), "s"(la_) : "memory", "m0"); } } while (0)
                if (cp == 0) {
                    xb0 = 0; xb1 = XBUF; xb2 = 2 * XBUF;
                    MOE_XDMA(0, xb0); MOE_XDMA(1, xb1);
                    MOE_WLOAD(0, 0); MOE_WLOAD(1, 1);
                    MOE_WPARK(0, 0); MOE_WLOAD(2, 0);
                    asm volatile("s_waitcnt vmcnt(0)" ::: "memory");
                    MOE_BAR();
                }
#define MOE_SLAB(s, PAR, R1) do { \
                    const int swr = (s) + 1 + WD; const bool wnext = swr >= NSLAB && cp + 1 < NCP;     \
                    const int sw = swr < NSLAB ? swr : (wnext ? swr - NSLAB : NSLAB - 1); \
                    MOE_WPARK(R1, 1 - (PAR)); \
                    MOE_XDMA((s) + 2, xb2);                                                           \
                    const float* wn_ = wp + (wnext ? CPSTRIDE : 0) + (size_t)((sw + rot) & (NSLAB - 1)) * 64 * LDW; \
                    const char* xk0 = lds + xb0 + xrd[0]; const char* xk1 = lds + xb0 + xrd[1]; const char* xk2 = lds + xb0 + xrd[2]; const char* xk3 = lds + xb0 + xrd[3]; \
                    bf16x8 xq[4]; bf16x8 fq[2];                                                       \
                    xq[0] = *(const bf16x8*)(xk0); xq[1] = *(const bf16x8*)(xk0 + 32 * XS); xq[2] = *(const bf16x8*)(xk0 + 64 * XS); \
                    fq[0] = *(const bf16x8*)(ar + (PAR) * ABUF); \
                    _Pragma("unroll") for (int kk = 0; kk < 4; ++kk) { \
                        if (kk < 3) fq[(kk + 1) & 1] = *(const bf16x8*)(ar + (PAR) * ABUF + (kk + 1) * 1024); \
                        _Pragma("unroll") for (int tl = 0; tl < TW; ++tl) { \
                            const int cur = kk * TW + tl, nx = cur + 3, nkk = nx / TW, ntl = nx % TW;       \
                            if (nx < 4 * TW) xq[nx & 3] = *(const bf16x8*)((nkk == 0 ? xk0 : nkk == 1 ? xk1 : nkk == 2 ? xk2 : xk3) + ntl * 32 * XS); \
                            acc[tl] = __builtin_amdgcn_mfma_f32_32x32x16_bf16(fq[kk & 1], xq[cur & 3], acc[tl], 0, 0, 0); \
                            const int li = kk * TW + tl; \
                            MOE_WLD1(wn_, R1, li); \
                            __builtin_amdgcn_sched_barrier(0); } } \
                    if constexpr (UP) asm volatile("s_waitcnt vmcnt(9)" ::: "memory"); else asm volatile("s_waitcnt vmcnt(21)" ::: "memory");     \
                    MOE_BAR(); \
                    { const int t_ = xb0; xb0 = xb1; xb1 = xb2; xb2 = t_; } } while (0)
#pragma unroll 1
                for (int s = 0; s < NSLAB; s += 2) { MOE_SLAB(s, 0, 1); MOE_SLAB(s + 1, 1, 0); }
#undef MOE_SLAB
#undef MOE_WLOAD
#undef MOE_WLD1
#undef MOE_WPARK
#undef MOE_XDMA
                const int T = (cntp + 31) >> 5;
                const int Tw = (T - TW * th) < 0 ? 0 : ((T - TW * th) > TW ? TW : (T - TW * th));
#pragma unroll
                for (int tl = 0; tl < TW; ++tl) if (tl < Tw) {
                    const int rho = (th * TW + tl) * 32 + r32;
                    if (rho < cntp) {
                        const size_t grow = (size_t)(row0 + pass0 + rho);
                        if constexpr (UP) {
                            bf16_t* hp = P->H + grow * DE + ns * 128 + cgi * 16 + 4 * hh; const float rs = rsl[rho];
#pragma unroll
                            for (int g = 0; g < 2; ++g) {
                                float y[4];
#pragma unroll
                                for (int q = 0; q < 4; ++q) { const float a = acc[tl][4 * g + q] * rs, b = acc[tl][8 + 4 * g + q] * rs; y[q] = a / (1.f + __expf(-a)) * b; }
                                uint2 w; w.x = cvtpk(y[0], y[1]); w.y = cvtpk(y[2], y[3]);
                                *(uint2*)(hp + 8 * g) = w;
                            }
                        } else {
                            bf16_t* yp = P->Y + grow * DM + ns * 512 + cgi * 32 + 4 * hh;
#pragma unroll
                            for (int g = 0; g < 4; ++g) {
                                uint2 w; w.x = cvtpk(acc[tl][4 * g + 0], acc[tl][4 * g + 1]); w.y = cvtpk(acc[tl][4 * g + 2], acc[tl][4 * g + 3]);
                                *(uint2*)(yp + 8 * g) = w;
                            }
                        }
                    }
                }
            }
            asm volatile("s_waitcnt vmcnt(0)" ::: "memory");
            __syncthreads();
        }
    }
}
#undef MOE_BAR
}


namespace s5 {
using bf16x8 = __attribute__((ext_vector_type(8))) short;
using f32x16 = __attribute__((ext_vector_type(16))) float;
using u32x4  = __attribute__((ext_vector_type(4))) unsigned;
constexpr int NCHK = 516, NMT = 17;
__device__ __forceinline__ unsigned cvtpk(float lo, float hi) { unsigned r; asm volatile("v_cvt_pk_bf16_f32 %0, %1, %2" : "=v"(r) : "v"(lo), "v"(hi)); return r; }
__device__ __forceinline__ bf16x8 ld8f(const float* p) {
    const float4 a = *(const float4*)p, b = *(const float4*)(p + 4);
    u32x4 w; w.x = cvtpk(a.x, a.y); w.y = cvtpk(a.z, a.w); w.z = cvtpk(b.x, b.y); w.w = cvtpk(b.z, b.w);
    return *reinterpret_cast<bf16x8*>(&w);
}
__device__ __forceinline__ void prep_unit(KP P, char* lds, int layer, int g) {
    float2* pw = (float2*)lds; float2* bb = pw + 17 * 64; float2* cc = bb + 1024; float* kd = (float*)(cc + 1024);
    const int tid = tid_();
    const float dt = expf(P->log_dt[layer * 32 + g]);
    const float* a_re = P->a_re + (layer * 32 + g) * 64; const float* a_im = P->a_im + (layer * 32 + g) * 64;
    for (int idx = tid; idx < 17 * 64; idx += NTHR) { const int d = idx >> 6, p = idx & 63;
        const float mag = expf(a_re[p] * dt * (float)d), ang = a_im[p] * dt * (float)d; pw[idx] = make_float2(mag * cosf(ang), mag * sinf(ang)); }
    for (int idx = tid; idx < 1024; idx += NTHR) {
        { const int p = idx >> 4, c = idx & 15; const float are = a_re[p], aim = a_im[p];
          const float mag = expf(are * dt), abr = mag * cosf(aim * dt), abi = mag * sinf(aim * dt), den = are * are + aim * aim;
          const float zr = ((abr - 1.f) * are + abi * aim) / den, zi = (abi * are - (abr - 1.f) * aim) / den;
          const float br = P->b_re[((layer * 32 + g) * 64 + p) * 16 + c], bi = P->b_im[((layer * 32 + g) * 64 + p) * 16 + c];
          bb[idx] = make_float2(zr * br - zi * bi, zr * bi + zi * br); }
        { const int c = idx >> 6, p = idx & 63; cc[idx] = make_float2(P->c_re[((layer * 32 + g) * 16 + c) * 64 + p], P->c_im[((layer * 32 + g) * 16 + c) * 64 + p]); }
    }
    __syncthreads();
    if (tid < 64) ((float2*)P->A16)[(layer * 32 + g) * 64 + tid] = pw[16 * 64 + tid];
    for (int idx = tid; idx < 4096; idx += NTHR) { const int d = idx >> 8, c = (idx >> 4) & 15, c2 = idx & 15;
        float acc = 0.f;
        for (int p = 0; p < 64; ++p) { const float2 C = cc[c * 64 + p], W = pw[d * 64 + p], B = bb[p * 16 + c2];
            const float xr = C.x * W.x - C.y * W.y, xi = C.x * W.y + C.y * W.x; acc += xr * B.x - xi * B.y; }
        if (d == 0 && c == c2) acc += P->s5d[layer * 512 + g * 16 + c];
        kd[idx] = acc; }
    __syncthreads();
    bf16_t* BtY = P->BtY + (size_t)(layer * 32 + g) * 256 * 384; bf16_t* BtE = P->BtE + (size_t)(layer * 32 + g) * 128 * 256;
    for (int idx = tid; idx < 256 * 48; idx += NTHR) { const int n = idx / 48, ch = idx % 48, t = n >> 4, c = n & 15;
        float v[8];
        if (ch < 32) { const int s = ch >> 1, c0 = (ch & 1) * 8;
#pragma unroll
            for (int jj = 0; jj < 8; ++jj) v[jj] = (s <= t) ? kd[((t - s) * 16 + c) * 16 + c0 + jj] : 0.f;
        } else {
#pragma unroll
            for (int jj = 0; jj < 8; ++jj) { const int kq = (ch - 32) * 8 + jj, p = kq >> 1; const float2 C = cc[c * 64 + p], W = pw[(t + 1) * 64 + p];
                v[jj] = (kq & 1) ? -(C.x * W.y + C.y * W.x) : (C.x * W.x - C.y * W.y); }
        }
        u32x4 w; w.x = cvtpk(v[0], v[1]); w.y = cvtpk(v[2], v[3]); w.z = cvtpk(v[4], v[5]); w.w = cvtpk(v[6], v[7]);
        *(u32x4*)(BtY + ((size_t)(((n >> 5) * 24 + (ch >> 1)) * 64 + (ch & 1) * 32 + (n & 31))) * 8) = w; }
    for (int idx = tid; idx < 128 * 32; idx += NTHR) { const int n = idx >> 5, ch = idx & 31, p = n >> 1, s = ch >> 1, c0 = (ch & 1) * 8;
        const float2 W = pw[(15 - s) * 64 + p];
        float v[8];
#pragma unroll
        for (int jj = 0; jj < 8; ++jj) { const float2 B = bb[p * 16 + c0 + jj]; v[jj] = (n & 1) ? (W.x * B.y + W.y * B.x) : (W.x * B.x - W.y * B.y); }
        u32x4 w; w.x = cvtpk(v[0], v[1]); w.y = cvtpk(v[2], v[3]); w.z = cvtpk(v[4], v[5]); w.w = cvtpk(v[6], v[7]);
        *(u32x4*)(BtE + ((size_t)(((n >> 5) * 16 + (ch >> 1)) * 64 + (ch & 1) * 32 + (n & 31))) * 8) = w; }
    __syncthreads();
}
__device__ __forceinline__ float gelu_t(float x) { const float u = 0.7978845608028654f * (x + 0.044715f * x * x * x); const float e = __expf(2.f * u); return x - x / (e + 1.f); }
__device__ __forceinline__ void fused_unit(KP P, char* lds, int layer, int b, int g) {
    const int tid = tid_(), lane = tid & 63, wid = tid >> 6, r32 = lane & 31, hh = lane >> 5;
    constexpr int UCH = 528, UBYTES = 68352;
    char* U16 = lds; float* El = (float*)(lds + UBYTES);
    const float* PA = P->PA; bf16_t* YG = P->YG;
    { const float* ub = PA + (size_t)(b * LL) * PAW + 2048 + g * 16;
#pragma unroll 1
      for (int i0 = 0; i0 < LL * 4; i0 += NTHR * 4) {
          float4 v[4];
#pragma unroll
          for (int q = 0; q < 4; ++q) { const int idx = i0 + q * NTHR + tid, ic = idx < LL * 4 ? idx : LL * 4 - 1; v[q] = *(const float4*)(ub + (size_t)(ic >> 2) * PAW + (ic & 3) * 4); }
#pragma unroll
          for (int q = 0; q < 4; ++q) { const int idx = i0 + q * NTHR + tid; if (idx < LL * 4) { const int r = idx >> 2;
              uint2 w; w.x = cvtpk(v[q].x, v[q].y); w.y = cvtpk(v[q].z, v[q].w); *(uint2*)(U16 + (r >> 4) * UCH + (r & 15) * 32 + (idx & 3) * 8) = w; } }
      } }
    __syncthreads();
    int mrow[5];
#pragma unroll
    for (int mt = 0; mt < 5; ++mt) { const int m = mt * 32 + r32; mrow[mt] = m < 129 ? m : 128; }
    if (wid < 4) {
        const bf16_t* Bt = P->BtE + (size_t)(layer * 32 + g) * 128 * 256 + ((size_t)(wid * 16) * 64 + lane) * 8;
        f32x16 acc[5];
#pragma unroll
        for (int mt = 0; mt < 5; ++mt) acc[mt] = f32x16{};
#pragma unroll 4
        for (int s = 0; s < 16; ++s) {
            const bf16x8 af = *(const bf16x8*)(Bt + (size_t)(s * 64) * 8);
#pragma unroll
            for (int mt = 0; mt < 5; ++mt) { const bf16x8 bf = *(const bf16x8*)(U16 + mrow[mt] * UCH + hh * 16 + 32 * s); acc[mt] = __builtin_amdgcn_mfma_f32_32x32x16_bf16(af, bf, acc[mt], 0, 0, 0); }
        }
#pragma unroll
        for (int mt = 0; mt < 5; ++mt) { const int m = mt * 32 + r32; if (m < 129) { float* ep = El + m * 128 + wid * 32 + 4 * hh;
#pragma unroll
            for (int q = 0; q < 4; ++q) *(float4*)(ep + 8 * q) = make_float4(acc[mt][4 * q], acc[mt][4 * q + 1], acc[mt][4 * q + 2], acc[mt][4 * q + 3]); } }
    }
    __syncthreads();
    if (tid < 64) {
        const float2 A = ((const float2*)P->A16)[(layer * 32 + g) * 64 + tid];
        float2* e2 = (float2*)El + tid;
        float xr = 0.f, xi = 0.f;
#pragma unroll 1
        for (int j0 = 0; j0 < 128; j0 += 8) {
            float2 e[8];
#pragma unroll
            for (int i = 0; i < 8; ++i) e[i] = e2[(j0 + i) * 64];
#pragma unroll
            for (int i = 0; i < 8; ++i) { e2[(j0 + i) * 64] = make_float2(xr, xi);
                const float nr = A.x * xr - A.y * xi + e[i].x, ni = A.x * xi + A.y * xr + e[i].y; xr = nr; xi = ni; }
        }
        e2[128 * 64] = make_float2(xr, xi);
    }
    __syncthreads();
    {
        const bf16_t* Bt = P->BtY + (size_t)(layer * 32 + g) * 256 * 384 + ((size_t)(wid * 24) * 64 + lane) * 8;
        f32x16 acc[5];
#pragma unroll
        for (int mt = 0; mt < 5; ++mt) acc[mt] = f32x16{};
#pragma unroll 4
        for (int s = 0; s < 16; ++s) if (2 * wid + 1 >= s) {
            const bf16x8 af = *(const bf16x8*)(Bt + (size_t)(s * 64) * 8);
#pragma unroll
            for (int mt = 0; mt < 5; ++mt) { const bf16x8 bf = *(const bf16x8*)(U16 + mrow[mt] * UCH + hh * 16 + 32 * s); acc[mt] = __builtin_amdgcn_mfma_f32_32x32x16_bf16(af, bf, acc[mt], 0, 0, 0); }
        }
#pragma unroll 4
        for (int ks = 0; ks < 8; ++ks) {
            const bf16x8 af = *(const bf16x8*)(Bt + (size_t)((16 + ks) * 64) * 8);
#pragma unroll
            for (int mt = 0; mt < 5; ++mt) { const bf16x8 bf = ld8f(El + mrow[mt] * 128 + 8 * hh + ks * 16); acc[mt] = __builtin_amdgcn_mfma_f32_32x32x16_bf16(af, bf, acc[mt], 0, 0, 0); }
        }
#pragma unroll
        for (int mt = 0; mt < 5; ++mt) { const int ml = mt * 32 + r32; if (ml < 129) { const int m = b * 129 + ml;
#pragma unroll
            for (int q = 0; q < 4; ++q) { const int t = 2 * wid + (q >> 1);
                uint2 w; w.x = cvtpk(gelu_t(acc[mt][4 * q]), gelu_t(acc[mt][4 * q + 1])); w.y = cvtpk(gelu_t(acc[mt][4 * q + 2]), gelu_t(acc[mt][4 * q + 3]));
                *(uint2*)(YG + (size_t)(m * 16 + t) * 512 + g * 16 + 8 * (q & 1) + 4 * hh) = w; } } }
    }
    __syncthreads();
}
}

__device__ __forceinline__ float wave_sum(float v) {
    v += swz_xor<1>(v); v += swz_xor<2>(v); v += swz_xor<4>(v); v += swz_xor<8>(v); v += swz_xor<16>(v);
    { auto rr = __builtin_amdgcn_permlane32_swap(__float_as_uint(v), __float_as_uint(v), false, false); v = __uint_as_float(rr[0]) + __uint_as_float(rr[1]); }
    return v;
}
__device__ __forceinline__ unsigned cvtpk_(float lo, float hi) { unsigned r; asm volatile("v_cvt_pk_bf16_f32 %0, %1, %2" : "=v"(r) : "v"(lo), "v"(hi)); return r; }
__device__ __forceinline__ void ph_attn_out(KP P, int layer, int cu0) {
    const int tid = tid_(), lane = tid & 63, gw = (bid_() - cu0) * 8 + (tid >> 6), NGW = (gridDim.x - cu0) * 8;
    if (gw < 0) return;
    const float scale = 1.f - (0.8f - 0.6f * expf(-0.3f * (float)layer));
    const float lam = P->lam[layer];
    const float4 sw = ((const float4*)(P->subln + layer * 256))[lane];
    const float* OC = P->OC; bf16_t* MIX = P->MIX;
    for (int it0 = gw; it0 < TOK * 4; it0 += NGW * 4) {
        float4 a[4], b[4];
#pragma unroll
        for (int q = 0; q < 4; ++q) { const int it = it0 + NGW * q, itc = it < TOK * 4 ? it : TOK * 4 - 1, r = itc >> 2, h = itc & 3;
            a[q] = *(const float4*)(OC + (size_t)r * DM + h * 512 + lane * 4); b[q] = *(const float4*)(OC + (size_t)r * DM + h * 512 + 256 + lane * 4); }
#pragma unroll
        for (int q = 0; q < 4; ++q) { const int it = it0 + NGW * q; if (it < TOK * 4) { const int r = it >> 2, h = it & 3;
            const float o0 = a[q].x - lam * b[q].x, o1 = a[q].y - lam * b[q].y, o2 = a[q].z - lam * b[q].z, o3 = a[q].w - lam * b[q].w;
            const float ss = wave_sum(o0 * o0 + o1 * o1 + o2 * o2 + o3 * o3);
            const float rs = rsqrtf(ss * (1.f / 256.f) + EPS) * scale;
            uint2 w; w.x = cvtpk_(o0 * rs * sw.x, o1 * rs * sw.y); w.y = cvtpk_(o2 * rs * sw.z, o3 * rs * sw.w);
            *(uint2*)(MIX + (size_t)r * DM + 1024 + h * 256 + lane * 4) = w; } }
    }
}
__device__ __forceinline__ void ph_build_norm(KP P) {
    const int tid = tid_(), lane = tid & 63, gw = bid_() * 8 + (tid >> 6), NGW = gridDim.x * 8;
    for (int r = gw; r < MP; r += NGW) {
        float4 v[8];
        if (r < TOK) { const int b = r / LL, t = r % LL;
            const float4* src = (const float4*)(t < NMETA ? P->meta + (size_t)t * DM : P->x + ((size_t)b * SEQ + (t - NMETA)) * DM);
#pragma unroll
            for (int j = 0; j < 8; ++j) v[j] = src[lane + 64 * j];
        } else {
#pragma unroll
            for (int j = 0; j < 8; ++j) v[j] = make_float4(0.f, 0.f, 0.f, 0.f);
        }
        float ss = 0.f;
#pragma unroll
        for (int j = 0; j < 8; ++j) { ((float4*)(P->Z + (size_t)r * DM))[lane + 64 * j] = v[j]; ss += v[j].x * v[j].x + v[j].y * v[j].y + v[j].z * v[j].z + v[j].w * v[j].w; }
        const float rs = rsqrtf(wave_sum(ss) * (1.f / DM) + EPS);
#pragma unroll
        for (int j = 0; j < 8; ++j) { const float4 w = ((const float4*)P->ln1_w)[lane + 64 * j];
            uint2 o; o.x = cvtpk_(v[j].x * rs * w.x, v[j].y * rs * w.y); o.y = cvtpk_(v[j].z * rs * w.z, v[j].w * rs * w.w);
            ((uint2*)(P->HN + (size_t)r * DM))[lane + 64 * j] = o; }
    }
}
__device__ __forceinline__ void ph_prep(KP P) {
    const int tid = tid_();
    if (bid_() == 0) {
        const int c = tid;
        const float l0 = P->lbnd[c], l1 = P->lbnd[512 + c], m = fmaxf(l0, l1), e0 = expf(l0 - m), e1 = expf(l1 - m);
        P->lbtab[c] = 0.f; P->lbtab[512 + c] = e1 / (e0 + e1);
        if (c < 2) {
            float s1 = 0.f, s2 = 0.f;
            for (int i = 0; i < 128; ++i) { s1 += P->lq1[c * 128 + i] * P->lk1[c * 128 + i]; s2 += P->lq2[c * 128 + i] * P->lk2[c * 128 + i]; }
            const float li = 0.8f - 0.6f * expf(-0.3f * (float)c);
            P->lam[c] = expf(s1) - expf(s2) + li;
        }
    }
    for (int i = bid_() * NTHR + tid; i < 2 * 128 * 3 * 64 * 8; i += gridDim.x * NTHR) {
        const int jj = i & 7, ln = (i >> 3) & 63, ct = (i >> 9) % 3, ksg = ((i >> 9) / 3) & 127, layer = (i >> 9) / (3 * 128);
        const int jc = ct * 32 + (ln & 31), k = ksg * 16 + 8 * (ln >> 5) + jj;
        float v = 0.f;
        if (jc < 8) v = P->wrg[((size_t)layer * DM + k) * 8 + jc]; else if (jc < 72) v = P->wre[((size_t)layer * DM + k) * 64 + jc - 8];
        v *= P->ln2_w[layer * DM + k];
        const bf16_t hi = f2bf(v), lo = f2bf(v - bf2f(hi));
        const size_t o = ((size_t)((ksg * 3 + ct) * 64 + ln)) * 8 + jj;
        P->WRT[(size_t)(layer * 2 + 0) * 96 * DM + o] = hi; P->WRT[(size_t)(layer * 2 + 1) * 96 * DM + o] = lo;
    }
}
namespace rt {
using f32x16 = __attribute__((ext_vector_type(16))) float;
using bf16x8 = __attribute__((ext_vector_type(8))) short;
using u32x4  = __attribute__((ext_vector_type(4))) unsigned;
__device__ __forceinline__ void norm_router(KP P, char* lds, int layer) {
    const int tid = tid_(), lane = tid & 63, wid = tid >> 6, r32 = lane & 31, hh = lane >> 5;
    float* part = (float*)lds;
    float* ssqp = (float*)(lds + 98304);
    float* lg = ssqp + 256;
    float* rsv = lg + 32 * 97;
    const bf16_t* Whi = P->WRT + (size_t)(layer * 2 + 0) * 96 * DM; const bf16_t* Wlo = P->WRT + (size_t)(layer * 2 + 1) * 96 * DM;
    const float* Z = P->Z;
    float* st = (float*)lds + wid * (32 * 68);
    const int nunits = layer == 1 ? (NB * SEQ) / 32 : TOK / 32;
    for (int u = bid_(); u < nunits; u += gridDim.x) {
        const int tok0 = layer == 1 ? (u >> 6) * LL + NMETA + (u & 63) * 32 : u * 32, kb = wid * 256;
        if (false) {
            float* Zw = P->Z; const float* ZP = P->ZP;
            for (int i = tid; i < 32 * DM / 4; i += NTHR) { const int r = i / (DM / 4), c4 = i % (DM / 4);
                float4 z = ((const float4*)(Zw + (size_t)(tok0 + r) * DM))[c4];
#pragma unroll
                for (int ks = 0; ks < 8; ++ks) { const float4 p4 = ((const float4*)(ZP + ((size_t)ks * 256 + (tok0 - 8192 + r)) * DM))[c4]; z.x += p4.x; z.y += p4.y; z.z += p4.z; z.w += p4.w; }
                ((float4*)(Zw + (size_t)(tok0 + r) * DM))[c4] = z; }
            asm volatile("s_waitcnt vmcnt(0)" ::: "memory");
            __syncthreads();
        }
        f32x16 acc[3] = {f32x16{}, f32x16{}, f32x16{}};
        float sq8[8];
#pragma unroll
        for (int j = 0; j < 8; ++j) sq8[j] = 0.f;
        const float* zg = Z + (size_t)(tok0 + (lane >> 4)) * DM + kb + (lane & 15) * 4;
        const bf16_t* dg = P->DLT + (size_t)(tok0 + (lane >> 4)) * DM + kb + (lane & 15) * 4;
        bf16_t* hg_ = P->HN + (size_t)(tok0 + (lane >> 4)) * DM + kb + (lane & 15) * 4;
        float4 zs[8]; uint2 ds[8];
#pragma unroll
        for (int j = 0; j < 8; ++j) { zs[j] = *(const float4*)(zg + (size_t)(4 * j) * DM); ds[j] = *(const uint2*)(dg + (size_t)(4 * j) * DM); }
#pragma unroll 1
        for (int sc = 0; sc < 4; ++sc) {
            const float4 lw = *(const float4*)(P->ln2_w + layer * DM + kb + (lane & 15) * 4 + sc * 64);
#pragma unroll
            for (int j = 0; j < 8; ++j) { float4 z = zs[j]; z.x += __uint_as_float(ds[j].x << 16); z.y += __uint_as_float(ds[j].x & 0xffff0000u); z.z += __uint_as_float(ds[j].y << 16); z.w += __uint_as_float(ds[j].y & 0xffff0000u);
                sq8[j] += z.x * z.x + z.y * z.y + z.z * z.z + z.w * z.w;
                *(float4*)(st + ((lane >> 4) + 4 * j) * 68 + (lane & 15) * 4) = z;
                uint2 o; o.x = cvtpk_(z.x * lw.x, z.y * lw.y); o.y = cvtpk_(z.z * lw.z, z.w * lw.w);
                *(uint2*)(hg_ + (size_t)(4 * j) * DM + sc * 64) = o; }
            const int scn = sc < 3 ? sc + 1 : 3;
#pragma unroll
            for (int j = 0; j < 8; ++j) { zs[j] = *(const float4*)(zg + (size_t)(4 * j) * DM + scn * 64); ds[j] = *(const uint2*)(dg + (size_t)(4 * j) * DM + scn * 64); }
            asm volatile("s_waitcnt lgkmcnt(0)" ::: "memory");
            const bf16_t* wh = Whi + ((size_t)((wid * 16 + sc * 4) * 3) * 64 + lane) * 8; const bf16_t* wl = Wlo + ((size_t)((wid * 16 + sc * 4) * 3) * 64 + lane) * 8;
#pragma unroll
            for (int ks = 0; ks < 4; ++ks) {
                const float4 z0 = *(const float4*)(st + r32 * 68 + ks * 16 + 8 * hh), z1 = *(const float4*)(st + r32 * 68 + ks * 16 + 8 * hh + 4);
                u32x4 h; h.x = cvtpk_(z0.x, z0.y); h.y = cvtpk_(z0.z, z0.w); h.z = cvtpk_(z1.x, z1.y); h.w = cvtpk_(z1.z, z1.w);
                u32x4 l; l.x = cvtpk_(z0.x - __uint_as_float(h.x << 16), z0.y - __uint_as_float(h.x & 0xffff0000u)); l.y = cvtpk_(z0.z - __uint_as_float(h.y << 16), z0.w - __uint_as_float(h.y & 0xffff0000u));
                l.z = cvtpk_(z1.x - __uint_as_float(h.z << 16), z1.y - __uint_as_float(h.z & 0xffff0000u)); l.w = cvtpk_(z1.z - __uint_as_float(h.w << 16), z1.w - __uint_as_float(h.w & 0xffff0000u));
                const bf16x8 zh = *reinterpret_cast<bf16x8*>(&h), zl = *reinterpret_cast<bf16x8*>(&l);
#pragma unroll
                for (int ct = 0; ct < 3; ++ct) {
                    const bf16x8 ah = *(const bf16x8*)(wh + (size_t)((ks * 3 + ct) * 64) * 8), al = *(const bf16x8*)(wl + (size_t)((ks * 3 + ct) * 64) * 8);
                    acc[ct] = __builtin_amdgcn_mfma_f32_32x32x16_bf16(ah, zh, acc[ct], 0, 0, 0);
                    acc[ct] = __builtin_amdgcn_mfma_f32_32x32x16_bf16(ah, zl, acc[ct], 0, 0, 0);
                    acc[ct] = __builtin_amdgcn_mfma_f32_32x32x16_bf16(al, zh, acc[ct], 0, 0, 0);
                }
            }
            asm volatile("s_waitcnt lgkmcnt(0)" ::: "memory");
        }
#pragma unroll
        for (int j = 0; j < 8; ++j) { float v = sq8[j]; v += swz_xor<1>(v); v += swz_xor<2>(v); v += swz_xor<4>(v); v += swz_xor<8>(v); sq8[j] = v; }
        __syncthreads();
        if ((lane & 15) == 0) {
#pragma unroll
            for (int j = 0; j < 8; ++j) ssqp[wid * 32 + (lane >> 4) + 4 * j] = sq8[j];
        }

#pragma unroll
        for (int ct = 0; ct < 3; ++ct)
#pragma unroll
            for (int rg = 0; rg < 16; ++rg) part[((wid * 3 + ct) * 16 + rg) * 64 + lane] = acc[ct][rg];
        __syncthreads();
        if (tid < 32) { float t = 0.f;
#pragma unroll
            for (int w = 0; w < 8; ++w) t += ssqp[w * 32 + tid];
            rsv[tid] = rsqrtf(t * (1.f / DM) + EPS); }
#pragma unroll
        for (int q = 0; q < 6; ++q) { const int o = tid + NTHR * q, col = o >> 5, tok = o & 31, ct = col >> 5, cl = col & 31, h2 = (cl >> 2) & 1, rg = (cl & 3) + 4 * (cl >> 3);
            float t = 0.f;
#pragma unroll
            for (int w = 0; w < 8; ++w) t += part[((w * 3 + ct) * 16 + rg) * 64 + h2 * 32 + tok];
            lg[tok * 97 + col] = t; }
        __syncthreads();
        if (tid < 32) {
            const int t = tok0 + tid; const float rs = rsv[tid]; const float* l = lg + tid * 97;
            const float* brg = P->brg + layer * 8; const float* bre = P->bre + layer * 64;
            float gl[8];
#pragma unroll
            for (int j = 0; j < 8; ++j) gl[j] = l[j] * rs + brg[j];
            int gs = 0; float gm = gl[0];
#pragma unroll
            for (int j = 1; j < 8; ++j) if (gl[j] > gm) { gm = gl[j]; gs = j; }
            float den = 0.f;
#pragma unroll
            for (int j = 0; j < 8; ++j) den += expf(gl[j] - gm);
            const float pg = 1.f / den;
            float el[8];
#pragma unroll
            for (int j = 0; j < 8; ++j) el[j] = l[8 + gs * 8 + j] * rs + bre[gs * 8 + j];
            int j0 = 0; float v0 = el[0];
#pragma unroll
            for (int j = 1; j < 8; ++j) if (el[j] > v0) { v0 = el[j]; j0 = j; }
            int j1 = -1; float v1 = -INFINITY;
#pragma unroll
            for (int j = 0; j < 8; ++j) if (j != j0 && el[j] > v1) { v1 = el[j]; j1 = j; }
            const float e1 = expf(v1 - v0), g0 = pg / (1.f + e1), g1 = pg * e1 / (1.f + e1);
            const int x0 = gs * 8 + j0, x1 = gs * 8 + j1;
            P->ridx[t * 2] = x0; P->ridx[t * 2 + 1] = x1; P->rgate[t * 2] = g0; P->rgate[t * 2 + 1] = g1;
            const int s0 = atomicAdd(&P->cnt[x0 * CSTR], 1), s1 = atomicAdd(&P->cnt[x1 * CSTR], 1);
            P->rslot[t * 2] = s0; P->rslot[t * 2 + 1] = s1;
            P->rsn[t] = rs;
            if (s0 < ECAP) { P->elist[x0 * ECAP + s0] = t; P->ers[x0 * ECAP + s0] = rs; } if (s1 < ECAP) { P->elist[x1 * ECAP + s1] = t; P->ers[x1 * ECAP + s1] = rs; }
        }
        __syncthreads();
    }
}
}
__device__ __forceinline__ void ph_combine_norm(KP P, char* lds, int layer) {
    int* base = (int*)lds;
    const int tid = tid_(), lane = tid & 63, gw = bid_() * 8 + (tid >> 6), NGW = gridDim.x * 8;
    if (tid < 64) base[64 + tid] = P->cnt[tid * CSTR];
    __syncthreads();
    if (tid < 64) { int a = 0; for (int q = 0; q < tid; ++q) a += base[64 + q]; base[tid] = a; }
    __syncthreads();
    for (int t0 = gw; t0 < TOK; t0 += 2 * NGW) {
        int r0[2], r1[2]; float g0[2], g1[2]; bool ok[2]; int tcs[2];
        int2 ex[2], sl[2]; float2 gg[2];
        float4 v[2][8]; uint2 ya[2][8], yb[2][8], dl[2][8];
#pragma unroll
        for (int q = 0; q < 2; ++q) { const int t = t0 + q * NGW; ok[q] = t < TOK && !(layer == 1 && (t % LL) < NMETA); tcs[q] = ok[q] ? t : (layer == 1 ? NMETA : t0);
            ex[q] = ((const int2*)P->ridx)[tcs[q]]; sl[q] = ((const int2*)P->rslot)[tcs[q]]; gg[q] = ((const float2*)P->rgate)[tcs[q]];
#pragma unroll
            for (int j = 0; j < 8; ++j) { v[q][j] = ((const float4*)(P->Z + (size_t)tcs[q] * DM))[lane + 64 * j]; dl[q][j] = ((const uint2*)(P->DLT + (size_t)tcs[q] * DM))[lane + 64 * j]; } }
#pragma unroll
        for (int q = 0; q < 2; ++q) { r0[q] = base[ex[q].x] + sl[q].x; r1[q] = base[ex[q].y] + sl[q].y; g0[q] = gg[q].x; g1[q] = gg[q].y;
#pragma unroll
            for (int j = 0; j < 8; ++j) { ya[q][j] = ((const uint2*)(P->Y + (size_t)r0[q] * DM))[lane + 64 * j]; yb[q][j] = ((const uint2*)(P->Y + (size_t)r1[q] * DM))[lane + 64 * j]; } }
#pragma unroll
        for (int q = 0; q < 2; ++q) if (ok[q]) { const int t = t0 + q * NGW;
            float ss = 0.f;
#pragma unroll
            for (int j = 0; j < 8; ++j) { const uint2 a = ya[q][j], b = yb[q][j], d = dl[q][j]; float4& x = v[q][j];
                x.x += __uint_as_float(d.x << 16); x.y += __uint_as_float(d.x & 0xffff0000u); x.z += __uint_as_float(d.y << 16); x.w += __uint_as_float(d.y & 0xffff0000u);
                x.x += g0[q] * __uint_as_float(a.x << 16) + g1[q] * __uint_as_float(b.x << 16); x.y += g0[q] * __uint_as_float(a.x & 0xffff0000u) + g1[q] * __uint_as_float(b.x & 0xffff0000u);
                x.z += g0[q] * __uint_as_float(a.y << 16) + g1[q] * __uint_as_float(b.y << 16); x.w += g0[q] * __uint_as_float(a.y & 0xffff0000u) + g1[q] * __uint_as_float(b.y & 0xffff0000u);
                ss += x.x * x.x + x.y * x.y + x.z * x.z + x.w * x.w; }
            const float rs = rsqrtf(wave_sum(ss) * (1.f / DM) + EPS);
            if (layer == 0) {
#pragma unroll
                for (int j = 0; j < 8; ++j) { ((float4*)(P->Z + (size_t)t * DM))[lane + 64 * j] = v[q][j];
                    const float4 w = ((const float4*)(P->ln1_w + DM))[lane + 64 * j];
                    uint2 o; o.x = cvtpk_(v[q][j].x * rs * w.x, v[q][j].y * rs * w.y); o.y = cvtpk_(v[q][j].z * rs * w.z, v[q][j].w * rs * w.w);
                    ((uint2*)(P->HN + (size_t)t * DM))[lane + 64 * j] = o; }
            } else {
                const int b = t / LL, tt = t % LL;
                if (tt >= NMETA) {
#pragma unroll
                    for (int j = 0; j < 8; ++j) { const float4 w = ((const float4*)P->fnw)[lane + 64 * j];
                        ((float4*)(P->out + ((size_t)b * SEQ + (tt - NMETA)) * DM))[lane + 64 * j] = make_float4(v[q][j].x * rs * w.x, v[q][j].y * rs * w.y, v[q][j].z * rs * w.z, v[q][j].w * rs * w.w); }
                }
            }
        }
    }
    __syncthreads();
}

__global__ void __launch_bounds__(NTHR, 2) mega_fwd(Params P_arg) {
    extern __shared__ __attribute__((aligned(16))) char lds[];
    const int tid = tid_(), G = gridDim.x;
    volatile LAS unsigned* ctlw = (volatile LAS unsigned*)((LAS char*)lds + LDS_CTL);
    if (tid < 64) ctlw[tid] = 0u;
    __syncthreads();
    KP P = kp_();
    XcdBarrier bar = xcd_barrier_post(P->bar, ctlw + 8);
#define GRID_BAR() do { xcd_barrier(bar); P = kp_(); } while (0)

    ph_build_norm(P);
    ph_prep(P);
    ph_weights(P, lds);
    __syncthreads();
    for (int un = bid_(); un < 64; un += G) s5::prep_unit(P, lds, un >> 5, un & 31);
    GRID_BAR();
#pragma unroll
    for (int layer = 0; layer < 2; ++layer) {
        { pg8::Gemm g{P->HN, P->WinT + (size_t)layer * INW * DM, MP, INW, DM, DM}; pg8::StaticOrder S; S.init(MP, INW, G, bid_(), DM / 64); pg8::EpiInProj E{P->PA, P->QKV};
          pg8::gemm_phase<pg8::EpiInProj, pg8::StaticOrder, true, true>((LAS unsigned char*)lds, g, S, E); }
        { const int t2 = tid_(), b2 = bid_(); if (b2 == 0 && t2 < NE) P->cnt[t2 * CSTR] = 0;
 }
        GRID_BAR();
        hg::local_states(P, lds, layer);
        { const int b0 = bid_(); for (int un = (G == 256) ? ((b0 + 128) & 255) : b0; un < 128; un += G) s5::fused_unit(P, lds, layer, un >> 5, un & 31); }
        ph_attention(P, lds);
        GRID_BAR();
        hg::scan_states(P);
        ph_attn_out(P, layer, G > 192 ? 132 : 0);
        __syncthreads();
        { pg8::Gemm g{P->YG, P->WgluT + (size_t)layer * 1024 * 512, MP, 1024, 512, 512}; pg8::StaticOrder S; S.init(MP, 1024, G, bid_(), 512 / 64); pg8::EpiGlu E{P->MIX, P->b_glu + layer * 1024};
          pg8::gemm_phase<pg8::EpiGlu, pg8::StaticOrder, true, true>((LAS unsigned char*)lds, g, S, E); }
        GRID_BAR();
        hg::outputs(P, lds, layer);
        GRID_BAR();
        { pg8::Gemm g{P->MIX, P->WoutT + (size_t)layer * DM * DM, MP, DM, DM, DM}; pg8::StaticOrder S; S.init(MP, DM, G, bid_(), DM / 64); pg8::EpiResidual E{P->DLT};
          pg8::gemm_phase<pg8::EpiResidual, pg8::StaticOrder, true, true>((LAS unsigned char*)lds, g, S, E); }
        GRID_BAR();
        rt::norm_router(P, lds, layer);
        GRID_BAR();
        moe::stream_gemm<true>(P, lds, layer);
        GRID_BAR();
        moe::stream_gemm<false>(P, lds, layer);
        GRID_BAR();
        ph_combine_norm(P, lds, layer);
        if (layer == 0) GRID_BAR();
    }
}
}

extern "C" void kernel_launch(void* const* d_in, const int* in_sizes, int n_in, void* d_out, int out_size, void* d_ws, size_t ws_size, hipStream_t stream) {
    static int grid = 0;
    if (grid == 0) {
        int dev = 0, cus = 0;
        if (hipGetDevice(&dev) != hipSuccess || hipDeviceGetAttribute(&cus, hipDeviceAttributeMultiprocessorCount, dev) != hipSuccess) { grid = -1; return; }
        if (hipFuncSetAttribute((const void*)mega_fwd, hipFuncAttributeMaxDynamicSharedMemorySize, LDS_BYTES) != hipSuccess) { grid = -1; return; }
        int per_cu = 0;
        if (hipOccupancyMaxActiveBlocksPerMultiprocessor(&per_cu, (const void*)mega_fwd, NTHR, LDS_BYTES) != hipSuccess || per_cu < 1) { (void)hipGetLastError(); }
        grid = cus;
    }
    if (grid < 0) return;
    Params p{};
    const float** pin = (const float**)&p;
    for (int i = 0; i < 31; ++i) pin[i] = (const float*)d_in[i];
    p.out = (float*)d_out;
    char* ws = (char*)d_ws; size_t off = 0;
    auto alloc = [&](size_t bytes) { char* q = ws + off; off += (bytes + 255) & ~(size_t)255; return q; };
    p.bar = (unsigned*)alloc(XCD_BAR_WORDS * 4);
    p.elist = (int*)alloc((size_t)NE * ECAP * 4); p.ers = (float*)alloc((size_t)NE * ECAP * 4); p.rsn = (float*)alloc((size_t)MP * 4);
    p.cnt = (int*)alloc((size_t)NE * CSTR * 4); p.blk_e = (int*)alloc(1024); p.base = (int*)alloc(256);
    p.lbtab = (float*)alloc(1024 * 4); p.lam = (float*)alloc(256);
    p.Z = (float*)alloc((size_t)MP * DM * 4);
    p.HN = (bf16_t*)alloc((size_t)MP * DM * 2);
    p.PA = (float*)alloc((size_t)MP * PAW * 4);
    p.QKV = (bf16_t*)alloc((size_t)MP * QKVW * 2);
    p.OA = (float*)alloc((size_t)MP * HW * 4);
    p.ZP = (float*)alloc((size_t)8 * 256 * DM * 4);
    p.WRT = (bf16_t*)alloc((size_t)2 * 2 * 96 * DM * 2);
    p.A16 = (float*)alloc(2 * 32 * 64 * 8); p.S5E = (float*)alloc((size_t)516 * 32 * 128 * 4); p.S5X = (float*)alloc((size_t)516 * 32 * 128 * 4);
    p.BtY = (bf16_t*)alloc((size_t)2 * 32 * 256 * 384 * 2); p.BtE = (bf16_t*)alloc((size_t)2 * 32 * 128 * 256 * 2);
    p.SLOC = (float*)alloc((size_t)528 * 16384 * 4); p.DEC = (float*)alloc((size_t)528 * 128 * 4); p.SPREV = (bf16_t*)alloc((size_t)529 * 16384 * 2);
    p.YG = (bf16_t*)alloc((size_t)MP * 512 * 2); p.DLT = (bf16_t*)alloc((size_t)MP * DM * 2);
    p.T = nullptr;
    p.MIX = (bf16_t*)alloc((size_t)MP * DM * 2);
    p.OC = (float*)alloc((size_t)MP * DM * 4);
    p.ridx = (int*)alloc((size_t)NASSIGN * 4); p.rgate = (float*)alloc((size_t)NASSIGN * 4); p.rslot = (int*)alloc((size_t)NASSIGN * 4);
    p.tokrow = (int*)alloc((size_t)NASSIGN * 4); p.rowtok = (int*)alloc((size_t)NRMAX * 4);
    p.H1 = nullptr;
    p.H = (bf16_t*)alloc((size_t)NRMAX * DE * 2);
    p.Y = (bf16_t*)alloc((size_t)NRMAX * DM * 2);
    p.S = nullptr;
    p.WinT = (bf16_t*)alloc((size_t)2 * INW * DM * 2); p.WoutT = (bf16_t*)alloc((size_t)2 * DM * DM * 2); p.WgluT = (bf16_t*)alloc((size_t)2 * 1024 * 512 * 2);
    if (off > ws_size) return;
    if (hipMemsetAsync(p.bar, 0, XCD_BAR_WORDS * 4, stream) != hipSuccess) return;
    hipLaunchKernelGGL(mega_fwd, dim3(grid), dim3(NTHR), LDS_BYTES, stream, p);
}
```

```cpp
#include <hip/hip_runtime.h>
#include <stdint.h>
#include <math.h>

namespace {
typedef unsigned short bf16_t;
constexpr int DM = 2048, NB = 4, SEQ = 2048, NMETA = 16, LL = SEQ + NMETA, TOK = NB * LL, MP = 8448;
constexpr int HW = 512;
constexpr int INW = 5632, PAW = 2560, QKVW = 3072;
constexpr int NE = 64, DE = 512, NASSIGN = TOK * 2;
constexpr int RB = 128;
constexpr int NRMAX = NASSIGN + NE * RB;
constexpr float EPS = 1e-6f;
constexpr int NTHR = 512;
constexpr int CSTR = 64;
constexpr int ECAP = 1024;
constexpr int LDS_BYTES = 163840;
constexpr int LDS_CTL = 159744;

__device__ __forceinline__ float bf2f(bf16_t h) { return __uint_as_float(((unsigned)h) << 16); }
__device__ __forceinline__ bf16_t f2bf(float f) { unsigned u = __float_as_uint(f); return (bf16_t)((u + 0x7fffu + ((u >> 16) & 1u)) >> 16); }
__device__ __forceinline__ float sigmoidf_(float x) { return 1.f / (1.f + expf(-x)); }
__device__ __forceinline__ int tid_() { int t = threadIdx.x; asm volatile("" : "+v"(t)); return t; }
template <int K> __device__ __forceinline__ float swz_xor(float v) { return __int_as_float(__builtin_amdgcn_ds_swizzle(__float_as_int(v), (K << 10) | 0x1f)); }
__device__ __forceinline__ int bid_() { int b = blockIdx.x; asm volatile("" : "+s"(b)); return b; }

#define XB_TMO      128
#define XB_XCNT(j)  (256  + 64 * (j))
#define XB_XSUB(j)  (1280 + 64 * (j))
#define XB_XGEN(j)  (2304 + 64 * (j))
#define XB_TOP      3328
#define XB_TOPGEN   3392
#define XCD_BAR_WORDS 3456
#define XB_SPIN_CAP (1u << 24)
#define LAS __attribute__((address_space(3)))
__device__ __forceinline__ unsigned xb_ld(unsigned* p)              { return __hip_atomic_load(p, __ATOMIC_RELAXED, __HIP_MEMORY_SCOPE_AGENT); }
__device__ __forceinline__ unsigned xb_add(unsigned* p, unsigned v) { return __hip_atomic_fetch_add(p, v, __ATOMIC_RELAXED, __HIP_MEMORY_SCOPE_AGENT); }
__device__ __forceinline__ unsigned xb_xcc_id() { return (unsigned)__builtin_amdgcn_s_getreg((3 << 11) | 20) & 0xFu; }
#define XB_SPIN(cond, bar) do { unsigned _sp = 0; while (cond) { __builtin_amdgcn_s_sleep(1); \
    if ((++_sp & 255u) == 0u) { if (xb_ld(&(bar)[XB_TMO])) break; if (_sp > XB_SPIN_CAP) { atomicAdd(&(bar)[XB_TMO], 1u); break; } } } } while (0)
struct XcdBarrier { unsigned* bar; unsigned x; volatile LAS unsigned* st; };
__device__ __forceinline__ XcdBarrier xcd_barrier_post(unsigned* bar, volatile LAS unsigned* st) {
    XcdBarrier b; b.bar = bar; b.x = xb_xcc_id(); b.st = st;
    if (threadIdx.x == 0) (void)xb_add(&bar[XB_XCNT(b.x)], 1u);
    return b;
}
__device__ __forceinline__ void xcd_barrier_complete(unsigned* bar, unsigned x, unsigned& nloc, unsigned& nx) {
    const unsigned G = gridDim.x * gridDim.y * gridDim.z;
    unsigned sum, cnt, mine, sp = 0u;
    for (;;) {
        sum = 0u; cnt = 0u; mine = 0u;
#pragma unroll
        for (unsigned j = 0; j < 16; ++j) { const unsigned c = xb_ld(&bar[XB_XCNT(j)]); sum += c; cnt += (c > 0u) ? 1u : 0u; mine = (j == x) ? c : mine; }
        if (sum == G) break;
        __builtin_amdgcn_s_sleep(1);
        if ((++sp & 255u) == 0u) { if (xb_ld(&bar[XB_TMO])) break; if (sp > XB_SPIN_CAP) { atomicAdd(&bar[XB_TMO], 1u); break; } }
    }
    nloc = mine > 0u ? mine : 1u; nx = cnt > 0u ? cnt : 1u;
}
__device__ __forceinline__ void xcd_barrier(const XcdBarrier& b) {
    asm volatile("s_waitcnt vmcnt(0)" ::: "memory");
    __syncthreads();
    if (threadIdx.x == 0) {
        unsigned* bar = b.bar;
        const unsigned bx_ = xb_xcc_id();
        __builtin_amdgcn_s_waitcnt(0);
        unsigned nloc = b.st[0], nx = b.st[1];
        if (nloc == 0u) { xcd_barrier_complete(bar, bx_, nloc, nx); b.st[0] = nloc; b.st[1] = nx; }
        const unsigned old = xb_add(&bar[XB_XSUB(bx_)], 1u);
        const unsigned gen = old / nloc;
        if (old + 1u == (gen + 1u) * nloc) {
            __builtin_amdgcn_fence(__ATOMIC_RELEASE, "agent");
            asm volatile("s_waitcnt vmcnt(0)" ::: "memory");
            const unsigned og = xb_add(&bar[XB_TOP], 1u);
            const unsigned tg = og / nx;
            if (og + 1u == (tg + 1u) * nx) xb_add(&bar[XB_TOPGEN], 1u);
            else XB_SPIN(xb_ld(&bar[XB_TOPGEN]) == tg, bar);
            __builtin_amdgcn_fence(__ATOMIC_ACQUIRE, "agent");
            xb_add(&bar[XB_XGEN(bx_)], 1u);
            asm volatile("s_waitcnt vmcnt(0)" ::: "memory");
        } else {
            XB_SPIN(xb_ld(&bar[XB_XGEN(bx_)]) == gen, bar);
            __builtin_amdgcn_fence(__ATOMIC_ACQUIRE, "agent");
            asm volatile("s_waitcnt vmcnt(0)" ::: "memory");
        }
    }
    __syncthreads();
}

struct Params {
    const float *x, *meta, *ln1_w, *w_in, *lbnd, *hnw, *a_re, *a_im, *b_re, *b_im, *c_re, *c_im, *s5d, *log_dt, *w_glu, *b_glu,
                *lq1, *lk1, *lq2, *lk2, *subln, *w_out, *ln2_w, *wrg, *brg, *wre, *bre, *w1, *w3, *w2, *fnw;
    float* out;
    unsigned* bar;
    int *cnt, *blk_e, *ridx, *rslot, *tokrow, *rowtok, *base, *elist;
    float *lbtab, *lam, *Z, *PA, *OA, *T, *OC, *rgate, *H1, *S, *SLOC, *DEC, *A16, *S5E, *S5X, *ZP, *ers, *rsn;
    bf16_t *HN, *QKV, *YG, *MIX, *H, *Y, *WinT, *WoutT, *WgluT, *SPREV, *BtY, *BtE, *WRT, *DLT;
};
typedef const __attribute__((address_space(4))) Params* KP;
__device__ __forceinline__ KP kp_() { KP p = (KP)__builtin_amdgcn_kernarg_segment_ptr(); asm volatile("" : "+s"(p)); return p; }


namespace pg8 {
#define PG8_LAS __attribute__((address_space(3)))
typedef short bf16x8 __attribute__((ext_vector_type(8)));
typedef float f32x4 __attribute__((ext_vector_type(4)));
typedef unsigned u32x4 __attribute__((ext_vector_type(4)));
constexpr int BM = 256, BK = 64, HALF = 128, HTB = HALF * BK * 2, STAGE_BYTES = 8 * HTB, NXCD = 8, WGM = 8;
__host__ __device__ __forceinline__ int lds_byte(int r, int c) { const int st = (r >> 4) * 2 + (c >> 5), rr = r & 15, cc = c & 31, ob = rr * 64 + cc * 2; return st * 1024 + (ob ^ (((ob >> 9) & 1) << 5)); }
__host__ __device__ __forceinline__ void stage_rc(int b, int& R, int& C) { const int st = b / 1024, sb = b % 1024, swz = sb ^ (((sb >> 9) & 1) << 5); R = (st >> 1) * 16 + swz / 64; C = (st & 1) * 32 + (swz % 64) / 2; }
__host__ __device__ __forceinline__ int perm32(int rho) { const int n = rho >> 4, i = rho & 15; return 8 * (i >> 2) + 4 * n + (i & 3); }
struct Unit { int pm, pn, ko, nt; };
struct Gemm { const bf16_t* A; const bf16_t* Bt; int M, N, K, ld; };
struct StaticOrder {
    static constexpr bool PER_UNIT_K = false;
    int nM, nN, nwg, G, c, nt;
    __host__ __device__ void init(int M, int N, int G_, int c_, int nt_) { nM = M / BM; nN = N / BM; nwg = nM * nN; G = G_; c = c_; nt = nt_; }
    __host__ __device__ bool next(int i, Unit& u) const {
        const long L = (long)i * G + c; if (L >= nwg) return false;
        int wgid = (int)L; { const int q = nwg / NXCD, r = nwg % NXCD, xcd = wgid % NXCD, off = wgid / NXCD; wgid = (xcd < r ? xcd * (q + 1) : r * (q + 1) + (xcd - r) * q) + off; }
        const int nig = WGM * nN, gid = wgid / nig, fm = gid * WGM, gsz = (nM - fm) < WGM ? (nM - fm) : WGM;
        u.pm = fm + ((wgid % nig) % gsz); u.pn = (wgid % nig) / gsz; u.ko = 0; u.nt = nt; return true;
    }
    __device__ __forceinline__ void a_ready(const Unit&) const {}
    __device__ __forceinline__ void done(const Unit&) const {}
};
__device__ __forceinline__ unsigned cvt_pk_bf16(float lo, float hi) { unsigned r; asm volatile("v_cvt_pk_bf16_f32 %0, %1, %2" : "=v"(r) : "v"(lo), "v"(hi)); return r; }

template <class Epi, class Sched, bool ALIGN_EPI = false, bool SP2 = false>
__device__ __forceinline__ void gemm_phase(PG8_LAS unsigned char* lds, const Gemm g, const Sched& S, const Epi& E) {
    const int tid = tid_(), wid = __builtin_amdgcn_readfirstlane(tid >> 6), lane = tid & 63, wr = wid >> 2, wc = wid & 3, fr = lane & 15, fq = lane >> 4;
    const int K = g.ld;
    unsigned voffA[2], voffB[2];
#pragma unroll
    for (int i = 0; i < 2; ++i) { int R, C; stage_rc(tid * 16 + i * 8192, R, C); const int Rb = Epi::PERM ? ((R & ~31) + perm32(R & 31)) : R;
        voffA[i] = (unsigned)(R * K + C) * 2u; voffB[i] = (unsigned)(Rb * K + C) * 2u; }
    const size_t kstep = (size_t)(BK * 2);
    const size_t hstep = (size_t)HALF * K * 2;
    const size_t tstep = 2 * hstep;
    const unsigned ldsw = (unsigned)wid * 1024u;
    const int aoff = lds_byte(wr * 64 + fr, fq * 8), boff = lds_byte(wc * 32 + fr, fq * 8);
#define PG8_SA(b, h) (((b) * 2 + (h)) * HTB)
#define PG8_SB(b, h) ((4 + (b) * 2 + (h)) * HTB)
#define PG8_STAGE(bufoff, gbase, voff) do { _Pragma("unroll") for (int _i = 0; _i < 2; ++_i) \
        __builtin_amdgcn_global_load_lds((const unsigned*)((const char*)(gbase) + (voff)[_i]), (PG8_LAS unsigned*)(lds + (bufoff) + ldsw + _i * 8192), 16, 0, 0); } while (0)
#define PG8_LDA(dst, b, h) do { _Pragma("unroll") for (int m = 0; m < 4; ++m) _Pragma("unroll") for (int k = 0; k < 2; ++k) dst[m][k] = *(const PG8_LAS bf16x8*)(lds + PG8_SA(b, h) + aoff + m * 2048 + k * 1024); } while (0)
#define PG8_LDB(dst, b, h) do { _Pragma("unroll") for (int n = 0; n < 2; ++n) _Pragma("unroll") for (int k = 0; k < 2; ++k) dst[n][k] = *(const PG8_LAS bf16x8*)(lds + PG8_SB(b, h) + boff + n * 2048 + k * 1024); } while (0)
#define PG8_MMA(ai, bj, At, Bt) do { __builtin_amdgcn_s_setprio(1); _Pragma("unroll") for (int m = 0; m < 4; ++m) _Pragma("unroll") for (int n = 0; n < 2; ++n) _Pragma("unroll") for (int k = 0; k < 2; ++k) \
        acc[ai][bj][m][n] = __builtin_amdgcn_mfma_f32_16x16x32_bf16(Bt[n][k], At[m][k], acc[ai][bj][m][n], 0, 0, 0); __builtin_amdgcn_s_setprio(0); } while (0)
#define PG8_WAIT_V(n) asm volatile("s_waitcnt vmcnt(" #n ")" ::: "memory")
#define PG8_WAIT_L(n) asm volatile("s_waitcnt lgkmcnt(" #n ")" ::: "memory")
#define PG8_BAR __builtin_amdgcn_s_barrier()
#define PG8_SCHED __builtin_amdgcn_sched_barrier(0)
    Unit cur, nxt; int ui = 0;
    if (!S.next(0, cur)) return;
    f32x4 acc[2][2][4][2];
#pragma unroll
    for (int a = 0; a < 2; ++a)
#pragma unroll
        for (int b = 0; b < 2; ++b)
#pragma unroll
            for (int m = 0; m < 4; ++m)
#pragma unroll
                for (int n = 0; n < 2; ++n) acc[a][b][m][n] = (f32x4){0.f, 0.f, 0.f, 0.f};
    bf16x8 At[4][2], B0[2][2], B1[2][2];
    const char* cA = (const char*)g.A + (size_t)cur.pm * tstep + (size_t)cur.ko * 2; const char* cB = (const char*)g.Bt + (size_t)cur.pn * tstep + (size_t)cur.ko * 2;
    S.a_ready(cur);
    if constexpr (SP2) {
        PG8_STAGE(PG8_SB(0, 0), cB, voffB); PG8_STAGE(PG8_SB(0, 1), cB + hstep, voffB); PG8_STAGE(PG8_SA(0, 0), cA, voffA); PG8_STAGE(PG8_SA(0, 1), cA + hstep, voffA);
        if (wr == 1) PG8_BAR;
        PG8_WAIT_V(2); PG8_BAR;
        PG8_STAGE(PG8_SB(1, 0), cB + kstep, voffB); PG8_STAGE(PG8_SA(1, 0), cA + kstep, voffA); PG8_STAGE(PG8_SB(1, 1), cB + hstep + kstep, voffB);
        PG8_WAIT_V(6); PG8_BAR;
    } else {
        PG8_STAGE(PG8_SB(0, 0), cB, voffB); PG8_STAGE(PG8_SA(0, 0), cA, voffA); PG8_STAGE(PG8_SB(0, 1), cB + hstep, voffB); PG8_STAGE(PG8_SA(0, 1), cA + hstep, voffA);
        if (wr == 1) PG8_BAR;
        PG8_WAIT_V(4); PG8_BAR;
        PG8_STAGE(PG8_SB(1, 0), cB + kstep, voffB); PG8_STAGE(PG8_SA(1, 0), cA + kstep, voffA); PG8_STAGE(PG8_SB(1, 1), cB + hstep + kstep, voffB);
        PG8_WAIT_V(6); PG8_BAR;
    }
    for (;;) {
        const bool has_next = S.next(ui + 1, nxt);
        const char* nA = has_next ? (const char*)g.A + (size_t)nxt.pm * tstep + (size_t)nxt.ko * 2 : cA; const char* nB = has_next ? (const char*)g.Bt + (size_t)nxt.pn * tstep + (size_t)nxt.ko * 2 : cB;
        const int nt = Sched::PER_UNIT_K ? cur.nt : g.K / BK;
        for (int t = 0; t < nt; t += 2) {
            const bool last = (t == nt - 2);
            const char* a1 = cA + (size_t)(t + 1) * kstep;
            const char* a2 = last ? nA : cA + (size_t)(t + 2) * kstep; const char* b2 = last ? nB : cB + (size_t)(t + 2) * kstep;
            const char* a3 = a2 + kstep; const char* b3 = b2 + kstep;
            if (last && has_next) S.a_ready(nxt);
            if constexpr (SP2) {
            PG8_LDB(B0, 0, 0); PG8_LDB(B1, 0, 1); PG8_SCHED; PG8_LDA(At, 0, 0); PG8_STAGE(PG8_SA(1, 1), a1 + hstep, voffA);
            PG8_WAIT_V(8); PG8_WAIT_L(0); PG8_BAR; PG8_MMA(0, 0, At, B0); PG8_MMA(0, 1, At, B1); PG8_BAR; PG8_SCHED;
            PG8_LDA(At, 0, 1); PG8_STAGE(PG8_SB(0, 0), b2, voffB); PG8_STAGE(PG8_SB(0, 1), b2 + hstep, voffB); PG8_STAGE(PG8_SA(0, 0), a2, voffA);
            PG8_WAIT_V(8); PG8_WAIT_L(0); PG8_BAR; PG8_MMA(1, 0, At, B0); PG8_MMA(1, 1, At, B1); PG8_BAR; PG8_SCHED;
            PG8_LDB(B0, 1, 0); PG8_LDB(B1, 1, 1); PG8_SCHED; PG8_LDA(At, 1, 0); PG8_STAGE(PG8_SA(0, 1), a2 + hstep, voffA);
            PG8_WAIT_V(8); PG8_WAIT_L(0); PG8_BAR; PG8_MMA(0, 0, At, B0); PG8_MMA(0, 1, At, B1); PG8_BAR; PG8_SCHED;
            PG8_LDA(At, 1, 1); PG8_STAGE(PG8_SB(1, 0), b3, voffB); PG8_STAGE(PG8_SB(1, 1), b3 + hstep, voffB); PG8_STAGE(PG8_SA(1, 0), a3, voffA);
            PG8_WAIT_V(8); PG8_WAIT_L(0); PG8_BAR; PG8_MMA(1, 0, At, B0); PG8_MMA(1, 1, At, B1); PG8_BAR; PG8_SCHED;
            } else {
            PG8_LDB(B0, 0, 0); PG8_SCHED; PG8_LDA(At, 0, 0); PG8_STAGE(PG8_SA(1, 1), a1 + hstep, voffA);
            PG8_WAIT_L(8); PG8_BAR; PG8_WAIT_L(0); PG8_MMA(0, 0, At, B0); PG8_BAR; PG8_SCHED;
            PG8_LDB(B1, 0, 1); PG8_STAGE(PG8_SB(0, 0), b2, voffB);
            PG8_BAR; PG8_WAIT_L(0); PG8_MMA(0, 1, At, B1); PG8_BAR;
            PG8_LDA(At, 0, 1); PG8_STAGE(PG8_SA(0, 0), a2, voffA);
            PG8_BAR; PG8_WAIT_L(0); PG8_MMA(1, 0, At, B0); PG8_BAR; PG8_SCHED;
            PG8_STAGE(PG8_SB(0, 1), b2 + hstep, voffB);
            PG8_WAIT_V(6); PG8_BAR; PG8_MMA(1, 1, At, B1); PG8_BAR;
            PG8_LDB(B0, 1, 0); PG8_SCHED; PG8_LDA(At, 1, 0); PG8_STAGE(PG8_SA(0, 1), a2 + hstep, voffA);
            PG8_WAIT_L(8); PG8_BAR; PG8_WAIT_L(0); PG8_MMA(0, 0, At, B0); PG8_BAR; PG8_SCHED;
            PG8_LDB(B1, 1, 1); PG8_STAGE(PG8_SB(1, 0), b3, voffB);
            PG8_BAR; PG8_WAIT_L(0); PG8_MMA(0, 1, At, B1); PG8_BAR;
            PG8_LDA(At, 1, 1); PG8_STAGE(PG8_SA(1, 0), a3, voffA);
            PG8_BAR; PG8_WAIT_L(0); PG8_MMA(1, 0, At, B0); PG8_BAR; PG8_SCHED;
            PG8_STAGE(PG8_SB(1, 1), b3 + hstep, voffB);
            PG8_WAIT_V(6); PG8_BAR; PG8_MMA(1, 1, At, B1); PG8_BAR;
            }
        }
        if constexpr (ALIGN_EPI) { if (wr == 0) PG8_BAR; }
        E(acc, cur, wr, wc, fr, fq);
        if (!has_next) break;
#pragma unroll
        for (int a = 0; a < 2; ++a)
#pragma unroll
            for (int b = 0; b < 2; ++b)
#pragma unroll
                for (int m = 0; m < 4; ++m)
#pragma unroll
                    for (int n = 0; n < 2; ++n) acc[a][b][m][n] = (f32x4){0.f, 0.f, 0.f, 0.f};
        cur = nxt; cA = nA; cB = nB; ++ui;
        if constexpr (ALIGN_EPI) { if (wr == 1) PG8_BAR; }
    }
    PG8_WAIT_V(0);
    if constexpr (!ALIGN_EPI) { if (wr == 0) PG8_BAR; }
    PG8_BAR;
#undef PG8_SA
#undef PG8_SB
#undef PG8_STAGE
#undef PG8_LDA
#undef PG8_LDB
#undef PG8_MMA
#undef PG8_WAIT_V
#undef PG8_WAIT_L
#undef PG8_BAR
#undef PG8_SCHED
}
struct EpiInProj {
    static constexpr bool PERM = true;
    float* PA; bf16_t* QKV;
    __device__ __forceinline__ void operator()(const f32x4 (&acc)[2][2][4][2], const Unit& u, int wr, int wc, int fr, int fq) const {
        const int row0 = u.pm * BM + wr * 64 + fr, colt = u.pn * BM + wc * 32 + 8 * fq;
        if (colt < PAW) {
#pragma unroll
            for (int ai = 0; ai < 2; ++ai)
#pragma unroll
                for (int m = 0; m < 4; ++m) { float* rp = PA + (size_t)(row0 + ai * HALF + m * 16) * PAW + colt;
#pragma unroll
                    for (int bj = 0; bj < 2; ++bj) { *(f32x4*)(rp + bj * HALF) = acc[ai][bj][m][0]; *(f32x4*)(rp + bj * HALF + 4) = acc[ai][bj][m][1]; } }
        } else {
#pragma unroll
            for (int ai = 0; ai < 2; ++ai)
#pragma unroll
                for (int m = 0; m < 4; ++m) { bf16_t* rp = QKV + (size_t)(row0 + ai * HALF + m * 16) * QKVW + (colt - PAW);
#pragma unroll
                    for (int bj = 0; bj < 2; ++bj) { const f32x4 v0 = acc[ai][bj][m][0], v1 = acc[ai][bj][m][1];
                        u32x4 w; w.x = cvt_pk_bf16(v0[0], v0[1]); w.y = cvt_pk_bf16(v0[2], v0[3]); w.z = cvt_pk_bf16(v1[0], v1[1]); w.w = cvt_pk_bf16(v1[2], v1[3]);
                        *(u32x4*)(rp + bj * HALF) = w; } }
        }
    }
};
struct EpiResidual {
    static constexpr bool PERM = true;
    bf16_t* D;
    __device__ __forceinline__ void operator()(const f32x4 (&acc)[2][2][4][2], const Unit& u, int wr, int wc, int fr, int fq) const {
        const int row0 = u.pm * BM + wr * 64 + fr, colt = u.pn * BM + wc * 32 + 8 * fq;
#pragma unroll
        for (int ai = 0; ai < 2; ++ai)
#pragma unroll
            for (int m = 0; m < 4; ++m) { const int row = row0 + ai * HALF + m * 16; if (row < TOK) { bf16_t* rp = D + (size_t)row * DM + colt;
#pragma unroll
                for (int bj = 0; bj < 2; ++bj) { const f32x4 v0 = acc[ai][bj][m][0], v1 = acc[ai][bj][m][1];
                    u32x4 w; w.x = cvt_pk_bf16(v0[0], v0[1]); w.y = cvt_pk_bf16(v0[2], v0[3]); w.z = cvt_pk_bf16(v1[0], v1[1]); w.w = cvt_pk_bf16(v1[2], v1[3]);
                    *(u32x4*)(rp + bj * HALF) = w; } } }
    }
};
struct OutOrder {
    static constexpr bool PER_UNIT_K = true;
    StaticOrder main;
    __device__ bool next(int i, Unit& u) const {
        if (main.next(i, u)) return true;
        const int r0 = (main.nwg + main.G - 1) / main.G;
        const int L = (i - r0) * main.G + main.c; if (i < r0 || L >= 64) return false;
        u.pm = 32; u.pn = L & 7; u.ko = (L >> 3) * 256; u.nt = 4; return true; }
    __device__ __forceinline__ void a_ready(const Unit&) const {}
    __device__ __forceinline__ void done(const Unit&) const {}
};
struct EpiOutProj {
    static constexpr bool PERM = true;
    float* Z; float* ZP;
    __device__ __forceinline__ void operator()(const f32x4 (&acc)[2][2][4][2], const Unit& u, int wr, int wc, int fr, int fq) const {
        const bool tail = u.pm == 32;
        const int row0 = (tail ? (u.ko >> 8) * BM : u.pm * BM) + wr * 64 + fr, colt = u.pn * BM + wc * 32 + 8 * fq;
        float* base = tail ? ZP : Z;
#pragma unroll
        for (int ai = 0; ai < 2; ++ai)
#pragma unroll
            for (int m = 0; m < 4; ++m) { float* rp = base + (size_t)(row0 + ai * HALF + m * 16) * DM + colt;
#pragma unroll
                for (int bj = 0; bj < 2; ++bj) { f32x4* p0 = (f32x4*)(rp + bj * HALF); f32x4* p1 = (f32x4*)(rp + bj * HALF + 4);
                    f32x4 z0 = {0.f, 0.f, 0.f, 0.f}, z1 = {0.f, 0.f, 0.f, 0.f};
                    if (!tail) { z0 = *p0; z1 = *p1; }
                    *p0 = z0 + acc[ai][bj][m][0]; *p1 = z1 + acc[ai][bj][m][1]; } }
    }
};
struct TailOrder {
    static constexpr bool PER_UNIT_K = false;
    int G, c;
    __device__ bool next(int i, Unit& u) const { const int L = i * G + c; if (L >= 64) return false; u.pm = 32; u.pn = L & 7; u.ko = (L >> 3) * 256; u.nt = 4; return true; }
    __device__ __forceinline__ void a_ready(const Unit&) const {}
    __device__ __forceinline__ void done(const Unit&) const {}
};
struct EpiTailPartial {
    static constexpr bool PERM = true;
    float* ZP;
    __device__ __forceinline__ void operator()(const f32x4 (&acc)[2][2][4][2], const Unit& u, int wr, int wc, int fr, int fq) const {
        const int row0 = (u.ko >> 8) * BM + wr * 64 + fr, colt = u.pn * BM + wc * 32 + 8 * fq;
#pragma unroll
        for (int ai = 0; ai < 2; ++ai)
#pragma unroll
            for (int m = 0; m < 4; ++m) { float* rp = ZP + (size_t)(row0 + ai * HALF + m * 16) * DM + colt;
#pragma unroll
                for (int bj = 0; bj < 2; ++bj) { *(f32x4*)(rp + bj * HALF) = acc[ai][bj][m][0]; *(f32x4*)(rp + bj * HALF + 4) = acc[ai][bj][m][1]; } }
    }
};
struct EpiGlu {
    static constexpr bool PERM = true;
    bf16_t* MIX; const float* bias;
    __device__ __forceinline__ void operator()(const f32x4 (&acc)[2][2][4][2], const Unit& u, int wr, int wc, int fr, int fq) const {
        const int row0 = u.pm * BM + wr * 64 + fr, c0 = u.pn * HALF + wc * 32 + 8 * fq;
        const f32x4 bv0 = *(const f32x4*)(bias + c0), bv1 = *(const f32x4*)(bias + c0 + 4), bg0 = *(const f32x4*)(bias + 512 + c0), bg1 = *(const f32x4*)(bias + 512 + c0 + 4);
        float one = 1.f; asm volatile("" : "+v"(one));
#pragma unroll
        for (int ai = 0; ai < 2; ++ai)
#pragma unroll
            for (int m = 0; m < 4; ++m) { const f32x4 v0 = acc[ai][0][m][0] + bv0, v1 = acc[ai][0][m][1] + bv1, g0 = acc[ai][1][m][0] + bg0, g1 = acc[ai][1][m][1] + bg1;
                float o[8];
#pragma unroll
                for (int e = 0; e < 4; ++e) { o[e] = v0[e] * __builtin_amdgcn_rcpf(one + __expf(-g0[e])); o[4 + e] = v1[e] * __builtin_amdgcn_rcpf(one + __expf(-g1[e])); }
                u32x4 w; w.x = cvt_pk_bf16(o[0], o[1]); w.y = cvt_pk_bf16(o[2], o[3]); w.z = cvt_pk_bf16(o[4], o[5]); w.w = cvt_pk_bf16(o[6], o[7]);
                *(u32x4*)(MIX + (size_t)(row0 + ai * HALF + m * 16) * DM + 512 + c0) = w; }
    }
};
}

__device__ __forceinline__ void transpose_item(const float* W, int K, int N, bf16_t* WT, int k0, int n0, int row0, float* scr, int lane) {
    float tv[32];
#pragma unroll
    for (int i = 0; i < 32; ++i) { const int kk = 2 * i + (lane >> 5); tv[i] = W[(size_t)(k0 + kk) * N + n0 + (lane & 31)]; }
#pragma unroll
    for (int i = 0; i < 32; ++i) { const int kk = 2 * i + (lane >> 5); scr[kk * 33 + (lane & 31)] = tv[i]; }
    asm volatile("s_waitcnt lgkmcnt(0)" ::: "memory");
    const int c = lane & 7;
#pragma unroll
    for (int j = 0; j < 4; ++j) { const int n = (lane >> 3) + 8 * j; const float* sp = scr + (8 * c) * 33 + n;
        pg8::u32x4 o; o.x = pg8::cvt_pk_bf16(sp[0 * 33], sp[1 * 33]); o.y = pg8::cvt_pk_bf16(sp[2 * 33], sp[3 * 33]); o.z = pg8::cvt_pk_bf16(sp[4 * 33], sp[5 * 33]); o.w = pg8::cvt_pk_bf16(sp[6 * 33], sp[7 * 33]);
        *(pg8::u32x4*)(WT + (size_t)(row0 + n) * K + k0 + 8 * c) = o; }
    asm volatile("s_waitcnt lgkmcnt(0)" ::: "memory");
}
__device__ __forceinline__ void ph_weights(KP P, char* lds) {
    const int tid = tid_(), lane = tid & 63, wave = tid >> 6;
    float* scr = (float*)lds + wave * (64 * 33);
    const int cu0 = gridDim.x == 256 ? 64 : 0, gw = (bid_() - cu0) * 8 + wave, NGW = (gridDim.x - cu0) * 8;
    if (gw < 0) return;
    constexpr int I_IN = (DM / 64) * (INW / 32), I_OUT = (DM / 64) * (DM / 32), I_GLU = (512 / 64) * (1024 / 32), I_L = I_IN + I_OUT + I_GLU;
    for (int it = gw; it < 2 * I_L; it += NGW) {
        const int layer = it / I_L; int r = it % I_L;
        if (r < I_IN) { const int nb = INW / 32, kb = r / nb, n0 = (r % nb) * 32;
            transpose_item(P->w_in + (size_t)layer * DM * INW, DM, INW, P->WinT + (size_t)layer * INW * DM, kb * 64, n0, n0, scr, lane); continue; }
        r -= I_IN;
        if (r < I_OUT) { const int nb = DM / 32, kb = r / nb, n0 = (r % nb) * 32;
            transpose_item(P->w_out + (size_t)layer * DM * DM, DM, DM, P->WoutT + (size_t)layer * DM * DM, kb * 64, n0, n0, scr, lane); continue; }
        r -= I_OUT;
        { const int nb = 1024 / 32, kb = r / nb, n0 = (r % nb) * 32;
          const int row0 = ((n0 & 511) >> 7) * 256 + (n0 >> 9) * 128 + (n0 & 127);
          transpose_item(P->w_glu + (size_t)layer * 512 * 1024, 512, 1024, P->WgluT + (size_t)layer * 1024 * 512, kb * 64, n0, row0, scr, lane); }
    }
}


namespace fa {
using bf16x8 = __attribute__((ext_vector_type(8))) short;
using s16x4  = __attribute__((ext_vector_type(4))) short;
using f32x16 = __attribute__((ext_vector_type(16))) float;
using u32x4  = __attribute__((ext_vector_type(4))) unsigned;
constexpr int D = 128, NW = 8, QBLK = 32, KVBLK = 64, LDQK = QKVW;
constexpr float SCALE = 0.088388347648318440f, THR = 8.f, NEG = -1e30f;
constexpr size_t SHM_V = KVBLK * D * 2, SHM_K = KVBLK * D * 2, SHM_ATTN = 2 * SHM_V + 2 * SHM_K + NW * 64 * 4;
#define KSWZ(row, colB) ((row) * 256 + ((colB) ^ (((row) & 7) << 4)))
#define SBAR() __builtin_amdgcn_sched_barrier(0)
__device__ __forceinline__ int crow(int r, int hi) { return (r & 3) + 8 * (r >> 2) + 4 * hi; }
__device__ __forceinline__ unsigned cvtpk(float lo, float hi) { unsigned r; asm volatile("v_cvt_pk_bf16_f32 %0, %1, %2" : "=v"(r) : "v"(lo), "v"(hi)); return r; }
__device__ __forceinline__ void partialSM(f32x16& p0, f32x16& p1, float& m_reg, float& mn, float& alpha) {
  constexpr float C = SCALE * 1.4426950408889634f;
  float pmax = p0[0]; for (int r = 1; r < 16; ++r) pmax = fmaxf(pmax, p0[r]); for (int r = 0; r < 16; ++r) pmax = fmaxf(pmax, p1[r]);
  { auto rr = __builtin_amdgcn_permlane32_swap(__float_as_uint(pmax), __float_as_uint(pmax), false, false);
    pmax = fmaxf(__uint_as_float(rr[0]), __uint_as_float(rr[1])); }
  if (__builtin_expect(__all(pmax - m_reg <= THR / SCALE), 1)) { mn = m_reg; alpha = 1.f; }
  else { mn = fmaxf(m_reg, pmax); alpha = __builtin_amdgcn_exp2f((m_reg - mn) * C); m_reg = mn; }
  float mnC = -mn * C;
  for (int r = 0; r < 16; ++r) p0[r] = fmaf(p0[r], C, mnC); for (int r = 0; r < 16; ++r) p1[r] = fmaf(p1[r], C, mnC);
  for (int r = 0; r < 16; ++r) p0[r] = __builtin_amdgcn_exp2f(p0[r]);
}
__device__ __forceinline__ void finishSM(f32x16& p0, f32x16& p1, float alpha, float& l_reg, bf16x8& pa0, bf16x8& pa1, bf16x8& pa2, bf16x8& pa3) {
  for (int r = 0; r < 16; ++r) p1[r] = __builtin_amdgcn_exp2f(p1[r]);
  float ps = 0; for (int r = 0; r < 16; ++r) ps += p0[r]; for (int r = 0; r < 16; ++r) ps += p1[r];
  { auto rr = __builtin_amdgcn_permlane32_swap(__float_as_uint(ps), __float_as_uint(ps), false, false);
    ps = __uint_as_float(rr[0]) + __uint_as_float(rr[1]); }
  l_reg = l_reg * alpha + ps;
#define PK4(P, BASE, OUT) do { unsigned a0 = cvtpk(P[BASE + 0], P[BASE + 1]), a1 = cvtpk(P[BASE + 2], P[BASE + 3]);   \
    unsigned b0 = cvtpk(P[BASE + 4], P[BASE + 5]), b1 = cvtpk(P[BASE + 6], P[BASE + 7]);                              \
    auto r0 = __builtin_amdgcn_permlane32_swap(a0, b0, false, false); auto r1 = __builtin_amdgcn_permlane32_swap(a1, b1, false, false); \
    u32x4 w = {r0[0], r1[0], r0[1], r1[1]}; OUT = *reinterpret_cast<bf16x8*>(&w); } while (0)
  PK4(p0, 0, pa0); PK4(p0, 8, pa1); PK4(p1, 0, pa2); PK4(p1, 8, pa3);
#undef PK4
}
__device__ __forceinline__ void qkt(f32x16& p0, f32x16& p1, const bf16_t* Ks, const bf16x8* qr, int r32, int hi) {
  p0 = f32x16{}; p1 = f32x16{};
  for (int d0 = 0; d0 < 8; ++d0) { int cb = (d0 * 16 + hi * 8) * 2;
    bf16x8 b0 = *reinterpret_cast<const bf16x8*>((const char*)Ks + KSWZ(r32, cb));
    bf16x8 b1 = *reinterpret_cast<const bf16x8*>((const char*)Ks + KSWZ(32 + r32, cb));
    p0 = __builtin_amdgcn_mfma_f32_32x32x16_bf16(b0, qr[d0], p0, 0, 0, 0);
    p1 = __builtin_amdgcn_mfma_f32_32x32x16_bf16(b1, qr[d0], p1, 0, 0, 0); }
}
__device__ __forceinline__ void mask_tile(f32x16& p0, f32x16& p1, int kt, int vis) {
  if (kt > vis) {
    const bool part = (kt == vis + 1);
    for (int r = 0; r < 16; ++r) p1[r] = NEG;
    for (int r = 8; r < 16; ++r) p0[r] = NEG;
    if (!part) for (int r = 0; r < 8; ++r) p0[r] = NEG;
  }
}
__device__ __forceinline__ int v_st(int k, int c) { const int kk = (k & ~0xC) | ((k & 4) << 1) | ((k & 8) >> 1); return ((kk >> 3) * 4 + (c >> 5)) * 512 + ((kk & 7) * 32 + (c & 31)) * 2; }
__device__ __forceinline__ int v_rd_base(int lane) { return ((lane & 3) << 3) | (((lane >> 2) & 3) << 6) | (((lane >> 4) & 1) << 5) | (((lane >> 5) & 1) << 8); }
constexpr int v_rd_off(int d0, int ks, int half) { return d0 * 512 + ks * 4096 + half * 2048; }
template <int OFF> __device__ __forceinline__ s16x4 tr_read(int vb) {
  s16x4 r; asm volatile("ds_read_b64_tr_b16 %0, %1 offset:%2" : "=&v"(r) : "v"(vb), "i"(OFF) : "memory"); return r;
}
template <int D0> __device__ __forceinline__ void pv_one(f32x16& od, int vb, bf16x8 pa0, bf16x8 pa1, bf16x8 pa2, bf16x8 pa3) {
  const s16x4 l0 = tr_read<v_rd_off(D0, 0, 0)>(vb), h0 = tr_read<v_rd_off(D0, 0, 1)>(vb), l1 = tr_read<v_rd_off(D0, 1, 0)>(vb), h1 = tr_read<v_rd_off(D0, 1, 1)>(vb);
  const s16x4 l2 = tr_read<v_rd_off(D0, 2, 0)>(vb), h2 = tr_read<v_rd_off(D0, 2, 1)>(vb), l3 = tr_read<v_rd_off(D0, 3, 0)>(vb), h3 = tr_read<v_rd_off(D0, 3, 1)>(vb);
  asm volatile("s_waitcnt lgkmcnt(0)" ::: "memory"); SBAR();
#define PK(L, H) (bf16x8){L[0], L[1], L[2], L[3], H[0], H[1], H[2], H[3]}
  od = __builtin_amdgcn_mfma_f32_32x32x16_bf16(pa0, PK(l0, h0), od, 0, 0, 0);
  od = __builtin_amdgcn_mfma_f32_32x32x16_bf16(pa1, PK(l1, h1), od, 0, 0, 0);
  od = __builtin_amdgcn_mfma_f32_32x32x16_bf16(pa2, PK(l2, h2), od, 0, 0, 0);
  od = __builtin_amdgcn_mfma_f32_32x32x16_bf16(pa3, PK(l3, h3), od, 0, 0, 0);
#undef PK
}
__device__ __forceinline__ void pv_d0(f32x16* o, int vb, bf16x8 pa0, bf16x8 pa1, bf16x8 pa2, bf16x8 pa3) {
  pv_one<0>(o[0], vb, pa0, pa1, pa2, pa3); pv_one<1>(o[1], vb, pa0, pa1, pa2, pa3); pv_one<2>(o[2], vb, pa0, pa1, pa2, pa3); pv_one<3>(o[3], vb, pa0, pa1, pa2, pa3);
}
__device__ __forceinline__ void attn_unit(const bf16_t* __restrict__ Qb, const bf16_t* __restrict__ Kh, const bf16_t* __restrict__ Vh, float* __restrict__ Ob, int NT, int vis4, char* lds) {
  const int tid = tid_(), wid = tid >> 6, lane = tid & 63, r32 = lane & 31, hi = lane >> 5;
  const int vis = vis4 + (wid >> 1);
  bf16_t* V_lds = (bf16_t*)lds; bf16_t* K_lds = (bf16_t*)(lds + 2 * SHM_V);
  float* ws = (float*)(lds + 2 * SHM_V + 2 * SHM_K) + wid * 64; float* li_l = ws; float* al_l = ws + 32;
  float m_reg = NEG, l_reg = 0; f32x16 o[4] = {}; bf16x8 qr[8];
  const bf16_t* Qw = Qb + (long)(wid * QBLK + r32) * LDQK + hi * 8;
#pragma unroll
  for (int d0 = 0; d0 < 8; ++d0) qr[d0] = *reinterpret_cast<const bf16x8*>(Qw + d0 * 16);
  const int sr = tid >> 4, sc = (tid & 15) * 8, vst0 = v_st(sr, sc), vst1 = v_st(32 + sr, sc);
  const int vb0 = (int)(uintptr_t)V_lds + v_rd_base(lane);
  struct { bf16x8 vs0, vs1, ks0, ks1; } sr_[2];
#define SLOAD(i, k0) do { sr_[i].vs0 = *reinterpret_cast<const bf16x8*>(&Vh[(long)((k0) + sr) * LDQK + sc]); sr_[i].vs1 = *reinterpret_cast<const bf16x8*>(&Vh[(long)((k0) + 32 + sr) * LDQK + sc]); \
    sr_[i].ks0 = *reinterpret_cast<const bf16x8*>(&Kh[(long)((k0) + sr) * LDQK + sc]); sr_[i].ks1 = *reinterpret_cast<const bf16x8*>(&Kh[(long)((k0) + 32 + sr) * LDQK + sc]); } while (0)
#define SWRITE(b, i) do { *(bf16x8*)((char*)V_lds + (b) * SHM_V + vst0) = sr_[i].vs0;          \
    *(bf16x8*)((char*)V_lds + (b) * SHM_V + vst1) = sr_[i].vs1; int kc = sc * 2;               \
    *(bf16x8*)((char*)K_lds + (b) * SHM_K + KSWZ(sr, kc)) = sr_[i].ks0;                       \
    *(bf16x8*)((char*)K_lds + (b) * SHM_K + KSWZ(32 + sr, kc)) = sr_[i].ks1; } while (0)
#define SWAIT() asm volatile("s_waitcnt vmcnt(4)" ::: "memory")
#define RESC(a) do { if (__any((a) < 1.f)) { if (hi == 0) al_l[r32] = (a); asm volatile("s_waitcnt lgkmcnt(0)" ::: "memory"); \
    for (int d = 0; d < 4; ++d) for (int r = 0; r < 16; ++r) o[d][r] *= al_l[crow(r, hi)]; } } while (0)
  f32x16 pA0, pA1, pB0, pB1; float mnA, mnB, alA, alB; bf16x8 pa0, pa1, pa2, pa3;
  constexpr int SE = 0, SO = 1;
  SLOAD(SE, 0); asm volatile("s_waitcnt vmcnt(0)" ::: "memory"); SWRITE(0, SE); __syncthreads();
  qkt(pA0, pA1, K_lds, qr, r32, hi); mask_tile(pA0, pA1, 0, vis); partialSM(pA0, pA1, m_reg, mnA, alA);
  SLOAD(SO, KVBLK); if (2 < NT) SLOAD(SE, 2 * KVBLK);
  SWAIT(); SWRITE(1, SO); __syncthreads();
  for (int j = 1; j + 1 < NT; j += 2) {
    SBAR(); qkt(pB0, pB1, (bf16_t*)((char*)K_lds + SHM_K), qr, r32, hi); mask_tile(pB0, pB1, j, vis);
    finishSM(pA0, pA1, alA, l_reg, pa0, pa1, pa2, pa3); SBAR();
    SLOAD(SO, (j + 2) * KVBLK); SBAR();
    pv_d0(o, vb0, pa0, pa1, pa2, pa3); partialSM(pB0, pB1, m_reg, mnB, alB);
    __syncthreads(); SWAIT(); SWRITE(0, SE);
    RESC(alB); __syncthreads();
    SBAR(); qkt(pA0, pA1, K_lds, qr, r32, hi); mask_tile(pA0, pA1, j + 1, vis);
    finishSM(pB0, pB1, alB, l_reg, pa0, pa1, pa2, pa3); SBAR();
    if (j + 3 < NT) SLOAD(SE, (j + 3) * KVBLK); SBAR();
    pv_d0(o, vb0 + (int)SHM_V, pa0, pa1, pa2, pa3); partialSM(pA0, pA1, m_reg, mnA, alA);
    __syncthreads(); SWAIT(); SWRITE(1, SO);
    RESC(alA); __syncthreads();
  }
  SBAR(); qkt(pB0, pB1, (bf16_t*)((char*)K_lds + SHM_K), qr, r32, hi); mask_tile(pB0, pB1, NT - 1, vis);
  finishSM(pA0, pA1, alA, l_reg, pa0, pa1, pa2, pa3); SBAR();
  pv_d0(o, vb0, pa0, pa1, pa2, pa3); partialSM(pB0, pB1, m_reg, mnB, alB);
  __syncthreads(); RESC(alB);
  finishSM(pB0, pB1, alB, l_reg, pa0, pa1, pa2, pa3); SBAR();
  pv_d0(o, vb0 + (int)SHM_V, pa0, pa1, pa2, pa3);
  if (hi == 0) li_l[r32] = l_reg; asm volatile("s_waitcnt lgkmcnt(0)" ::: "memory");
  float rli[16];
#pragma unroll
  for (int r = 0; r < 16; ++r) rli[r] = __builtin_amdgcn_rcpf(li_l[crow(r, hi)]);
  float* Ow = Ob + (long)(wid * QBLK) * DM;
#pragma unroll
  for (int r = 0; r < 16; ++r) { int orow = crow(r, hi);
    for (int d0 = 0; d0 < 4; ++d0) Ow[(long)orow * DM + d0 * 32 + r32] = o[d0][r] * rli[r]; }
  __syncthreads();
#undef SLOAD
#undef SWRITE
#undef SWAIT
#undef RESC
}
#undef KSWZ
#undef SBAR
}

__device__ __forceinline__ void ph_attention(KP P, char* lds) {
    const bf16_t* QKV = P->QKV; float* OC = P->OC;
#pragma unroll 1
    for (int c = bid_(); c < 256; c += gridDim.x) {
        const int combo = c >> 2, b = combo >> 4, h = (combo >> 2) & 3, i = (combo >> 1) & 1, vh = combo & 1;
        const bf16_t* Kh = QKV + (size_t)(b * LL) * QKVW + 1024 + h * 256 + i * 128;
        const bf16_t* Vh = QKV + (size_t)(b * LL) * QKVW + 2048 + h * 256 + vh * 128;
#pragma unroll 1
        for (int s = 0; s < 2; ++s) {
            const int jb = s == 0 ? (c & 3) : 7 - (c & 3);
            const size_t row0 = (size_t)(b * LL) + NMETA + 256 * jb;
            fa::attn_unit(QKV + row0 * QKVW + h * 256 + i * 128, Kh, Vh, OC + row0 * DM + h * 512 + i * 256 + vh * 128, 4 * jb + 6, 4 * jb, lds);
        }
    }
#pragma unroll 1
    for (int gw0 = bid_() * 8; gw0 < 512; gw0 += gridDim.x * 8) {
        const int tid = tid_(), lane = tid & 63, gw = gw0 + (tid >> 6);
        if (gw < 512) {
            const int b = gw >> 7, h = (gw >> 5) & 3, i = (gw >> 4) & 1, row = gw & 15;
            const bf16_t* q = QKV + (size_t)(b * LL + row) * QKVW + h * 256 + i * 128;
            const int key = lane & 15;
            const bf16_t* k = QKV + (size_t)(b * LL + key) * QKVW + 1024 + h * 256 + i * 128;
            float sc = 0.f;
            { pg8::u32x4 qv[16], kv[16];
#pragma unroll
              for (int c8 = 0; c8 < 16; ++c8) { qv[c8] = *(const pg8::u32x4*)(q + c8 * 8); kv[c8] = *(const pg8::u32x4*)(k + c8 * 8); }
#pragma unroll
              for (int c8 = 0; c8 < 16; ++c8)
#pragma unroll
                  for (int w2 = 0; w2 < 4; ++w2) { const unsigned a = qv[c8][w2], bq = kv[c8][w2];
                      sc = fmaf(__uint_as_float(a << 16), __uint_as_float(bq << 16), sc); sc = fmaf(__uint_as_float(a & 0xffff0000u), __uint_as_float(bq & 0xffff0000u), sc); } }
            sc *= 0.08838834764831845f;
            float m = sc;
            m = fmaxf(m, swz_xor<8>(m)); m = fmaxf(m, swz_xor<4>(m)); m = fmaxf(m, swz_xor<2>(m)); m = fmaxf(m, swz_xor<1>(m));
            const float e = expf(sc - m);
            float ssum = e;
            ssum += swz_xor<8>(ssum); ssum += swz_xor<4>(ssum); ssum += swz_xor<2>(ssum); ssum += swz_xor<1>(ssum);
            const float p = e / ssum;
            float acc[4] = {0.f, 0.f, 0.f, 0.f};
#pragma unroll
            for (int j = 0; j < 16; ++j) {
                const float pj = __int_as_float(__builtin_amdgcn_readlane(__float_as_int(p), j));
                const uint2 v2 = *(const uint2*)(QKV + (size_t)(b * LL + j) * QKVW + 2048 + h * 256 + lane * 4);
                acc[0] = fmaf(pj, __uint_as_float(v2.x << 16), acc[0]); acc[1] = fmaf(pj, __uint_as_float(v2.x & 0xffff0000u), acc[1]);
                acc[2] = fmaf(pj, __uint_as_float(v2.y << 16), acc[2]); acc[3] = fmaf(pj, __uint_as_float(v2.y & 0xffff0000u), acc[3]);
            }
            float* o = OC + (size_t)(b * LL + row) * DM + h * 512 + i * 256 + lane * 4;
            *(float4*)o = make_float4(acc[0], acc[1], acc[2], acc[3]);
        }
    }
}


namespace hg {
using bf16x8 = __attribute__((ext_vector_type(8))) short;
using s16x4  = __attribute__((ext_vector_type(4))) short;
using f32x16 = __attribute__((ext_vector_type(16))) float;
using u32x4  = __attribute__((ext_vector_type(4))) unsigned;
constexpr int NCH = 33, NU = 16 * NCH;
constexpr int SK = 136;
constexpr int SS = 72;
__device__ __forceinline__ int crow(int r, int hi) { return (r & 3) + 8 * (r >> 2) + 4 * hi; }
__device__ __forceinline__ unsigned cvtpk(float lo, float hi) { unsigned r; asm volatile("v_cvt_pk_bf16_f32 %0, %1, %2" : "=v"(r) : "v"(lo), "v"(hi)); return r; }

__device__ __forceinline__ void prep(const float (&fpv)[16], float lbv, int c, int k, int tq, float* qsum, float (&b)[16], float (&kk)[16], float& bend, float& r) {
    float run = 0.f;
#pragma unroll
    for (int i = 0; i < 16; ++i) {
        const int t = 16 * tq + i; const bool valid = (c * 64 + t) < LL;
        const float kv = valid ? (1.f - lbv) * __builtin_amdgcn_rcpf(1.f + __expf(fpv[i])) : 0.f;
        kk[i] = kv; run += fmaxf(__logf(1.f - kv), -30.f); b[i] = run;
    }
    qsum[tq * 128 + k] = run;
    __syncthreads();
    const float q0 = qsum[k], q1 = qsum[128 + k], q2 = qsum[256 + k], q3 = qsum[384 + k];
    const float off = tq == 0 ? 0.f : (tq == 1 ? q0 : (tq == 2 ? q0 + q1 : q0 + q1 + q2));
    r = q0 + q1; bend = (q0 + q1) + (q2 + q3);
#pragma unroll
    for (int i = 0; i < 16; ++i) b[i] += off;
}
__device__ __forceinline__ void store16(bf16_t* dst, const float (&x)[16]) {
    u32x4 w0, w1;
    w0.x = cvtpk(x[0], x[1]); w0.y = cvtpk(x[2], x[3]); w0.z = cvtpk(x[4], x[5]); w0.w = cvtpk(x[6], x[7]);
    w1.x = cvtpk(x[8], x[9]); w1.y = cvtpk(x[10], x[11]); w1.z = cvtpk(x[12], x[13]); w1.w = cvtpk(x[14], x[15]);
    *(u32x4*)dst = w0; *(u32x4*)(dst + 8) = w1;
}

__device__ __forceinline__ void local_states(KP P, char* lds, int layer) {
    bf16_t* KhT = (bf16_t*)lds; bf16_t* VT = KhT + 128 * SS; float* qsum = (float*)(VT + 128 * SS);
    const float* PA = P->PA; const float* lbtab = P->lbtab + layer * 512; float* SLOC = P->SLOC; float* DEC = P->DEC;
    const int tid = tid_(), k = tid & 127, tq = tid >> 7, lane = tid & 63, wid = tid >> 6, r32 = lane & 31, hh = lane >> 5;
    for (int u = bid_(); u < NU; u += gridDim.x) {
        const int bh = u / NCH, c = u % NCH, b_ = bh >> 2, h = bh & 3; const size_t row0 = (size_t)b_ * LL + c * 64;
        float fpv[16], vv[16];
#pragma unroll
        for (int i = 0; i < 16; ++i) { const int t = 16 * tq + i; const bool valid = (c * 64 + t) < LL; const float* rp = PA + (row0 + (valid ? t : 0)) * PAW + h * 128 + k;
            fpv[i] = rp[512]; vv[i] = valid ? rp[1024] : 0.f; }
        float b[16], kk[16], bend, r;
        prep(fpv, lbtab[h * 128 + k], c, k, tq, qsum, b, kk, bend, r);
        float x[16];
#pragma unroll
        for (int i = 0; i < 16; ++i) x[i] = kk[i] * __expf(bend - b[i]);
        store16(KhT + k * SS + 16 * tq, x);
        store16(VT + k * SS + 16 * tq, vv);
        if (tq == 0) DEC[u * 128 + k] = __expf(bend);
        __syncthreads();
        const int vt = wid >> 1;
#pragma unroll
        for (int j = 0; j < 2; ++j) {
            const int kt = (wid & 1) * 2 + j;
            f32x16 acc = {};
#pragma unroll
            for (int sg = 0; sg < 4; ++sg) {
                const bf16x8 a = *(const bf16x8*)(VT + (vt * 32 + r32) * SS + sg * 16 + hh * 8);
                const bf16x8 bb = *(const bf16x8*)(KhT + (kt * 32 + r32) * SS + sg * 16 + hh * 8);
                acc = __builtin_amdgcn_mfma_f32_32x32x16_bf16(a, bb, acc, 0, 0, 0);
            }
            float* o = SLOC + (size_t)u * 16384 + kt * 32 + r32;
#pragma unroll
            for (int rg = 0; rg < 16; ++rg) o[(vt * 32 + crow(rg, hh)) * 128] = acc[rg];
        }
        __syncthreads();
    }
}
__device__ __forceinline__ void scan_states(KP P) {
    const float* SLOC = P->SLOC; const float* DEC = P->DEC; bf16_t* SPREV = P->SPREV;
    const int tid = tid_();
    for (int e = bid_() * NTHR + tid; e < 16 * 16384; e += gridDim.x * NTHR) {
        const int bh = e >> 14, vk = e & 16383, k = vk & 127;
        float d[NCH - 1], x[NCH - 1];
#pragma unroll
        for (int c = 0; c < NCH - 1; ++c) { const int u = bh * NCH + c; d[c] = DEC[u * 128 + k]; x[c] = SLOC[(size_t)u * 16384 + vk]; }
        float S = 0.f;
#pragma unroll
        for (int c = 0; c < NCH - 1; ++c) { S = fmaf(d[c], S, x[c]); SPREV[(size_t)(bh * NCH + c + 1) * 16384 + vk] = f2bf(S); }
    }
}
__device__ __forceinline__ void outputs(KP P, char* lds, int layer) {
    bf16_t* Qt = (bf16_t*)lds; bf16_t* Qh = Qt + 64 * SK; bf16_t* Kt = Qh + 64 * SK; bf16_t* VT = Kt + 64 * SK; bf16_t* SpT = VT + 128 * SS;
    float* qsum = (float*)(SpT + 128 * SK); float* part = qsum + 512;
    const float* PA = P->PA; const float* lbtab = P->lbtab + layer * 512; const bf16_t* SPREV = P->SPREV; const float* nw = P->hnw + layer * 128; bf16_t* MIX = P->MIX;
    const int tid = tid_(), k = tid & 127, tq = tid >> 7, lane = tid & 63, wid = tid >> 6, r32 = lane & 31, hh = lane >> 5;
    for (int u = bid_(); u < NU; u += gridDim.x) {
        const int bh = u / NCH, c = u % NCH, b_ = bh >> 2, h = bh & 3; const size_t row0 = (size_t)b_ * LL + c * 64;
        const int tt = wid & 1, vt = wid >> 1;
        float fpv[16], qv[16], vv[16]; u32x4 sp[4]; float4 gv[4];
#pragma unroll
        for (int i = 0; i < 16; ++i) { const int t = 16 * tq + i; const bool valid = (c * 64 + t) < LL; const float* rp = PA + (row0 + (valid ? t : 0)) * PAW + h * 128 + k;
            fpv[i] = rp[512]; qv[i] = valid ? rp[0] : 0.f; vv[i] = valid ? rp[1024] : 0.f; }
#pragma unroll
        for (int j = 0; j < 4; ++j) { const int idx = tid + 512 * j, v = idx >> 4, ch = idx & 15; sp[j] = *(const u32x4*)(SPREV + (size_t)(c > 0 ? u : u + 1) * 16384 + v * 128 + ch * 8); }
        { const int te = tt * 32 + r32; const float* gp = PA + (row0 + ((c * 64 + te) < LL ? te : 0)) * PAW + 1536 + h * 128 + vt * 32 + 4 * hh;
#pragma unroll
          for (int g4 = 0; g4 < 4; ++g4) gv[g4] = *(const float4*)(gp + 8 * g4); }
        float b[16], kk[16], bend, r;
        prep(fpv, lbtab[h * 128 + k], c, k, tq, qsum, b, kk, bend, r);
#pragma unroll
        for (int i = 0; i < 16; ++i) { const int t = 16 * tq + i; const float q = qv[i];
            Qt[t * SK + k] = f2bf(q * __expf(b[i] - r)); Qh[t * SK + k] = f2bf(q * __expf(b[i])); Kt[t * SK + k] = f2bf(kk[i] * __expf(r - b[i])); }
        store16(VT + k * SS + 16 * tq, vv);
        if (c > 0) {
#pragma unroll
            for (int j = 0; j < 4; ++j) { const int idx = tid + 512 * j, v = idx >> 4, ch = idx & 15; *(u32x4*)(SpT + v * SK + ch * 8) = sp[j]; }
        }
        __syncthreads();
        f32x16 oacc = {};
#pragma unroll
        for (int st = 0; st < 2; ++st) {
            if (st <= tt) {
                f32x16 sc = {};
#pragma unroll
                for (int d0 = 0; d0 < 8; ++d0) {
                    const bf16x8 a = *(const bf16x8*)(Kt + (st * 32 + r32) * SK + d0 * 16 + hh * 8);
                    const bf16x8 bq = *(const bf16x8*)(Qt + (tt * 32 + r32) * SK + d0 * 16 + hh * 8);
                    sc = __builtin_amdgcn_mfma_f32_32x32x16_bf16(a, bq, sc, 0, 0, 0);
                }
                if (st == tt) {
#pragma unroll
                    for (int rg = 0; rg < 16; ++rg) sc[rg] = (crow(rg, hh) <= r32) ? sc[rg] : 0.f;
                }
#pragma unroll
                for (int g = 0; g < 2; ++g) {
                    u32x4 w; w.x = cvtpk(sc[8 * g + 0], sc[8 * g + 1]); w.y = cvtpk(sc[8 * g + 2], sc[8 * g + 3]); w.z = cvtpk(sc[8 * g + 4], sc[8 * g + 5]); w.w = cvtpk(sc[8 * g + 6], sc[8 * g + 7]);
                    const bf16x8 pb = *reinterpret_cast<bf16x8*>(&w);
                    const bf16_t* vp = VT + (vt * 32 + r32) * SS + st * 32 + 16 * g + 4 * hh;
                    const s16x4 lo = *(const s16x4*)vp, hi4 = *(const s16x4*)(vp + 8);
                    const bf16x8 a = (bf16x8){lo[0], lo[1], lo[2], lo[3], hi4[0], hi4[1], hi4[2], hi4[3]};
                    oacc = __builtin_amdgcn_mfma_f32_32x32x16_bf16(a, pb, oacc, 0, 0, 0);
                }
            }
        }
        if (c > 0) {
#pragma unroll
            for (int d0 = 0; d0 < 8; ++d0) {
                const bf16x8 a = *(const bf16x8*)(SpT + (vt * 32 + r32) * SK + d0 * 16 + hh * 8);
                const bf16x8 bq = *(const bf16x8*)(Qh + (tt * 32 + r32) * SK + d0 * 16 + hh * 8);
                oacc = __builtin_amdgcn_mfma_f32_32x32x16_bf16(a, bq, oacc, 0, 0, 0);
            }
        }
        float ss = 0.f;
#pragma unroll
        for (int rg = 0; rg < 16; ++rg) ss = fmaf(oacc[rg], oacc[rg], ss);
        { auto rr = __builtin_amdgcn_permlane32_swap(__float_as_uint(ss), __float_as_uint(ss), false, false); ss = __uint_as_float(rr[0]) + __uint_as_float(rr[1]); }
        if (hh == 0) part[vt * 64 + tt * 32 + r32] = ss;
        __syncthreads();
        const int t = tt * 32 + r32;
        const float tot = (part[t] + part[64 + t]) + (part[128 + t] + part[192 + t]);
        const float scale = rsqrtf(tot * (1.f / 128.f) + EPS);
        if ((c * 64 + t) < LL) {
            bf16_t* op = MIX + (row0 + t) * DM + h * 128 + vt * 32;
#pragma unroll
            for (int g4 = 0; g4 < 4; ++g4) {
                const int v0 = 8 * g4 + 4 * hh;
                const float4 gg = gv[g4]; const float4 wv = *(const float4*)(nw + vt * 32 + v0);
                const float y0 = oacc[4 * g4 + 0] * scale * wv.x * gg.x / (1.f + __expf(-gg.x)), y1 = oacc[4 * g4 + 1] * scale * wv.y * gg.y / (1.f + __expf(-gg.y));
                const float y2 = oacc[4 * g4 + 2] * scale * wv.z * gg.z / (1.f + __expf(-gg.z)), y3 = oacc[4 * g4 + 3] * scale * wv.w * gg.w / (1.f + __expf(-gg.w));
                uint2 w; w.x = cvtpk(y0, y1); w.y = cvtpk(y2, y3);
                *(uint2*)(op + v0) = w;
            }
        }
        __syncthreads();
    }
}
}


namespace moe {
using bf16x8 = __attribute__((ext_vector_type(8))) short;
using f32x16 = __attribute__((ext_vector_type(16))) float;
using u32x4  = __attribute__((ext_vector_type(4))) unsigned;
using f32x4_ = __attribute__((ext_vector_type(4))) float;
constexpr int TW = 5, PROWS = 64 * TW, XS = 128, XBUF = PROWS * XS;
__device__ __forceinline__ unsigned cvtpk(float lo, float hi) { unsigned r; asm volatile("v_cvt_pk_bf16_f32 %0, %1, %2" : "=v"(r) : "v"(lo), "v"(hi)); return r; }
#define MOE_BAR() asm volatile("s_waitcnt lgkmcnt(0)\n\ts_barrier" ::: "memory")
constexpr int WD = 2;
constexpr int ABUF = 4 * 4 * 1024, AOFF = 3 * XBUF, LOFF = AOFF + 2 * ABUF;
template <bool UP>
__device__ __forceinline__ void stream_gemm(KP P, char* lds, int layer) {
    constexpr int KTOT = UP ? DM : DE, NSLAB = KTOT / 64, NCP = UP ? 2 : 4, LDW = UP ? DE : DM, CPSTRIDE = UP ? 64 : 128;
    static_assert(NSLAB % WD == 0 && NSLAB >= 2 * WD && WD == 2, "slab loop is unrolled by WD");
    constexpr int NW = UP ? 4 : 16;
    const int tid = tid_(), lane = tid & 63, wid = tid >> 6, r32 = lane & 31, hh = lane >> 5, cg = wid & 3, th = wid >> 2;
    const int* cnt_ = P->cnt;
    const bf16_t* X = UP ? P->HN : P->H;
    int* basel = (int*)(lds + LOFF); int* tlist = basel + 64; float* rsl = (float*)(basel + 64 + 320 + 64);
    for (int ub = bid_(); ub < 256; ub += gridDim.x) {
        const int u = ((ub & 7) << 5) | (ub >> 3);
        const int e = u >> 2, ns = u & 3;
        const int rot = ((u >> 2) * 11) & (NSLAB - 1);
        __syncthreads();
        if (tid < 64) basel[64 + 320 + tid] = cnt_[tid * CSTR];
        __syncthreads();
        if (tid < 64) { int a = 0; for (int q = 0; q < tid; ++q) a += basel[64 + 320 + q]; basel[tid] = a; }
        __syncthreads();
        const int cnt = cnt_[e * CSTR], row0 = basel[e];
        for (int pass0 = 0; pass0 < cnt; pass0 += PROWS) {
            const int cntp = (cnt - pass0) < PROWS ? (cnt - pass0) : PROWS;
            if constexpr (UP) { if (cnt <= ECAP) {
                __syncthreads();
                if (tid < PROWS && pass0 + tid < cnt) { tlist[tid] = P->elist[e * ECAP + pass0 + tid]; rsl[tid] = P->ers[e * ECAP + pass0 + tid]; }
                __syncthreads();
              } else {
                __syncthreads();
                const int* ridx = P->ridx; const int* rslot = P->rslot;
#pragma unroll 1
                for (int i0 = tid; i0 < NASSIGN; i0 += NTHR * 8) {
                    int ex[8], sl[8];
#pragma unroll
                    for (int q = 0; q < 8; ++q) { const int i = i0 + NTHR * q; ex[q] = i < NASSIGN ? ridx[i] : -1; sl[q] = i < NASSIGN ? rslot[i] : 0; }
#pragma unroll
                    for (int q = 0; q < 8; ++q) { const int sp = sl[q] - pass0; if (ex[q] == e && sp >= 0 && sp < PROWS) { tlist[sp] = (i0 + NTHR * q) >> 1; rsl[sp] = P->rsn[(i0 + NTHR * q) >> 1]; } }
                }
                __syncthreads();
            } }
            int xoff[5];
#pragma unroll
            for (int j = 0; j < 5; ++j) { int rho = (tid >> 3) + 64 * j; rho = rho < cntp ? rho : cntp - 1; const int grow = row0 + pass0 + rho;
                xoff[j] = (UP ? tlist[rho] * DM : grow * DE) + ((tid & 7) ^ ((tid >> 4) & 7)) * 8; }
            const int xdma = __builtin_amdgcn_readfirstlane(wid) * 8 * XS;
            int xrd[4];
#pragma unroll
            for (int kk = 0; kk < 4; ++kk) xrd[kk] = (th * TW * 32 + r32) * XS + (((2 * kk + hh) ^ ((r32 >> 1) & 7)) << 4);
            const unsigned ldsb = (unsigned)(size_t)(LAS char*)lds;
            int xb0 = 0, xb1 = XBUF, xb2 = 2 * XBUF;
            char* const aw = lds + AOFF + (cg * 4 + 2 * th) * 1024 + lane * 16;
            const char* const ar = lds + AOFF + cg * 4 * 1024 + lane * 16;
            float wreg[WD][16];
#pragma unroll 1
            for (int cp = 0; cp < NCP; ++cp) {
                const int cgi = cp * 4 + cg;
                const int kkw = wid >> 1, half = wid & 1;
                const float* wp;
                if constexpr (UP) wp = (r32 < 16 ? P->w1 : P->w3) + ((size_t)(layer * NE + e) * DM + kkw * 16 + 8 * hh + 4 * half) * DE + ns * 128 + cp * 64 + 4 * (r32 & 15);
                else wp = P->w2 + ((size_t)(layer * NE + e) * DE + 32 * hh + 2 * th) * DM + ns * 512 + cgi * 32 + r32;
                f32x16 acc[TW];
#pragma unroll
                for (int tl = 0; tl < TW; ++tl) acc[tl] = f32x16{};
#define MOE_WLD1(wn_, R, li) do { if constexpr (UP) { if ((li) < 4) { f32x4_ t_; asm volatile("global_load_dwordx4 %0, %1, off" : "=v"(t_) : "v"((wn_) + (size_t)(li) * DE)); wreg[R][4 * (li)] = t_[0]; wreg[R][4 * (li) + 1] = t_[1]; wreg[R][4 * (li) + 2] = t_[2]; wreg[R][4 * (li) + 3] = t_[3]; } } \
                    else { if ((li) < 16) asm volatile("global_load_dword %0, %1, off" : "=v"(wreg[R][li]) : "v"((wn_) + (size_t)(((li) >> 3) + 4 * ((li) & 7)) * DM)); } } while (0)
#define MOE_WLOAD(slab, R) do { const float* wn_ = wp + (size_t)(((slab) + rot) & (NSLAB - 1)) * 64 * LDW; \
                    _Pragma("unroll") for (int li = 0; li < 16; ++li) MOE_WLD1(wn_, R, li); } while (0)
#define MOE_WPARK(R, PAR) do { if constexpr (UP) { _Pragma("unroll") for (int q = 0; q < 4; ++q) { uint2 fw; fw.x = cvtpk(wreg[R][q], wreg[R][4 + q]); fw.y = cvtpk(wreg[R][8 + q], wreg[R][12 + q]); \
                            *(uint2*)(lds + AOFF + (PAR) * ABUF + (q * 4 + kkw) * 1024 + lane * 16 + half * 8) = fw; } } \
                    else { _Pragma("unroll") for (int i = 0; i < 2; ++i) { u32x4 fw; fw.x = cvtpk(wreg[R][8 * i + 0], wreg[R][8 * i + 1]); fw.y = cvtpk(wreg[R][8 * i + 2], wreg[R][8 * i + 3]); \
                            fw.z = cvtpk(wreg[R][8 * i + 4], wreg[R][8 * i + 5]); fw.w = cvtpk(wreg[R][8 * i + 6], wreg[R][8 * i + 7]); *(u32x4*)(aw + (PAR) * ABUF + i * 1024) = fw; } } } while (0)
#define MOE_XDMA(slab, bo) do { const bf16_t* xn0_ = X + ((((slab) & (NSLAB - 1)) + rot) & (NSLAB - 1)) * 64; \
                    _Pragma("unroll") for (int j = 0; j < TW; ++j) { const unsigned la_ = ldsb + (unsigned)((bo) + xdma + 64 * j * XS); const bf16_t* gp_ = xn0_ + xoff[j]; \
                        asm volatile("s_mov_b32 m0, %1\n\ts_nop 0\n\tglobal_load_lds_dwordx4 %0, off" :: "v"(gp_), "s"(la_) : "memory", "m0"); } } while (0)
                if (cp == 0) {
                    xb0 = 0; xb1 = XBUF; xb2 = 2 * XBUF;
                    MOE_XDMA(0, xb0); MOE_XDMA(1, xb1);
                    MOE_WLOAD(0, 0); MOE_WLOAD(1, 1);
                    asm volatile("s_waitcnt vmcnt(%0)" :: "n"(NW) : "memory");
                    MOE_WPARK(0, 0); MOE_WLOAD(2, 0);
                    asm volatile("s_waitcnt vmcnt(%0)" :: "n"(NW) : "memory");
                    MOE_BAR();
                }
#define MOE_SLAB(s, PAR, R1) do { \
                    const int swr = (s) + 1 + WD; const bool wnext = swr >= NSLAB && cp + 1 < NCP;     \
                    const int sw = swr < NSLAB ? swr : (wnext ? swr - NSLAB : NSLAB - 1); \
                    asm volatile("s_waitcnt vmcnt(%0)" :: "n"(TW + NW) : "memory");                     \
                    MOE_WPARK(R1, 1 - (PAR)); \
                    MOE_XDMA((s) + 2, xb2);                                                           \
                    const float* wn_ = wp + (wnext ? CPSTRIDE : 0) + (size_t)((sw + rot) & (NSLAB - 1)) * 64 * LDW; \
                    const char* xk0 = lds + xb0 + xrd[0]; const char* xk1 = lds + xb0 + xrd[1]; const char* xk2 = lds + xb0 + xrd[2]; const char* xk3 = lds + xb0 + xrd[3]; \
                    bf16x8 xq[4]; bf16x8 fq[2];                                                       \
                    xq[0] = *(const bf16x8*)(xk0); xq[1] = *(const bf16x8*)(xk0 + 32 * XS); xq[2] = *(const bf16x8*)(xk0 + 64 * XS); \
                    fq[0] = *(const bf16x8*)(ar + (PAR) * ABUF); \
                    _Pragma("unroll") for (int kk = 0; kk < 4; ++kk) { \
                        if (kk < 3) fq[(kk + 1) & 1] = *(const bf16x8*)(ar + (PAR) * ABUF + (kk + 1) * 1024); \
                        _Pragma("unroll") for (int tl = 0; tl < TW; ++tl) { \
                            const int cur = kk * TW + tl, nx = cur + 3, nkk = nx / TW, ntl = nx % TW;       \
                            if (nx < 4 * TW) xq[nx & 3] = *(const bf16x8*)((nkk == 0 ? xk0 : nkk == 1 ? xk1 : nkk == 2 ? xk2 : xk3) + ntl * 32 * XS); \
                            acc[tl] = __builtin_amdgcn_mfma_f32_32x32x16_bf16(fq[kk & 1], xq[cur & 3], acc[tl], 0, 0, 0); \
                            const int li = kk * TW + tl; \
                            MOE_WLD1(wn_, R1, li); \
                            __builtin_amdgcn_sched_barrier(0); } } \
                    asm volatile("s_waitcnt vmcnt(%0)" :: "n"(2 * NW + TW) : "memory");     \
                    MOE_BAR(); \
                    { const int t_ = xb0; xb0 = xb1; xb1 = xb2; xb2 = t_; } } while (0)
#pragma unroll 1
                for (int s = 0; s < NSLAB; s += 2) { MOE_SLAB(s, 0, 1); MOE_SLAB(s + 1, 1, 0); }
#undef MOE_SLAB
#undef MOE_WLOAD
#undef MOE_WLD1
#undef MOE_WPARK
#undef MOE_XDMA
                const int T = (cntp + 31) >> 5;
                const int Tw = (T - TW * th) < 0 ? 0 : ((T - TW * th) > TW ? TW : (T - TW * th));
#pragma unroll
                for (int tl = 0; tl < TW; ++tl) if (tl < Tw) {
                    const int rho = (th * TW + tl) * 32 + r32;
                    if (rho < cntp) {
                        const size_t grow = (size_t)(row0 + pass0 + rho);
                        if constexpr (UP) {
                            bf16_t* hp = P->H + grow * DE + ns * 128 + cgi * 16 + 4 * hh; const float rs = rsl[rho];
#pragma unroll
                            for (int g = 0; g < 2; ++g) {
                                float y[4];
#pragma unroll
                                for (int q = 0; q < 4; ++q) { const float a = acc[tl][4 * g + q] * rs, b = acc[tl][8 + 4 * g + q] * rs; y[q] = a / (1.f + __expf(-a)) * b; }
                                uint2 w; w.x = cvtpk(y[0], y[1]); w.y = cvtpk(y[2], y[3]);
                                *(uint2*)(hp + 8 * g) = w;
                            }
                        } else {
                            bf16_t* yp = P->Y + grow * DM + ns * 512 + cgi * 32 + 4 * hh;
#pragma unroll
                            for (int g = 0; g < 4; ++g) {
                                uint2 w; w.x = cvtpk(acc[tl][4 * g + 0], acc[tl][4 * g + 1]); w.y = cvtpk(acc[tl][4 * g + 2], acc[tl][4 * g + 3]);
                                *(uint2*)(yp + 8 * g) = w;
                            }
                        }
                    }
                }
            }
            asm volatile("s_waitcnt vmcnt(0)" ::: "memory");
            __syncthreads();
        }
    }
}
#undef MOE_BAR
}


namespace s5 {
using bf16x8 = __attribute__((ext_vector_type(8))) short;
using f32x16 = __attribute__((ext_vector_type(16))) float;
using u32x4  = __attribute__((ext_vector_type(4))) unsigned;
constexpr int NCHK = 516, NMT = 17;
__device__ __forceinline__ unsigned cvtpk(float lo, float hi) { unsigned r; asm volatile("v_cvt_pk_bf16_f32 %0, %1, %2" : "=v"(r) : "v"(lo), "v"(hi)); return r; }
__device__ __forceinline__ bf16x8 ld8f(const float* p) {
    const float4 a = *(const float4*)p, b = *(const float4*)(p + 4);
    u32x4 w; w.x = cvtpk(a.x, a.y); w.y = cvtpk(a.z, a.w); w.z = cvtpk(b.x, b.y); w.w = cvtpk(b.z, b.w);
    return *reinterpret_cast<bf16x8*>(&w);
}
__device__ __forceinline__ void prep_unit(KP P, char* lds, int layer, int g) {
    float2* pw = (float2*)lds; float2* bb = pw + 17 * 64; float2* cc = bb + 1024; float* kd = (float*)(cc + 1024);
    const int tid = tid_();
    const float dt = expf(P->log_dt[layer * 32 + g]);
    const float* a_re = P->a_re + (layer * 32 + g) * 64; const float* a_im = P->a_im + (layer * 32 + g) * 64;
    for (int idx = tid; idx < 17 * 64; idx += NTHR) { const int d = idx >> 6, p = idx & 63;
        const float mag = expf(a_re[p] * dt * (float)d), ang = a_im[p] * dt * (float)d; pw[idx] = make_float2(mag * cosf(ang), mag * sinf(ang)); }
    for (int idx = tid; idx < 1024; idx += NTHR) {
        { const int p = idx >> 4, c = idx & 15; const float are = a_re[p], aim = a_im[p];
          const float mag = expf(are * dt), abr = mag * cosf(aim * dt), abi = mag * sinf(aim * dt), den = are * are + aim * aim;
          const float zr = ((abr - 1.f) * are + abi * aim) / den, zi = (abi * are - (abr - 1.f) * aim) / den;
          const float br = P->b_re[((layer * 32 + g) * 64 + p) * 16 + c], bi = P->b_im[((layer * 32 + g) * 64 + p) * 16 + c];
          bb[idx] = make_float2(zr * br - zi * bi, zr * bi + zi * br); }
        { const int c = idx >> 6, p = idx & 63; cc[idx] = make_float2(P->c_re[((layer * 32 + g) * 16 + c) * 64 + p], P->c_im[((layer * 32 + g) * 16 + c) * 64 + p]); }
    }
    __syncthreads();
    if (tid < 64) ((float2*)P->A16)[(layer * 32 + g) * 64 + tid] = pw[16 * 64 + tid];
    for (int idx = tid; idx < 4096; idx += NTHR) { const int d = idx >> 8, c = (idx >> 4) & 15, c2 = idx & 15;
        float acc = 0.f;
        for (int p = 0; p < 64; ++p) { const float2 C = cc[c * 64 + p], W = pw[d * 64 + p], B = bb[p * 16 + c2];
            const float xr = C.x * W.x - C.y * W.y, xi = C.x * W.y + C.y * W.x; acc += xr * B.x - xi * B.y; }
        if (d == 0 && c == c2) acc += P->s5d[layer * 512 + g * 16 + c];
        kd[idx] = acc; }
    __syncthreads();
    bf16_t* BtY = P->BtY + (size_t)(layer * 32 + g) * 256 * 384; bf16_t* BtE = P->BtE + (size_t)(layer * 32 + g) * 128 * 256;
    for (int idx = tid; idx < 256 * 48; idx += NTHR) { const int n = idx / 48, ch = idx % 48, t = n >> 4, c = n & 15;
        float v[8];
        if (ch < 32) { const int s = ch >> 1, c0 = (ch & 1) * 8;
#pragma unroll
            for (int jj = 0; jj < 8; ++jj) v[jj] = (s <= t) ? kd[((t - s) * 16 + c) * 16 + c0 + jj] : 0.f;
        } else {
#pragma unroll
            for (int jj = 0; jj < 8; ++jj) { const int kq = (ch - 32) * 8 + jj, p = kq >> 1; const float2 C = cc[c * 64 + p], W = pw[(t + 1) * 64 + p];
                v[jj] = (kq & 1) ? -(C.x * W.y + C.y * W.x) : (C.x * W.x - C.y * W.y); }
        }
        u32x4 w; w.x = cvtpk(v[0], v[1]); w.y = cvtpk(v[2], v[3]); w.z = cvtpk(v[4], v[5]); w.w = cvtpk(v[6], v[7]);
        *(u32x4*)(BtY + ((size_t)(((n >> 5) * 24 + (ch >> 1)) * 64 + (ch & 1) * 32 + (n & 31))) * 8) = w; }
    for (int idx = tid; idx < 128 * 32; idx += NTHR) { const int n = idx >> 5, ch = idx & 31, p = n >> 1, s = ch >> 1, c0 = (ch & 1) * 8;
        const float2 W = pw[(15 - s) * 64 + p];
        float v[8];
#pragma unroll
        for (int jj = 0; jj < 8; ++jj) { const float2 B = bb[p * 16 + c0 + jj]; v[jj] = (n & 1) ? (W.x * B.y + W.y * B.x) : (W.x * B.x - W.y * B.y); }
        u32x4 w; w.x = cvtpk(v[0], v[1]); w.y = cvtpk(v[2], v[3]); w.z = cvtpk(v[4], v[5]); w.w = cvtpk(v[6], v[7]);
        *(u32x4*)(BtE + ((size_t)(((n >> 5) * 16 + (ch >> 1)) * 64 + (ch & 1) * 32 + (n & 31))) * 8) = w; }
    __syncthreads();
}
__device__ __forceinline__ float gelu_t(float x) { const float u = 0.7978845608028654f * (x + 0.044715f * x * x * x); const float e = __expf(2.f * u); return x - x / (e + 1.f); }
__device__ __forceinline__ void fused_unit(KP P, char* lds, int layer, int b, int g) {
    const int tid = tid_(), lane = tid & 63, wid = tid >> 6, r32 = lane & 31, hh = lane >> 5;
    constexpr int UCH = 528, UBYTES = 68352;
    char* U16 = lds; float* El = (float*)(lds + UBYTES);
    const float* PA = P->PA; bf16_t* YG = P->YG;
    { const float* ub = PA + (size_t)(b * LL) * PAW + 2048 + g * 16;
#pragma unroll 1
      for (int i0 = 0; i0 < LL * 4; i0 += NTHR * 4) {
          float4 v[4];
#pragma unroll
          for (int q = 0; q < 4; ++q) { const int idx = i0 + q * NTHR + tid, ic = idx < LL * 4 ? idx : LL * 4 - 1; v[q] = *(const float4*)(ub + (size_t)(ic >> 2) * PAW + (ic & 3) * 4); }
#pragma unroll
          for (int q = 0; q < 4; ++q) { const int idx = i0 + q * NTHR + tid; if (idx < LL * 4) { const int r = idx >> 2;
              uint2 w; w.x = cvtpk(v[q].x, v[q].y); w.y = cvtpk(v[q].z, v[q].w); *(uint2*)(U16 + (r >> 4) * UCH + (r & 15) * 32 + (idx & 3) * 8) = w; } }
      } }
    __syncthreads();
    int mrow[5];
#pragma unroll
    for (int mt = 0; mt < 5; ++mt) { const int m = mt * 32 + r32; mrow[mt] = m < 129 ? m : 128; }
    if (wid < 4) {
        const bf16_t* Bt = P->BtE + (size_t)(layer * 32 + g) * 128 * 256 + ((size_t)(wid * 16) * 64 + lane) * 8;
        f32x16 acc[5];
#pragma unroll
        for (int mt = 0; mt < 5; ++mt) acc[mt] = f32x16{};
#pragma unroll 4
        for (int s = 0; s < 16; ++s) {
            const bf16x8 af = *(const bf16x8*)(Bt + (size_t)(s * 64) * 8);
#pragma unroll
            for (int mt = 0; mt < 5; ++mt) { const bf16x8 bf = *(const bf16x8*)(U16 + mrow[mt] * UCH + hh * 16 + 32 * s); acc[mt] = __builtin_amdgcn_mfma_f32_32x32x16_bf16(af, bf, acc[mt], 0, 0, 0); }
        }
#pragma unroll
        for (int mt = 0; mt < 5; ++mt) { const int m = mt * 32 + r32; if (m < 129) { float* ep = El + m * 128 + wid * 32 + 4 * hh;
#pragma unroll
            for (int q = 0; q < 4; ++q) *(float4*)(ep + 8 * q) = make_float4(acc[mt][4 * q], acc[mt][4 * q + 1], acc[mt][4 * q + 2], acc[mt][4 * q + 3]); } }
    }
    __syncthreads();
    if (tid < 64) {
        const float2 A = ((const float2*)P->A16)[(layer * 32 + g) * 64 + tid];
        float2* e2 = (float2*)El + tid;
        float xr = 0.f, xi = 0.f;
#pragma unroll 1
        for (int j0 = 0; j0 < 128; j0 += 8) {
            float2 e[8];
#pragma unroll
            for (int i = 0; i < 8; ++i) e[i] = e2[(j0 + i) * 64];
#pragma unroll
            for (int i = 0; i < 8; ++i) { e2[(j0 + i) * 64] = make_float2(xr, xi);
                const float nr = A.x * xr - A.y * xi + e[i].x, ni = A.x * xi + A.y * xr + e[i].y; xr = nr; xi = ni; }
        }
        e2[128 * 64] = make_float2(xr, xi);
    }
    __syncthreads();
    {
        const bf16_t* Bt = P->BtY + (size_t)(layer * 32 + g) * 256 * 384 + ((size_t)(wid * 24) * 64 + lane) * 8;
        f32x16 acc[5];
#pragma unroll
        for (int mt = 0; mt < 5; ++mt) acc[mt] = f32x16{};
#pragma unroll 4
        for (int s = 0; s < 16; ++s) if (2 * wid + 1 >= s) {
            const bf16x8 af = *(const bf16x8*)(Bt + (size_t)(s * 64) * 8);
#pragma unroll
            for (int mt = 0; mt < 5; ++mt) { const bf16x8 bf = *(const bf16x8*)(U16 + mrow[mt] * UCH + hh * 16 + 32 * s); acc[mt] = __builtin_amdgcn_mfma_f32_32x32x16_bf16(af, bf, acc[mt], 0, 0, 0); }
        }
#pragma unroll 4
        for (int ks = 0; ks < 8; ++ks) {
            const bf16x8 af = *(const bf16x8*)(Bt + (size_t)((16 + ks) * 64) * 8);
#pragma unroll
            for (int mt = 0; mt < 5; ++mt) { const bf16x8 bf = ld8f(El + mrow[mt] * 128 + 8 * hh + ks * 16); acc[mt] = __builtin_amdgcn_mfma_f32_32x32x16_bf16(af, bf, acc[mt], 0, 0, 0); }
        }
#pragma unroll
        for (int mt = 0; mt < 5; ++mt) { const int ml = mt * 32 + r32; if (ml < 129) { const int m = b * 129 + ml;
#pragma unroll
            for (int q = 0; q < 4; ++q) { const int t = 2 * wid + (q >> 1);
                uint2 w; w.x = cvtpk(gelu_t(acc[mt][4 * q]), gelu_t(acc[mt][4 * q + 1])); w.y = cvtpk(gelu_t(acc[mt][4 * q + 2]), gelu_t(acc[mt][4 * q + 3]));
                *(uint2*)(YG + (size_t)(m * 16 + t) * 512 + g * 16 + 8 * (q & 1) + 4 * hh) = w; } } }
    }
    __syncthreads();
}
}

__device__ __forceinline__ float wave_sum(float v) {
    v += swz_xor<1>(v); v += swz_xor<2>(v); v += swz_xor<4>(v); v += swz_xor<8>(v); v += swz_xor<16>(v);
    { auto rr = __builtin_amdgcn_permlane32_swap(__float_as_uint(v), __float_as_uint(v), false, false); v = __uint_as_float(rr[0]) + __uint_as_float(rr[1]); }
    return v;
}
__device__ __forceinline__ unsigned cvtpk_(float lo, float hi) { unsigned r; asm volatile("v_cvt_pk_bf16_f32 %0, %1, %2" : "=v"(r) : "v"(lo), "v"(hi)); return r; }
__device__ __forceinline__ void ph_attn_out(KP P, int layer, int cu0) {
    const int tid = tid_(), lane = tid & 63, gw = (bid_() - cu0) * 8 + (tid >> 6), NGW = (gridDim.x - cu0) * 8;
    if (gw < 0) return;
    const float scale = 1.f - (0.8f - 0.6f * expf(-0.3f * (float)layer));
    const float lam = P->lam[layer];
    const float4 sw = ((const float4*)(P->subln + layer * 256))[lane];
    const float* OC = P->OC; bf16_t* MIX = P->MIX;
    for (int it0 = gw; it0 < TOK * 4; it0 += NGW * 4) {
        float4 a[4], b[4];
#pragma unroll
        for (int q = 0; q < 4; ++q) { const int it = it0 + NGW * q, itc = it < TOK * 4 ? it : TOK * 4 - 1, r = itc >> 2, h = itc & 3;
            a[q] = *(const float4*)(OC + (size_t)r * DM + h * 512 + lane * 4); b[q] = *(const float4*)(OC + (size_t)r * DM + h * 512 + 256 + lane * 4); }
#pragma unroll
        for (int q = 0; q < 4; ++q) { const int it = it0 + NGW * q; if (it < TOK * 4) { const int r = it >> 2, h = it & 3;
            const float o0 = a[q].x - lam * b[q].x, o1 = a[q].y - lam * b[q].y, o2 = a[q].z - lam * b[q].z, o3 = a[q].w - lam * b[q].w;
            const float ss = wave_sum(o0 * o0 + o1 * o1 + o2 * o2 + o3 * o3);
            const float rs = rsqrtf(ss * (1.f / 256.f) + EPS) * scale;
            uint2 w; w.x = cvtpk_(o0 * rs * sw.x, o1 * rs * sw.y); w.y = cvtpk_(o2 * rs * sw.z, o3 * rs * sw.w);
            *(uint2*)(MIX + (size_t)r * DM + 1024 + h * 256 + lane * 4) = w; } }
    }
}
__device__ __forceinline__ void ph_build_norm(KP P) {
    const int tid = tid_(), lane = tid & 63, gw = bid_() * 8 + (tid >> 6), NGW = gridDim.x * 8;
    for (int r = gw; r < MP; r += NGW) {
        float4 v[8];
        if (r < TOK) { const int b = r / LL, t = r % LL;
            const float4* src = (const float4*)(t < NMETA ? P->meta + (size_t)t * DM : P->x + ((size_t)b * SEQ + (t - NMETA)) * DM);
#pragma unroll
            for (int j = 0; j < 8; ++j) v[j] = src[lane + 64 * j];
        } else {
#pragma unroll
            for (int j = 0; j < 8; ++j) v[j] = make_float4(0.f, 0.f, 0.f, 0.f);
        }
        float ss = 0.f;
#pragma unroll
        for (int j = 0; j < 8; ++j) { ((float4*)(P->Z + (size_t)r * DM))[lane + 64 * j] = v[j]; ss += v[j].x * v[j].x + v[j].y * v[j].y + v[j].z * v[j].z + v[j].w * v[j].w; }
        const float rs = rsqrtf(wave_sum(ss) * (1.f / DM) + EPS);
#pragma unroll
        for (int j = 0; j < 8; ++j) { const float4 w = ((const float4*)P->ln1_w)[lane + 64 * j];
            uint2 o; o.x = cvtpk_(v[j].x * rs * w.x, v[j].y * rs * w.y); o.y = cvtpk_(v[j].z * rs * w.z, v[j].w * rs * w.w);
            ((uint2*)(P->HN + (size_t)r * DM))[lane + 64 * j] = o; }
    }
}
__device__ __forceinline__ void ph_prep(KP P) {
    const int tid = tid_();
    if (bid_() == 0) {
        const int c = tid;
        const float l0 = P->lbnd[c], l1 = P->lbnd[512 + c], m = fmaxf(l0, l1), e0 = expf(l0 - m), e1 = expf(l1 - m);
        P->lbtab[c] = 0.f; P->lbtab[512 + c] = e1 / (e0 + e1);
        if (c < 2) {
            float s1 = 0.f, s2 = 0.f;
            for (int i = 0; i < 128; ++i) { s1 += P->lq1[c * 128 + i] * P->lk1[c * 128 + i]; s2 += P->lq2[c * 128 + i] * P->lk2[c * 128 + i]; }
            const float li = 0.8f - 0.6f * expf(-0.3f * (float)c);
            P->lam[c] = expf(s1) - expf(s2) + li;
        }
    }
    for (int i = bid_() * NTHR + tid; i < 2 * 128 * 3 * 64 * 8; i += gridDim.x * NTHR) {
        const int jj = i & 7, ln = (i >> 3) & 63, ct = (i >> 9) % 3, ksg = ((i >> 9) / 3) & 127, layer = (i >> 9) / (3 * 128);
        const int jc = ct * 32 + (ln & 31), k = ksg * 16 + 8 * (ln >> 5) + jj;
        float v = 0.f;
        if (jc < 8) v = P->wrg[((size_t)layer * DM + k) * 8 + jc]; else if (jc < 72) v = P->wre[((size_t)layer * DM + k) * 64 + jc - 8];
        v *= P->ln2_w[layer * DM + k];
        const bf16_t hi = f2bf(v), lo = f2bf(v - bf2f(hi));
        const size_t o = ((size_t)((ksg * 3 + ct) * 64 + ln)) * 8 + jj;
        P->WRT[(size_t)(layer * 2 + 0) * 96 * DM + o] = hi; P->WRT[(size_t)(layer * 2 + 1) * 96 * DM + o] = lo;
    }
}
namespace rt {
using f32x16 = __attribute__((ext_vector_type(16))) float;
using bf16x8 = __attribute__((ext_vector_type(8))) short;
using u32x4  = __attribute__((ext_vector_type(4))) unsigned;
__device__ __forceinline__ void norm_router(KP P, char* lds, int layer) {
    const int tid = tid_(), lane = tid & 63, wid = tid >> 6, r32 = lane & 31, hh = lane >> 5;
    float* part = (float*)lds;
    float* ssqp = (float*)(lds + 98304);
    float* lg = ssqp + 256;
    float* rsv = lg + 32 * 97;
    const bf16_t* Whi = P->WRT + (size_t)(layer * 2 + 0) * 96 * DM; const bf16_t* Wlo = P->WRT + (size_t)(layer * 2 + 1) * 96 * DM;
    const float* Z = P->Z;
    float* st = (float*)lds + wid * (32 * 68);
    const int nunits = layer == 1 ? (NB * SEQ) / 32 : TOK / 32;
    for (int u = bid_(); u < nunits; u += gridDim.x) {
        const int tok0 = layer == 1 ? (u >> 6) * LL + NMETA + (u & 63) * 32 : u * 32, kb = wid * 256;
        if (false) {
            float* Zw = P->Z; const float* ZP = P->ZP;
            for (int i = tid; i < 32 * DM / 4; i += NTHR) { const int r = i / (DM / 4), c4 = i % (DM / 4);
                float4 z = ((const float4*)(Zw + (size_t)(tok0 + r) * DM))[c4];
#pragma unroll
                for (int ks = 0; ks < 8; ++ks) { const float4 p4 = ((const float4*)(ZP + ((size_t)ks * 256 + (tok0 - 8192 + r)) * DM))[c4]; z.x += p4.x; z.y += p4.y; z.z += p4.z; z.w += p4.w; }
                ((float4*)(Zw + (size_t)(tok0 + r) * DM))[c4] = z; }
            asm volatile("s_waitcnt vmcnt(0)" ::: "memory");
            __syncthreads();
        }
        f32x16 acc[3] = {f32x16{}, f32x16{}, f32x16{}};
        float sq8[8];
#pragma unroll
        for (int j = 0; j < 8; ++j) sq8[j] = 0.f;
        const float* zg = Z + (size_t)(tok0 + (lane >> 4)) * DM + kb + (lane & 15) * 4;
        const bf16_t* dg = P->DLT + (size_t)(tok0 + (lane >> 4)) * DM + kb + (lane & 15) * 4;
        bf16_t* hg_ = P->HN + (size_t)(tok0 + (lane >> 4)) * DM + kb + (lane & 15) * 4;
        float4 zs[8]; uint2 ds[8];
#pragma unroll
        for (int j = 0; j < 8; ++j) { zs[j] = *(const float4*)(zg + (size_t)(4 * j) * DM); ds[j] = *(const uint2*)(dg + (size_t)(4 * j) * DM); }
#pragma unroll 1
        for (int sc = 0; sc < 4; ++sc) {
            const float4 lw = *(const float4*)(P->ln2_w + layer * DM + kb + (lane & 15) * 4 + sc * 64);
#pragma unroll
            for (int j = 0; j < 8; ++j) { float4 z = zs[j]; z.x += __uint_as_float(ds[j].x << 16); z.y += __uint_as_float(ds[j].x & 0xffff0000u); z.z += __uint_as_float(ds[j].y << 16); z.w += __uint_as_float(ds[j].y & 0xffff0000u);
                sq8[j] += z.x * z.x + z.y * z.y + z.z * z.z + z.w * z.w;
                *(float4*)(st + ((lane >> 4) + 4 * j) * 68 + (lane & 15) * 4) = z;
                uint2 o; o.x = cvtpk_(z.x * lw.x, z.y * lw.y); o.y = cvtpk_(z.z * lw.z, z.w * lw.w);
                *(uint2*)(hg_ + (size_t)(4 * j) * DM + sc * 64) = o; }
            const int scn = sc < 3 ? sc + 1 : 3;
#pragma unroll
            for (int j = 0; j < 8; ++j) { zs[j] = *(const float4*)(zg + (size_t)(4 * j) * DM + scn * 64); ds[j] = *(const uint2*)(dg + (size_t)(4 * j) * DM + scn * 64); }
            asm volatile("s_waitcnt lgkmcnt(0)" ::: "memory");
            const bf16_t* wh = Whi + ((size_t)((wid * 16 + sc * 4) * 3) * 64 + lane) * 8; const bf16_t* wl = Wlo + ((size_t)((wid * 16 + sc * 4) * 3) * 64 + lane) * 8;
#pragma unroll
            for (int ks = 0; ks < 4; ++ks) {
                const float4 z0 = *(const float4*)(st + r32 * 68 + ks * 16 + 8 * hh), z1 = *(const float4*)(st + r32 * 68 + ks * 16 + 8 * hh + 4);
                u32x4 h; h.x = cvtpk_(z0.x, z0.y); h.y = cvtpk_(z0.z, z0.w); h.z = cvtpk_(z1.x, z1.y); h.w = cvtpk_(z1.z, z1.w);
                u32x4 l; l.x = cvtpk_(z0.x - __uint_as_float(h.x << 16), z0.y - __uint_as_float(h.x & 0xffff0000u)); l.y = cvtpk_(z0.z - __uint_as_float(h.y << 16), z0.w - __uint_as_float(h.y & 0xffff0000u));
                l.z = cvtpk_(z1.x - __uint_as_float(h.z << 16), z1.y - __uint_as_float(h.z & 0xffff0000u)); l.w = cvtpk_(z1.z - __uint_as_float(h.w << 16), z1.w - __uint_as_float(h.w & 0xffff0000u));
                const bf16x8 zh = *reinterpret_cast<bf16x8*>(&h), zl = *reinterpret_cast<bf16x8*>(&l);
#pragma unroll
                for (int ct = 0; ct < 3; ++ct) {
                    const bf16x8 ah = *(const bf16x8*)(wh + (size_t)((ks * 3 + ct) * 64) * 8), al = *(const bf16x8*)(wl + (size_t)((ks * 3 + ct) * 64) * 8);
                    acc[ct] = __builtin_amdgcn_mfma_f32_32x32x16_bf16(ah, zh, acc[ct], 0, 0, 0);
                    acc[ct] = __builtin_amdgcn_mfma_f32_32x32x16_bf16(ah, zl, acc[ct], 0, 0, 0);
                    acc[ct] = __builtin_amdgcn_mfma_f32_32x32x16_bf16(al, zh, acc[ct], 0, 0, 0);
                }
            }
            asm volatile("s_waitcnt lgkmcnt(0)" ::: "memory");
        }
#pragma unroll
        for (int j = 0; j < 8; ++j) { float v = sq8[j]; v += swz_xor<1>(v); v += swz_xor<2>(v); v += swz_xor<4>(v); v += swz_xor<8>(v); sq8[j] = v; }
        __syncthreads();
        if ((lane & 15) == 0) {
#pragma unroll
            for (int j = 0; j < 8; ++j) ssqp[wid * 32 + (lane >> 4) + 4 * j] = sq8[j];
        }

#pragma unroll
        for (int ct = 0; ct < 3; ++ct)
#pragma unroll
            for (int rg = 0; rg < 16; ++rg) part[((wid * 3 + ct) * 16 + rg) * 64 + lane] = acc[ct][rg];
        __syncthreads();
        if (tid < 32) { float t = 0.f;
#pragma unroll
            for (int w = 0; w < 8; ++w) t += ssqp[w * 32 + tid];
            rsv[tid] = rsqrtf(t * (1.f / DM) + EPS); }
#pragma unroll
        for (int q = 0; q < 6; ++q) { const int o = tid + NTHR * q, col = o >> 5, tok = o & 31, ct = col >> 5, cl = col & 31, h2 = (cl >> 2) & 1, rg = (cl & 3) + 4 * (cl >> 3);
            float t = 0.f;
#pragma unroll
            for (int w = 0; w < 8; ++w) t += part[((w * 3 + ct) * 16 + rg) * 64 + h2 * 32 + tok];
            lg[tok * 97 + col] = t; }
        __syncthreads();
        if (tid < 32) {
            const int t = tok0 + tid; const float rs = rsv[tid]; const float* l = lg + tid * 97;
            const float* brg = P->brg + layer * 8; const float* bre = P->bre + layer * 64;
            float gl[8];
#pragma unroll
            for (int j = 0; j < 8; ++j) gl[j] = l[j] * rs + brg[j];
            int gs = 0; float gm = gl[0];
#pragma unroll
            for (int j = 1; j < 8; ++j) if (gl[j] > gm) { gm = gl[j]; gs = j; }
            float den = 0.f;
#pragma unroll
            for (int j = 0; j < 8; ++j) den += expf(gl[j] - gm);
            const float pg = 1.f / den;
            float el[8];
#pragma unroll
            for (int j = 0; j < 8; ++j) el[j] = l[8 + gs * 8 + j] * rs + bre[gs * 8 + j];
            int j0 = 0; float v0 = el[0];
#pragma unroll
            for (int j = 1; j < 8; ++j) if (el[j] > v0) { v0 = el[j]; j0 = j; }
            int j1 = -1; float v1 = -INFINITY;
#pragma unroll
            for (int j = 0; j < 8; ++j) if (j != j0 && el[j] > v1) { v1 = el[j]; j1 = j; }
            const float e1 = expf(v1 - v0), g0 = pg / (1.f + e1), g1 = pg * e1 / (1.f + e1);
            const int x0 = gs * 8 + j0, x1 = gs * 8 + j1;
            P->ridx[t * 2] = x0; P->ridx[t * 2 + 1] = x1; P->rgate[t * 2] = g0; P->rgate[t * 2 + 1] = g1;
            const int s0 = atomicAdd(&P->cnt[x0 * CSTR], 1), s1 = atomicAdd(&P->cnt[x1 * CSTR], 1);
            P->rslot[t * 2] = s0; P->rslot[t * 2 + 1] = s1;
            P->rsn[t] = rs;
            if (s0 < ECAP) { P->elist[x0 * ECAP + s0] = t; P->ers[x0 * ECAP + s0] = rs; } if (s1 < ECAP) { P->elist[x1 * ECAP + s1] = t; P->ers[x1 * ECAP + s1] = rs; }
        }
        __syncthreads();
    }
}
}
__device__ __forceinline__ void ph_combine_norm(KP P, char* lds, int layer) {
    int* base = (int*)lds;
    const int tid = tid_(), lane = tid & 63, gw = bid_() * 8 + (tid >> 6), NGW = gridDim.x * 8;
    if (tid < 64) base[64 + tid] = P->cnt[tid * CSTR];
    __syncthreads();
    if (tid < 64) { int a = 0; for (int q = 0; q < tid; ++q) a += base[64 + q]; base[tid] = a; }
    __syncthreads();
    for (int t0 = gw; t0 < TOK; t0 += 2 * NGW) {
        int r0[2], r1[2]; float g0[2], g1[2]; bool ok[2]; int tcs[2];
        int2 ex[2], sl[2]; float2 gg[2];
        float4 v[2][8]; uint2 ya[2][8], yb[2][8], dl[2][8];
#pragma unroll
        for (int q = 0; q < 2; ++q) { const int t = t0 + q * NGW; ok[q] = t < TOK && !(layer == 1 && (t % LL) < NMETA); tcs[q] = ok[q] ? t : (layer == 1 ? NMETA : t0);
            ex[q] = ((const int2*)P->ridx)[tcs[q]]; sl[q] = ((const int2*)P->rslot)[tcs[q]]; gg[q] = ((const float2*)P->rgate)[tcs[q]];
#pragma unroll
            for (int j = 0; j < 8; ++j) { v[q][j] = ((const float4*)(P->Z + (size_t)tcs[q] * DM))[lane + 64 * j]; dl[q][j] = ((const uint2*)(P->DLT + (size_t)tcs[q] * DM))[lane + 64 * j]; } }
#pragma unroll
        for (int q = 0; q < 2; ++q) { r0[q] = base[ex[q].x] + sl[q].x; r1[q] = base[ex[q].y] + sl[q].y; g0[q] = gg[q].x; g1[q] = gg[q].y;
#pragma unroll
            for (int j = 0; j < 8; ++j) { ya[q][j] = ((const uint2*)(P->Y + (size_t)r0[q] * DM))[lane + 64 * j]; yb[q][j] = ((const uint2*)(P->Y + (size_t)r1[q] * DM))[lane + 64 * j]; } }
#pragma unroll
        for (int q = 0; q < 2; ++q) if (ok[q]) { const int t = t0 + q * NGW;
            float ss = 0.f;
#pragma unroll
            for (int j = 0; j < 8; ++j) { const uint2 a = ya[q][j], b = yb[q][j], d = dl[q][j]; float4& x = v[q][j];
                x.x += __uint_as_float(d.x << 16); x.y += __uint_as_float(d.x & 0xffff0000u); x.z += __uint_as_float(d.y << 16); x.w += __uint_as_float(d.y & 0xffff0000u);
                x.x += g0[q] * __uint_as_float(a.x << 16) + g1[q] * __uint_as_float(b.x << 16); x.y += g0[q] * __uint_as_float(a.x & 0xffff0000u) + g1[q] * __uint_as_float(b.x & 0xffff0000u);
                x.z += g0[q] * __uint_as_float(a.y << 16) + g1[q] * __uint_as_float(b.y << 16); x.w += g0[q] * __uint_as_float(a.y & 0xffff0000u) + g1[q] * __uint_as_float(b.y & 0xffff0000u);
                ss += x.x * x.x + x.y * x.y + x.z * x.z + x.w * x.w; }
            const float rs = rsqrtf(wave_sum(ss) * (1.f / DM) + EPS);
            if (layer == 0) {
#pragma unroll
                for (int j = 0; j < 8; ++j) { ((float4*)(P->Z + (size_t)t * DM))[lane + 64 * j] = v[q][j];
                    const float4 w = ((const float4*)(P->ln1_w + DM))[lane + 64 * j];
                    uint2 o; o.x = cvtpk_(v[q][j].x * rs * w.x, v[q][j].y * rs * w.y); o.y = cvtpk_(v[q][j].z * rs * w.z, v[q][j].w * rs * w.w);
                    ((uint2*)(P->HN + (size_t)t * DM))[lane + 64 * j] = o; }
            } else {
                const int b = t / LL, tt = t % LL;
                if (tt >= NMETA) {
#pragma unroll
                    for (int j = 0; j < 8; ++j) { const float4 w = ((const float4*)P->fnw)[lane + 64 * j];
                        ((float4*)(P->out + ((size_t)b * SEQ + (tt - NMETA)) * DM))[lane + 64 * j] = make_float4(v[q][j].x * rs * w.x, v[q][j].y * rs * w.y, v[q][j].z * rs * w.z, v[q][j].w * rs * w.w); }
                }
            }
        }
    }
    __syncthreads();
}

__global__ void __launch_bounds__(NTHR, 2) mega_fwd(Params P_arg) {
    extern __shared__ __attribute__((aligned(16))) char lds[];
    const int tid = tid_(), G = gridDim.x;
    volatile LAS unsigned* ctlw = (volatile LAS unsigned*)((LAS char*)lds + LDS_CTL);
    if (tid < 64) ctlw[tid] = 0u;
    __syncthreads();
    KP P = kp_();
    XcdBarrier bar = xcd_barrier_post(P->bar, ctlw + 8);
#define GRID_BAR() do { xcd_barrier(bar); P = kp_(); } while (0)

    ph_build_norm(P);
    ph_prep(P);
    ph_weights(P, lds);
    __syncthreads();
    for (int un = bid_(); un < 64; un += G) s5::prep_unit(P, lds, un >> 5, un & 31);
    GRID_BAR();
#pragma unroll
    for (int layer = 0; layer < 2; ++layer) {
        { pg8::Gemm g{P->HN, P->WinT + (size_t)layer * INW * DM, MP, INW, DM, DM}; pg8::StaticOrder S; S.init(MP, INW, G, bid_(), DM / 64); pg8::EpiInProj E{P->PA, P->QKV};
          pg8::gemm_phase<pg8::EpiInProj, pg8::StaticOrder, true, true>((LAS unsigned char*)lds, g, S, E); }
        { const int t2 = tid_(), b2 = bid_(); if (b2 == 0 && t2 < NE) P->cnt[t2 * CSTR] = 0;
 }
        GRID_BAR();
        hg::local_states(P, lds, layer);
        { const int b0 = bid_(); for (int un = (G == 256) ? ((b0 + 128) & 255) : b0; un < 128; un += G) s5::fused_unit(P, lds, layer, un >> 5, un & 31); }
        ph_attention(P, lds);
        GRID_BAR();
        hg::scan_states(P);
        ph_attn_out(P, layer, G > 192 ? 132 : 0);
        __syncthreads();
        { pg8::Gemm g{P->YG, P->WgluT + (size_t)layer * 1024 * 512, MP, 1024, 512, 512}; pg8::StaticOrder S; S.init(MP, 1024, G, bid_(), 512 / 64); pg8::EpiGlu E{P->MIX, P->b_glu + layer * 1024};
          pg8::gemm_phase<pg8::EpiGlu, pg8::StaticOrder, true, true>((LAS unsigned char*)lds, g, S, E); }
        GRID_BAR();
        hg::outputs(P, lds, layer);
        GRID_BAR();
        { pg8::Gemm g{P->MIX, P->WoutT + (size_t)layer * DM * DM, MP, DM, DM, DM}; pg8::StaticOrder S; S.init(MP, DM, G, bid_(), DM / 64); pg8::EpiResidual E{P->DLT};
          pg8::gemm_phase<pg8::EpiResidual, pg8::StaticOrder, true, true>((LAS unsigned char*)lds, g, S, E); }
        GRID_BAR();
        rt::norm_router(P, lds, layer);
        GRID_BAR();
        moe::stream_gemm<true>(P, lds, layer);
        GRID_BAR();
        moe::stream_gemm<false>(P, lds, layer);
        GRID_BAR();
        ph_combine_norm(P, lds, layer);
        if (layer == 0) GRID_BAR();
    }
}
}

extern "C" void kernel_launch(void* const* d_in, const int* in_sizes, int n_in, void* d_out, int out_size, void* d_ws, size_t ws_size, hipStream_t stream) {
    static int grid = 0;
    if (grid == 0) {
        int dev = 0, cus = 0;
        if (hipGetDevice(&dev) != hipSuccess || hipDeviceGetAttribute(&cus, hipDeviceAttributeMultiprocessorCount, dev) != hipSuccess) { grid = -1; return; }
        if (hipFuncSetAttribute((const void*)mega_fwd, hipFuncAttributeMaxDynamicSharedMemorySize, LDS_BYTES) != hipSuccess) { grid = -1; return; }
        int per_cu = 0;
        if (hipOccupancyMaxActiveBlocksPerMultiprocessor(&per_cu, (const void*)mega_fwd, NTHR, LDS_BYTES) != hipSuccess || per_cu < 1) { (void)hipGetLastError(); }
        grid = cus;
    }
    if (grid < 0) return;
    Params p{};
    const float** pin = (const float**)&p;
    for (int i = 0; i < 31; ++i) pin[i] = (const float*)d_in[i];
    p.out = (float*)d_out;
    char* ws = (char*)d_ws; size_t off = 0;
    auto alloc = [&](size_t bytes) { char* q = ws + off; off += (bytes + 255) & ~(size_t)255; return q; };
    p.bar = (unsigned*)alloc(XCD_BAR_WORDS * 4);
    p.elist = (int*)alloc((size_t)NE * ECAP * 4); p.ers = (float*)alloc((size_t)NE * ECAP * 4); p.rsn = (float*)alloc((size_t)MP * 4);
    p.cnt = (int*)alloc((size_t)NE * CSTR * 4); p.blk_e = (int*)alloc(1024); p.base = (int*)alloc(256);
    p.lbtab = (float*)alloc(1024 * 4); p.lam = (float*)alloc(256);
    p.Z = (float*)alloc((size_t)MP * DM * 4);
    p.HN = (bf16_t*)alloc((size_t)MP * DM * 2);
    p.PA = (float*)alloc((size_t)MP * PAW * 4);
    p.QKV = (bf16_t*)alloc((size_t)MP * QKVW * 2);
    p.OA = (float*)alloc((size_t)MP * HW * 4);
    p.ZP = (float*)alloc((size_t)8 * 256 * DM * 4);
    p.WRT = (bf16_t*)alloc((size_t)2 * 2 * 96 * DM * 2);
    p.A16 = (float*)alloc(2 * 32 * 64 * 8); p.S5E = (float*)alloc((size_t)516 * 32 * 128 * 4); p.S5X = (float*)alloc((size_t)516 * 32 * 128 * 4);
    p.BtY = (bf16_t*)alloc((size_t)2 * 32 * 256 * 384 * 2); p.BtE = (bf16_t*)alloc((size_t)2 * 32 * 128 * 256 * 2);
    p.SLOC = (float*)alloc((size_t)528 * 16384 * 4); p.DEC = (float*)alloc((size_t)528 * 128 * 4); p.SPREV = (bf16_t*)alloc((size_t)529 * 16384 * 2);
    p.YG = (bf16_t*)alloc((size_t)MP * 512 * 2); p.DLT = (bf16_t*)alloc((size_t)MP * DM * 2);
    p.T = nullptr;
    p.MIX = (bf16_t*)alloc((size_t)MP * DM * 2);
    p.OC = (float*)alloc((size_t)MP * DM * 4);
    p.ridx = (int*)alloc((size_t)NASSIGN * 4); p.rgate = (float*)alloc((size_t)NASSIGN * 4); p.rslot = (int*)alloc((size_t)NASSIGN * 4);
    p.tokrow = (int*)alloc((size_t)NASSIGN * 4); p.rowtok = (int*)alloc((size_t)NRMAX * 4);
    p.H1 = nullptr;
    p.H = (bf16_t*)alloc((size_t)NRMAX * DE * 2);
    p.Y = (bf16_t*)alloc((size_t)NRMAX * DM * 2);
    p.S = nullptr;
    p.WinT = (bf16_t*)alloc((size_t)2 * INW * DM * 2); p.WoutT = (bf16_t*)alloc((size_t)2 * DM * DM * 2); p.WgluT = (bf16_t*)alloc((size_t)2 * 1024 * 512 * 2);
    if (off > ws_size) return;
    if (hipMemsetAsync(p.bar, 0, XCD_BAR_WORDS * 4, stream) != hipSuccess) return;
    hipLaunchKernelGGL(mega_fwd, dim3(grid), dim3(NTHR), LDS_BYTES, stream, p);
}
```

```cpp
#include <hip/hip_runtime.h>
#include <stdint.h>
#include <math.h>

namespace {
typedef unsigned short bf16_t;
constexpr int DM = 2048, NB = 4, SEQ = 2048, NMETA = 16, LL = SEQ + NMETA, TOK = NB * LL, MP = 8448;
constexpr int HW = 512;
constexpr int INW = 5632, PAW = 2560, QKVW = 3072;
constexpr int NE = 64, DE = 512, NASSIGN = TOK * 2;
constexpr int RB = 128;
constexpr int NRMAX = NASSIGN + NE * RB;
constexpr float EPS = 1e-6f;
constexpr int NTHR = 512;
constexpr int CSTR = 64;
constexpr int ECAP = 1024;
constexpr int LDS_BYTES = 163840;
constexpr int LDS_CTL = 159744;

__device__ __forceinline__ float bf2f(bf16_t h) { return __uint_as_float(((unsigned)h) << 16); }
__device__ __forceinline__ bf16_t f2bf(float f) { unsigned u = __float_as_uint(f); return (bf16_t)((u + 0x7fffu + ((u >> 16) & 1u)) >> 16); }
__device__ __forceinline__ float sigmoidf_(float x) { return 1.f / (1.f + expf(-x)); }
__device__ __forceinline__ int tid_() { int t = threadIdx.x; asm volatile("" : "+v"(t)); return t; }
template <int K> __device__ __forceinline__ float swz_xor(float v) { return __int_as_float(__builtin_amdgcn_ds_swizzle(__float_as_int(v), (K << 10) | 0x1f)); }
__device__ __forceinline__ int bid_() { int b = blockIdx.x; asm volatile("" : "+s"(b)); return b; }

#define XB_TMO      128
#define XB_XCNT(j)  (256  + 64 * (j))
#define XB_XSUB(j)  (1280 + 64 * (j))
#define XB_XGEN(j)  (2304 + 64 * (j))
#define XB_TOP      3328
#define XB_TOPGEN   3392
#define XCD_BAR_WORDS 3456
#define XB_SPIN_CAP (1u << 24)
#define LAS __attribute__((address_space(3)))
__device__ __forceinline__ unsigned xb_ld(unsigned* p)              { return __hip_atomic_load(p, __ATOMIC_RELAXED, __HIP_MEMORY_SCOPE_AGENT); }
__device__ __forceinline__ unsigned xb_add(unsigned* p, unsigned v) { return __hip_atomic_fetch_add(p, v, __ATOMIC_RELAXED, __HIP_MEMORY_SCOPE_AGENT); }
__device__ __forceinline__ unsigned xb_xcc_id() { return (unsigned)__builtin_amdgcn_s_getreg((3 << 11) | 20) & 0xFu; }
#define XB_SPIN(cond, bar) do { unsigned _sp = 0; while (cond) { __builtin_amdgcn_s_sleep(1); \
    if ((++_sp & 255u) == 0u) { if (xb_ld(&(bar)[XB_TMO])) break; if (_sp > XB_SPIN_CAP) { atomicAdd(&(bar)[XB_TMO], 1u); break; } } } } while (0)
struct XcdBarrier { unsigned* bar; unsigned x; volatile LAS unsigned* st; };
__device__ __forceinline__ XcdBarrier xcd_barrier_post(unsigned* bar, volatile LAS unsigned* st) {
    XcdBarrier b; b.bar = bar; b.x = xb_xcc_id(); b.st = st;
    if (threadIdx.x == 0) (void)xb_add(&bar[XB_XCNT(b.x)], 1u);
    return b;
}
__device__ __forceinline__ void xcd_barrier_complete(unsigned* bar, unsigned x, unsigned& nloc, unsigned& nx) {
    const unsigned G = gridDim.x * gridDim.y * gridDim.z;
    unsigned sum, cnt, mine, sp = 0u;
    for (;;) {
        sum = 0u; cnt = 0u; mine = 0u;
#pragma unroll
        for (unsigned j = 0; j < 16; ++j) { const unsigned c = xb_ld(&bar[XB_XCNT(j)]); sum += c; cnt += (c > 0u) ? 1u : 0u; mine = (j == x) ? c : mine; }
        if (sum == G) break;
        __builtin_amdgcn_s_sleep(1);
        if ((++sp & 255u) == 0u) { if (xb_ld(&bar[XB_TMO])) break; if (sp > XB_SPIN_CAP) { atomicAdd(&bar[XB_TMO], 1u); break; } }
    }
    nloc = mine > 0u ? mine : 1u; nx = cnt > 0u ? cnt : 1u;
}
__device__ __forceinline__ void xcd_barrier(const XcdBarrier& b) {
    asm volatile("s_waitcnt vmcnt(0)" ::: "memory");
    __syncthreads();
    if (threadIdx.x == 0) {
        unsigned* bar = b.bar;
        const unsigned bx_ = xb_xcc_id();
        __builtin_amdgcn_s_waitcnt(0);
        unsigned nloc = b.st[0], nx = b.st[1];
        if (nloc == 0u) { xcd_barrier_complete(bar, bx_, nloc, nx); b.st[0] = nloc; b.st[1] = nx; }
        const unsigned old = xb_add(&bar[XB_XSUB(bx_)], 1u);
        const unsigned gen = old / nloc;
        if (old + 1u == (gen + 1u) * nloc) {
            __builtin_amdgcn_fence(__ATOMIC_RELEASE, "agent");
            asm volatile("s_waitcnt vmcnt(0)" ::: "memory");
            const unsigned og = xb_add(&bar[XB_TOP], 1u);
            const unsigned tg = og / nx;
            if (og + 1u == (tg + 1u) * nx) xb_add(&bar[XB_TOPGEN], 1u);
            else XB_SPIN(xb_ld(&bar[XB_TOPGEN]) == tg, bar);
            __builtin_amdgcn_fence(__ATOMIC_ACQUIRE, "agent");
            xb_add(&bar[XB_XGEN(bx_)], 1u);
            asm volatile("s_waitcnt vmcnt(0)" ::: "memory");
        } else {
            XB_SPIN(xb_ld(&bar[XB_XGEN(bx_)]) == gen, bar);
            __builtin_amdgcn_fence(__ATOMIC_ACQUIRE, "agent");
            asm volatile("s_waitcnt vmcnt(0)" ::: "memory");
        }
    }
    __syncthreads();
}

struct Params {
    const float *x, *meta, *ln1_w, *w_in, *lbnd, *hnw, *a_re, *a_im, *b_re, *b_im, *c_re, *c_im, *s5d, *log_dt, *w_glu, *b_glu,
                *lq1, *lk1, *lq2, *lk2, *subln, *w_out, *ln2_w, *wrg, *brg, *wre, *bre, *w1, *w3, *w2, *fnw;
    float* out;
    unsigned* bar;
    int *cnt, *blk_e, *ridx, *rslot, *tokrow, *rowtok, *base, *elist;
    float *lbtab, *lam, *Z, *PA, *OA, *T, *OC, *rgate, *H1, *S, *SLOC, *DEC, *A16, *S5E, *S5X, *ZP, *ers, *rsn;
    bf16_t *HN, *QKV, *YG, *MIX, *H, *Y, *WinT, *WoutT, *WgluT, *SPREV, *BtY, *BtE, *WRT, *DLT;
};
typedef const __attribute__((address_space(4))) Params* KP;
__device__ __forceinline__ KP kp_() { KP p = (KP)__builtin_amdgcn_kernarg_segment_ptr(); asm volatile("" : "+s"(p)); return p; }


namespace pg8 {
#define PG8_LAS __attribute__((address_space(3)))
typedef short bf16x8 __attribute__((ext_vector_type(8)));
typedef float f32x4 __attribute__((ext_vector_type(4)));
typedef unsigned u32x4 __attribute__((ext_vector_type(4)));
constexpr int BM = 256, BK = 64, HALF = 128, HTB = HALF * BK * 2, STAGE_BYTES = 8 * HTB, NXCD = 8, WGM = 8;
__host__ __device__ __forceinline__ int lds_byte(int r, int c) { const int st = (r >> 4) * 2 + (c >> 5), rr = r & 15, cc = c & 31, ob = rr * 64 + cc * 2; return st * 1024 + (ob ^ (((ob >> 9) & 1) << 5)); }
__host__ __device__ __forceinline__ void stage_rc(int b, int& R, int& C) { const int st = b / 1024, sb = b % 1024, swz = sb ^ (((sb >> 9) & 1) << 5); R = (st >> 1) * 16 + swz / 64; C = (st & 1) * 32 + (swz % 64) / 2; }
__host__ __device__ __forceinline__ int perm32(int rho) { const int n = rho >> 4, i = rho & 15; return 8 * (i >> 2) + 4 * n + (i & 3); }
struct Unit { int pm, pn, ko, nt; };
struct Gemm { const bf16_t* A; const bf16_t* Bt; int M, N, K, ld; };
struct StaticOrder {
    static constexpr bool PER_UNIT_K = false;
    int nM, nN, nwg, G, c, nt;
    __host__ __device__ void init(int M, int N, int G_, int c_, int nt_) { nM = M / BM; nN = N / BM; nwg = nM * nN; G = G_; c = c_; nt = nt_; }
    __host__ __device__ bool next(int i, Unit& u) const {
        const long L = (long)i * G + c; if (L >= nwg) return false;
        int wgid = (int)L; { const int q = nwg / NXCD, r = nwg % NXCD, xcd = wgid % NXCD, off = wgid / NXCD; wgid = (xcd < r ? xcd * (q + 1) : r * (q + 1) + (xcd - r) * q) + off; }
        const int nig = WGM * nN, gid = wgid / nig, fm = gid * WGM, gsz = (nM - fm) < WGM ? (nM - fm) : WGM;
        u.pm = fm + ((wgid % nig) % gsz); u.pn = (wgid % nig) / gsz; u.ko = 0; u.nt = nt; return true;
    }
    __device__ __forceinline__ void a_ready(const Unit&) const {}
    __device__ __forceinline__ void done(const Unit&) const {}
};
__device__ __forceinline__ unsigned cvt_pk_bf16(float lo, float hi) { unsigned r; asm volatile("v_cvt_pk_bf16_f32 %0, %1, %2" : "=v"(r) : "v"(lo), "v"(hi)); return r; }

template <class Epi, class Sched, bool ALIGN_EPI = false, bool SP2 = false>
__device__ __forceinline__ void gemm_phase(PG8_LAS unsigned char* lds, const Gemm g, const Sched& S, const Epi& E) {
    const int tid = tid_(), wid = __builtin_amdgcn_readfirstlane(tid >> 6), lane = tid & 63, wr = wid >> 2, wc = wid & 3, fr = lane & 15, fq = lane >> 4;
    const int K = g.ld;
    unsigned voffA[2], voffB[2];
#pragma unroll
    for (int i = 0; i < 2; ++i) { int R, C; stage_rc(tid * 16 + i * 8192, R, C); const int Rb = Epi::PERM ? ((R & ~31) + perm32(R & 31)) : R;
        voffA[i] = (unsigned)(R * K + C) * 2u; voffB[i] = (unsigned)(Rb * K + C) * 2u; }
    const size_t kstep = (size_t)(BK * 2);
    const size_t hstep = (size_t)HALF * K * 2;
    const size_t tstep = 2 * hstep;
    const unsigned ldsw = (unsigned)wid * 1024u;
    const int aoff = lds_byte(wr * 64 + fr, fq * 8), boff = lds_byte(wc * 32 + fr, fq * 8);
#define PG8_SA(b, h) (((b) * 2 + (h)) * HTB)
#define PG8_SB(b, h) ((4 + (b) * 2 + (h)) * HTB)
#define PG8_STAGE(bufoff, gbase, voff) do { _Pragma("unroll") for (int _i = 0; _i < 2; ++_i) \
        __builtin_amdgcn_global_load_lds((const unsigned*)((const char*)(gbase) + (voff)[_i]), (PG8_LAS unsigned*)(lds + (bufoff) + ldsw + _i * 8192), 16, 0, 0); } while (0)
#define PG8_LDA(dst, b, h) do { _Pragma("unroll") for (int m = 0; m < 4; ++m) _Pragma("unroll") for (int k = 0; k < 2; ++k) dst[m][k] = *(const PG8_LAS bf16x8*)(lds + PG8_SA(b, h) + aoff + m * 2048 + k * 1024); } while (0)
#define PG8_LDB(dst, b, h) do { _Pragma("unroll") for (int n = 0; n < 2; ++n) _Pragma("unroll") for (int k = 0; k < 2; ++k) dst[n][k] = *(const PG8_LAS bf16x8*)(lds + PG8_SB(b, h) + boff + n * 2048 + k * 1024); } while (0)
#define PG8_MMA(ai, bj, At, Bt) do { __builtin_amdgcn_s_setprio(1); _Pragma("unroll") for (int m = 0; m < 4; ++m) _Pragma("unroll") for (int n = 0; n < 2; ++n) _Pragma("unroll") for (int k = 0; k < 2; ++k) \
        acc[ai][bj][m][n] = __builtin_amdgcn_mfma_f32_16x16x32_bf16(Bt[n][k], At[m][k], acc[ai][bj][m][n], 0, 0, 0); __builtin_amdgcn_s_setprio(0); } while (0)
#define PG8_WAIT_V(n) asm volatile("s_waitcnt vmcnt(" #n ")" ::: "memory")
#define PG8_WAIT_L(n) asm volatile("s_waitcnt lgkmcnt(" #n ")" ::: "memory")
#define PG8_BAR __builtin_amdgcn_s_barrier()
#define PG8_SCHED __builtin_amdgcn_sched_barrier(0)
    Unit cur, nxt; int ui = 0;
    if (!S.next(0, cur)) return;
    f32x4 acc[2][2][4][2];
#pragma unroll
    for (int a = 0; a < 2; ++a)
#pragma unroll
        for (int b = 0; b < 2; ++b)
#pragma unroll
            for (int m = 0; m < 4; ++m)
#pragma unroll
                for (int n = 0; n < 2; ++n) acc[a][b][m][n] = (f32x4){0.f, 0.f, 0.f, 0.f};
    bf16x8 At[4][2], B0[2][2], B1[2][2];
    const char* cA = (const char*)g.A + (size_t)cur.pm * tstep + (size_t)cur.ko * 2; const char* cB = (const char*)g.Bt + (size_t)cur.pn * tstep + (size_t)cur.ko * 2;
    S.a_ready(cur);
    if constexpr (SP2) {
        PG8_STAGE(PG8_SB(0, 0), cB, voffB); PG8_STAGE(PG8_SB(0, 1), cB + hstep, voffB); PG8_STAGE(PG8_SA(0, 0), cA, voffA); PG8_STAGE(PG8_SA(0, 1), cA + hstep, voffA);
        if (wr == 1) PG8_BAR;
        PG8_WAIT_V(2); PG8_BAR;
        PG8_STAGE(PG8_SB(1, 0), cB + kstep, voffB); PG8_STAGE(PG8_SA(1, 0), cA + kstep, voffA); PG8_STAGE(PG8_SB(1, 1), cB + hstep + kstep, voffB);
        PG8_WAIT_V(6); PG8_BAR;
    } else {
        PG8_STAGE(PG8_SB(0, 0), cB, voffB); PG8_STAGE(PG8_SA(0, 0), cA, voffA); PG8_STAGE(PG8_SB(0, 1), cB + hstep, voffB); PG8_STAGE(PG8_SA(0, 1), cA + hstep, voffA);
        if (wr == 1) PG8_BAR;
        PG8_WAIT_V(4); PG8_BAR;
        PG8_STAGE(PG8_SB(1, 0), cB + kstep, voffB); PG8_STAGE(PG8_SA(1, 0), cA + kstep, voffA); PG8_STAGE(PG8_SB(1, 1), cB + hstep + kstep, voffB);
        PG8_WAIT_V(6); PG8_BAR;
    }
    for (;;) {
        const bool has_next = S.next(ui + 1, nxt);
        const char* nA = has_next ? (const char*)g.A + (size_t)nxt.pm * tstep + (size_t)nxt.ko * 2 : cA; const char* nB = has_next ? (const char*)g.Bt + (size_t)nxt.pn * tstep + (size_t)nxt.ko * 2 : cB;
        const int nt = Sched::PER_UNIT_K ? cur.nt : g.K / BK;
        for (int t = 0; t < nt; t += 2) {
            const bool last = (t == nt - 2);
            const char* a1 = cA + (size_t)(t + 1) * kstep;
            const char* a2 = last ? nA : cA + (size_t)(t + 2) * kstep; const char* b2 = last ? nB : cB + (size_t)(t + 2) * kstep;
            const char* a3 = a2 + kstep; const char* b3 = b2 + kstep;
            if (last && has_next) S.a_ready(nxt);
            if constexpr (SP2) {
            PG8_LDB(B0, 0, 0); PG8_LDB(B1, 0, 1); PG8_SCHED; PG8_LDA(At, 0, 0); PG8_STAGE(PG8_SA(1, 1), a1 + hstep, voffA);
            PG8_WAIT_V(8); PG8_WAIT_L(0); PG8_BAR; PG8_MMA(0, 0, At, B0); PG8_MMA(0, 1, At, B1); PG8_BAR; PG8_SCHED;
            PG8_LDA(At, 0, 1); PG8_STAGE(PG8_SB(0, 0), b2, voffB); PG8_STAGE(PG8_SB(0, 1), b2 + hstep, voffB); PG8_STAGE(PG8_SA(0, 0), a2, voffA);
            PG8_WAIT_V(8); PG8_WAIT_L(0); PG8_BAR; PG8_MMA(1, 0, At, B0); PG8_MMA(1, 1, At, B1); PG8_BAR; PG8_SCHED;
            PG8_LDB(B0, 1, 0); PG8_LDB(B1, 1, 1); PG8_SCHED; PG8_LDA(At, 1, 0); PG8_STAGE(PG8_SA(0, 1), a2 + hstep, voffA);
            PG8_WAIT_V(8); PG8_WAIT_L(0); PG8_BAR; PG8_MMA(0, 0, At, B0); PG8_MMA(0, 1, At, B1); PG8_BAR; PG8_SCHED;
            PG8_LDA(At, 1, 1); PG8_STAGE(PG8_SB(1, 0), b3, voffB); PG8_STAGE(PG8_SB(1, 1), b3 + hstep, voffB); PG8_STAGE(PG8_SA(1, 0), a3, voffA);
            PG8_WAIT_V(8); PG8_WAIT_L(0); PG8_BAR; PG8_MMA(1, 0, At, B0); PG8_MMA(1, 1, At, B1); PG8_BAR; PG8_SCHED;
            } else {
            PG8_LDB(B0, 0, 0); PG8_SCHED; PG8_LDA(At, 0, 0); PG8_STAGE(PG8_SA(1, 1), a1 + hstep, voffA);
            PG8_WAIT_L(8); PG8_BAR; PG8_WAIT_L(0); PG8_MMA(0, 0, At, B0); PG8_BAR; PG8_SCHED;
            PG8_LDB(B1, 0, 1); PG8_STAGE(PG8_SB(0, 0), b2, voffB);
            PG8_BAR; PG8_WAIT_L(0); PG8_MMA(0, 1, At, B1); PG8_BAR;
            PG8_LDA(At, 0, 1); PG8_STAGE(PG8_SA(0, 0), a2, voffA);
            PG8_BAR; PG8_WAIT_L(0); PG8_MMA(1, 0, At, B0); PG8_BAR; PG8_SCHED;
            PG8_STAGE(PG8_SB(0, 1), b2 + hstep, voffB);
            PG8_WAIT_V(6); PG8_BAR; PG8_MMA(1, 1, At, B1); PG8_BAR;
            PG8_LDB(B0, 1, 0); PG8_SCHED; PG8_LDA(At, 1, 0); PG8_STAGE(PG8_SA(0, 1), a2 + hstep, voffA);
            PG8_WAIT_L(8); PG8_BAR; PG8_WAIT_L(0); PG8_MMA(0, 0, At, B0); PG8_BAR; PG8_SCHED;
            PG8_LDB(B1, 1, 1); PG8_STAGE(PG8_SB(1, 0), b3, voffB);
            PG8_BAR; PG8_WAIT_L(0); PG8_MMA(0, 1, At, B1); PG8_BAR;
            PG8_LDA(At, 1, 1); PG8_STAGE(PG8_SA(1, 0), a3, voffA);
            PG8_BAR; PG8_WAIT_L(0); PG8_MMA(1, 0, At, B0); PG8_BAR; PG8_SCHED;
            PG8_STAGE(PG8_SB(1, 1), b3 + hstep, voffB);
            PG8_WAIT_V(6); PG8_BAR; PG8_MMA(1, 1, At, B1); PG8_BAR;
            }
        }
        if constexpr (ALIGN_EPI) { if (wr == 0) PG8_BAR; }
        E(acc, cur, wr, wc, fr, fq);
        if (!has_next) break;
#pragma unroll
        for (int a = 0; a < 2; ++a)
#pragma unroll
            for (int b = 0; b < 2; ++b)
#pragma unroll
                for (int m = 0; m < 4; ++m)
#pragma unroll
                    for (int n = 0; n < 2; ++n) acc[a][b][m][n] = (f32x4){0.f, 0.f, 0.f, 0.f};
        cur = nxt; cA = nA; cB = nB; ++ui;
        if constexpr (ALIGN_EPI) { if (wr == 1) PG8_BAR; }
    }
    PG8_WAIT_V(0);
    if constexpr (!ALIGN_EPI) { if (wr == 0) PG8_BAR; }
    PG8_BAR;
#undef PG8_SA
#undef PG8_SB
#undef PG8_STAGE
#undef PG8_LDA
#undef PG8_LDB
#undef PG8_MMA
#undef PG8_WAIT_V
#undef PG8_WAIT_L
#undef PG8_BAR
#undef PG8_SCHED
}
struct EpiInProj {
    static constexpr bool PERM = true;
    float* PA; bf16_t* QKV;
    __device__ __forceinline__ void operator()(const f32x4 (&acc)[2][2][4][2], const Unit& u, int wr, int wc, int fr, int fq) const {
        const int row0 = u.pm * BM + wr * 64 + fr, colt = u.pn * BM + wc * 32 + 8 * fq;
        if (colt < PAW) {
#pragma unroll
            for (int ai = 0; ai < 2; ++ai)
#pragma unroll
                for (int m = 0; m < 4; ++m) { float* rp = PA + (size_t)(row0 + ai * HALF + m * 16) * PAW + colt;
#pragma unroll
                    for (int bj = 0; bj < 2; ++bj) { *(f32x4*)(rp + bj * HALF) = acc[ai][bj][m][0]; *(f32x4*)(rp + bj * HALF + 4) = acc[ai][bj][m][1]; } }
        } else {
#pragma unroll
            for (int ai = 0; ai < 2; ++ai)
#pragma unroll
                for (int m = 0; m < 4; ++m) { bf16_t* rp = QKV + (size_t)(row0 + ai * HALF + m * 16) * QKVW + (colt - PAW);
#pragma unroll
                    for (int bj = 0; bj < 2; ++bj) { const f32x4 v0 = acc[ai][bj][m][0], v1 = acc[ai][bj][m][1];
                        u32x4 w; w.x = cvt_pk_bf16(v0[0], v0[1]); w.y = cvt_pk_bf16(v0[2], v0[3]); w.z = cvt_pk_bf16(v1[0], v1[1]); w.w = cvt_pk_bf16(v1[2], v1[3]);
                        *(u32x4*)(rp + bj * HALF) = w; } }
        }
    }
};
struct EpiResidual {
    static constexpr bool PERM = true;
    bf16_t* D;
    __device__ __forceinline__ void operator()(const f32x4 (&acc)[2][2][4][2], const Unit& u, int wr, int wc, int fr, int fq) const {
        const int row0 = u.pm * BM + wr * 64 + fr, colt = u.pn * BM + wc * 32 + 8 * fq;
#pragma unroll
        for (int ai = 0; ai < 2; ++ai)
#pragma unroll
            for (int m = 0; m < 4; ++m) { const int row = row0 + ai * HALF + m * 16; if (row < TOK) { bf16_t* rp = D + (size_t)row * DM + colt;
#pragma unroll
                for (int bj = 0; bj < 2; ++bj) { const f32x4 v0 = acc[ai][bj][m][0], v1 = acc[ai][bj][m][1];
                    u32x4 w; w.x = cvt_pk_bf16(v0[0], v0[1]); w.y = cvt_pk_bf16(v0[2], v0[3]); w.z = cvt_pk_bf16(v1[0], v1[1]); w.w = cvt_pk_bf16(v1[2], v1[3]);
                    *(u32x4*)(rp + bj * HALF) = w; } } }
    }
};
struct OutOrder {
    static constexpr bool PER_UNIT_K = true;
    StaticOrder main;
    __device__ bool next(int i, Unit& u) const {
        if (main.next(i, u)) return true;
        const int r0 = (main.nwg + main.G - 1) / main.G;
        const int L = (i - r0) * main.G + main.c; if (i < r0 || L >= 64) return false;
        u.pm = 32; u.pn = L & 7; u.ko = (L >> 3) * 256; u.nt = 4; return true; }
    __device__ __forceinline__ void a_ready(const Unit&) const {}
    __device__ __forceinline__ void done(const Unit&) const {}
};
struct EpiOutProj {
    static constexpr bool PERM = true;
    float* Z; float* ZP;
    __device__ __forceinline__ void operator()(const f32x4 (&acc)[2][2][4][2], const Unit& u, int wr, int wc, int fr, int fq) const {
        const bool tail = u.pm == 32;
        const int row0 = (tail ? (u.ko >> 8) * BM : u.pm * BM) + wr * 64 + fr, colt = u.pn * BM + wc * 32 + 8 * fq;
        float* base = tail ? ZP : Z;
#pragma unroll
        for (int ai = 0; ai < 2; ++ai)
#pragma unroll
            for (int m = 0; m < 4; ++m) { float* rp = base + (size_t)(row0 + ai * HALF + m * 16) * DM + colt;
#pragma unroll
                for (int bj = 0; bj < 2; ++bj) { f32x4* p0 = (f32x4*)(rp + bj * HALF); f32x4* p1 = (f32x4*)(rp + bj * HALF + 4);
                    f32x4 z0 = {0.f, 0.f, 0.f, 0.f}, z1 = {0.f, 0.f, 0.f, 0.f};
                    if (!tail) { z0 = *p0; z1 = *p1; }
                    *p0 = z0 + acc[ai][bj][m][0]; *p1 = z1 + acc[ai][bj][m][1]; } }
    }
};
struct TailOrder {
    static constexpr bool PER_UNIT_K = false;
    int G, c;
    __device__ bool next(int i, Unit& u) const { const int L = i * G + c; if (L >= 64) return false; u.pm = 32; u.pn = L & 7; u.ko = (L >> 3) * 256; u.nt = 4; return true; }
    __device__ __forceinline__ void a_ready(const Unit&) const {}
    __device__ __forceinline__ void done(const Unit&) const {}
};
struct EpiTailPartial {
    static constexpr bool PERM = true;
    float* ZP;
    __device__ __forceinline__ void operator()(const f32x4 (&acc)[2][2][4][2], const Unit& u, int wr, int wc, int fr, int fq) const {
        const int row0 = (u.ko >> 8) * BM + wr * 64 + fr, colt = u.pn * BM + wc * 32 + 8 * fq;
#pragma unroll
        for (int ai = 0; ai < 2; ++ai)
#pragma unroll
            for (int m = 0; m < 4; ++m) { float* rp = ZP + (size_t)(row0 + ai * HALF + m * 16) * DM + colt;
#pragma unroll
                for (int bj = 0; bj < 2; ++bj) { *(f32x4*)(rp + bj * HALF) = acc[ai][bj][m][0]; *(f32x4*)(rp + bj * HALF + 4) = acc[ai][bj][m][1]; } }
    }
};
struct EpiGlu {
    static constexpr bool PERM = true;
    bf16_t* MIX; const float* bias;
    __device__ __forceinline__ void operator()(const f32x4 (&acc)[2][2][4][2], const Unit& u, int wr, int wc, int fr, int fq) const {
        const int row0 = u.pm * BM + wr * 64 + fr, c0 = u.pn * HALF + wc * 32 + 8 * fq;
        const f32x4 bv0 = *(const f32x4*)(bias + c0), bv1 = *(const f32x4*)(bias + c0 + 4), bg0 = *(const f32x4*)(bias + 512 + c0), bg1 = *(const f32x4*)(bias + 512 + c0 + 4);
        float one = 1.f; asm volatile("" : "+v"(one));
#pragma unroll
        for (int ai = 0; ai < 2; ++ai)
#pragma unroll
            for (int m = 0; m < 4; ++m) { const f32x4 v0 = acc[ai][0][m][0] + bv0, v1 = acc[ai][0][m][1] + bv1, g0 = acc[ai][1][m][0] + bg0, g1 = acc[ai][1][m][1] + bg1;
                float o[8];
#pragma unroll
                for (int e = 0; e < 4; ++e) { o[e] = v0[e] * __builtin_amdgcn_rcpf(one + __expf(-g0[e])); o[4 + e] = v1[e] * __builtin_amdgcn_rcpf(one + __expf(-g1[e])); }
                u32x4 w; w.x = cvt_pk_bf16(o[0], o[1]); w.y = cvt_pk_bf16(o[2], o[3]); w.z = cvt_pk_bf16(o[4], o[5]); w.w = cvt_pk_bf16(o[6], o[7]);
                *(u32x4*)(MIX + (size_t)(row0 + ai * HALF + m * 16) * DM + 512 + c0) = w; }
    }
};
}

__device__ __forceinline__ void transpose_item(const float* W, int K, int N, bf16_t* WT, int k0, int n0, int row0, float* scr, int lane) {
    float tv[32];
#pragma unroll
    for (int i = 0; i < 32; ++i) { const int kk = 2 * i + (lane >> 5); tv[i] = W[(size_t)(k0 + kk) * N + n0 + (lane & 31)]; }
#pragma unroll
    for (int i = 0; i < 32; ++i) { const int kk = 2 * i + (lane >> 5); scr[kk * 33 + (lane & 31)] = tv[i]; }
    asm volatile("s_waitcnt lgkmcnt(0)" ::: "memory");
    const int c = lane & 7;
#pragma unroll
    for (int j = 0; j < 4; ++j) { const int n = (lane >> 3) + 8 * j; const float* sp = scr + (8 * c) * 33 + n;
        pg8::u32x4 o; o.x = pg8::cvt_pk_bf16(sp[0 * 33], sp[1 * 33]); o.y = pg8::cvt_pk_bf16(sp[2 * 33], sp[3 * 33]); o.z = pg8::cvt_pk_bf16(sp[4 * 33], sp[5 * 33]); o.w = pg8::cvt_pk_bf16(sp[6 * 33], sp[7 * 33]);
        *(pg8::u32x4*)(WT + (size_t)(row0 + n) * K + k0 + 8 * c) = o; }
    asm volatile("s_waitcnt lgkmcnt(0)" ::: "memory");
}
__device__ __forceinline__ void ph_weights(KP P, char* lds) {
    const int tid = tid_(), lane = tid & 63, wave = tid >> 6;
    float* scr = (float*)lds + wave * (64 * 33);
    const int cu0 = gridDim.x == 256 ? 64 : 0, gw = (bid_() - cu0) * 8 + wave, NGW = (gridDim.x - cu0) * 8;
    if (gw < 0) return;
    constexpr int I_IN = (DM / 64) * (INW / 32), I_OUT = (DM / 64) * (DM / 32), I_GLU = (512 / 64) * (1024 / 32), I_L = I_IN + I_OUT + I_GLU;
    for (int it = gw; it < 2 * I_L; it += NGW) {
        const int layer = it / I_L; int r = it % I_L;
        if (r < I_IN) { const int nb = INW / 32, kb = r / nb, n0 = (r % nb) * 32;
            transpose_item(P->w_in + (size_t)layer * DM * INW, DM, INW, P->WinT + (size_t)layer * INW * DM, kb * 64, n0, n0, scr, lane); continue; }
        r -= I_IN;
        if (r < I_OUT) { const int nb = DM / 32, kb = r / nb, n0 = (r % nb) * 32;
            transpose_item(P->w_out + (size_t)layer * DM * DM, DM, DM, P->WoutT + (size_t)layer * DM * DM, kb * 64, n0, n0, scr, lane); continue; }
        r -= I_OUT;
        { const int nb = 1024 / 32, kb = r / nb, n0 = (r % nb) * 32;
          const int row0 = ((n0 & 511) >> 7) * 256 + (n0 >> 9) * 128 + (n0 & 127);
          transpose_item(P->w_glu + (size_t)layer * 512 * 1024, 512, 1024, P->WgluT + (size_t)layer * 1024 * 512, kb * 64, n0, row0, scr, lane); }
    }
}


namespace fa {
using bf16x8 = __attribute__((ext_vector_type(8))) short;
using s16x4  = __attribute__((ext_vector_type(4))) short;
using f32x16 = __attribute__((ext_vector_type(16))) float;
using u32x4  = __attribute__((ext_vector_type(4))) unsigned;
constexpr int D = 128, NW = 8, QBLK = 32, KVBLK = 64, LDQK = QKVW;
constexpr float SCALE = 0.088388347648318440f, THR = 8.f, NEG = -1e30f;
constexpr size_t SHM_V = KVBLK * D * 2, SHM_K = KVBLK * D * 2, SHM_ATTN = 2 * SHM_V + 2 * SHM_K + NW * 64 * 4;
#define KSWZ(row, colB) ((row) * 256 + ((colB) ^ (((row) & 7) << 4)))
#define SBAR() __builtin_amdgcn_sched_barrier(0)
__device__ __forceinline__ int crow(int r, int hi) { return (r & 3) + 8 * (r >> 2) + 4 * hi; }
__device__ __forceinline__ unsigned cvtpk(float lo, float hi) { unsigned r; asm volatile("v_cvt_pk_bf16_f32 %0, %1, %2" : "=v"(r) : "v"(lo), "v"(hi)); return r; }
__device__ __forceinline__ void partialSM(f32x16& p0, f32x16& p1, float& m_reg, float& mn, float& alpha) {
  constexpr float C = SCALE * 1.4426950408889634f;
  float pmax = p0[0]; for (int r = 1; r < 16; ++r) pmax = fmaxf(pmax, p0[r]); for (int r = 0; r < 16; ++r) pmax = fmaxf(pmax, p1[r]);
  { auto rr = __builtin_amdgcn_permlane32_swap(__float_as_uint(pmax), __float_as_uint(pmax), false, false);
    pmax = fmaxf(__uint_as_float(rr[0]), __uint_as_float(rr[1])); }
  if (__builtin_expect(__all(pmax - m_reg <= THR / SCALE), 1)) { mn = m_reg; alpha = 1.f; }
  else { mn = fmaxf(m_reg, pmax); alpha = __builtin_amdgcn_exp2f((m_reg - mn) * C); m_reg = mn; }
  float mnC = -mn * C;
  for (int r = 0; r < 16; ++r) p0[r] = fmaf(p0[r], C, mnC); for (int r = 0; r < 16; ++r) p1[r] = fmaf(p1[r], C, mnC);
  for (int r = 0; r < 16; ++r) p0[r] = __builtin_amdgcn_exp2f(p0[r]);
}
__device__ __forceinline__ void finishSM(f32x16& p0, f32x16& p1, float alpha, float& l_reg, bf16x8& pa0, bf16x8& pa1, bf16x8& pa2, bf16x8& pa3) {
  for (int r = 0; r < 16; ++r) p1[r] = __builtin_amdgcn_exp2f(p1[r]);
  float ps = 0; for (int r = 0; r < 16; ++r) ps += p0[r]; for (int r = 0; r < 16; ++r) ps += p1[r];
  { auto rr = __builtin_amdgcn_permlane32_swap(__float_as_uint(ps), __float_as_uint(ps), false, false);
    ps = __uint_as_float(rr[0]) + __uint_as_float(rr[1]); }
  l_reg = l_reg * alpha + ps;
#define PK4(P, BASE, OUT) do { unsigned a0 = cvtpk(P[BASE + 0], P[BASE + 1]), a1 = cvtpk(P[BASE + 2], P[BASE + 3]);   \
    unsigned b0 = cvtpk(P[BASE + 4], P[BASE + 5]), b1 = cvtpk(P[BASE + 6], P[BASE + 7]);                              \
    auto r0 = __builtin_amdgcn_permlane32_swap(a0, b0, false, false); auto r1 = __builtin_amdgcn_permlane32_swap(a1, b1, false, false); \
    u32x4 w = {r0[0], r1[0], r0[1], r1[1]}; OUT = *reinterpret_cast<bf16x8*>(&w); } while (0)
  PK4(p0, 0, pa0); PK4(p0, 8, pa1); PK4(p1, 0, pa2); PK4(p1, 8, pa3);
#undef PK4
}
__device__ __forceinline__ void qkt(f32x16& p0, f32x16& p1, const bf16_t* Ks, const bf16x8* qr, int r32, int hi) {
  p0 = f32x16{}; p1 = f32x16{};
  for (int d0 = 0; d0 < 8; ++d0) { int cb = (d0 * 16 + hi * 8) * 2;
    bf16x8 b0 = *reinterpret_cast<const bf16x8*>((const char*)Ks + KSWZ(r32, cb));
    bf16x8 b1 = *reinterpret_cast<const bf16x8*>((const char*)Ks + KSWZ(32 + r32, cb));
    p0 = __builtin_amdgcn_mfma_f32_32x32x16_bf16(b0, qr[d0], p0, 0, 0, 0);
    p1 = __builtin_amdgcn_mfma_f32_32x32x16_bf16(b1, qr[d0], p1, 0, 0, 0); }
}
__device__ __forceinline__ void mask_tile(f32x16& p0, f32x16& p1, int kt, int vis) {
  if (kt > vis) {
    const bool part = (kt == vis + 1);
    for (int r = 0; r < 16; ++r) p1[r] = NEG;
    for (int r = 8; r < 16; ++r) p0[r] = NEG;
    if (!part) for (int r = 0; r < 8; ++r) p0[r] = NEG;
  }
}
__device__ __forceinline__ int v_st(int k, int c) { const int kk = (k & ~0xC) | ((k & 4) << 1) | ((k & 8) >> 1); return ((kk >> 3) * 4 + (c >> 5)) * 512 + ((kk & 7) * 32 + (c & 31)) * 2; }
__device__ __forceinline__ int v_rd_base(int lane) { return ((lane & 3) << 3) | (((lane >> 2) & 3) << 6) | (((lane >> 4) & 1) << 5) | (((lane >> 5) & 1) << 8); }
constexpr int v_rd_off(int d0, int ks, int half) { return d0 * 512 + ks * 4096 + half * 2048; }
template <int OFF> __device__ __forceinline__ s16x4 tr_read(int vb) {
  s16x4 r; asm volatile("ds_read_b64_tr_b16 %0, %1 offset:%2" : "=&v"(r) : "v"(vb), "i"(OFF) : "memory"); return r;
}
template <int D0> __device__ __forceinline__ void pv_one(f32x16& od, int vb, bf16x8 pa0, bf16x8 pa1, bf16x8 pa2, bf16x8 pa3) {
  const s16x4 l0 = tr_read<v_rd_off(D0, 0, 0)>(vb), h0 = tr_read<v_rd_off(D0, 0, 1)>(vb), l1 = tr_read<v_rd_off(D0, 1, 0)>(vb), h1 = tr_read<v_rd_off(D0, 1, 1)>(vb);
  const s16x4 l2 = tr_read<v_rd_off(D0, 2, 0)>(vb), h2 = tr_read<v_rd_off(D0, 2, 1)>(vb), l3 = tr_read<v_rd_off(D0, 3, 0)>(vb), h3 = tr_read<v_rd_off(D0, 3, 1)>(vb);
  asm volatile("s_waitcnt lgkmcnt(0)" ::: "memory"); SBAR();
#define PK(L, H) (bf16x8){L[0], L[1], L[2], L[3], H[0], H[1], H[2], H[3]}
  od = __builtin_amdgcn_mfma_f32_32x32x16_bf16(pa0, PK(l0, h0), od, 0, 0, 0);
  od = __builtin_amdgcn_mfma_f32_32x32x16_bf16(pa1, PK(l1, h1), od, 0, 0, 0);
  od = __builtin_amdgcn_mfma_f32_32x32x16_bf16(pa2, PK(l2, h2), od, 0, 0, 0);
  od = __builtin_amdgcn_mfma_f32_32x32x16_bf16(pa3, PK(l3, h3), od, 0, 0, 0);
#undef PK
}
__device__ __forceinline__ void pv_d0(f32x16* o, int vb, bf16x8 pa0, bf16x8 pa1, bf16x8 pa2, bf16x8 pa3) {
  pv_one<0>(o[0], vb, pa0, pa1, pa2, pa3); pv_one<1>(o[1], vb, pa0, pa1, pa2, pa3); pv_one<2>(o[2], vb, pa0, pa1, pa2, pa3); pv_one<3>(o[3], vb, pa0, pa1, pa2, pa3);
}
__device__ __forceinline__ void attn_unit(const bf16_t* __restrict__ Qb, const bf16_t* __restrict__ Kh, const bf16_t* __restrict__ Vh, bf16_t* __restrict__ Ob, int NT, int vis4, char* lds) {
  const int tid = tid_(), wid = tid >> 6, lane = tid & 63, r32 = lane & 31, hi = lane >> 5;
  const int vis = vis4 + (wid >> 1);
  bf16_t* V_lds = (bf16_t*)lds; bf16_t* K_lds = (bf16_t*)(lds + 2 * SHM_V);
  float* ws = (float*)(lds + 2 * SHM_V + 2 * SHM_K) + wid * 64; float* li_l = ws; float* al_l = ws + 32;
  float m_reg = NEG, l_reg = 0; f32x16 o[4] = {}; bf16x8 qr[8];
  const bf16_t* Qw = Qb + (long)(wid * QBLK + r32) * LDQK + hi * 8;
#pragma unroll
  for (int d0 = 0; d0 < 8; ++d0) qr[d0] = *reinterpret_cast<const bf16x8*>(Qw + d0 * 16);
  const int sr = tid >> 4, sc = (tid & 15) * 8, vst0 = v_st(sr, sc), vst1 = v_st(32 + sr, sc);
  const int vb0 = (int)(uintptr_t)V_lds + v_rd_base(lane);
  struct { bf16x8 vs0, vs1, ks0, ks1; } sr_[2];
#define SLOAD(i, k0) do { sr_[i].vs0 = *reinterpret_cast<const bf16x8*>(&Vh[(long)((k0) + sr) * LDQK + sc]); sr_[i].vs1 = *reinterpret_cast<const bf16x8*>(&Vh[(long)((k0) + 32 + sr) * LDQK + sc]); \
    sr_[i].ks0 = *reinterpret_cast<const bf16x8*>(&Kh[(long)((k0) + sr) * LDQK + sc]); sr_[i].ks1 = *reinterpret_cast<const bf16x8*>(&Kh[(long)((k0) + 32 + sr) * LDQK + sc]); } while (0)
#define SWRITE(b, i) do { *(bf16x8*)((char*)V_lds + (b) * SHM_V + vst0) = sr_[i].vs0;          \
    *(bf16x8*)((char*)V_lds + (b) * SHM_V + vst1) = sr_[i].vs1; int kc = sc * 2;               \
    *(bf16x8*)((char*)K_lds + (b) * SHM_K + KSWZ(sr, kc)) = sr_[i].ks0;                       \
    *(bf16x8*)((char*)K_lds + (b) * SHM_K + KSWZ(32 + sr, kc)) = sr_[i].ks1; } while (0)
#define SWAIT() asm volatile("s_waitcnt vmcnt(4)" ::: "memory")
#define RESC(a) do { if (__any((a) < 1.f)) { if (hi == 0) al_l[r32] = (a); asm volatile("s_waitcnt lgkmcnt(0)" ::: "memory"); \
    for (int d = 0; d < 4; ++d) for (int r = 0; r < 16; ++r) o[d][r] *= al_l[crow(r, hi)]; } } while (0)
  f32x16 pA0, pA1, pB0, pB1; float mnA, mnB, alA, alB; bf16x8 pa0, pa1, pa2, pa3;
  constexpr int SE = 0, SO = 1;
  SLOAD(SE, 0); asm volatile("s_waitcnt vmcnt(0)" ::: "memory"); SWRITE(0, SE); __syncthreads();
  qkt(pA0, pA1, K_lds, qr, r32, hi); mask_tile(pA0, pA1, 0, vis); partialSM(pA0, pA1, m_reg, mnA, alA);
  SLOAD(SO, KVBLK); if (2 < NT) SLOAD(SE, 2 * KVBLK);
  SWAIT(); SWRITE(1, SO); __syncthreads();
  for (int j = 1; j + 1 < NT; j += 2) {
    SBAR(); qkt(pB0, pB1, (bf16_t*)((char*)K_lds + SHM_K), qr, r32, hi); mask_tile(pB0, pB1, j, vis);
    finishSM(pA0, pA1, alA, l_reg, pa0, pa1, pa2, pa3); SBAR();
    SLOAD(SO, (j + 2) * KVBLK); SBAR();
    pv_d0(o, vb0, pa0, pa1, pa2, pa3); partialSM(pB0, pB1, m_reg, mnB, alB);
    __syncthreads(); SWAIT(); SWRITE(0, SE);
    RESC(alB); __syncthreads();
    SBAR(); qkt(pA0, pA1, K_lds, qr, r32, hi); mask_tile(pA0, pA1, j + 1, vis);
    finishSM(pB0, pB1, alB, l_reg, pa0, pa1, pa2, pa3); SBAR();
    if (j + 3 < NT) SLOAD(SE, (j + 3) * KVBLK); SBAR();
    pv_d0(o, vb0 + (int)SHM_V, pa0, pa1, pa2, pa3); partialSM(pA0, pA1, m_reg, mnA, alA);
    __syncthreads(); SWAIT(); SWRITE(1, SO);
    RESC(alA); __syncthreads();
  }
  SBAR(); qkt(pB0, pB1, (bf16_t*)((char*)K_lds + SHM_K), qr, r32, hi); mask_tile(pB0, pB1, NT - 1, vis);
  finishSM(pA0, pA1, alA, l_reg, pa0, pa1, pa2, pa3); SBAR();
  pv_d0(o, vb0, pa0, pa1, pa2, pa3); partialSM(pB0, pB1, m_reg, mnB, alB);
  __syncthreads(); RESC(alB);
  finishSM(pB0, pB1, alB, l_reg, pa0, pa1, pa2, pa3); SBAR();
  pv_d0(o, vb0 + (int)SHM_V, pa0, pa1, pa2, pa3);
  if (hi == 0) li_l[r32] = l_reg; asm volatile("s_waitcnt lgkmcnt(0)" ::: "memory");
  float rli[16];
#pragma unroll
  for (int r = 0; r < 16; ++r) rli[r] = __builtin_amdgcn_rcpf(li_l[crow(r, hi)]);
  bf16_t* Ow = Ob + (long)(wid * QBLK) * DM;
#pragma unroll
  for (int r = 0; r < 16; ++r) { int orow = crow(r, hi);
    for (int d0 = 0; d0 < 4; ++d0) Ow[(long)orow * DM + d0 * 32 + r32] = f2bf(o[d0][r] * rli[r]); }
  __syncthreads();
#undef SLOAD
#undef SWRITE
#undef SWAIT
#undef RESC
}
#undef KSWZ
#undef SBAR
}

__device__ __forceinline__ void ph_attention(KP P, char* lds) {
    const bf16_t* QKV = P->QKV; bf16_t* OC = (bf16_t*)P->OC;
#pragma unroll 1
    for (int c = bid_(); c < 256; c += gridDim.x) {
        const int combo = c >> 2, b = combo >> 4, h = (combo >> 2) & 3, i = (combo >> 1) & 1, vh = combo & 1;
        const bf16_t* Kh = QKV + (size_t)(b * LL) * QKVW + 1024 + h * 256 + i * 128;
        const bf16_t* Vh = QKV + (size_t)(b * LL) * QKVW + 2048 + h * 256 + vh * 128;
#pragma unroll 1
        for (int s = 0; s < 2; ++s) {
            const int jb = s == 0 ? (c & 3) : 7 - (c & 3);
            const size_t row0 = (size_t)(b * LL) + NMETA + 256 * jb;
            fa::attn_unit(QKV + row0 * QKVW + h * 256 + i * 128, Kh, Vh, OC + row0 * DM + h * 512 + i * 256 + vh * 128, 4 * jb + 6, 4 * jb, lds);
        }
    }
#pragma unroll 1
    for (int gw0 = bid_() * 8; gw0 < 512; gw0 += gridDim.x * 8) {
        const int tid = tid_(), lane = tid & 63, gw = gw0 + (tid >> 6);
        if (gw < 512) {
            const int b = gw >> 7, h = (gw >> 5) & 3, i = (gw >> 4) & 1, row = gw & 15;
            const bf16_t* q = QKV + (size_t)(b * LL + row) * QKVW + h * 256 + i * 128;
            const int key = lane & 15;
            const bf16_t* k = QKV + (size_t)(b * LL + key) * QKVW + 1024 + h * 256 + i * 128;
            float sc = 0.f;
            { pg8::u32x4 qv[16], kv[16];
#pragma unroll
              for (int c8 = 0; c8 < 16; ++c8) { qv[c8] = *(const pg8::u32x4*)(q + c8 * 8); kv[c8] = *(const pg8::u32x4*)(k + c8 * 8); }
#pragma unroll
              for (int c8 = 0; c8 < 16; ++c8)
#pragma unroll
                  for (int w2 = 0; w2 < 4; ++w2) { const unsigned a = qv[c8][w2], bq = kv[c8][w2];
                      sc = fmaf(__uint_as_float(a << 16), __uint_as_float(bq << 16), sc); sc = fmaf(__uint_as_float(a & 0xffff0000u), __uint_as_float(bq & 0xffff0000u), sc); } }
            sc *= 0.08838834764831845f;
            float m = sc;
            m = fmaxf(m, swz_xor<8>(m)); m = fmaxf(m, swz_xor<4>(m)); m = fmaxf(m, swz_xor<2>(m)); m = fmaxf(m, swz_xor<1>(m));
            const float e = expf(sc - m);
            float ssum = e;
            ssum += swz_xor<8>(ssum); ssum += swz_xor<4>(ssum); ssum += swz_xor<2>(ssum); ssum += swz_xor<1>(ssum);
            const float p = e / ssum;
            float acc[4] = {0.f, 0.f, 0.f, 0.f};
#pragma unroll
            for (int j = 0; j < 16; ++j) {
                const float pj = __int_as_float(__builtin_amdgcn_readlane(__float_as_int(p), j));
                const uint2 v2 = *(const uint2*)(QKV + (size_t)(b * LL + j) * QKVW + 2048 + h * 256 + lane * 4);
                acc[0] = fmaf(pj, __uint_as_float(v2.x << 16), acc[0]); acc[1] = fmaf(pj, __uint_as_float(v2.x & 0xffff0000u), acc[1]);
                acc[2] = fmaf(pj, __uint_as_float(v2.y << 16), acc[2]); acc[3] = fmaf(pj, __uint_as_float(v2.y & 0xffff0000u), acc[3]);
            }
            bf16_t* o = OC + (size_t)(b * LL + row) * DM + h * 512 + i * 256 + lane * 4;
            { uint2 w; w.x = pg8::cvt_pk_bf16(acc[0], acc[1]); w.y = pg8::cvt_pk_bf16(acc[2], acc[3]); *(uint2*)o = w; }
        }
    }
}


namespace hg {
using bf16x8 = __attribute__((ext_vector_type(8))) short;
using s16x4  = __attribute__((ext_vector_type(4))) short;
using f32x16 = __attribute__((ext_vector_type(16))) float;
using u32x4  = __attribute__((ext_vector_type(4))) unsigned;
constexpr int NCH = 33, NU = 16 * NCH;
constexpr int SK = 136;
constexpr int SS = 72;
__device__ __forceinline__ int crow(int r, int hi) { return (r & 3) + 8 * (r >> 2) + 4 * hi; }
__device__ __forceinline__ unsigned cvtpk(float lo, float hi) { unsigned r; asm volatile("v_cvt_pk_bf16_f32 %0, %1, %2" : "=v"(r) : "v"(lo), "v"(hi)); return r; }

__device__ __forceinline__ void prep(const float (&fpv)[16], float lbv, int c, int k, int tq, float* qsum, float (&b)[16], float (&kk)[16], float& bend, float& r) {
    float run = 0.f;
#pragma unroll
    for (int i = 0; i < 16; ++i) {
        const int t = 16 * tq + i; const bool valid = (c * 64 + t) < LL;
        const float kv = valid ? (1.f - lbv) * __builtin_amdgcn_rcpf(1.f + __expf(fpv[i])) : 0.f;
        kk[i] = kv; run += fmaxf(__logf(1.f - kv), -30.f); b[i] = run;
    }
    qsum[tq * 128 + k] = run;
    __syncthreads();
    const float q0 = qsum[k], q1 = qsum[128 + k], q2 = qsum[256 + k], q3 = qsum[384 + k];
    const float off = tq == 0 ? 0.f : (tq == 1 ? q0 : (tq == 2 ? q0 + q1 : q0 + q1 + q2));
    r = q0 + q1; bend = (q0 + q1) + (q2 + q3);
#pragma unroll
    for (int i = 0; i < 16; ++i) b[i] += off;
}
__device__ __forceinline__ void store16(bf16_t* dst, const float (&x)[16]) {
    u32x4 w0, w1;
    w0.x = cvtpk(x[0], x[1]); w0.y = cvtpk(x[2], x[3]); w0.z = cvtpk(x[4], x[5]); w0.w = cvtpk(x[6], x[7]);
    w1.x = cvtpk(x[8], x[9]); w1.y = cvtpk(x[10], x[11]); w1.z = cvtpk(x[12], x[13]); w1.w = cvtpk(x[14], x[15]);
    *(u32x4*)dst = w0; *(u32x4*)(dst + 8) = w1;
}

__device__ __forceinline__ void local_states(KP P, char* lds, int layer) {
    bf16_t* KhT = (bf16_t*)lds; bf16_t* VT = KhT + 128 * SS; float* qsum = (float*)(VT + 128 * SS);
    const float* PA = P->PA; const float* lbtab = P->lbtab + layer * 512; float* SLOC = P->SLOC; float* DEC = P->DEC;
    const int tid = tid_(), k = tid & 127, tq = tid >> 7, lane = tid & 63, wid = tid >> 6, r32 = lane & 31, hh = lane >> 5;
    for (int u = bid_(); u < NU; u += gridDim.x) {
        const int bh = u / NCH, c = u % NCH, b_ = bh >> 2, h = bh & 3; const size_t row0 = (size_t)b_ * LL + c * 64;
        float fpv[16], vv[16];
#pragma unroll
        for (int i = 0; i < 16; ++i) { const int t = 16 * tq + i; const bool valid = (c * 64 + t) < LL; const float* rp = PA + (row0 + (valid ? t : 0)) * PAW + h * 128 + k;
            fpv[i] = rp[512]; vv[i] = valid ? rp[1024] : 0.f; }
        float b[16], kk[16], bend, r;
        prep(fpv, lbtab[h * 128 + k], c, k, tq, qsum, b, kk, bend, r);
        float x[16];
#pragma unroll
        for (int i = 0; i < 16; ++i) x[i] = kk[i] * __expf(bend - b[i]);
        store16(KhT + k * SS + 16 * tq, x);
        store16(VT + k * SS + 16 * tq, vv);
        if (tq == 0) DEC[u * 128 + k] = __expf(bend);
        __syncthreads();
        const int vt = wid >> 1;
#pragma unroll
        for (int j = 0; j < 2; ++j) {
            const int kt = (wid & 1) * 2 + j;
            f32x16 acc = {};
#pragma unroll
            for (int sg = 0; sg < 4; ++sg) {
                const bf16x8 a = *(const bf16x8*)(VT + (vt * 32 + r32) * SS + sg * 16 + hh * 8);
                const bf16x8 bb = *(const bf16x8*)(KhT + (kt * 32 + r32) * SS + sg * 16 + hh * 8);
                acc = __builtin_amdgcn_mfma_f32_32x32x16_bf16(a, bb, acc, 0, 0, 0);
            }
            float* o = SLOC + (size_t)u * 16384 + kt * 32 + r32;
#pragma unroll
            for (int rg = 0; rg < 16; ++rg) o[(vt * 32 + crow(rg, hh)) * 128] = acc[rg];
        }
        __syncthreads();
    }
}
__device__ __forceinline__ void scan_states(KP P) {
    const float* SLOC = P->SLOC; const float* DEC = P->DEC; bf16_t* SPREV = P->SPREV;
    const int tid = tid_();
    for (int e = bid_() * NTHR + tid; e < 16 * 16384; e += gridDim.x * NTHR) {
        const int bh = e >> 14, vk = e & 16383, k = vk & 127;
        float d[NCH - 1], x[NCH - 1];
#pragma unroll
        for (int c = 0; c < NCH - 1; ++c) { const int u = bh * NCH + c; d[c] = DEC[u * 128 + k]; x[c] = SLOC[(size_t)u * 16384 + vk]; }
        float S = 0.f;
#pragma unroll
        for (int c = 0; c < NCH - 1; ++c) { S = fmaf(d[c], S, x[c]); SPREV[(size_t)(bh * NCH + c + 1) * 16384 + vk] = f2bf(S); }
    }
}
__device__ __forceinline__ void outputs(KP P, char* lds, int layer) {
    bf16_t* Qt = (bf16_t*)lds; bf16_t* Qh = Qt + 64 * SK; bf16_t* Kt = Qh + 64 * SK; bf16_t* VT = Kt + 64 * SK; bf16_t* SpT = VT + 128 * SS;
    float* qsum = (float*)(SpT + 128 * SK); float* part = qsum + 512;
    const float* PA = P->PA; const float* lbtab = P->lbtab + layer * 512; const bf16_t* SPREV = P->SPREV; const float* nw = P->hnw + layer * 128; bf16_t* MIX = P->MIX;
    const int tid = tid_(), k = tid & 127, tq = tid >> 7, lane = tid & 63, wid = tid >> 6, r32 = lane & 31, hh = lane >> 5;
    for (int u = bid_(); u < NU; u += gridDim.x) {
        const int bh = u / NCH, c = u % NCH, b_ = bh >> 2, h = bh & 3; const size_t row0 = (size_t)b_ * LL + c * 64;
        const int tt = wid & 1, vt = wid >> 1;
        float fpv[16], qv[16], vv[16]; u32x4 sp[4]; float4 gv[4];
#pragma unroll
        for (int i = 0; i < 16; ++i) { const int t = 16 * tq + i; const bool valid = (c * 64 + t) < LL; const float* rp = PA + (row0 + (valid ? t : 0)) * PAW + h * 128 + k;
            fpv[i] = rp[512]; qv[i] = valid ? rp[0] : 0.f; vv[i] = valid ? rp[1024] : 0.f; }
#pragma unroll
        for (int j = 0; j < 4; ++j) { const int idx = tid + 512 * j, v = idx >> 4, ch = idx & 15; sp[j] = *(const u32x4*)(SPREV + (size_t)(c > 0 ? u : u + 1) * 16384 + v * 128 + ch * 8); }
        { const int te = tt * 32 + r32; const float* gp = PA + (row0 + ((c * 64 + te) < LL ? te : 0)) * PAW + 1536 + h * 128 + vt * 32 + 4 * hh;
#pragma unroll
          for (int g4 = 0; g4 < 4; ++g4) gv[g4] = *(const float4*)(gp + 8 * g4); }
        float b[16], kk[16], bend, r;
        prep(fpv, lbtab[h * 128 + k], c, k, tq, qsum, b, kk, bend, r);
#pragma unroll
        for (int i = 0; i < 16; ++i) { const int t = 16 * tq + i; const float q = qv[i];
            Qt[t * SK + k] = f2bf(q * __expf(b[i] - r)); Qh[t * SK + k] = f2bf(q * __expf(b[i])); Kt[t * SK + k] = f2bf(kk[i] * __expf(r - b[i])); }
        store16(VT + k * SS + 16 * tq, vv);
        if (c > 0) {
#pragma unroll
            for (int j = 0; j < 4; ++j) { const int idx = tid + 512 * j, v = idx >> 4, ch = idx & 15; *(u32x4*)(SpT + v * SK + ch * 8) = sp[j]; }
        }
        __syncthreads();
        f32x16 oacc = {};
#pragma unroll
        for (int st = 0; st < 2; ++st) {
            if (st <= tt) {
                f32x16 sc = {};
#pragma unroll
                for (int d0 = 0; d0 < 8; ++d0) {
                    const bf16x8 a = *(const bf16x8*)(Kt + (st * 32 + r32) * SK + d0 * 16 + hh * 8);
                    const bf16x8 bq = *(const bf16x8*)(Qt + (tt * 32 + r32) * SK + d0 * 16 + hh * 8);
                    sc = __builtin_amdgcn_mfma_f32_32x32x16_bf16(a, bq, sc, 0, 0, 0);
                }
                if (st == tt) {
#pragma unroll
                    for (int rg = 0; rg < 16; ++rg) sc[rg] = (crow(rg, hh) <= r32) ? sc[rg] : 0.f;
                }
#pragma unroll
                for (int g = 0; g < 2; ++g) {
                    u32x4 w; w.x = cvtpk(sc[8 * g + 0], sc[8 * g + 1]); w.y = cvtpk(sc[8 * g + 2], sc[8 * g + 3]); w.z = cvtpk(sc[8 * g + 4], sc[8 * g + 5]); w.w = cvtpk(sc[8 * g + 6], sc[8 * g + 7]);
                    const bf16x8 pb = *reinterpret_cast<bf16x8*>(&w);
                    const bf16_t* vp = VT + (vt * 32 + r32) * SS + st * 32 + 16 * g + 4 * hh;
                    const s16x4 lo = *(const s16x4*)vp, hi4 = *(const s16x4*)(vp + 8);
                    const bf16x8 a = (bf16x8){lo[0], lo[1], lo[2], lo[3], hi4[0], hi4[1], hi4[2], hi4[3]};
                    oacc = __builtin_amdgcn_mfma_f32_32x32x16_bf16(a, pb, oacc, 0, 0, 0);
                }
            }
        }
        if (c > 0) {
#pragma unroll
            for (int d0 = 0; d0 < 8; ++d0) {
                const bf16x8 a = *(const bf16x8*)(SpT + (vt * 32 + r32) * SK + d0 * 16 + hh * 8);
                const bf16x8 bq = *(const bf16x8*)(Qh + (tt * 32 + r32) * SK + d0 * 16 + hh * 8);
                oacc = __builtin_amdgcn_mfma_f32_32x32x16_bf16(a, bq, oacc, 0, 0, 0);
            }
        }
        float ss = 0.f;
#pragma unroll
        for (int rg = 0; rg < 16; ++rg) ss = fmaf(oacc[rg], oacc[rg], ss);
        { auto rr = __builtin_amdgcn_permlane32_swap(__float_as_uint(ss), __float_as_uint(ss), false, false); ss = __uint_as_float(rr[0]) + __uint_as_float(rr[1]); }
        if (hh == 0) part[vt * 64 + tt * 32 + r32] = ss;
        __syncthreads();
        const int t = tt * 32 + r32;
        const float tot = (part[t] + part[64 + t]) + (part[128 + t] + part[192 + t]);
        const float scale = rsqrtf(tot * (1.f / 128.f) + EPS);
        if ((c * 64 + t) < LL) {
            bf16_t* op = MIX + (row0 + t) * DM + h * 128 + vt * 32;
#pragma unroll
            for (int g4 = 0; g4 < 4; ++g4) {
                const int v0 = 8 * g4 + 4 * hh;
                const float4 gg = gv[g4]; const float4 wv = *(const float4*)(nw + vt * 32 + v0);
                const float y0 = oacc[4 * g4 + 0] * scale * wv.x * gg.x / (1.f + __expf(-gg.x)), y1 = oacc[4 * g4 + 1] * scale * wv.y * gg.y / (1.f + __expf(-gg.y));
                const float y2 = oacc[4 * g4 + 2] * scale * wv.z * gg.z / (1.f + __expf(-gg.z)), y3 = oacc[4 * g4 + 3] * scale * wv.w * gg.w / (1.f + __expf(-gg.w));
                uint2 w; w.x = cvtpk(y0, y1); w.y = cvtpk(y2, y3);
                *(uint2*)(op + v0) = w;
            }
        }
        __syncthreads();
    }
}
}


__device__ __forceinline__ float wave_sum(float v) {
    v += swz_xor<1>(v); v += swz_xor<2>(v); v += swz_xor<4>(v); v += swz_xor<8>(v); v += swz_xor<16>(v);
    { auto rr = __builtin_amdgcn_permlane32_swap(__float_as_uint(v), __float_as_uint(v), false, false); v = __uint_as_float(rr[0]) + __uint_as_float(rr[1]); }
    return v;
}
namespace moe {
using bf16x8 = __attribute__((ext_vector_type(8))) short;
using f32x16 = __attribute__((ext_vector_type(16))) float;
using u32x4  = __attribute__((ext_vector_type(4))) unsigned;
using f32x4_ = __attribute__((ext_vector_type(4))) float;
constexpr int TW = 5, PROWS = 64 * TW, XS = 128, XBUF = PROWS * XS;
__device__ __forceinline__ unsigned cvtpk(float lo, float hi) { unsigned r; asm volatile("v_cvt_pk_bf16_f32 %0, %1, %2" : "=v"(r) : "v"(lo), "v"(hi)); return r; }
#define MOE_BAR() asm volatile("s_waitcnt lgkmcnt(0)\n\ts_barrier" ::: "memory")
constexpr int WD = 2;
constexpr int ABUF = 4 * 4 * 1024, AOFF = 3 * XBUF, LOFF = AOFF + 2 * ABUF;
template <bool UP>
__device__ __forceinline__ void stream_gemm(KP P, char* lds, int layer) {
    constexpr int KTOT = UP ? DM : DE, NSLAB = KTOT / 64, NCP = UP ? 2 : 4, LDW = UP ? DE : DM, CPSTRIDE = UP ? 64 : 128;
    constexpr int XQD = 2;
    constexpr int WD = 4;
    static_assert(NSLAB % WD == 0 && NSLAB >= 2 * WD, "slab loop is unrolled by WD");
    constexpr int NW = 4;
    const int tid = tid_(), lane = tid & 63, wid = tid >> 6, r32 = lane & 31, hh = lane >> 5, cg = wid & 3, th = wid >> 2;
    const int* cnt_ = P->cnt;
    const bf16_t* X = UP ? P->HN : P->H;
    int* basel = (int*)(lds + LOFF); int* tlist = basel + 64; float* rsl = (float*)(basel + 64 + 320 + 64);
    for (int ub = bid_(); ub < 256; ub += gridDim.x) {
        const int u = ((ub & 7) << 5) | (ub >> 3);
        const int e = u >> 2, ns = u & 3;
        const int rot = ((u >> 2) * 11) & (NSLAB - 1);
        __syncthreads();
        const int eu = __builtin_amdgcn_readfirstlane(e);
        const int cl_ = cnt_[lane * CSTR];
        const int row0 = (int)wave_sum(lane < eu ? (float)cl_ : 0.f), cnt = __builtin_amdgcn_readlane(cl_, eu);
        for (int pass0 = 0; pass0 < cnt; pass0 += PROWS) {
            const int cntp = (cnt - pass0) < PROWS ? (cnt - pass0) : PROWS;
            if constexpr (UP) { if (cnt <= ECAP) {
                __syncthreads();
                if (tid < PROWS && pass0 + tid < cnt) { tlist[tid] = P->elist[e * ECAP + pass0 + tid]; rsl[tid] = P->ers[e * ECAP + pass0 + tid]; }
                __syncthreads();
              } else {
                __syncthreads();
                const int* ridx = P->ridx; const int* rslot = P->rslot;
#pragma unroll 1
                for (int i0 = tid; i0 < NASSIGN; i0 += NTHR * 8) {
                    int ex[8], sl[8];
#pragma unroll
                    for (int q = 0; q < 8; ++q) { const int i = i0 + NTHR * q; ex[q] = i < NASSIGN ? ridx[i] : -1; sl[q] = i < NASSIGN ? rslot[i] : 0; }
#pragma unroll
                    for (int q = 0; q < 8; ++q) { const int sp = sl[q] - pass0; if (ex[q] == e && sp >= 0 && sp < PROWS) { tlist[sp] = (i0 + NTHR * q) >> 1; rsl[sp] = P->rsn[(i0 + NTHR * q) >> 1]; } }
                }
                __syncthreads();
            } }
            int xoff[5];
#pragma unroll
            for (int j = 0; j < 5; ++j) { int rho = (tid >> 3) + 64 * j; const bool pad = rho >= cntp; rho = pad ? cntp - 1 : rho; const int grow = row0 + pass0 + rho;
                xoff[j] = (UP ? (pad ? TOK : tlist[rho]) * DM : (pad ? NRMAX - 1 : grow) * DE) + ((tid & 7) ^ ((tid >> 4) & 7)) * 8; }
            const int xdma = __builtin_amdgcn_readfirstlane(wid) * 8 * XS;
            int xrd[4];
#pragma unroll
            for (int kk = 0; kk < 4; ++kk) xrd[kk] = (th * TW * 32 + r32) * XS + (((2 * kk + hh) ^ ((r32 >> 1) & 7)) << 4);
            const unsigned ldsb = (unsigned)(size_t)(LAS char*)lds;
            int xb0 = 0, xb1 = XBUF, xb2 = 2 * XBUF;
            char* const aw = lds + AOFF + (cg * 4 + 2 * th) * 1024 + lane * 16;
            const char* const ar = lds + AOFF + cg * 4 * 1024 + lane * 16;
            float wreg[WD][16];
#pragma unroll 1
            for (int cp = 0; cp < NCP; ++cp) {
                const int cgi = cp * 4 + cg;
                const int kkw = wid >> 1, half = wid & 1;
                const float* wp;
                if constexpr (UP) wp = (r32 < 16 ? P->w1 : P->w3) + ((size_t)(layer * NE + e) * DM + kkw * 16 + 8 * hh + 4 * half) * DE + ns * 128 + cp * 64 + 4 * (r32 & 15);
                else wp = P->w2 + ((size_t)(layer * NE + e) * DE + 4 * (8 * hh + 4 * half) + kkw) * DM + ns * 512 + cp * 128 + 4 * r32;
                f32x16 acc[TW];
#pragma unroll
                for (int tl = 0; tl < TW; ++tl) acc[tl] = f32x16{};
#define MOE_WLD1(wn_, R, li) do { if ((li) < 4) { f32x4_ t_; asm volatile("global_load_dwordx4 %0, %1, off" : "=v"(t_) : "v"((wn_) + (size_t)(li) * (UP ? DE : 4 * DM))); wreg[R][4 * (li)] = t_[0]; wreg[R][4 * (li) + 1] = t_[1]; wreg[R][4 * (li) + 2] = t_[2]; wreg[R][4 * (li) + 3] = t_[3]; } } while (0)
#define MOE_WLOAD(slab, R) do { const float* wn_ = wp + (size_t)(((slab) + rot) & (NSLAB - 1)) * 64 * LDW; \
                    _Pragma("unroll") for (int li = 0; li < 16; ++li) MOE_WLD1(wn_, R, li); } while (0)
#define MOE_WPARK(R, PAR) do { _Pragma("unroll") for (int q = 0; q < 4; ++q) { uint2 fw; fw.x = cvtpk(wreg[R][q], wreg[R][4 + q]); fw.y = cvtpk(wreg[R][8 + q], wreg[R][12 + q]); \
                            *(uint2*)(lds + AOFF + (PAR) * ABUF + (q * 4 + kkw) * 1024 + lane * 16 + half * 8) = fw; } } while (0)
#define MOE_XDMA(slab, bo) do { const bf16_t* xn0_ = X + ((((slab) & (NSLAB - 1)) + rot) & (NSLAB - 1)) * 64; \
                    _Pragma("unroll") for (int j = 0; j < TW; ++j) { const unsigned la_ = ldsb + (unsigned)((bo) + xdma + 64 * j * XS); const bf16_t* gp_ = xn0_ + xoff[j]; \
                        asm volatile("s_mov_b32 m0, %1\n\ts_nop 0\n\tglobal_load_lds_dwordx4 %0, off" :: "v"(gp_), "s"(la_) : "memory", "m0"); } } while (0)
                if (cp == 0) {
                    xb0 = 0; xb1 = XBUF; xb2 = 2 * XBUF;
                    MOE_XDMA(0, xb0); MOE_XDMA(1, xb1);
                    MOE_WLOAD(0, 0); MOE_WLOAD(1, 1); if constexpr (WD == 4) { MOE_WLOAD(2, 2); MOE_WLOAD(3, 3); }
                    asm volatile("s_waitcnt vmcnt(%0)" :: "n"((WD - 1) * NW) : "memory");
                    MOE_WPARK(0, 0); MOE_WLOAD(WD, 0);
                    asm volatile("s_waitcnt vmcnt(%0)" :: "n"((WD - 1) * NW) : "memory");
                    MOE_BAR();
                }
#define MOE_SLAB(s, PAR, R1) do { \
                    const int swr = (s) + 1 + WD; const bool wnext = swr >= NSLAB && cp + 1 < NCP;     \
                    const int sw = swr < NSLAB ? swr : (wnext ? swr - NSLAB : NSLAB - 1); \
                    asm volatile("s_waitcnt vmcnt(%0)" :: "n"((WD - 1) * (TW + NW)) : "memory");        \
                    MOE_WPARK(R1, 1 - (PAR)); \
                    MOE_XDMA((s) + 2, xb2);                                                           \
                    const float* wn_ = wp + (wnext ? CPSTRIDE : 0) + (size_t)((sw + rot) & (NSLAB - 1)) * 64 * LDW; \
                    const char* xk0 = lds + xb0 + xrd[0]; const char* xk1 = lds + xb0 + xrd[1]; const char* xk2 = lds + xb0 + xrd[2]; const char* xk3 = lds + xb0 + xrd[3]; \
                    bf16x8 xq[XQD + 1]; bf16x8 fq[2];                                                       \
                    xq[0] = *(const bf16x8*)(xk0); xq[1] = *(const bf16x8*)(xk0 + 32 * XS); if constexpr (XQD == 3) xq[2] = *(const bf16x8*)(xk0 + 64 * XS); \
                    fq[0] = *(const bf16x8*)(ar + (PAR) * ABUF); \
                    _Pragma("unroll") for (int kk = 0; kk < 4; ++kk) { \
                        if (kk < 3) fq[(kk + 1) & 1] = *(const bf16x8*)(ar + (PAR) * ABUF + (kk + 1) * 1024); \
                        _Pragma("unroll") for (int tl = 0; tl < TW; ++tl) { \
                            const int cur = kk * TW + tl, nx = cur + XQD, nkk = nx / TW, ntl = nx % TW;       \
                            if (nx < 4 * TW) xq[nx % (XQD + 1)] = *(const bf16x8*)((nkk == 0 ? xk0 : nkk == 1 ? xk1 : nkk == 2 ? xk2 : xk3) + ntl * 32 * XS); \
                            acc[tl] = __builtin_amdgcn_mfma_f32_32x32x16_bf16(fq[kk & 1], xq[cur % (XQD + 1)], acc[tl], 0, 0, 0); \
                            const int li = kk * TW + tl; \
                            MOE_WLD1(wn_, R1, li); \
                            __builtin_amdgcn_sched_barrier(0); } } \
                    asm volatile("s_waitcnt vmcnt(%0)" :: "n"(2 * NW + TW) : "memory");     \
                    MOE_BAR(); \
                    { const int t_ = xb0; xb0 = xb1; xb1 = xb2; xb2 = t_; } } while (0)
#pragma unroll 1
                for (int s = 0; s < NSLAB; s += 4) { if constexpr (WD == 2) { MOE_SLAB(s, 0, 1); MOE_SLAB(s + 1, 1, 0); MOE_SLAB(s + 2, 0, 1); MOE_SLAB(s + 3, 1, 0); }
                    else { MOE_SLAB(s, 0, 1); MOE_SLAB(s + 1, 1, 2); MOE_SLAB(s + 2, 0, 3); MOE_SLAB(s + 3, 1, 0); } }
#undef MOE_SLAB
#undef MOE_WLOAD
#undef MOE_WLD1
#undef MOE_WPARK
#undef MOE_XDMA
                const int T = (cntp + 31) >> 5;
                const int Tw = (T - TW * th) < 0 ? 0 : ((T - TW * th) > TW ? TW : (T - TW * th));
#pragma unroll
                for (int tl = 0; tl < TW; ++tl) if (tl < Tw) {
                    const int rho = (th * TW + tl) * 32 + r32;
                    if (rho < cntp) {
                        const size_t grow = (size_t)(row0 + pass0 + rho);
                        if constexpr (UP) {
                            bf16_t* hp = P->H + grow * DE + ns * 128 + cgi * 16 + 4 * hh; const float rs = rsl[rho];
#pragma unroll
                            for (int g = 0; g < 2; ++g) {
                                float y[4];
#pragma unroll
                                for (int q = 0; q < 4; ++q) { const float a = acc[tl][4 * g + q] * rs, b = acc[tl][8 + 4 * g + q] * rs; y[q] = a / (1.f + __expf(-a)) * b; }
                                uint2 w; w.x = cvtpk(y[0], y[1]); w.y = cvtpk(y[2], y[3]);
                                *(uint2*)(hp + 8 * g) = w;
                            }
                        } else {
                            bf16_t* yp = P->Y + grow * DM + ns * 512 + cgi * 32 + 4 * hh;
#pragma unroll
                            for (int g = 0; g < 4; ++g) {
                                uint2 w; w.x = cvtpk(acc[tl][4 * g + 0], acc[tl][4 * g + 1]); w.y = cvtpk(acc[tl][4 * g + 2], acc[tl][4 * g + 3]);
                                *(uint2*)(yp + 8 * g) = w;
                            }
                        }
                    }
                }
            }
            asm volatile("s_waitcnt vmcnt(0)" ::: "memory");
            __syncthreads();
        }
    }
}
#undef MOE_BAR
}


namespace s5 {
using bf16x8 = __attribute__((ext_vector_type(8))) short;
using f32x16 = __attribute__((ext_vector_type(16))) float;
using u32x4  = __attribute__((ext_vector_type(4))) unsigned;
constexpr int NCHK = 516, NMT = 17;
__device__ __forceinline__ unsigned cvtpk(float lo, float hi) { unsigned r; asm volatile("v_cvt_pk_bf16_f32 %0, %1, %2" : "=v"(r) : "v"(lo), "v"(hi)); return r; }
__device__ __forceinline__ bf16x8 ld8f(const float* p) {
    const float4 a = *(const float4*)p, b = *(const float4*)(p + 4);
    u32x4 w; w.x = cvtpk(a.x, a.y); w.y = cvtpk(a.z, a.w); w.z = cvtpk(b.x, b.y); w.w = cvtpk(b.z, b.w);
    return *reinterpret_cast<bf16x8*>(&w);
}
__device__ __forceinline__ void prep_unit(KP P, char* lds, int layer, int g) {
    float2* pw = (float2*)lds; float2* bb = pw + 17 * 64; float2* cc = bb + 1024; float* kd = (float*)(cc + 1024);
    const int tid = tid_();
    const float dt = expf(P->log_dt[layer * 32 + g]);
    const float* a_re = P->a_re + (layer * 32 + g) * 64; const float* a_im = P->a_im + (layer * 32 + g) * 64;
    for (int idx = tid; idx < 17 * 64; idx += NTHR) { const int d = idx >> 6, p = idx & 63;
        const float mag = expf(a_re[p] * dt * (float)d), ang = a_im[p] * dt * (float)d; pw[idx] = make_float2(mag * cosf(ang), mag * sinf(ang)); }
    for (int idx = tid; idx < 1024; idx += NTHR) {
        { const int p = idx >> 4, c = idx & 15; const float are = a_re[p], aim = a_im[p];
          const float mag = expf(are * dt), abr = mag * cosf(aim * dt), abi = mag * sinf(aim * dt), den = are * are + aim * aim;
          const float zr = ((abr - 1.f) * are + abi * aim) / den, zi = (abi * are - (abr - 1.f) * aim) / den;
          const float br = P->b_re[((layer * 32 + g) * 64 + p) * 16 + c], bi = P->b_im[((layer * 32 + g) * 64 + p) * 16 + c];
          bb[idx] = make_float2(zr * br - zi * bi, zr * bi + zi * br); }
        { const int c = idx >> 6, p = idx & 63; cc[idx] = make_float2(P->c_re[((layer * 32 + g) * 16 + c) * 64 + p], P->c_im[((layer * 32 + g) * 16 + c) * 64 + p]); }
    }
    __syncthreads();
    if (tid < 64) ((float2*)P->A16)[(layer * 32 + g) * 64 + tid] = pw[16 * 64 + tid];
    for (int idx = tid; idx < 4096; idx += NTHR) { const int d = idx >> 8, c = (idx >> 4) & 15, c2 = idx & 15;
        float acc = 0.f;
        for (int p = 0; p < 64; ++p) { const float2 C = cc[c * 64 + p], W = pw[d * 64 + p], B = bb[p * 16 + c2];
            const float xr = C.x * W.x - C.y * W.y, xi = C.x * W.y + C.y * W.x; acc += xr * B.x - xi * B.y; }
        if (d == 0 && c == c2) acc += P->s5d[layer * 512 + g * 16 + c];
        kd[idx] = acc; }
    __syncthreads();
    bf16_t* BtY = P->BtY + (size_t)(layer * 32 + g) * 256 * 384; bf16_t* BtE = P->BtE + (size_t)(layer * 32 + g) * 128 * 256;
    for (int idx = tid; idx < 256 * 48; idx += NTHR) { const int n = idx / 48, ch = idx % 48, t = n >> 4, c = n & 15;
        float v[8];
        if (ch < 32) { const int s = ch >> 1, c0 = (ch & 1) * 8;
#pragma unroll
            for (int jj = 0; jj < 8; ++jj) v[jj] = (s <= t) ? kd[((t - s) * 16 + c) * 16 + c0 + jj] : 0.f;
        } else {
#pragma unroll
            for (int jj = 0; jj < 8; ++jj) { const int kq = (ch - 32) * 8 + jj, p = kq >> 1; const float2 C = cc[c * 64 + p], W = pw[(t + 1) * 64 + p];
                v[jj] = (kq & 1) ? -(C.x * W.y + C.y * W.x) : (C.x * W.x - C.y * W.y); }
        }
        u32x4 w; w.x = cvtpk(v[0], v[1]); w.y = cvtpk(v[2], v[3]); w.z = cvtpk(v[4], v[5]); w.w = cvtpk(v[6], v[7]);
        *(u32x4*)(BtY + ((size_t)(((n >> 5) * 24 + (ch >> 1)) * 64 + (ch & 1) * 32 + (n & 31))) * 8) = w; }
    for (int idx = tid; idx < 128 * 32; idx += NTHR) { const int n = idx >> 5, ch = idx & 31, p = n >> 1, s = ch >> 1, c0 = (ch & 1) * 8;
        const float2 W = pw[(15 - s) * 64 + p];
        float v[8];
#pragma unroll
        for (int jj = 0; jj < 8; ++jj) { const float2 B = bb[p * 16 + c0 + jj]; v[jj] = (n & 1) ? (W.x * B.y + W.y * B.x) : (W.x * B.x - W.y * B.y); }
        u32x4 w; w.x = cvtpk(v[0], v[1]); w.y = cvtpk(v[2], v[3]); w.z = cvtpk(v[4], v[5]); w.w = cvtpk(v[6], v[7]);
        *(u32x4*)(BtE + ((size_t)(((n >> 5) * 16 + (ch >> 1)) * 64 + (ch & 1) * 32 + (n & 31))) * 8) = w; }
    __syncthreads();
}
__device__ __forceinline__ float gelu_t(float x) { const float u = 0.7978845608028654f * (x + 0.044715f * x * x * x); const float e = __expf(2.f * u); return x - x / (e + 1.f); }
__device__ __forceinline__ void fused_unit(KP P, char* lds, int layer, int b, int g) {
    const int tid = tid_(), lane = tid & 63, wid = tid >> 6, r32 = lane & 31, hh = lane >> 5;
    constexpr int UCH = 528, UBYTES = 68352;
    char* U16 = lds; float* El = (float*)(lds + UBYTES);
    const float* PA = P->PA; bf16_t* YG = P->YG;
    { const float* ub = PA + (size_t)(b * LL) * PAW + 2048 + g * 16;
#pragma unroll 1
      for (int i0 = 0; i0 < LL * 4; i0 += NTHR * 4) {
          float4 v[4];
#pragma unroll
          for (int q = 0; q < 4; ++q) { const int idx = i0 + q * NTHR + tid, ic = idx < LL * 4 ? idx : LL * 4 - 1; v[q] = *(const float4*)(ub + (size_t)(ic >> 2) * PAW + (ic & 3) * 4); }
#pragma unroll
          for (int q = 0; q < 4; ++q) { const int idx = i0 + q * NTHR + tid; if (idx < LL * 4) { const int r = idx >> 2;
              uint2 w; w.x = cvtpk(v[q].x, v[q].y); w.y = cvtpk(v[q].z, v[q].w); *(uint2*)(U16 + (r >> 4) * UCH + (r & 15) * 32 + (idx & 3) * 8) = w; } }
      } }
    __syncthreads();
    int mrow[5];
#pragma unroll
    for (int mt = 0; mt < 5; ++mt) { const int m = mt * 32 + r32; mrow[mt] = m < 129 ? m : 128; }
    if (wid < 4) {
        const bf16_t* Bt = P->BtE + (size_t)(layer * 32 + g) * 128 * 256 + ((size_t)(wid * 16) * 64 + lane) * 8;
        f32x16 acc[5];
#pragma unroll
        for (int mt = 0; mt < 5; ++mt) acc[mt] = f32x16{};
#pragma unroll 4
        for (int s = 0; s < 16; ++s) {
            const bf16x8 af = *(const bf16x8*)(Bt + (size_t)(s * 64) * 8);
#pragma unroll
            for (int mt = 0; mt < 5; ++mt) { const bf16x8 bf = *(const bf16x8*)(U16 + mrow[mt] * UCH + hh * 16 + 32 * s); acc[mt] = __builtin_amdgcn_mfma_f32_32x32x16_bf16(af, bf, acc[mt], 0, 0, 0); }
        }
#pragma unroll
        for (int mt = 0; mt < 5; ++mt) { const int m = mt * 32 + r32; if (m < 129) { float* ep = El + m * 128 + wid * 32 + 4 * hh;
#pragma unroll
            for (int q = 0; q < 4; ++q) *(float4*)(ep + 8 * q) = make_float4(acc[mt][4 * q], acc[mt][4 * q + 1], acc[mt][4 * q + 2], acc[mt][4 * q + 3]); } }
    }
    __syncthreads();
    if (tid < 64) {
        const float2 A = ((const float2*)P->A16)[(layer * 32 + g) * 64 + tid];
        float2* e2 = (float2*)El + tid;
        float xr = 0.f, xi = 0.f;
#pragma unroll 1
        for (int j0 = 0; j0 < 128; j0 += 8) {
            float2 e[8];
#pragma unroll
            for (int i = 0; i < 8; ++i) e[i] = e2[(j0 + i) * 64];
#pragma unroll
            for (int i = 0; i < 8; ++i) { e2[(j0 + i) * 64] = make_float2(xr, xi);
                const float nr = A.x * xr - A.y * xi + e[i].x, ni = A.x * xi + A.y * xr + e[i].y; xr = nr; xi = ni; }
        }
        e2[128 * 64] = make_float2(xr, xi);
    }
    __syncthreads();
    {
        const bf16_t* Bt = P->BtY + (size_t)(layer * 32 + g) * 256 * 384 + ((size_t)(wid * 24) * 64 + lane) * 8;
        f32x16 acc[5];
#pragma unroll
        for (int mt = 0; mt < 5; ++mt) acc[mt] = f32x16{};
#pragma unroll 4
        for (int s = 0; s < 16; ++s) if (2 * wid + 1 >= s) {
            const bf16x8 af = *(const bf16x8*)(Bt + (size_t)(s * 64) * 8);
#pragma unroll
            for (int mt = 0; mt < 5; ++mt) { const bf16x8 bf = *(const bf16x8*)(U16 + mrow[mt] * UCH + hh * 16 + 32 * s); acc[mt] = __builtin_amdgcn_mfma_f32_32x32x16_bf16(af, bf, acc[mt], 0, 0, 0); }
        }
#pragma unroll 4
        for (int ks = 0; ks < 8; ++ks) {
            const bf16x8 af = *(const bf16x8*)(Bt + (size_t)((16 + ks) * 64) * 8);
#pragma unroll
            for (int mt = 0; mt < 5; ++mt) { const bf16x8 bf = ld8f(El + mrow[mt] * 128 + 8 * hh + ks * 16); acc[mt] = __builtin_amdgcn_mfma_f32_32x32x16_bf16(af, bf, acc[mt], 0, 0, 0); }
        }
#pragma unroll
        for (int mt = 0; mt < 5; ++mt) { const int ml = mt * 32 + r32; if (ml < 129) { const int m = b * 129 + ml;
#pragma unroll
            for (int q = 0; q < 4; ++q) { const int t = 2 * wid + (q >> 1);
                uint2 w; w.x = cvtpk(gelu_t(acc[mt][4 * q]), gelu_t(acc[mt][4 * q + 1])); w.y = cvtpk(gelu_t(acc[mt][4 * q + 2]), gelu_t(acc[mt][4 * q + 3]));
                *(uint2*)(YG + (size_t)(m * 16 + t) * 512 + g * 16 + 8 * (q & 1) + 4 * hh) = w; } } }
    }
    __syncthreads();
}
}

__device__ __forceinline__ unsigned cvtpk_(float lo, float hi) { unsigned r; asm volatile("v_cvt_pk_bf16_f32 %0, %1, %2" : "=v"(r) : "v"(lo), "v"(hi)); return r; }
__device__ __forceinline__ void ph_attn_out(KP P, int layer, int cu0) {
    const int tid = tid_(), lane = tid & 63, gw = (bid_() - cu0) * 8 + (tid >> 6), NGW = (gridDim.x - cu0) * 8;
    if (gw < 0) return;
    const float scale = 1.f - (0.8f - 0.6f * expf(-0.3f * (float)layer));
    const float lam = P->lam[layer];
    const float4 sw = ((const float4*)(P->subln + layer * 256))[lane];
    const bf16_t* OC = (const bf16_t*)P->OC; bf16_t* MIX = P->MIX;
    for (int it0 = gw; it0 < TOK * 4; it0 += NGW * 4) {
        uint2 a[4], b[4];
#pragma unroll
        for (int q = 0; q < 4; ++q) { const int it = it0 + NGW * q, itc = it < TOK * 4 ? it : TOK * 4 - 1, r = itc >> 2, h = itc & 3;
            a[q] = *(const uint2*)(OC + (size_t)r * DM + h * 512 + lane * 4); b[q] = *(const uint2*)(OC + (size_t)r * DM + h * 512 + 256 + lane * 4); }
#pragma unroll
        for (int q = 0; q < 4; ++q) { const int it = it0 + NGW * q; if (it < TOK * 4) { const int r = it >> 2, h = it & 3;
            const float o0 = __uint_as_float(a[q].x << 16) - lam * __uint_as_float(b[q].x << 16), o1 = __uint_as_float(a[q].x & 0xffff0000u) - lam * __uint_as_float(b[q].x & 0xffff0000u);
            const float o2 = __uint_as_float(a[q].y << 16) - lam * __uint_as_float(b[q].y << 16), o3 = __uint_as_float(a[q].y & 0xffff0000u) - lam * __uint_as_float(b[q].y & 0xffff0000u);
            const float ss = wave_sum(o0 * o0 + o1 * o1 + o2 * o2 + o3 * o3);
            const float rs = rsqrtf(ss * (1.f / 256.f) + EPS) * scale;
            uint2 w; w.x = cvtpk_(o0 * rs * sw.x, o1 * rs * sw.y); w.y = cvtpk_(o2 * rs * sw.z, o3 * rs * sw.w);
            *(uint2*)(MIX + (size_t)r * DM + 1024 + h * 256 + lane * 4) = w; } }
    }
}
__device__ __forceinline__ void ph_build_norm(KP P) {
    const int tid = tid_(), lane = tid & 63, gw = bid_() * 8 + (tid >> 6), NGW = gridDim.x * 8;
    for (int r = gw; r < MP; r += NGW) {
        float4 v[8];
        if (r < TOK) { const int b = r / LL, t = r % LL;
            const float4* src = (const float4*)(t < NMETA ? P->meta + (size_t)t * DM : P->x + ((size_t)b * SEQ + (t - NMETA)) * DM);
#pragma unroll
            for (int j = 0; j < 8; ++j) v[j] = src[lane + 64 * j];
        } else {
#pragma unroll
            for (int j = 0; j < 8; ++j) v[j] = make_float4(0.f, 0.f, 0.f, 0.f);
        }
        float ss = 0.f;
#pragma unroll
        for (int j = 0; j < 8; ++j) ss += v[j].x * v[j].x + v[j].y * v[j].y + v[j].z * v[j].z + v[j].w * v[j].w;
        const float rs = rsqrtf(wave_sum(ss) * (1.f / DM) + EPS);
#pragma unroll
        for (int j = 0; j < 8; ++j) { const float4 w = ((const float4*)P->ln1_w)[lane + 64 * j];
            uint2 o; o.x = cvtpk_(v[j].x * rs * w.x, v[j].y * rs * w.y); o.y = cvtpk_(v[j].z * rs * w.z, v[j].w * rs * w.w);
            ((uint2*)(P->HN + (size_t)r * DM))[lane + 64 * j] = o; }
    }
}
__device__ __forceinline__ void ph_prep(KP P) {
    const int tid = tid_();
    if (bid_() == 1 && tid < DE / 2) ((unsigned*)(P->H + (size_t)(NRMAX - 1) * DE))[tid] = 0u;
    if (bid_() == 0) {
        const int c = tid;
        const float l0 = P->lbnd[c], l1 = P->lbnd[512 + c], m = fmaxf(l0, l1), e0 = expf(l0 - m), e1 = expf(l1 - m);
        P->lbtab[c] = 0.f; P->lbtab[512 + c] = e1 / (e0 + e1);
        if (c < 2) {
            float s1 = 0.f, s2 = 0.f;
            for (int i = 0; i < 128; ++i) { s1 += P->lq1[c * 128 + i] * P->lk1[c * 128 + i]; s2 += P->lq2[c * 128 + i] * P->lk2[c * 128 + i]; }
            const float li = 0.8f - 0.6f * expf(-0.3f * (float)c);
            P->lam[c] = expf(s1) - expf(s2) + li;
        }
    }
    for (int i = bid_() * NTHR + tid; i < 2 * 128 * 3 * 64 * 8; i += gridDim.x * NTHR) {
        const int jj = i & 7, ln = (i >> 3) & 63, ct = (i >> 9) % 3, ksg = ((i >> 9) / 3) & 127, layer = (i >> 9) / (3 * 128);
        const int jc = ct * 32 + (ln & 31), k = ksg * 16 + 8 * (ln >> 5) + jj;
        float v = 0.f;
        if (jc < 8) v = P->wrg[((size_t)layer * DM + k) * 8 + jc]; else if (jc < 72) v = P->wre[((size_t)layer * DM + k) * 64 + jc - 8];
        v *= P->ln2_w[layer * DM + k];
        const bf16_t hi = f2bf(v), lo = f2bf(v - bf2f(hi));
        const size_t o = ((size_t)((ksg * 3 + ct) * 64 + ln)) * 8 + jj;
        P->WRT[(size_t)(layer * 2 + 0) * 96 * DM + o] = hi; P->WRT[(size_t)(layer * 2 + 1) * 96 * DM + o] = lo;
    }
}
__device__ __forceinline__ const float* zrow(KP P, int layer, int t) {
    if (layer == 0) { const int b = t / LL, tt = t - b * LL; return tt < NMETA ? P->meta + (size_t)tt * DM : P->x + ((size_t)b * SEQ + (tt - NMETA)) * DM; }
    return P->Z + (size_t)t * DM;
}
namespace rt {
using f32x16 = __attribute__((ext_vector_type(16))) float;
using bf16x8 = __attribute__((ext_vector_type(8))) short;
using u32x4  = __attribute__((ext_vector_type(4))) unsigned;
__device__ __forceinline__ void norm_router(KP P, char* lds, int layer) {
    const int tid = tid_(), lane = tid & 63, wid = tid >> 6, r32 = lane & 31, hh = lane >> 5;
    float* part = (float*)lds;
    float* ssqp = (float*)(lds + 98304);
    float* lg = ssqp + 256;
    float* rsv = lg + 32 * 97;
    const bf16_t* Whi = P->WRT + (size_t)(layer * 2 + 0) * 96 * DM; const bf16_t* Wlo = P->WRT + (size_t)(layer * 2 + 1) * 96 * DM;
    const float* Z = P->Z;
    float* st = (float*)lds + wid * (32 * 68);
    const int nunits = layer == 1 ? (NB * SEQ) / 32 : TOK / 32;
    for (int u = bid_(); u < nunits; u += gridDim.x) {
        const int tok0 = layer == 1 ? (u >> 6) * LL + NMETA + (u & 63) * 32 : u * 32, kb = wid * 256;
        if (false) {
            float* Zw = P->Z; const float* ZP = P->ZP;
            for (int i = tid; i < 32 * DM / 4; i += NTHR) { const int r = i / (DM / 4), c4 = i % (DM / 4);
                float4 z = ((const float4*)(Zw + (size_t)(tok0 + r) * DM))[c4];
#pragma unroll
                for (int ks = 0; ks < 8; ++ks) { const float4 p4 = ((const float4*)(ZP + ((size_t)ks * 256 + (tok0 - 8192 + r)) * DM))[c4]; z.x += p4.x; z.y += p4.y; z.z += p4.z; z.w += p4.w; }
                ((float4*)(Zw + (size_t)(tok0 + r) * DM))[c4] = z; }
            asm volatile("s_waitcnt vmcnt(0)" ::: "memory");
            __syncthreads();
        }
        f32x16 acc[3] = {f32x16{}, f32x16{}, f32x16{}};
        float sq8[8];
#pragma unroll
        for (int j = 0; j < 8; ++j) sq8[j] = 0.f;
        const float* zr_[8];
#pragma unroll
        for (int j = 0; j < 8; ++j) zr_[j] = zrow(P, layer, tok0 + (lane >> 4) + 4 * j) + kb + (lane & 15) * 4;
        const bf16_t* dg = P->DLT + (size_t)(tok0 + (lane >> 4)) * DM + kb + (lane & 15) * 4;
        bf16_t* hg_ = P->HN + (size_t)(tok0 + (lane >> 4)) * DM + kb + (lane & 15) * 4;
        float4 zs[8]; uint2 ds[8];
#pragma unroll
        for (int j = 0; j < 8; ++j) { zs[j] = *(const float4*)(zr_[j]); ds[j] = *(const uint2*)(dg + (size_t)(4 * j) * DM); }
#pragma unroll 1
        for (int sc = 0; sc < 4; ++sc) {
            const float4 lw = *(const float4*)(P->ln2_w + layer * DM + kb + (lane & 15) * 4 + sc * 64);
#pragma unroll
            for (int j = 0; j < 8; ++j) { float4 z = zs[j]; z.x += __uint_as_float(ds[j].x << 16); z.y += __uint_as_float(ds[j].x & 0xffff0000u); z.z += __uint_as_float(ds[j].y << 16); z.w += __uint_as_float(ds[j].y & 0xffff0000u);
                sq8[j] += z.x * z.x + z.y * z.y + z.z * z.z + z.w * z.w;
                *(float4*)(st + ((lane >> 4) + 4 * j) * 68 + (lane & 15) * 4) = z;
                uint2 o; o.x = cvtpk_(z.x * lw.x, z.y * lw.y); o.y = cvtpk_(z.z * lw.z, z.w * lw.w);
                *(uint2*)(hg_ + (size_t)(4 * j) * DM + sc * 64) = o; }
            const int scn = sc < 3 ? sc + 1 : 3;
#pragma unroll
            for (int j = 0; j < 8; ++j) { zs[j] = *(const float4*)(zr_[j] + scn * 64); ds[j] = *(const uint2*)(dg + (size_t)(4 * j) * DM + scn * 64); }
            asm volatile("s_waitcnt lgkmcnt(0)" ::: "memory");
            const bf16_t* wh = Whi + ((size_t)((wid * 16 + sc * 4) * 3) * 64 + lane) * 8; const bf16_t* wl = Wlo + ((size_t)((wid * 16 + sc * 4) * 3) * 64 + lane) * 8;
#pragma unroll
            for (int ks = 0; ks < 4; ++ks) {
                const float4 z0 = *(const float4*)(st + r32 * 68 + ks * 16 + 8 * hh), z1 = *(const float4*)(st + r32 * 68 + ks * 16 + 8 * hh + 4);
                u32x4 h; h.x = cvtpk_(z0.x, z0.y); h.y = cvtpk_(z0.z, z0.w); h.z = cvtpk_(z1.x, z1.y); h.w = cvtpk_(z1.z, z1.w);
                u32x4 l; l.x = cvtpk_(z0.x - __uint_as_float(h.x << 16), z0.y - __uint_as_float(h.x & 0xffff0000u)); l.y = cvtpk_(z0.z - __uint_as_float(h.y << 16), z0.w - __uint_as_float(h.y & 0xffff0000u));
                l.z = cvtpk_(z1.x - __uint_as_float(h.z << 16), z1.y - __uint_as_float(h.z & 0xffff0000u)); l.w = cvtpk_(z1.z - __uint_as_float(h.w << 16), z1.w - __uint_as_float(h.w & 0xffff0000u));
                const bf16x8 zh = *reinterpret_cast<bf16x8*>(&h), zl = *reinterpret_cast<bf16x8*>(&l);
#pragma unroll
                for (int ct = 0; ct < 3; ++ct) {
                    const bf16x8 ah = *(const bf16x8*)(wh + (size_t)((ks * 3 + ct) * 64) * 8), al = *(const bf16x8*)(wl + (size_t)((ks * 3 + ct) * 64) * 8);
                    acc[ct] = __builtin_amdgcn_mfma_f32_32x32x16_bf16(ah, zh, acc[ct], 0, 0, 0);
                    acc[ct] = __builtin_amdgcn_mfma_f32_32x32x16_bf16(ah, zl, acc[ct], 0, 0, 0);
                    acc[ct] = __builtin_amdgcn_mfma_f32_32x32x16_bf16(al, zh, acc[ct], 0, 0, 0);
                }
            }
            asm volatile("s_waitcnt lgkmcnt(0)" ::: "memory");
        }
#pragma unroll
        for (int j = 0; j < 8; ++j) { float v = sq8[j]; v += swz_xor<1>(v); v += swz_xor<2>(v); v += swz_xor<4>(v); v += swz_xor<8>(v); sq8[j] = v; }
        __syncthreads();
        if ((lane & 15) == 0) {
#pragma unroll
            for (int j = 0; j < 8; ++j) ssqp[wid * 32 + (lane >> 4) + 4 * j] = sq8[j];
        }

#pragma unroll
        for (int ct = 0; ct < 3; ++ct)
#pragma unroll
            for (int rg = 0; rg < 16; ++rg) part[((wid * 3 + ct) * 16 + rg) * 64 + lane] = acc[ct][rg];
        __syncthreads();
        if (tid < 32) { float t = 0.f;
#pragma unroll
            for (int w = 0; w < 8; ++w) t += ssqp[w * 32 + tid];
            rsv[tid] = rsqrtf(t * (1.f / DM) + EPS); }
#pragma unroll
        for (int q = 0; q < 6; ++q) { const int o = tid + NTHR * q, col = o >> 5, tok = o & 31, ct = col >> 5, cl = col & 31, h2 = (cl >> 2) & 1, rg = (cl & 3) + 4 * (cl >> 3);
            float t = 0.f;
#pragma unroll
            for (int w = 0; w < 8; ++w) t += part[((w * 3 + ct) * 16 + rg) * 64 + h2 * 32 + tok];
            lg[tok * 97 + col] = t; }
        __syncthreads();
        if (tid < 32) {
            const int t = tok0 + tid; const float rs = rsv[tid]; const float* l = lg + tid * 97;
            const float* brg = P->brg + layer * 8; const float* bre = P->bre + layer * 64;
            float gl[8];
#pragma unroll
            for (int j = 0; j < 8; ++j) gl[j] = l[j] * rs + brg[j];
            int gs = 0; float gm = gl[0];
#pragma unroll
            for (int j = 1; j < 8; ++j) if (gl[j] > gm) { gm = gl[j]; gs = j; }
            float den = 0.f;
#pragma unroll
            for (int j = 0; j < 8; ++j) den += expf(gl[j] - gm);
            const float pg = 1.f / den;
            float el[8];
#pragma unroll
            for (int j = 0; j < 8; ++j) el[j] = l[8 + gs * 8 + j] * rs + bre[gs * 8 + j];
            int j0 = 0; float v0 = el[0];
#pragma unroll
            for (int j = 1; j < 8; ++j) if (el[j] > v0) { v0 = el[j]; j0 = j; }
            int j1 = -1; float v1 = -INFINITY;
#pragma unroll
            for (int j = 0; j < 8; ++j) if (j != j0 && el[j] > v1) { v1 = el[j]; j1 = j; }
            const float e1 = expf(v1 - v0), g0 = pg / (1.f + e1), g1 = pg * e1 / (1.f + e1);
            const int x0 = gs * 8 + j0, x1 = gs * 8 + j1;
            P->ridx[t * 2] = x0; P->ridx[t * 2 + 1] = x1; P->rgate[t * 2] = g0; P->rgate[t * 2 + 1] = g1;
            const int s0 = atomicAdd(&P->cnt[x0 * CSTR], 1), s1 = atomicAdd(&P->cnt[x1 * CSTR], 1);
            P->rslot[t * 2] = s0; P->rslot[t * 2 + 1] = s1;
            P->rsn[t] = rs;
            if (s0 < ECAP) { P->elist[x0 * ECAP + s0] = t; P->ers[x0 * ECAP + s0] = rs; } if (s1 < ECAP) { P->elist[x1 * ECAP + s1] = t; P->ers[x1 * ECAP + s1] = rs; }
        }
        __syncthreads();
    }
}
}
__device__ __forceinline__ void ph_combine_norm(KP P, char* lds, int layer) {
    int* base = (int*)lds;
    const int tid = tid_(), lane = tid & 63, gw = bid_() * 8 + (tid >> 6), NGW = gridDim.x * 8;
    if (tid < 64) { const int c_ = P->cnt[tid * CSTR];
        float a = (float)c_;
#pragma unroll
        for (int d = 1; d < 64; d <<= 1) { const float o = __int_as_float(__builtin_amdgcn_ds_bpermute(4 * ((tid - d) & 63), __float_as_int(a))); if (tid >= d) a += o; }
        base[tid] = (int)a - c_; }
    __syncthreads();
    for (int t0 = gw; t0 < TOK; t0 += 2 * NGW) {
        int r0[2], r1[2]; float g0[2], g1[2]; bool ok[2]; int tcs[2];
        int2 ex[2], sl[2]; float2 gg[2];
        float4 v[2][8]; uint2 ya[2][8], yb[2][8], dl[2][8];
#pragma unroll
        for (int q = 0; q < 2; ++q) { const int t = t0 + q * NGW; ok[q] = t < TOK && !(layer == 1 && (t % LL) < NMETA); tcs[q] = ok[q] ? t : (layer == 1 ? NMETA : t0);
            ex[q] = ((const int2*)P->ridx)[tcs[q]]; sl[q] = ((const int2*)P->rslot)[tcs[q]]; gg[q] = ((const float2*)P->rgate)[tcs[q]];
#pragma unroll
            for (int j = 0; j < 8; ++j) { v[q][j] = ((const float4*)zrow(P, layer, tcs[q]))[lane + 64 * j]; dl[q][j] = ((const uint2*)(P->DLT + (size_t)tcs[q] * DM))[lane + 64 * j]; } }
#pragma unroll
        for (int q = 0; q < 2; ++q) { r0[q] = base[ex[q].x] + sl[q].x; r1[q] = base[ex[q].y] + sl[q].y; g0[q] = gg[q].x; g1[q] = gg[q].y;
#pragma unroll
            for (int j = 0; j < 8; ++j) { ya[q][j] = ((const uint2*)(P->Y + (size_t)r0[q] * DM))[lane + 64 * j]; yb[q][j] = ((const uint2*)(P->Y + (size_t)r1[q] * DM))[lane + 64 * j]; } }
#pragma unroll
        for (int q = 0; q < 2; ++q) if (ok[q]) { const int t = t0 + q * NGW;
            float ss = 0.f;
#pragma unroll
            for (int j = 0; j < 8; ++j) { const uint2 a = ya[q][j], b = yb[q][j], d = dl[q][j]; float4& x = v[q][j];
                {
                  float t[4] = { g0[q] * __uint_as_float(a.x << 16) + g1[q] * __uint_as_float(b.x << 16), g0[q] * __uint_as_float(a.x & 0xffff0000u) + g1[q] * __uint_as_float(b.x & 0xffff0000u),
                                 g0[q] * __uint_as_float(a.y << 16) + g1[q] * __uint_as_float(b.y << 16), g0[q] * __uint_as_float(a.y & 0xffff0000u) + g1[q] * __uint_as_float(b.y & 0xffff0000u) };
                  const int mm = lane & 31, si = mm >> 3, da = mm >> 2, del = mm & 3; float o[4] = {0.f, 0.f, 0.f, 0.f};
#pragma unroll
                  for (int r = 0; r < 4; ++r) { const int se = (si + r) & 3; const float snd = se == 0 ? t[0] : se == 1 ? t[1] : se == 2 ? t[2] : t[3];
                      const int sl = (del - r) & 3; const float rcv = __int_as_float(__builtin_amdgcn_ds_bpermute(4 * ((lane & 32) + 8 * sl + da), __float_as_int(snd)));
                      o[0] = sl == 0 ? rcv : o[0]; o[1] = sl == 1 ? rcv : o[1]; o[2] = sl == 2 ? rcv : o[2]; o[3] = sl == 3 ? rcv : o[3]; }
                  x.x += o[0]; x.y += o[1]; x.z += o[2]; x.w += o[3]; }
                x.x += __uint_as_float(d.x << 16); x.y += __uint_as_float(d.x & 0xffff0000u); x.z += __uint_as_float(d.y << 16); x.w += __uint_as_float(d.y & 0xffff0000u);
                ss += x.x * x.x + x.y * x.y + x.z * x.z + x.w * x.w; }
            const float rs = rsqrtf(wave_sum(ss) * (1.f / DM) + EPS);
            if (layer == 0) {
#pragma unroll
                for (int j = 0; j < 8; ++j) { ((float4*)(P->Z + (size_t)t * DM))[lane + 64 * j] = v[q][j];
                    const float4 w = ((const float4*)(P->ln1_w + DM))[lane + 64 * j];
                    uint2 o; o.x = cvtpk_(v[q][j].x * rs * w.x, v[q][j].y * rs * w.y); o.y = cvtpk_(v[q][j].z * rs * w.z, v[q][j].w * rs * w.w);
                    ((uint2*)(P->HN + (size_t)t * DM))[lane + 64 * j] = o; }
            } else {
                const int b = t / LL, tt = t % LL;
                if (tt >= NMETA) {
#pragma unroll
                    for (int j = 0; j < 8; ++j) { const float4 w = ((const float4*)P->fnw)[lane + 64 * j];
                        typedef float f32x4n __attribute__((ext_vector_type(4)));
                        const f32x4n ov = {v[q][j].x * rs * w.x, v[q][j].y * rs * w.y, v[q][j].z * rs * w.z, v[q][j].w * rs * w.w};
                        __builtin_nontemporal_store(ov, (f32x4n*)(P->out + ((size_t)b * SEQ + (tt - NMETA)) * DM) + lane + 64 * j); }
                }
            }
        }
    }
    __syncthreads();
}

__global__ void __launch_bounds__(NTHR, 2) mega_fwd(Params P_arg) {
    extern __shared__ __attribute__((aligned(16))) char lds[];
    const int tid = tid_(), G = gridDim.x;
    volatile LAS unsigned* ctlw = (volatile LAS unsigned*)((LAS char*)lds + LDS_CTL);
    if (tid < 64) ctlw[tid] = 0u;
    __syncthreads();
    KP P = kp_();
    XcdBarrier bar = xcd_barrier_post(P->bar, ctlw + 8);
#define GRID_BAR() do { xcd_barrier(bar); P = kp_(); } while (0)

    ph_build_norm(P);
    ph_prep(P);
    ph_weights(P, lds);
    __syncthreads();
    for (int un = bid_(); un < 64; un += G) s5::prep_unit(P, lds, un >> 5, un & 31);
    GRID_BAR();
#pragma unroll
    for (int layer = 0; layer < 2; ++layer) {
        { pg8::Gemm g{P->HN, P->WinT + (size_t)layer * INW * DM, MP, INW, DM, DM}; pg8::StaticOrder S; S.init(MP, INW, G, bid_(), DM / 64); pg8::EpiInProj E{P->PA, P->QKV};
          pg8::gemm_phase<pg8::EpiInProj, pg8::StaticOrder, true, true>((LAS unsigned char*)lds, g, S, E); }
        { const int t2 = tid_(), b2 = bid_(); if (b2 == 0 && t2 < NE) P->cnt[t2 * CSTR] = 0;
 }
        GRID_BAR();
        hg::local_states(P, lds, layer);
        { const int b0 = bid_(); for (int un = (G == 256) ? ((b0 + 128) & 255) : b0; un < 128; un += G) s5::fused_unit(P, lds, layer, un >> 5, un & 31); }
        ph_attention(P, lds);
        GRID_BAR();
        hg::scan_states(P);
        ph_attn_out(P, layer, G > 192 ? 132 : 0);
        __syncthreads();
        { pg8::Gemm g{P->YG, P->WgluT + (size_t)layer * 1024 * 512, MP, 1024, 512, 512}; pg8::StaticOrder S; S.init(MP, 1024, G, bid_(), 512 / 64); pg8::EpiGlu E{P->MIX, P->b_glu + layer * 1024};
          pg8::gemm_phase<pg8::EpiGlu, pg8::StaticOrder, true, true>((LAS unsigned char*)lds, g, S, E); }
        GRID_BAR();
        hg::outputs(P, lds, layer);
        GRID_BAR();
        { pg8::Gemm g{P->MIX, P->WoutT + (size_t)layer * DM * DM, MP, DM, DM, DM}; pg8::StaticOrder S; S.init(MP, DM, G, bid_(), DM / 64); pg8::EpiResidual E{P->DLT};
          pg8::gemm_phase<pg8::EpiResidual, pg8::StaticOrder, true, true>((LAS unsigned char*)lds, g, S, E); }
        GRID_BAR();
        rt::norm_router(P, lds, layer);
        GRID_BAR();
        moe::stream_gemm<true>(P, lds, layer);
        GRID_BAR();
        moe::stream_gemm<false>(P, lds, layer);
        GRID_BAR();
        ph_combine_norm(P, lds, layer);
        if (layer == 0) GRID_BAR();
    }
}
}

extern "C" void kernel_launch(void* const* d_in, const int* in_sizes, int n_in, void* d_out, int out_size, void* d_ws, size_t ws_size, hipStream_t stream) {
    static int grid = 0;
    if (grid == 0) {
        int dev = 0, cus = 0;
        if (hipGetDevice(&dev) != hipSuccess || hipDeviceGetAttribute(&cus, hipDeviceAttributeMultiprocessorCount, dev) != hipSuccess) { grid = -1; return; }
        if (hipFuncSetAttribute((const void*)mega_fwd, hipFuncAttributeMaxDynamicSharedMemorySize, LDS_BYTES) != hipSuccess) { grid = -1; return; }
        int per_cu = 0;
        if (hipOccupancyMaxActiveBlocksPerMultiprocessor(&per_cu, (const void*)mega_fwd, NTHR, LDS_BYTES) != hipSuccess || per_cu < 1) { (void)hipGetLastError(); }
        grid = cus;
    }
    if (grid < 0) return;
    Params p{};
    const float** pin = (const float**)&p;
    for (int i = 0; i < 31; ++i) pin[i] = (const float*)d_in[i];
    p.out = (float*)d_out;
    char* ws = (char*)d_ws; size_t off = 0;
    auto alloc = [&](size_t bytes) { char* q = ws + off; off += (bytes + 255) & ~(size_t)255; return q; };
    p.bar = (unsigned*)alloc(XCD_BAR_WORDS * 4);
    p.elist = (int*)alloc((size_t)NE * ECAP * 4); p.ers = (float*)alloc((size_t)NE * ECAP * 4); p.rsn = (float*)alloc((size_t)MP * 4);
    p.cnt = (int*)alloc((size_t)NE * CSTR * 4); p.blk_e = (int*)alloc(1024); p.base = (int*)alloc(256);
    p.lbtab = (float*)alloc(1024 * 4); p.lam = (float*)alloc(256);
    p.Z = (float*)alloc((size_t)MP * DM * 4);
    p.HN = (bf16_t*)alloc((size_t)MP * DM * 2);
    p.PA = (float*)alloc((size_t)MP * PAW * 4);
    p.QKV = (bf16_t*)alloc((size_t)MP * QKVW * 2);
    p.OA = (float*)alloc((size_t)MP * HW * 4);
    p.ZP = (float*)alloc((size_t)8 * 256 * DM * 4);
    p.WRT = (bf16_t*)alloc((size_t)2 * 2 * 96 * DM * 2);
    p.A16 = (float*)alloc(2 * 32 * 64 * 8); p.S5E = (float*)alloc((size_t)516 * 32 * 128 * 4); p.S5X = (float*)alloc((size_t)516 * 32 * 128 * 4);
    p.BtY = (bf16_t*)alloc((size_t)2 * 32 * 256 * 384 * 2); p.BtE = (bf16_t*)alloc((size_t)2 * 32 * 128 * 256 * 2);
    p.SLOC = (float*)alloc((size_t)528 * 16384 * 4); p.DEC = (float*)alloc((size_t)528 * 128 * 4); p.SPREV = (bf16_t*)alloc((size_t)529 * 16384 * 2);
    p.YG = (bf16_t*)alloc((size_t)MP * 512 * 2); p.DLT = (bf16_t*)alloc((size_t)MP * DM * 2);
    p.T = nullptr;
    p.MIX = (bf16_t*)alloc((size_t)MP * DM * 2);
    p.OC = (float*)alloc((size_t)MP * DM * 4);
    p.ridx = (int*)alloc((size_t)NASSIGN * 4); p.rgate = (float*)alloc((size_t)NASSIGN * 4); p.rslot = (int*)alloc((size_t)NASSIGN * 4);
    p.tokrow = (int*)alloc((size_t)NASSIGN * 4); p.rowtok = (int*)alloc((size_t)NRMAX * 4);
    p.H1 = nullptr;
    p.H = (bf16_t*)alloc((size_t)NRMAX * DE * 2);
    p.Y = (bf16_t*)alloc((size_t)NRMAX * DM * 2);
    p.S = nullptr;
    p.WinT = (bf16_t*)alloc((size_t)2 * INW * DM * 2); p.WoutT = (bf16_t*)alloc((size_t)2 * DM * DM * 2); p.WgluT = (bf16_t*)alloc((size_t)2 * 1024 * 512 * 2);
    if (off > ws_size) return;
    if (hipMemsetAsync(p.bar, 0, XCD_BAR_WORDS * 4, stream) != hipSuccess) return;
    hipLaunchKernelGGL(mega_fwd, dim3(grid), dim3(NTHR), LDS_BYTES, stream, p);
}
```
